# Optimizing an MI355X kernel written in HIP

```python
import numpy as np
import jax, jax.numpy as jnp
from jax import lax

D_MODEL = 1024
BATCH = 4
SEQ = 8192
DEPTH = 1

GRID_W = 64
MIX_WIDTH = D_MODEL
NA_HEADS = 8
NA_WIDTH = MIX_WIDTH // 2
NA_HEAD_DIM = NA_WIDTH // NA_HEADS
NA_WIN_ROWS = 8
NA_WIN_COLS = 16
HG_HEADS = 4
HG_WIDTH = MIX_WIDTH // 4
HG_VAL_DIM = HG_WIDTH // HG_HEADS
HG_KEY_DIM = 64
HG_KWIDTH = HG_HEADS * HG_KEY_DIM
HG_CHUNK = 64
MEM_TOKENS = 256
MEM_HEADS = 4
MEM_WIDTH = MIX_WIDTH // 4
MEM_HEAD_DIM = MEM_WIDTH // MEM_HEADS
IN_SPLITS = (NA_WIDTH, NA_WIDTH, NA_WIDTH,
             HG_KWIDTH, HG_KWIDTH, HG_KWIDTH,
             HG_WIDTH, HG_WIDTH,
             MEM_WIDTH)
IN_WIDTH = sum(IN_SPLITS)
PEER_HEADS = 8
PEER_NKEYS = 128
PEER_TOPK = 16
PEER_QDIM = 256
N_EXPERTS = PEER_NKEYS * PEER_NKEYS
PEER_BLOCK = 128
RMS_EPS = 1e-6

kernel_name = 'hybrid_natten_hgrn2_memxattn_peer_encoder'


def _rms_normalize(x):
    xf = x.astype(jnp.float32)
    return xf * lax.rsqrt(jnp.mean(xf * xf, axis=-1, keepdims=True) + RMS_EPS)


def rmsnorm(x, g):
    return (_rms_normalize(x) * g.astype(jnp.float32)).astype(x.dtype)


def neighbourhood_attention(q, k, v, rpb):
    B, T, H, Dh = q.shape
    rows = T // GRID_W
    wr = min(NA_WIN_ROWS, rows)
    wc = NA_WIN_COLS
    cols = np.arange(GRID_W)
    c0 = np.clip(cols - wc // 2, 0, GRID_W - wc)
    col_idx = c0[:, None] + np.arange(wc)[None, :]
    dc = col_idx - cols[:, None] + (NA_WIN_COLS - 1)
    bias_c = rpb[:, :, dc]
    qg = q.reshape(B, rows, GRID_W, H, Dh)
    kg = k.reshape(B, rows, GRID_W, H, Dh)
    vg = v.reshape(B, rows, GRID_W, H, Dh)
    scale = Dh ** -0.5

    def one_row(r):
        rs = jnp.clip(r - wr // 2, 0, rows - wr)
        kb = lax.dynamic_slice_in_dim(kg, rs, wr, axis=1)
        vb = lax.dynamic_slice_in_dim(vg, rs, wr, axis=1)
        kw = kb[:, :, col_idx]
        vw = vb[:, :, col_idx]
        qr = lax.dynamic_index_in_dim(qg, r, axis=1, keepdims=False)
        dr = rs + jnp.arange(wr) - r + (NA_WIN_ROWS - 1)
        bias = jnp.take(bias_c, dr, axis=1).transpose(0, 2, 1, 3)
        s = jnp.einsum('bqhd,brqjhd->bhqrj', qr, kw) * scale + bias[None].astype(qr.dtype)
        p = jax.nn.softmax(s.reshape(B, H, GRID_W, wr * wc).astype(jnp.float32), axis=-1)
        p = p.reshape(B, H, GRID_W, wr, wc).astype(v.dtype)
        return jnp.einsum('bhqrj,brqjhd->bqhd', p, vw)

    out = lax.map(one_row, jnp.arange(rows))
    return out.transpose(1, 0, 2, 3, 4).reshape(B, T, H * Dh)


def hgrn2_scan(q, k, v, log_f):
    B, T, H, K = q.shape
    V = v.shape[-1]
    n = T // HG_CHUNK

    def to_chunks(a):
        return a.reshape(B, n, HG_CHUNK, H, a.shape[-1]).transpose(1, 0, 2, 3, 4)

    causal_in_chunk = jnp.tril(jnp.ones((HG_CHUNK, HG_CHUNK), dtype=bool))[None, :, :, None, None]

    def step(S, inp):
        qc, kc, vc, lc = inp
        b = jnp.cumsum(lc, axis=1)
        o_inter = jnp.einsum('bthk,bhkv->bthv', qc * jnp.exp(b), S)
        d = b[:, :, None] - b[:, None]
        decay = jnp.exp(jnp.where(causal_in_chunk, d, -jnp.inf))
        A = jnp.einsum('bthk,bshk,btshk->bhts', qc, kc, decay)
        o = o_inter + jnp.einsum('bhts,bshv->bthv', A, vc)
        b_last = b[:, -1]
        S = jnp.exp(b_last)[..., None] * S + jnp.einsum(
            'bshk,bshv->bhkv', kc * jnp.exp(b_last[:, None] - b), vc)
        return S, o

    S0 = jnp.zeros((B, H, K, V), jnp.float32)
    _, o = lax.scan(step, S0, (to_chunks(q), to_chunks(k), to_chunks(v), to_chunks(log_f)))
    return o.transpose(1, 0, 2, 3, 4).reshape(B, T, H, V)


def hgrn2_bidirectional(q, i, f_pre_fwd, f_pre_bwd, lb_fwd, lb_bwd):
    B, T, _ = q.shape
    qh = q.astype(jnp.float32).reshape(B, T, HG_HEADS, HG_KEY_DIM)
    vh = i.astype(jnp.float32).reshape(B, T, HG_HEADS, HG_VAL_DIM)

    def gates(f_pre, lb):
        f = lb + (1.0 - lb) * jax.nn.sigmoid(f_pre.astype(jnp.float32))
        f = f.reshape(B, T, HG_HEADS, HG_KEY_DIM)
        return 1.0 - f, jnp.log(f)

    kf, lf = gates(f_pre_fwd, lb_fwd)
    kb, lbk = gates(f_pre_bwd, lb_bwd)
    o_fwd = hgrn2_scan(qh, kf, vh, lf)
    flip = lambda a: a[:, ::-1]
    o_bwd = flip(hgrn2_scan(flip(qh), flip(kb), flip(vh), flip(lbk)))
    return o_fwd + o_bwd


def memory_cross_attention(mq, mem_n, w_kv):
    B, T, _ = mq.shape
    M = mem_n.shape[1]
    kv = mem_n @ w_kv
    mk, mv = jnp.split(kv, 2, axis=-1)
    qh = mq.reshape(B, T, MEM_HEADS, MEM_HEAD_DIM)
    mk = mk.reshape(B, M, MEM_HEADS, MEM_HEAD_DIM)
    mv = mv.reshape(B, M, MEM_HEADS, MEM_HEAD_DIM)
    s = jnp.einsum('bthd,bmhd->bhtm', qh, mk) * (MEM_HEAD_DIM ** -0.5)
    p = jax.nn.softmax(s.astype(jnp.float32), axis=-1).astype(mv.dtype)
    return jnp.einsum('bhtm,bmhd->bthd', p, mv).reshape(B, T, MEM_WIDTH)


def peer_ffn(h, w_query, sub_keys, u, v):
    B, T, D = h.shape
    qp = (h @ w_query).reshape(B, T, PEER_HEADS, 2, PEER_QDIM // 2)
    s = jnp.einsum('bthcd,hcnd->bthcn', qp, sub_keys).astype(jnp.float32)
    top_s, top_i = lax.top_k(s, PEER_TOPK)
    cand_s = top_s[..., 0, :, None] + top_s[..., 1, None, :]
    cand_i = top_i[..., 0, :, None] * PEER_NKEYS + top_i[..., 1, None, :]
    cand_s = cand_s.reshape(B, T, PEER_HEADS, PEER_TOPK * PEER_TOPK)
    cand_i = cand_i.reshape(B, T, PEER_HEADS, PEER_TOPK * PEER_TOPK)
    best_s, pos = lax.top_k(cand_s, PEER_TOPK)
    eidx = jnp.take_along_axis(cand_i, pos, axis=-1)
    gate = jax.nn.softmax(best_s, axis=-1)
    nb = (B * T) // PEER_BLOCK
    E = PEER_HEADS * PEER_TOPK
    xb = h.reshape(nb, PEER_BLOCK, D)
    ib = eidx.reshape(nb, PEER_BLOCK, E)
    gb = gate.reshape(nb, PEER_BLOCK, E).astype(h.dtype)

    def block(args):
        xt, it, gt = args
        ue = u[it]
        ve = v[it]
        a = jax.nn.gelu(jnp.einsum('nd,ned->ne', xt, ue), approximate=False)
        return jnp.einsum('ne,ned->nd', a * gt, ve)

    return lax.map(block, (xb, ib, gb)).reshape(B, T, D)


def setup_inputs(seed: int = 0) -> dict:
    key = jax.random.key(seed)
    ks = jax.random.split(key, 16)
    nrm = lambda k, shape, scale: jax.random.normal(k, shape, jnp.float32) * scale
    return {
        'x': nrm(ks[0], (BATCH, SEQ, D_MODEL), 1.0),
        'mem': nrm(ks[1], (BATCH, MEM_TOKENS, D_MODEL), 1.0),
        'attn_norm_g': 1.0 + nrm(ks[2], (DEPTH, D_MODEL), 0.02),
        'w_in': nrm(ks[3], (DEPTH, D_MODEL, IN_WIDTH), D_MODEL ** -0.5),
        'na_rpb': nrm(ks[4], (DEPTH, NA_HEADS, 2 * NA_WIN_ROWS - 1, 2 * NA_WIN_COLS - 1), 0.1),
        'hg_lower_bound': nrm(ks[5], (2, DEPTH + 1, HG_KWIDTH), 0.1),
        'hg_out_norm_g': 1.0 + nrm(ks[6], (DEPTH, HG_WIDTH), 0.02),
        'mem_norm_g': 1.0 + nrm(ks[7], (DEPTH, D_MODEL), 0.02),
        'w_mem_kv': nrm(ks[8], (DEPTH, D_MODEL, 2 * MEM_WIDTH), D_MODEL ** -0.5),
        'w_out': nrm(ks[9], (DEPTH, MIX_WIDTH, D_MODEL), MIX_WIDTH ** -0.5),
        'ffn_norm_g': 1.0 + nrm(ks[10], (DEPTH, D_MODEL), 0.02),
        'peer_w_query': nrm(ks[11], (DEPTH, D_MODEL, PEER_HEADS * PEER_QDIM), D_MODEL ** -0.5),
        'peer_sub_keys': nrm(ks[12], (DEPTH, PEER_HEADS, 2, PEER_NKEYS, PEER_QDIM // 2), (PEER_QDIM // 2) ** -0.5),
        'peer_u': nrm(ks[13], (DEPTH, N_EXPERTS, D_MODEL), D_MODEL ** -0.5),
        'peer_v': nrm(ks[14], (DEPTH, N_EXPERTS, D_MODEL), 0.5),
        'final_norm_g': 1.0 + nrm(ks[15], (D_MODEL,), 0.02),
    }


def reference(x, mem, attn_norm_g, w_in, na_rpb, hg_lower_bound, hg_out_norm_g, mem_norm_g,
              w_mem_kv, w_out, ffn_norm_g, peer_w_query, peer_sub_keys, peer_u, peer_v,
              final_norm_g):
    B, T, _ = x.shape
    lb_table = jnp.cumsum(jax.nn.softmax(hg_lower_bound.astype(jnp.float32), axis=1), axis=1)
    offsets = np.cumsum(IN_SPLITS)[:-1].tolist()
    for layer in range(DEPTH):
        h = rmsnorm(x, attn_norm_g[layer])
        z = h @ w_in[layer]
        na_q, na_k, na_v, hg_q, hg_ff, hg_fb, hg_i, hg_g, mem_q = jnp.split(z, offsets, axis=-1)
        shp = (B, T, NA_HEADS, NA_HEAD_DIM)
        na_out = neighbourhood_attention(na_q.reshape(shp), na_k.reshape(shp), na_v.reshape(shp),
                                         na_rpb[layer])
        o = hgrn2_bidirectional(hg_q, hg_i, hg_ff, hg_fb, lb_table[0, layer], lb_table[1, layer])
        o = _rms_normalize(o) * hg_out_norm_g[layer].astype(jnp.float32).reshape(HG_HEADS, HG_VAL_DIM)
        hg_out = (o.reshape(B, T, HG_WIDTH) * jax.nn.silu(hg_g.astype(jnp.float32))).astype(x.dtype)
        mem_out = memory_cross_attention(mem_q, rmsnorm(mem, mem_norm_g[layer]), w_mem_kv[layer])
        mix = jnp.concatenate([na_out, hg_out, mem_out], axis=-1)
        x = x + mix @ w_out[layer]
        h2 = rmsnorm(x, ffn_norm_g[layer])
        x = x + peer_ffn(h2, peer_w_query[layer], peer_sub_keys[layer], peer_u[layer], peer_v[layer])
    return rmsnorm(x, final_norm_g)
```

```cpp
#include <hip/hip_runtime.h>
#include <hip/hip_cooperative_groups.h>
#include <stdint.h>
#include <cstdio>

namespace cg = cooperative_groups;

#define VTID ((int)(threadIdx.x & 255))
#define VHB ((int)(threadIdx.x >> 8))
#define VBID ((int)(blockIdx.x * 2 + (threadIdx.x >> 8)))
#define VGRID ((int)(gridDim.x * 2))
constexpr int HALF_SMEM = 73728;

typedef unsigned short bf16_t;
typedef short bf16x8 __attribute__((ext_vector_type(8)));
typedef float f32x4 __attribute__((ext_vector_type(4)));

constexpr int D = 1024;
constexpr int NB = 4;
constexpr int T = 8192;
constexpr int NTOK = NB * T;
constexpr int INW = 3072;
constexpr int QW = 2048;
constexpr float EPS = 1e-6f;
constexpr int SMEM_BYTES = 2 * 73728;
constexpr int NPHASE = 14;

constexpr size_t al256(size_t x) { return (x + 255) & ~(size_t)255; }
constexpr size_t OFF_W_IN_T = 0;
constexpr size_t OFF_W_OUT_T = OFF_W_IN_T + al256((size_t)3072 * 1024 * 2);
constexpr size_t OFF_W_Q_T = OFF_W_OUT_T + al256((size_t)1024 * 1024 * 2);
constexpr size_t OFF_W_KV_T = OFF_W_Q_T + al256((size_t)2048 * 1024 * 2);
constexpr size_t OFF_H = OFF_W_KV_T + al256((size_t)512 * 1024 * 2);
constexpr size_t OFF_Z = OFF_H + al256((size_t)32768 * 1024 * 2);
constexpr size_t OFF_MIX = OFF_Z + al256((size_t)32768 * 3072 * 2);
constexpr size_t OFF_MEMN = OFF_MIX + al256((size_t)32768 * 1024 * 2);
constexpr size_t OFF_KVB = OFF_MEMN + al256((size_t)1024 * 1024 * 2);
constexpr size_t OFF_LB = OFF_KVB + al256((size_t)1024 * 512 * 2);
constexpr size_t OFF_HSTATE = OFF_LB + al256(512 * 4);
constexpr size_t OFF_HDEC = OFF_HSTATE + al256((size_t)4096 * 4096 * 4);
constexpr size_t OFF_UC = OFF_HDEC + al256((size_t)4096 * 64 * 4);
constexpr size_t OFF_VC = OFF_UC + al256((size_t)16384 * 1024);
constexpr size_t OFF_QUEUE = OFF_VC + al256((size_t)16384 * 1024);
constexpr size_t OFF_SUBK = OFF_QUEUE + al256(2048 * 4);
constexpr size_t OFF_BAR = OFF_SUBK + al256((size_t)16 * 128 * 128 * 2);
constexpr size_t OFF_SS1 = OFF_BAR + al256(4096 * 4);
constexpr size_t OFF_HMAX = OFF_SS1 + al256((size_t)32768 * 4);
constexpr size_t OFF_CSUM = OFF_HMAX + al256((size_t)32768 * 4);
constexpr size_t OFF_SCALE_U = OFF_CSUM + al256((size_t)32768 * 4);
constexpr size_t OFF_SCALE_V = OFF_SCALE_U + al256(16384 * 4);
constexpr size_t OFF_VT = OFF_SCALE_V + al256(16384 * 4);
constexpr size_t OFF_KVT = OFF_VT + al256((size_t)32768 * 512 * 2);
constexpr size_t WS_TOTAL = OFF_KVT + al256((size_t)1024 * 256 * 2);
constexpr size_t OFF_EIDX = OFF_HSTATE;
constexpr size_t OFF_GATE = OFF_HSTATE + (size_t)32768 * 128 * 4;
constexpr size_t OFF_COEF = OFF_HSTATE + (size_t)32768 * 128 * 8;
constexpr size_t OFF_SS = OFF_HSTATE + (size_t)32768 * 128 * 12;
constexpr size_t OFF_PARTIAL = OFF_Z;
constexpr size_t OFF_PEER_OUT = OFF_Z + (size_t)8 * 32768 * 128 * 4;

struct Params {
    const float *x, *mem, *attn_g, *w_in, *rpb, *hg_lb, *hg_g, *mem_g, *w_kv, *w_out, *ffn_g, *w_q, *subk, *pu, *pv, *fin_g;
    float* out;
    char* ws;
#define WSF(type, name, off) __device__ __forceinline__ type* name() const { return (type*)(ws + (off)); }
    WSF(bf16_t, w_in_t, OFF_W_IN_T) WSF(bf16_t, w_out_t, OFF_W_OUT_T) WSF(bf16_t, w_q_t, OFF_W_Q_T) WSF(bf16_t, w_kv_t, OFF_W_KV_T)
    WSF(bf16_t, h, OFF_H)
    WSF(bf16_t, z, OFF_Z)
    WSF(bf16_t, mix, OFF_MIX)
    WSF(bf16_t, memn, OFF_MEMN)
    WSF(bf16_t, kvb, OFF_KVB)
    WSF(float, lb, OFF_LB)
    WSF(float, hstate, OFF_HSTATE)
    WSF(float, hdec, OFF_HDEC)
    WSF(unsigned short, eidx, OFF_EIDX)
    WSF(float, gate, OFF_GATE)
    WSF(signed char, coef, OFF_COEF)
    WSF(bf16_t, peer_out, OFF_PEER_OUT)
    WSF(float, ss, OFF_SS)
    WSF(float, partial, OFF_PARTIAL)
    WSF(bf16_t, u_c, OFF_UC) WSF(bf16_t, v_c, OFF_VC)
    WSF(unsigned, queue, OFF_QUEUE)
    WSF(bf16_t, subk_b, OFF_SUBK)
    WSF(unsigned, bar, OFF_BAR)
    WSF(float, ss1, OFF_SS1) WSF(unsigned, hmax, OFF_HMAX) WSF(float, csum, OFF_CSUM)
    WSF(float, scale_u, OFF_SCALE_U) WSF(float, scale_v, OFF_SCALE_V)
    WSF(bf16_t, vT, OFF_VT)
    WSF(bf16_t, kvT, OFF_KVT)
#undef WSF
};

__device__ __forceinline__ float bf2f(bf16_t v) { return __uint_as_float(((unsigned)v) << 16); }
__device__ __forceinline__ bf16_t f2bf(float f) {
    unsigned u = __float_as_uint(f);
    u += 0x7FFFu + ((u >> 16) & 1u);
    return (bf16_t)(u >> 16);
}
__device__ __forceinline__ float bflo(unsigned u) { return __uint_as_float(u << 16); }
__device__ __forceinline__ float bfhi(unsigned u) { return __uint_as_float(u & 0xFFFF0000u); }
typedef __bf16 bf16x2v_t __attribute__((ext_vector_type(2)));
typedef float f32x2v_t __attribute__((ext_vector_type(2)));
__device__ __forceinline__ unsigned pack2(float a, float b) {
    const f32x2v_t v = {a, b};
    return __builtin_bit_cast(unsigned, __builtin_convertvector(v, bf16x2v_t));
}

__device__ __forceinline__ float wave_sum(float v) {
#pragma unroll
    for (int o = 32; o; o >>= 1) v += __shfl_xor(v, o);
    return v;
}
__device__ __forceinline__ float wave_max(float v) {
#pragma unroll
    for (int o = 32; o; o >>= 1) v = fmaxf(v, __shfl_xor(v, o));
    return v;
}


typedef __bf16 bf16x2_t __attribute__((ext_vector_type(2)));
__device__ __forceinline__ float dot2bf(unsigned a, unsigned b, float acc) {
    return __builtin_amdgcn_fdot2_f32_bf16(__builtin_bit_cast(bf16x2_t, a), __builtin_bit_cast(bf16x2_t, b), acc, false);
}
template <int CTRL>
__device__ __forceinline__ float dpp_mov(float v) {
    return __builtin_bit_cast(float, __builtin_amdgcn_update_dpp(0, __builtin_bit_cast(int, v), CTRL, 0xf, 0xf, true));
}
#define DPP_QP_X1 0xB1
#define DPP_QP_X2 0x4E
#define DPP_HMIRROR 0x141
#define DPP_ROR8 0x128
__device__ __forceinline__ unsigned xcc_id() { return (unsigned)__builtin_amdgcn_s_getreg((3 << 11) | 20) & 0xFu; }

__device__ __forceinline__ void transpose_tile(const float* __restrict__ in, bf16_t* __restrict__ out, int K, int N, int tile, char* smem) {
    float* tl = (float*)smem;
    const int ntn = N >> 6;
    const int k0 = (tile / ntn) << 6, n0 = (tile % ntn) << 6;
    const int tid = VTID;
    __syncthreads();
#pragma unroll 4
    for (int i = 0; i < 16; ++i) {
        int idx = tid + 256 * i;
        int r = idx >> 6, c = idx & 63;
        tl[r * 65 + c] = in[(size_t)(k0 + r) * N + n0 + c];
    }
    __syncthreads();
#pragma unroll 4
    for (int i = 0; i < 16; ++i) {
        int idx = tid + 256 * i;
        int r = idx >> 6, c = idx & 63;
        out[(size_t)(n0 + r) * K + k0 + c] = f2bf(tl[c * 65 + r]);
    }
}

__device__ __forceinline__ void rmsnorm_row_bf16(const float* __restrict__ xr, const float* __restrict__ g, bf16_t* __restrict__ o, int lane) {
    float4 v[4];
    float ss = 0.f;
#pragma unroll
    for (int j = 0; j < 4; ++j) {
        v[j] = *(const float4*)(xr + (j * 64 + lane) * 4);
        ss += v[j].x * v[j].x + v[j].y * v[j].y + v[j].z * v[j].z + v[j].w * v[j].w;
    }
    ss = wave_sum(ss);
    const float rs = rsqrtf(ss * (1.0f / 1024.0f) + EPS);
#pragma unroll
    for (int j = 0; j < 4; ++j) {
        const float4 gg = *(const float4*)(g + (j * 64 + lane) * 4);
        uint2 pk;
        pk.x = pack2(v[j].x * rs * gg.x, v[j].y * rs * gg.y);
        pk.y = pack2(v[j].z * rs * gg.z, v[j].w * rs * gg.w);
        *(uint2*)(o + (j * 64 + lane) * 4) = pk;
    }
}

__device__ void phase_prep(const Params& p, char* smem) {
    const int tid = VTID, lane = tid & 63, w = tid >> 6;
    const int gsz = VGRID, bid = VBID;
    const int t_in = (1024 / 64) * (INW / 64);
    const int t_out = 16 * 16;
    const int t_q = 16 * (QW / 64);
    const int t_kv = 16 * 8;
    const int t_all = t_in + t_out + t_q + t_kv;
    for (int it = bid; it < t_all; it += gsz) {
        if (it < t_in) transpose_tile(p.w_in, p.w_in_t(), 1024, INW, it, smem);
        else if (it < t_in + t_out) transpose_tile(p.w_out, p.w_out_t(), 1024, 1024, it - t_in, smem);
        else if (it < t_in + t_out + t_q) transpose_tile(p.w_q, p.w_q_t(), 1024, QW, it - t_in - t_out, smem);
        else transpose_tile(p.w_kv, p.w_kv_t(), 1024, 512, it - t_in - t_out - t_q, smem);
    }
    for (int i = bid * 256 + tid; i < NTOK; i += gsz * 256) { p.ss1()[i] = 0.f; p.hmax()[i] = 0u; }
    if (bid == 0) for (int i = tid; i < 2048; i += 256) p.queue()[i] = 0u;
    if (bid == 0) {
        for (int i = tid; i < 512; i += 256) {
            int dir = i >> 8, k = i & 255;
            float a0 = p.hg_lb[(dir * 2 + 0) * 256 + k], a1 = p.hg_lb[(dir * 2 + 1) * 256 + k];
            float m = fmaxf(a0, a1);
            float e0 = expf(a0 - m), e1 = expf(a1 - m);
            p.lb()[i] = e0 / (e0 + e1);
        }
    }
    const int nrows = NTOK + 1024;
    for (int r0 = bid * 4; r0 < nrows; r0 += gsz * 4) {
        int r = r0 + w;
        if (r < NTOK) rmsnorm_row_bf16(p.x + (size_t)r * D, p.attn_g, p.h() + (size_t)r * D, lane);
        else if (r < nrows) rmsnorm_row_bf16(p.mem + (size_t)(r - NTOK) * D, p.mem_g, p.memn() + (size_t)(r - NTOK) * D, lane);
    }
    for (int i = bid * 256 + tid; i < 16 * 128 * 128 / 4; i += gsz * 256) {
        const float4 v = *(const float4*)(p.subk + (size_t)i * 4);
        uint2 pk; pk.x = pack2(v.x, v.y); pk.y = pack2(v.z, v.w);
        *(uint2*)(p.subk_b() + (size_t)i * 4) = pk;
    }
    for (int r0 = bid * 4; r0 < 2 * 16384; r0 += gsz * 4) {
        const int r = r0 + w;
        const bool isv = r >= 16384;
        const int e = r & 16383;
        const float* srcp = (isv ? p.pv : p.pu) + (size_t)e * D;
        unsigned* dst = (unsigned*)(isv ? p.v_c() : p.u_c());
        float4 v[4];
        float am = 0.f;
#pragma unroll
        for (int j = 0; j < 4; ++j) {
            v[j] = *(const float4*)(srcp + (j * 64 + lane) * 4);
            am = fmaxf(am, fmaxf(fmaxf(fabsf(v[j].x), fabsf(v[j].y)), fmaxf(fabsf(v[j].z), fabsf(v[j].w))));
        }
        am = wave_max(am);
        const float qs = am > 0.f ? 127.0f / am : 0.f;
        if (lane == 0) (isv ? p.scale_v() : p.scale_u())[e] = am * (1.0f / 127.0f);
        const int off = 0;
#pragma unroll
        for (int j = 0; j < 4; ++j) {
            const int q0 = (int)rintf(v[j].x * qs) + off, q1 = (int)rintf(v[j].y * qs) + off;
            const int q2 = (int)rintf(v[j].z * qs) + off, q3 = (int)rintf(v[j].w * qs) + off;
            const unsigned pk = (unsigned)(q0 & 255) | ((unsigned)(q1 & 255) << 8) | ((unsigned)(q2 & 255) << 16) | ((unsigned)(q3 & 255) << 24);
            const int c = j * 2 + (lane >> 5), d = (lane & 31) * 4;
            dst[(((size_t)c * 16384 + e) * 128 + d) >> 2] = pk;
        }
    }
}

struct EpiBf16 {
    bf16_t* C; int ldc;
    __device__ __forceinline__ void operator()(int row, int col, const f32x4& v) const {
        uint2 pk; pk.x = pack2(v[0], v[1]); pk.y = pack2(v[2], v[3]);
        *(uint2*)(C + (size_t)row * ldc + col) = pk;
    }
};
struct EpiBf16T {
    bf16_t* C; int col0, ncols, rows_per_b;
    __device__ __forceinline__ void operator()(int row, int col, const f32x4& v) const {
        const int bb = row / rows_per_b, rr = row - bb * rows_per_b;
        uint2 pk; pk.x = pack2(v[0], v[1]); pk.y = pack2(v[2], v[3]);
        *(uint2*)(C + ((size_t)bb * ncols + (col - col0)) * rows_per_b + rr) = pk;
    }
};
struct EpiBf16RowScale {
    bf16_t* C; int ldc; const float* ssrow;
    __device__ __forceinline__ void operator()(int row, int col, const f32x4& v) const {
        const float rs = rsqrtf(ssrow[row] * (1.0f / 1024.0f) + EPS);
        uint2 pk; pk.x = pack2(v[0] * rs, v[1] * rs); pk.y = pack2(v[2] * rs, v[3] * rs);
        *(uint2*)(C + (size_t)row * ldc + col) = pk;
    }
};
struct EpiResNorm {
    float* C; const float* R; const float* g; bf16_t* H; int ldc; float* ssrow; unsigned* hmax;
    __device__ __forceinline__ void operator()(int row, int col, const f32x4& v, float& ssq, float& am) const {
        const float4 r = *(const float4*)(R + (size_t)row * ldc + col);
        const float4 gg = *(const float4*)(g + col);
        float4 o; o.x = v[0] + r.x; o.y = v[1] + r.y; o.z = v[2] + r.z; o.w = v[3] + r.w;
        *(float4*)(C + (size_t)row * ldc + col) = o;
        const float h0 = o.x * gg.x, h1 = o.y * gg.y, h2 = o.z * gg.z, h3 = o.w * gg.w;
        uint2 pk; pk.x = pack2(h0, h1); pk.y = pack2(h2, h3);
        *(uint2*)(H + (size_t)row * ldc + col) = pk;
        ssq += o.x * o.x + o.y * o.y + o.z * o.z + o.w * o.w;
        am = fmaxf(am, fmaxf(fmaxf(fabsf(h0), fabsf(h1)), fmaxf(fabsf(h2), fabsf(h3))));
    }
    __device__ __forceinline__ void row_done(int row, float ssq, float am) const {
        atomicAdd(ssrow + row, ssq);
        atomicMax(hmax + row, __float_as_uint(am));
    }
};
struct EpiResF32 {
    float* C; const float* R; int ldc;
    __device__ __forceinline__ void operator()(int row, int col, const f32x4& v) const {
        const float4 r = *(const float4*)(R + (size_t)row * ldc + col);
        float4 o; o.x = v[0] + r.x; o.y = v[1] + r.y; o.z = v[2] + r.z; o.w = v[3] + r.w;
        *(float4*)(C + (size_t)row * ldc + col) = o;
    }
};

template <bool TRANS, class Epi, bool ROWSS = false>
__device__ __forceinline__ void gemm_tile(const bf16_t* __restrict__ A, int lda, const bf16_t* __restrict__ Bt, int ldb, int K,
                                          int m0, int n0, char* smem, const Epi& epi, float* ssrow = nullptr) {
    const int tid = VTID, lane = tid & 63, w = tid >> 6, wr = w >> 1, wc = w & 1;
    const int fr = lane & 15, fq = lane >> 4;
    const int srow = lane >> 3, sslot = lane & 7;
    f32x4 acc[4][4];
#pragma unroll
    for (int mi = 0; mi < 4; ++mi)
#pragma unroll
        for (int ni = 0; ni < 4; ++ni) acc[mi][ni] = (f32x4){0.f, 0.f, 0.f, 0.f};
    const int g0 = (sslot ^ (srow >> 1)) * 8, g1 = (sslot ^ (4 + (srow >> 1))) * 8;
    const bf16_t* Ab = A + (size_t)(m0 + w * 32 + srow) * lda;
    const bf16_t* Bb = Bt + (size_t)(n0 + w * 32 + srow) * ldb;
    const int nk = K >> 6;
    __syncthreads();
#define GEMM_STAGE(kt, buf)                                                                                                  \
    do {                                                                                                                     \
        char* sa = smem + (buf) * 32768 + w * 4096;                                                                          \
        char* sb = sa + 16384;                                                                                               \
        _Pragma("unroll") for (int i = 0; i < 4; ++i) {                                                                      \
            const int gc = (i & 1) ? g1 : g0;                                                                                \
            __builtin_amdgcn_global_load_lds((const unsigned*)(Ab + (size_t)(i * 8) * lda + (kt) * 64 + gc), (unsigned*)(sa + i * 1024), 16, 0, 0); \
            __builtin_amdgcn_global_load_lds((const unsigned*)(Bb + (size_t)(i * 8) * ldb + (kt) * 64 + gc), (unsigned*)(sb + i * 1024), 16, 0, 0); \
        }                                                                                                                    \
    } while (0)
    GEMM_STAGE(0, 0);
    const int key = fr >> 1;
    for (int kt = 0; kt < nk; ++kt) {
        asm volatile("s_waitcnt vmcnt(0)" ::: "memory");
        __syncthreads();
        if (kt + 1 < nk) GEMM_STAGE(kt + 1, (kt + 1) & 1);
        const char* sa = smem + (kt & 1) * 32768;
        const char* sb = sa + 16384;
#pragma unroll
        for (int ks = 0; ks < 2; ++ks) {
            bf16x8 af[4], bfr[4];
            const int co = ((ks * 4 + fq) ^ key) << 4;
#pragma unroll
            for (int mi = 0; mi < 4; ++mi) af[mi] = *(const bf16x8*)(sa + (wr * 64 + mi * 16 + fr) * 128 + co);
#pragma unroll
            for (int ni = 0; ni < 4; ++ni) bfr[ni] = *(const bf16x8*)(sb + (wc * 64 + ni * 16 + fr) * 128 + co);
#pragma unroll
            for (int mi = 0; mi < 4; ++mi)
#pragma unroll
                for (int ni = 0; ni < 4; ++ni)
                    acc[mi][ni] = TRANS ? __builtin_amdgcn_mfma_f32_16x16x32_bf16(af[mi], bfr[ni], acc[mi][ni], 0, 0, 0)
                                        : __builtin_amdgcn_mfma_f32_16x16x32_bf16(bfr[ni], af[mi], acc[mi][ni], 0, 0, 0);
        }
    }
#undef GEMM_STAGE
    if constexpr (ROWSS) {
#pragma unroll
        for (int mi = 0; mi < 4; ++mi) {
            const int row = m0 + wr * 64 + mi * 16 + fr;
            float ssq = 0.f, am = 0.f;
#pragma unroll
            for (int ni = 0; ni < 4; ++ni) epi(row, n0 + wc * 64 + ni * 16 + fq * 4, acc[mi][ni], ssq, am);
            ssq += __shfl_xor(ssq, 16);
            ssq += __shfl_xor(ssq, 32);
            am = fmaxf(am, __shfl_xor(am, 16));
            am = fmaxf(am, __shfl_xor(am, 32));
            if (fq == 0) epi.row_done(row, ssq, am);
        }
    } else {
#pragma unroll
        for (int mi = 0; mi < 4; ++mi)
#pragma unroll
            for (int ni = 0; ni < 4; ++ni) {
                if (TRANS) epi(m0 + wr * 64 + mi * 16 + fq * 4, n0 + wc * 64 + ni * 16 + fr, acc[mi][ni]);
                else epi(m0 + wr * 64 + mi * 16 + fr, n0 + wc * 64 + ni * 16 + fq * 4, acc[mi][ni]);
            }
    }
}


namespace g8 {
constexpr int BM = 256, BK = 64, HALF = 128, HT = HALF * BK;
__device__ __forceinline__ int lds_byte(int r, int c) {
    const int st = (r >> 4) * 2 + (c >> 5), rr = r & 15, cc = c & 31, ob = rr * 64 + cc * 2;
    return st * 1024 + (ob ^ (((ob >> 9) & 1) << 5));
}
__device__ __forceinline__ void stage_rc(int b, int& R, int& C) {
    const int st = b / 1024, sb = b % 1024, swz = sb ^ (((sb >> 9) & 1) << 5);
    R = (st >> 1) * 16 + swz / 64; C = (st & 1) * 32 + (swz % 64) / 2;
}
__device__ __forceinline__ void tile_of(int L, int nM, int nN, int& pm, int& pn) {
    const int nwg = nM * nN;
    int wgid = L;
    { const int q = nwg / 8, r = nwg % 8, xcd = wgid % 8, off = wgid / 8; wgid = (xcd < r ? xcd * (q + 1) : r * (q + 1) + (xcd - r) * q) + off; }
    const int nig = 8 * nN, gid = wgid / nig, fm = gid * 8, gsz = (nM - fm) < 8 ? (nM - fm) : 8;
    pm = fm + ((wgid % nig) % gsz); pn = (wgid % nig) / gsz;
}
}

#define G8_LAS __attribute__((address_space(3)))
template <bool TRANS, bool ROWSS, class Epi>
__device__ __forceinline__ void gemm256_tile(const bf16_t* __restrict__ A, const bf16_t* __restrict__ Bt, int K, int brow, int bcol,
                                             char* shmc, const Epi& epi) {
    using namespace g8;
    G8_LAS unsigned char* lds = (G8_LAS unsigned char*)shmc;
    const int tid = threadIdx.x, wid = __builtin_amdgcn_readfirstlane(tid >> 6), lane = tid & 63, wr = wid >> 2, wc = wid & 3, fr = lane & 15, fq = lane >> 4;
    constexpr int HTB = HALF * BK * 2;
    unsigned voff[2];
#pragma unroll
    for (int i = 0; i < 2; ++i) { int R, C; stage_rc(tid * 16 + i * 8192, R, C); voff[i] = (unsigned)(R * K + C) * 2u; }
    const size_t kstep = (size_t)(BK * 2);
    const size_t hstep = (size_t)HALF * K * 2;
    const unsigned ldsw = (unsigned)wid * 1024u;
    const int aoff = lds_byte(wr * 64 + fr, fq * 8), boff = lds_byte(wc * 32 + fr, fq * 8);
    const char* cA = (const char*)A + (size_t)brow * K * 2;
    const char* cB = (const char*)Bt + (size_t)bcol * K * 2;
#define G8_SA(b, h) (((b) * 2 + (h)) * HTB)
#define G8_SB(b, h) ((4 + (b) * 2 + (h)) * HTB)
#define G8_STAGE(bufoff, gbase) do { _Pragma("unroll") for (int _i = 0; _i < 2; ++_i) \
        __builtin_amdgcn_global_load_lds((const unsigned*)((const char*)(gbase) + voff[_i]), (G8_LAS unsigned*)(lds + (bufoff) + ldsw + _i * 8192), 16, 0, 0); } while (0)
#define G8_LDA(dst, b, h) do { _Pragma("unroll") for (int m = 0; m < 4; ++m) _Pragma("unroll") for (int k = 0; k < 2; ++k) dst[m][k] = *(const G8_LAS bf16x8*)(lds + G8_SA(b, h) + aoff + m * 2048 + k * 1024); } while (0)
#define G8_LDB(dst, b, h) do { _Pragma("unroll") for (int n = 0; n < 2; ++n) _Pragma("unroll") for (int k = 0; k < 2; ++k) dst[n][k] = *(const G8_LAS bf16x8*)(lds + G8_SB(b, h) + boff + n * 2048 + k * 1024); } while (0)
#define G8_MMA(ai, bj, At_, Bt_) do { __builtin_amdgcn_s_setprio(1); _Pragma("unroll") for (int m = 0; m < 4; ++m) _Pragma("unroll") for (int n = 0; n < 2; ++n) _Pragma("unroll") for (int k = 0; k < 2; ++k) \
        acc[ai][bj][m][n] = TRANS ? __builtin_amdgcn_mfma_f32_16x16x32_bf16(At_[m][k], Bt_[n][k], acc[ai][bj][m][n], 0, 0, 0) \
                                  : __builtin_amdgcn_mfma_f32_16x16x32_bf16(Bt_[n][k], At_[m][k], acc[ai][bj][m][n], 0, 0, 0); \
        __builtin_amdgcn_s_setprio(0); } while (0)
#define G8_WAIT_V(n) asm volatile("s_waitcnt vmcnt(" #n ")" ::: "memory")
#define G8_WAIT_L(n) asm volatile("s_waitcnt lgkmcnt(" #n ")" ::: "memory")
#define G8_BAR __builtin_amdgcn_s_barrier()
#define G8_SCHED __builtin_amdgcn_sched_barrier(0)
    f32x4 acc[2][2][4][2];
#pragma unroll
    for (int a = 0; a < 2; ++a)
#pragma unroll
        for (int b = 0; b < 2; ++b)
#pragma unroll
            for (int m = 0; m < 4; ++m)
#pragma unroll
                for (int n = 0; n < 2; ++n) acc[a][b][m][n] = (f32x4){0.f, 0.f, 0.f, 0.f};
    bf16x8 At[4][2], B0[2][2], B1[2][2];
    const int nt = K / BK;
    __syncthreads();
    G8_STAGE(G8_SB(0, 0), cB); G8_STAGE(G8_SA(0, 0), cA); G8_STAGE(G8_SB(0, 1), cB + hstep); G8_STAGE(G8_SA(0, 1), cA + hstep);
    if (wr == 1) G8_BAR;
    G8_WAIT_V(4); G8_BAR;
    G8_STAGE(G8_SB(1, 0), cB + kstep); G8_STAGE(G8_SA(1, 0), cA + kstep); G8_STAGE(G8_SB(1, 1), cB + hstep + kstep);
    G8_WAIT_V(6); G8_BAR;
    for (int t = 0; t < nt - 2; t += 2) {
        const char* a1 = cA + (size_t)(t + 1) * kstep; const char* a2 = a1 + kstep; const char* a3 = a2 + kstep;
        const char* b2 = cB + (size_t)(t + 2) * kstep; const char* b3 = b2 + kstep;
        G8_LDB(B0, 0, 0); G8_SCHED; G8_LDA(At, 0, 0); G8_STAGE(G8_SA(1, 1), a1 + hstep);
        G8_WAIT_L(8); G8_BAR; G8_WAIT_L(0); G8_MMA(0, 0, At, B0); G8_BAR; G8_SCHED;
        G8_LDB(B1, 0, 1); G8_STAGE(G8_SB(0, 0), b2);
        G8_BAR; G8_WAIT_L(0); G8_MMA(0, 1, At, B1); G8_BAR;
        G8_LDA(At, 0, 1); G8_STAGE(G8_SA(0, 0), a2);
        G8_BAR; G8_WAIT_L(0); G8_MMA(1, 0, At, B0); G8_BAR; G8_SCHED;
        G8_STAGE(G8_SB(0, 1), b2 + hstep);
        G8_WAIT_V(6); G8_BAR; G8_MMA(1, 1, At, B1); G8_BAR;
        G8_LDB(B0, 1, 0); G8_SCHED; G8_LDA(At, 1, 0); G8_STAGE(G8_SA(0, 1), a2 + hstep);
        G8_WAIT_L(8); G8_BAR; G8_WAIT_L(0); G8_MMA(0, 0, At, B0); G8_BAR; G8_SCHED;
        G8_LDB(B1, 1, 1); G8_STAGE(G8_SB(1, 0), b3);
        G8_BAR; G8_WAIT_L(0); G8_MMA(0, 1, At, B1); G8_BAR;
        G8_LDA(At, 1, 1); G8_STAGE(G8_SA(1, 0), a3);
        G8_BAR; G8_WAIT_L(0); G8_MMA(1, 0, At, B0); G8_BAR; G8_SCHED;
        G8_STAGE(G8_SB(1, 1), b3 + hstep);
        G8_WAIT_V(6); G8_BAR; G8_MMA(1, 1, At, B1); G8_BAR;
    }
    { G8_LDB(B0, 0, 0); G8_LDA(At, 0, 0); G8_STAGE(G8_SA(1, 1), cA + (size_t)(nt - 1) * kstep + hstep);
      G8_BAR; G8_WAIT_L(0); G8_MMA(0, 0, At, B0); G8_BAR;
      G8_LDB(B1, 0, 1); G8_BAR; G8_WAIT_L(0); G8_MMA(0, 1, At, B1); G8_BAR;
      G8_LDA(At, 0, 1); G8_WAIT_V(4); G8_BAR; G8_WAIT_L(0); G8_MMA(1, 0, At, B0); G8_MMA(1, 1, At, B1); G8_BAR; }
    { G8_LDB(B0, 1, 0); G8_LDA(At, 1, 0); G8_WAIT_V(2); G8_BAR; G8_WAIT_L(0); G8_MMA(0, 0, At, B0); G8_BAR;
      G8_LDB(B1, 1, 1); G8_WAIT_V(0); G8_BAR; G8_WAIT_L(0); G8_MMA(0, 1, At, B1); G8_BAR;
      G8_LDA(At, 1, 1); G8_BAR; G8_WAIT_L(0); G8_MMA(1, 0, At, B0); G8_MMA(1, 1, At, B1); G8_BAR; }
    if (wr == 0) G8_BAR;
    if constexpr (ROWSS) {
#pragma unroll
        for (int ai = 0; ai < 2; ++ai)
#pragma unroll
            for (int m = 0; m < 4; ++m) {
                const int row = brow + ai * HALF + wr * 64 + m * 16 + fr;
                float ssq = 0.f, am = 0.f;
#pragma unroll
                for (int bj = 0; bj < 2; ++bj)
#pragma unroll
                    for (int n = 0; n < 2; ++n) epi(row, bcol + bj * HALF + wc * 32 + n * 16 + fq * 4, acc[ai][bj][m][n], ssq, am);
                ssq += __shfl_xor(ssq, 16);
                ssq += __shfl_xor(ssq, 32);
                am = fmaxf(am, __shfl_xor(am, 16));
                am = fmaxf(am, __shfl_xor(am, 32));
                if (fq == 0) epi.row_done(row, ssq, am);
            }
    } else {
#pragma unroll
        for (int ai = 0; ai < 2; ++ai)
#pragma unroll
            for (int bj = 0; bj < 2; ++bj)
#pragma unroll
                for (int m = 0; m < 4; ++m)
#pragma unroll
                    for (int n = 0; n < 2; ++n) {
                        if (TRANS) epi(brow + ai * HALF + wr * 64 + m * 16 + fq * 4, bcol + bj * HALF + wc * 32 + n * 16 + fr, acc[ai][bj][m][n]);
                        else epi(brow + ai * HALF + wr * 64 + m * 16 + fr, bcol + bj * HALF + wc * 32 + n * 16 + fq * 4, acc[ai][bj][m][n]);
                    }
    }
#undef G8_SA
#undef G8_SB
#undef G8_STAGE
#undef G8_LDA
#undef G8_LDB
#undef G8_MMA
#undef G8_WAIT_V
#undef G8_WAIT_L
#undef G8_BAR
#undef G8_SCHED
}

__device__ void phase_gemm_in(const Params& p, char* smem) {
    const int nM = NTOK / 256, nN = INW / 256;
    EpiBf16 e1{p.z(), INW};
    EpiBf16T e1t{p.vT(), 1024, 512, T};
    for (int i = 0; i * (int)gridDim.x + (int)blockIdx.x < nM * nN; ++i) {
        int pm, pn;
        g8::tile_of(i * gridDim.x + blockIdx.x, nM, nN, pm, pn);
        if (pn >= 4 && pn < 6) gemm256_tile<true, false>(p.h(), p.w_in_t(), D, pm * 256, pn * 256, smem, e1t);
        else gemm256_tile<false, false>(p.h(), p.w_in_t(), D, pm * 256, pn * 256, smem, e1);
    }
}

__device__ void phase_gemm_kv(const Params& p, char* smem) {
    EpiBf16 e2{p.kvb(), 512};
    EpiBf16T e2t{p.kvT(), 256, 256, 256};
    if (blockIdx.x < 4) gemm256_tile<false, false>(p.memn(), p.w_kv_t(), D, blockIdx.x * 256, 0, smem, e2);
    else if (blockIdx.x < 8) gemm256_tile<true, false>(p.memn(), p.w_kv_t(), D, (blockIdx.x - 4) * 256, 256, smem, e2t);
}

__device__ void phase_gemm_out(const Params& p, char* smem) {
    const int nM = NTOK / 256, nN = D / 256;
    EpiResNorm e{p.out, p.x, p.ffn_g, p.h(), D, p.ss1(), p.hmax()};
    for (int i = 0; i * (int)gridDim.x + (int)blockIdx.x < nM * nN; ++i) {
        int pm, pn;
        g8::tile_of(i * gridDim.x + blockIdx.x, nM, nN, pm, pn);
        gemm256_tile<false, true>(p.mix(), p.w_out_t(), D, pm * 256, pn * 256, smem, e);
    }
}

__device__ void phase_gemm_q(const Params& p, char* smem) {
    const int nM = NTOK / 256, nN = QW / 256;
    EpiBf16RowScale e{p.z(), QW, p.ss1()};
    for (int i = 0; i * (int)gridDim.x + (int)blockIdx.x < nM * nN; ++i) {
        int pm, pn;
        g8::tile_of(i * gridDim.x + blockIdx.x, nM, nN, pm, pn);
        gemm256_tile<false, false>(p.h(), p.w_q_t(), D, pm * 256, pn * 256, smem, e);
    }
}

__device__ __forceinline__ float dot8(const uint4& v, const float* __restrict__ q) {
    return bflo(v.x) * q[0] + bfhi(v.x) * q[1] + bflo(v.y) * q[2] + bfhi(v.y) * q[3] +
           bflo(v.z) * q[4] + bfhi(v.z) * q[5] + bflo(v.w) * q[6] + bfhi(v.w) * q[7];
}

typedef float f32x16 __attribute__((ext_vector_type(16)));
constexpr int HRS = 144;
__device__ __forceinline__ f32x16 tile_mm64(const char* X, const char* Y, int xrow0, int yrow0, int lane, f32x16 acc) {
    const int r = lane & 31, hh = lane >> 5;
#pragma unroll
    for (int ks = 0; ks < 4; ++ks) {
        const bf16x8 a = *(const bf16x8*)(X + (xrow0 + r) * HRS + ks * 32 + hh * 16);
        const bf16x8 b = *(const bf16x8*)(Y + (yrow0 + r) * HRS + ks * 32 + hh * 16);
        acc = __builtin_amdgcn_mfma_f32_32x32x16_bf16(a, b, acc, 0, 0, 0);
    }
    return acc;
}
__device__ __forceinline__ int crow(int reg, int hh) { return (reg & 3) + 8 * (reg >> 2) + 4 * hh; }

__device__ __forceinline__ void hg_load_vt(const Params& p, char* sVT, int tok0, int h, int kcol, int sq) {
    const bf16_t* zp = p.z() + (size_t)(tok0 + sq * 16) * INW + 2304 + h * 64 + kcol;
    unsigned pk[8];
#pragma unroll
    for (int j = 0; j < 8; ++j) {
        const unsigned lo = zp[(size_t)(2 * j) * INW], hi = zp[(size_t)(2 * j + 1) * INW];
        pk[j] = lo | (hi << 16);
    }
    *(uint4*)(sVT + kcol * HRS + sq * 32) = make_uint4(pk[0], pk[1], pk[2], pk[3]);
    *(uint4*)(sVT + kcol * HRS + sq * 32 + 16) = make_uint4(pk[4], pk[5], pk[6], pk[7]);
}

__device__ __forceinline__ float hg_gates(const Params& p, float* sTot, int tok0, int h, int dir, int kcol, int sq, float (&bj)[16], float (&kk)[16]) {
    const bf16_t* zp = p.z() + (size_t)(tok0 + sq * 16) * INW + 1792 + dir * 256 + h * 64 + kcol;
    const float lbv = p.lb()[dir * 256 + h * 64 + kcol];
#pragma unroll
    for (int j = 0; j < 16; ++j) {
        const float pre = bf2f(zp[(size_t)j * INW]);
        const float f = lbv + (1.0f - lbv) * (1.0f / (1.0f + __expf(-pre)));
        bj[j] = __logf(f);
        kk[j] = 1.0f - f;
    }
    if (dir == 0) {
#pragma unroll
        for (int j = 1; j < 16; ++j) bj[j] += bj[j - 1];
        sTot[sq * 64 + kcol] = bj[15];
    } else {
#pragma unroll
        for (int j = 14; j >= 0; --j) bj[j] += bj[j + 1];
        sTot[sq * 64 + kcol] = bj[0];
    }
    __syncthreads();
    const float t0 = sTot[kcol], t1 = sTot[64 + kcol], t2 = sTot[128 + kcol], t3 = sTot[192 + kcol];
    float off;
    if (dir == 0) off = (sq > 0 ? t0 : 0.f) + (sq > 1 ? t1 : 0.f) + (sq > 2 ? t2 : 0.f);
    else off = (sq < 3 ? t3 : 0.f) + (sq < 2 ? t2 : 0.f) + (sq < 1 ? t1 : 0.f);
#pragma unroll
    for (int j = 0; j < 16; ++j) bj[j] += off;
    return t0 + t1 + t2 + t3;
}
__device__ __forceinline__ void hg_gates_load(const Params& p, int tok0, int h, int dir, int kcol, int sq, bf16_t (&pre)[16]) {
    const bf16_t* zp = p.z() + (size_t)(tok0 + sq * 16) * INW + 1792 + dir * 256 + h * 64 + kcol;
#pragma unroll
    for (int j = 0; j < 16; ++j) pre[j] = zp[(size_t)j * INW];
}
__device__ __forceinline__ float hg_gates_pre(const Params& p, float* sTot, const bf16_t (&prel)[16], int h, int dir, int kcol, int sq, float (&bj)[16], float (&kk)[16]) {
    const float lbv = p.lb()[dir * 256 + h * 64 + kcol];
#pragma unroll
    for (int j = 0; j < 16; ++j) {
        const float pre = bf2f(prel[j]);
        const float f = lbv + (1.0f - lbv) * (1.0f / (1.0f + __expf(-pre)));
        bj[j] = __logf(f);
        kk[j] = 1.0f - f;
    }
    if (dir == 0) {
#pragma unroll
        for (int j = 1; j < 16; ++j) bj[j] += bj[j - 1];
        sTot[sq * 64 + kcol] = bj[15];
    } else {
#pragma unroll
        for (int j = 14; j >= 0; --j) bj[j] += bj[j + 1];
        sTot[sq * 64 + kcol] = bj[0];
    }
    __syncthreads();
    const float t0 = sTot[kcol], t1 = sTot[64 + kcol], t2 = sTot[128 + kcol], t3 = sTot[192 + kcol];
    float off;
    if (dir == 0) off = (sq > 0 ? t0 : 0.f) + (sq > 1 ? t1 : 0.f) + (sq > 2 ? t2 : 0.f);
    else off = (sq < 3 ? t3 : 0.f) + (sq < 2 ? t2 : 0.f) + (sq < 1 ? t1 : 0.f);
#pragma unroll
    for (int j = 0; j < 16; ++j) bj[j] += off;
    return t0 + t1 + t2 + t3;
}

__device__ void hg_local(const Params& p, char* smem) {
    char* sVT = smem;
    char* sKT = smem + 9216;
    float* sTot = (float*)(smem + 18432);
    const int tid = VTID, lane = tid & 63, w = tid >> 6;
    const int kcol = tid & 63, sq = tid >> 6;
    for (int item = VBID; item < 4096; item += VGRID) {
        const int c = item & 127, dir = (item >> 7) & 1, h = (item >> 8) & 3, b = item >> 10;
        const int tok0 = b * T + c * 64;
        __syncthreads();
        hg_load_vt(p, sVT, tok0, h, kcol, sq);
        float bj[16], kk[16];
        const float btot = hg_gates(p, sTot, tok0, h, dir, kcol, sq, bj, kk);
        unsigned pk[8];
#pragma unroll
        for (int j = 0; j < 8; ++j)
            pk[j] = pack2(kk[2 * j] * __expf(btot - bj[2 * j]), kk[2 * j + 1] * __expf(btot - bj[2 * j + 1]));
        *(uint4*)(sKT + kcol * HRS + sq * 32) = make_uint4(pk[0], pk[1], pk[2], pk[3]);
        *(uint4*)(sKT + kcol * HRS + sq * 32 + 16) = make_uint4(pk[4], pk[5], pk[6], pk[7]);
        if (sq == 0) p.hdec()[item * 64 + kcol] = __expf(btot);
        __syncthreads();
        const int vi = w >> 1, ki = w & 1, hh = lane >> 5;
        f32x16 acc;
#pragma unroll
        for (int r = 0; r < 16; ++r) acc[r] = 0.f;
        acc = tile_mm64(sVT, sKT, vi * 32, ki * 32, lane, acc);
        float* dst = p.hstate() + (size_t)item * 4096 + ki * 32 + (lane & 31);
#pragma unroll
        for (int r = 0; r < 16; ++r) dst[(vi * 32 + crow(r, hh)) * 64] = acc[r];
    }
}

__device__ __forceinline__ bf16x8 pack8(const f32x16& x, int s8) {
    typedef unsigned u32x4_t __attribute__((ext_vector_type(4)));
    u32x4_t pk;
    pk[0] = pack2(x[s8], x[s8 + 1]); pk[1] = pack2(x[s8 + 2], x[s8 + 3]);
    pk[2] = pack2(x[s8 + 4], x[s8 + 5]); pk[3] = pack2(x[s8 + 6], x[s8 + 7]);
    return __builtin_bit_cast(bf16x8, pk);
}
__device__ __forceinline__ bf16x8 join8(const uint2& lo, const uint2& hi) {
    typedef unsigned u32x4_t __attribute__((ext_vector_type(4)));
    u32x4_t pk; pk[0] = lo.x; pk[1] = lo.y; pk[2] = hi.x; pk[3] = hi.y;
    return __builtin_bit_cast(bf16x8, pk);
}

__device__ __forceinline__ int swap23(int r) { return (r & ~12) | ((r & 4) << 1) | ((r & 8) >> 1); }

__device__ __forceinline__ void mem_attn_wave(const Params& p, int wu, int lane) {
    const int tile = wu & 255, h = (wu >> 8) & 3, b = wu >> 10;
    const int l31 = lane & 31, hh = lane >> 5;
    const int tok = b * T + tile * 32 + l31;
    bf16x8 qf[4];
#pragma unroll
    for (int ks = 0; ks < 4; ++ks) qf[ks] = *(const bf16x8*)(p.z() + (size_t)tok * INW + 2816 + h * 64 + ks * 16 + hh * 8);
    const bf16_t* kb = p.kvb() + (size_t)(b * 256 + swap23(l31)) * 512 + h * 64 + hh * 8;
    float m = -1e30f;
    f32x16 o0, o1;
#pragma unroll
    for (int r = 0; r < 16; ++r) { o0[r] = 0.f; o1[r] = 0.f; }
    float sum = 0.f;
    const bf16_t* vt = p.kvT() + ((size_t)(b * 4 + h) * 64 + l31) * 256 + 8 * hh;
    bf16x8 kf[4], vf[4];
#pragma unroll
    for (int ks = 0; ks < 4; ++ks) kf[ks] = *(const bf16x8*)(kb + ks * 16);
#pragma unroll
    for (int st = 0; st < 2; ++st) { vf[2 * st] = *(const bf16x8*)(vt + st * 16); vf[2 * st + 1] = *(const bf16x8*)(vt + 32 * 256 + st * 16); }
    for (int kt = 0; kt < 8; ++kt) {
        const int ktn = min(kt + 1, 7);
        bf16x8 kn[4], vn[4];
#pragma unroll
        for (int ks = 0; ks < 4; ++ks) kn[ks] = *(const bf16x8*)(kb + (size_t)ktn * 32 * 512 + ks * 16);
#pragma unroll
        for (int st = 0; st < 2; ++st) { vn[2 * st] = *(const bf16x8*)(vt + ktn * 32 + st * 16); vn[2 * st + 1] = *(const bf16x8*)(vt + 32 * 256 + ktn * 32 + st * 16); }
        f32x16 s;
#pragma unroll
        for (int r = 0; r < 16; ++r) s[r] = 0.f;
#pragma unroll
        for (int ks = 0; ks < 4; ++ks) s = __builtin_amdgcn_mfma_f32_32x32x16_bf16(kf[ks], qf[ks], s, 0, 0, 0);
        float tm = s[0];
#pragma unroll
        for (int r = 1; r < 16; ++r) tm = fmaxf(tm, s[r]);
        tm = fmaxf(tm, __shfl_xor(tm, 32));
        const float mn = fmaxf(m, tm);
        if (__any(mn > m)) {
            const float sc = __builtin_amdgcn_exp2f((m - mn) * 0.18033688011112042f);
            sum *= sc;
#pragma unroll
            for (int r = 0; r < 16; ++r) { o0[r] *= sc; o1[r] *= sc; }
        }
        m = mn;
        const float mb = mn * 0.18033688011112042f;
#pragma unroll
        for (int r = 0; r < 16; ++r) { s[r] = __builtin_amdgcn_exp2f(fmaf(s[r], 0.18033688011112042f, -mb)); sum += s[r]; }
#pragma unroll
        for (int st = 0; st < 2; ++st) {
            const bf16x8 pb = pack8(s, st * 8);
            o0 = __builtin_amdgcn_mfma_f32_32x32x16_bf16(vf[2 * st], pb, o0, 0, 0, 0);
            o1 = __builtin_amdgcn_mfma_f32_32x32x16_bf16(vf[2 * st + 1], pb, o1, 0, 0, 0);
        }
#pragma unroll
        for (int ks = 0; ks < 4; ++ks) kf[ks] = kn[ks];
#pragma unroll
        for (int q = 0; q < 4; ++q) vf[q] = vn[q];
    }
    sum += __shfl_xor(sum, 32);
    const float inv = 1.0f / sum;
    bf16_t* mo = p.mix() + (size_t)tok * D + 768 + h * 64 + 4 * hh;
#pragma unroll
    for (int g = 0; g < 4; ++g) {
        uint2 pk;
        pk.x = pack2(o0[4 * g] * inv, o0[4 * g + 1] * inv); pk.y = pack2(o0[4 * g + 2] * inv, o0[4 * g + 3] * inv);
        *(uint2*)(mo + 8 * g) = pk;
        pk.x = pack2(o1[4 * g] * inv, o1[4 * g + 1] * inv); pk.y = pack2(o1[4 * g + 2] * inv, o1[4 * g + 3] * inv);
        *(uint2*)(mo + 32 + 8 * g) = pk;
    }
}

struct NaCtx {
    const bf16_t* kbase; const bf16_t* vbase; const float* bh;
    int rs, r, c, c0, cb, hh;
    bf16x8 qf[4];
    float m, sum;
    f32x16 o0, o1;
};
template <int TI>
__device__ __forceinline__ void na_load(const NaCtx& x, bf16x8 (&kf)[4], bf16x8 (&vf)[4]) {
    constexpr int ip = TI / 3, cg = TI % 3;
    const bf16_t* kp = x.kbase + (size_t)(ip * 128 + cg * 16) * INW;
#pragma unroll
    for (int ks = 0; ks < 4; ++ks) kf[ks] = *(const bf16x8*)(kp + ks * 16);
    const bf16_t* vr = x.vbase + ip * 128 + cg * 16;
#pragma unroll
    for (int st = 0; st < 2; ++st) { vf[2 * st] = *(const bf16x8*)(vr + st * 64); vf[2 * st + 1] = *(const bf16x8*)(vr + (size_t)32 * T + st * 64); }
}
template <int TI>
__device__ __forceinline__ void na_comp(NaCtx& x, const bf16x8 (&kf)[4], const bf16x8 (&vf)[4]) {
    constexpr int ip = TI / 3, cg = TI % 3;
    f32x16 s;
#pragma unroll
    for (int q = 0; q < 16; ++q) s[q] = 0.f;
#pragma unroll
    for (int ks = 0; ks < 4; ++ks) s = __builtin_amdgcn_mfma_f32_32x32x16_bf16(kf[ks], x.qf[ks], s, 0, 0, 0);
    const int kc0 = x.cb + 16 * cg + 8 * x.hh;
    const float* brow = x.bh + (x.rs + 2 * ip - x.r + 7) * 31 + 15 - x.c + kc0;
    const int d0 = kc0 - x.c0;
    float tm = -1e30f;
    float bv[16];
#pragma unroll
    for (int q = 0; q < 16; ++q) bv[q] = brow[(q & 3) + 4 * ((q >> 2) & 1) + 31 * (q >> 3)];
#pragma unroll
    for (int q = 0; q < 16; ++q) asm volatile("" : "+v"(bv[q]));
#pragma unroll
    for (int q = 0; q < 16; ++q) {
        const int cq = (q & 3) + 4 * ((q >> 2) & 1);
        const bool valid = (unsigned)(d0 + cq) < 16u;
        const float sc = valid ? fmaf(s[q], 0.18033688011112042f, bv[q]) : -INFINITY;
        s[q] = sc;
        tm = fmaxf(tm, sc);
    }
    tm = fmaxf(tm, __shfl_xor(tm, 32));
    const float mn = fmaxf(x.m, tm);
    if (__any(mn > x.m)) {
        const float scl = __builtin_amdgcn_exp2f(x.m - mn);
        x.sum *= scl;
#pragma unroll
        for (int q = 0; q < 16; ++q) { x.o0[q] *= scl; x.o1[q] *= scl; }
    }
    x.m = mn;
#pragma unroll
    for (int q = 0; q < 16; ++q) { const float pe = __builtin_amdgcn_exp2f(s[q] - mn); s[q] = pe; x.sum += pe; }
#pragma unroll
    for (int st = 0; st < 2; ++st) {
        const bf16x8 pb = pack8(s, st * 8);
        x.o0 = __builtin_amdgcn_mfma_f32_32x32x16_bf16(vf[2 * st], pb, x.o0, 0, 0, 0);
        x.o1 = __builtin_amdgcn_mfma_f32_32x32x16_bf16(vf[2 * st + 1], pb, x.o1, 0, 0, 0);
    }
}

__device__ __forceinline__ void na_attn_wave(const Params& p, int wu, int lane, const float* sbias) {
    const int j = wu & 1, h = (wu >> 1) & 7, r = (wu >> 4) & 127, b = wu >> 11;
    const int l31 = lane & 31, hh = lane >> 5;
    NaCtx x;
    x.hh = hh; x.r = r;
    x.c = 32 * j + l31;
    x.c0 = min(max(x.c - 8, 0), 48); x.rs = min(max(r - 4, 0), 120);
    const int tokq = b * T + r * 64 + x.c;
    x.cb = 16 * j;
#pragma unroll
    for (int ks = 0; ks < 4; ++ks) x.qf[ks] = *(const bf16x8*)(p.z() + (size_t)tokq * INW + h * 64 + ks * 16 + hh * 8);
    x.bh = sbias + 64 + h * 465;
    const int kap = swap23(l31);
    x.kbase = p.z() + (size_t)(b * T + (x.rs + (kap >> 4)) * 64 + x.cb + (kap & 15)) * INW + 512 + h * 64 + hh * 8;
    x.vbase = p.vT() + ((size_t)(b * 8 + h) * 64 + l31) * T + x.rs * 64 + x.cb + 8 * hh;
    x.m = -1e30f; x.sum = 0.f;
#pragma unroll
    for (int q = 0; q < 16; ++q) { x.o0[q] = 0.f; x.o1[q] = 0.f; }
    bf16x8 k0[4], v0[4], k1[4], v1[4], k2[4], v2[4], k3[4], v3[4];
    na_load<0>(x, k0, v0); na_load<1>(x, k1, v1); na_load<2>(x, k2, v2);
    na_load<3>(x, k3, v3);  na_comp<0>(x, k0, v0);
    na_load<4>(x, k0, v0);  na_comp<1>(x, k1, v1);
    na_load<5>(x, k1, v1);  na_comp<2>(x, k2, v2);
    na_load<6>(x, k2, v2);  na_comp<3>(x, k3, v3);
    na_load<7>(x, k3, v3);  na_comp<4>(x, k0, v0);
    na_load<8>(x, k0, v0);  na_comp<5>(x, k1, v1);
    na_load<9>(x, k1, v1);  na_comp<6>(x, k2, v2);
    na_load<10>(x, k2, v2); na_comp<7>(x, k3, v3);
    na_load<11>(x, k3, v3); na_comp<8>(x, k0, v0);
    na_comp<9>(x, k1, v1);
    na_comp<10>(x, k2, v2);
    na_comp<11>(x, k3, v3);
    float sum = x.sum;
    sum += __shfl_xor(sum, 32);
    const float inv = 1.0f / sum;
    bf16_t* mo = p.mix() + (size_t)tokq * D + h * 64 + 4 * hh;
#pragma unroll
    for (int g = 0; g < 4; ++g) {
        uint2 pk;
        pk.x = pack2(x.o0[4 * g] * inv, x.o0[4 * g + 1] * inv); pk.y = pack2(x.o0[4 * g + 2] * inv, x.o0[4 * g + 3] * inv);
        *(uint2*)(mo + 8 * g) = pk;
        pk.x = pack2(x.o1[4 * g] * inv, x.o1[4 * g + 1] * inv); pk.y = pack2(x.o1[4 * g + 2] * inv, x.o1[4 * g + 3] * inv);
        *(uint2*)(mo + 32 + 8 * g) = pk;
    }
}

__device__ void phase_mixers(const Params& p, char* smem) {
    const int tid = VTID, lane = tid & 63, w = tid >> 6;
    {
        float* sbias = (float*)smem;
        __syncthreads();
        for (int i = tid; i < 8 * 465; i += 256) sbias[64 + i] = p.rpb[i] * 1.4426950408889634f;
        __syncthreads();
        for (int wu = VBID * 4 + w; wu < 8192; wu += VGRID * 4) na_attn_wave(p, wu, lane, sbias);
    }
    __syncthreads();
    hg_local(p, smem);
}

__device__ void phase_hg_scan(const Params& p) {
    const int tid = VTID;
    if (blockIdx.x < 8) return;
    for (int item = VBID - 16; item < 512; item += VGRID - 16) {
        const int g = item * 256 + tid;
        const int seq = g >> 12, kv = g & 4095, k = kv & 63;
        const int dir = seq & 1;
        float S = 0.f;
        for (int cc0 = 0; cc0 < 128; cc0 += 8) {
            float L[8], d[8];
#pragma unroll
            for (int u = 0; u < 8; ++u) {
                const int c = dir ? 127 - (cc0 + u) : cc0 + u;
                const size_t it = (size_t)seq * 128 + c;
                L[u] = p.hstate()[it * 4096 + kv];
                d[u] = p.hdec()[it * 64 + k];
            }
#pragma unroll
            for (int u = 0; u < 8; ++u) {
                const int c = dir ? 127 - (cc0 + u) : cc0 + u;
                const size_t it = (size_t)seq * 128 + c;
                ((float*)p.h())[it * 4096 + kv] = S;
                S = d[u] * S + L[u];
            }
        }
    }
}

__device__ void phase_hg_out(const Params& p, char* smem) {
    char* sQt = smem;
    char* sKt = smem + 9216;
    char* sQh = smem + 18432;
    char* sVT = smem + 27648;
    char* sST = smem + 36864;
    char* sP = smem + 46080;
    float* sTot = (float*)(smem + 55296);
    float* sSS = sTot + 256;
    const int tid = VTID, lane = tid & 63, w = tid >> 6;
    const int kcol = tid & 63, sq = tid >> 6;
    const int l31 = lane & 31, hh = lane >> 5;
    for (int item = VBID; item < 2048; item += VGRID) {
        const int c = item & 127, h = (item >> 7) & 3, b = item >> 9;
        const int tok0 = b * T + c * 64;
        __syncthreads();
        hg_load_vt(p, sVT, tok0, h, kcol, sq);
        float qv[16];
        {
            const bf16_t* zp = p.z() + (size_t)(tok0 + sq * 16) * INW + 1536 + h * 64 + kcol;
#pragma unroll
            for (int j = 0; j < 16; ++j) qv[j] = bf2f(zp[(size_t)j * INW]);
        }
        bf16_t pre0[16], pre1[16];
        hg_gates_load(p, tok0, h, 0, kcol, sq, pre0);
        hg_gates_load(p, tok0, h, 1, kcol, sq, pre1);
        float4 st0[4], st1[4];
        {
            const float* sp0 = (const float*)p.h() + ((size_t)(((b * 4 + h) * 2 + 0) * 128 + c)) * 4096;
            const float* sp1 = (const float*)p.h() + ((size_t)(((b * 4 + h) * 2 + 1) * 128 + c)) * 4096;
#pragma unroll
            for (int i = 0; i < 4; ++i) { st0[i] = *(const float4*)(sp0 + tid * 4 + 1024 * i); st1[i] = *(const float4*)(sp1 + tid * 4 + 1024 * i); }
        }
        f32x16 accO;
#pragma unroll
        for (int r = 0; r < 16; ++r) accO[r] = 0.f;
#pragma unroll
        for (int dir = 0; dir < 2; ++dir) {
            float bj[16], kk[16];
            const float btot = dir == 0 ? hg_gates_pre(p, sTot, pre0, h, 0, kcol, sq, bj, kk) : hg_gates_pre(p, sTot, pre1, h, 1, kcol, sq, bj, kk);
            const float bref = 0.5f * btot;
#pragma unroll
            for (int j = 0; j < 16; ++j) {
                const int s = sq * 16 + j;
                *(bf16_t*)(sQt + s * HRS + kcol * 2) = f2bf(qv[j] * __expf(bj[j] - bref));
                *(bf16_t*)(sKt + s * HRS + kcol * 2) = f2bf(kk[j] * __expf(bref - bj[j]));
                *(bf16_t*)(sQh + s * HRS + kcol * 2) = f2bf(qv[j] * __expf(bj[j]));
            }
            {
#pragma unroll
                for (int i = 0; i < 4; ++i) {
                    const int idx = tid * 4 + 1024 * i;
                    const float4 v = dir == 0 ? st0[i] : st1[i];
                    uint2 pk; pk.x = pack2(v.x, v.y); pk.y = pack2(v.z, v.w);
                    *(uint2*)(sST + (idx >> 6) * HRS + (idx & 63) * 2) = pk;
                }
            }
            __syncthreads();
            {
                const int si = w >> 1, ti = w & 1;
                const bool live = dir == 0 ? (si <= ti) : (si >= ti);
                f32x16 pt;
#pragma unroll
                for (int r = 0; r < 16; ++r) pt[r] = 0.f;
                if (live) pt = tile_mm64(sKt, sQt, si * 32, ti * 32, lane, pt);
                const int t = ti * 32 + l31;
#pragma unroll
                for (int g = 0; g < 4; ++g) {
                    const int s0 = si * 32 + 8 * g + 4 * hh;
                    float v0 = pt[4 * g], v1 = pt[4 * g + 1], v2 = pt[4 * g + 2], v3 = pt[4 * g + 3];
                    if (dir == 0) {
                        if (s0 > t) v0 = 0.f; if (s0 + 1 > t) v1 = 0.f; if (s0 + 2 > t) v2 = 0.f; if (s0 + 3 > t) v3 = 0.f;
                    } else {
                        if (s0 < t) v0 = 0.f; if (s0 + 1 < t) v1 = 0.f; if (s0 + 2 < t) v2 = 0.f; if (s0 + 3 < t) v3 = 0.f;
                    }
                    uint2 pk; pk.x = pack2(v0, v1); pk.y = pack2(v2, v3);
                    *(uint2*)(sP + t * HRS + s0 * 2) = pk;
                }
            }
            __syncthreads();
            {
                const int vi = w >> 1, ti = w & 1;
                accO = tile_mm64(sVT, sP, vi * 32, ti * 32, lane, accO);
                accO = tile_mm64(sST, sQh, vi * 32, ti * 32, lane, accO);
            }
            __syncthreads();
        }
        const int vi = w >> 1, ti = w & 1;
        float ssq = 0.f;
#pragma unroll
        for (int r = 0; r < 16; ++r) ssq += accO[r] * accO[r];
        ssq += __shfl_xor(ssq, 32);
        sSS[w * 64 + lane] = ssq;
        __syncthreads();
        const float tot = sSS[ti * 64 + l31] + sSS[(2 + ti) * 64 + l31];
        const float rs = rsqrtf(tot * (1.0f / 64.0f) + EPS);
        const int tok = tok0 + ti * 32 + l31;
#pragma unroll
        for (int g = 0; g < 4; ++g) {
            const int v0 = vi * 32 + 8 * g + 4 * hh;
            const uint2 gz = *(const uint2*)(p.z() + (size_t)tok * INW + 2560 + h * 64 + v0);
            const float4 gn = *(const float4*)(p.hg_g + h * 64 + v0);
            const float g0 = bflo(gz.x), g1 = bfhi(gz.x), g2 = bflo(gz.y), g3 = bfhi(gz.y);
            const float o0 = accO[4 * g] * rs * gn.x * (g0 / (1.0f + __expf(-g0)));
            const float o1 = accO[4 * g + 1] * rs * gn.y * (g1 / (1.0f + __expf(-g1)));
            const float o2 = accO[4 * g + 2] * rs * gn.z * (g2 / (1.0f + __expf(-g2)));
            const float o3 = accO[4 * g + 3] * rs * gn.w * (g3 / (1.0f + __expf(-g3)));
            uint2 pk; pk.x = pack2(o0, o1); pk.y = pack2(o2, o3);
            *(uint2*)(p.mix() + (size_t)tok * D + 512 + h * 64 + v0) = pk;
        }
    }
    for (int wu = VBID * 4 + w; wu < 4096; wu += VGRID * 4) mem_attn_wave(p, wu, lane);
}


__device__ __forceinline__ int ord_key(int fb) { return fb ^ ((fb >> 31) & 0x7FFFFFFF); }

template <int N>
__device__ __forceinline__ void bitonic_sort_desc(int (&v)[N]) {
#pragma unroll
    for (int k = 2; k <= N; k <<= 1) {
#pragma unroll
        for (int j = k >> 1; j > 0; j >>= 1) {
#pragma unroll
            for (int i = 0; i < N; ++i) {
                const int l = i ^ j;
                if (l > i) {
                    const bool desc = ((i & k) == 0);
                    const int a = v[i], b = v[l];
                    const int mx = max(a, b), mn = min(a, b);
                    v[i] = desc ? mx : mn;
                    v[l] = desc ? mn : mx;
                }
            }
        }
    }
}
template <int N>
__device__ __forceinline__ void bitonic_merge_desc(int (&v)[N]) {
#pragma unroll
    for (int j = N >> 1; j > 0; j >>= 1) {
#pragma unroll
        for (int i = 0; i < N; ++i) {
            const int l = i ^ j;
            if (l > i) {
                const int a = v[i], b = v[l];
                v[i] = max(a, b);
                v[l] = min(a, b);
            }
        }
    }
}
__device__ __forceinline__ void merge_prune16(int (&r)[16], const int (&o)[16]) {
#pragma unroll
    for (int i = 0; i < 16; ++i) r[i] = max(r[i], o[15 - i]);
    bitonic_merge_desc<16>(r);
}

__device__ void phase_route(const Params& p, char* smem) {
    char* sk = smem;
    const int tid = VTID, lane = tid & 63, w = tid >> 6;
    int* sA = (int*)(smem + 32768) + w * 2048;
    int* sB = (int*)(smem + 65536) + w * 512;
    const int tl = lane & 31, hh = lane >> 5;
    const int h = VBID & 7, tg0 = VBID >> 3, tgs = VGRID >> 3;
    for (int base = tg0; base < 256; base += 4 * tgs)
    for (int c = 0; c < 2; ++c) {
        const int hc = h * 2 + c;
        __syncthreads();
        {
            const bf16_t* sp = p.subk_b() + (size_t)hc * 16384;
#pragma unroll
            for (int i = 0; i < 8; ++i) {
                const int ch = tid + 256 * i;
                const int row = ch >> 4, cc = ch & 15;
                const uint4 v = *(const uint4*)(sp + row * 128 + cc * 8);
                *(uint4*)(sk + row * 256 + ((cc ^ (row & 15)) << 4)) = v;
            }
        }
        __syncthreads();
        for (int it = 0; it < 4; ++it) {
            const int tgp = base + it * tgs;
            if (tgp >= 256) break;
            const int tok = tgp * 128 + w * 32 + tl;
            int* sidx = sA + it * 512;
            bf16x8 qf[8];
            {
                const bf16_t* qr = p.z() + (size_t)tok * QW + hc * 128 + hh * 8;
#pragma unroll
                for (int ks = 0; ks < 8; ++ks) qf[ks] = *(const bf16x8*)(qr + ks * 16);
            }
            int cur[16];
#pragma unroll
            for (int kb = 0; kb < 4; ++kb) {
                f32x16 acc;
#pragma unroll
                for (int r = 0; r < 16; ++r) acc[r] = 0.f;
                const int row = kb * 32 + tl;
#pragma unroll
                for (int ks = 0; ks < 8; ++ks) {
                    const bf16x8 af = *(const bf16x8*)(sk + row * 256 + (((ks * 2 + hh) ^ (row & 15)) << 4));
                    acc = __builtin_amdgcn_mfma_f32_32x32x16_bf16(af, qf[ks], acc, 0, 0, 0);
                }
                int v[16];
#pragma unroll
                for (int r = 0; r < 16; ++r) {
                    const int key = kb * 32 + (r & 3) + 8 * (r >> 2) + 4 * hh;
                    const int fb = (__float_as_int(acc[r]) & ~127) | (127 - key);
                    v[r] = ord_key(fb);
                }
                bitonic_sort_desc<16>(v);
                if (kb == 0) {
#pragma unroll
                    for (int r = 0; r < 16; ++r) cur[r] = v[r];
                } else {
                    merge_prune16(cur, v);
                }
            }
            {
                int o[16];
#pragma unroll
                for (int r = 0; r < 16; ++r) o[r] = __shfl_xor(cur[r], 32);
                merge_prune16(cur, o);
            }
            if (c == 0) {
#pragma unroll
                for (int r = 0; r < 16; ++r) sidx[r * 32 + tl] = cur[r];
                continue;
            }
#pragma unroll
            for (int r = 0; r < 16; ++r) sB[r * 32 + tl] = cur[r];
        float va[16], vb[16];
#pragma unroll
        for (int r = 0; r < 16; ++r) {
            const int fa = ord_key(sidx[r * 32 + tl]), fb = ord_key(sB[r * 32 + tl]);
            va[r] = __int_as_float(fa & ~127);
            vb[r] = __int_as_float(fb & ~127);
        }
        int best[16];
#pragma unroll
        for (int j = 0; j < 16; ++j) best[j] = ord_key((__float_as_int(va[0] + vb[j]) & ~255) | (255 - j));
#pragma unroll
        for (int i = 1; i < 16; ++i) {
            const int n = 16 / (i + 1);
            int row[16];
#pragma unroll
            for (int j = 0; j < 16; ++j)
                row[j] = (j < n) ? ord_key((__float_as_int(va[i] + vb[j]) & ~255) | (255 - (i * 16 + j))) : (int)0x80000000;
            merge_prune16(best, row);
        }
        float sv[16];
        int pid[16];
#pragma unroll
        for (int r = 0; r < 16; ++r) {
            const int cb = ord_key(best[r]);
            sv[r] = __int_as_float(cb & ~255);
            pid[r] = 255 - (cb & 255);
        }
        float tot = 0.f;
        const float smax = sv[0];
#pragma unroll
        for (int r = 0; r < 16; ++r) { sv[r] = __expf(sv[r] - smax); tot += sv[r]; }
        const float inv = 1.0f / tot;
        if (hh == 0) {
#pragma unroll
            for (int r = 0; r < 16; ++r) {
                const int ia = 127 - (ord_key(sidx[(pid[r] >> 4) * 32 + tl]) & 127);
                const int ib = 127 - (ord_key(sB[(pid[r] & 15) * 32 + tl]) & 127);
                const int pos = (r & 7) * 16 + h * 2 + (r >> 3);
                p.eidx()[(size_t)tok * 128 + pos] = (unsigned short)(ia * 128 + ib);
                p.gate()[(size_t)tok * 128 + pos] = sv[r] * inv;
            }
        }
        }
    }
}

constexpr int PEER_TG = 512;
constexpr int PEER_TPW = PEER_TG / 8;
constexpr int PEER_NTG = NTOK / PEER_TG;
constexpr int PEER_NCH = 8;

__device__ __forceinline__ bool peer_pop(unsigned* q, int my, int& cur, int& chunk, int& tg, int* sh) {
    __syncthreads();
    if (threadIdx.x == 0) {
        int qi = -1, idx = 0;
        while (cur < 8) {
            qi = (my + cur) & 7;
            idx = (int)atomicAdd(&q[qi * 64], 1u);
            if (idx < PEER_NTG) break;
            ++cur; qi = -1;
        }
        sh[0] = qi; sh[1] = idx;
    }
    __syncthreads();
    const int qi = sh[0], idx = sh[1];
    if (qi < 0) return false;
    chunk = qi;
    tg = idx;
    return true;
}

#define PEER_G1(base, wv, hi) (*(const uint4*)((base) + (size_t)((hi) ? ((wv) >> 16) : ((wv) & 0xFFFFu)) * 128))
#define PEER_GATHER16(dst, base, ia, ib)                                                             \
    dst[0] = PEER_G1(base, (ia).x, 0);  dst[1] = PEER_G1(base, (ia).x, 1);  dst[2] = PEER_G1(base, (ia).y, 0);  dst[3] = PEER_G1(base, (ia).y, 1);   \
    dst[4] = PEER_G1(base, (ia).z, 0);  dst[5] = PEER_G1(base, (ia).z, 1);  dst[6] = PEER_G1(base, (ia).w, 0);  dst[7] = PEER_G1(base, (ia).w, 1);   \
    dst[8] = PEER_G1(base, (ib).x, 0);  dst[9] = PEER_G1(base, (ib).x, 1);  dst[10] = PEER_G1(base, (ib).y, 0); dst[11] = PEER_G1(base, (ib).y, 1);  \
    dst[12] = PEER_G1(base, (ib).z, 0); dst[13] = PEER_G1(base, (ib).z, 1); dst[14] = PEER_G1(base, (ib).w, 0); dst[15] = PEER_G1(base, (ib).w, 1);

__device__ __forceinline__ unsigned quant4(float a, float b, float c, float d, float qs) {
    const int q0 = (int)rintf(__builtin_amdgcn_fmed3f(a * qs, -127.f, 127.f)), q1 = (int)rintf(__builtin_amdgcn_fmed3f(b * qs, -127.f, 127.f));
    const int q2 = (int)rintf(__builtin_amdgcn_fmed3f(c * qs, -127.f, 127.f)), q3 = (int)rintf(__builtin_amdgcn_fmed3f(d * qs, -127.f, 127.f));
    return (unsigned)(q0 & 255) | ((unsigned)(q1 & 255) << 8) | ((unsigned)(q2 & 255) << 16) | ((unsigned)(q3 & 255) << 24);
}
template <int CTRL>
__device__ __forceinline__ int dpp_movi(int v) { return __builtin_amdgcn_update_dpp(0, v, CTRL, 0xf, 0xf, true); }

struct DotTok { uint4 ia, ib; uint4 ha, hb; float hm; };
__device__ __forceinline__ void dots_load(const Params& p, DotTok& t, int tok, int c, int g, int d8) {
    const uint4* idp = (const uint4*)(p.eidx() + (size_t)tok * 128 + g * 16);
    t.ia = idp[0]; t.ib = idp[1];
    const uint4* hp = (const uint4*)(p.h() + (size_t)tok * D + c * 128 + d8 * 16);
    t.ha = hp[0]; t.hb = hp[1];
    t.hm = __uint_as_float(p.hmax()[tok]);
}
__device__ __forceinline__ void dots_finish(const Params& p, const uint4 (&uu)[16], const DotTok& t, int tok, int c, int g, int d8) {
    const float qs = t.hm > 0.f ? 127.0f / t.hm : 0.f;
    const int h0 = (int)quant4(bflo(t.ha.x), bfhi(t.ha.x), bflo(t.ha.y), bfhi(t.ha.y), qs);
    const int h1 = (int)quant4(bflo(t.ha.z), bfhi(t.ha.z), bflo(t.ha.w), bfhi(t.ha.w), qs);
    const int h2 = (int)quant4(bflo(t.hb.x), bfhi(t.hb.x), bflo(t.hb.y), bfhi(t.hb.y), qs);
    const int h3 = (int)quant4(bflo(t.hb.z), bfhi(t.hb.z), bflo(t.hb.w), bfhi(t.hb.w), qs);
    int acc[16];
#pragma unroll
    for (int i = 0; i < 16; ++i) {
        int a = __builtin_amdgcn_sdot4((int)uu[i].x, h0, 0, false);
        a = __builtin_amdgcn_sdot4((int)uu[i].y, h1, a, false);
        a = __builtin_amdgcn_sdot4((int)uu[i].z, h2, a, false);
        a = __builtin_amdgcn_sdot4((int)uu[i].w, h3, a, false);
        a += dpp_movi<DPP_QP_X1>(a);
        a += dpp_movi<DPP_QP_X2>(a);
        a += dpp_movi<DPP_HMIRROR>(a);
        acc[i] = a;
    }
    if (d8 == 0) {
        int4* dst = (int4*)((int*)p.partial() + ((size_t)c * NTOK + tok) * 128 + g * 16);
        dst[0] = make_int4(acc[0], acc[1], acc[2], acc[3]);
        dst[1] = make_int4(acc[4], acc[5], acc[6], acc[7]);
        dst[2] = make_int4(acc[8], acc[9], acc[10], acc[11]);
        dst[3] = make_int4(acc[12], acc[13], acc[14], acc[15]);
    }
}

__device__ void phase_peer_dots(const Params& p, char* smem) {
    int* sh = (int*)smem;
    const int tid = threadIdx.x, lane = tid & 63, w = tid >> 6;
    const int g = lane >> 3, d8 = lane & 7;
    const int my = (int)(xcc_id() & 7u);
    int cur = 0, c = 0, tg = 0;
    while (peer_pop(p.queue(), my, cur, c, tg, sh)) {
        const char* ub = (const char*)p.u_c() + (size_t)c * 16384 * 128 + d8 * 16;
        const int tok0 = tg * PEER_TG + w;
        DotTok ta, tb, tn;
        uint4 ua[16], ubuf[16];
        dots_load(p, ta, tok0, c, g, d8);
        dots_load(p, tb, tok0 + 8, c, g, d8);
        PEER_GATHER16(ua, ub, ta.ia, ta.ib)
        PEER_GATHER16(ubuf, ub, tb.ia, tb.ib)
        dots_load(p, tn, tok0 + 16, c, g, d8);
        for (int k = 0; k < PEER_TPW; k += 2) {
            dots_finish(p, ua, ta, tok0 + 8 * k, c, g, d8);
            if (k + 2 < PEER_TPW) {
                ta = tn;
                PEER_GATHER16(ua, ub, ta.ia, ta.ib)
                dots_load(p, tn, tok0 + 8 * min(k + 3, PEER_TPW - 1), c, g, d8);
            }
            dots_finish(p, ubuf, tb, tok0 + 8 * (k + 1), c, g, d8);
            if (k + 3 < PEER_TPW) {
                tb = tn;
                PEER_GATHER16(ubuf, ub, tb.ia, tb.ib)
                dots_load(p, tn, tok0 + 8 * min(k + 4, PEER_TPW - 1), c, g, d8);
            }
        }
    }
}

__device__ __forceinline__ float gelu_erf(float v) {
    const float av = fabsf(v);
    const float t = __builtin_amdgcn_rcpf(fmaf(av, 0.2316418882f, 1.0f));
    float q = fmaf(t, 0.5307027145f, -0.7265760135f);
    q = fmaf(q, t, 0.7107068705f);
    q = fmaf(q, t, -0.142248368f);
    q = fmaf(q, t, 0.127414796f);
    q = q * t;
    const float e = __builtin_amdgcn_exp2f(v * v * -0.72134752044f);
    const float m = v * (q * e);
    return v < 0.f ? m : v - m;
}
__device__ void phase_peer_coef(const Params& p) {
    const int tid = threadIdx.x, lane = tid & 63, w = tid >> 6;
    const int* partial = (const int*)p.partial();
    for (int tok = blockIdx.x * 8 + w; tok < NTOK; tok += gridDim.x * 8) {
        const float sh = __uint_as_float(p.hmax()[tok]) * (1.0f / 127.0f) * rsqrtf(p.ss1()[tok] * (1.0f / 1024.0f) + EPS);
        float cf[2];
#pragma unroll
        for (int u = 0; u < 2; ++u) {
            const size_t i = (size_t)tok * 128 + lane + 64 * u;
            int ps = 0;
#pragma unroll
            for (int c = 0; c < PEER_NCH; ++c) ps += partial[(size_t)c * NTOK * 128 + i];
            const int e = p.eidx()[i];
            const float d = (float)ps * p.scale_u()[e] * sh;
            cf[u] = gelu_erf(d) * p.gate()[i] * p.scale_v()[e];
        }
        const float cm = wave_max(fmaxf(fabsf(cf[0]), fabsf(cf[1])));
        const float qs = cm > 0.f ? 127.0f / cm : 0.f;
        p.coef()[(size_t)tok * 128 + lane] = (signed char)(int)rintf(cf[0] * qs);
        p.coef()[(size_t)tok * 128 + lane + 64] = (signed char)(int)rintf(cf[1] * qs);
        if (lane == 0) p.csum()[tok] = cm * (1.0f / 127.0f);
    }
}

struct AccTok { uint4 ia, ib; uint4 cq; float cs; };
__device__ __forceinline__ void acc_load(const Params& p, AccTok& t, int tok, int g) {
    const uint4* idp = (const uint4*)(p.eidx() + (size_t)tok * 128 + g * 16);
    t.ia = idp[0]; t.ib = idp[1];
    t.cq = *(const uint4*)(p.coef() + (size_t)tok * 128 + g * 16);
    t.cs = p.csum()[tok];
}
#define PEER_T4DOT(acc, B, r0, r1, r2, r3, cq)                                   \
    {                                                                            \
        const unsigned t0 = __builtin_amdgcn_perm(r1, r0, 0x05010400u), t1 = __builtin_amdgcn_perm(r1, r0, 0x07030602u); \
        const unsigned t2 = __builtin_amdgcn_perm(r3, r2, 0x05010400u), t3 = __builtin_amdgcn_perm(r3, r2, 0x07030602u); \
        acc[(B) + 0] = __builtin_amdgcn_sdot4((int)__builtin_amdgcn_perm(t2, t0, 0x05040100u), (int)(cq), acc[(B) + 0], false); \
        acc[(B) + 1] = __builtin_amdgcn_sdot4((int)__builtin_amdgcn_perm(t2, t0, 0x07060302u), (int)(cq), acc[(B) + 1], false); \
        acc[(B) + 2] = __builtin_amdgcn_sdot4((int)__builtin_amdgcn_perm(t3, t1, 0x05040100u), (int)(cq), acc[(B) + 2], false); \
        acc[(B) + 3] = __builtin_amdgcn_sdot4((int)__builtin_amdgcn_perm(t3, t1, 0x07060302u), (int)(cq), acc[(B) + 3], false); \
    }
__device__ __forceinline__ void acc_finish(const Params& p, const uint4 (&vv)[16], const AccTok& t, int tok, int c, int g, int d8) {
    const unsigned cw[4] = {t.cq.x, t.cq.y, t.cq.z, t.cq.w};
    int acc[16];
#pragma unroll
    for (int j = 0; j < 16; ++j) acc[j] = 0;
#pragma unroll
    for (int j = 0; j < 4; ++j) {
        PEER_T4DOT(acc, 0, vv[4 * j].x, vv[4 * j + 1].x, vv[4 * j + 2].x, vv[4 * j + 3].x, cw[j])
        PEER_T4DOT(acc, 4, vv[4 * j].y, vv[4 * j + 1].y, vv[4 * j + 2].y, vv[4 * j + 3].y, cw[j])
        PEER_T4DOT(acc, 8, vv[4 * j].z, vv[4 * j + 1].z, vv[4 * j + 2].z, vv[4 * j + 3].z, cw[j])
        PEER_T4DOT(acc, 12, vv[4 * j].w, vv[4 * j + 1].w, vv[4 * j + 2].w, vv[4 * j + 3].w, cw[j])
    }
    float o[16];
#pragma unroll
    for (int j = 0; j < 16; ++j) {
        int v = acc[j];
        v += dpp_movi<DPP_ROR8>(v);
        v += __shfl_xor(v, 16);
        v += __shfl_xor(v, 32);
        o[j] = (float)v * t.cs;
    }
    if (g == 0) {
        uint4 w0, w1;
        w0.x = pack2(o[0], o[1]); w0.y = pack2(o[2], o[3]); w0.z = pack2(o[4], o[5]); w0.w = pack2(o[6], o[7]);
        w1.x = pack2(o[8], o[9]); w1.y = pack2(o[10], o[11]); w1.z = pack2(o[12], o[13]); w1.w = pack2(o[14], o[15]);
        uint4* dst = (uint4*)(p.peer_out() + (size_t)tok * D + c * 128 + d8 * 16);
        dst[0] = w0; dst[1] = w1;
    }
}

__device__ void phase_peer_accum(const Params& p, char* smem) {
    int* sh = (int*)smem;
    const int tid = threadIdx.x, lane = tid & 63, w = tid >> 6;
    const int g = lane >> 3, d8 = lane & 7;
    const int my = (int)(xcc_id() & 7u);
    int cur = 0, c = 0, tg = 0;
    while (peer_pop(p.queue() + 1024, my, cur, c, tg, sh)) {
        const char* vb = (const char*)p.v_c() + (size_t)c * 16384 * 128 + d8 * 16;
        const int tok0 = tg * PEER_TG + w;
        AccTok ta, tb, tn;
        uint4 va[16], vbuf[16];
        acc_load(p, ta, tok0, g);
        acc_load(p, tb, tok0 + 8, g);
        PEER_GATHER16(va, vb, ta.ia, ta.ib)
        PEER_GATHER16(vbuf, vb, tb.ia, tb.ib)
        acc_load(p, tn, tok0 + 16, g);
        for (int k = 0; k < PEER_TPW; k += 2) {
            acc_finish(p, va, ta, tok0 + 8 * k, c, g, d8);
            if (k + 2 < PEER_TPW) {
                ta = tn;
                PEER_GATHER16(va, vb, ta.ia, ta.ib)
                acc_load(p, tn, tok0 + 8 * min(k + 3, PEER_TPW - 1), g);
            }
            acc_finish(p, vbuf, tb, tok0 + 8 * (k + 1), c, g, d8);
            if (k + 3 < PEER_TPW) {
                tb = tn;
                PEER_GATHER16(vbuf, vb, tb.ia, tb.ib)
                acc_load(p, tn, tok0 + 8 * min(k + 4, PEER_TPW - 1), g);
            }
        }
    }
}

__device__ void phase_final(const Params& p) {
    const int tid = threadIdx.x, lane = tid & 63, w = tid >> 6;
    for (int tok = blockIdx.x * 8 + w; tok < NTOK; tok += gridDim.x * 8) {
        float* orow = p.out + (size_t)tok * D;
        const bf16_t* prow = p.peer_out() + (size_t)tok * D;
        float4 v[4];
        float ss = 0.f;
#pragma unroll
        for (int j = 0; j < 4; ++j) {
            v[j] = *(const float4*)(orow + (j * 64 + lane) * 4);
            const uint2 pk = *(const uint2*)(prow + (j * 64 + lane) * 4);
            v[j].x += bflo(pk.x); v[j].y += bfhi(pk.x); v[j].z += bflo(pk.y); v[j].w += bfhi(pk.y);
            ss += v[j].x * v[j].x + v[j].y * v[j].y + v[j].z * v[j].z + v[j].w * v[j].w;
        }
        ss = wave_sum(ss);
        const float rs = rsqrtf(ss * (1.0f / 1024.0f) + EPS);
#pragma unroll
        for (int j = 0; j < 4; ++j) {
            const float4 gg = *(const float4*)(p.fin_g + (j * 64 + lane) * 4);
            float4 o;
            o.x = v[j].x * rs * gg.x; o.y = v[j].y * rs * gg.y; o.z = v[j].z * rs * gg.z; o.w = v[j].w * rs * gg.w;
            *(float4*)(orow + (j * 64 + lane) * 4) = o;
        }
    }
}

#define XB_TMO      128
#define XB_XCNT(j)  (256  + 64 * (j))
#define XB_XSUB(j)  (1280 + 64 * (j))
#define XB_XGEN(j)  (2304 + 64 * (j))
#define XB_TOP      3328
#define XB_TOPGEN   3392
#define XCD_BAR_WORDS 3456
#define XB_SPIN_CAP (1u << 18)
__device__ __forceinline__ unsigned xb_ld(unsigned* p)              { return __hip_atomic_load(p, __ATOMIC_RELAXED, __HIP_MEMORY_SCOPE_AGENT); }
__device__ __forceinline__ unsigned xb_add(unsigned* p, unsigned v) { return __hip_atomic_fetch_add(p, v, __ATOMIC_RELAXED, __HIP_MEMORY_SCOPE_AGENT); }
#define XB_SPIN(cond, bar) do { unsigned _sp = 0; while (cond) { __builtin_amdgcn_s_sleep(1); \
    if ((++_sp & 255u) == 0u) { if (xb_ld(&(bar)[XB_TMO])) break; if (_sp > XB_SPIN_CAP) { atomicAdd(&(bar)[XB_TMO], 1u); break; } } } } while (0)

struct XcdBarrier { unsigned* bar; unsigned x; volatile unsigned* st; };

__device__ __forceinline__ XcdBarrier xcd_barrier_post(unsigned* bar, volatile unsigned* st) {
    XcdBarrier b; b.bar = bar; b.x = xcc_id(); b.st = st;
    if (threadIdx.x == 0) (void)xb_add(&bar[XB_XCNT(b.x)], 1u);
    return b;
}
__device__ __forceinline__ void xcd_barrier_complete(unsigned* bar, unsigned x, unsigned& nloc, unsigned& nx) {
    const unsigned G = gridDim.x * gridDim.y * gridDim.z;
    unsigned sum, cnt, mine, sp = 0u;
    for (;;) {
        sum = 0u; cnt = 0u; mine = 0u;
#pragma unroll
        for (unsigned j = 0; j < 16; ++j) { const unsigned c = xb_ld(&bar[XB_XCNT(j)]); sum += c; cnt += (c > 0u) ? 1u : 0u; mine = (j == x) ? c : mine; }
        if (sum == G) break;
        __builtin_amdgcn_s_sleep(1);
        if ((++sp & 255u) == 0u) { if (xb_ld(&bar[XB_TMO])) break; if (sp > XB_SPIN_CAP) { atomicAdd(&bar[XB_TMO], 1u); break; } }
    }
    nloc = mine > 0u ? mine : 1u; nx = cnt > 0u ? cnt : 1u;
}
__device__ __forceinline__ void xcd_barrier(const XcdBarrier& b) {
    asm volatile("s_waitcnt vmcnt(0)" ::: "memory");
    __syncthreads();
    if (threadIdx.x == 0) {
        unsigned* bar = b.bar;
        __builtin_amdgcn_s_waitcnt(0);
        unsigned nloc = b.st[0], nx = b.st[1];
        if (nloc == 0u) { xcd_barrier_complete(bar, b.x, nloc, nx); b.st[0] = nloc; b.st[1] = nx; }
        const unsigned old = xb_add(&bar[XB_XSUB(b.x)], 1u);
        const unsigned gen = old / nloc;
        if (old + 1u == (gen + 1u) * nloc) {
            __builtin_amdgcn_fence(__ATOMIC_RELEASE, "agent");
            asm volatile("s_waitcnt vmcnt(0)" ::: "memory");
            const unsigned og = xb_add(&bar[XB_TOP], 1u);
            const unsigned tg = og / nx;
            if (og + 1u == (tg + 1u) * nx) xb_add(&bar[XB_TOPGEN], 1u);
            else XB_SPIN(xb_ld(&bar[XB_TOPGEN]) == tg, bar);
            __builtin_amdgcn_fence(__ATOMIC_ACQUIRE, "agent");
            xb_add(&bar[XB_XGEN(b.x)], 1u);
            asm volatile("s_waitcnt vmcnt(0)" ::: "memory");
        } else {
            XB_SPIN(xb_ld(&bar[XB_XGEN(b.x)]) == gen, bar);
            __builtin_amdgcn_fence(__ATOMIC_ACQUIRE, "agent");
            asm volatile("s_waitcnt vmcnt(0)" ::: "memory");
        }
    }
    __syncthreads();
}

#define RUN_PHASE(K, CALL)                                              \
    if (ph_lo <= (K) && (K) < ph_hi) {                                  \
        CALL;                                                           \
        if (COOP) { if ((K) + 1 < ph_hi) { xcd_barrier(xb); } } \
    }

template <bool COOP>
__global__ void __launch_bounds__(512, 2) fwd_kernel(Params p, int ph_lo, int ph_hi) {
    __shared__ __attribute__((aligned(16))) char smem[SMEM_BYTES + 16];
    char* smh = smem + VHB * HALF_SMEM;
    XcdBarrier xb;
    if (COOP) {
        if (threadIdx.x == 0) *(uint4*)(smem + SMEM_BYTES) = make_uint4(0u, 0u, 0u, 0u);
        __syncthreads();
        xb = xcd_barrier_post(p.bar(), (volatile unsigned*)(smem + SMEM_BYTES));
    }
    if (COOP) { if (ph_lo < 0) cg::this_grid().sync(); }
    RUN_PHASE(0, phase_prep(p, smh))
    RUN_PHASE(1, phase_gemm_in(p, smem))
    RUN_PHASE(2, phase_mixers(p, smh))
    RUN_PHASE(3, (phase_gemm_kv(p, smem), phase_hg_scan(p)))
    RUN_PHASE(4, phase_hg_out(p, smh))
    RUN_PHASE(5, phase_gemm_out(p, smem))
    RUN_PHASE(7, phase_gemm_q(p, smem))
    RUN_PHASE(8, phase_route(p, smh))
    RUN_PHASE(10, phase_peer_dots(p, smem))
    RUN_PHASE(11, phase_peer_coef(p))
    RUN_PHASE(12, phase_peer_accum(p, smem))
    RUN_PHASE(13, phase_final(p))
}

extern "C" void kernel_launch(void* const* d_in, const int* in_sizes, int n_in, void* d_out, int out_size, void* d_ws, size_t ws_size,
                              hipStream_t stream) {
    Params p{};
    p.x = (const float*)d_in[0]; p.mem = (const float*)d_in[1]; p.attn_g = (const float*)d_in[2]; p.w_in = (const float*)d_in[3];
    p.rpb = (const float*)d_in[4]; p.hg_lb = (const float*)d_in[5]; p.hg_g = (const float*)d_in[6]; p.mem_g = (const float*)d_in[7];
    p.w_kv = (const float*)d_in[8]; p.w_out = (const float*)d_in[9]; p.ffn_g = (const float*)d_in[10]; p.w_q = (const float*)d_in[11];
    p.subk = (const float*)d_in[12]; p.pu = (const float*)d_in[13]; p.pv = (const float*)d_in[14]; p.fin_g = (const float*)d_in[15];
    p.out = (float*)d_out;
    p.ws = (char*)d_ws;
    if (WS_TOTAL > ws_size) { fprintf(stderr, "workspace too small: need %zu have %zu\n", (size_t)WS_TOTAL, ws_size); return; }

#if defined(MULTI_LAUNCH)
    for (int ph = 0; ph < NPHASE; ++ph) fwd_kernel<false><<<dim3(512), dim3(512), 0, stream>>>(p, ph, ph + 1);
#else
    static int grid_blocks = 0;
    if (!grid_blocks) {
        int dev = 0, cus = 0, per_cu = 0;
        hipGetDevice(&dev);
        hipDeviceGetAttribute(&cus, hipDeviceAttributeMultiprocessorCount, dev);
        hipOccupancyMaxActiveBlocksPerMultiprocessor(&per_cu, fwd_kernel<true>, 512, 0);
        if (per_cu > 1) per_cu = 1;
        grid_blocks = (cus * per_cu) & ~3;
    }
    (void)hipMemsetAsync((char*)d_ws + OFF_BAR, 0, XCD_BAR_WORDS * 4, stream);
    int lo = 0, hi = NPHASE;
    void* args[] = {&p, &lo, &hi};
    hipError_t e = hipLaunchCooperativeKernel((void*)fwd_kernel<true>, dim3(grid_blocks), dim3(512), args, 0, stream);
    if (e != hipSuccess) fprintf(stderr, "cooperative launch failed: %s (grid %d)\n", hipGetErrorString(e), grid_blocks);
#endif
}
```

```cpp
#include <hip/hip_runtime.h>
#include <hip/hip_cooperative_groups.h>
#include <stdint.h>
#include <cstdio>

namespace cg = cooperative_groups;

#define VTID ((int)(threadIdx.x & 255))
#define VHB ((int)(threadIdx.x >> 8))
#define VBID ((int)(blockIdx.x * 2 + (threadIdx.x >> 8)))
#define VGRID ((int)(gridDim.x * 2))
constexpr int HALF_SMEM = 73728;

typedef unsigned short bf16_t;
typedef short bf16x8 __attribute__((ext_vector_type(8)));
typedef float f32x4 __attribute__((ext_vector_type(4)));

constexpr int D = 1024;
constexpr int NB = 4;
constexpr int T = 8192;
constexpr int NTOK = NB * T;
constexpr int INW = 3072;
constexpr int QW = 2048;
constexpr float EPS = 1e-6f;
constexpr int SMEM_BYTES = 2 * 73728;
constexpr int NPHASE = 14;

constexpr size_t al256(size_t x) { return (x + 255) & ~(size_t)255; }
constexpr size_t OFF_W_IN_T = 0;
constexpr size_t OFF_W_OUT_T = OFF_W_IN_T + al256((size_t)3072 * 1024 * 2);
constexpr size_t OFF_W_Q_T = OFF_W_OUT_T + al256((size_t)1024 * 1024 * 2);
constexpr size_t OFF_W_KV_T = OFF_W_Q_T + al256((size_t)2048 * 1024 * 2);
constexpr size_t OFF_H = OFF_W_KV_T + al256((size_t)512 * 1024 * 2);
constexpr size_t OFF_Z = OFF_H + al256((size_t)32768 * 1024 * 2);
constexpr size_t OFF_MIX = OFF_Z + al256((size_t)32768 * 3072 * 2);
constexpr size_t OFF_MEMN = OFF_MIX + al256((size_t)32768 * 1024 * 2);
constexpr size_t OFF_KVB = OFF_MEMN + al256((size_t)1024 * 1024 * 2);
constexpr size_t OFF_LB = OFF_KVB + al256((size_t)1024 * 512 * 2);
constexpr size_t OFF_HSTATE = OFF_LB + al256(512 * 4);
constexpr size_t OFF_HDEC = OFF_HSTATE + al256((size_t)4096 * 4096 * 4);
constexpr size_t OFF_UC = OFF_HDEC + al256((size_t)4096 * 64 * 4);
constexpr size_t OFF_VC = OFF_UC + al256((size_t)16384 * 1024);
constexpr size_t OFF_QUEUE = OFF_VC + al256((size_t)16384 * 1024);
constexpr size_t OFF_SUBK = OFF_QUEUE + al256(2048 * 4);
constexpr size_t OFF_BAR = OFF_SUBK + al256((size_t)16 * 128 * 128 * 2);
constexpr size_t OFF_SS1 = OFF_BAR + al256(4096 * 4);
constexpr size_t OFF_HMAX = OFF_SS1 + al256((size_t)32768 * 4);
constexpr size_t OFF_CSUM = OFF_HMAX + al256((size_t)32768 * 4);
constexpr size_t OFF_SCALE_U = OFF_CSUM + al256((size_t)32768 * 4);
constexpr size_t OFF_SCALE_V = OFF_SCALE_U + al256(16384 * 4);
constexpr size_t OFF_VT = OFF_SCALE_V + al256(16384 * 4);
constexpr size_t OFF_KVT = OFF_VT + al256((size_t)32768 * 512 * 2);
constexpr size_t WS_TOTAL = OFF_KVT + al256((size_t)1024 * 256 * 2);
constexpr size_t OFF_EIDX = OFF_HSTATE;
constexpr size_t OFF_GATE = OFF_HSTATE + (size_t)32768 * 128 * 4;
constexpr size_t OFF_COEF = OFF_HSTATE + (size_t)32768 * 128 * 8;
constexpr size_t OFF_SS = OFF_HSTATE + (size_t)32768 * 128 * 12;
constexpr size_t OFF_PARTIAL = OFF_Z;
constexpr size_t OFF_PEER_OUT = OFF_Z + (size_t)8 * 32768 * 128 * 4;

struct Params {
    const float *x, *mem, *attn_g, *w_in, *rpb, *hg_lb, *hg_g, *mem_g, *w_kv, *w_out, *ffn_g, *w_q, *subk, *pu, *pv, *fin_g;
    float* out;
    char* ws;
#define WSF(type, name, off) __device__ __forceinline__ type* name() const { return (type*)(ws + (off)); }
    WSF(bf16_t, w_in_t, OFF_W_IN_T) WSF(bf16_t, w_out_t, OFF_W_OUT_T) WSF(bf16_t, w_q_t, OFF_W_Q_T) WSF(bf16_t, w_kv_t, OFF_W_KV_T)
    WSF(bf16_t, h, OFF_H)
    WSF(bf16_t, z, OFF_Z)
    WSF(bf16_t, mix, OFF_MIX)
    WSF(bf16_t, memn, OFF_MEMN)
    WSF(bf16_t, kvb, OFF_KVB)
    WSF(float, lb, OFF_LB)
    WSF(float, hstate, OFF_HSTATE)
    WSF(float, hdec, OFF_HDEC)
    WSF(unsigned short, eidx, OFF_EIDX)
    WSF(float, gate, OFF_GATE)
    WSF(signed char, coef, OFF_COEF)
    WSF(bf16_t, peer_out, OFF_PEER_OUT)
    WSF(float, ss, OFF_SS)
    WSF(float, partial, OFF_PARTIAL)
    WSF(bf16_t, u_c, OFF_UC) WSF(bf16_t, v_c, OFF_VC)
    WSF(unsigned, queue, OFF_QUEUE)
    WSF(bf16_t, subk_b, OFF_SUBK)
    WSF(unsigned, bar, OFF_BAR)
    WSF(float, ss1, OFF_SS1) WSF(unsigned, hmax, OFF_HMAX) WSF(float, csum, OFF_CSUM)
    WSF(float, scale_u, OFF_SCALE_U) WSF(float, scale_v, OFF_SCALE_V)
    WSF(bf16_t, vT, OFF_VT)
    WSF(bf16_t, kvT, OFF_KVT)
#undef WSF
};

__device__ __forceinline__ float bf2f(bf16_t v) { return __uint_as_float(((unsigned)v) << 16); }
__device__ __forceinline__ bf16_t f2bf(float f) {
    unsigned u = __float_as_uint(f);
    u += 0x7FFFu + ((u >> 16) & 1u);
    return (bf16_t)(u >> 16);
}
__device__ __forceinline__ float bflo(unsigned u) { return __uint_as_float(u << 16); }
__device__ __forceinline__ float bfhi(unsigned u) { return __uint_as_float(u & 0xFFFF0000u); }
typedef __bf16 bf16x2v_t __attribute__((ext_vector_type(2)));
typedef float f32x2v_t __attribute__((ext_vector_type(2)));
__device__ __forceinline__ unsigned pack2(float a, float b) {
    const f32x2v_t v = {a, b};
    return __builtin_bit_cast(unsigned, __builtin_convertvector(v, bf16x2v_t));
}

__device__ __forceinline__ float wave_sum(float v) {
#pragma unroll
    for (int o = 32; o; o >>= 1) v += __shfl_xor(v, o);
    return v;
}
__device__ __forceinline__ float wave_max(float v) {
#pragma unroll
    for (int o = 32; o; o >>= 1) v = fmaxf(v, __shfl_xor(v, o));
    return v;
}


typedef __bf16 bf16x2_t __attribute__((ext_vector_type(2)));
__device__ __forceinline__ float dot2bf(unsigned a, unsigned b, float acc) {
    return __builtin_amdgcn_fdot2_f32_bf16(__builtin_bit_cast(bf16x2_t, a), __builtin_bit_cast(bf16x2_t, b), acc, false);
}
template <int CTRL>
__device__ __forceinline__ float dpp_mov(float v) {
    return __builtin_bit_cast(float, __builtin_amdgcn_update_dpp(0, __builtin_bit_cast(int, v), CTRL, 0xf, 0xf, true));
}
#define DPP_QP_X1 0xB1
#define DPP_QP_X2 0x4E
#define DPP_HMIRROR 0x141
#define DPP_ROR8 0x128
__device__ __forceinline__ unsigned xcc_id() { return (unsigned)__builtin_amdgcn_s_getreg((3 << 11) | 20) & 0xFu; }

__device__ __forceinline__ void transpose_tile(const float* __restrict__ in, bf16_t* __restrict__ out, int K, int N, int tile, char* smem) {
    float* tl = (float*)smem;
    const int ntn = N >> 6;
    const int k0 = (tile / ntn) << 6, n0 = (tile % ntn) << 6;
    const int tid = VTID;
    __syncthreads();
#pragma unroll 4
    for (int i = 0; i < 16; ++i) {
        int idx = tid + 256 * i;
        int r = idx >> 6, c = idx & 63;
        tl[r * 65 + c] = in[(size_t)(k0 + r) * N + n0 + c];
    }
    __syncthreads();
#pragma unroll 4
    for (int i = 0; i < 16; ++i) {
        int idx = tid + 256 * i;
        int r = idx >> 6, c = idx & 63;
        out[(size_t)(n0 + r) * K + k0 + c] = f2bf(tl[c * 65 + r]);
    }
}

__device__ __forceinline__ void rmsnorm_row_bf16(const float* __restrict__ xr, const float* __restrict__ g, bf16_t* __restrict__ o, int lane) {
    float4 v[4];
    float ss = 0.f;
#pragma unroll
    for (int j = 0; j < 4; ++j) {
        v[j] = *(const float4*)(xr + (j * 64 + lane) * 4);
        ss += v[j].x * v[j].x + v[j].y * v[j].y + v[j].z * v[j].z + v[j].w * v[j].w;
    }
    ss = wave_sum(ss);
    const float rs = rsqrtf(ss * (1.0f / 1024.0f) + EPS);
#pragma unroll
    for (int j = 0; j < 4; ++j) {
        const float4 gg = *(const float4*)(g + (j * 64 + lane) * 4);
        uint2 pk;
        pk.x = pack2(v[j].x * rs * gg.x, v[j].y * rs * gg.y);
        pk.y = pack2(v[j].z * rs * gg.z, v[j].w * rs * gg.w);
        *(uint2*)(o + (j * 64 + lane) * 4) = pk;
    }
}

__device__ void phase_prep(const Params& p, char* smem) {
    const int tid = VTID, lane = tid & 63, w = tid >> 6;
    const int gsz = VGRID, bid = VBID;
    const int t_in = (1024 / 64) * (INW / 64);
    const int t_out = 16 * 16;
    const int t_q = 16 * (QW / 64);
    const int t_kv = 16 * 8;
    const int t_all = t_in + t_out + t_q + t_kv;
    for (int it = bid; it < t_all; it += gsz) {
        if (it < t_in) transpose_tile(p.w_in, p.w_in_t(), 1024, INW, it, smem);
        else if (it < t_in + t_out) transpose_tile(p.w_out, p.w_out_t(), 1024, 1024, it - t_in, smem);
        else if (it < t_in + t_out + t_q) transpose_tile(p.w_q, p.w_q_t(), 1024, QW, it - t_in - t_out, smem);
        else transpose_tile(p.w_kv, p.w_kv_t(), 1024, 512, it - t_in - t_out - t_q, smem);
    }
    for (int i = bid * 256 + tid; i < NTOK; i += gsz * 256) { p.ss1()[i] = 0.f; p.hmax()[i] = 0u; }
    if (bid == 0) for (int i = tid; i < 2048; i += 256) p.queue()[i] = 0u;
    if (bid == 0) {
        for (int i = tid; i < 512; i += 256) {
            int dir = i >> 8, k = i & 255;
            float a0 = p.hg_lb[(dir * 2 + 0) * 256 + k], a1 = p.hg_lb[(dir * 2 + 1) * 256 + k];
            float m = fmaxf(a0, a1);
            float e0 = expf(a0 - m), e1 = expf(a1 - m);
            p.lb()[i] = e0 / (e0 + e1);
        }
    }
    const int nrows = NTOK + 1024;
    for (int r0 = bid * 4; r0 < nrows; r0 += gsz * 4) {
        int r = r0 + w;
        if (r < NTOK) rmsnorm_row_bf16(p.x + (size_t)r * D, p.attn_g, p.h() + (size_t)r * D, lane);
        else if (r < nrows) rmsnorm_row_bf16(p.mem + (size_t)(r - NTOK) * D, p.mem_g, p.memn() + (size_t)(r - NTOK) * D, lane);
    }
    for (int i = bid * 256 + tid; i < 16 * 128 * 128 / 4; i += gsz * 256) {
        const float4 v = *(const float4*)(p.subk + (size_t)i * 4);
        uint2 pk; pk.x = pack2(v.x, v.y); pk.y = pack2(v.z, v.w);
        *(uint2*)(p.subk_b() + (size_t)i * 4) = pk;
    }
    for (int r0 = bid * 4; r0 < 2 * 16384; r0 += gsz * 4) {
        const int r = r0 + w;
        const bool isv = r >= 16384;
        const int e = r & 16383;
        const float* srcp = (isv ? p.pv : p.pu) + (size_t)e * D;
        unsigned* dst = (unsigned*)(isv ? p.v_c() : p.u_c());
        float4 v[4];
        float am = 0.f;
#pragma unroll
        for (int j = 0; j < 4; ++j) {
            v[j] = *(const float4*)(srcp + (j * 64 + lane) * 4);
            am = fmaxf(am, fmaxf(fmaxf(fabsf(v[j].x), fabsf(v[j].y)), fmaxf(fabsf(v[j].z), fabsf(v[j].w))));
        }
        am = wave_max(am);
        const float qs = am > 0.f ? 127.0f / am : 0.f;
        if (lane == 0) (isv ? p.scale_v() : p.scale_u())[e] = am * (1.0f / 127.0f);
        const int off = 0;
#pragma unroll
        for (int j = 0; j < 4; ++j) {
            const int q0 = (int)rintf(v[j].x * qs) + off, q1 = (int)rintf(v[j].y * qs) + off;
            const int q2 = (int)rintf(v[j].z * qs) + off, q3 = (int)rintf(v[j].w * qs) + off;
            const unsigned pk = (unsigned)(q0 & 255) | ((unsigned)(q1 & 255) << 8) | ((unsigned)(q2 & 255) << 16) | ((unsigned)(q3 & 255) << 24);
            const int c = j * 2 + (lane >> 5), d = (lane & 31) * 4;
            dst[(((size_t)c * 16384 + e) * 128 + d) >> 2] = pk;
        }
    }
}

struct EpiBf16 {
    bf16_t* C; int ldc;
    __device__ __forceinline__ void operator()(int row, int col, const f32x4& v) const {
        uint2 pk; pk.x = pack2(v[0], v[1]); pk.y = pack2(v[2], v[3]);
        *(uint2*)(C + (size_t)row * ldc + col) = pk;
    }
};
struct EpiBf16T {
    bf16_t* C; int col0, ncols, rows_per_b;
    __device__ __forceinline__ void operator()(int row, int col, const f32x4& v) const {
        const int bb = row / rows_per_b, rr = row - bb * rows_per_b;
        uint2 pk; pk.x = pack2(v[0], v[1]); pk.y = pack2(v[2], v[3]);
        *(uint2*)(C + ((size_t)bb * ncols + (col - col0)) * rows_per_b + rr) = pk;
    }
};
struct EpiBf16RowScale {
    bf16_t* C; int ldc; const float* ssrow;
    __device__ __forceinline__ void operator()(int row, int col, const f32x4& v) const {
        const float rs = rsqrtf(ssrow[row] * (1.0f / 1024.0f) + EPS);
        uint2 pk; pk.x = pack2(v[0] * rs, v[1] * rs); pk.y = pack2(v[2] * rs, v[3] * rs);
        *(uint2*)(C + (size_t)row * ldc + col) = pk;
    }
};
struct EpiResNorm {
    float* C; const float* R; const float* g; bf16_t* H; int ldc; float* ssrow; unsigned* hmax;
    __device__ __forceinline__ void operator()(int row, int col, const f32x4& v, float& ssq, float& am) const {
        const float4 r = *(const float4*)(R + (size_t)row * ldc + col);
        const float4 gg = *(const float4*)(g + col);
        float4 o; o.x = v[0] + r.x; o.y = v[1] + r.y; o.z = v[2] + r.z; o.w = v[3] + r.w;
        *(float4*)(C + (size_t)row * ldc + col) = o;
        const float h0 = o.x * gg.x, h1 = o.y * gg.y, h2 = o.z * gg.z, h3 = o.w * gg.w;
        uint2 pk; pk.x = pack2(h0, h1); pk.y = pack2(h2, h3);
        *(uint2*)(H + (size_t)row * ldc + col) = pk;
        ssq += o.x * o.x + o.y * o.y + o.z * o.z + o.w * o.w;
        am = fmaxf(am, fmaxf(fmaxf(fabsf(h0), fabsf(h1)), fmaxf(fabsf(h2), fabsf(h3))));
    }
    __device__ __forceinline__ void row_done(int row, float ssq, float am) const {
        atomicAdd(ssrow + row, ssq);
        atomicMax(hmax + row, __float_as_uint(am));
    }
};
struct EpiResF32 {
    float* C; const float* R; int ldc;
    __device__ __forceinline__ void operator()(int row, int col, const f32x4& v) const {
        const float4 r = *(const float4*)(R + (size_t)row * ldc + col);
        float4 o; o.x = v[0] + r.x; o.y = v[1] + r.y; o.z = v[2] + r.z; o.w = v[3] + r.w;
        *(float4*)(C + (size_t)row * ldc + col) = o;
    }
};

template <bool TRANS, class Epi, bool ROWSS = false>
__device__ __forceinline__ void gemm_tile(const bf16_t* __restrict__ A, int lda, const bf16_t* __restrict__ Bt, int ldb, int K,
                                          int m0, int n0, char* smem, const Epi& epi, float* ssrow = nullptr) {
    const int tid = VTID, lane = tid & 63, w = tid >> 6, wr = w >> 1, wc = w & 1;
    const int fr = lane & 15, fq = lane >> 4;
    const int srow = lane >> 3, sslot = lane & 7;
    f32x4 acc[4][4];
#pragma unroll
    for (int mi = 0; mi < 4; ++mi)
#pragma unroll
        for (int ni = 0; ni < 4; ++ni) acc[mi][ni] = (f32x4){0.f, 0.f, 0.f, 0.f};
    const int g0 = (sslot ^ (srow >> 1)) * 8, g1 = (sslot ^ (4 + (srow >> 1))) * 8;
    const bf16_t* Ab = A + (size_t)(m0 + w * 32 + srow) * lda;
    const bf16_t* Bb = Bt + (size_t)(n0 + w * 32 + srow) * ldb;
    const int nk = K >> 6;
    __syncthreads();
#define GEMM_STAGE(kt, buf)                                                                                                  \
    do {                                                                                                                     \
        char* sa = smem + (buf) * 32768 + w * 4096;                                                                          \
        char* sb = sa + 16384;                                                                                               \
        _Pragma("unroll") for (int i = 0; i < 4; ++i) {                                                                      \
            const int gc = (i & 1) ? g1 : g0;                                                                                \
            __builtin_amdgcn_global_load_lds((const unsigned*)(Ab + (size_t)(i * 8) * lda + (kt) * 64 + gc), (unsigned*)(sa + i * 1024), 16, 0, 0); \
            __builtin_amdgcn_global_load_lds((const unsigned*)(Bb + (size_t)(i * 8) * ldb + (kt) * 64 + gc), (unsigned*)(sb + i * 1024), 16, 0, 0); \
        }                                                                                                                    \
    } while (0)
    GEMM_STAGE(0, 0);
    const int key = fr >> 1;
    for (int kt = 0; kt < nk; ++kt) {
        asm volatile("s_waitcnt vmcnt(0)" ::: "memory");
        __syncthreads();
        if (kt + 1 < nk) GEMM_STAGE(kt + 1, (kt + 1) & 1);
        const char* sa = smem + (kt & 1) * 32768;
        const char* sb = sa + 16384;
#pragma unroll
        for (int ks = 0; ks < 2; ++ks) {
            bf16x8 af[4], bfr[4];
            const int co = ((ks * 4 + fq) ^ key) << 4;
#pragma unroll
            for (int mi = 0; mi < 4; ++mi) af[mi] = *(const bf16x8*)(sa + (wr * 64 + mi * 16 + fr) * 128 + co);
#pragma unroll
            for (int ni = 0; ni < 4; ++ni) bfr[ni] = *(const bf16x8*)(sb + (wc * 64 + ni * 16 + fr) * 128 + co);
#pragma unroll
            for (int mi = 0; mi < 4; ++mi)
#pragma unroll
                for (int ni = 0; ni < 4; ++ni)
                    acc[mi][ni] = TRANS ? __builtin_amdgcn_mfma_f32_16x16x32_bf16(af[mi], bfr[ni], acc[mi][ni], 0, 0, 0)
                                        : __builtin_amdgcn_mfma_f32_16x16x32_bf16(bfr[ni], af[mi], acc[mi][ni], 0, 0, 0);
        }
    }
#undef GEMM_STAGE
    if constexpr (ROWSS) {
#pragma unroll
        for (int mi = 0; mi < 4; ++mi) {
            const int row = m0 + wr * 64 + mi * 16 + fr;
            float ssq = 0.f, am = 0.f;
#pragma unroll
            for (int ni = 0; ni < 4; ++ni) epi(row, n0 + wc * 64 + ni * 16 + fq * 4, acc[mi][ni], ssq, am);
            ssq += __shfl_xor(ssq, 16);
            ssq += __shfl_xor(ssq, 32);
            am = fmaxf(am, __shfl_xor(am, 16));
            am = fmaxf(am, __shfl_xor(am, 32));
            if (fq == 0) epi.row_done(row, ssq, am);
        }
    } else {
#pragma unroll
        for (int mi = 0; mi < 4; ++mi)
#pragma unroll
            for (int ni = 0; ni < 4; ++ni) {
                if (TRANS) epi(m0 + wr * 64 + mi * 16 + fq * 4, n0 + wc * 64 + ni * 16 + fr, acc[mi][ni]);
                else epi(m0 + wr * 64 + mi * 16 + fr, n0 + wc * 64 + ni * 16 + fq * 4, acc[mi][ni]);
            }
    }
}


namespace g8 {
constexpr int BM = 256, BK = 64, HALF = 128, HT = HALF * BK;
__device__ __forceinline__ int lds_byte(int r, int c) {
    const int st = (r >> 4) * 2 + (c >> 5), rr = r & 15, cc = c & 31, ob = rr * 64 + cc * 2;
    return st * 1024 + (ob ^ (((ob >> 9) & 1) << 5));
}
__device__ __forceinline__ void stage_rc(int b, int& R, int& C) {
    const int st = b / 1024, sb = b % 1024, swz = sb ^ (((sb >> 9) & 1) << 5);
    R = (st >> 1) * 16 + swz / 64; C = (st & 1) * 32 + (swz % 64) / 2;
}
__device__ __forceinline__ void tile_of(int L, int nM, int nN, int& pm, int& pn) {
    const int nwg = nM * nN;
    int wgid = L;
    { const int q = nwg / 8, r = nwg % 8, xcd = wgid % 8, off = wgid / 8; wgid = (xcd < r ? xcd * (q + 1) : r * (q + 1) + (xcd - r) * q) + off; }
    const int nig = 8 * nN, gid = wgid / nig, fm = gid * 8, gsz = (nM - fm) < 8 ? (nM - fm) : 8;
    pm = fm + ((wgid % nig) % gsz); pn = (wgid % nig) / gsz;
}
}

#define G8_LAS __attribute__((address_space(3)))
template <bool TRANS, bool ROWSS, class Epi>
__device__ __forceinline__ void gemm256_tile(const bf16_t* __restrict__ A, const bf16_t* __restrict__ Bt, int K, int brow, int bcol,
                                             char* shmc, const Epi& epi) {
    using namespace g8;
    G8_LAS unsigned char* lds = (G8_LAS unsigned char*)shmc;
    const int tid = threadIdx.x, wid = __builtin_amdgcn_readfirstlane(tid >> 6), lane = tid & 63, wr = wid >> 2, wc = wid & 3, fr = lane & 15, fq = lane >> 4;
    constexpr int HTB = HALF * BK * 2;
    unsigned voff[2];
#pragma unroll
    for (int i = 0; i < 2; ++i) { int R, C; stage_rc(tid * 16 + i * 8192, R, C); voff[i] = (unsigned)(R * K + C) * 2u; }
    const size_t kstep = (size_t)(BK * 2);
    const size_t hstep = (size_t)HALF * K * 2;
    const unsigned ldsw = (unsigned)wid * 1024u;
    const int aoff = lds_byte(wr * 64 + fr, fq * 8), boff = lds_byte(wc * 32 + fr, fq * 8);
    const char* cA = (const char*)A + (size_t)brow * K * 2;
    const char* cB = (const char*)Bt + (size_t)bcol * K * 2;
#define G8_SA(b, h) (((b) * 2 + (h)) * HTB)
#define G8_SB(b, h) ((4 + (b) * 2 + (h)) * HTB)
#define G8_STAGE(bufoff, gbase) do { _Pragma("unroll") for (int _i = 0; _i < 2; ++_i) \
        __builtin_amdgcn_global_load_lds((const unsigned*)((const char*)(gbase) + voff[_i]), (G8_LAS unsigned*)(lds + (bufoff) + ldsw + _i * 8192), 16, 0, 0); } while (0)
#define G8_LDA(dst, b, h) do { _Pragma("unroll") for (int m = 0; m < 4; ++m) _Pragma("unroll") for (int k = 0; k < 2; ++k) dst[m][k] = *(const G8_LAS bf16x8*)(lds + G8_SA(b, h) + aoff + m * 2048 + k * 1024); } while (0)
#define G8_LDB(dst, b, h) do { _Pragma("unroll") for (int n = 0; n < 2; ++n) _Pragma("unroll") for (int k = 0; k < 2; ++k) dst[n][k] = *(const G8_LAS bf16x8*)(lds + G8_SB(b, h) + boff + n * 2048 + k * 1024); } while (0)
#define G8_MMA(ai, bj, At_, Bt_) do { __builtin_amdgcn_s_setprio(1); _Pragma("unroll") for (int m = 0; m < 4; ++m) _Pragma("unroll") for (int n = 0; n < 2; ++n) _Pragma("unroll") for (int k = 0; k < 2; ++k) \
        acc[ai][bj][m][n] = TRANS ? __builtin_amdgcn_mfma_f32_16x16x32_bf16(At_[m][k], Bt_[n][k], acc[ai][bj][m][n], 0, 0, 0) \
                                  : __builtin_amdgcn_mfma_f32_16x16x32_bf16(Bt_[n][k], At_[m][k], acc[ai][bj][m][n], 0, 0, 0); \
        __builtin_amdgcn_s_setprio(0); } while (0)
#define G8_WAIT_V(n) asm volatile("s_waitcnt vmcnt(" #n ")" ::: "memory")
#define G8_WAIT_L(n) asm volatile("s_waitcnt lgkmcnt(" #n ")" ::: "memory")
#define G8_BAR __builtin_amdgcn_s_barrier()
#define G8_SCHED __builtin_amdgcn_sched_barrier(0)
    f32x4 acc[2][2][4][2];
#pragma unroll
    for (int a = 0; a < 2; ++a)
#pragma unroll
        for (int b = 0; b < 2; ++b)
#pragma unroll
            for (int m = 0; m < 4; ++m)
#pragma unroll
                for (int n = 0; n < 2; ++n) acc[a][b][m][n] = (f32x4){0.f, 0.f, 0.f, 0.f};
    bf16x8 At[4][2], B0[2][2], B1[2][2];
    const int nt = K / BK;
    __syncthreads();
    G8_STAGE(G8_SB(0, 0), cB); G8_STAGE(G8_SA(0, 0), cA); G8_STAGE(G8_SB(0, 1), cB + hstep); G8_STAGE(G8_SA(0, 1), cA + hstep);
    if (wr == 1) G8_BAR;
    G8_WAIT_V(4); G8_BAR;
    G8_STAGE(G8_SB(1, 0), cB + kstep); G8_STAGE(G8_SA(1, 0), cA + kstep); G8_STAGE(G8_SB(1, 1), cB + hstep + kstep);
    G8_WAIT_V(6); G8_BAR;
    for (int t = 0; t < nt - 2; t += 2) {
        const char* a1 = cA + (size_t)(t + 1) * kstep; const char* a2 = a1 + kstep; const char* a3 = a2 + kstep;
        const char* b2 = cB + (size_t)(t + 2) * kstep; const char* b3 = b2 + kstep;
        G8_LDB(B0, 0, 0); G8_SCHED; G8_LDA(At, 0, 0); G8_STAGE(G8_SA(1, 1), a1 + hstep);
        G8_WAIT_L(8); G8_BAR; G8_WAIT_L(0); G8_MMA(0, 0, At, B0); G8_BAR; G8_SCHED;
        G8_LDB(B1, 0, 1); G8_STAGE(G8_SB(0, 0), b2);
        G8_BAR; G8_WAIT_L(0); G8_MMA(0, 1, At, B1); G8_BAR;
        G8_LDA(At, 0, 1); G8_STAGE(G8_SA(0, 0), a2);
        G8_BAR; G8_WAIT_L(0); G8_MMA(1, 0, At, B0); G8_BAR; G8_SCHED;
        G8_STAGE(G8_SB(0, 1), b2 + hstep);
        G8_WAIT_V(6); G8_BAR; G8_MMA(1, 1, At, B1); G8_BAR;
        G8_LDB(B0, 1, 0); G8_SCHED; G8_LDA(At, 1, 0); G8_STAGE(G8_SA(0, 1), a2 + hstep);
        G8_WAIT_L(8); G8_BAR; G8_WAIT_L(0); G8_MMA(0, 0, At, B0); G8_BAR; G8_SCHED;
        G8_LDB(B1, 1, 1); G8_STAGE(G8_SB(1, 0), b3);
        G8_BAR; G8_WAIT_L(0); G8_MMA(0, 1, At, B1); G8_BAR;
        G8_LDA(At, 1, 1); G8_STAGE(G8_SA(1, 0), a3);
        G8_BAR; G8_WAIT_L(0); G8_MMA(1, 0, At, B0); G8_BAR; G8_SCHED;
        G8_STAGE(G8_SB(1, 1), b3 + hstep);
        G8_WAIT_V(6); G8_BAR; G8_MMA(1, 1, At, B1); G8_BAR;
    }
    { G8_LDB(B0, 0, 0); G8_LDA(At, 0, 0); G8_STAGE(G8_SA(1, 1), cA + (size_t)(nt - 1) * kstep + hstep);
      G8_BAR; G8_WAIT_L(0); G8_MMA(0, 0, At, B0); G8_BAR;
      G8_LDB(B1, 0, 1); G8_BAR; G8_WAIT_L(0); G8_MMA(0, 1, At, B1); G8_BAR;
      G8_LDA(At, 0, 1); G8_WAIT_V(4); G8_BAR; G8_WAIT_L(0); G8_MMA(1, 0, At, B0); G8_MMA(1, 1, At, B1); G8_BAR; }
    { G8_LDB(B0, 1, 0); G8_LDA(At, 1, 0); G8_WAIT_V(2); G8_BAR; G8_WAIT_L(0); G8_MMA(0, 0, At, B0); G8_BAR;
      G8_LDB(B1, 1, 1); G8_WAIT_V(0); G8_BAR; G8_WAIT_L(0); G8_MMA(0, 1, At, B1); G8_BAR;
      G8_LDA(At, 1, 1); G8_BAR; G8_WAIT_L(0); G8_MMA(1, 0, At, B0); G8_MMA(1, 1, At, B1); G8_BAR; }
    if (wr == 0) G8_BAR;
    if constexpr (ROWSS) {
#pragma unroll
        for (int ai = 0; ai < 2; ++ai)
#pragma unroll
            for (int m = 0; m < 4; ++m) {
                const int row = brow + ai * HALF + wr * 64 + m * 16 + fr;
                float ssq = 0.f, am = 0.f;
#pragma unroll
                for (int bj = 0; bj < 2; ++bj)
#pragma unroll
                    for (int n = 0; n < 2; ++n) epi(row, bcol + bj * HALF + wc * 32 + n * 16 + fq * 4, acc[ai][bj][m][n], ssq, am);
                ssq += __shfl_xor(ssq, 16);
                ssq += __shfl_xor(ssq, 32);
                am = fmaxf(am, __shfl_xor(am, 16));
                am = fmaxf(am, __shfl_xor(am, 32));
                if (fq == 0) epi.row_done(row, ssq, am);
            }
    } else {
#pragma unroll
        for (int ai = 0; ai < 2; ++ai)
#pragma unroll
            for (int bj = 0; bj < 2; ++bj)
#pragma unroll
                for (int m = 0; m < 4; ++m)
#pragma unroll
                    for (int n = 0; n < 2; ++n) {
                        if (TRANS) epi(brow + ai * HALF + wr * 64 + m * 16 + fq * 4, bcol + bj * HALF + wc * 32 + n * 16 + fr, acc[ai][bj][m][n]);
                        else epi(brow + ai * HALF + wr * 64 + m * 16 + fr, bcol + bj * HALF + wc * 32 + n * 16 + fq * 4, acc[ai][bj][m][n]);
                    }
    }
#undef G8_SA
#undef G8_SB
#undef G8_STAGE
#undef G8_LDA
#undef G8_LDB
#undef G8_MMA
#undef G8_WAIT_V
#undef G8_WAIT_L
#undef G8_BAR
#undef G8_SCHED
}

__device__ void phase_gemm_in(const Params& p, char* smem) {
    const int nM = NTOK / 256, nN = INW / 256;
    EpiBf16 e1{p.z(), INW};
    EpiBf16T e1t{p.vT(), 1024, 512, T};
    for (int i = 0; i * (int)gridDim.x + (int)blockIdx.x < nM * nN; ++i) {
        int pm, pn;
        g8::tile_of(i * gridDim.x + blockIdx.x, nM, nN, pm, pn);
        if (pn >= 4 && pn < 6) gemm256_tile<true, false>(p.h(), p.w_in_t(), D, pm * 256, pn * 256, smem, e1t);
        else gemm256_tile<false, false>(p.h(), p.w_in_t(), D, pm * 256, pn * 256, smem, e1);
    }
}

__device__ void phase_gemm_kv(const Params& p, char* smem) {
    EpiBf16 e2{p.kvb(), 512};
    EpiBf16T e2t{p.kvT(), 256, 256, 256};
    if (blockIdx.x < 4) gemm256_tile<false, false>(p.memn(), p.w_kv_t(), D, blockIdx.x * 256, 0, smem, e2);
    else if (blockIdx.x < 8) gemm256_tile<true, false>(p.memn(), p.w_kv_t(), D, (blockIdx.x - 4) * 256, 256, smem, e2t);
}

__device__ void phase_gemm_out(const Params& p, char* smem) {
    const int nM = NTOK / 256, nN = D / 256;
    EpiResNorm e{p.out, p.x, p.ffn_g, p.h(), D, p.ss1(), p.hmax()};
    for (int i = 0; i * (int)gridDim.x + (int)blockIdx.x < nM * nN; ++i) {
        int pm, pn;
        g8::tile_of(i * gridDim.x + blockIdx.x, nM, nN, pm, pn);
        gemm256_tile<false, true>(p.mix(), p.w_out_t(), D, pm * 256, pn * 256, smem, e);
    }
}

__device__ void phase_gemm_q(const Params& p, char* smem) {
    const int nM = NTOK / 256, nN = QW / 256;
    EpiBf16RowScale e{p.z(), QW, p.ss1()};
    for (int i = 0; i * (int)gridDim.x + (int)blockIdx.x < nM * nN; ++i) {
        int pm, pn;
        g8::tile_of(i * gridDim.x + blockIdx.x, nM, nN, pm, pn);
        gemm256_tile<false, false>(p.h(), p.w_q_t(), D, pm * 256, pn * 256, smem, e);
    }
}

__device__ __forceinline__ float dot8(const uint4& v, const float* __restrict__ q) {
    return bflo(v.x) * q[0] + bfhi(v.x) * q[1] + bflo(v.y) * q[2] + bfhi(v.y) * q[3] +
           bflo(v.z) * q[4] + bfhi(v.z) * q[5] + bflo(v.w) * q[6] + bfhi(v.w) * q[7];
}

typedef float f32x16 __attribute__((ext_vector_type(16)));
constexpr int HRS = 144;
__device__ __forceinline__ f32x16 tile_mm64(const char* X, const char* Y, int xrow0, int yrow0, int lane, f32x16 acc) {
    const int r = lane & 31, hh = lane >> 5;
#pragma unroll
    for (int ks = 0; ks < 4; ++ks) {
        const bf16x8 a = *(const bf16x8*)(X + (xrow0 + r) * HRS + ks * 32 + hh * 16);
        const bf16x8 b = *(const bf16x8*)(Y + (yrow0 + r) * HRS + ks * 32 + hh * 16);
        acc = __builtin_amdgcn_mfma_f32_32x32x16_bf16(a, b, acc, 0, 0, 0);
    }
    return acc;
}
__device__ __forceinline__ int crow(int reg, int hh) { return (reg & 3) + 8 * (reg >> 2) + 4 * hh; }

__device__ __forceinline__ void hg_load_vt(const Params& p, char* sVT, int tok0, int h, int kcol, int sq) {
    const bf16_t* zp = p.z() + (size_t)(tok0 + sq * 16) * INW + 2304 + h * 64 + kcol;
    unsigned pk[8];
#pragma unroll
    for (int j = 0; j < 8; ++j) {
        const unsigned lo = zp[(size_t)(2 * j) * INW], hi = zp[(size_t)(2 * j + 1) * INW];
        pk[j] = lo | (hi << 16);
    }
    *(uint4*)(sVT + kcol * HRS + sq * 32) = make_uint4(pk[0], pk[1], pk[2], pk[3]);
    *(uint4*)(sVT + kcol * HRS + sq * 32 + 16) = make_uint4(pk[4], pk[5], pk[6], pk[7]);
}

__device__ __forceinline__ float hg_gates(const Params& p, float* sTot, int tok0, int h, int dir, int kcol, int sq, float (&bj)[16], float (&kk)[16]) {
    const bf16_t* zp = p.z() + (size_t)(tok0 + sq * 16) * INW + 1792 + dir * 256 + h * 64 + kcol;
    const float lbv = p.lb()[dir * 256 + h * 64 + kcol];
#pragma unroll
    for (int j = 0; j < 16; ++j) {
        const float pre = bf2f(zp[(size_t)j * INW]);
        const float f = lbv + (1.0f - lbv) * (1.0f / (1.0f + __expf(-pre)));
        bj[j] = __logf(f);
        kk[j] = 1.0f - f;
    }
    if (dir == 0) {
#pragma unroll
        for (int j = 1; j < 16; ++j) bj[j] += bj[j - 1];
        sTot[sq * 64 + kcol] = bj[15];
    } else {
#pragma unroll
        for (int j = 14; j >= 0; --j) bj[j] += bj[j + 1];
        sTot[sq * 64 + kcol] = bj[0];
    }
    __syncthreads();
    const float t0 = sTot[kcol], t1 = sTot[64 + kcol], t2 = sTot[128 + kcol], t3 = sTot[192 + kcol];
    float off;
    if (dir == 0) off = (sq > 0 ? t0 : 0.f) + (sq > 1 ? t1 : 0.f) + (sq > 2 ? t2 : 0.f);
    else off = (sq < 3 ? t3 : 0.f) + (sq < 2 ? t2 : 0.f) + (sq < 1 ? t1 : 0.f);
#pragma unroll
    for (int j = 0; j < 16; ++j) bj[j] += off;
    return t0 + t1 + t2 + t3;
}

__device__ void hg_local(const Params& p, char* smem) {
    char* sVT = smem;
    char* sKT = smem + 9216;
    float* sTot = (float*)(smem + 18432);
    const int tid = VTID, lane = tid & 63, w = tid >> 6;
    const int kcol = tid & 63, sq = tid >> 6;
    for (int item = VBID; item < 4096; item += VGRID) {
        const int c = item & 127, dir = (item >> 7) & 1, h = (item >> 8) & 3, b = item >> 10;
        const int tok0 = b * T + c * 64;
        __syncthreads();
        hg_load_vt(p, sVT, tok0, h, kcol, sq);
        float bj[16], kk[16];
        const float btot = hg_gates(p, sTot, tok0, h, dir, kcol, sq, bj, kk);
        unsigned pk[8];
#pragma unroll
        for (int j = 0; j < 8; ++j)
            pk[j] = pack2(kk[2 * j] * __expf(btot - bj[2 * j]), kk[2 * j + 1] * __expf(btot - bj[2 * j + 1]));
        *(uint4*)(sKT + kcol * HRS + sq * 32) = make_uint4(pk[0], pk[1], pk[2], pk[3]);
        *(uint4*)(sKT + kcol * HRS + sq * 32 + 16) = make_uint4(pk[4], pk[5], pk[6], pk[7]);
        if (sq == 0) p.hdec()[item * 64 + kcol] = __expf(btot);
        __syncthreads();
        const int vi = w >> 1, ki = w & 1, hh = lane >> 5;
        f32x16 acc;
#pragma unroll
        for (int r = 0; r < 16; ++r) acc[r] = 0.f;
        acc = tile_mm64(sVT, sKT, vi * 32, ki * 32, lane, acc);
        float* dst = p.hstate() + (size_t)item * 4096 + ki * 32 + (lane & 31);
#pragma unroll
        for (int r = 0; r < 16; ++r) dst[(vi * 32 + crow(r, hh)) * 64] = acc[r];
    }
}

__device__ __forceinline__ bf16x8 pack8(const f32x16& x, int s8) {
    typedef unsigned u32x4_t __attribute__((ext_vector_type(4)));
    u32x4_t pk;
    pk[0] = pack2(x[s8], x[s8 + 1]); pk[1] = pack2(x[s8 + 2], x[s8 + 3]);
    pk[2] = pack2(x[s8 + 4], x[s8 + 5]); pk[3] = pack2(x[s8 + 6], x[s8 + 7]);
    return __builtin_bit_cast(bf16x8, pk);
}
__device__ __forceinline__ bf16x8 join8(const uint2& lo, const uint2& hi) {
    typedef unsigned u32x4_t __attribute__((ext_vector_type(4)));
    u32x4_t pk; pk[0] = lo.x; pk[1] = lo.y; pk[2] = hi.x; pk[3] = hi.y;
    return __builtin_bit_cast(bf16x8, pk);
}

__device__ __forceinline__ int swap23(int r) { return (r & ~12) | ((r & 4) << 1) | ((r & 8) >> 1); }

__device__ __forceinline__ void mem_attn_wave(const Params& p, int wu, int lane) {
    const int tile = wu & 255, h = (wu >> 8) & 3, b = wu >> 10;
    const int l31 = lane & 31, hh = lane >> 5;
    const int tok = b * T + tile * 32 + l31;
    bf16x8 qf[4];
#pragma unroll
    for (int ks = 0; ks < 4; ++ks) qf[ks] = *(const bf16x8*)(p.z() + (size_t)tok * INW + 2816 + h * 64 + ks * 16 + hh * 8);
    const bf16_t* kb = p.kvb() + (size_t)(b * 256 + swap23(l31)) * 512 + h * 64 + hh * 8;
    float m = -1e30f;
    f32x16 o0, o1;
#pragma unroll
    for (int r = 0; r < 16; ++r) { o0[r] = 0.f; o1[r] = 0.f; }
    float sum = 0.f;
    const bf16_t* vt = p.kvT() + ((size_t)(b * 4 + h) * 64 + l31) * 256 + 8 * hh;
    bf16x8 kf[4], vf[4];
#pragma unroll
    for (int ks = 0; ks < 4; ++ks) kf[ks] = *(const bf16x8*)(kb + ks * 16);
#pragma unroll
    for (int st = 0; st < 2; ++st) { vf[2 * st] = *(const bf16x8*)(vt + st * 16); vf[2 * st + 1] = *(const bf16x8*)(vt + 32 * 256 + st * 16); }
    for (int kt = 0; kt < 8; ++kt) {
        const int ktn = min(kt + 1, 7);
        bf16x8 kn[4], vn[4];
#pragma unroll
        for (int ks = 0; ks < 4; ++ks) kn[ks] = *(const bf16x8*)(kb + (size_t)ktn * 32 * 512 + ks * 16);
#pragma unroll
        for (int st = 0; st < 2; ++st) { vn[2 * st] = *(const bf16x8*)(vt + ktn * 32 + st * 16); vn[2 * st + 1] = *(const bf16x8*)(vt + 32 * 256 + ktn * 32 + st * 16); }
        f32x16 s;
#pragma unroll
        for (int r = 0; r < 16; ++r) s[r] = 0.f;
#pragma unroll
        for (int ks = 0; ks < 4; ++ks) s = __builtin_amdgcn_mfma_f32_32x32x16_bf16(kf[ks], qf[ks], s, 0, 0, 0);
        float tm = s[0];
#pragma unroll
        for (int r = 1; r < 16; ++r) tm = fmaxf(tm, s[r]);
        tm = fmaxf(tm, __shfl_xor(tm, 32));
        const float mn = fmaxf(m, tm);
        if (__any(mn > m)) {
            const float sc = __builtin_amdgcn_exp2f((m - mn) * 0.18033688011112042f);
            sum *= sc;
#pragma unroll
            for (int r = 0; r < 16; ++r) { o0[r] *= sc; o1[r] *= sc; }
        }
        m = mn;
        const float mb = mn * 0.18033688011112042f;
#pragma unroll
        for (int r = 0; r < 16; ++r) { s[r] = __builtin_amdgcn_exp2f(fmaf(s[r], 0.18033688011112042f, -mb)); sum += s[r]; }
#pragma unroll
        for (int st = 0; st < 2; ++st) {
            const bf16x8 pb = pack8(s, st * 8);
            o0 = __builtin_amdgcn_mfma_f32_32x32x16_bf16(vf[2 * st], pb, o0, 0, 0, 0);
            o1 = __builtin_amdgcn_mfma_f32_32x32x16_bf16(vf[2 * st + 1], pb, o1, 0, 0, 0);
        }
#pragma unroll
        for (int ks = 0; ks < 4; ++ks) kf[ks] = kn[ks];
#pragma unroll
        for (int q = 0; q < 4; ++q) vf[q] = vn[q];
    }
    sum += __shfl_xor(sum, 32);
    const float inv = 1.0f / sum;
    bf16_t* mo = p.mix() + (size_t)tok * D + 768 + h * 64 + 4 * hh;
#pragma unroll
    for (int g = 0; g < 4; ++g) {
        uint2 pk;
        pk.x = pack2(o0[4 * g] * inv, o0[4 * g + 1] * inv); pk.y = pack2(o0[4 * g + 2] * inv, o0[4 * g + 3] * inv);
        *(uint2*)(mo + 8 * g) = pk;
        pk.x = pack2(o1[4 * g] * inv, o1[4 * g + 1] * inv); pk.y = pack2(o1[4 * g + 2] * inv, o1[4 * g + 3] * inv);
        *(uint2*)(mo + 32 + 8 * g) = pk;
    }
}

struct NaCtx {
    const bf16_t* kbase; const bf16_t* vbase; const float* bh;
    int rs, r, c, c0, cb, hh;
    bf16x8 qf[4];
    float m, sum;
    f32x16 o0, o1;
};
template <int TI>
__device__ __forceinline__ void na_load(const NaCtx& x, bf16x8 (&kf)[4], bf16x8 (&vf)[4]) {
    constexpr int ip = TI / 3, cg = TI % 3;
    const bf16_t* kp = x.kbase + (size_t)(ip * 128 + cg * 16) * INW;
#pragma unroll
    for (int ks = 0; ks < 4; ++ks) kf[ks] = *(const bf16x8*)(kp + ks * 16);
    const bf16_t* vr = x.vbase + ip * 128 + cg * 16;
#pragma unroll
    for (int st = 0; st < 2; ++st) { vf[2 * st] = *(const bf16x8*)(vr + st * 64); vf[2 * st + 1] = *(const bf16x8*)(vr + (size_t)32 * T + st * 64); }
}
template <int TI>
__device__ __forceinline__ void na_comp(NaCtx& x, const bf16x8 (&kf)[4], const bf16x8 (&vf)[4]) {
    constexpr int ip = TI / 3, cg = TI % 3;
    f32x16 s;
#pragma unroll
    for (int q = 0; q < 16; ++q) s[q] = 0.f;
#pragma unroll
    for (int ks = 0; ks < 4; ++ks) s = __builtin_amdgcn_mfma_f32_32x32x16_bf16(kf[ks], x.qf[ks], s, 0, 0, 0);
    const int kc0 = x.cb + 16 * cg + 8 * x.hh;
    const float* brow = x.bh + (x.rs + 2 * ip - x.r + 7) * 31 + 15 - x.c + kc0;
    const int d0 = kc0 - x.c0;
    float tm = -1e30f;
    float bv[16];
#pragma unroll
    for (int q = 0; q < 16; ++q) bv[q] = brow[(q & 3) + 4 * ((q >> 2) & 1) + 31 * (q >> 3)];
#pragma unroll
    for (int q = 0; q < 16; ++q) asm volatile("" : "+v"(bv[q]));
#pragma unroll
    for (int q = 0; q < 16; ++q) {
        const int cq = (q & 3) + 4 * ((q >> 2) & 1);
        const bool valid = (unsigned)(d0 + cq) < 16u;
        const float sc = valid ? fmaf(s[q], 0.18033688011112042f, bv[q]) : -INFINITY;
        s[q] = sc;
        tm = fmaxf(tm, sc);
    }
    tm = fmaxf(tm, __shfl_xor(tm, 32));
    const float mn = fmaxf(x.m, tm);
    if (__any(mn > x.m)) {
        const float scl = __builtin_amdgcn_exp2f(x.m - mn);
        x.sum *= scl;
#pragma unroll
        for (int q = 0; q < 16; ++q) { x.o0[q] *= scl; x.o1[q] *= scl; }
    }
    x.m = mn;
#pragma unroll
    for (int q = 0; q < 16; ++q) { const float pe = __builtin_amdgcn_exp2f(s[q] - mn); s[q] = pe; x.sum += pe; }
#pragma unroll
    for (int st = 0; st < 2; ++st) {
        const bf16x8 pb = pack8(s, st * 8);
        x.o0 = __builtin_amdgcn_mfma_f32_32x32x16_bf16(vf[2 * st], pb, x.o0, 0, 0, 0);
        x.o1 = __builtin_amdgcn_mfma_f32_32x32x16_bf16(vf[2 * st + 1], pb, x.o1, 0, 0, 0);
    }
}

__device__ __forceinline__ void na_attn_wave(const Params& p, int wu, int lane, const float* sbias) {
    const int j = wu & 1, h = (wu >> 1) & 7, r = (wu >> 4) & 127, b = wu >> 11;
    const int l31 = lane & 31, hh = lane >> 5;
    NaCtx x;
    x.hh = hh; x.r = r;
    x.c = 32 * j + l31;
    x.c0 = min(max(x.c - 8, 0), 48); x.rs = min(max(r - 4, 0), 120);
    const int tokq = b * T + r * 64 + x.c;
    x.cb = 16 * j;
#pragma unroll
    for (int ks = 0; ks < 4; ++ks) x.qf[ks] = *(const bf16x8*)(p.z() + (size_t)tokq * INW + h * 64 + ks * 16 + hh * 8);
    x.bh = sbias + 64 + h * 465;
    const int kap = swap23(l31);
    x.kbase = p.z() + (size_t)(b * T + (x.rs + (kap >> 4)) * 64 + x.cb + (kap & 15)) * INW + 512 + h * 64 + hh * 8;
    x.vbase = p.vT() + ((size_t)(b * 8 + h) * 64 + l31) * T + x.rs * 64 + x.cb + 8 * hh;
    x.m = -1e30f; x.sum = 0.f;
#pragma unroll
    for (int q = 0; q < 16; ++q) { x.o0[q] = 0.f; x.o1[q] = 0.f; }
    bf16x8 k0[4], v0[4], k1[4], v1[4], k2[4], v2[4], k3[4], v3[4];
    na_load<0>(x, k0, v0); na_load<1>(x, k1, v1); na_load<2>(x, k2, v2);
    na_load<3>(x, k3, v3);  na_comp<0>(x, k0, v0);
    na_load<4>(x, k0, v0);  na_comp<1>(x, k1, v1);
    na_load<5>(x, k1, v1);  na_comp<2>(x, k2, v2);
    na_load<6>(x, k2, v2);  na_comp<3>(x, k3, v3);
    na_load<7>(x, k3, v3);  na_comp<4>(x, k0, v0);
    na_load<8>(x, k0, v0);  na_comp<5>(x, k1, v1);
    na_load<9>(x, k1, v1);  na_comp<6>(x, k2, v2);
    na_load<10>(x, k2, v2); na_comp<7>(x, k3, v3);
    na_load<11>(x, k3, v3); na_comp<8>(x, k0, v0);
    na_comp<9>(x, k1, v1);
    na_comp<10>(x, k2, v2);
    na_comp<11>(x, k3, v3);
    float sum = x.sum;
    sum += __shfl_xor(sum, 32);
    const float inv = 1.0f / sum;
    bf16_t* mo = p.mix() + (size_t)tokq * D + h * 64 + 4 * hh;
#pragma unroll
    for (int g = 0; g < 4; ++g) {
        uint2 pk;
        pk.x = pack2(x.o0[4 * g] * inv, x.o0[4 * g + 1] * inv); pk.y = pack2(x.o0[4 * g + 2] * inv, x.o0[4 * g + 3] * inv);
        *(uint2*)(mo + 8 * g) = pk;
        pk.x = pack2(x.o1[4 * g] * inv, x.o1[4 * g + 1] * inv); pk.y = pack2(x.o1[4 * g + 2] * inv, x.o1[4 * g + 3] * inv);
        *(uint2*)(mo + 32 + 8 * g) = pk;
    }
}

__device__ void phase_mixers(const Params& p, char* smem) {
    const int tid = VTID, lane = tid & 63, w = tid >> 6;
    {
        float* sbias = (float*)smem;
        __syncthreads();
        for (int i = tid; i < 8 * 465; i += 256) sbias[64 + i] = p.rpb[i] * 1.4426950408889634f;
        __syncthreads();
        for (int wu = VBID * 4 + w; wu < 8192; wu += VGRID * 4) na_attn_wave(p, wu, lane, sbias);
    }
    __syncthreads();
    hg_local(p, smem);
}

__device__ void phase_hg_scan(const Params& p) {
    const int tid = VTID;
    if (blockIdx.x < 8) return;
    for (int item = VBID - 16; item < 512; item += VGRID - 16) {
        const int g = item * 256 + tid;
        const int seq = g >> 12, kv = g & 4095, k = kv & 63;
        const int dir = seq & 1;
        float S = 0.f;
        for (int cc0 = 0; cc0 < 128; cc0 += 8) {
            float L[8], d[8];
#pragma unroll
            for (int u = 0; u < 8; ++u) {
                const int c = dir ? 127 - (cc0 + u) : cc0 + u;
                const size_t it = (size_t)seq * 128 + c;
                L[u] = p.hstate()[it * 4096 + kv];
                d[u] = p.hdec()[it * 64 + k];
            }
#pragma unroll
            for (int u = 0; u < 8; ++u) {
                const int c = dir ? 127 - (cc0 + u) : cc0 + u;
                const size_t it = (size_t)seq * 128 + c;
                ((float*)p.h())[it * 4096 + kv] = S;
                S = d[u] * S + L[u];
            }
        }
    }
}

__device__ void phase_hg_out(const Params& p, char* smem) {
    char* sQt = smem;
    char* sKt = smem + 9216;
    char* sQh = smem + 18432;
    char* sVT = smem + 27648;
    char* sST = smem + 36864;
    char* sP = smem + 46080;
    float* sTot = (float*)(smem + 55296);
    float* sSS = sTot + 256;
    const int tid = VTID, lane = tid & 63, w = tid >> 6;
    const int kcol = tid & 63, sq = tid >> 6;
    const int l31 = lane & 31, hh = lane >> 5;
    for (int item = VBID; item < 2048; item += VGRID) {
        const int c = item & 127, h = (item >> 7) & 3, b = item >> 9;
        const int tok0 = b * T + c * 64;
        __syncthreads();
        hg_load_vt(p, sVT, tok0, h, kcol, sq);
        float qv[16];
        {
            const bf16_t* zp = p.z() + (size_t)(tok0 + sq * 16) * INW + 1536 + h * 64 + kcol;
#pragma unroll
            for (int j = 0; j < 16; ++j) qv[j] = bf2f(zp[(size_t)j * INW]);
        }
        f32x16 accO;
#pragma unroll
        for (int r = 0; r < 16; ++r) accO[r] = 0.f;
        for (int dir = 0; dir < 2; ++dir) {
            float bj[16], kk[16];
            const float btot = hg_gates(p, sTot, tok0, h, dir, kcol, sq, bj, kk);
            const float bref = 0.5f * btot;
#pragma unroll
            for (int j = 0; j < 16; ++j) {
                const int s = sq * 16 + j;
                *(bf16_t*)(sQt + s * HRS + kcol * 2) = f2bf(qv[j] * __expf(bj[j] - bref));
                *(bf16_t*)(sKt + s * HRS + kcol * 2) = f2bf(kk[j] * __expf(bref - bj[j]));
                *(bf16_t*)(sQh + s * HRS + kcol * 2) = f2bf(qv[j] * __expf(bj[j]));
            }
            {
                const float* sp = (const float*)p.h() + ((size_t)(((b * 4 + h) * 2 + dir) * 128 + c)) * 4096;
#pragma unroll
                for (int i = 0; i < 4; ++i) {
                    const int idx = tid * 4 + 1024 * i;
                    const float4 v = *(const float4*)(sp + idx);
                    uint2 pk; pk.x = pack2(v.x, v.y); pk.y = pack2(v.z, v.w);
                    *(uint2*)(sST + (idx >> 6) * HRS + (idx & 63) * 2) = pk;
                }
            }
            __syncthreads();
            {
                const int si = w >> 1, ti = w & 1;
                const bool live = dir == 0 ? (si <= ti) : (si >= ti);
                f32x16 pt;
#pragma unroll
                for (int r = 0; r < 16; ++r) pt[r] = 0.f;
                if (live) pt = tile_mm64(sKt, sQt, si * 32, ti * 32, lane, pt);
                const int t = ti * 32 + l31;
#pragma unroll
                for (int g = 0; g < 4; ++g) {
                    const int s0 = si * 32 + 8 * g + 4 * hh;
                    float v0 = pt[4 * g], v1 = pt[4 * g + 1], v2 = pt[4 * g + 2], v3 = pt[4 * g + 3];
                    if (dir == 0) {
                        if (s0 > t) v0 = 0.f; if (s0 + 1 > t) v1 = 0.f; if (s0 + 2 > t) v2 = 0.f; if (s0 + 3 > t) v3 = 0.f;
                    } else {
                        if (s0 < t) v0 = 0.f; if (s0 + 1 < t) v1 = 0.f; if (s0 + 2 < t) v2 = 0.f; if (s0 + 3 < t) v3 = 0.f;
                    }
                    uint2 pk; pk.x = pack2(v0, v1); pk.y = pack2(v2, v3);
                    *(uint2*)(sP + t * HRS + s0 * 2) = pk;
                }
            }
            __syncthreads();
            {
                const int vi = w >> 1, ti = w & 1;
                accO = tile_mm64(sVT, sP, vi * 32, ti * 32, lane, accO);
                accO = tile_mm64(sST, sQh, vi * 32, ti * 32, lane, accO);
            }
            __syncthreads();
        }
        const int vi = w >> 1, ti = w & 1;
        float ssq = 0.f;
#pragma unroll
        for (int r = 0; r < 16; ++r) ssq += accO[r] * accO[r];
        ssq += __shfl_xor(ssq, 32);
        sSS[w * 64 + lane] = ssq;
        __syncthreads();
        const float tot = sSS[ti * 64 + l31] + sSS[(2 + ti) * 64 + l31];
        const float rs = rsqrtf(tot * (1.0f / 64.0f) + EPS);
        const int tok = tok0 + ti * 32 + l31;
#pragma unroll
        for (int g = 0; g < 4; ++g) {
            const int v0 = vi * 32 + 8 * g + 4 * hh;
            const uint2 gz = *(const uint2*)(p.z() + (size_t)tok * INW + 2560 + h * 64 + v0);
            const float4 gn = *(const float4*)(p.hg_g + h * 64 + v0);
            const float g0 = bflo(gz.x), g1 = bfhi(gz.x), g2 = bflo(gz.y), g3 = bfhi(gz.y);
            const float o0 = accO[4 * g] * rs * gn.x * (g0 / (1.0f + __expf(-g0)));
            const float o1 = accO[4 * g + 1] * rs * gn.y * (g1 / (1.0f + __expf(-g1)));
            const float o2 = accO[4 * g + 2] * rs * gn.z * (g2 / (1.0f + __expf(-g2)));
            const float o3 = accO[4 * g + 3] * rs * gn.w * (g3 / (1.0f + __expf(-g3)));
            uint2 pk; pk.x = pack2(o0, o1); pk.y = pack2(o2, o3);
            *(uint2*)(p.mix() + (size_t)tok * D + 512 + h * 64 + v0) = pk;
        }
    }
    for (int wu = VBID * 4 + w; wu < 4096; wu += VGRID * 4) mem_attn_wave(p, wu, lane);
}


__device__ __forceinline__ int ord_key(int fb) { return fb ^ ((fb >> 31) & 0x7FFFFFFF); }

template <int N>
__device__ __forceinline__ void bitonic_sort_desc(int (&v)[N]) {
#pragma unroll
    for (int k = 2; k <= N; k <<= 1) {
#pragma unroll
        for (int j = k >> 1; j > 0; j >>= 1) {
#pragma unroll
            for (int i = 0; i < N; ++i) {
                const int l = i ^ j;
                if (l > i) {
                    const bool desc = ((i & k) == 0);
                    const int a = v[i], b = v[l];
                    const int mx = max(a, b), mn = min(a, b);
                    v[i] = desc ? mx : mn;
                    v[l] = desc ? mn : mx;
                }
            }
        }
    }
}
template <int N>
__device__ __forceinline__ void bitonic_merge_desc(int (&v)[N]) {
#pragma unroll
    for (int j = N >> 1; j > 0; j >>= 1) {
#pragma unroll
        for (int i = 0; i < N; ++i) {
            const int l = i ^ j;
            if (l > i) {
                const int a = v[i], b = v[l];
                v[i] = max(a, b);
                v[l] = min(a, b);
            }
        }
    }
}
__device__ __forceinline__ void merge_prune16(int (&r)[16], const int (&o)[16]) {
#pragma unroll
    for (int i = 0; i < 16; ++i) r[i] = max(r[i], o[15 - i]);
    bitonic_merge_desc<16>(r);
}

__device__ void phase_route(const Params& p, char* smem) {
    char* sk = smem;
    const int tid = VTID, lane = tid & 63, w = tid >> 6;
    int* sA = (int*)(smem + 32768) + w * 2048;
    int* sB = (int*)(smem + 65536) + w * 512;
    const int tl = lane & 31, hh = lane >> 5;
    const int h = VBID & 7, tg0 = VBID >> 3, tgs = VGRID >> 3;
    for (int base = tg0; base < 256; base += 4 * tgs)
    for (int c = 0; c < 2; ++c) {
        const int hc = h * 2 + c;
        __syncthreads();
        {
            const bf16_t* sp = p.subk_b() + (size_t)hc * 16384;
#pragma unroll
            for (int i = 0; i < 8; ++i) {
                const int ch = tid + 256 * i;
                const int row = ch >> 4, cc = ch & 15;
                const uint4 v = *(const uint4*)(sp + row * 128 + cc * 8);
                *(uint4*)(sk + row * 256 + ((cc ^ (row & 15)) << 4)) = v;
            }
        }
        __syncthreads();
        for (int it = 0; it < 4; ++it) {
            const int tgp = base + it * tgs;
            if (tgp >= 256) break;
            const int tok = tgp * 128 + w * 32 + tl;
            int* sidx = sA + it * 512;
            bf16x8 qf[8];
            {
                const bf16_t* qr = p.z() + (size_t)tok * QW + hc * 128 + hh * 8;
#pragma unroll
                for (int ks = 0; ks < 8; ++ks) qf[ks] = *(const bf16x8*)(qr + ks * 16);
            }
            int cur[16];
#pragma unroll
            for (int kb = 0; kb < 4; ++kb) {
                f32x16 acc;
#pragma unroll
                for (int r = 0; r < 16; ++r) acc[r] = 0.f;
                const int row = kb * 32 + tl;
#pragma unroll
                for (int ks = 0; ks < 8; ++ks) {
                    const bf16x8 af = *(const bf16x8*)(sk + row * 256 + (((ks * 2 + hh) ^ (row & 15)) << 4));
                    acc = __builtin_amdgcn_mfma_f32_32x32x16_bf16(af, qf[ks], acc, 0, 0, 0);
                }
                int v[16];
#pragma unroll
                for (int r = 0; r < 16; ++r) {
                    const int key = kb * 32 + (r & 3) + 8 * (r >> 2) + 4 * hh;
                    const int fb = (__float_as_int(acc[r]) & ~127) | (127 - key);
                    v[r] = ord_key(fb);
                }
                bitonic_sort_desc<16>(v);
                if (kb == 0) {
#pragma unroll
                    for (int r = 0; r < 16; ++r) cur[r] = v[r];
                } else {
                    merge_prune16(cur, v);
                }
            }
            {
                int o[16];
#pragma unroll
                for (int r = 0; r < 16; ++r) o[r] = __shfl_xor(cur[r], 32);
                merge_prune16(cur, o);
            }
            if (c == 0) {
#pragma unroll
                for (int r = 0; r < 16; ++r) sidx[r * 32 + tl] = cur[r];
                continue;
            }
#pragma unroll
            for (int r = 0; r < 16; ++r) sB[r * 32 + tl] = cur[r];
        float va[16], vb[16];
#pragma unroll
        for (int r = 0; r < 16; ++r) {
            const int fa = ord_key(sidx[r * 32 + tl]), fb = ord_key(sB[r * 32 + tl]);
            va[r] = __int_as_float(fa & ~127);
            vb[r] = __int_as_float(fb & ~127);
        }
        int best[16];
#pragma unroll
        for (int j = 0; j < 16; ++j) best[j] = ord_key((__float_as_int(va[0] + vb[j]) & ~255) | (255 - j));
#pragma unroll
        for (int i = 1; i < 16; ++i) {
            const int n = 16 / (i + 1);
            int row[16];
#pragma unroll
            for (int j = 0; j < 16; ++j)
                row[j] = (j < n) ? ord_key((__float_as_int(va[i] + vb[j]) & ~255) | (255 - (i * 16 + j))) : (int)0x80000000;
            merge_prune16(best, row);
        }
        float sv[16];
        int pid[16];
#pragma unroll
        for (int r = 0; r < 16; ++r) {
            const int cb = ord_key(best[r]);
            sv[r] = __int_as_float(cb & ~255);
            pid[r] = 255 - (cb & 255);
        }
        float tot = 0.f;
        const float smax = sv[0];
#pragma unroll
        for (int r = 0; r < 16; ++r) { sv[r] = __expf(sv[r] - smax); tot += sv[r]; }
        const float inv = 1.0f / tot;
        if (hh == 0) {
#pragma unroll
            for (int r = 0; r < 16; ++r) {
                const int ia = 127 - (ord_key(sidx[(pid[r] >> 4) * 32 + tl]) & 127);
                const int ib = 127 - (ord_key(sB[(pid[r] & 15) * 32 + tl]) & 127);
                const int pos = (r & 7) * 16 + h * 2 + (r >> 3);
                p.eidx()[(size_t)tok * 128 + pos] = (unsigned short)(ia * 128 + ib);
                p.gate()[(size_t)tok * 128 + pos] = sv[r] * inv;
            }
        }
        }
    }
}

constexpr int PEER_TG = 512;
constexpr int PEER_TPW = PEER_TG / 8;
constexpr int PEER_NTG = NTOK / PEER_TG;
constexpr int PEER_NCH = 8;

__device__ __forceinline__ bool peer_pop(unsigned* q, int my, int& cur, int& chunk, int& tg, int* sh) {
    __syncthreads();
    if (threadIdx.x == 0) {
        int qi = -1, idx = 0;
        while (cur < 8) {
            qi = (my + cur) & 7;
            idx = (int)atomicAdd(&q[qi * 64], 1u);
            if (idx < PEER_NTG) break;
            ++cur; qi = -1;
        }
        sh[0] = qi; sh[1] = idx;
    }
    __syncthreads();
    const int qi = sh[0], idx = sh[1];
    if (qi < 0) return false;
    chunk = qi;
    tg = idx;
    return true;
}

#define PEER_G1(base, wv, hi) (*(const uint4*)((base) + (size_t)((hi) ? ((wv) >> 16) : ((wv) & 0xFFFFu)) * 128))
#define PEER_GATHER16(dst, base, ia, ib)                                                             \
    dst[0] = PEER_G1(base, (ia).x, 0);  dst[1] = PEER_G1(base, (ia).x, 1);  dst[2] = PEER_G1(base, (ia).y, 0);  dst[3] = PEER_G1(base, (ia).y, 1);   \
    dst[4] = PEER_G1(base, (ia).z, 0);  dst[5] = PEER_G1(base, (ia).z, 1);  dst[6] = PEER_G1(base, (ia).w, 0);  dst[7] = PEER_G1(base, (ia).w, 1);   \
    dst[8] = PEER_G1(base, (ib).x, 0);  dst[9] = PEER_G1(base, (ib).x, 1);  dst[10] = PEER_G1(base, (ib).y, 0); dst[11] = PEER_G1(base, (ib).y, 1);  \
    dst[12] = PEER_G1(base, (ib).z, 0); dst[13] = PEER_G1(base, (ib).z, 1); dst[14] = PEER_G1(base, (ib).w, 0); dst[15] = PEER_G1(base, (ib).w, 1);

__device__ __forceinline__ unsigned quant4(float a, float b, float c, float d, float qs) {
    const int q0 = (int)rintf(__builtin_amdgcn_fmed3f(a * qs, -127.f, 127.f)), q1 = (int)rintf(__builtin_amdgcn_fmed3f(b * qs, -127.f, 127.f));
    const int q2 = (int)rintf(__builtin_amdgcn_fmed3f(c * qs, -127.f, 127.f)), q3 = (int)rintf(__builtin_amdgcn_fmed3f(d * qs, -127.f, 127.f));
    return (unsigned)(q0 & 255) | ((unsigned)(q1 & 255) << 8) | ((unsigned)(q2 & 255) << 16) | ((unsigned)(q3 & 255) << 24);
}
template <int CTRL>
__device__ __forceinline__ int dpp_movi(int v) { return __builtin_amdgcn_update_dpp(0, v, CTRL, 0xf, 0xf, true); }

struct DotTok { uint4 ia, ib; uint4 ha, hb; float hm; };
__device__ __forceinline__ void dots_load(const Params& p, DotTok& t, int tok, int c, int g, int d8) {
    const uint4* idp = (const uint4*)(p.eidx() + (size_t)tok * 128 + g * 16);
    t.ia = idp[0]; t.ib = idp[1];
    const uint4* hp = (const uint4*)(p.h() + (size_t)tok * D + c * 128 + d8 * 16);
    t.ha = hp[0]; t.hb = hp[1];
    t.hm = __uint_as_float(p.hmax()[tok]);
}
__device__ __forceinline__ void dots_finish(const Params& p, const uint4 (&uu)[16], const DotTok& t, int tok, int c, int g, int d8) {
    const float qs = t.hm > 0.f ? 127.0f / t.hm : 0.f;
    const int h0 = (int)quant4(bflo(t.ha.x), bfhi(t.ha.x), bflo(t.ha.y), bfhi(t.ha.y), qs);
    const int h1 = (int)quant4(bflo(t.ha.z), bfhi(t.ha.z), bflo(t.ha.w), bfhi(t.ha.w), qs);
    const int h2 = (int)quant4(bflo(t.hb.x), bfhi(t.hb.x), bflo(t.hb.y), bfhi(t.hb.y), qs);
    const int h3 = (int)quant4(bflo(t.hb.z), bfhi(t.hb.z), bflo(t.hb.w), bfhi(t.hb.w), qs);
    int acc[16];
#pragma unroll
    for (int i = 0; i < 16; ++i) {
        int a = __builtin_amdgcn_sdot4((int)uu[i].x, h0, 0, false);
        a = __builtin_amdgcn_sdot4((int)uu[i].y, h1, a, false);
        a = __builtin_amdgcn_sdot4((int)uu[i].z, h2, a, false);
        a = __builtin_amdgcn_sdot4((int)uu[i].w, h3, a, false);
        a += dpp_movi<DPP_QP_X1>(a);
        a += dpp_movi<DPP_QP_X2>(a);
        a += dpp_movi<DPP_HMIRROR>(a);
        acc[i] = a;
    }
    if (d8 == 0) {
        int4* dst = (int4*)((int*)p.partial() + ((size_t)c * NTOK + tok) * 128 + g * 16);
        dst[0] = make_int4(acc[0], acc[1], acc[2], acc[3]);
        dst[1] = make_int4(acc[4], acc[5], acc[6], acc[7]);
        dst[2] = make_int4(acc[8], acc[9], acc[10], acc[11]);
        dst[3] = make_int4(acc[12], acc[13], acc[14], acc[15]);
    }
}

__device__ __forceinline__ void dotsf_load(const Params& p, DotTok& t, int tokb, int s, int g, int d8) {
    dots_load(p, t, tokb + 8 * (s & 15), s >> 4, g, d8);
}
__device__ __forceinline__ void dotsf_finish(const uint4 (&uu)[16], const DotTok& t, int* part, int g, int d8) {
    const float qs = t.hm > 0.f ? 127.0f / t.hm : 0.f;
    const int h0 = (int)quant4(bflo(t.ha.x), bfhi(t.ha.x), bflo(t.ha.y), bfhi(t.ha.y), qs);
    const int h1 = (int)quant4(bflo(t.ha.z), bfhi(t.ha.z), bflo(t.ha.w), bfhi(t.ha.w), qs);
    const int h2 = (int)quant4(bflo(t.hb.x), bfhi(t.hb.x), bflo(t.hb.y), bfhi(t.hb.y), qs);
    const int h3 = (int)quant4(bflo(t.hb.z), bfhi(t.hb.z), bflo(t.hb.w), bfhi(t.hb.w), qs);
    int acc[16];
#pragma unroll
    for (int i = 0; i < 16; ++i) {
        int a = __builtin_amdgcn_sdot4((int)uu[i].x, h0, 0, false);
        a = __builtin_amdgcn_sdot4((int)uu[i].y, h1, a, false);
        a = __builtin_amdgcn_sdot4((int)uu[i].z, h2, a, false);
        a = __builtin_amdgcn_sdot4((int)uu[i].w, h3, a, false);
        a += dpp_movi<DPP_QP_X1>(a);
        a += dpp_movi<DPP_QP_X2>(a);
        a += dpp_movi<DPP_HMIRROR>(a);
        acc[i] = a;
    }
    if (d8 == 0) {
        int4* dst = (int4*)(part + g * 16);
#pragma unroll
        for (int q = 0; q < 4; ++q) {
            int4 v = dst[q];
            v.x += acc[4 * q]; v.y += acc[4 * q + 1]; v.z += acc[4 * q + 2]; v.w += acc[4 * q + 3];
            dst[q] = v;
        }
    }
}

__device__ __forceinline__ float gelu_erf(float v);

__device__ void phase_peer_dots(const Params& p, char* smem) {
    const int tid = threadIdx.x, lane = tid & 63, w = tid >> 6;
    const int g = lane >> 3, d8 = lane & 7;
    int* part = (int*)smem + w * 2048;
    for (int tgp = blockIdx.x; tgp < NTOK / 128; tgp += gridDim.x) {
        const int tokb = tgp * 128 + w;
        __syncthreads();
        for (int i = lane; i < 2048; i += 64) part[i] = 0;
        __syncthreads();
        const char* ubase = (const char*)p.u_c() + d8 * 16;
        DotTok ta, tb, tn;
        uint4 ua[16], ubuf[16];
        dotsf_load(p, ta, tokb, 0, g, d8);
        dotsf_load(p, tb, tokb, 1, g, d8);
        PEER_GATHER16(ua, ubase, ta.ia, ta.ib)
        PEER_GATHER16(ubuf, ubase, tb.ia, tb.ib)
        dotsf_load(p, tn, tokb, 2, g, d8);
        for (int s = 0; s < 128; s += 2) {
            dotsf_finish(ua, ta, part + (s & 15) * 128, g, d8);
            if (s + 2 < 128) {
                ta = tn;
                const char* ub = ubase + (size_t)((s + 2) >> 4) * 16384 * 128;
                PEER_GATHER16(ua, ub, ta.ia, ta.ib)
                dotsf_load(p, tn, tokb, min(s + 3, 127), g, d8);
            }
            dotsf_finish(ubuf, tb, part + ((s + 1) & 15) * 128, g, d8);
            if (s + 3 < 128) {
                tb = tn;
                const char* ub = ubase + (size_t)((s + 3) >> 4) * 16384 * 128;
                PEER_GATHER16(ubuf, ub, tb.ia, tb.ib)
                dotsf_load(p, tn, tokb, min(s + 4, 127), g, d8);
            }
        }
        __syncthreads();
        for (int k0 = 0; k0 < 16; k0 += 4) {
            int ps[4][2], e[4][2];
            float gt[4][2], sh[4];
#pragma unroll
            for (int q = 0; q < 4; ++q) {
                const int tok = tokb + 8 * (k0 + q);
                sh[q] = __uint_as_float(p.hmax()[tok]) * (1.0f / 127.0f) * rsqrtf(p.ss1()[tok] * (1.0f / 1024.0f) + EPS);
#pragma unroll
                for (int u = 0; u < 2; ++u) {
                    const int slot = lane + 64 * u;
                    ps[q][u] = part[(k0 + q) * 128 + slot];
                    e[q][u] = p.eidx()[(size_t)tok * 128 + slot];
                    gt[q][u] = p.gate()[(size_t)tok * 128 + slot];
                }
            }
            float su[4][2], sv[4][2];
#pragma unroll
            for (int q = 0; q < 4; ++q)
#pragma unroll
                for (int u = 0; u < 2; ++u) { su[q][u] = p.scale_u()[e[q][u]]; sv[q][u] = p.scale_v()[e[q][u]]; }
#pragma unroll
            for (int q = 0; q < 4; ++q) {
                const int tok = tokb + 8 * (k0 + q);
                float cf[2];
#pragma unroll
                for (int u = 0; u < 2; ++u) cf[u] = gelu_erf((float)ps[q][u] * su[q][u] * sh[q]) * gt[q][u] * sv[q][u];
                const float cm = wave_max(fmaxf(fabsf(cf[0]), fabsf(cf[1])));
                const float qs = cm > 0.f ? 127.0f / cm : 0.f;
                p.coef()[(size_t)tok * 128 + lane] = (signed char)(int)rintf(cf[0] * qs);
                p.coef()[(size_t)tok * 128 + lane + 64] = (signed char)(int)rintf(cf[1] * qs);
                if (lane == 0) p.csum()[tok] = cm * (1.0f / 127.0f);
            }
        }
    }
}

__device__ __forceinline__ float gelu_erf(float v) {
    const float av = fabsf(v);
    const float t = __builtin_amdgcn_rcpf(fmaf(av, 0.2316418882f, 1.0f));
    float q = fmaf(t, 0.5307027145f, -0.7265760135f);
    q = fmaf(q, t, 0.7107068705f);
    q = fmaf(q, t, -0.142248368f);
    q = fmaf(q, t, 0.127414796f);
    q = q * t;
    const float e = __builtin_amdgcn_exp2f(v * v * -0.72134752044f);
    const float m = v * (q * e);
    return v < 0.f ? m : v - m;
}
__device__ void phase_peer_coef(const Params& p) {
    const int tid = threadIdx.x, lane = tid & 63, w = tid >> 6;
    const int* partial = (const int*)p.partial();
    for (int tok = blockIdx.x * 8 + w; tok < NTOK; tok += gridDim.x * 8) {
        const float sh = __uint_as_float(p.hmax()[tok]) * (1.0f / 127.0f) * rsqrtf(p.ss1()[tok] * (1.0f / 1024.0f) + EPS);
        float cf[2];
#pragma unroll
        for (int u = 0; u < 2; ++u) {
            const size_t i = (size_t)tok * 128 + lane + 64 * u;
            int ps = 0;
#pragma unroll
            for (int c = 0; c < PEER_NCH; ++c) ps += partial[(size_t)c * NTOK * 128 + i];
            const int e = p.eidx()[i];
            const float d = (float)ps * p.scale_u()[e] * sh;
            cf[u] = gelu_erf(d) * p.gate()[i] * p.scale_v()[e];
        }
        const float cm = wave_max(fmaxf(fabsf(cf[0]), fabsf(cf[1])));
        const float qs = cm > 0.f ? 127.0f / cm : 0.f;
        p.coef()[(size_t)tok * 128 + lane] = (signed char)(int)rintf(cf[0] * qs);
        p.coef()[(size_t)tok * 128 + lane + 64] = (signed char)(int)rintf(cf[1] * qs);
        if (lane == 0) p.csum()[tok] = cm * (1.0f / 127.0f);
    }
}

struct AccTok { uint4 ia, ib; uint4 cq; float cs; };
__device__ __forceinline__ void acc_load(const Params& p, AccTok& t, int tok, int g) {
    const uint4* idp = (const uint4*)(p.eidx() + (size_t)tok * 128 + g * 16);
    t.ia = idp[0]; t.ib = idp[1];
    t.cq = *(const uint4*)(p.coef() + (size_t)tok * 128 + g * 16);
    t.cs = p.csum()[tok];
}
#define PEER_T4DOT(acc, B, r0, r1, r2, r3, cq)                                   \
    {                                                                            \
        const unsigned t0 = __builtin_amdgcn_perm(r1, r0, 0x05010400u), t1 = __builtin_amdgcn_perm(r1, r0, 0x07030602u); \
        const unsigned t2 = __builtin_amdgcn_perm(r3, r2, 0x05010400u), t3 = __builtin_amdgcn_perm(r3, r2, 0x07030602u); \
        acc[(B) + 0] = __builtin_amdgcn_sdot4((int)__builtin_amdgcn_perm(t2, t0, 0x05040100u), (int)(cq), acc[(B) + 0], false); \
        acc[(B) + 1] = __builtin_amdgcn_sdot4((int)__builtin_amdgcn_perm(t2, t0, 0x07060302u), (int)(cq), acc[(B) + 1], false); \
        acc[(B) + 2] = __builtin_amdgcn_sdot4((int)__builtin_amdgcn_perm(t3, t1, 0x05040100u), (int)(cq), acc[(B) + 2], false); \
        acc[(B) + 3] = __builtin_amdgcn_sdot4((int)__builtin_amdgcn_perm(t3, t1, 0x07060302u), (int)(cq), acc[(B) + 3], false); \
    }
__device__ __forceinline__ void acc_finish(const Params& p, const uint4 (&vv)[16], const AccTok& t, int tok, int c, int g, int d8) {
    const unsigned cw[4] = {t.cq.x, t.cq.y, t.cq.z, t.cq.w};
    int acc[16];
#pragma unroll
    for (int j = 0; j < 16; ++j) acc[j] = 0;
#pragma unroll
    for (int j = 0; j < 4; ++j) {
        PEER_T4DOT(acc, 0, vv[4 * j].x, vv[4 * j + 1].x, vv[4 * j + 2].x, vv[4 * j + 3].x, cw[j])
        PEER_T4DOT(acc, 4, vv[4 * j].y, vv[4 * j + 1].y, vv[4 * j + 2].y, vv[4 * j + 3].y, cw[j])
        PEER_T4DOT(acc, 8, vv[4 * j].z, vv[4 * j + 1].z, vv[4 * j + 2].z, vv[4 * j + 3].z, cw[j])
        PEER_T4DOT(acc, 12, vv[4 * j].w, vv[4 * j + 1].w, vv[4 * j + 2].w, vv[4 * j + 3].w, cw[j])
    }
    float o[16];
#pragma unroll
    for (int j = 0; j < 16; ++j) {
        int v = acc[j];
        v += dpp_movi<DPP_ROR8>(v);
        v += __shfl_xor(v, 16);
        v += __shfl_xor(v, 32);
        o[j] = (float)v * t.cs;
    }
    if (g == 0) {
        uint4 w0, w1;
        w0.x = pack2(o[0], o[1]); w0.y = pack2(o[2], o[3]); w0.z = pack2(o[4], o[5]); w0.w = pack2(o[6], o[7]);
        w1.x = pack2(o[8], o[9]); w1.y = pack2(o[10], o[11]); w1.z = pack2(o[12], o[13]); w1.w = pack2(o[14], o[15]);
        uint4* dst = (uint4*)(p.peer_out() + (size_t)tok * D + c * 128 + d8 * 16);
        dst[0] = w0; dst[1] = w1;
    }
}

__device__ __forceinline__ void accf_finish(const uint4 (&vv)[16], const AccTok& t, char* rowp, int g) {
    const unsigned cw[4] = {t.cq.x, t.cq.y, t.cq.z, t.cq.w};
    int acc[16];
#pragma unroll
    for (int j = 0; j < 16; ++j) acc[j] = 0;
#pragma unroll
    for (int j = 0; j < 4; ++j) {
        PEER_T4DOT(acc, 0, vv[4 * j].x, vv[4 * j + 1].x, vv[4 * j + 2].x, vv[4 * j + 3].x, cw[j])
        PEER_T4DOT(acc, 4, vv[4 * j].y, vv[4 * j + 1].y, vv[4 * j + 2].y, vv[4 * j + 3].y, cw[j])
        PEER_T4DOT(acc, 8, vv[4 * j].z, vv[4 * j + 1].z, vv[4 * j + 2].z, vv[4 * j + 3].z, cw[j])
        PEER_T4DOT(acc, 12, vv[4 * j].w, vv[4 * j + 1].w, vv[4 * j + 2].w, vv[4 * j + 3].w, cw[j])
    }
    float o[16];
#pragma unroll
    for (int j = 0; j < 16; ++j) {
        int v = acc[j];
        v += dpp_movi<DPP_ROR8>(v);
        v += __shfl_xor(v, 16);
        v += __shfl_xor(v, 32);
        o[j] = (float)v * t.cs;
    }
    if (g == 0) {
        uint4 w0, w1;
        w0.x = pack2(o[0], o[1]); w0.y = pack2(o[2], o[3]); w0.z = pack2(o[4], o[5]); w0.w = pack2(o[6], o[7]);
        w1.x = pack2(o[8], o[9]); w1.y = pack2(o[10], o[11]); w1.z = pack2(o[12], o[13]); w1.w = pack2(o[14], o[15]);
        uint4* dst = (uint4*)rowp;
        dst[0] = w0; dst[1] = w1;
    }
}

__device__ void phase_peer_accum(const Params& p, char* smem) {
    const int tid = threadIdx.x, lane = tid & 63, w = tid >> 6;
    const int g = lane >> 3, d8 = lane & 7;
    char* rowbuf = smem + w * 16384;
    for (int tgp = blockIdx.x; tgp < NTOK / 64; tgp += gridDim.x) {
        const int tokb = tgp * 64 + w;
        __syncthreads();
        const char* vbase = (const char*)p.v_c() + d8 * 16;
        AccTok ta, tb, tn;
        uint4 va[16], vbuf[16];
        acc_load(p, ta, tokb, g);
        acc_load(p, tb, tokb + 8, g);
        PEER_GATHER16(va, vbase, ta.ia, ta.ib)
        PEER_GATHER16(vbuf, vbase, tb.ia, tb.ib)
        acc_load(p, tn, tokb + 16, g);
        for (int s = 0; s < 64; s += 2) {
            accf_finish(va, ta, rowbuf + (s & 7) * 2048 + (s >> 3) * 256 + d8 * 32, g);
            if (s + 2 < 64) {
                ta = tn;
                const char* vb = vbase + (size_t)((s + 2) >> 3) * 16384 * 128;
                PEER_GATHER16(va, vb, ta.ia, ta.ib)
                acc_load(p, tn, tokb + 8 * (min(s + 3, 63) & 7), g);
            }
            accf_finish(vbuf, tb, rowbuf + ((s + 1) & 7) * 2048 + ((s + 1) >> 3) * 256 + d8 * 32, g);
            if (s + 3 < 64) {
                tb = tn;
                const char* vb = vbase + (size_t)((s + 3) >> 3) * 16384 * 128;
                PEER_GATHER16(vbuf, vb, tb.ia, tb.ib)
                acc_load(p, tn, tokb + 8 * (min(s + 4, 63) & 7), g);
            }
        }
        __syncthreads();
        for (int k0 = 0; k0 < 8; k0 += 2) {
            float4 v[2][4];
#pragma unroll
            for (int q = 0; q < 2; ++q) {
                const float* orow = p.out + (size_t)(tokb + 8 * (k0 + q)) * D;
#pragma unroll
                for (int j = 0; j < 4; ++j) v[q][j] = *(const float4*)(orow + (j * 64 + lane) * 4);
            }
#pragma unroll
            for (int q = 0; q < 2; ++q) {
                float* orow = p.out + (size_t)(tokb + 8 * (k0 + q)) * D;
                const char* prow = rowbuf + (k0 + q) * 2048;
                float ss = 0.f;
#pragma unroll
                for (int j = 0; j < 4; ++j) {
                    const uint2 pk = *(const uint2*)(prow + (j * 64 + lane) * 8);
                    v[q][j].x += bflo(pk.x); v[q][j].y += bfhi(pk.x); v[q][j].z += bflo(pk.y); v[q][j].w += bfhi(pk.y);
                    ss += v[q][j].x * v[q][j].x + v[q][j].y * v[q][j].y + v[q][j].z * v[q][j].z + v[q][j].w * v[q][j].w;
                }
                ss = wave_sum(ss);
                const float rs = rsqrtf(ss * (1.0f / 1024.0f) + EPS);
#pragma unroll
                for (int j = 0; j < 4; ++j) {
                    const float4 gg = *(const float4*)(p.fin_g + (j * 64 + lane) * 4);
                    float4 o;
                    o.x = v[q][j].x * rs * gg.x; o.y = v[q][j].y * rs * gg.y; o.z = v[q][j].z * rs * gg.z; o.w = v[q][j].w * rs * gg.w;
                    *(float4*)(orow + (j * 64 + lane) * 4) = o;
                }
            }
        }
    }
}

#define XB_TMO      128
#define XB_XCNT(j)  (256  + 64 * (j))
#define XB_XSUB(j)  (1280 + 64 * (j))
#define XB_XGEN(j)  (2304 + 64 * (j))
#define XB_TOP      3328
#define XB_TOPGEN   3392
#define XCD_BAR_WORDS 3456
#define XB_SPIN_CAP (1u << 18)
__device__ __forceinline__ unsigned xb_ld(unsigned* p)              { return __hip_atomic_load(p, __ATOMIC_RELAXED, __HIP_MEMORY_SCOPE_AGENT); }
__device__ __forceinline__ unsigned xb_add(unsigned* p, unsigned v) { return __hip_atomic_fetch_add(p, v, __ATOMIC_RELAXED, __HIP_MEMORY_SCOPE_AGENT); }
#define XB_SPIN(cond, bar) do { unsigned _sp = 0; while (cond) { __builtin_amdgcn_s_sleep(1); \
    if ((++_sp & 255u) == 0u) { if (xb_ld(&(bar)[XB_TMO])) break; if (_sp > XB_SPIN_CAP) { atomicAdd(&(bar)[XB_TMO], 1u); break; } } } } while (0)

struct XcdBarrier { unsigned* bar; unsigned x; volatile unsigned* st; };

__device__ __forceinline__ XcdBarrier xcd_barrier_post(unsigned* bar, volatile unsigned* st) {
    XcdBarrier b; b.bar = bar; b.x = xcc_id(); b.st = st;
    if (threadIdx.x == 0) (void)xb_add(&bar[XB_XCNT(b.x)], 1u);
    return b;
}
__device__ __forceinline__ void xcd_barrier_complete(unsigned* bar, unsigned x, unsigned& nloc, unsigned& nx) {
    const unsigned G = gridDim.x * gridDim.y * gridDim.z;
    unsigned sum, cnt, mine, sp = 0u;
    for (;;) {
        sum = 0u; cnt = 0u; mine = 0u;
#pragma unroll
        for (unsigned j = 0; j < 16; ++j) { const unsigned c = xb_ld(&bar[XB_XCNT(j)]); sum += c; cnt += (c > 0u) ? 1u : 0u; mine = (j == x) ? c : mine; }
        if (sum == G) break;
        __builtin_amdgcn_s_sleep(1);
        if ((++sp & 255u) == 0u) { if (xb_ld(&bar[XB_TMO])) break; if (sp > XB_SPIN_CAP) { atomicAdd(&bar[XB_TMO], 1u); break; } }
    }
    nloc = mine > 0u ? mine : 1u; nx = cnt > 0u ? cnt : 1u;
}
__device__ __forceinline__ void xcd_barrier(const XcdBarrier& b) {
    asm volatile("s_waitcnt vmcnt(0)" ::: "memory");
    __syncthreads();
    if (threadIdx.x == 0) {
        unsigned* bar = b.bar;
        __builtin_amdgcn_s_waitcnt(0);
        unsigned nloc = b.st[0], nx = b.st[1];
        if (nloc == 0u) { xcd_barrier_complete(bar, b.x, nloc, nx); b.st[0] = nloc; b.st[1] = nx; }
        const unsigned old = xb_add(&bar[XB_XSUB(b.x)], 1u);
        const unsigned gen = old / nloc;
        if (old + 1u == (gen + 1u) * nloc) {
            __builtin_amdgcn_fence(__ATOMIC_RELEASE, "agent");
            asm volatile("s_waitcnt vmcnt(0)" ::: "memory");
            const unsigned og = xb_add(&bar[XB_TOP], 1u);
            const unsigned tg = og / nx;
            if (og + 1u == (tg + 1u) * nx) xb_add(&bar[XB_TOPGEN], 1u);
            else XB_SPIN(xb_ld(&bar[XB_TOPGEN]) == tg, bar);
            __builtin_amdgcn_fence(__ATOMIC_ACQUIRE, "agent");
            xb_add(&bar[XB_XGEN(b.x)], 1u);
            asm volatile("s_waitcnt vmcnt(0)" ::: "memory");
        } else {
            XB_SPIN(xb_ld(&bar[XB_XGEN(b.x)]) == gen, bar);
            __builtin_amdgcn_fence(__ATOMIC_ACQUIRE, "agent");
            asm volatile("s_waitcnt vmcnt(0)" ::: "memory");
        }
    }
    __syncthreads();
}

#define RUN_PHASE(K, CALL)                                              \
    if (ph_lo <= (K) && (K) < ph_hi) {                                  \
        CALL;                                                           \
        if (COOP) { if ((K) + 1 < ph_hi) { xcd_barrier(xb); } } \
    }

template <bool COOP>
__global__ void __launch_bounds__(512, 2) fwd_kernel(Params p, int ph_lo, int ph_hi) {
    __shared__ __attribute__((aligned(16))) char smem[SMEM_BYTES + 16];
    char* smh = smem + VHB * HALF_SMEM;
    XcdBarrier xb;
    if (COOP) {
        if (threadIdx.x == 0) *(uint4*)(smem + SMEM_BYTES) = make_uint4(0u, 0u, 0u, 0u);
        __syncthreads();
        xb = xcd_barrier_post(p.bar(), (volatile unsigned*)(smem + SMEM_BYTES));
    }
    if (COOP) { if (ph_lo < 0) cg::this_grid().sync(); }
    RUN_PHASE(0, phase_prep(p, smh))
    RUN_PHASE(1, phase_gemm_in(p, smem))
    RUN_PHASE(2, phase_mixers(p, smh))
    RUN_PHASE(3, (phase_gemm_kv(p, smem), phase_hg_scan(p)))
    RUN_PHASE(4, phase_hg_out(p, smh))
    RUN_PHASE(5, phase_gemm_out(p, smem))
    RUN_PHASE(7, phase_gemm_q(p, smem))
    RUN_PHASE(8, phase_route(p, smh))
    RUN_PHASE(10, phase_peer_dots(p, smem))
    RUN_PHASE(12, phase_peer_accum(p, smem))
}

extern "C" void kernel_launch(void* const* d_in, const int* in_sizes, int n_in, void* d_out, int out_size, void* d_ws, size_t ws_size,
                              hipStream_t stream) {
    Params p{};
    p.x = (const float*)d_in[0]; p.mem = (const float*)d_in[1]; p.attn_g = (const float*)d_in[2]; p.w_in = (const float*)d_in[3];
    p.rpb = (const float*)d_in[4]; p.hg_lb = (const float*)d_in[5]; p.hg_g = (const float*)d_in[6]; p.mem_g = (const float*)d_in[7];
    p.w_kv = (const float*)d_in[8]; p.w_out = (const float*)d_in[9]; p.ffn_g = (const float*)d_in[10]; p.w_q = (const float*)d_in[11];
    p.subk = (const float*)d_in[12]; p.pu = (const float*)d_in[13]; p.pv = (const float*)d_in[14]; p.fin_g = (const float*)d_in[15];
    p.out = (float*)d_out;
    p.ws = (char*)d_ws;
    if (WS_TOTAL > ws_size) { fprintf(stderr, "workspace too small: need %zu have %zu\n", (size_t)WS_TOTAL, ws_size); return; }

#if defined(MULTI_LAUNCH)
    for (int ph = 0; ph < NPHASE; ++ph) fwd_kernel<false><<<dim3(512), dim3(512), 0, stream>>>(p, ph, ph + 1);
#else
    static int grid_blocks = 0;
    if (!grid_blocks) {
        int dev = 0, cus = 0, per_cu = 0;
        hipGetDevice(&dev);
        hipDeviceGetAttribute(&cus, hipDeviceAttributeMultiprocessorCount, dev);
        hipOccupancyMaxActiveBlocksPerMultiprocessor(&per_cu, fwd_kernel<true>, 512, 0);
        if (per_cu > 1) per_cu = 1;
        grid_blocks = (cus * per_cu) & ~3;
    }
    (void)hipMemsetAsync((char*)d_ws + OFF_BAR, 0, XCD_BAR_WORDS * 4, stream);
    int lo = 0, hi = NPHASE;
    void* args[] = {&p, &lo, &hi};
    hipError_t e = hipLaunchCooperativeKernel((void*)fwd_kernel<true>, dim3(grid_blocks), dim3(512), args, 0, stream);
    if (e != hipSuccess) fprintf(stderr, "cooperative launch failed: %s (grid %d)\n", hipGetErrorString(e), grid_blocks);
#endif
}
```

```cpp
#include <hip/hip_runtime.h>
#include <hip/hip_cooperative_groups.h>
#include <stdint.h>
#include <cstdio>

namespace cg = cooperative_groups;

#define VTID ((int)(threadIdx.x & 255))
#define VHB ((int)(threadIdx.x >> 8))
#define VBID ((int)(blockIdx.x * 2 + (threadIdx.x >> 8)))
#define VGRID ((int)(gridDim.x * 2))
constexpr int HALF_SMEM = 73728;

typedef unsigned short bf16_t;
typedef short bf16x8 __attribute__((ext_vector_type(8)));
typedef float f32x4 __attribute__((ext_vector_type(4)));

constexpr int D = 1024;
constexpr int NB = 4;
constexpr int T = 8192;
constexpr int NTOK = NB * T;
constexpr int INW = 3072;
constexpr int QW = 2048;
constexpr float EPS = 1e-6f;
constexpr int SMEM_BYTES = 2 * 73728;
constexpr int NPHASE = 14;

constexpr size_t al256(size_t x) { return (x + 255) & ~(size_t)255; }
constexpr size_t OFF_W_IN_T = 0;
constexpr size_t OFF_W_OUT_T = OFF_W_IN_T + al256((size_t)3072 * 1024 * 2);
constexpr size_t OFF_W_Q_T = OFF_W_OUT_T + al256((size_t)1024 * 1024 * 2);
constexpr size_t OFF_W_KV_T = OFF_W_Q_T + al256((size_t)2048 * 1024 * 2);
constexpr size_t OFF_H = OFF_W_KV_T + al256((size_t)512 * 1024 * 2);
constexpr size_t OFF_Z = OFF_H + al256((size_t)32768 * 1024 * 2);
constexpr size_t OFF_MIX = OFF_Z + al256((size_t)32768 * 3072 * 2);
constexpr size_t OFF_MEMN = OFF_MIX + al256((size_t)32768 * 1024 * 2);
constexpr size_t OFF_KVB = OFF_MEMN + al256((size_t)1024 * 1024 * 2);
constexpr size_t OFF_LB = OFF_KVB + al256((size_t)1024 * 512 * 2);
constexpr size_t OFF_HSTATE = OFF_LB + al256(512 * 4);
constexpr size_t OFF_HDEC = OFF_HSTATE + al256((size_t)4096 * 4096 * 4);
constexpr size_t OFF_UC = OFF_HDEC + al256((size_t)4096 * 64 * 4);
constexpr size_t OFF_VC = OFF_UC + al256((size_t)16384 * 1024);
constexpr size_t OFF_QUEUE = OFF_VC + al256((size_t)16384 * 1024);
constexpr size_t OFF_SUBK = OFF_QUEUE + al256(2048 * 4);
constexpr size_t OFF_BAR = OFF_SUBK + al256((size_t)16 * 128 * 128 * 2);
constexpr size_t OFF_SS1 = OFF_BAR + al256(4096 * 4);
constexpr size_t OFF_HMAX = OFF_SS1 + al256((size_t)32768 * 4);
constexpr size_t OFF_CSUM = OFF_HMAX + al256((size_t)32768 * 4);
constexpr size_t OFF_SCALE_U = OFF_CSUM + al256((size_t)32768 * 4);
constexpr size_t OFF_SCALE_V = OFF_SCALE_U + al256(16384 * 4);
constexpr size_t OFF_VT = OFF_SCALE_V + al256(16384 * 4);
constexpr size_t OFF_KVT = OFF_VT + al256((size_t)32768 * 512 * 2);
constexpr size_t WS_TOTAL = OFF_KVT + al256((size_t)1024 * 256 * 2);
constexpr size_t OFF_EIDX = OFF_HSTATE;
constexpr size_t OFF_GATE = OFF_HSTATE + (size_t)32768 * 128 * 4;
constexpr size_t OFF_COEF = OFF_HSTATE + (size_t)32768 * 128 * 8;
constexpr size_t OFF_SS = OFF_HSTATE + (size_t)32768 * 128 * 12;
constexpr size_t OFF_PARTIAL = OFF_Z;
constexpr size_t OFF_PEER_OUT = OFF_Z + (size_t)8 * 32768 * 128 * 4;

struct Params {
    const float *x, *mem, *attn_g, *w_in, *rpb, *hg_lb, *hg_g, *mem_g, *w_kv, *w_out, *ffn_g, *w_q, *subk, *pu, *pv, *fin_g;
    float* out;
    char* ws;
#define WSF(type, name, off) __device__ __forceinline__ type* name() const { return (type*)(ws + (off)); }
    WSF(bf16_t, w_in_t, OFF_W_IN_T) WSF(bf16_t, w_out_t, OFF_W_OUT_T) WSF(bf16_t, w_q_t, OFF_W_Q_T) WSF(bf16_t, w_kv_t, OFF_W_KV_T)
    WSF(bf16_t, h, OFF_H)
    WSF(bf16_t, z, OFF_Z)
    WSF(bf16_t, mix, OFF_MIX)
    WSF(bf16_t, memn, OFF_MEMN)
    WSF(bf16_t, kvb, OFF_KVB)
    WSF(float, lb, OFF_LB)
    WSF(float, hstate, OFF_HSTATE)
    WSF(float, hdec, OFF_HDEC)
    WSF(unsigned short, eidx, OFF_EIDX)
    WSF(float, gate, OFF_GATE)
    WSF(signed char, coef, OFF_COEF)
    WSF(bf16_t, peer_out, OFF_PEER_OUT)
    WSF(float, ss, OFF_SS)
    WSF(float, partial, OFF_PARTIAL)
    WSF(bf16_t, u_c, OFF_UC) WSF(bf16_t, v_c, OFF_VC)
    WSF(unsigned, queue, OFF_QUEUE)
    WSF(bf16_t, subk_b, OFF_SUBK)
    WSF(unsigned, bar, OFF_BAR)
    WSF(float, ss1, OFF_SS1) WSF(unsigned, hmax, OFF_HMAX) WSF(float, csum, OFF_CSUM)
    WSF(float, scale_u, OFF_SCALE_U) WSF(float, scale_v, OFF_SCALE_V)
    WSF(bf16_t, vT, OFF_VT)
    WSF(bf16_t, kvT, OFF_KVT)
#undef WSF
};

__device__ __forceinline__ float bf2f(bf16_t v) { return __uint_as_float(((unsigned)v) << 16); }
__device__ __forceinline__ bf16_t f2bf(float f) {
    unsigned u = __float_as_uint(f);
    u += 0x7FFFu + ((u >> 16) & 1u);
    return (bf16_t)(u >> 16);
}
__device__ __forceinline__ float bflo(unsigned u) { return __uint_as_float(u << 16); }
__device__ __forceinline__ float bfhi(unsigned u) { return __uint_as_float(u & 0xFFFF0000u); }
typedef __bf16 bf16x2v_t __attribute__((ext_vector_type(2)));
typedef float f32x2v_t __attribute__((ext_vector_type(2)));
__device__ __forceinline__ unsigned pack2(float a, float b) {
    const f32x2v_t v = {a, b};
    return __builtin_bit_cast(unsigned, __builtin_convertvector(v, bf16x2v_t));
}

__device__ __forceinline__ float wave_sum(float v) {
#pragma unroll
    for (int o = 32; o; o >>= 1) v += __shfl_xor(v, o);
    return v;
}
__device__ __forceinline__ float wave_max(float v) {
#pragma unroll
    for (int o = 32; o; o >>= 1) v = fmaxf(v, __shfl_xor(v, o));
    return v;
}


typedef __bf16 bf16x2_t __attribute__((ext_vector_type(2)));
template <int CTRL>
__device__ __forceinline__ float dpp_mov(float v) {
    return __builtin_bit_cast(float, __builtin_amdgcn_update_dpp(0, __builtin_bit_cast(int, v), CTRL, 0xf, 0xf, true));
}
#define DPP_QP_X1 0xB1
#define DPP_QP_X2 0x4E
#define DPP_HMIRROR 0x141
#define DPP_ROR8 0x128
__device__ __forceinline__ unsigned xcc_id() { return (unsigned)__builtin_amdgcn_s_getreg((3 << 11) | 20) & 0xFu; }

__device__ __forceinline__ void transpose_tile(const float* __restrict__ in, bf16_t* __restrict__ out, int K, int N, int tile, char* smem) {
    float* tl = (float*)smem;
    const int ntn = N >> 6;
    const int k0 = (tile / ntn) << 6, n0 = (tile % ntn) << 6;
    const int tid = VTID;
    __syncthreads();
#pragma unroll 4
    for (int i = 0; i < 16; ++i) {
        int idx = tid + 256 * i;
        int r = idx >> 6, c = idx & 63;
        tl[r * 65 + c] = in[(size_t)(k0 + r) * N + n0 + c];
    }
    __syncthreads();
#pragma unroll 4
    for (int i = 0; i < 16; ++i) {
        int idx = tid + 256 * i;
        int r = idx >> 6, c = idx & 63;
        out[(size_t)(n0 + r) * K + k0 + c] = f2bf(tl[c * 65 + r]);
    }
}

__device__ __forceinline__ void rmsnorm_row_bf16(const float* __restrict__ xr, const float* __restrict__ g, bf16_t* __restrict__ o, int lane) {
    float4 v[4];
    float ss = 0.f;
#pragma unroll
    for (int j = 0; j < 4; ++j) {
        v[j] = *(const float4*)(xr + (j * 64 + lane) * 4);
        ss += v[j].x * v[j].x + v[j].y * v[j].y + v[j].z * v[j].z + v[j].w * v[j].w;
    }
    ss = wave_sum(ss);
    const float rs = rsqrtf(ss * (1.0f / 1024.0f) + EPS);
#pragma unroll
    for (int j = 0; j < 4; ++j) {
        const float4 gg = *(const float4*)(g + (j * 64 + lane) * 4);
        uint2 pk;
        pk.x = pack2(v[j].x * rs * gg.x, v[j].y * rs * gg.y);
        pk.y = pack2(v[j].z * rs * gg.z, v[j].w * rs * gg.w);
        *(uint2*)(o + (j * 64 + lane) * 4) = pk;
    }
}

__device__ void phase_prep(const Params& p, char* smem) {
    const int tid = VTID, lane = tid & 63, w = tid >> 6;
    const int gsz = VGRID, bid = VBID;
    const int t_in = (1024 / 64) * (INW / 64);
    const int t_out = 16 * 16;
    const int t_q = 16 * (QW / 64);
    const int t_kv = 16 * 8;
    const int t_all = t_in + t_out + t_q + t_kv;
    for (int it = bid; it < t_all; it += gsz) {
        if (it < t_in) transpose_tile(p.w_in, p.w_in_t(), 1024, INW, it, smem);
        else if (it < t_in + t_out) transpose_tile(p.w_out, p.w_out_t(), 1024, 1024, it - t_in, smem);
        else if (it < t_in + t_out + t_q) transpose_tile(p.w_q, p.w_q_t(), 1024, QW, it - t_in - t_out, smem);
        else transpose_tile(p.w_kv, p.w_kv_t(), 1024, 512, it - t_in - t_out - t_q, smem);
    }
    for (int i = bid * 256 + tid; i < NTOK; i += gsz * 256) { p.ss1()[i] = 0.f; p.hmax()[i] = 0u; }
    if (bid == 0) {
        for (int i = tid; i < 512; i += 256) {
            int dir = i >> 8, k = i & 255;
            float a0 = p.hg_lb[(dir * 2 + 0) * 256 + k], a1 = p.hg_lb[(dir * 2 + 1) * 256 + k];
            float m = fmaxf(a0, a1);
            float e0 = expf(a0 - m), e1 = expf(a1 - m);
            p.lb()[i] = e0 / (e0 + e1);
        }
    }
    const int nrows = NTOK + 1024;
    for (int r0 = bid * 4; r0 < nrows; r0 += gsz * 4) {
        int r = r0 + w;
        if (r < NTOK) rmsnorm_row_bf16(p.x + (size_t)r * D, p.attn_g, p.h() + (size_t)r * D, lane);
        else if (r < nrows) rmsnorm_row_bf16(p.mem + (size_t)(r - NTOK) * D, p.mem_g, p.memn() + (size_t)(r - NTOK) * D, lane);
    }
    for (int i = bid * 256 + tid; i < 16 * 128 * 128 / 4; i += gsz * 256) {
        const float4 v = *(const float4*)(p.subk + (size_t)i * 4);
        uint2 pk; pk.x = pack2(v.x, v.y); pk.y = pack2(v.z, v.w);
        *(uint2*)(p.subk_b() + (size_t)i * 4) = pk;
    }
    for (int r0 = bid * 4; r0 < 2 * 16384; r0 += gsz * 4) {
        const int r = r0 + w;
        const bool isv = r >= 16384;
        const int e = r & 16383;
        const float* srcp = (isv ? p.pv : p.pu) + (size_t)e * D;
        unsigned* dst = (unsigned*)(isv ? p.v_c() : p.u_c());
        float4 v[4];
        float am = 0.f;
#pragma unroll
        for (int j = 0; j < 4; ++j) {
            v[j] = *(const float4*)(srcp + (j * 64 + lane) * 4);
            am = fmaxf(am, fmaxf(fmaxf(fabsf(v[j].x), fabsf(v[j].y)), fmaxf(fabsf(v[j].z), fabsf(v[j].w))));
        }
        am = wave_max(am);
        const float qs = am > 0.f ? 127.0f / am : 0.f;
        if (lane == 0) (isv ? p.scale_v() : p.scale_u())[e] = am * (1.0f / 127.0f);
        const int off = 0;
#pragma unroll
        for (int j = 0; j < 4; ++j) {
            const int q0 = (int)rintf(v[j].x * qs) + off, q1 = (int)rintf(v[j].y * qs) + off;
            const int q2 = (int)rintf(v[j].z * qs) + off, q3 = (int)rintf(v[j].w * qs) + off;
            const unsigned pk = (unsigned)(q0 & 255) | ((unsigned)(q1 & 255) << 8) | ((unsigned)(q2 & 255) << 16) | ((unsigned)(q3 & 255) << 24);
            const int c = j * 2 + (lane >> 5), d = (lane & 31) * 4;
            dst[(((size_t)c * 16384 + e) * 128 + d) >> 2] = pk;
        }
    }
}

struct EpiBf16 {
    bf16_t* C; int ldc;
    __device__ __forceinline__ void operator()(int row, int col, const f32x4& v) const {
        uint2 pk; pk.x = pack2(v[0], v[1]); pk.y = pack2(v[2], v[3]);
        *(uint2*)(C + (size_t)row * ldc + col) = pk;
    }
};
struct EpiBf16T {
    bf16_t* C; int col0, ncols, rows_per_b;
    __device__ __forceinline__ void operator()(int row, int col, const f32x4& v) const {
        const int bb = row / rows_per_b, rr = row - bb * rows_per_b;
        uint2 pk; pk.x = pack2(v[0], v[1]); pk.y = pack2(v[2], v[3]);
        *(uint2*)(C + ((size_t)bb * ncols + (col - col0)) * rows_per_b + rr) = pk;
    }
};
struct EpiBf16RowScale {
    bf16_t* C; int ldc; const float* ssrow;
    __device__ __forceinline__ void operator()(int row, int col, const f32x4& v) const {
        const float rs = rsqrtf(ssrow[row] * (1.0f / 1024.0f) + EPS);
        uint2 pk; pk.x = pack2(v[0] * rs, v[1] * rs); pk.y = pack2(v[2] * rs, v[3] * rs);
        *(uint2*)(C + (size_t)row * ldc + col) = pk;
    }
};
struct EpiResNorm {
    float* C; const float* R; const float* g; bf16_t* H; int ldc; float* ssrow; unsigned* hmax;
    __device__ __forceinline__ void operator()(int row, int col, const f32x4& v, float& ssq, float& am) const {
        const float4 r = *(const float4*)(R + (size_t)row * ldc + col);
        const float4 gg = *(const float4*)(g + col);
        float4 o; o.x = v[0] + r.x; o.y = v[1] + r.y; o.z = v[2] + r.z; o.w = v[3] + r.w;
        *(float4*)(C + (size_t)row * ldc + col) = o;
        const float h0 = o.x * gg.x, h1 = o.y * gg.y, h2 = o.z * gg.z, h3 = o.w * gg.w;
        uint2 pk; pk.x = pack2(h0, h1); pk.y = pack2(h2, h3);
        *(uint2*)(H + (size_t)row * ldc + col) = pk;
        ssq += o.x * o.x + o.y * o.y + o.z * o.z + o.w * o.w;
        am = fmaxf(am, fmaxf(fmaxf(fabsf(h0), fabsf(h1)), fmaxf(fabsf(h2), fabsf(h3))));
    }
    __device__ __forceinline__ void row_done(int row, float ssq, float am) const {
        atomicAdd(ssrow + row, ssq);
        atomicMax(hmax + row, __float_as_uint(am));
    }
};
struct EpiResF32 {
    float* C; const float* R; int ldc;
    __device__ __forceinline__ void operator()(int row, int col, const f32x4& v) const {
        const float4 r = *(const float4*)(R + (size_t)row * ldc + col);
        float4 o; o.x = v[0] + r.x; o.y = v[1] + r.y; o.z = v[2] + r.z; o.w = v[3] + r.w;
        *(float4*)(C + (size_t)row * ldc + col) = o;
    }
};

template <bool TRANS, class Epi, bool ROWSS = false>
__device__ __forceinline__ void gemm_tile(const bf16_t* __restrict__ A, int lda, const bf16_t* __restrict__ Bt, int ldb, int K,
                                          int m0, int n0, char* smem, const Epi& epi, float* ssrow = nullptr) {
    const int tid = VTID, lane = tid & 63, w = tid >> 6, wr = w >> 1, wc = w & 1;
    const int fr = lane & 15, fq = lane >> 4;
    const int srow = lane >> 3, sslot = lane & 7;
    f32x4 acc[4][4];
#pragma unroll
    for (int mi = 0; mi < 4; ++mi)
#pragma unroll
        for (int ni = 0; ni < 4; ++ni) acc[mi][ni] = (f32x4){0.f, 0.f, 0.f, 0.f};
    const int g0 = (sslot ^ (srow >> 1)) * 8, g1 = (sslot ^ (4 + (srow >> 1))) * 8;
    const bf16_t* Ab = A + (size_t)(m0 + w * 32 + srow) * lda;
    const bf16_t* Bb = Bt + (size_t)(n0 + w * 32 + srow) * ldb;
    const int nk = K >> 6;
    __syncthreads();
#define GEMM_STAGE(kt, buf)                                                                                                  \
    do {                                                                                                                     \
        char* sa = smem + (buf) * 32768 + w * 4096;                                                                          \
        char* sb = sa + 16384;                                                                                               \
        _Pragma("unroll") for (int i = 0; i < 4; ++i) {                                                                      \
            const int gc = (i & 1) ? g1 : g0;                                                                                \
            __builtin_amdgcn_global_load_lds((const unsigned*)(Ab + (size_t)(i * 8) * lda + (kt) * 64 + gc), (unsigned*)(sa + i * 1024), 16, 0, 0); \
            __builtin_amdgcn_global_load_lds((const unsigned*)(Bb + (size_t)(i * 8) * ldb + (kt) * 64 + gc), (unsigned*)(sb + i * 1024), 16, 0, 0); \
        }                                                                                                                    \
    } while (0)
    GEMM_STAGE(0, 0);
    const int key = fr >> 1;
    for (int kt = 0; kt < nk; ++kt) {
        asm volatile("s_waitcnt vmcnt(0)" ::: "memory");
        __syncthreads();
        if (kt + 1 < nk) GEMM_STAGE(kt + 1, (kt + 1) & 1);
        const char* sa = smem + (kt & 1) * 32768;
        const char* sb = sa + 16384;
#pragma unroll
        for (int ks = 0; ks < 2; ++ks) {
            bf16x8 af[4], bfr[4];
            const int co = ((ks * 4 + fq) ^ key) << 4;
#pragma unroll
            for (int mi = 0; mi < 4; ++mi) af[mi] = *(const bf16x8*)(sa + (wr * 64 + mi * 16 + fr) * 128 + co);
#pragma unroll
            for (int ni = 0; ni < 4; ++ni) bfr[ni] = *(const bf16x8*)(sb + (wc * 64 + ni * 16 + fr) * 128 + co);
#pragma unroll
            for (int mi = 0; mi < 4; ++mi)
#pragma unroll
                for (int ni = 0; ni < 4; ++ni)
                    acc[mi][ni] = TRANS ? __builtin_amdgcn_mfma_f32_16x16x32_bf16(af[mi], bfr[ni], acc[mi][ni], 0, 0, 0)
                                        : __builtin_amdgcn_mfma_f32_16x16x32_bf16(bfr[ni], af[mi], acc[mi][ni], 0, 0, 0);
        }
    }
#undef GEMM_STAGE
    if constexpr (ROWSS) {
#pragma unroll
        for (int mi = 0; mi < 4; ++mi) {
            const int row = m0 + wr * 64 + mi * 16 + fr;
            float ssq = 0.f, am = 0.f;
#pragma unroll
            for (int ni = 0; ni < 4; ++ni) epi(row, n0 + wc * 64 + ni * 16 + fq * 4, acc[mi][ni], ssq, am);
            ssq += __shfl_xor(ssq, 16);
            ssq += __shfl_xor(ssq, 32);
            am = fmaxf(am, __shfl_xor(am, 16));
            am = fmaxf(am, __shfl_xor(am, 32));
            if (fq == 0) epi.row_done(row, ssq, am);
        }
    } else {
#pragma unroll
        for (int mi = 0; mi < 4; ++mi)
#pragma unroll
            for (int ni = 0; ni < 4; ++ni) {
                if (TRANS) epi(m0 + wr * 64 + mi * 16 + fq * 4, n0 + wc * 64 + ni * 16 + fr, acc[mi][ni]);
                else epi(m0 + wr * 64 + mi * 16 + fr, n0 + wc * 64 + ni * 16 + fq * 4, acc[mi][ni]);
            }
    }
}


namespace g8 {
constexpr int BM = 256, BK = 64, HALF = 128, HT = HALF * BK;
__device__ __forceinline__ int lds_byte(int r, int c) {
    const int st = (r >> 4) * 2 + (c >> 5), rr = r & 15, cc = c & 31, ob = rr * 64 + cc * 2;
    return st * 1024 + (ob ^ (((ob >> 9) & 1) << 5));
}
__device__ __forceinline__ void stage_rc(int b, int& R, int& C) {
    const int st = b / 1024, sb = b % 1024, swz = sb ^ (((sb >> 9) & 1) << 5);
    R = (st >> 1) * 16 + swz / 64; C = (st & 1) * 32 + (swz % 64) / 2;
}
__device__ __forceinline__ void tile_of(int L, int nM, int nN, int& pm, int& pn) {
    const int nwg = nM * nN;
    int wgid = L;
    { const int q = nwg / 8, r = nwg % 8, xcd = wgid % 8, off = wgid / 8; wgid = (xcd < r ? xcd * (q + 1) : r * (q + 1) + (xcd - r) * q) + off; }
    const int nig = 8 * nN, gid = wgid / nig, fm = gid * 8, gsz = (nM - fm) < 8 ? (nM - fm) : 8;
    pm = fm + ((wgid % nig) % gsz); pn = (wgid % nig) / gsz;
}
}

#define G8_LAS __attribute__((address_space(3)))
template <bool TRANS, bool ROWSS, class Epi>
__device__ __forceinline__ void gemm256_tile(const bf16_t* __restrict__ A, const bf16_t* __restrict__ Bt, int K, int brow, int bcol,
                                             char* shmc, const Epi& epi) {
    using namespace g8;
    G8_LAS unsigned char* lds = (G8_LAS unsigned char*)shmc;
    const int tid = threadIdx.x, wid = __builtin_amdgcn_readfirstlane(tid >> 6), lane = tid & 63, wr = wid >> 2, wc = wid & 3, fr = lane & 15, fq = lane >> 4;
    constexpr int HTB = HALF * BK * 2;
    unsigned voff[2];
#pragma unroll
    for (int i = 0; i < 2; ++i) { int R, C; stage_rc(tid * 16 + i * 8192, R, C); voff[i] = (unsigned)(R * K + C) * 2u; }
    const size_t kstep = (size_t)(BK * 2);
    const size_t hstep = (size_t)HALF * K * 2;
    const unsigned ldsw = (unsigned)wid * 1024u;
    const int aoff = lds_byte(wr * 64 + fr, fq * 8), boff = lds_byte(wc * 32 + fr, fq * 8);
    const char* cA = (const char*)A + (size_t)brow * K * 2;
    const char* cB = (const char*)Bt + (size_t)bcol * K * 2;
#define G8_SA(b, h) (((b) * 2 + (h)) * HTB)
#define G8_SB(b, h) ((4 + (b) * 2 + (h)) * HTB)
#define G8_STAGE(bufoff, gbase) do { _Pragma("unroll") for (int _i = 0; _i < 2; ++_i) \
        __builtin_amdgcn_global_load_lds((const unsigned*)((const char*)(gbase) + voff[_i]), (G8_LAS unsigned*)(lds + (bufoff) + ldsw + _i * 8192), 16, 0, 0); } while (0)
#define G8_LDA(dst, b, h) do { _Pragma("unroll") for (int m = 0; m < 4; ++m) _Pragma("unroll") for (int k = 0; k < 2; ++k) dst[m][k] = *(const G8_LAS bf16x8*)(lds + G8_SA(b, h) + aoff + m * 2048 + k * 1024); } while (0)
#define G8_LDB(dst, b, h) do { _Pragma("unroll") for (int n = 0; n < 2; ++n) _Pragma("unroll") for (int k = 0; k < 2; ++k) dst[n][k] = *(const G8_LAS bf16x8*)(lds + G8_SB(b, h) + boff + n * 2048 + k * 1024); } while (0)
#define G8_MMA(ai, bj, At_, Bt_) do { __builtin_amdgcn_s_setprio(1); _Pragma("unroll") for (int m = 0; m < 4; ++m) _Pragma("unroll") for (int n = 0; n < 2; ++n) _Pragma("unroll") for (int k = 0; k < 2; ++k) \
        acc[ai][bj][m][n] = TRANS ? __builtin_amdgcn_mfma_f32_16x16x32_bf16(At_[m][k], Bt_[n][k], acc[ai][bj][m][n], 0, 0, 0) \
                                  : __builtin_amdgcn_mfma_f32_16x16x32_bf16(Bt_[n][k], At_[m][k], acc[ai][bj][m][n], 0, 0, 0); \
        __builtin_amdgcn_s_setprio(0); } while (0)
#define G8_WAIT_V(n) asm volatile("s_waitcnt vmcnt(" #n ")" ::: "memory")
#define G8_WAIT_L(n) asm volatile("s_waitcnt lgkmcnt(" #n ")" ::: "memory")
#define G8_BAR __builtin_amdgcn_s_barrier()
#define G8_SCHED __builtin_amdgcn_sched_barrier(0)
    f32x4 acc[2][2][4][2];
#pragma unroll
    for (int a = 0; a < 2; ++a)
#pragma unroll
        for (int b = 0; b < 2; ++b)
#pragma unroll
            for (int m = 0; m < 4; ++m)
#pragma unroll
                for (int n = 0; n < 2; ++n) acc[a][b][m][n] = (f32x4){0.f, 0.f, 0.f, 0.f};
    bf16x8 At[4][2], B0[2][2], B1[2][2];
    const int nt = K / BK;
    __syncthreads();
    G8_STAGE(G8_SB(0, 0), cB); G8_STAGE(G8_SA(0, 0), cA); G8_STAGE(G8_SB(0, 1), cB + hstep); G8_STAGE(G8_SA(0, 1), cA + hstep);
    if (wr == 1) G8_BAR;
    G8_WAIT_V(4); G8_BAR;
    G8_STAGE(G8_SB(1, 0), cB + kstep); G8_STAGE(G8_SA(1, 0), cA + kstep); G8_STAGE(G8_SB(1, 1), cB + hstep + kstep);
    G8_WAIT_V(6); G8_BAR;
    for (int t = 0; t < nt - 2; t += 2) {
        const char* a1 = cA + (size_t)(t + 1) * kstep; const char* a2 = a1 + kstep; const char* a3 = a2 + kstep;
        const char* b2 = cB + (size_t)(t + 2) * kstep; const char* b3 = b2 + kstep;
        G8_LDB(B0, 0, 0); G8_SCHED; G8_LDA(At, 0, 0); G8_STAGE(G8_SA(1, 1), a1 + hstep);
        G8_WAIT_L(8); G8_BAR; G8_WAIT_L(0); G8_MMA(0, 0, At, B0); G8_BAR; G8_SCHED;
        G8_LDB(B1, 0, 1); G8_STAGE(G8_SB(0, 0), b2);
        G8_BAR; G8_WAIT_L(0); G8_MMA(0, 1, At, B1); G8_BAR;
        G8_LDA(At, 0, 1); G8_STAGE(G8_SA(0, 0), a2);
        G8_BAR; G8_WAIT_L(0); G8_MMA(1, 0, At, B0); G8_BAR; G8_SCHED;
        G8_STAGE(G8_SB(0, 1), b2 + hstep);
        G8_WAIT_V(6); G8_BAR; G8_MMA(1, 1, At, B1); G8_BAR;
        G8_LDB(B0, 1, 0); G8_SCHED; G8_LDA(At, 1, 0); G8_STAGE(G8_SA(0, 1), a2 + hstep);
        G8_WAIT_L(8); G8_BAR; G8_WAIT_L(0); G8_MMA(0, 0, At, B0); G8_BAR; G8_SCHED;
        G8_LDB(B1, 1, 1); G8_STAGE(G8_SB(1, 0), b3);
        G8_BAR; G8_WAIT_L(0); G8_MMA(0, 1, At, B1); G8_BAR;
        G8_LDA(At, 1, 1); G8_STAGE(G8_SA(1, 0), a3);
        G8_BAR; G8_WAIT_L(0); G8_MMA(1, 0, At, B0); G8_BAR; G8_SCHED;
        G8_STAGE(G8_SB(1, 1), b3 + hstep);
        G8_WAIT_V(6); G8_BAR; G8_MMA(1, 1, At, B1); G8_BAR;
    }
    { G8_LDB(B0, 0, 0); G8_LDA(At, 0, 0); G8_STAGE(G8_SA(1, 1), cA + (size_t)(nt - 1) * kstep + hstep);
      G8_BAR; G8_WAIT_L(0); G8_MMA(0, 0, At, B0); G8_BAR;
      G8_LDB(B1, 0, 1); G8_BAR; G8_WAIT_L(0); G8_MMA(0, 1, At, B1); G8_BAR;
      G8_LDA(At, 0, 1); G8_WAIT_V(4); G8_BAR; G8_WAIT_L(0); G8_MMA(1, 0, At, B0); G8_MMA(1, 1, At, B1); G8_BAR; }
    { G8_LDB(B0, 1, 0); G8_LDA(At, 1, 0); G8_WAIT_V(2); G8_BAR; G8_WAIT_L(0); G8_MMA(0, 0, At, B0); G8_BAR;
      G8_LDB(B1, 1, 1); G8_WAIT_V(0); G8_BAR; G8_WAIT_L(0); G8_MMA(0, 1, At, B1); G8_BAR;
      G8_LDA(At, 1, 1); G8_BAR; G8_WAIT_L(0); G8_MMA(1, 0, At, B0); G8_MMA(1, 1, At, B1); G8_BAR; }
    if (wr == 0) G8_BAR;
    if constexpr (ROWSS) {
#pragma unroll
        for (int ai = 0; ai < 2; ++ai)
#pragma unroll
            for (int m = 0; m < 4; ++m) {
                const int row = brow + ai * HALF + wr * 64 + m * 16 + fr;
                float ssq = 0.f, am = 0.f;
#pragma unroll
                for (int bj = 0; bj < 2; ++bj)
#pragma unroll
                    for (int n = 0; n < 2; ++n) epi(row, bcol + bj * HALF + wc * 32 + n * 16 + fq * 4, acc[ai][bj][m][n], ssq, am);
                ssq += __shfl_xor(ssq, 16);
                ssq += __shfl_xor(ssq, 32);
                am = fmaxf(am, __shfl_xor(am, 16));
                am = fmaxf(am, __shfl_xor(am, 32));
                if (fq == 0) epi.row_done(row, ssq, am);
            }
    } else {
#pragma unroll
        for (int ai = 0; ai < 2; ++ai)
#pragma unroll
            for (int bj = 0; bj < 2; ++bj)
#pragma unroll
                for (int m = 0; m < 4; ++m)
#pragma unroll
                    for (int n = 0; n < 2; ++n) {
                        if (TRANS) epi(brow + ai * HALF + wr * 64 + m * 16 + fq * 4, bcol + bj * HALF + wc * 32 + n * 16 + fr, acc[ai][bj][m][n]);
                        else epi(brow + ai * HALF + wr * 64 + m * 16 + fr, bcol + bj * HALF + wc * 32 + n * 16 + fq * 4, acc[ai][bj][m][n]);
                    }
    }
#undef G8_SA
#undef G8_SB
#undef G8_STAGE
#undef G8_LDA
#undef G8_LDB
#undef G8_MMA
#undef G8_WAIT_V
#undef G8_WAIT_L
#undef G8_BAR
#undef G8_SCHED
}

__device__ void phase_gemm_in(const Params& p, char* smem) {
    const int nM = NTOK / 256, nN = INW / 256;
    EpiBf16 e1{p.z(), INW};
    EpiBf16T e1t{p.vT(), 1024, 512, T};
    for (int i = 0; i * (int)gridDim.x + (int)blockIdx.x < nM * nN; ++i) {
        int pm, pn;
        g8::tile_of(i * gridDim.x + blockIdx.x, nM, nN, pm, pn);
        if (pn >= 4 && pn < 6) gemm256_tile<true, false>(p.h(), p.w_in_t(), D, pm * 256, pn * 256, smem, e1t);
        else gemm256_tile<false, false>(p.h(), p.w_in_t(), D, pm * 256, pn * 256, smem, e1);
    }
}

__device__ void phase_gemm_kv(const Params& p, char* smh) {
    EpiBf16 e2{p.kvb(), 512};
    EpiBf16T e2t{p.kvT(), 256, 256, 256};
    if (blockIdx.x >= 16) return;
    const int it = VBID;
    const int pm = it >> 2, pn = it & 3;
    if (pn >= 2) gemm_tile<true>(p.memn(), D, p.w_kv_t(), D, D, pm * 128, pn * 128, smh, e2t);
    else gemm_tile<false>(p.memn(), D, p.w_kv_t(), D, D, pm * 128, pn * 128, smh, e2);
}

__device__ void phase_gemm_out(const Params& p, char* smem) {
    const int nM = NTOK / 256, nN = D / 256;
    EpiResNorm e{p.out, p.x, p.ffn_g, p.h(), D, p.ss1(), p.hmax()};
    for (int i = 0; i * (int)gridDim.x + (int)blockIdx.x < nM * nN; ++i) {
        int pm, pn;
        g8::tile_of(i * gridDim.x + blockIdx.x, nM, nN, pm, pn);
        gemm256_tile<false, true>(p.mix(), p.w_out_t(), D, pm * 256, pn * 256, smem, e);
    }
}

__device__ void phase_gemm_q(const Params& p, char* smem) {
    const int nM = NTOK / 256, nN = QW / 256;
    EpiBf16RowScale e{p.z(), QW, p.ss1()};
    for (int i = 0; i * (int)gridDim.x + (int)blockIdx.x < nM * nN; ++i) {
        int pm, pn;
        g8::tile_of(i * gridDim.x + blockIdx.x, nM, nN, pm, pn);
        gemm256_tile<false, false>(p.h(), p.w_q_t(), D, pm * 256, pn * 256, smem, e);
    }
}

typedef float f32x16 __attribute__((ext_vector_type(16)));
constexpr int HRS = 144;
__device__ __forceinline__ f32x16 tile_mm64(const char* X, const char* Y, int xrow0, int yrow0, int lane, f32x16 acc) {
    const int r = lane & 31, hh = lane >> 5;
#pragma unroll
    for (int ks = 0; ks < 4; ++ks) {
        const bf16x8 a = *(const bf16x8*)(X + (xrow0 + r) * HRS + ks * 32 + hh * 16);
        const bf16x8 b = *(const bf16x8*)(Y + (yrow0 + r) * HRS + ks * 32 + hh * 16);
        acc = __builtin_amdgcn_mfma_f32_32x32x16_bf16(a, b, acc, 0, 0, 0);
    }
    return acc;
}
__device__ __forceinline__ int crow(int reg, int hh) { return (reg & 3) + 8 * (reg >> 2) + 4 * hh; }

__device__ __forceinline__ void hg_load_vt(const Params& p, char* sVT, int tok0, int h, int kcol, int sq) {
    const bf16_t* zp = p.z() + (size_t)(tok0 + sq * 16) * INW + 2304 + h * 64 + kcol;
    unsigned pk[8];
#pragma unroll
    for (int j = 0; j < 8; ++j) {
        const unsigned lo = zp[(size_t)(2 * j) * INW], hi = zp[(size_t)(2 * j + 1) * INW];
        pk[j] = lo | (hi << 16);
    }
    *(uint4*)(sVT + kcol * HRS + sq * 32) = make_uint4(pk[0], pk[1], pk[2], pk[3]);
    *(uint4*)(sVT + kcol * HRS + sq * 32 + 16) = make_uint4(pk[4], pk[5], pk[6], pk[7]);
}

__device__ __forceinline__ float hg_gates(const Params& p, float* sTot, int tok0, int h, int dir, int kcol, int sq, float (&bj)[16], float (&kk)[16]) {
    const bf16_t* zp = p.z() + (size_t)(tok0 + sq * 16) * INW + 1792 + dir * 256 + h * 64 + kcol;
    const float lbv = p.lb()[dir * 256 + h * 64 + kcol];
#pragma unroll
    for (int j = 0; j < 16; ++j) {
        const float pre = bf2f(zp[(size_t)j * INW]);
        const float f = lbv + (1.0f - lbv) * (1.0f / (1.0f + __expf(-pre)));
        bj[j] = __logf(f);
        kk[j] = 1.0f - f;
    }
    if (dir == 0) {
#pragma unroll
        for (int j = 1; j < 16; ++j) bj[j] += bj[j - 1];
        sTot[sq * 64 + kcol] = bj[15];
    } else {
#pragma unroll
        for (int j = 14; j >= 0; --j) bj[j] += bj[j + 1];
        sTot[sq * 64 + kcol] = bj[0];
    }
    __syncthreads();
    const float t0 = sTot[kcol], t1 = sTot[64 + kcol], t2 = sTot[128 + kcol], t3 = sTot[192 + kcol];
    float off;
    if (dir == 0) off = (sq > 0 ? t0 : 0.f) + (sq > 1 ? t1 : 0.f) + (sq > 2 ? t2 : 0.f);
    else off = (sq < 3 ? t3 : 0.f) + (sq < 2 ? t2 : 0.f) + (sq < 1 ? t1 : 0.f);
#pragma unroll
    for (int j = 0; j < 16; ++j) bj[j] += off;
    return t0 + t1 + t2 + t3;
}

__device__ void hg_local(const Params& p, char* smem) {
    char* sVT = smem;
    char* sKT = smem + 9216;
    float* sTot = (float*)(smem + 18432);
    const int tid = VTID, lane = tid & 63, w = tid >> 6;
    const int kcol = tid & 63, sq = tid >> 6;
    for (int item = VBID; item < 4096; item += VGRID) {
        const int c = item & 127, dir = (item >> 7) & 1, h = (item >> 8) & 3, b = item >> 10;
        const int tok0 = b * T + c * 64;
        __syncthreads();
        hg_load_vt(p, sVT, tok0, h, kcol, sq);
        float bj[16], kk[16];
        const float btot = hg_gates(p, sTot, tok0, h, dir, kcol, sq, bj, kk);
        unsigned pk[8];
#pragma unroll
        for (int j = 0; j < 8; ++j)
            pk[j] = pack2(kk[2 * j] * __expf(btot - bj[2 * j]), kk[2 * j + 1] * __expf(btot - bj[2 * j + 1]));
        *(uint4*)(sKT + kcol * HRS + sq * 32) = make_uint4(pk[0], pk[1], pk[2], pk[3]);
        *(uint4*)(sKT + kcol * HRS + sq * 32 + 16) = make_uint4(pk[4], pk[5], pk[6], pk[7]);
        if (sq == 0) p.hdec()[item * 64 + kcol] = __expf(btot);
        __syncthreads();
        const int vi = w >> 1, ki = w & 1, hh = lane >> 5;
        f32x16 acc;
#pragma unroll
        for (int r = 0; r < 16; ++r) acc[r] = 0.f;
        acc = tile_mm64(sVT, sKT, vi * 32, ki * 32, lane, acc);
        float* dst = p.hstate() + (size_t)item * 4096 + ki * 32 + (lane & 31);
#pragma unroll
        for (int r = 0; r < 16; ++r) dst[(vi * 32 + crow(r, hh)) * 64] = acc[r];
    }
}

__device__ __forceinline__ bf16x8 pack8(const f32x16& x, int s8) {
    typedef unsigned u32x4_t __attribute__((ext_vector_type(4)));
    u32x4_t pk;
    pk[0] = pack2(x[s8], x[s8 + 1]); pk[1] = pack2(x[s8 + 2], x[s8 + 3]);
    pk[2] = pack2(x[s8 + 4], x[s8 + 5]); pk[3] = pack2(x[s8 + 6], x[s8 + 7]);
    return __builtin_bit_cast(bf16x8, pk);
}
__device__ __forceinline__ bf16x8 join8(const uint2& lo, const uint2& hi) {
    typedef unsigned u32x4_t __attribute__((ext_vector_type(4)));
    u32x4_t pk; pk[0] = lo.x; pk[1] = lo.y; pk[2] = hi.x; pk[3] = hi.y;
    return __builtin_bit_cast(bf16x8, pk);
}

__device__ __forceinline__ int swap23(int r) { return (r & ~12) | ((r & 4) << 1) | ((r & 8) >> 1); }

__device__ __forceinline__ void mem_attn_wave(const Params& p, int wu, int lane) {
    const int tile = wu & 255, h = (wu >> 8) & 3, b = wu >> 10;
    const int l31 = lane & 31, hh = lane >> 5;
    const int tok = b * T + tile * 32 + l31;
    bf16x8 qf[4];
#pragma unroll
    for (int ks = 0; ks < 4; ++ks) qf[ks] = *(const bf16x8*)(p.z() + (size_t)tok * INW + 2816 + h * 64 + ks * 16 + hh * 8);
    const bf16_t* kb = p.kvb() + (size_t)(b * 256 + swap23(l31)) * 512 + h * 64 + hh * 8;
    float m = -1e30f;
    f32x16 o0, o1;
#pragma unroll
    for (int r = 0; r < 16; ++r) { o0[r] = 0.f; o1[r] = 0.f; }
    float sum = 0.f;
    const bf16_t* vt = p.kvT() + ((size_t)(b * 4 + h) * 64 + l31) * 256 + 8 * hh;
    bf16x8 kf[4], vf[4];
#pragma unroll
    for (int ks = 0; ks < 4; ++ks) kf[ks] = *(const bf16x8*)(kb + ks * 16);
#pragma unroll
    for (int st = 0; st < 2; ++st) { vf[2 * st] = *(const bf16x8*)(vt + st * 16); vf[2 * st + 1] = *(const bf16x8*)(vt + 32 * 256 + st * 16); }
    for (int kt = 0; kt < 8; ++kt) {
        const int ktn = min(kt + 1, 7);
        bf16x8 kn[4], vn[4];
#pragma unroll
        for (int ks = 0; ks < 4; ++ks) kn[ks] = *(const bf16x8*)(kb + (size_t)ktn * 32 * 512 + ks * 16);
#pragma unroll
        for (int st = 0; st < 2; ++st) { vn[2 * st] = *(const bf16x8*)(vt + ktn * 32 + st * 16); vn[2 * st + 1] = *(const bf16x8*)(vt + 32 * 256 + ktn * 32 + st * 16); }
        f32x16 s;
#pragma unroll
        for (int r = 0; r < 16; ++r) s[r] = 0.f;
#pragma unroll
        for (int ks = 0; ks < 4; ++ks) s = __builtin_amdgcn_mfma_f32_32x32x16_bf16(kf[ks], qf[ks], s, 0, 0, 0);
        float tm = s[0];
#pragma unroll
        for (int r = 1; r < 16; ++r) tm = fmaxf(tm, s[r]);
        tm = fmaxf(tm, __shfl_xor(tm, 32));
        const float mn = fmaxf(m, tm);
        if (__any(mn > m)) {
            const float sc = __builtin_amdgcn_exp2f((m - mn) * 0.18033688011112042f);
            sum *= sc;
#pragma unroll
            for (int r = 0; r < 16; ++r) { o0[r] *= sc; o1[r] *= sc; }
        }
        m = mn;
        const float mb = mn * 0.18033688011112042f;
#pragma unroll
        for (int r = 0; r < 16; ++r) { s[r] = __builtin_amdgcn_exp2f(fmaf(s[r], 0.18033688011112042f, -mb)); sum += s[r]; }
#pragma unroll
        for (int st = 0; st < 2; ++st) {
            const bf16x8 pb = pack8(s, st * 8);
            o0 = __builtin_amdgcn_mfma_f32_32x32x16_bf16(vf[2 * st], pb, o0, 0, 0, 0);
            o1 = __builtin_amdgcn_mfma_f32_32x32x16_bf16(vf[2 * st + 1], pb, o1, 0, 0, 0);
        }
#pragma unroll
        for (int ks = 0; ks < 4; ++ks) kf[ks] = kn[ks];
#pragma unroll
        for (int q = 0; q < 4; ++q) vf[q] = vn[q];
    }
    sum += __shfl_xor(sum, 32);
    const float inv = 1.0f / sum;
    bf16_t* mo = p.mix() + (size_t)tok * D + 768 + h * 64 + 4 * hh;
#pragma unroll
    for (int g = 0; g < 4; ++g) {
        uint2 pk;
        pk.x = pack2(o0[4 * g] * inv, o0[4 * g + 1] * inv); pk.y = pack2(o0[4 * g + 2] * inv, o0[4 * g + 3] * inv);
        *(uint2*)(mo + 8 * g) = pk;
        pk.x = pack2(o1[4 * g] * inv, o1[4 * g + 1] * inv); pk.y = pack2(o1[4 * g + 2] * inv, o1[4 * g + 3] * inv);
        *(uint2*)(mo + 32 + 8 * g) = pk;
    }
}

struct NaCtx {
    const bf16_t* kbase; const bf16_t* vbase; const float* bh;
    int rs, r, c, c0, cb, hh;
    bf16x8 qf[4];
    float m, sum;
    f32x16 o0, o1;
};
template <int TI>
__device__ __forceinline__ void na_load(const NaCtx& x, bf16x8 (&kf)[4], bf16x8 (&vf)[4]) {
    constexpr int ip = TI / 3, cg = TI % 3;
    const bf16_t* kp = x.kbase + (size_t)(ip * 128 + cg * 16) * INW;
#pragma unroll
    for (int ks = 0; ks < 4; ++ks) kf[ks] = *(const bf16x8*)(kp + ks * 16);
    const bf16_t* vr = x.vbase + ip * 128 + cg * 16;
#pragma unroll
    for (int st = 0; st < 2; ++st) { vf[2 * st] = *(const bf16x8*)(vr + st * 64); vf[2 * st + 1] = *(const bf16x8*)(vr + (size_t)32 * T + st * 64); }
}
template <int TI>
__device__ __forceinline__ void na_comp(NaCtx& x, const bf16x8 (&kf)[4], const bf16x8 (&vf)[4]) {
    constexpr int ip = TI / 3, cg = TI % 3;
    f32x16 s;
#pragma unroll
    for (int q = 0; q < 16; ++q) s[q] = 0.f;
#pragma unroll
    for (int ks = 0; ks < 4; ++ks) s = __builtin_amdgcn_mfma_f32_32x32x16_bf16(kf[ks], x.qf[ks], s, 0, 0, 0);
    const int kc0 = x.cb + 16 * cg + 8 * x.hh;
    const float* brow = x.bh + (x.rs + 2 * ip - x.r + 7) * 31 + 15 - x.c + kc0;
    const int d0 = kc0 - x.c0;
    float tm = -1e30f;
    float bv[16];
#pragma unroll
    for (int q = 0; q < 16; ++q) bv[q] = brow[(q & 3) + 4 * ((q >> 2) & 1) + 31 * (q >> 3)];
#pragma unroll
    for (int q = 0; q < 16; ++q) asm volatile("" : "+v"(bv[q]));
#pragma unroll
    for (int q = 0; q < 16; ++q) {
        const int cq = (q & 3) + 4 * ((q >> 2) & 1);
        const bool valid = (unsigned)(d0 + cq) < 16u;
        const float sc = valid ? fmaf(s[q], 0.18033688011112042f, bv[q]) : -INFINITY;
        s[q] = sc;
        tm = fmaxf(tm, sc);
    }
    tm = fmaxf(tm, __shfl_xor(tm, 32));
    const float mn = fmaxf(x.m, tm);
    if (__any(mn > x.m)) {
        const float scl = __builtin_amdgcn_exp2f(x.m - mn);
        x.sum *= scl;
#pragma unroll
        for (int q = 0; q < 16; ++q) { x.o0[q] *= scl; x.o1[q] *= scl; }
    }
    x.m = mn;
#pragma unroll
    for (int q = 0; q < 16; ++q) { const float pe = __builtin_amdgcn_exp2f(s[q] - mn); s[q] = pe; x.sum += pe; }
#pragma unroll
    for (int st = 0; st < 2; ++st) {
        const bf16x8 pb = pack8(s, st * 8);
        x.o0 = __builtin_amdgcn_mfma_f32_32x32x16_bf16(vf[2 * st], pb, x.o0, 0, 0, 0);
        x.o1 = __builtin_amdgcn_mfma_f32_32x32x16_bf16(vf[2 * st + 1], pb, x.o1, 0, 0, 0);
    }
}

__device__ __forceinline__ void na_attn_wave(const Params& p, int wu, int lane, const float* sbias) {
    const int j = wu & 1, h = (wu >> 1) & 7, r = (wu >> 4) & 127, b = wu >> 11;
    const int l31 = lane & 31, hh = lane >> 5;
    NaCtx x;
    x.hh = hh; x.r = r;
    x.c = 32 * j + l31;
    x.c0 = min(max(x.c - 8, 0), 48); x.rs = min(max(r - 4, 0), 120);
    const int tokq = b * T + r * 64 + x.c;
    x.cb = 16 * j;
#pragma unroll
    for (int ks = 0; ks < 4; ++ks) x.qf[ks] = *(const bf16x8*)(p.z() + (size_t)tokq * INW + h * 64 + ks * 16 + hh * 8);
    x.bh = sbias + 64 + h * 465;
    const int kap = swap23(l31);
    x.kbase = p.z() + (size_t)(b * T + (x.rs + (kap >> 4)) * 64 + x.cb + (kap & 15)) * INW + 512 + h * 64 + hh * 8;
    x.vbase = p.vT() + ((size_t)(b * 8 + h) * 64 + l31) * T + x.rs * 64 + x.cb + 8 * hh;
    x.m = -1e30f; x.sum = 0.f;
#pragma unroll
    for (int q = 0; q < 16; ++q) { x.o0[q] = 0.f; x.o1[q] = 0.f; }
    bf16x8 k0[4], v0[4], k1[4], v1[4], k2[4], v2[4], k3[4], v3[4];
    na_load<0>(x, k0, v0); na_load<1>(x, k1, v1); na_load<2>(x, k2, v2);
    na_load<3>(x, k3, v3);  na_comp<0>(x, k0, v0);
    na_load<4>(x, k0, v0);  na_comp<1>(x, k1, v1);
    na_load<5>(x, k1, v1);  na_comp<2>(x, k2, v2);
    na_load<6>(x, k2, v2);  na_comp<3>(x, k3, v3);
    na_load<7>(x, k3, v3);  na_comp<4>(x, k0, v0);
    na_load<8>(x, k0, v0);  na_comp<5>(x, k1, v1);
    na_load<9>(x, k1, v1);  na_comp<6>(x, k2, v2);
    na_load<10>(x, k2, v2); na_comp<7>(x, k3, v3);
    na_load<11>(x, k3, v3); na_comp<8>(x, k0, v0);
    na_comp<9>(x, k1, v1);
    na_comp<10>(x, k2, v2);
    na_comp<11>(x, k3, v3);
    float sum = x.sum;
    sum += __shfl_xor(sum, 32);
    const float inv = 1.0f / sum;
    bf16_t* mo = p.mix() + (size_t)tokq * D + h * 64 + 4 * hh;
#pragma unroll
    for (int g = 0; g < 4; ++g) {
        uint2 pk;
        pk.x = pack2(x.o0[4 * g] * inv, x.o0[4 * g + 1] * inv); pk.y = pack2(x.o0[4 * g + 2] * inv, x.o0[4 * g + 3] * inv);
        *(uint2*)(mo + 8 * g) = pk;
        pk.x = pack2(x.o1[4 * g] * inv, x.o1[4 * g + 1] * inv); pk.y = pack2(x.o1[4 * g + 2] * inv, x.o1[4 * g + 3] * inv);
        *(uint2*)(mo + 32 + 8 * g) = pk;
    }
}

__device__ void phase_mixers(const Params& p, char* smem) {
    const int tid = VTID, lane = tid & 63, w = tid >> 6;
    {
        float* sbias = (float*)smem;
        __syncthreads();
        for (int i = tid; i < 8 * 465; i += 256) sbias[64 + i] = p.rpb[i] * 1.4426950408889634f;
        __syncthreads();
        for (int wu = VBID * 4 + w; wu < 8192; wu += VGRID * 4) na_attn_wave(p, wu, lane, sbias);
    }
    __syncthreads();
    hg_local(p, smem);
}

__device__ void phase_hg_scan(const Params& p) {
    const int tid = VTID;
    if (blockIdx.x < 16) return;
    for (int item = VBID - 32; item < 512; item += VGRID - 32) {
        const int g = item * 256 + tid;
        const int seq = g >> 12, kv = g & 4095, k = kv & 63;
        const int dir = seq & 1;
        float S = 0.f;
        for (int cc0 = 0; cc0 < 128; cc0 += 8) {
            float L[8], d[8];
#pragma unroll
            for (int u = 0; u < 8; ++u) {
                const int c = dir ? 127 - (cc0 + u) : cc0 + u;
                const size_t it = (size_t)seq * 128 + c;
                L[u] = p.hstate()[it * 4096 + kv];
                d[u] = p.hdec()[it * 64 + k];
            }
#pragma unroll
            for (int u = 0; u < 8; ++u) {
                const int c = dir ? 127 - (cc0 + u) : cc0 + u;
                const size_t it = (size_t)seq * 128 + c;
                ((float*)p.h())[it * 4096 + kv] = S;
                S = d[u] * S + L[u];
            }
        }
    }
}

__device__ void phase_hg_out(const Params& p, char* smem) {
    char* sQt = smem;
    char* sKt = smem + 9216;
    char* sQh = smem + 18432;
    char* sVT = smem + 27648;
    char* sST = smem + 36864;
    char* sP = smem + 46080;
    float* sTot = (float*)(smem + 55296);
    float* sSS = sTot + 256;
    const int tid = VTID, lane = tid & 63, w = tid >> 6;
    const int kcol = tid & 63, sq = tid >> 6;
    const int l31 = lane & 31, hh = lane >> 5;
    for (int item = VBID; item < 2048; item += VGRID) {
        const int c = item & 127, h = (item >> 7) & 3, b = item >> 9;
        const int tok0 = b * T + c * 64;
        __syncthreads();
        hg_load_vt(p, sVT, tok0, h, kcol, sq);
        float qv[16];
        {
            const bf16_t* zp = p.z() + (size_t)(tok0 + sq * 16) * INW + 1536 + h * 64 + kcol;
#pragma unroll
            for (int j = 0; j < 16; ++j) qv[j] = bf2f(zp[(size_t)j * INW]);
        }
        f32x16 accO;
#pragma unroll
        for (int r = 0; r < 16; ++r) accO[r] = 0.f;
        for (int dir = 0; dir < 2; ++dir) {
            float bj[16], kk[16];
            const float btot = hg_gates(p, sTot, tok0, h, dir, kcol, sq, bj, kk);
            const float bref = 0.5f * btot;
#pragma unroll
            for (int j = 0; j < 16; ++j) {
                const int s = sq * 16 + j;
                *(bf16_t*)(sQt + s * HRS + kcol * 2) = f2bf(qv[j] * __expf(bj[j] - bref));
                *(bf16_t*)(sKt + s * HRS + kcol * 2) = f2bf(kk[j] * __expf(bref - bj[j]));
                *(bf16_t*)(sQh + s * HRS + kcol * 2) = f2bf(qv[j] * __expf(bj[j]));
            }
            {
                const float* sp = (const float*)p.h() + ((size_t)(((b * 4 + h) * 2 + dir) * 128 + c)) * 4096;
#pragma unroll
                for (int i = 0; i < 4; ++i) {
                    const int idx = tid * 4 + 1024 * i;
                    const float4 v = *(const float4*)(sp + idx);
                    uint2 pk; pk.x = pack2(v.x, v.y); pk.y = pack2(v.z, v.w);
                    *(uint2*)(sST + (idx >> 6) * HRS + (idx & 63) * 2) = pk;
                }
            }
            __syncthreads();
            {
                const int si = w >> 1, ti = w & 1;
                const bool live = dir == 0 ? (si <= ti) : (si >= ti);
                f32x16 pt;
#pragma unroll
                for (int r = 0; r < 16; ++r) pt[r] = 0.f;
                if (live) pt = tile_mm64(sKt, sQt, si * 32, ti * 32, lane, pt);
                const int t = ti * 32 + l31;
#pragma unroll
                for (int g = 0; g < 4; ++g) {
                    const int s0 = si * 32 + 8 * g + 4 * hh;
                    float v0 = pt[4 * g], v1 = pt[4 * g + 1], v2 = pt[4 * g + 2], v3 = pt[4 * g + 3];
                    if (dir == 0) {
                        if (s0 > t) v0 = 0.f; if (s0 + 1 > t) v1 = 0.f; if (s0 + 2 > t) v2 = 0.f; if (s0 + 3 > t) v3 = 0.f;
                    } else {
                        if (s0 < t) v0 = 0.f; if (s0 + 1 < t) v1 = 0.f; if (s0 + 2 < t) v2 = 0.f; if (s0 + 3 < t) v3 = 0.f;
                    }
                    uint2 pk; pk.x = pack2(v0, v1); pk.y = pack2(v2, v3);
                    *(uint2*)(sP + t * HRS + s0 * 2) = pk;
                }
            }
            __syncthreads();
            {
                const int vi = w >> 1, ti = w & 1;
                accO = tile_mm64(sVT, sP, vi * 32, ti * 32, lane, accO);
                accO = tile_mm64(sST, sQh, vi * 32, ti * 32, lane, accO);
            }
            __syncthreads();
        }
        const int vi = w >> 1, ti = w & 1;
        float ssq = 0.f;
#pragma unroll
        for (int r = 0; r < 16; ++r) ssq += accO[r] * accO[r];
        ssq += __shfl_xor(ssq, 32);
        sSS[w * 64 + lane] = ssq;
        __syncthreads();
        const float tot = sSS[ti * 64 + l31] + sSS[(2 + ti) * 64 + l31];
        const float rs = rsqrtf(tot * (1.0f / 64.0f) + EPS);
        const int tok = tok0 + ti * 32 + l31;
#pragma unroll
        for (int g = 0; g < 4; ++g) {
            const int v0 = vi * 32 + 8 * g + 4 * hh;
            const uint2 gz = *(const uint2*)(p.z() + (size_t)tok * INW + 2560 + h * 64 + v0);
            const float4 gn = *(const float4*)(p.hg_g + h * 64 + v0);
            const float g0 = bflo(gz.x), g1 = bfhi(gz.x), g2 = bflo(gz.y), g3 = bfhi(gz.y);
            const float o0 = accO[4 * g] * rs * gn.x * (g0 / (1.0f + __expf(-g0)));
            const float o1 = accO[4 * g + 1] * rs * gn.y * (g1 / (1.0f + __expf(-g1)));
            const float o2 = accO[4 * g + 2] * rs * gn.z * (g2 / (1.0f + __expf(-g2)));
            const float o3 = accO[4 * g + 3] * rs * gn.w * (g3 / (1.0f + __expf(-g3)));
            uint2 pk; pk.x = pack2(o0, o1); pk.y = pack2(o2, o3);
            *(uint2*)(p.mix() + (size_t)tok * D + 512 + h * 64 + v0) = pk;
        }
    }
    for (int wu = VBID * 4 + w; wu < 4096; wu += VGRID * 4) mem_attn_wave(p, wu, lane);
}


__device__ __forceinline__ int ord_key(int fb) { return fb ^ ((fb >> 31) & 0x7FFFFFFF); }

template <int N>
__device__ __forceinline__ void bitonic_sort_desc(int (&v)[N]) {
#pragma unroll
    for (int k = 2; k <= N; k <<= 1) {
#pragma unroll
        for (int j = k >> 1; j > 0; j >>= 1) {
#pragma unroll
            for (int i = 0; i < N; ++i) {
                const int l = i ^ j;
                if (l > i) {
                    const bool desc = ((i & k) == 0);
                    const int a = v[i], b = v[l];
                    const int mx = max(a, b), mn = min(a, b);
                    v[i] = desc ? mx : mn;
                    v[l] = desc ? mn : mx;
                }
            }
        }
    }
}
template <int N>
__device__ __forceinline__ void bitonic_merge_desc(int (&v)[N]) {
#pragma unroll
    for (int j = N >> 1; j > 0; j >>= 1) {
#pragma unroll
        for (int i = 0; i < N; ++i) {
            const int l = i ^ j;
            if (l > i) {
                const int a = v[i], b = v[l];
                v[i] = max(a, b);
                v[l] = min(a, b);
            }
        }
    }
}
__device__ __forceinline__ void merge_prune16(int (&r)[16], const int (&o)[16]) {
#pragma unroll
    for (int i = 0; i < 16; ++i) r[i] = max(r[i], o[15 - i]);
    bitonic_merge_desc<16>(r);
}

__device__ void phase_route(const Params& p, char* smem) {
    char* sk = smem;
    const int tid = VTID, lane = tid & 63, w = tid >> 6;
    int* sA = (int*)(smem + 32768) + w * 2048;
    int* sB = (int*)(smem + 65536) + w * 512;
    const int tl = lane & 31, hh = lane >> 5;
    const int h = VBID & 7, tg0 = VBID >> 3, tgs = VGRID >> 3;
    for (int base = tg0; base < 256; base += 4 * tgs)
    for (int c = 0; c < 2; ++c) {
        const int hc = h * 2 + c;
        __syncthreads();
        {
            const bf16_t* sp = p.subk_b() + (size_t)hc * 16384;
#pragma unroll
            for (int i = 0; i < 8; ++i) {
                const int ch = tid + 256 * i;
                const int row = ch >> 4, cc = ch & 15;
                const uint4 v = *(const uint4*)(sp + row * 128 + cc * 8);
                *(uint4*)(sk + row * 256 + ((cc ^ (row & 15)) << 4)) = v;
            }
        }
        __syncthreads();
        for (int it = 0; it < 4; ++it) {
            const int tgp = base + it * tgs;
            if (tgp >= 256) break;
            const int tok = tgp * 128 + w * 32 + tl;
            int* sidx = sA + it * 512;
            bf16x8 qf[8];
            {
                const bf16_t* qr = p.z() + (size_t)tok * QW + hc * 128 + hh * 8;
#pragma unroll
                for (int ks = 0; ks < 8; ++ks) qf[ks] = *(const bf16x8*)(qr + ks * 16);
            }
            int cur[16];
#pragma unroll
            for (int kb = 0; kb < 4; ++kb) {
                f32x16 acc;
#pragma unroll
                for (int r = 0; r < 16; ++r) acc[r] = 0.f;
                const int row = kb * 32 + tl;
#pragma unroll
                for (int ks = 0; ks < 8; ++ks) {
                    const bf16x8 af = *(const bf16x8*)(sk + row * 256 + (((ks * 2 + hh) ^ (row & 15)) << 4));
                    acc = __builtin_amdgcn_mfma_f32_32x32x16_bf16(af, qf[ks], acc, 0, 0, 0);
                }
                int v[16];
#pragma unroll
                for (int r = 0; r < 16; ++r) {
                    const int key = kb * 32 + (r & 3) + 8 * (r >> 2) + 4 * hh;
                    const int fb = (__float_as_int(acc[r]) & ~127) | (127 - key);
                    v[r] = ord_key(fb);
                }
                bitonic_sort_desc<16>(v);
                if (kb == 0) {
#pragma unroll
                    for (int r = 0; r < 16; ++r) cur[r] = v[r];
                } else {
                    merge_prune16(cur, v);
                }
            }
            {
                int o[16];
#pragma unroll
                for (int r = 0; r < 16; ++r) o[r] = __shfl_xor(cur[r], 32);
                merge_prune16(cur, o);
            }
            if (c == 0) {
#pragma unroll
                for (int r = 0; r < 16; ++r) sidx[r * 32 + tl] = cur[r];
                continue;
            }
#pragma unroll
            for (int r = 0; r < 16; ++r) sB[r * 32 + tl] = cur[r];
        float va[16], vb[16];
#pragma unroll
        for (int r = 0; r < 16; ++r) {
            const int fa = ord_key(sidx[r * 32 + tl]), fb = ord_key(sB[r * 32 + tl]);
            va[r] = __int_as_float(fa & ~127);
            vb[r] = __int_as_float(fb & ~127);
        }
        int best[16];
#pragma unroll
        for (int j = 0; j < 16; ++j) best[j] = ord_key((__float_as_int(va[0] + vb[j]) & ~255) | (255 - j));
#pragma unroll
        for (int i = 1; i < 8; ++i) {
            const int n = 16 / (i + 1);
            int row[16];
#pragma unroll
            for (int j = 0; j < 16; ++j)
                row[j] = (j < n) ? ord_key((__float_as_int(va[i] + vb[j]) & ~255) | (255 - (i * 16 + j))) : (int)0x80000000;
            merge_prune16(best, row);
        }
        {
            int row[16];
#pragma unroll
            for (int j = 0; j < 16; ++j)
                row[j] = (j < 8) ? ord_key((__float_as_int(va[8 + j] + vb[0]) & ~255) | (255 - ((8 + j) * 16))) : (int)0x80000000;
            merge_prune16(best, row);
        }
        float sv[16];
        int pid[16];
#pragma unroll
        for (int r = 0; r < 16; ++r) {
            const int cb = ord_key(best[r]);
            sv[r] = __int_as_float(cb & ~255);
            pid[r] = 255 - (cb & 255);
        }
        float tot = 0.f;
        const float smax = sv[0];
#pragma unroll
        for (int r = 0; r < 16; ++r) { sv[r] = __expf(sv[r] - smax); tot += sv[r]; }
        const float inv = 1.0f / tot;
        if (hh == 0) {
#pragma unroll
            for (int r = 0; r < 16; ++r) {
                const int ia = 127 - (ord_key(sidx[(pid[r] >> 4) * 32 + tl]) & 127);
                const int ib = 127 - (ord_key(sB[(pid[r] & 15) * 32 + tl]) & 127);
                const int pos = (r & 7) * 16 + h * 2 + (r >> 3);
                p.eidx()[(size_t)tok * 128 + pos] = (unsigned short)(ia * 128 + ib);
                p.gate()[(size_t)tok * 128 + pos] = sv[r] * inv;
            }
        }
        }
    }
}

constexpr int PEER_TG = 512;
constexpr int PEER_TPW = PEER_TG / 8;
constexpr int PEER_NTG = NTOK / PEER_TG;
constexpr int PEER_NCH = 8;

#define PEER_G1(base, wv, hi) (*(const uint4*)((base) + (size_t)((hi) ? ((wv) >> 16) : ((wv) & 0xFFFFu)) * 128))
#define PEER_GATHER16(dst, base, ia, ib)                                                             \
    dst[0] = PEER_G1(base, (ia).x, 0);  dst[1] = PEER_G1(base, (ia).x, 1);  dst[2] = PEER_G1(base, (ia).y, 0);  dst[3] = PEER_G1(base, (ia).y, 1);   \
    dst[4] = PEER_G1(base, (ia).z, 0);  dst[5] = PEER_G1(base, (ia).z, 1);  dst[6] = PEER_G1(base, (ia).w, 0);  dst[7] = PEER_G1(base, (ia).w, 1);   \
    dst[8] = PEER_G1(base, (ib).x, 0);  dst[9] = PEER_G1(base, (ib).x, 1);  dst[10] = PEER_G1(base, (ib).y, 0); dst[11] = PEER_G1(base, (ib).y, 1);  \
    dst[12] = PEER_G1(base, (ib).z, 0); dst[13] = PEER_G1(base, (ib).z, 1); dst[14] = PEER_G1(base, (ib).w, 0); dst[15] = PEER_G1(base, (ib).w, 1);

__device__ __forceinline__ unsigned quant4(float a, float b, float c, float d, float qs) {
    const int q0 = (int)rintf(__builtin_amdgcn_fmed3f(a * qs, -127.f, 127.f)), q1 = (int)rintf(__builtin_amdgcn_fmed3f(b * qs, -127.f, 127.f));
    const int q2 = (int)rintf(__builtin_amdgcn_fmed3f(c * qs, -127.f, 127.f)), q3 = (int)rintf(__builtin_amdgcn_fmed3f(d * qs, -127.f, 127.f));
    return (unsigned)(q0 & 255) | ((unsigned)(q1 & 255) << 8) | ((unsigned)(q2 & 255) << 16) | ((unsigned)(q3 & 255) << 24);
}
template <int CTRL>
__device__ __forceinline__ int dpp_movi(int v) { return __builtin_amdgcn_update_dpp(0, v, CTRL, 0xf, 0xf, true); }

struct DotTok { uint4 ia, ib; uint4 ha, hb; float hm; };
__device__ __forceinline__ void dots_load(const Params& p, DotTok& t, int tok, int c, int g, int d8) {
    const uint4* idp = (const uint4*)(p.eidx() + (size_t)tok * 128 + g * 16);
    t.ia = idp[0]; t.ib = idp[1];
    const uint4* hp = (const uint4*)(p.h() + (size_t)tok * D + c * 128 + d8 * 16);
    t.ha = hp[0]; t.hb = hp[1];
    t.hm = __uint_as_float(p.hmax()[tok]);
}
__device__ __forceinline__ void dotsf_load(const Params& p, DotTok& t, int tokb, int s, int g, int d8) {
    dots_load(p, t, tokb + 8 * (s & 15), s >> 4, g, d8);
}
__device__ __forceinline__ void dotsf_finish(const uint4 (&uu)[16], const DotTok& t, int* part, int g, int d8) {
    const float qs = t.hm > 0.f ? 127.0f / t.hm : 0.f;
    const int h0 = (int)quant4(bflo(t.ha.x), bfhi(t.ha.x), bflo(t.ha.y), bfhi(t.ha.y), qs);
    const int h1 = (int)quant4(bflo(t.ha.z), bfhi(t.ha.z), bflo(t.ha.w), bfhi(t.ha.w), qs);
    const int h2 = (int)quant4(bflo(t.hb.x), bfhi(t.hb.x), bflo(t.hb.y), bfhi(t.hb.y), qs);
    const int h3 = (int)quant4(bflo(t.hb.z), bfhi(t.hb.z), bflo(t.hb.w), bfhi(t.hb.w), qs);
    int acc[16];
#pragma unroll
    for (int i = 0; i < 16; ++i) {
        int a = __builtin_amdgcn_sdot4((int)uu[i].x, h0, 0, false);
        a = __builtin_amdgcn_sdot4((int)uu[i].y, h1, a, false);
        a = __builtin_amdgcn_sdot4((int)uu[i].z, h2, a, false);
        a = __builtin_amdgcn_sdot4((int)uu[i].w, h3, a, false);
        a += dpp_movi<DPP_QP_X1>(a);
        a += dpp_movi<DPP_QP_X2>(a);
        a += dpp_movi<DPP_HMIRROR>(a);
        acc[i] = a;
    }
    if (d8 == 0) {
        int4* dst = (int4*)(part + g * 16);
#pragma unroll
        for (int q = 0; q < 4; ++q) {
            int4 v = dst[q];
            v.x += acc[4 * q]; v.y += acc[4 * q + 1]; v.z += acc[4 * q + 2]; v.w += acc[4 * q + 3];
            dst[q] = v;
        }
    }
}

__device__ __forceinline__ float gelu_erf(float v);

__device__ void phase_peer_dots(const Params& p, char* smem) {
    const int tid = threadIdx.x, lane = tid & 63, w = tid >> 6;
    const int g = lane >> 3, d8 = lane & 7;
    int* part = (int*)smem + w * 2048;
    for (int tgp = blockIdx.x; tgp < NTOK / 128; tgp += gridDim.x) {
        const int tokb = tgp * 128 + w;
        __syncthreads();
        for (int i = lane; i < 2048; i += 64) part[i] = 0;
        __syncthreads();
        const char* ubase = (const char*)p.u_c() + d8 * 16;
        DotTok ta, tb, tn;
        uint4 ua[16], ubuf[16];
        dotsf_load(p, ta, tokb, 0, g, d8);
        dotsf_load(p, tb, tokb, 1, g, d8);
        PEER_GATHER16(ua, ubase, ta.ia, ta.ib)
        PEER_GATHER16(ubuf, ubase, tb.ia, tb.ib)
        dotsf_load(p, tn, tokb, 2, g, d8);
        for (int s = 0; s < 128; s += 2) {
            dotsf_finish(ua, ta, part + (s & 15) * 128, g, d8);
            if (s + 2 < 128) {
                ta = tn;
                const char* ub = ubase + (size_t)((s + 2) >> 4) * 16384 * 128;
                PEER_GATHER16(ua, ub, ta.ia, ta.ib)
                dotsf_load(p, tn, tokb, min(s + 3, 127), g, d8);
            }
            dotsf_finish(ubuf, tb, part + ((s + 1) & 15) * 128, g, d8);
            if (s + 3 < 128) {
                tb = tn;
                const char* ub = ubase + (size_t)((s + 3) >> 4) * 16384 * 128;
                PEER_GATHER16(ubuf, ub, tb.ia, tb.ib)
                dotsf_load(p, tn, tokb, min(s + 4, 127), g, d8);
            }
        }
        __syncthreads();
        for (int k0 = 0; k0 < 16; k0 += 4) {
            int ps[4][2], e[4][2];
            float gt[4][2], sh[4];
#pragma unroll
            for (int q = 0; q < 4; ++q) {
                const int tok = tokb + 8 * (k0 + q);
                sh[q] = __uint_as_float(p.hmax()[tok]) * (1.0f / 127.0f) * rsqrtf(p.ss1()[tok] * (1.0f / 1024.0f) + EPS);
#pragma unroll
                for (int u = 0; u < 2; ++u) {
                    const int slot = lane + 64 * u;
                    ps[q][u] = part[(k0 + q) * 128 + slot];
                    e[q][u] = p.eidx()[(size_t)tok * 128 + slot];
                    gt[q][u] = p.gate()[(size_t)tok * 128 + slot];
                }
            }
            float su[4][2], sv[4][2];
#pragma unroll
            for (int q = 0; q < 4; ++q)
#pragma unroll
                for (int u = 0; u < 2; ++u) { su[q][u] = p.scale_u()[e[q][u]]; sv[q][u] = p.scale_v()[e[q][u]]; }
#pragma unroll
            for (int q = 0; q < 4; ++q) {
                const int tok = tokb + 8 * (k0 + q);
                float cf[2];
#pragma unroll
                for (int u = 0; u < 2; ++u) cf[u] = gelu_erf((float)ps[q][u] * su[q][u] * sh[q]) * gt[q][u] * sv[q][u];
                const float cm = wave_max(fmaxf(fabsf(cf[0]), fabsf(cf[1])));
                const float qs = cm > 0.f ? 127.0f / cm : 0.f;
                p.coef()[(size_t)tok * 128 + lane] = (signed char)(int)rintf(cf[0] * qs);
                p.coef()[(size_t)tok * 128 + lane + 64] = (signed char)(int)rintf(cf[1] * qs);
                if (lane == 0) p.csum()[tok] = cm * (1.0f / 127.0f);
            }
        }
    }
}

__device__ __forceinline__ float gelu_erf(float v) {
    const float av = fabsf(v);
    const float t = __builtin_amdgcn_rcpf(fmaf(av, 0.2316418882f, 1.0f));
    float q = fmaf(t, 0.5307027145f, -0.7265760135f);
    q = fmaf(q, t, 0.7107068705f);
    q = fmaf(q, t, -0.142248368f);
    q = fmaf(q, t, 0.127414796f);
    q = q * t;
    const float e = __builtin_amdgcn_exp2f(v * v * -0.72134752044f);
    const float m = v * (q * e);
    return v < 0.f ? m : v - m;
}
struct AccTok { uint4 ia, ib; uint4 cq; float cs; };
__device__ __forceinline__ void acc_load(const Params& p, AccTok& t, int tok, int g) {
    const uint4* idp = (const uint4*)(p.eidx() + (size_t)tok * 128 + g * 16);
    t.ia = idp[0]; t.ib = idp[1];
    t.cq = *(const uint4*)(p.coef() + (size_t)tok * 128 + g * 16);
    t.cs = p.csum()[tok];
}
#define PEER_T4DOT(acc, B, r0, r1, r2, r3, cq)                                   \
    {                                                                            \
        const unsigned t0 = __builtin_amdgcn_perm(r1, r0, 0x05010400u), t1 = __builtin_amdgcn_perm(r1, r0, 0x07030602u); \
        const unsigned t2 = __builtin_amdgcn_perm(r3, r2, 0x05010400u), t3 = __builtin_amdgcn_perm(r3, r2, 0x07030602u); \
        acc[(B) + 0] = __builtin_amdgcn_sdot4((int)__builtin_amdgcn_perm(t2, t0, 0x05040100u), (int)(cq), acc[(B) + 0], false); \
        acc[(B) + 1] = __builtin_amdgcn_sdot4((int)__builtin_amdgcn_perm(t2, t0, 0x07060302u), (int)(cq), acc[(B) + 1], false); \
        acc[(B) + 2] = __builtin_amdgcn_sdot4((int)__builtin_amdgcn_perm(t3, t1, 0x05040100u), (int)(cq), acc[(B) + 2], false); \
        acc[(B) + 3] = __builtin_amdgcn_sdot4((int)__builtin_amdgcn_perm(t3, t1, 0x07060302u), (int)(cq), acc[(B) + 3], false); \
    }
__device__ __forceinline__ void accf_finish(const uint4 (&vv)[16], const AccTok& t, char* rowp, int g) {
    const unsigned cw[4] = {t.cq.x, t.cq.y, t.cq.z, t.cq.w};
    int acc[16];
#pragma unroll
    for (int j = 0; j < 16; ++j) acc[j] = 0;
#pragma unroll
    for (int j = 0; j < 4; ++j) {
        PEER_T4DOT(acc, 0, vv[4 * j].x, vv[4 * j + 1].x, vv[4 * j + 2].x, vv[4 * j + 3].x, cw[j])
        PEER_T4DOT(acc, 4, vv[4 * j].y, vv[4 * j + 1].y, vv[4 * j + 2].y, vv[4 * j + 3].y, cw[j])
        PEER_T4DOT(acc, 8, vv[4 * j].z, vv[4 * j + 1].z, vv[4 * j + 2].z, vv[4 * j + 3].z, cw[j])
        PEER_T4DOT(acc, 12, vv[4 * j].w, vv[4 * j + 1].w, vv[4 * j + 2].w, vv[4 * j + 3].w, cw[j])
    }
    float o[16];
#pragma unroll
    for (int j = 0; j < 16; ++j) {
        int v = acc[j];
        v += dpp_movi<DPP_ROR8>(v);
        v += __shfl_xor(v, 16);
        v += __shfl_xor(v, 32);
        o[j] = (float)v * t.cs;
    }
    if (g == 0) {
        uint4 w0, w1;
        w0.x = pack2(o[0], o[1]); w0.y = pack2(o[2], o[3]); w0.z = pack2(o[4], o[5]); w0.w = pack2(o[6], o[7]);
        w1.x = pack2(o[8], o[9]); w1.y = pack2(o[10], o[11]); w1.z = pack2(o[12], o[13]); w1.w = pack2(o[14], o[15]);
        uint4* dst = (uint4*)rowp;
        dst[0] = w0; dst[1] = w1;
    }
}

__device__ void phase_peer_accum(const Params& p, char* smem) {
    const int tid = threadIdx.x, lane = tid & 63, w = tid >> 6;
    const int g = lane >> 3, d8 = lane & 7;
    char* rowbuf = smem + w * 16384;
    for (int tgp = blockIdx.x; tgp < NTOK / 64; tgp += gridDim.x) {
        const int tokb = tgp * 64 + w;
        __syncthreads();
        const char* vbase = (const char*)p.v_c() + d8 * 16;
        AccTok ta, tb, tn;
        uint4 va[16], vbuf[16];
        acc_load(p, ta, tokb, g);
        acc_load(p, tb, tokb + 8, g);
        PEER_GATHER16(va, vbase, ta.ia, ta.ib)
        PEER_GATHER16(vbuf, vbase, tb.ia, tb.ib)
        acc_load(p, tn, tokb + 16, g);
        for (int s = 0; s < 64; s += 2) {
            accf_finish(va, ta, rowbuf + (s & 7) * 2048 + (s >> 3) * 256 + d8 * 32, g);
            if (s + 2 < 64) {
                ta = tn;
                const char* vb = vbase + (size_t)((s + 2) >> 3) * 16384 * 128;
                PEER_GATHER16(va, vb, ta.ia, ta.ib)
                acc_load(p, tn, tokb + 8 * (min(s + 3, 63) & 7), g);
            }
            accf_finish(vbuf, tb, rowbuf + ((s + 1) & 7) * 2048 + ((s + 1) >> 3) * 256 + d8 * 32, g);
            if (s + 3 < 64) {
                tb = tn;
                const char* vb = vbase + (size_t)((s + 3) >> 3) * 16384 * 128;
                PEER_GATHER16(vbuf, vb, tb.ia, tb.ib)
                acc_load(p, tn, tokb + 8 * (min(s + 4, 63) & 7), g);
            }
        }
        __syncthreads();
        for (int k0 = 0; k0 < 8; k0 += 2) {
            float4 v[2][4];
#pragma unroll
            for (int q = 0; q < 2; ++q) {
                const float* orow = p.out + (size_t)(tokb + 8 * (k0 + q)) * D;
#pragma unroll
                for (int j = 0; j < 4; ++j) v[q][j] = *(const float4*)(orow + (j * 64 + lane) * 4);
            }
#pragma unroll
            for (int q = 0; q < 2; ++q) {
                float* orow = p.out + (size_t)(tokb + 8 * (k0 + q)) * D;
                const char* prow = rowbuf + (k0 + q) * 2048;
                float ss = 0.f;
#pragma unroll
                for (int j = 0; j < 4; ++j) {
                    const uint2 pk = *(const uint2*)(prow + (j * 64 + lane) * 8);
                    v[q][j].x += bflo(pk.x); v[q][j].y += bfhi(pk.x); v[q][j].z += bflo(pk.y); v[q][j].w += bfhi(pk.y);
                    ss += v[q][j].x * v[q][j].x + v[q][j].y * v[q][j].y + v[q][j].z * v[q][j].z + v[q][j].w * v[q][j].w;
                }
                ss = wave_sum(ss);
                const float rs = rsqrtf(ss * (1.0f / 1024.0f) + EPS);
#pragma unroll
                for (int j = 0; j < 4; ++j) {
                    const float4 gg = *(const float4*)(p.fin_g + (j * 64 + lane) * 4);
                    float4 o;
                    o.x = v[q][j].x * rs * gg.x; o.y = v[q][j].y * rs * gg.y; o.z = v[q][j].z * rs * gg.z; o.w = v[q][j].w * rs * gg.w;
                    *(float4*)(orow + (j * 64 + lane) * 4) = o;
                }
            }
        }
    }
}

#define XB_TMO      128
#define XB_XCNT(j)  (256  + 64 * (j))
#define XB_XSUB(j)  (1280 + 64 * (j))
#define XB_XGEN(j)  (2304 + 64 * (j))
#define XB_TOP      3328
#define XB_TOPGEN   3392
#define XCD_BAR_WORDS 3456
#define XB_SPIN_CAP (1u << 18)
__device__ __forceinline__ unsigned xb_ld(unsigned* p)              { return __hip_atomic_load(p, __ATOMIC_RELAXED, __HIP_MEMORY_SCOPE_AGENT); }
__device__ __forceinline__ unsigned xb_add(unsigned* p, unsigned v) { return __hip_atomic_fetch_add(p, v, __ATOMIC_RELAXED, __HIP_MEMORY_SCOPE_AGENT); }
#define XB_SPIN(cond, bar) do { unsigned _sp = 0; while (cond) { __builtin_amdgcn_s_sleep(1); \
    if ((++_sp & 255u) == 0u) { if (xb_ld(&(bar)[XB_TMO])) break; if (_sp > XB_SPIN_CAP) { atomicAdd(&(bar)[XB_TMO], 1u); break; } } } } while (0)

struct XcdBarrier { unsigned* bar; unsigned x; volatile unsigned* st; };

__device__ __forceinline__ XcdBarrier xcd_barrier_post(unsigned* bar, volatile unsigned* st) {
    XcdBarrier b; b.bar = bar; b.x = xcc_id(); b.st = st;
    if (threadIdx.x == 0) (void)xb_add(&bar[XB_XCNT(b.x)], 1u);
    return b;
}
__device__ __forceinline__ void xcd_barrier_complete(unsigned* bar, unsigned x, unsigned& nloc, unsigned& nx) {
    const unsigned G = gridDim.x * gridDim.y * gridDim.z;
    unsigned sum, cnt, mine, sp = 0u;
    for (;;) {
        sum = 0u; cnt = 0u; mine = 0u;
#pragma unroll
        for (unsigned j = 0; j < 16; ++j) { const unsigned c = xb_ld(&bar[XB_XCNT(j)]); sum += c; cnt += (c > 0u) ? 1u : 0u; mine = (j == x) ? c : mine; }
        if (sum == G) break;
        __builtin_amdgcn_s_sleep(1);
        if ((++sp & 255u) == 0u) { if (xb_ld(&bar[XB_TMO])) break; if (sp > XB_SPIN_CAP) { atomicAdd(&bar[XB_TMO], 1u); break; } }
    }
    nloc = mine > 0u ? mine : 1u; nx = cnt > 0u ? cnt : 1u;
}
__device__ __forceinline__ void xcd_barrier(const XcdBarrier& b) {
    asm volatile("s_waitcnt vmcnt(0)" ::: "memory");
    __syncthreads();
    if (threadIdx.x == 0) {
        unsigned* bar = b.bar;
        __builtin_amdgcn_s_waitcnt(0);
        unsigned nloc = b.st[0], nx = b.st[1];
        if (nloc == 0u) { xcd_barrier_complete(bar, b.x, nloc, nx); b.st[0] = nloc; b.st[1] = nx; }
        const unsigned old = xb_add(&bar[XB_XSUB(b.x)], 1u);
        const unsigned gen = old / nloc;
        if (old + 1u == (gen + 1u) * nloc) {
            __builtin_amdgcn_fence(__ATOMIC_RELEASE, "agent");
            asm volatile("s_waitcnt vmcnt(0)" ::: "memory");
            const unsigned og = xb_add(&bar[XB_TOP], 1u);
            const unsigned tg = og / nx;
            if (og + 1u == (tg + 1u) * nx) xb_add(&bar[XB_TOPGEN], 1u);
            else XB_SPIN(xb_ld(&bar[XB_TOPGEN]) == tg, bar);
            __builtin_amdgcn_fence(__ATOMIC_ACQUIRE, "agent");
            xb_add(&bar[XB_XGEN(b.x)], 1u);
            asm volatile("s_waitcnt vmcnt(0)" ::: "memory");
        } else {
            XB_SPIN(xb_ld(&bar[XB_XGEN(b.x)]) == gen, bar);
            __builtin_amdgcn_fence(__ATOMIC_ACQUIRE, "agent");
            asm volatile("s_waitcnt vmcnt(0)" ::: "memory");
        }
    }
    __syncthreads();
}

#define RUN_PHASE(K, CALL)                                              \
    if (ph_lo <= (K) && (K) < ph_hi) {                                  \
        CALL;                                                           \
        if (COOP) { if ((K) + 1 < ph_hi) { xcd_barrier(xb); } } \
    }

template <bool COOP>
__global__ void __launch_bounds__(512, 2) fwd_kernel(Params p, int ph_lo, int ph_hi) {
    __shared__ __attribute__((aligned(16))) char smem[SMEM_BYTES + 16];
    char* smh = smem + VHB * HALF_SMEM;
    XcdBarrier xb;
    if (COOP) {
        if (threadIdx.x == 0) *(uint4*)(smem + SMEM_BYTES) = make_uint4(0u, 0u, 0u, 0u);
        __syncthreads();
        xb = xcd_barrier_post(p.bar(), (volatile unsigned*)(smem + SMEM_BYTES));
    }
    if (COOP) { if (ph_lo < 0) cg::this_grid().sync(); }
    RUN_PHASE(0, phase_prep(p, smh))
    RUN_PHASE(1, phase_gemm_in(p, smem))
    RUN_PHASE(2, phase_mixers(p, smh))
    RUN_PHASE(3, (phase_gemm_kv(p, smh), phase_hg_scan(p)))
    RUN_PHASE(4, phase_hg_out(p, smh))
    RUN_PHASE(5, phase_gemm_out(p, smem))
    RUN_PHASE(7, phase_gemm_q(p, smem))
    RUN_PHASE(8, phase_route(p, smh))
    RUN_PHASE(10, phase_peer_dots(p, smem))
    RUN_PHASE(12, phase_peer_accum(p, smem))
}

extern "C" void kernel_launch(void* const* d_in, const int* in_sizes, int n_in, void* d_out, int out_size, void* d_ws, size_t ws_size,
                              hipStream_t stream) {
    Params p{};
    p.x = (const float*)d_in[0]; p.mem = (const float*)d_in[1]; p.attn_g = (const float*)d_in[2]; p.w_in = (const float*)d_in[3];
    p.rpb = (const float*)d_in[4]; p.hg_lb = (const float*)d_in[5]; p.hg_g = (const float*)d_in[6]; p.mem_g = (const float*)d_in[7];
    p.w_kv = (const float*)d_in[8]; p.w_out = (const float*)d_in[9]; p.ffn_g = (const float*)d_in[10]; p.w_q = (const float*)d_in[11];
    p.subk = (const float*)d_in[12]; p.pu = (const float*)d_in[13]; p.pv = (const float*)d_in[14]; p.fin_g = (const float*)d_in[15];
    p.out = (float*)d_out;
    p.ws = (char*)d_ws;
    if (WS_TOTAL > ws_size) { fprintf(stderr, "workspace too small: need %zu have %zu\n", (size_t)WS_TOTAL, ws_size); return; }

#if defined(MULTI_LAUNCH)
    for (int ph = 0; ph < NPHASE; ++ph) fwd_kernel<false><<<dim3(512), dim3(512), 0, stream>>>(p, ph, ph + 1);
#else
    static int grid_blocks = 0;
    if (!grid_blocks) {
        int dev = 0, cus = 0, per_cu = 0;
        hipGetDevice(&dev);
        hipDeviceGetAttribute(&cus, hipDeviceAttributeMultiprocessorCount, dev);
        hipOccupancyMaxActiveBlocksPerMultiprocessor(&per_cu, fwd_kernel<true>, 512, 0);
        if (per_cu > 1) per_cu = 1;
        grid_blocks = (cus * per_cu) & ~3;
    }
    (void)hipMemsetAsync((char*)d_ws + OFF_BAR, 0, XCD_BAR_WORDS * 4, stream);
    int lo = 0, hi = NPHASE;
    void* args[] = {&p, &lo, &hi};
    hipError_t e = hipLaunchCooperativeKernel((void*)fwd_kernel<true>, dim3(grid_blocks), dim3(512), args, 0, stream);
    if (e != hipSuccess) fprintf(stderr, "cooperative launch failed: %s (grid %d)\n", hipGetErrorString(e), grid_blocks);
#endif
}
```

```cpp
#include <hip/hip_runtime.h>
#include <hip/hip_cooperative_groups.h>
#include <stdint.h>
#include <cstdio>

namespace cg = cooperative_groups;

#define VTID ((int)(threadIdx.x & 255))
#define VHB ((int)(threadIdx.x >> 8))
#define VBID ((int)(blockIdx.x * 2 + (threadIdx.x >> 8)))
#define VGRID ((int)(gridDim.x * 2))
constexpr int HALF_SMEM = 73728;

typedef unsigned short bf16_t;
typedef short bf16x8 __attribute__((ext_vector_type(8)));
typedef float f32x4 __attribute__((ext_vector_type(4)));

constexpr int D = 1024;
constexpr int NB = 4;
constexpr int T = 8192;
constexpr int NTOK = NB * T;
constexpr int INW = 3072;
constexpr int QW = 2048;
constexpr float EPS = 1e-6f;
constexpr int SMEM_BYTES = 2 * 73728;
constexpr int NPHASE = 14;

constexpr size_t al256(size_t x) { return (x + 255) & ~(size_t)255; }
constexpr size_t OFF_W_IN_T = 0;
constexpr size_t OFF_W_OUT_T = OFF_W_IN_T + al256((size_t)3072 * 1024 * 2);
constexpr size_t OFF_W_Q_T = OFF_W_OUT_T + al256((size_t)1024 * 1024 * 2);
constexpr size_t OFF_W_KV_T = OFF_W_Q_T + al256((size_t)2048 * 1024 * 2);
constexpr size_t OFF_H = OFF_W_KV_T + al256((size_t)512 * 1024 * 2);
constexpr size_t OFF_Z = OFF_H + al256((size_t)32768 * 1024 * 2);
constexpr size_t OFF_MIX = OFF_Z + al256((size_t)32768 * 3072 * 2);
constexpr size_t OFF_MEMN = OFF_MIX + al256((size_t)32768 * 1024 * 2);
constexpr size_t OFF_KVB = OFF_MEMN + al256((size_t)1024 * 1024 * 2);
constexpr size_t OFF_LB = OFF_KVB + al256((size_t)1024 * 512 * 2);
constexpr size_t OFF_HSTATE = OFF_LB + al256(512 * 4);
constexpr size_t OFF_HDEC = OFF_HSTATE + al256((size_t)4096 * 4096 * 4);
constexpr size_t OFF_UC = OFF_HDEC + al256((size_t)4096 * 64 * 4);
constexpr size_t OFF_VC = OFF_UC + al256((size_t)16384 * 1024);
constexpr size_t OFF_QUEUE = OFF_VC + al256((size_t)16384 * 1024);
constexpr size_t OFF_SUBK = OFF_QUEUE + al256(2048 * 4);
constexpr size_t OFF_BAR = OFF_SUBK + al256((size_t)16 * 128 * 128 * 2);
constexpr size_t OFF_SS1 = OFF_BAR + al256(4096 * 4);
constexpr size_t OFF_HMAX = OFF_SS1 + al256((size_t)32768 * 4);
constexpr size_t OFF_CSUM = OFF_HMAX + al256((size_t)32768 * 4);
constexpr size_t OFF_SCALE_U = OFF_CSUM + al256((size_t)32768 * 4);
constexpr size_t OFF_SCALE_V = OFF_SCALE_U + al256(16384 * 4);
constexpr size_t OFF_VT = OFF_SCALE_V + al256(16384 * 4);
constexpr size_t OFF_KVT = OFF_VT + al256((size_t)32768 * 512 * 2);
constexpr size_t WS_TOTAL = OFF_KVT + al256((size_t)1024 * 256 * 2);
constexpr size_t OFF_EIDX = OFF_HSTATE;
constexpr size_t OFF_GATE = OFF_HSTATE + (size_t)32768 * 128 * 4;
constexpr size_t OFF_COEF = OFF_HSTATE + (size_t)32768 * 128 * 8;
constexpr size_t OFF_SS = OFF_HSTATE + (size_t)32768 * 128 * 12;
constexpr size_t OFF_PARTIAL = OFF_Z;
constexpr size_t OFF_PEER_OUT = OFF_Z + (size_t)8 * 32768 * 128 * 4;

struct Params {
    const float *x, *mem, *attn_g, *w_in, *rpb, *hg_lb, *hg_g, *mem_g, *w_kv, *w_out, *ffn_g, *w_q, *subk, *pu, *pv, *fin_g;
    float* out;
    char* ws;
#define WSF(type, name, off) __device__ __forceinline__ type* name() const { return (type*)(ws + (off)); }
    WSF(bf16_t, w_in_t, OFF_W_IN_T) WSF(bf16_t, w_out_t, OFF_W_OUT_T) WSF(bf16_t, w_q_t, OFF_W_Q_T) WSF(bf16_t, w_kv_t, OFF_W_KV_T)
    WSF(bf16_t, h, OFF_H)
    WSF(bf16_t, z, OFF_Z)
    WSF(bf16_t, mix, OFF_MIX)
    WSF(bf16_t, memn, OFF_MEMN)
    WSF(bf16_t, kvb, OFF_KVB)
    WSF(float, lb, OFF_LB)
    WSF(float, hstate, OFF_HSTATE)
    WSF(float, hdec, OFF_HDEC)
    WSF(unsigned short, eidx, OFF_EIDX)
    WSF(float, gate, OFF_GATE)
    WSF(signed char, coef, OFF_COEF)
    WSF(bf16_t, x1b, OFF_PEER_OUT)
    WSF(float, ss, OFF_SS)
    WSF(float, partial, OFF_PARTIAL)
    WSF(bf16_t, u_c, OFF_UC) WSF(bf16_t, v_c, OFF_VC)
    WSF(unsigned, queue, OFF_QUEUE)
    WSF(bf16_t, subk_b, OFF_SUBK)
    WSF(unsigned, bar, OFF_BAR)
    WSF(float, ss1, OFF_SS1) WSF(unsigned, hmax, OFF_HMAX) WSF(float, csum, OFF_CSUM)
    WSF(float, scale_u, OFF_SCALE_U) WSF(float, scale_v, OFF_SCALE_V)
    WSF(bf16_t, vT, OFF_VT)
    WSF(bf16_t, kvT, OFF_KVT)
#undef WSF
};

__device__ __forceinline__ float bf2f(bf16_t v) { return __uint_as_float(((unsigned)v) << 16); }
__device__ __forceinline__ bf16_t f2bf(float f) {
    unsigned u = __float_as_uint(f);
    u += 0x7FFFu + ((u >> 16) & 1u);
    return (bf16_t)(u >> 16);
}
__device__ __forceinline__ float bflo(unsigned u) { return __uint_as_float(u << 16); }
__device__ __forceinline__ float bfhi(unsigned u) { return __uint_as_float(u & 0xFFFF0000u); }
typedef __bf16 bf16x2v_t __attribute__((ext_vector_type(2)));
typedef float f32x2v_t __attribute__((ext_vector_type(2)));
__device__ __forceinline__ unsigned pack2(float a, float b) {
    const f32x2v_t v = {a, b};
    return __builtin_bit_cast(unsigned, __builtin_convertvector(v, bf16x2v_t));
}

__device__ __forceinline__ float wave_sum(float v) {
#pragma unroll
    for (int o = 32; o; o >>= 1) v += __shfl_xor(v, o);
    return v;
}
__device__ __forceinline__ float wave_max(float v) {
#pragma unroll
    for (int o = 32; o; o >>= 1) v = fmaxf(v, __shfl_xor(v, o));
    return v;
}


typedef __bf16 bf16x2_t __attribute__((ext_vector_type(2)));
template <int CTRL>
__device__ __forceinline__ float dpp_mov(float v) {
    return __builtin_bit_cast(float, __builtin_amdgcn_update_dpp(0, __builtin_bit_cast(int, v), CTRL, 0xf, 0xf, true));
}
#define DPP_QP_X1 0xB1
#define DPP_QP_X2 0x4E
#define DPP_HMIRROR 0x141
#define DPP_ROR8 0x128
__device__ __forceinline__ unsigned xcc_id() { return (unsigned)__builtin_amdgcn_s_getreg((3 << 11) | 20) & 0xFu; }

__device__ __forceinline__ void transpose_tile(const float* __restrict__ in, bf16_t* __restrict__ out, int K, int N, int tile, char* smem) {
    float* tl = (float*)smem;
    const int ntn = N >> 6;
    const int k0 = (tile / ntn) << 6, n0 = (tile % ntn) << 6;
    const int tid = VTID;
    __syncthreads();
#pragma unroll 4
    for (int i = 0; i < 16; ++i) {
        int idx = tid + 256 * i;
        int r = idx >> 6, c = idx & 63;
        tl[r * 65 + c] = in[(size_t)(k0 + r) * N + n0 + c];
    }
    __syncthreads();
#pragma unroll 4
    for (int i = 0; i < 16; ++i) {
        int idx = tid + 256 * i;
        int r = idx >> 6, c = idx & 63;
        out[(size_t)(n0 + r) * K + k0 + c] = f2bf(tl[c * 65 + r]);
    }
}

__device__ __forceinline__ void rmsnorm_row_bf16(const float* __restrict__ xr, const float* __restrict__ g, bf16_t* __restrict__ o, int lane) {
    float4 v[4];
    float ss = 0.f;
#pragma unroll
    for (int j = 0; j < 4; ++j) {
        v[j] = *(const float4*)(xr + (j * 64 + lane) * 4);
        ss += v[j].x * v[j].x + v[j].y * v[j].y + v[j].z * v[j].z + v[j].w * v[j].w;
    }
    ss = wave_sum(ss);
    const float rs = rsqrtf(ss * (1.0f / 1024.0f) + EPS);
#pragma unroll
    for (int j = 0; j < 4; ++j) {
        const float4 gg = *(const float4*)(g + (j * 64 + lane) * 4);
        uint2 pk;
        pk.x = pack2(v[j].x * rs * gg.x, v[j].y * rs * gg.y);
        pk.y = pack2(v[j].z * rs * gg.z, v[j].w * rs * gg.w);
        *(uint2*)(o + (j * 64 + lane) * 4) = pk;
    }
}

__device__ void phase_prep(const Params& p, char* smem) {
    const int tid = VTID, lane = tid & 63, w = tid >> 6;
    const int gsz = VGRID, bid = VBID;
    const int t_in = (1024 / 64) * (INW / 64);
    const int t_out = 16 * 16;
    const int t_q = 16 * (QW / 64);
    const int t_kv = 16 * 8;
    const int t_all = t_in + t_out + t_q + t_kv;
    for (int it = bid; it < t_all; it += gsz) {
        if (it < t_in) transpose_tile(p.w_in, p.w_in_t(), 1024, INW, it, smem);
        else if (it < t_in + t_out) transpose_tile(p.w_out, p.w_out_t(), 1024, 1024, it - t_in, smem);
        else if (it < t_in + t_out + t_q) transpose_tile(p.w_q, p.w_q_t(), 1024, QW, it - t_in - t_out, smem);
        else transpose_tile(p.w_kv, p.w_kv_t(), 1024, 512, it - t_in - t_out - t_q, smem);
    }
    for (int i = bid * 256 + tid; i < NTOK; i += gsz * 256) { p.ss1()[i] = 0.f; p.hmax()[i] = 0u; }
    if (bid == 0) {
        for (int i = tid; i < 512; i += 256) {
            int dir = i >> 8, k = i & 255;
            float a0 = p.hg_lb[(dir * 2 + 0) * 256 + k], a1 = p.hg_lb[(dir * 2 + 1) * 256 + k];
            float m = fmaxf(a0, a1);
            float e0 = expf(a0 - m), e1 = expf(a1 - m);
            p.lb()[i] = e0 / (e0 + e1);
        }
    }
    const int nrows = NTOK + 1024;
    for (int r0 = bid * 4; r0 < nrows; r0 += gsz * 4) {
        int r = r0 + w;
        if (r < NTOK) rmsnorm_row_bf16(p.x + (size_t)r * D, p.attn_g, p.h() + (size_t)r * D, lane);
        else if (r < nrows) rmsnorm_row_bf16(p.mem + (size_t)(r - NTOK) * D, p.mem_g, p.memn() + (size_t)(r - NTOK) * D, lane);
    }
    for (int i = bid * 256 + tid; i < 16 * 128 * 128 / 4; i += gsz * 256) {
        const float4 v = *(const float4*)(p.subk + (size_t)i * 4);
        uint2 pk; pk.x = pack2(v.x, v.y); pk.y = pack2(v.z, v.w);
        *(uint2*)(p.subk_b() + (size_t)i * 4) = pk;
    }
    for (int r0 = bid * 4; r0 < 2 * 16384; r0 += gsz * 4) {
        const int r = r0 + w;
        const bool isv = r >= 16384;
        const int e = r & 16383;
        const float* srcp = (isv ? p.pv : p.pu) + (size_t)e * D;
        unsigned* dst = (unsigned*)(isv ? p.v_c() : p.u_c());
        float4 v[4];
        float am = 0.f;
#pragma unroll
        for (int j = 0; j < 4; ++j) {
            v[j] = *(const float4*)(srcp + (j * 64 + lane) * 4);
            am = fmaxf(am, fmaxf(fmaxf(fabsf(v[j].x), fabsf(v[j].y)), fmaxf(fabsf(v[j].z), fabsf(v[j].w))));
        }
        am = wave_max(am);
        const float qs = am > 0.f ? 127.0f / am : 0.f;
        if (lane == 0) (isv ? p.scale_v() : p.scale_u())[e] = am * (1.0f / 127.0f);
        const int off = 0;
#pragma unroll
        for (int j = 0; j < 4; ++j) {
            const int q0 = (int)rintf(v[j].x * qs) + off, q1 = (int)rintf(v[j].y * qs) + off;
            const int q2 = (int)rintf(v[j].z * qs) + off, q3 = (int)rintf(v[j].w * qs) + off;
            const unsigned pk = (unsigned)(q0 & 255) | ((unsigned)(q1 & 255) << 8) | ((unsigned)(q2 & 255) << 16) | ((unsigned)(q3 & 255) << 24);
            const int c = j * 2 + (lane >> 5), d = (lane & 31) * 4;
            dst[(((size_t)c * 16384 + e) * 128 + d) >> 2] = pk;
        }
    }
}

struct EpiBf16 {
    bf16_t* C; int ldc;
    __device__ __forceinline__ void operator()(int row, int col, const f32x4& v) const {
        uint2 pk; pk.x = pack2(v[0], v[1]); pk.y = pack2(v[2], v[3]);
        *(uint2*)(C + (size_t)row * ldc + col) = pk;
    }
};
struct EpiBf16T {
    bf16_t* C; int col0, ncols, rows_per_b;
    __device__ __forceinline__ void operator()(int row, int col, const f32x4& v) const {
        const int bb = row / rows_per_b, rr = row - bb * rows_per_b;
        uint2 pk; pk.x = pack2(v[0], v[1]); pk.y = pack2(v[2], v[3]);
        *(uint2*)(C + ((size_t)bb * ncols + (col - col0)) * rows_per_b + rr) = pk;
    }
};
struct EpiBf16RowScale {
    bf16_t* C; int ldc; const float* ssrow;
    __device__ __forceinline__ void operator()(int row, int col, const f32x4& v) const {
        const float rs = rsqrtf(ssrow[row] * (1.0f / 1024.0f) + EPS);
        uint2 pk; pk.x = pack2(v[0] * rs, v[1] * rs); pk.y = pack2(v[2] * rs, v[3] * rs);
        *(uint2*)(C + (size_t)row * ldc + col) = pk;
    }
};
struct EpiResNorm {
    bf16_t* C; const float* R; const float* g; bf16_t* H; int ldc; float* ssrow; unsigned* hmax;
    __device__ __forceinline__ void operator()(int row, int col, const f32x4& v, float& ssq, float& am) const {
        const float4 r = *(const float4*)(R + (size_t)row * ldc + col);
        const float4 gg = *(const float4*)(g + col);
        float4 o; o.x = v[0] + r.x; o.y = v[1] + r.y; o.z = v[2] + r.z; o.w = v[3] + r.w;
        { uint2 xk; xk.x = pack2(o.x, o.y); xk.y = pack2(o.z, o.w); *(uint2*)(C + (size_t)row * ldc + col) = xk; }
        const float h0 = o.x * gg.x, h1 = o.y * gg.y, h2 = o.z * gg.z, h3 = o.w * gg.w;
        uint2 pk; pk.x = pack2(h0, h1); pk.y = pack2(h2, h3);
        *(uint2*)(H + (size_t)row * ldc + col) = pk;
        ssq += o.x * o.x + o.y * o.y + o.z * o.z + o.w * o.w;
        am = fmaxf(am, fmaxf(fmaxf(fabsf(h0), fabsf(h1)), fmaxf(fabsf(h2), fabsf(h3))));
    }
    __device__ __forceinline__ void row_done(int row, float ssq, float am) const {
        atomicAdd(ssrow + row, ssq);
        atomicMax(hmax + row, __float_as_uint(am));
    }
};
struct EpiResF32 {
    float* C; const float* R; int ldc;
    __device__ __forceinline__ void operator()(int row, int col, const f32x4& v) const {
        const float4 r = *(const float4*)(R + (size_t)row * ldc + col);
        float4 o; o.x = v[0] + r.x; o.y = v[1] + r.y; o.z = v[2] + r.z; o.w = v[3] + r.w;
        *(float4*)(C + (size_t)row * ldc + col) = o;
    }
};

template <bool TRANS, class Epi, bool ROWSS = false>
__device__ __forceinline__ void gemm_tile(const bf16_t* __restrict__ A, int lda, const bf16_t* __restrict__ Bt, int ldb, int K,
                                          int m0, int n0, char* smem, const Epi& epi, float* ssrow = nullptr) {
    const int tid = VTID, lane = tid & 63, w = tid >> 6, wr = w >> 1, wc = w & 1;
    const int fr = lane & 15, fq = lane >> 4;
    const int srow = lane >> 3, sslot = lane & 7;
    f32x4 acc[4][4];
#pragma unroll
    for (int mi = 0; mi < 4; ++mi)
#pragma unroll
        for (int ni = 0; ni < 4; ++ni) acc[mi][ni] = (f32x4){0.f, 0.f, 0.f, 0.f};
    const int g0 = (sslot ^ (srow >> 1)) * 8, g1 = (sslot ^ (4 + (srow >> 1))) * 8;
    const bf16_t* Ab = A + (size_t)(m0 + w * 32 + srow) * lda;
    const bf16_t* Bb = Bt + (size_t)(n0 + w * 32 + srow) * ldb;
    const int nk = K >> 6;
    __syncthreads();
#define GEMM_STAGE(kt, buf)                                                                                                  \
    do {                                                                                                                     \
        char* sa = smem + (buf) * 32768 + w * 4096;                                                                          \
        char* sb = sa + 16384;                                                                                               \
        _Pragma("unroll") for (int i = 0; i < 4; ++i) {                                                                      \
            const int gc = (i & 1) ? g1 : g0;                                                                                \
            __builtin_amdgcn_global_load_lds((const unsigned*)(Ab + (size_t)(i * 8) * lda + (kt) * 64 + gc), (unsigned*)(sa + i * 1024), 16, 0, 0); \
            __builtin_amdgcn_global_load_lds((const unsigned*)(Bb + (size_t)(i * 8) * ldb + (kt) * 64 + gc), (unsigned*)(sb + i * 1024), 16, 0, 0); \
        }                                                                                                                    \
    } while (0)
    GEMM_STAGE(0, 0);
    const int key = fr >> 1;
    for (int kt = 0; kt < nk; ++kt) {
        asm volatile("s_waitcnt vmcnt(0)" ::: "memory");
        __syncthreads();
        if (kt + 1 < nk) GEMM_STAGE(kt + 1, (kt + 1) & 1);
        const char* sa = smem + (kt & 1) * 32768;
        const char* sb = sa + 16384;
#pragma unroll
        for (int ks = 0; ks < 2; ++ks) {
            bf16x8 af[4], bfr[4];
            const int co = ((ks * 4 + fq) ^ key) << 4;
#pragma unroll
            for (int mi = 0; mi < 4; ++mi) af[mi] = *(const bf16x8*)(sa + (wr * 64 + mi * 16 + fr) * 128 + co);
#pragma unroll
            for (int ni = 0; ni < 4; ++ni) bfr[ni] = *(const bf16x8*)(sb + (wc * 64 + ni * 16 + fr) * 128 + co);
#pragma unroll
            for (int mi = 0; mi < 4; ++mi)
#pragma unroll
                for (int ni = 0; ni < 4; ++ni)
                    acc[mi][ni] = TRANS ? __builtin_amdgcn_mfma_f32_16x16x32_bf16(af[mi], bfr[ni], acc[mi][ni], 0, 0, 0)
                                        : __builtin_amdgcn_mfma_f32_16x16x32_bf16(bfr[ni], af[mi], acc[mi][ni], 0, 0, 0);
        }
    }
#undef GEMM_STAGE
    if constexpr (ROWSS) {
#pragma unroll
        for (int mi = 0; mi < 4; ++mi) {
            const int row = m0 + wr * 64 + mi * 16 + fr;
            float ssq = 0.f, am = 0.f;
#pragma unroll
            for (int ni = 0; ni < 4; ++ni) epi(row, n0 + wc * 64 + ni * 16 + fq * 4, acc[mi][ni], ssq, am);
            ssq += __shfl_xor(ssq, 16);
            ssq += __shfl_xor(ssq, 32);
            am = fmaxf(am, __shfl_xor(am, 16));
            am = fmaxf(am, __shfl_xor(am, 32));
            if (fq == 0) epi.row_done(row, ssq, am);
        }
    } else {
#pragma unroll
        for (int mi = 0; mi < 4; ++mi)
#pragma unroll
            for (int ni = 0; ni < 4; ++ni) {
                if (TRANS) epi(m0 + wr * 64 + mi * 16 + fq * 4, n0 + wc * 64 + ni * 16 + fr, acc[mi][ni]);
                else epi(m0 + wr * 64 + mi * 16 + fr, n0 + wc * 64 + ni * 16 + fq * 4, acc[mi][ni]);
            }
    }
}


namespace g8 {
constexpr int BM = 256, BK = 64, HALF = 128, HT = HALF * BK;
__device__ __forceinline__ int lds_byte(int r, int c) {
    const int st = (r >> 4) * 2 + (c >> 5), rr = r & 15, cc = c & 31, ob = rr * 64 + cc * 2;
    return st * 1024 + (ob ^ (((ob >> 9) & 1) << 5));
}
__device__ __forceinline__ void stage_rc(int b, int& R, int& C) {
    const int st = b / 1024, sb = b % 1024, swz = sb ^ (((sb >> 9) & 1) << 5);
    R = (st >> 1) * 16 + swz / 64; C = (st & 1) * 32 + (swz % 64) / 2;
}
__device__ __forceinline__ void tile_of(int L, int nM, int nN, int& pm, int& pn) {
    const int nwg = nM * nN;
    int wgid = L;
    { const int q = nwg / 8, r = nwg % 8, xcd = wgid % 8, off = wgid / 8; wgid = (xcd < r ? xcd * (q + 1) : r * (q + 1) + (xcd - r) * q) + off; }
    const int nig = 8 * nN, gid = wgid / nig, fm = gid * 8, gsz = (nM - fm) < 8 ? (nM - fm) : 8;
    pm = fm + ((wgid % nig) % gsz); pn = (wgid % nig) / gsz;
}
}

#define G8_LAS __attribute__((address_space(3)))
template <bool TRANS, bool ROWSS, class Epi>
__device__ __forceinline__ void gemm256_tile(const bf16_t* __restrict__ A, const bf16_t* __restrict__ Bt, int K, int brow, int bcol,
                                             char* shmc, const Epi& epi) {
    using namespace g8;
    G8_LAS unsigned char* lds = (G8_LAS unsigned char*)shmc;
    const int tid = threadIdx.x, wid = __builtin_amdgcn_readfirstlane(tid >> 6), lane = tid & 63, wr = wid >> 2, wc = wid & 3, fr = lane & 15, fq = lane >> 4;
    constexpr int HTB = HALF * BK * 2;
    unsigned voff[2];
#pragma unroll
    for (int i = 0; i < 2; ++i) { int R, C; stage_rc(tid * 16 + i * 8192, R, C); voff[i] = (unsigned)(R * K + C) * 2u; }
    const size_t kstep = (size_t)(BK * 2);
    const size_t hstep = (size_t)HALF * K * 2;
    const unsigned ldsw = (unsigned)wid * 1024u;
    const int aoff = lds_byte(wr * 64 + fr, fq * 8), boff = lds_byte(wc * 32 + fr, fq * 8);
    const char* cA = (const char*)A + (size_t)brow * K * 2;
    const char* cB = (const char*)Bt + (size_t)bcol * K * 2;
#define G8_SA(b, h) (((b) * 2 + (h)) * HTB)
#define G8_SB(b, h) ((4 + (b) * 2 + (h)) * HTB)
#define G8_STAGE(bufoff, gbase) do { _Pragma("unroll") for (int _i = 0; _i < 2; ++_i) \
        __builtin_amdgcn_global_load_lds((const unsigned*)((const char*)(gbase) + voff[_i]), (G8_LAS unsigned*)(lds + (bufoff) + ldsw + _i * 8192), 16, 0, 0); } while (0)
#define G8_LDA(dst, b, h) do { _Pragma("unroll") for (int m = 0; m < 4; ++m) _Pragma("unroll") for (int k = 0; k < 2; ++k) dst[m][k] = *(const G8_LAS bf16x8*)(lds + G8_SA(b, h) + aoff + m * 2048 + k * 1024); } while (0)
#define G8_LDB(dst, b, h) do { _Pragma("unroll") for (int n = 0; n < 2; ++n) _Pragma("unroll") for (int k = 0; k < 2; ++k) dst[n][k] = *(const G8_LAS bf16x8*)(lds + G8_SB(b, h) + boff + n * 2048 + k * 1024); } while (0)
#define G8_MMA(ai, bj, At_, Bt_) do { __builtin_amdgcn_s_setprio(1); _Pragma("unroll") for (int m = 0; m < 4; ++m) _Pragma("unroll") for (int n = 0; n < 2; ++n) _Pragma("unroll") for (int k = 0; k < 2; ++k) \
        acc[ai][bj][m][n] = TRANS ? __builtin_amdgcn_mfma_f32_16x16x32_bf16(At_[m][k], Bt_[n][k], acc[ai][bj][m][n], 0, 0, 0) \
                                  : __builtin_amdgcn_mfma_f32_16x16x32_bf16(Bt_[n][k], At_[m][k], acc[ai][bj][m][n], 0, 0, 0); \
        __builtin_amdgcn_s_setprio(0); } while (0)
#define G8_WAIT_V(n) asm volatile("s_waitcnt vmcnt(" #n ")" ::: "memory")
#define G8_WAIT_L(n) asm volatile("s_waitcnt lgkmcnt(" #n ")" ::: "memory")
#define G8_BAR __builtin_amdgcn_s_barrier()
#define G8_SCHED __builtin_amdgcn_sched_barrier(0)
    f32x4 acc[2][2][4][2];
#pragma unroll
    for (int a = 0; a < 2; ++a)
#pragma unroll
        for (int b = 0; b < 2; ++b)
#pragma unroll
            for (int m = 0; m < 4; ++m)
#pragma unroll
                for (int n = 0; n < 2; ++n) acc[a][b][m][n] = (f32x4){0.f, 0.f, 0.f, 0.f};
    bf16x8 At[4][2], B0[2][2], B1[2][2];
    const int nt = K / BK;
    __syncthreads();
    G8_STAGE(G8_SB(0, 0), cB); G8_STAGE(G8_SA(0, 0), cA); G8_STAGE(G8_SB(0, 1), cB + hstep); G8_STAGE(G8_SA(0, 1), cA + hstep);
    if (wr == 1) G8_BAR;
    G8_WAIT_V(4); G8_BAR;
    G8_STAGE(G8_SB(1, 0), cB + kstep); G8_STAGE(G8_SA(1, 0), cA + kstep); G8_STAGE(G8_SB(1, 1), cB + hstep + kstep);
    G8_WAIT_V(6); G8_BAR;
    for (int t = 0; t < nt - 2; t += 2) {
        const char* a1 = cA + (size_t)(t + 1) * kstep; const char* a2 = a1 + kstep; const char* a3 = a2 + kstep;
        const char* b2 = cB + (size_t)(t + 2) * kstep; const char* b3 = b2 + kstep;
        G8_LDB(B0, 0, 0); G8_SCHED; G8_LDA(At, 0, 0); G8_STAGE(G8_SA(1, 1), a1 + hstep);
        G8_WAIT_L(8); G8_BAR; G8_WAIT_L(0); G8_MMA(0, 0, At, B0); G8_BAR; G8_SCHED;
        G8_LDB(B1, 0, 1); G8_STAGE(G8_SB(0, 0), b2);
        G8_BAR; G8_WAIT_L(0); G8_MMA(0, 1, At, B1); G8_BAR;
        G8_LDA(At, 0, 1); G8_STAGE(G8_SA(0, 0), a2);
        G8_BAR; G8_WAIT_L(0); G8_MMA(1, 0, At, B0); G8_BAR; G8_SCHED;
        G8_STAGE(G8_SB(0, 1), b2 + hstep);
        G8_WAIT_V(6); G8_BAR; G8_MMA(1, 1, At, B1); G8_BAR;
        G8_LDB(B0, 1, 0); G8_SCHED; G8_LDA(At, 1, 0); G8_STAGE(G8_SA(0, 1), a2 + hstep);
        G8_WAIT_L(8); G8_BAR; G8_WAIT_L(0); G8_MMA(0, 0, At, B0); G8_BAR; G8_SCHED;
        G8_LDB(B1, 1, 1); G8_STAGE(G8_SB(1, 0), b3);
        G8_BAR; G8_WAIT_L(0); G8_MMA(0, 1, At, B1); G8_BAR;
        G8_LDA(At, 1, 1); G8_STAGE(G8_SA(1, 0), a3);
        G8_BAR; G8_WAIT_L(0); G8_MMA(1, 0, At, B0); G8_BAR; G8_SCHED;
        G8_STAGE(G8_SB(1, 1), b3 + hstep);
        G8_WAIT_V(6); G8_BAR; G8_MMA(1, 1, At, B1); G8_BAR;
    }
    { G8_LDB(B0, 0, 0); G8_LDA(At, 0, 0); G8_STAGE(G8_SA(1, 1), cA + (size_t)(nt - 1) * kstep + hstep);
      G8_BAR; G8_WAIT_L(0); G8_MMA(0, 0, At, B0); G8_BAR;
      G8_LDB(B1, 0, 1); G8_BAR; G8_WAIT_L(0); G8_MMA(0, 1, At, B1); G8_BAR;
      G8_LDA(At, 0, 1); G8_WAIT_V(4); G8_BAR; G8_WAIT_L(0); G8_MMA(1, 0, At, B0); G8_MMA(1, 1, At, B1); G8_BAR; }
    { G8_LDB(B0, 1, 0); G8_LDA(At, 1, 0); G8_WAIT_V(2); G8_BAR; G8_WAIT_L(0); G8_MMA(0, 0, At, B0); G8_BAR;
      G8_LDB(B1, 1, 1); G8_WAIT_V(0); G8_BAR; G8_WAIT_L(0); G8_MMA(0, 1, At, B1); G8_BAR;
      G8_LDA(At, 1, 1); G8_BAR; G8_WAIT_L(0); G8_MMA(1, 0, At, B0); G8_MMA(1, 1, At, B1); G8_BAR; }
    if (wr == 0) G8_BAR;
    if constexpr (ROWSS) {
#pragma unroll
        for (int ai = 0; ai < 2; ++ai)
#pragma unroll
            for (int m = 0; m < 4; ++m) {
                const int row = brow + ai * HALF + wr * 64 + m * 16 + fr;
                float ssq = 0.f, am = 0.f;
#pragma unroll
                for (int bj = 0; bj < 2; ++bj)
#pragma unroll
                    for (int n = 0; n < 2; ++n) epi(row, bcol + bj * HALF + wc * 32 + n * 16 + fq * 4, acc[ai][bj][m][n], ssq, am);
                ssq += __shfl_xor(ssq, 16);
                ssq += __shfl_xor(ssq, 32);
                am = fmaxf(am, __shfl_xor(am, 16));
                am = fmaxf(am, __shfl_xor(am, 32));
                if (fq == 0) epi.row_done(row, ssq, am);
            }
    } else {
#pragma unroll
        for (int ai = 0; ai < 2; ++ai)
#pragma unroll
            for (int bj = 0; bj < 2; ++bj)
#pragma unroll
                for (int m = 0; m < 4; ++m)
#pragma unroll
                    for (int n = 0; n < 2; ++n) {
                        if (TRANS) epi(brow + ai * HALF + wr * 64 + m * 16 + fq * 4, bcol + bj * HALF + wc * 32 + n * 16 + fr, acc[ai][bj][m][n]);
                        else epi(brow + ai * HALF + wr * 64 + m * 16 + fr, bcol + bj * HALF + wc * 32 + n * 16 + fq * 4, acc[ai][bj][m][n]);
                    }
    }
#undef G8_SA
#undef G8_SB
#undef G8_STAGE
#undef G8_LDA
#undef G8_LDB
#undef G8_MMA
#undef G8_WAIT_V
#undef G8_WAIT_L
#undef G8_BAR
#undef G8_SCHED
}

__device__ void phase_gemm_in(const Params& p, char* smem) {
    const int nM = NTOK / 256, nN = INW / 256;
    EpiBf16 e1{p.z(), INW};
    EpiBf16T e1t{p.vT(), 1024, 512, T};
    for (int i = 0; i * (int)gridDim.x + (int)blockIdx.x < nM * nN; ++i) {
        int pm, pn;
        g8::tile_of(i * gridDim.x + blockIdx.x, nM, nN, pm, pn);
        if (pn >= 4 && pn < 6) gemm256_tile<true, false>(p.h(), p.w_in_t(), D, pm * 256, pn * 256, smem, e1t);
        else gemm256_tile<false, false>(p.h(), p.w_in_t(), D, pm * 256, pn * 256, smem, e1);
    }
}

__device__ void phase_gemm_kv(const Params& p, char* smh) {
    EpiBf16 e2{p.kvb(), 512};
    EpiBf16T e2t{p.kvT(), 256, 256, 256};
    const bool dedicated = gridDim.x >= 64;
    if (dedicated && blockIdx.x >= 16) return;
    for (int it = VBID; it < 32; it += dedicated ? 32 : VGRID) {
        const int pm = it >> 2, pn = it & 3;
        if (pn >= 2) gemm_tile<true>(p.memn(), D, p.w_kv_t(), D, D, pm * 128, pn * 128, smh, e2t);
        else gemm_tile<false>(p.memn(), D, p.w_kv_t(), D, D, pm * 128, pn * 128, smh, e2);
    }
}

__device__ void phase_gemm_out(const Params& p, char* smem) {
    const int nM = NTOK / 256, nN = D / 256;
    EpiResNorm e{p.x1b(), p.x, p.ffn_g, p.h(), D, p.ss1(), p.hmax()};
    for (int i = 0; i * (int)gridDim.x + (int)blockIdx.x < nM * nN; ++i) {
        int pm, pn;
        g8::tile_of(i * gridDim.x + blockIdx.x, nM, nN, pm, pn);
        gemm256_tile<false, true>(p.mix(), p.w_out_t(), D, pm * 256, pn * 256, smem, e);
    }
}

__device__ void phase_gemm_q(const Params& p, char* smem) {
    const int nM = NTOK / 256, nN = QW / 256;
    EpiBf16RowScale e{p.z(), QW, p.ss1()};
    for (int i = 0; i * (int)gridDim.x + (int)blockIdx.x < nM * nN; ++i) {
        int pm, pn;
        g8::tile_of(i * gridDim.x + blockIdx.x, nM, nN, pm, pn);
        gemm256_tile<false, false>(p.h(), p.w_q_t(), D, pm * 256, pn * 256, smem, e);
    }
}

typedef float f32x16 __attribute__((ext_vector_type(16)));
constexpr int HRS = 144;
__device__ __forceinline__ f32x16 tile_mm64(const char* X, const char* Y, int xrow0, int yrow0, int lane, f32x16 acc) {
    const int r = lane & 31, hh = lane >> 5;
#pragma unroll
    for (int ks = 0; ks < 4; ++ks) {
        const bf16x8 a = *(const bf16x8*)(X + (xrow0 + r) * HRS + ks * 32 + hh * 16);
        const bf16x8 b = *(const bf16x8*)(Y + (yrow0 + r) * HRS + ks * 32 + hh * 16);
        acc = __builtin_amdgcn_mfma_f32_32x32x16_bf16(a, b, acc, 0, 0, 0);
    }
    return acc;
}
__device__ __forceinline__ int crow(int reg, int hh) { return (reg & 3) + 8 * (reg >> 2) + 4 * hh; }

__device__ __forceinline__ void hg_load_vt(const Params& p, char* sVT, int tok0, int h, int kcol, int sq) {
    const bf16_t* zp = p.z() + (size_t)(tok0 + sq * 16) * INW + 2304 + h * 64 + kcol;
    unsigned pk[8];
#pragma unroll
    for (int j = 0; j < 8; ++j) {
        const unsigned lo = zp[(size_t)(2 * j) * INW], hi = zp[(size_t)(2 * j + 1) * INW];
        pk[j] = lo | (hi << 16);
    }
    *(uint4*)(sVT + kcol * HRS + sq * 32) = make_uint4(pk[0], pk[1], pk[2], pk[3]);
    *(uint4*)(sVT + kcol * HRS + sq * 32 + 16) = make_uint4(pk[4], pk[5], pk[6], pk[7]);
}

__device__ __forceinline__ float hg_gates(const Params& p, float* sTot, int tok0, int h, int dir, int kcol, int sq, float (&bj)[16], float (&kk)[16]) {
    const bf16_t* zp = p.z() + (size_t)(tok0 + sq * 16) * INW + 1792 + dir * 256 + h * 64 + kcol;
    const float lbv = p.lb()[dir * 256 + h * 64 + kcol];
#pragma unroll
    for (int j = 0; j < 16; ++j) {
        const float pre = bf2f(zp[(size_t)j * INW]);
        const float f = lbv + (1.0f - lbv) * (1.0f / (1.0f + __expf(-pre)));
        bj[j] = __logf(f);
        kk[j] = 1.0f - f;
    }
    if (dir == 0) {
#pragma unroll
        for (int j = 1; j < 16; ++j) bj[j] += bj[j - 1];
        sTot[sq * 64 + kcol] = bj[15];
    } else {
#pragma unroll
        for (int j = 14; j >= 0; --j) bj[j] += bj[j + 1];
        sTot[sq * 64 + kcol] = bj[0];
    }
    __syncthreads();
    const float t0 = sTot[kcol], t1 = sTot[64 + kcol], t2 = sTot[128 + kcol], t3 = sTot[192 + kcol];
    float off;
    if (dir == 0) off = (sq > 0 ? t0 : 0.f) + (sq > 1 ? t1 : 0.f) + (sq > 2 ? t2 : 0.f);
    else off = (sq < 3 ? t3 : 0.f) + (sq < 2 ? t2 : 0.f) + (sq < 1 ? t1 : 0.f);
#pragma unroll
    for (int j = 0; j < 16; ++j) bj[j] += off;
    return t0 + t1 + t2 + t3;
}

__device__ void hg_local(const Params& p, char* smem) {
    char* sVT = smem;
    char* sKT = smem + 9216;
    float* sTot = (float*)(smem + 18432);
    const int tid = VTID, lane = tid & 63, w = tid >> 6;
    const int kcol = tid & 63, sq = tid >> 6;
    for (int item = VBID; item < 4096; item += VGRID) {
        const int c = item & 127, dir = (item >> 7) & 1, h = (item >> 8) & 3, b = item >> 10;
        const int tok0 = b * T + c * 64;
        __syncthreads();
        hg_load_vt(p, sVT, tok0, h, kcol, sq);
        float bj[16], kk[16];
        const float btot = hg_gates(p, sTot, tok0, h, dir, kcol, sq, bj, kk);
        unsigned pk[8];
#pragma unroll
        for (int j = 0; j < 8; ++j)
            pk[j] = pack2(kk[2 * j] * __expf(btot - bj[2 * j]), kk[2 * j + 1] * __expf(btot - bj[2 * j + 1]));
        *(uint4*)(sKT + kcol * HRS + sq * 32) = make_uint4(pk[0], pk[1], pk[2], pk[3]);
        *(uint4*)(sKT + kcol * HRS + sq * 32 + 16) = make_uint4(pk[4], pk[5], pk[6], pk[7]);
        if (sq == 0) p.hdec()[item * 64 + kcol] = __expf(btot);
        __syncthreads();
        const int vi = w >> 1, ki = w & 1, hh = lane >> 5;
        f32x16 acc;
#pragma unroll
        for (int r = 0; r < 16; ++r) acc[r] = 0.f;
        acc = tile_mm64(sVT, sKT, vi * 32, ki * 32, lane, acc);
        bf16_t* dst = (bf16_t*)p.hstate() + (size_t)item * 4096 + ki * 32 + (lane & 31);
#pragma unroll
        for (int r = 0; r < 16; ++r) dst[(vi * 32 + crow(r, hh)) * 64] = f2bf(acc[r]);
    }
}

__device__ __forceinline__ bf16x8 pack8(const f32x16& x, int s8) {
    typedef unsigned u32x4_t __attribute__((ext_vector_type(4)));
    u32x4_t pk;
    pk[0] = pack2(x[s8], x[s8 + 1]); pk[1] = pack2(x[s8 + 2], x[s8 + 3]);
    pk[2] = pack2(x[s8 + 4], x[s8 + 5]); pk[3] = pack2(x[s8 + 6], x[s8 + 7]);
    return __builtin_bit_cast(bf16x8, pk);
}
__device__ __forceinline__ bf16x8 join8(const uint2& lo, const uint2& hi) {
    typedef unsigned u32x4_t __attribute__((ext_vector_type(4)));
    u32x4_t pk; pk[0] = lo.x; pk[1] = lo.y; pk[2] = hi.x; pk[3] = hi.y;
    return __builtin_bit_cast(bf16x8, pk);
}

__device__ __forceinline__ int swap23(int r) { return (r & ~12) | ((r & 4) << 1) | ((r & 8) >> 1); }

__device__ __forceinline__ void mem_attn_wave(const Params& p, int wu, int lane) {
    const int tile = wu & 255, h = (wu >> 8) & 3, b = wu >> 10;
    const int l31 = lane & 31, hh = lane >> 5;
    const int tok = b * T + tile * 32 + l31;
    bf16x8 qf[4];
#pragma unroll
    for (int ks = 0; ks < 4; ++ks) qf[ks] = *(const bf16x8*)(p.z() + (size_t)tok * INW + 2816 + h * 64 + ks * 16 + hh * 8);
    const bf16_t* kb = p.kvb() + (size_t)(b * 256 + swap23(l31)) * 512 + h * 64 + hh * 8;
    float m = -1e30f;
    f32x16 o0, o1;
#pragma unroll
    for (int r = 0; r < 16; ++r) { o0[r] = 0.f; o1[r] = 0.f; }
    float sum = 0.f;
    const bf16_t* vt = p.kvT() + ((size_t)(b * 4 + h) * 64 + l31) * 256 + 8 * hh;
    bf16x8 kf[4], vf[4];
#pragma unroll
    for (int ks = 0; ks < 4; ++ks) kf[ks] = *(const bf16x8*)(kb + ks * 16);
#pragma unroll
    for (int st = 0; st < 2; ++st) { vf[2 * st] = *(const bf16x8*)(vt + st * 16); vf[2 * st + 1] = *(const bf16x8*)(vt + 32 * 256 + st * 16); }
    for (int kt = 0; kt < 8; ++kt) {
        const int ktn = min(kt + 1, 7);
        bf16x8 kn[4], vn[4];
#pragma unroll
        for (int ks = 0; ks < 4; ++ks) kn[ks] = *(const bf16x8*)(kb + (size_t)ktn * 32 * 512 + ks * 16);
#pragma unroll
        for (int st = 0; st < 2; ++st) { vn[2 * st] = *(const bf16x8*)(vt + ktn * 32 + st * 16); vn[2 * st + 1] = *(const bf16x8*)(vt + 32 * 256 + ktn * 32 + st * 16); }
        f32x16 s;
#pragma unroll
        for (int r = 0; r < 16; ++r) s[r] = 0.f;
#pragma unroll
        for (int ks = 0; ks < 4; ++ks) s = __builtin_amdgcn_mfma_f32_32x32x16_bf16(kf[ks], qf[ks], s, 0, 0, 0);
        float tm = s[0];
#pragma unroll
        for (int r = 1; r < 16; ++r) tm = fmaxf(tm, s[r]);
        tm = fmaxf(tm, __shfl_xor(tm, 32));
        const float mn = fmaxf(m, tm);
        if (__any(mn > m)) {
            const float sc = __builtin_amdgcn_exp2f((m - mn) * 0.18033688011112042f);
            sum *= sc;
#pragma unroll
            for (int r = 0; r < 16; ++r) { o0[r] *= sc; o1[r] *= sc; }
        }
        m = mn;
        const float mb = mn * 0.18033688011112042f;
#pragma unroll
        for (int r = 0; r < 16; ++r) { s[r] = __builtin_amdgcn_exp2f(fmaf(s[r], 0.18033688011112042f, -mb)); sum += s[r]; }
#pragma unroll
        for (int st = 0; st < 2; ++st) {
            const bf16x8 pb = pack8(s, st * 8);
            o0 = __builtin_amdgcn_mfma_f32_32x32x16_bf16(vf[2 * st], pb, o0, 0, 0, 0);
            o1 = __builtin_amdgcn_mfma_f32_32x32x16_bf16(vf[2 * st + 1], pb, o1, 0, 0, 0);
        }
#pragma unroll
        for (int ks = 0; ks < 4; ++ks) kf[ks] = kn[ks];
#pragma unroll
        for (int q = 0; q < 4; ++q) vf[q] = vn[q];
    }
    sum += __shfl_xor(sum, 32);
    const float inv = 1.0f / sum;
    bf16_t* mo = p.mix() + (size_t)tok * D + 768 + h * 64 + 4 * hh;
#pragma unroll
    for (int g = 0; g < 4; ++g) {
        uint2 pk;
        pk.x = pack2(o0[4 * g] * inv, o0[4 * g + 1] * inv); pk.y = pack2(o0[4 * g + 2] * inv, o0[4 * g + 3] * inv);
        *(uint2*)(mo + 8 * g) = pk;
        pk.x = pack2(o1[4 * g] * inv, o1[4 * g + 1] * inv); pk.y = pack2(o1[4 * g + 2] * inv, o1[4 * g + 3] * inv);
        *(uint2*)(mo + 32 + 8 * g) = pk;
    }
}

struct NaCtx {
    const bf16_t* kbase; const bf16_t* vbase; const float* bh;
    int rs, r, c, c0, cb, hh;
    bf16x8 qf[4];
    float m, sum;
    f32x16 o0, o1;
};
template <int TI>
__device__ __forceinline__ void na_load(const NaCtx& x, bf16x8 (&kf)[4], bf16x8 (&vf)[4]) {
    constexpr int ip = TI / 3, cg = TI % 3;
    const bf16_t* kp = x.kbase + (size_t)(ip * 128 + cg * 16) * INW;
#pragma unroll
    for (int ks = 0; ks < 4; ++ks) kf[ks] = *(const bf16x8*)(kp + ks * 16);
    const bf16_t* vr = x.vbase + ip * 128 + cg * 16;
#pragma unroll
    for (int st = 0; st < 2; ++st) { vf[2 * st] = *(const bf16x8*)(vr + st * 64); vf[2 * st + 1] = *(const bf16x8*)(vr + (size_t)32 * T + st * 64); }
}
template <int TI>
__device__ __forceinline__ void na_comp(NaCtx& x, const bf16x8 (&kf)[4], const bf16x8 (&vf)[4]) {
    constexpr int ip = TI / 3, cg = TI % 3;
    f32x16 s;
#pragma unroll
    for (int q = 0; q < 16; ++q) s[q] = 0.f;
#pragma unroll
    for (int ks = 0; ks < 4; ++ks) s = __builtin_amdgcn_mfma_f32_32x32x16_bf16(kf[ks], x.qf[ks], s, 0, 0, 0);
    const int kc0 = x.cb + 16 * cg + 8 * x.hh;
    const float* brow = x.bh + (x.rs + 2 * ip - x.r + 7) * 31 + 15 - x.c + kc0;
    const int d0 = kc0 - x.c0;
    float tm = -1e30f;
    float bv[16];
#pragma unroll
    for (int q = 0; q < 16; ++q) bv[q] = brow[(q & 3) + 4 * ((q >> 2) & 1) + 31 * (q >> 3)];
#pragma unroll
    for (int q = 0; q < 16; ++q) asm volatile("" : "+v"(bv[q]));
#pragma unroll
    for (int q = 0; q < 16; ++q) {
        const int cq = (q & 3) + 4 * ((q >> 2) & 1);
        const bool valid = (unsigned)(d0 + cq) < 16u;
        const float sc = valid ? fmaf(s[q], 0.18033688011112042f, bv[q]) : -INFINITY;
        s[q] = sc;
        tm = fmaxf(tm, sc);
    }
    tm = fmaxf(tm, __shfl_xor(tm, 32));
    const float mn = fmaxf(x.m, tm);
    if (__any(mn > x.m)) {
        const float scl = __builtin_amdgcn_exp2f(x.m - mn);
        x.sum *= scl;
#pragma unroll
        for (int q = 0; q < 16; ++q) { x.o0[q] *= scl; x.o1[q] *= scl; }
    }
    x.m = mn;
#pragma unroll
    for (int q = 0; q < 16; ++q) { const float pe = __builtin_amdgcn_exp2f(s[q] - mn); s[q] = pe; x.sum += pe; }
#pragma unroll
    for (int st = 0; st < 2; ++st) {
        const bf16x8 pb = pack8(s, st * 8);
        x.o0 = __builtin_amdgcn_mfma_f32_32x32x16_bf16(vf[2 * st], pb, x.o0, 0, 0, 0);
        x.o1 = __builtin_amdgcn_mfma_f32_32x32x16_bf16(vf[2 * st + 1], pb, x.o1, 0, 0, 0);
    }
}

__device__ __forceinline__ void na_attn_wave(const Params& p, int wu, int lane, const float* sbias) {
    const int j = wu & 1, h = (wu >> 1) & 7, r = (wu >> 4) & 127, b = wu >> 11;
    const int l31 = lane & 31, hh = lane >> 5;
    NaCtx x;
    x.hh = hh; x.r = r;
    x.c = 32 * j + l31;
    x.c0 = min(max(x.c - 8, 0), 48); x.rs = min(max(r - 4, 0), 120);
    const int tokq = b * T + r * 64 + x.c;
    x.cb = 16 * j;
#pragma unroll
    for (int ks = 0; ks < 4; ++ks) x.qf[ks] = *(const bf16x8*)(p.z() + (size_t)tokq * INW + h * 64 + ks * 16 + hh * 8);
    x.bh = sbias + 64 + h * 465;
    const int kap = swap23(l31);
    x.kbase = p.z() + (size_t)(b * T + (x.rs + (kap >> 4)) * 64 + x.cb + (kap & 15)) * INW + 512 + h * 64 + hh * 8;
    x.vbase = p.vT() + ((size_t)(b * 8 + h) * 64 + l31) * T + x.rs * 64 + x.cb + 8 * hh;
    x.m = -1e30f; x.sum = 0.f;
#pragma unroll
    for (int q = 0; q < 16; ++q) { x.o0[q] = 0.f; x.o1[q] = 0.f; }
    bf16x8 k0[4], v0[4], k1[4], v1[4], k2[4], v2[4], k3[4], v3[4];
    na_load<0>(x, k0, v0); na_load<1>(x, k1, v1); na_load<2>(x, k2, v2);
    na_load<3>(x, k3, v3);  na_comp<0>(x, k0, v0);
    na_load<4>(x, k0, v0);  na_comp<1>(x, k1, v1);
    na_load<5>(x, k1, v1);  na_comp<2>(x, k2, v2);
    na_load<6>(x, k2, v2);  na_comp<3>(x, k3, v3);
    na_load<7>(x, k3, v3);  na_comp<4>(x, k0, v0);
    na_load<8>(x, k0, v0);  na_comp<5>(x, k1, v1);
    na_load<9>(x, k1, v1);  na_comp<6>(x, k2, v2);
    na_load<10>(x, k2, v2); na_comp<7>(x, k3, v3);
    na_load<11>(x, k3, v3); na_comp<8>(x, k0, v0);
    na_comp<9>(x, k1, v1);
    na_comp<10>(x, k2, v2);
    na_comp<11>(x, k3, v3);
    float sum = x.sum;
    sum += __shfl_xor(sum, 32);
    const float inv = 1.0f / sum;
    bf16_t* mo = p.mix() + (size_t)tokq * D + h * 64 + 4 * hh;
#pragma unroll
    for (int g = 0; g < 4; ++g) {
        uint2 pk;
        pk.x = pack2(x.o0[4 * g] * inv, x.o0[4 * g + 1] * inv); pk.y = pack2(x.o0[4 * g + 2] * inv, x.o0[4 * g + 3] * inv);
        *(uint2*)(mo + 8 * g) = pk;
        pk.x = pack2(x.o1[4 * g] * inv, x.o1[4 * g + 1] * inv); pk.y = pack2(x.o1[4 * g + 2] * inv, x.o1[4 * g + 3] * inv);
        *(uint2*)(mo + 32 + 8 * g) = pk;
    }
}

__device__ void phase_mixers(const Params& p, char* smem) {
    const int tid = VTID, lane = tid & 63, w = tid >> 6;
    {
        float* sbias = (float*)smem;
        __syncthreads();
        for (int i = tid; i < 8 * 465; i += 256) sbias[64 + i] = p.rpb[i] * 1.4426950408889634f;
        __syncthreads();
        for (int wu = VBID * 4 + w; wu < 8192; wu += VGRID * 4) na_attn_wave(p, wu, lane, sbias);
    }
    __syncthreads();
    hg_local(p, smem);
}

__device__ void phase_hg_scan(const Params& p) {
    const int tid = VTID;
    const int skip = gridDim.x >= 64 ? 32 : 0;
    if (VBID < skip) return;
    for (int item = VBID - skip; item < 512; item += VGRID - skip) {
        const int g = item * 256 + tid;
        const int seq = g >> 12, kv = g & 4095, k = kv & 63;
        const int dir = seq & 1;
        float S = 0.f;
        for (int cc0 = 0; cc0 < 128; cc0 += 8) {
            float L[8], d[8];
#pragma unroll
            for (int u = 0; u < 8; ++u) {
                const int c = dir ? 127 - (cc0 + u) : cc0 + u;
                const size_t it = (size_t)seq * 128 + c;
                L[u] = bf2f(((const bf16_t*)p.hstate())[it * 4096 + kv]);
                d[u] = p.hdec()[it * 64 + k];
            }
#pragma unroll
            for (int u = 0; u < 8; ++u) {
                const int c = dir ? 127 - (cc0 + u) : cc0 + u;
                const size_t it = (size_t)seq * 128 + c;
                ((bf16_t*)p.h())[it * 4096 + kv] = f2bf(S);
                S = d[u] * S + L[u];
            }
        }
    }
}

__device__ void phase_hg_out(const Params& p, char* smem) {
    char* sQt = smem;
    char* sKt = smem + 9216;
    char* sQh = smem + 18432;
    char* sVT = smem + 27648;
    char* sST = smem + 36864;
    char* sP = smem + 46080;
    float* sTot = (float*)(smem + 55296);
    float* sSS = sTot + 256;
    const int tid = VTID, lane = tid & 63, w = tid >> 6;
    const int kcol = tid & 63, sq = tid >> 6;
    const int l31 = lane & 31, hh = lane >> 5;
    for (int item = VBID; item < 2048; item += VGRID) {
        const int c = item & 127, h = (item >> 7) & 3, b = item >> 9;
        const int tok0 = b * T + c * 64;
        __syncthreads();
        hg_load_vt(p, sVT, tok0, h, kcol, sq);
        float qv[16];
        {
            const bf16_t* zp = p.z() + (size_t)(tok0 + sq * 16) * INW + 1536 + h * 64 + kcol;
#pragma unroll
            for (int j = 0; j < 16; ++j) qv[j] = bf2f(zp[(size_t)j * INW]);
        }
        f32x16 accO;
#pragma unroll
        for (int r = 0; r < 16; ++r) accO[r] = 0.f;
        for (int dir = 0; dir < 2; ++dir) {
            float bj[16], kk[16];
            const float btot = hg_gates(p, sTot, tok0, h, dir, kcol, sq, bj, kk);
            const float bref = 0.5f * btot;
#pragma unroll
            for (int j = 0; j < 16; ++j) {
                const int s = sq * 16 + j;
                *(bf16_t*)(sQt + s * HRS + kcol * 2) = f2bf(qv[j] * __expf(bj[j] - bref));
                *(bf16_t*)(sKt + s * HRS + kcol * 2) = f2bf(kk[j] * __expf(bref - bj[j]));
                *(bf16_t*)(sQh + s * HRS + kcol * 2) = f2bf(qv[j] * __expf(bj[j]));
            }
            {
                const bf16_t* sp = (const bf16_t*)p.h() + ((size_t)(((b * 4 + h) * 2 + dir) * 128 + c)) * 4096;
#pragma unroll
                for (int i = 0; i < 4; ++i) {
                    const int idx = tid * 4 + 1024 * i;
                    *(uint2*)(sST + (idx >> 6) * HRS + (idx & 63) * 2) = *(const uint2*)(sp + idx);
                }
            }
            __syncthreads();
            {
                const int si = w >> 1, ti = w & 1;
                const bool live = dir == 0 ? (si <= ti) : (si >= ti);
                f32x16 pt;
#pragma unroll
                for (int r = 0; r < 16; ++r) pt[r] = 0.f;
                if (live) pt = tile_mm64(sKt, sQt, si * 32, ti * 32, lane, pt);
                const int t = ti * 32 + l31;
#pragma unroll
                for (int g = 0; g < 4; ++g) {
                    const int s0 = si * 32 + 8 * g + 4 * hh;
                    float v0 = pt[4 * g], v1 = pt[4 * g + 1], v2 = pt[4 * g + 2], v3 = pt[4 * g + 3];
                    if (dir == 0) {
                        if (s0 > t) v0 = 0.f; if (s0 + 1 > t) v1 = 0.f; if (s0 + 2 > t) v2 = 0.f; if (s0 + 3 > t) v3 = 0.f;
                    } else {
                        if (s0 < t) v0 = 0.f; if (s0 + 1 < t) v1 = 0.f; if (s0 + 2 < t) v2 = 0.f; if (s0 + 3 < t) v3 = 0.f;
                    }
                    uint2 pk; pk.x = pack2(v0, v1); pk.y = pack2(v2, v3);
                    *(uint2*)(sP + t * HRS + s0 * 2) = pk;
                }
            }
            __syncthreads();
            {
                const int vi = w >> 1, ti = w & 1;
                accO = tile_mm64(sVT, sP, vi * 32, ti * 32, lane, accO);
                accO = tile_mm64(sST, sQh, vi * 32, ti * 32, lane, accO);
            }
            __syncthreads();
        }
        const int vi = w >> 1, ti = w & 1;
        float ssq = 0.f;
#pragma unroll
        for (int r = 0; r < 16; ++r) ssq += accO[r] * accO[r];
        ssq += __shfl_xor(ssq, 32);
        sSS[w * 64 + lane] = ssq;
        __syncthreads();
        const float tot = sSS[ti * 64 + l31] + sSS[(2 + ti) * 64 + l31];
        const float rs = rsqrtf(tot * (1.0f / 64.0f) + EPS);
        const int tok = tok0 + ti * 32 + l31;
#pragma unroll
        for (int g = 0; g < 4; ++g) {
            const int v0 = vi * 32 + 8 * g + 4 * hh;
            const uint2 gz = *(const uint2*)(p.z() + (size_t)tok * INW + 2560 + h * 64 + v0);
            const float4 gn = *(const float4*)(p.hg_g + h * 64 + v0);
            const float g0 = bflo(gz.x), g1 = bfhi(gz.x), g2 = bflo(gz.y), g3 = bfhi(gz.y);
            const float o0 = accO[4 * g] * rs * gn.x * (g0 / (1.0f + __expf(-g0)));
            const float o1 = accO[4 * g + 1] * rs * gn.y * (g1 / (1.0f + __expf(-g1)));
            const float o2 = accO[4 * g + 2] * rs * gn.z * (g2 / (1.0f + __expf(-g2)));
            const float o3 = accO[4 * g + 3] * rs * gn.w * (g3 / (1.0f + __expf(-g3)));
            uint2 pk; pk.x = pack2(o0, o1); pk.y = pack2(o2, o3);
            *(uint2*)(p.mix() + (size_t)tok * D + 512 + h * 64 + v0) = pk;
        }
    }
    for (int wu = VBID * 4 + w; wu < 4096; wu += VGRID * 4) mem_attn_wave(p, wu, lane);
}


__device__ __forceinline__ int ord_key(int fb) { return fb ^ ((fb >> 31) & 0x7FFFFFFF); }

template <int N>
__device__ __forceinline__ void bitonic_sort_desc(int (&v)[N]) {
#pragma unroll
    for (int k = 2; k <= N; k <<= 1) {
#pragma unroll
        for (int j = k >> 1; j > 0; j >>= 1) {
#pragma unroll
            for (int i = 0; i < N; ++i) {
                const int l = i ^ j;
                if (l > i) {
                    const bool desc = ((i & k) == 0);
                    const int a = v[i], b = v[l];
                    const int mx = max(a, b), mn = min(a, b);
                    v[i] = desc ? mx : mn;
                    v[l] = desc ? mn : mx;
                }
            }
        }
    }
}
template <int N>
__device__ __forceinline__ void bitonic_merge_desc(int (&v)[N]) {
#pragma unroll
    for (int j = N >> 1; j > 0; j >>= 1) {
#pragma unroll
        for (int i = 0; i < N; ++i) {
            const int l = i ^ j;
            if (l > i) {
                const int a = v[i], b = v[l];
                v[i] = max(a, b);
                v[l] = min(a, b);
            }
        }
    }
}
__device__ __forceinline__ void merge_prune16(int (&r)[16], const int (&o)[16]) {
#pragma unroll
    for (int i = 0; i < 16; ++i) r[i] = max(r[i], o[15 - i]);
    bitonic_merge_desc<16>(r);
}

__device__ void phase_route(const Params& p, char* smem) {
    char* sk = smem;
    const int tid = VTID, lane = tid & 63, w = tid >> 6;
    int* sA = (int*)(smem + 32768) + w * 2048;
    int* sB = (int*)(smem + 65536) + w * 512;
    const int tl = lane & 31, hh = lane >> 5;
    const int h = VBID & 7, tg0 = VBID >> 3, tgs = VGRID >> 3;
    for (int base = tg0; base < 256; base += 4 * tgs)
    for (int c = 0; c < 2; ++c) {
        const int hc = h * 2 + c;
        __syncthreads();
        {
            const bf16_t* sp = p.subk_b() + (size_t)hc * 16384;
#pragma unroll
            for (int i = 0; i < 8; ++i) {
                const int ch = tid + 256 * i;
                const int row = ch >> 4, cc = ch & 15;
                const uint4 v = *(const uint4*)(sp + row * 128 + cc * 8);
                *(uint4*)(sk + row * 256 + ((cc ^ (row & 15)) << 4)) = v;
            }
        }
        __syncthreads();
        bf16x8 qf[8];
        if (base < 256) {
            const bf16_t* qr = p.z() + (size_t)(base * 128 + w * 32 + tl) * QW + hc * 128 + hh * 8;
#pragma unroll
            for (int ks = 0; ks < 8; ++ks) qf[ks] = *(const bf16x8*)(qr + ks * 16);
        }
        for (int it = 0; it < 4; ++it) {
            const int tgp = base + it * tgs;
            if (tgp >= 256) break;
            const int tok = tgp * 128 + w * 32 + tl;
            int* sidx = sA + it * 512;
            f32x16 acc4[4];
#pragma unroll
            for (int kb = 0; kb < 4; ++kb) {
#pragma unroll
                for (int r = 0; r < 16; ++r) acc4[kb][r] = 0.f;
                const int row = kb * 32 + tl;
#pragma unroll
                for (int ks = 0; ks < 8; ++ks) {
                    const bf16x8 af = *(const bf16x8*)(sk + row * 256 + (((ks * 2 + hh) ^ (row & 15)) << 4));
                    acc4[kb] = __builtin_amdgcn_mfma_f32_32x32x16_bf16(af, qf[ks], acc4[kb], 0, 0, 0);
                }
            }
            if (it + 1 < 4 && tgp + tgs < 256) {
                const bf16_t* qr = p.z() + (size_t)((tgp + tgs) * 128 + w * 32 + tl) * QW + hc * 128 + hh * 8;
#pragma unroll
                for (int ks = 0; ks < 8; ++ks) qf[ks] = *(const bf16x8*)(qr + ks * 16);
            }
            int cur[16];
#pragma unroll
            for (int kb = 0; kb < 4; ++kb) {
                int v[16];
#pragma unroll
                for (int r = 0; r < 16; ++r) {
                    const int key = kb * 32 + (r & 3) + 8 * (r >> 2) + 4 * hh;
                    const int fb = (__float_as_int(acc4[kb][r]) & ~127) | (127 - key);
                    v[r] = ord_key(fb);
                }
                bitonic_sort_desc<16>(v);
                if (kb == 0) {
#pragma unroll
                    for (int r = 0; r < 16; ++r) cur[r] = v[r];
                } else {
                    merge_prune16(cur, v);
                }
            }
            {
                int o[16];
#pragma unroll
                for (int r = 0; r < 16; ++r) o[r] = __shfl_xor(cur[r], 32);
                merge_prune16(cur, o);
            }
            if (c == 0) {
#pragma unroll
                for (int r = 0; r < 16; ++r) sidx[r * 32 + tl] = cur[r];
                continue;
            }
#pragma unroll
            for (int r = 0; r < 16; ++r) sB[r * 32 + tl] = cur[r];
        float va[16], vb[16];
#pragma unroll
        for (int r = 0; r < 16; ++r) {
            const int fa = ord_key(sidx[r * 32 + tl]), fb = ord_key(sB[r * 32 + tl]);
            va[r] = __int_as_float(fa & ~127);
            vb[r] = __int_as_float(fb & ~127);
        }
        int best[16];
#pragma unroll
        for (int j = 0; j < 16; ++j) best[j] = ord_key((__float_as_int(va[0] + vb[j]) & ~255) | (255 - j));
#pragma unroll
        for (int i = 1; i < 8; ++i) {
            const int n = 16 / (i + 1);
            int row[16];
#pragma unroll
            for (int j = 0; j < 16; ++j)
                row[j] = (j < n) ? ord_key((__float_as_int(va[i] + vb[j]) & ~255) | (255 - (i * 16 + j))) : (int)0x80000000;
            merge_prune16(best, row);
        }
        {
            int row[16];
#pragma unroll
            for (int j = 0; j < 16; ++j)
                row[j] = (j < 8) ? ord_key((__float_as_int(va[8 + j] + vb[0]) & ~255) | (255 - ((8 + j) * 16))) : (int)0x80000000;
            merge_prune16(best, row);
        }
        float sv[16];
        int pid[16];
#pragma unroll
        for (int r = 0; r < 16; ++r) {
            const int cb = ord_key(best[r]);
            sv[r] = __int_as_float(cb & ~255);
            pid[r] = 255 - (cb & 255);
        }
        float tot = 0.f;
        const float smax = sv[0];
#pragma unroll
        for (int r = 0; r < 16; ++r) { sv[r] = __expf(sv[r] - smax); tot += sv[r]; }
        const float inv = 1.0f / tot;
        if (hh == 0) {
#pragma unroll
            for (int r = 0; r < 16; ++r) {
                const int ia = 127 - (ord_key(sidx[(pid[r] >> 4) * 32 + tl]) & 127);
                const int ib = 127 - (ord_key(sB[(pid[r] & 15) * 32 + tl]) & 127);
                const int pos = (r & 7) * 16 + h * 2 + (r >> 3);
                p.eidx()[(size_t)tok * 128 + pos] = (unsigned short)(ia * 128 + ib);
                p.gate()[(size_t)tok * 128 + pos] = sv[r] * inv;
            }
        }
        }
    }
}

constexpr int PEER_TG = 512;
constexpr int PEER_TPW = PEER_TG / 8;
constexpr int PEER_NTG = NTOK / PEER_TG;
constexpr int PEER_NCH = 8;

#define PEER_G1(base, wv, hi) (*(const uint4*)((base) + (unsigned)((((hi) ? ((wv) >> 16) : ((wv) & 0xFFFFu)) << 7) + dlo)))
#define PEER_GATHER16(dst, base, ia, ib)                                                             \
    dst[0] = PEER_G1(base, (ia).x, 0);  dst[1] = PEER_G1(base, (ia).x, 1);  dst[2] = PEER_G1(base, (ia).y, 0);  dst[3] = PEER_G1(base, (ia).y, 1);   \
    dst[4] = PEER_G1(base, (ia).z, 0);  dst[5] = PEER_G1(base, (ia).z, 1);  dst[6] = PEER_G1(base, (ia).w, 0);  dst[7] = PEER_G1(base, (ia).w, 1);   \
    dst[8] = PEER_G1(base, (ib).x, 0);  dst[9] = PEER_G1(base, (ib).x, 1);  dst[10] = PEER_G1(base, (ib).y, 0); dst[11] = PEER_G1(base, (ib).y, 1);  \
    dst[12] = PEER_G1(base, (ib).z, 0); dst[13] = PEER_G1(base, (ib).z, 1); dst[14] = PEER_G1(base, (ib).w, 0); dst[15] = PEER_G1(base, (ib).w, 1);

__device__ __forceinline__ unsigned quant4(float a, float b, float c, float d, float qs) {
    const int q0 = (int)rintf(__builtin_amdgcn_fmed3f(a * qs, -127.f, 127.f)), q1 = (int)rintf(__builtin_amdgcn_fmed3f(b * qs, -127.f, 127.f));
    const int q2 = (int)rintf(__builtin_amdgcn_fmed3f(c * qs, -127.f, 127.f)), q3 = (int)rintf(__builtin_amdgcn_fmed3f(d * qs, -127.f, 127.f));
    return (unsigned)(q0 & 255) | ((unsigned)(q1 & 255) << 8) | ((unsigned)(q2 & 255) << 16) | ((unsigned)(q3 & 255) << 24);
}
template <int CTRL>
__device__ __forceinline__ int dpp_movi(int v) { return __builtin_amdgcn_update_dpp(0, v, CTRL, 0xf, 0xf, true); }

struct DotTok { uint4 ia, ib; uint4 ha, hb; float hm; };
__device__ __forceinline__ void dots_load(const Params& p, DotTok& t, int tok, int c, int g, int d8) {
    const uint4* idp = (const uint4*)(p.eidx() + (size_t)tok * 128 + g * 16);
    t.ia = idp[0]; t.ib = idp[1];
    const uint4* hp = (const uint4*)(p.h() + (size_t)tok * D + c * 128 + d8 * 16);
    t.ha = hp[0]; t.hb = hp[1];
    t.hm = __uint_as_float(p.hmax()[tok]);
}
__device__ __forceinline__ void dotsf_load(const Params& p, DotTok& t, int tokb, int s, int g, int d8) {
    dots_load(p, t, tokb + 8 * (s & 15), s >> 4, g, d8);
}
__device__ __forceinline__ void dotsf_finish(const uint4 (&uu)[16], const DotTok& t, int* part, int g, int d8) {
    const float qs = t.hm > 0.f ? 127.0f / t.hm : 0.f;
    const int h0 = (int)quant4(bflo(t.ha.x), bfhi(t.ha.x), bflo(t.ha.y), bfhi(t.ha.y), qs);
    const int h1 = (int)quant4(bflo(t.ha.z), bfhi(t.ha.z), bflo(t.ha.w), bfhi(t.ha.w), qs);
    const int h2 = (int)quant4(bflo(t.hb.x), bfhi(t.hb.x), bflo(t.hb.y), bfhi(t.hb.y), qs);
    const int h3 = (int)quant4(bflo(t.hb.z), bfhi(t.hb.z), bflo(t.hb.w), bfhi(t.hb.w), qs);
    int acc[16];
#pragma unroll
    for (int i = 0; i < 16; ++i) {
        int a = __builtin_amdgcn_sdot4((int)uu[i].x, h0, 0, false);
        a = __builtin_amdgcn_sdot4((int)uu[i].y, h1, a, false);
        a = __builtin_amdgcn_sdot4((int)uu[i].z, h2, a, false);
        a = __builtin_amdgcn_sdot4((int)uu[i].w, h3, a, false);
        a += dpp_movi<DPP_QP_X1>(a);
        a += dpp_movi<DPP_QP_X2>(a);
        a += dpp_movi<DPP_HMIRROR>(a);
        acc[i] = a;
    }
    if (d8 == 0) {
        int4* dst = (int4*)(part + g * 16);
#pragma unroll
        for (int q = 0; q < 4; ++q) {
            int4 v = dst[q];
            v.x += acc[4 * q]; v.y += acc[4 * q + 1]; v.z += acc[4 * q + 2]; v.w += acc[4 * q + 3];
            dst[q] = v;
        }
    }
}

__device__ __forceinline__ float gelu_erf(float v);

__device__ void phase_peer_dots(const Params& p, char* smem) {
    const int tid = threadIdx.x, lane = tid & 63, w = tid >> 6;
    const int g = lane >> 3, d8 = lane & 7;
    int* part = (int*)smem + w * 2048;
    for (int tgp = blockIdx.x; tgp < NTOK / 128; tgp += gridDim.x) {
        const int tokb = tgp * 128 + w;
        __syncthreads();
        for (int i = lane; i < 2048; i += 64) part[i] = 0;
        __syncthreads();
        const char* ubase = (const char*)p.u_c();
        const unsigned dlo = d8 * 16;
        DotTok ta, tb, tn;
        uint4 ua[16], ubuf[16];
        dotsf_load(p, ta, tokb, 0, g, d8);
        dotsf_load(p, tb, tokb, 1, g, d8);
        PEER_GATHER16(ua, ubase, ta.ia, ta.ib)
        PEER_GATHER16(ubuf, ubase, tb.ia, tb.ib)
        dotsf_load(p, tn, tokb, 2, g, d8);
        for (int s = 0; s < 128; s += 2) {
            dotsf_finish(ua, ta, part + (s & 15) * 128, g, d8);
            if (s + 2 < 128) {
                ta = tn;
                const char* ub = ubase + (size_t)((s + 2) >> 4) * 16384 * 128;
                PEER_GATHER16(ua, ub, ta.ia, ta.ib)
                dotsf_load(p, tn, tokb, min(s + 3, 127), g, d8);
            }
            dotsf_finish(ubuf, tb, part + ((s + 1) & 15) * 128, g, d8);
            if (s + 3 < 128) {
                tb = tn;
                const char* ub = ubase + (size_t)((s + 3) >> 4) * 16384 * 128;
                PEER_GATHER16(ubuf, ub, tb.ia, tb.ib)
                dotsf_load(p, tn, tokb, min(s + 4, 127), g, d8);
            }
        }
        __syncthreads();
        for (int k0 = 0; k0 < 16; k0 += 4) {
            int ps[4][2], e[4][2];
            float gt[4][2], sh[4];
#pragma unroll
            for (int q = 0; q < 4; ++q) {
                const int tok = tokb + 8 * (k0 + q);
                sh[q] = __uint_as_float(p.hmax()[tok]) * (1.0f / 127.0f) * rsqrtf(p.ss1()[tok] * (1.0f / 1024.0f) + EPS);
#pragma unroll
                for (int u = 0; u < 2; ++u) {
                    const int slot = lane + 64 * u;
                    ps[q][u] = part[(k0 + q) * 128 + slot];
                    e[q][u] = p.eidx()[(size_t)tok * 128 + slot];
                    gt[q][u] = p.gate()[(size_t)tok * 128 + slot];
                }
            }
            float su[4][2], sv[4][2];
#pragma unroll
            for (int q = 0; q < 4; ++q)
#pragma unroll
                for (int u = 0; u < 2; ++u) { su[q][u] = p.scale_u()[e[q][u]]; sv[q][u] = p.scale_v()[e[q][u]]; }
#pragma unroll
            for (int q = 0; q < 4; ++q) {
                const int tok = tokb + 8 * (k0 + q);
                float cf[2];
#pragma unroll
                for (int u = 0; u < 2; ++u) cf[u] = gelu_erf((float)ps[q][u] * su[q][u] * sh[q]) * gt[q][u] * sv[q][u];
                const float cm = wave_max(fmaxf(fabsf(cf[0]), fabsf(cf[1])));
                const float qs = cm > 0.f ? 127.0f / cm : 0.f;
                p.coef()[(size_t)tok * 128 + lane] = (signed char)(int)rintf(cf[0] * qs);
                p.coef()[(size_t)tok * 128 + lane + 64] = (signed char)(int)rintf(cf[1] * qs);
                if (lane == 0) p.csum()[tok] = cm * (1.0f / 127.0f);
            }
        }
    }
}

__device__ __forceinline__ float gelu_erf(float v) {
    const float av = fabsf(v);
    const float t = __builtin_amdgcn_rcpf(fmaf(av, 0.2316418882f, 1.0f));
    float q = fmaf(t, 0.5307027145f, -0.7265760135f);
    q = fmaf(q, t, 0.7107068705f);
    q = fmaf(q, t, -0.142248368f);
    q = fmaf(q, t, 0.127414796f);
    q = q * t;
    const float e = __builtin_amdgcn_exp2f(v * v * -0.72134752044f);
    const float m = v * (q * e);
    return v < 0.f ? m : v - m;
}
struct AccTok { uint4 ia, ib; uint4 cq; float cs; };
__device__ __forceinline__ void acc_load(const Params& p, AccTok& t, int tok, int g) {
    const uint4* idp = (const uint4*)(p.eidx() + (size_t)tok * 128 + g * 16);
    t.ia = idp[0]; t.ib = idp[1];
    t.cq = *(const uint4*)(p.coef() + (size_t)tok * 128 + g * 16);
    t.cs = p.csum()[tok];
}
#define PEER_T4DOT(acc, B, r0, r1, r2, r3, cq)                                   \
    {                                                                            \
        const unsigned t0 = __builtin_amdgcn_perm(r1, r0, 0x05010400u), t1 = __builtin_amdgcn_perm(r1, r0, 0x07030602u); \
        const unsigned t2 = __builtin_amdgcn_perm(r3, r2, 0x05010400u), t3 = __builtin_amdgcn_perm(r3, r2, 0x07030602u); \
        acc[(B) + 0] = __builtin_amdgcn_sdot4((int)__builtin_amdgcn_perm(t2, t0, 0x05040100u), (int)(cq), acc[(B) + 0], false); \
        acc[(B) + 1] = __builtin_amdgcn_sdot4((int)__builtin_amdgcn_perm(t2, t0, 0x07060302u), (int)(cq), acc[(B) + 1], false); \
        acc[(B) + 2] = __builtin_amdgcn_sdot4((int)__builtin_amdgcn_perm(t3, t1, 0x05040100u), (int)(cq), acc[(B) + 2], false); \
        acc[(B) + 3] = __builtin_amdgcn_sdot4((int)__builtin_amdgcn_perm(t3, t1, 0x07060302u), (int)(cq), acc[(B) + 3], false); \
    }
__device__ __forceinline__ void accf_finish(const uint4 (&vv)[16], const AccTok& t, char* rowp, int g) {
    const unsigned cw[4] = {t.cq.x, t.cq.y, t.cq.z, t.cq.w};
    int acc[16];
#pragma unroll
    for (int j = 0; j < 16; ++j) acc[j] = 0;
#pragma unroll
    for (int j = 0; j < 4; ++j) {
        PEER_T4DOT(acc, 0, vv[4 * j].x, vv[4 * j + 1].x, vv[4 * j + 2].x, vv[4 * j + 3].x, cw[j])
        PEER_T4DOT(acc, 4, vv[4 * j].y, vv[4 * j + 1].y, vv[4 * j + 2].y, vv[4 * j + 3].y, cw[j])
        PEER_T4DOT(acc, 8, vv[4 * j].z, vv[4 * j + 1].z, vv[4 * j + 2].z, vv[4 * j + 3].z, cw[j])
        PEER_T4DOT(acc, 12, vv[4 * j].w, vv[4 * j + 1].w, vv[4 * j + 2].w, vv[4 * j + 3].w, cw[j])
    }
    float o[16];
#pragma unroll
    for (int j = 0; j < 16; ++j) {
        int v = acc[j];
        v += dpp_movi<DPP_ROR8>(v);
        v += __shfl_xor(v, 16);
        v += __shfl_xor(v, 32);
        o[j] = (float)v * t.cs;
    }
    if (g == 0) {
        uint4 w0, w1;
        w0.x = pack2(o[0], o[1]); w0.y = pack2(o[2], o[3]); w0.z = pack2(o[4], o[5]); w0.w = pack2(o[6], o[7]);
        w1.x = pack2(o[8], o[9]); w1.y = pack2(o[10], o[11]); w1.z = pack2(o[12], o[13]); w1.w = pack2(o[14], o[15]);
        uint4* dst = (uint4*)rowp;
        dst[0] = w0; dst[1] = w1;
    }
}

__device__ void phase_peer_accum(const Params& p, char* smem) {
    const int tid = threadIdx.x, lane = tid & 63, w = tid >> 6;
    const int g = lane >> 3, d8 = lane & 7;
    char* rowbuf = smem + w * 16384;
    for (int tgp = blockIdx.x; tgp < NTOK / 64; tgp += gridDim.x) {
        const int tokb = tgp * 64 + w;
        __syncthreads();
        const char* vbase = (const char*)p.v_c();
        const unsigned dlo = d8 * 16;
        AccTok ta, tb, tn;
        uint4 va[16], vbuf[16];
        acc_load(p, ta, tokb, g);
        acc_load(p, tb, tokb + 8, g);
        PEER_GATHER16(va, vbase, ta.ia, ta.ib)
        PEER_GATHER16(vbuf, vbase, tb.ia, tb.ib)
        acc_load(p, tn, tokb + 16, g);
        for (int s = 0; s < 64; s += 2) {
            accf_finish(va, ta, rowbuf + (s & 7) * 2048 + (s >> 3) * 256 + d8 * 32, g);
            if (s + 2 < 64) {
                ta = tn;
                const char* vb = vbase + (size_t)((s + 2) >> 3) * 16384 * 128;
                PEER_GATHER16(va, vb, ta.ia, ta.ib)
                acc_load(p, tn, tokb + 8 * (min(s + 3, 63) & 7), g);
            }
            accf_finish(vbuf, tb, rowbuf + ((s + 1) & 7) * 2048 + ((s + 1) >> 3) * 256 + d8 * 32, g);
            if (s + 3 < 64) {
                tb = tn;
                const char* vb = vbase + (size_t)((s + 3) >> 3) * 16384 * 128;
                PEER_GATHER16(vbuf, vb, tb.ia, tb.ib)
                acc_load(p, tn, tokb + 8 * (min(s + 4, 63) & 7), g);
            }
        }
        __syncthreads();
        for (int k0 = 0; k0 < 8; k0 += 2) {
            float4 v[2][4];
#pragma unroll
            for (int q = 0; q < 2; ++q) {
                const bf16_t* xrow = p.x1b() + (size_t)(tokb + 8 * (k0 + q)) * D;
#pragma unroll
                for (int j = 0; j < 4; ++j) {
                    const uint2 xk = *(const uint2*)(xrow + (j * 64 + lane) * 4);
                    v[q][j] = make_float4(bflo(xk.x), bfhi(xk.x), bflo(xk.y), bfhi(xk.y));
                }
            }
#pragma unroll
            for (int q = 0; q < 2; ++q) {
                float* orow = p.out + (size_t)(tokb + 8 * (k0 + q)) * D;
                const char* prow = rowbuf + (k0 + q) * 2048;
                float ss = 0.f;
#pragma unroll
                for (int j = 0; j < 4; ++j) {
                    const uint2 pk = *(const uint2*)(prow + (j * 64 + lane) * 8);
                    v[q][j].x += bflo(pk.x); v[q][j].y += bfhi(pk.x); v[q][j].z += bflo(pk.y); v[q][j].w += bfhi(pk.y);
                    ss += v[q][j].x * v[q][j].x + v[q][j].y * v[q][j].y + v[q][j].z * v[q][j].z + v[q][j].w * v[q][j].w;
                }
                ss = wave_sum(ss);
                const float rs = rsqrtf(ss * (1.0f / 1024.0f) + EPS);
#pragma unroll
                for (int j = 0; j < 4; ++j) {
                    const float4 gg = *(const float4*)(p.fin_g + (j * 64 + lane) * 4);
                    float4 o;
                    o.x = v[q][j].x * rs * gg.x; o.y = v[q][j].y * rs * gg.y; o.z = v[q][j].z * rs * gg.z; o.w = v[q][j].w * rs * gg.w;
                    *(float4*)(orow + (j * 64 + lane) * 4) = o;
                }
            }
        }
    }
}

#define XB_TMO      128
#define XB_XCNT(j)  (256  + 64 * (j))
#define XB_XSUB(j)  (1280 + 64 * (j))
#define XB_XGEN(j)  (2304 + 64 * (j))
#define XB_TOP      3328
#define XB_TOPGEN   3392
#define XCD_BAR_WORDS 3456
#define XB_SPIN_CAP (1u << 18)
__device__ __forceinline__ unsigned xb_ld(unsigned* p)              { return __hip_atomic_load(p, __ATOMIC_RELAXED, __HIP_MEMORY_SCOPE_AGENT); }
__device__ __forceinline__ unsigned xb_add(unsigned* p, unsigned v) { return __hip_atomic_fetch_add(p, v, __ATOMIC_RELAXED, __HIP_MEMORY_SCOPE_AGENT); }
#define XB_SPIN(cond, bar) do { unsigned _sp = 0; while (cond) { __builtin_amdgcn_s_sleep(1); \
    if ((++_sp & 255u) == 0u) { if (xb_ld(&(bar)[XB_TMO])) break; if (_sp > XB_SPIN_CAP) { atomicAdd(&(bar)[XB_TMO], 1u); break; } } } } while (0)

struct XcdBarrier { unsigned* bar; unsigned x; volatile unsigned* st; };

__device__ __forceinline__ XcdBarrier xcd_barrier_post(unsigned* bar, volatile unsigned* st) {
    XcdBarrier b; b.bar = bar; b.x = xcc_id(); b.st = st;
    if (threadIdx.x == 0) (void)xb_add(&bar[XB_XCNT(b.x)], 1u);
    return b;
}
__device__ __forceinline__ void xcd_barrier_complete(unsigned* bar, unsigned x, unsigned& nloc, unsigned& nx) {
    const unsigned G = gridDim.x * gridDim.y * gridDim.z;
    unsigned sum, cnt, mine, sp = 0u;
    for (;;) {
        sum = 0u; cnt = 0u; mine = 0u;
#pragma unroll
        for (unsigned j = 0; j < 16; ++j) { const unsigned c = xb_ld(&bar[XB_XCNT(j)]); sum += c; cnt += (c > 0u) ? 1u : 0u; mine = (j == x) ? c : mine; }
        if (sum == G) break;
        __builtin_amdgcn_s_sleep(1);
        if ((++sp & 255u) == 0u) { if (xb_ld(&bar[XB_TMO])) break; if (sp > XB_SPIN_CAP) { atomicAdd(&bar[XB_TMO], 1u); break; } }
    }
    nloc = mine > 0u ? mine : 1u; nx = cnt > 0u ? cnt : 1u;
}
__device__ __forceinline__ void xcd_barrier(const XcdBarrier& b) {
    asm volatile("s_waitcnt vmcnt(0)" ::: "memory");
    __syncthreads();
    if (threadIdx.x == 0) {
        unsigned* bar = b.bar;
        __builtin_amdgcn_s_waitcnt(0);
        unsigned nloc = b.st[0], nx = b.st[1];
        if (nloc == 0u) { xcd_barrier_complete(bar, b.x, nloc, nx); b.st[0] = nloc; b.st[1] = nx; }
        const unsigned old = xb_add(&bar[XB_XSUB(b.x)], 1u);
        const unsigned gen = old / nloc;
        if (old + 1u == (gen + 1u) * nloc) {
            __builtin_amdgcn_fence(__ATOMIC_RELEASE, "agent");
            asm volatile("s_waitcnt vmcnt(0)" ::: "memory");
            const unsigned og = xb_add(&bar[XB_TOP], 1u);
            const unsigned tg = og / nx;
            if (og + 1u == (tg + 1u) * nx) xb_add(&bar[XB_TOPGEN], 1u);
            else XB_SPIN(xb_ld(&bar[XB_TOPGEN]) == tg, bar);
            __builtin_amdgcn_fence(__ATOMIC_ACQUIRE, "agent");
            xb_add(&bar[XB_XGEN(b.x)], 1u);
            asm volatile("s_waitcnt vmcnt(0)" ::: "memory");
        } else {
            XB_SPIN(xb_ld(&bar[XB_XGEN(b.x)]) == gen, bar);
            __builtin_amdgcn_fence(__ATOMIC_ACQUIRE, "agent");
            asm volatile("s_waitcnt vmcnt(0)" ::: "memory");
        }
    }
    __syncthreads();
}

#define RUN_PHASE(K, CALL)                                              \
    if (ph_lo <= (K) && (K) < ph_hi) {                                  \
        CALL;                                                           \
        if (COOP) { if ((K) + 1 < ph_hi) { xcd_barrier(xb); } } \
    }

template <bool COOP>
__global__ void __launch_bounds__(512, 2) fwd_kernel(Params p, int ph_lo, int ph_hi) {
    __shared__ __attribute__((aligned(16))) char smem[SMEM_BYTES + 16];
    char* smh = smem + VHB * HALF_SMEM;
    XcdBarrier xb;
    if (COOP) {
        if (threadIdx.x == 0) *(uint4*)(smem + SMEM_BYTES) = make_uint4(0u, 0u, 0u, 0u);
        __syncthreads();
        xb = xcd_barrier_post(p.bar(), (volatile unsigned*)(smem + SMEM_BYTES));
    }
    if (COOP) { if (ph_lo < 0) cg::this_grid().sync(); }
    RUN_PHASE(0, phase_prep(p, smh))
    RUN_PHASE(1, phase_gemm_in(p, smem))
    RUN_PHASE(2, phase_mixers(p, smh))
    RUN_PHASE(3, (phase_gemm_kv(p, smh), phase_hg_scan(p)))
    RUN_PHASE(4, phase_hg_out(p, smh))
    RUN_PHASE(5, phase_gemm_out(p, smem))
    RUN_PHASE(7, phase_gemm_q(p, smem))
    RUN_PHASE(8, phase_route(p, smh))
    RUN_PHASE(10, phase_peer_dots(p, smem))
    RUN_PHASE(12, phase_peer_accum(p, smem))
}

extern "C" void kernel_launch(void* const* d_in, const int* in_sizes, int n_in, void* d_out, int out_size, void* d_ws, size_t ws_size,
                              hipStream_t stream) {
    Params p{};
    p.x = (const float*)d_in[0]; p.mem = (const float*)d_in[1]; p.attn_g = (const float*)d_in[2]; p.w_in = (const float*)d_in[3];
    p.rpb = (const float*)d_in[4]; p.hg_lb = (const float*)d_in[5]; p.hg_g = (const float*)d_in[6]; p.mem_g = (const float*)d_in[7];
    p.w_kv = (const float*)d_in[8]; p.w_out = (const float*)d_in[9]; p.ffn_g = (const float*)d_in[10]; p.w_q = (const float*)d_in[11];
    p.subk = (const float*)d_in[12]; p.pu = (const float*)d_in[13]; p.pv = (const float*)d_in[14]; p.fin_g = (const float*)d_in[15];
    p.out = (float*)d_out;
    p.ws = (char*)d_ws;
    if (WS_TOTAL > ws_size) { fprintf(stderr, "workspace too small: need %zu have %zu\n", (size_t)WS_TOTAL, ws_size); return; }

#if defined(MULTI_LAUNCH)
    for (int ph = 0; ph < NPHASE; ++ph) fwd_kernel<false><<<dim3(512), dim3(512), 0, stream>>>(p, ph, ph + 1);
#else
    static int grid_blocks = 0;
    if (!grid_blocks) {
        int dev = 0, cus = 0, per_cu = 0;
        hipGetDevice(&dev);
        hipDeviceGetAttribute(&cus, hipDeviceAttributeMultiprocessorCount, dev);
        hipOccupancyMaxActiveBlocksPerMultiprocessor(&per_cu, fwd_kernel<true>, 512, 0);
        if (per_cu > 1) per_cu = 1;
        grid_blocks = (cus * per_cu) & ~3;
    }
    (void)hipMemsetAsync((char*)d_ws + OFF_BAR, 0, XCD_BAR_WORDS * 4, stream);
    int lo = 0, hi = NPHASE;
    void* args[] = {&p, &lo, &hi};
    hipError_t e = hipLaunchCooperativeKernel((void*)fwd_kernel<true>, dim3(grid_blocks), dim3(512), args, 0, stream);
    if (e != hipSuccess) fprintf(stderr, "cooperative launch failed: %s (grid %d)\n", hipGetErrorString(e), grid_blocks);
#endif
}
```

```cpp
#include <hip/hip_runtime.h>
#include <hip/hip_cooperative_groups.h>
#include <stdint.h>
#include <cstdio>

namespace cg = cooperative_groups;

#define VTID ((int)(threadIdx.x & 255))
#define VHB ((int)(threadIdx.x >> 8))
#define VBID ((int)(blockIdx.x * 2 + (threadIdx.x >> 8)))
#define VGRID ((int)(gridDim.x * 2))
constexpr int HALF_SMEM = 73728;

typedef unsigned short bf16_t;
typedef short bf16x8 __attribute__((ext_vector_type(8)));
typedef float f32x4 __attribute__((ext_vector_type(4)));

constexpr int D = 1024;
constexpr int NB = 4;
constexpr int T = 8192;
constexpr int NTOK = NB * T;
constexpr int INW = 3072;
constexpr int QW = 2048;
constexpr float EPS = 1e-6f;
constexpr int SMEM_BYTES = 2 * 73728;
constexpr int NPHASE = 14;

constexpr size_t al256(size_t x) { return (x + 255) & ~(size_t)255; }
constexpr size_t OFF_W_IN_T = 0;
constexpr size_t OFF_W_OUT_T = OFF_W_IN_T + al256((size_t)3072 * 1024 * 2);
constexpr size_t OFF_W_Q_T = OFF_W_OUT_T + al256((size_t)1024 * 1024 * 2);
constexpr size_t OFF_W_KV_T = OFF_W_Q_T + al256((size_t)2048 * 1024 * 2);
constexpr size_t OFF_H = OFF_W_KV_T + al256((size_t)512 * 1024 * 2);
constexpr size_t OFF_Z = OFF_H + al256((size_t)32768 * 1024 * 2);
constexpr size_t OFF_MIX = OFF_Z + al256((size_t)32768 * 3072 * 2);
constexpr size_t OFF_MEMN = OFF_MIX + al256((size_t)32768 * 1024 * 2);
constexpr size_t OFF_KVB = OFF_MEMN + al256((size_t)1024 * 1024 * 2);
constexpr size_t OFF_LB = OFF_KVB + al256((size_t)1024 * 512 * 2);
constexpr size_t OFF_HSTATE = OFF_LB + al256(512 * 4);
constexpr size_t OFF_HDEC = OFF_HSTATE + al256((size_t)4096 * 4096 * 4);
constexpr size_t OFF_UC = OFF_HDEC + al256((size_t)4096 * 64 * 4);
constexpr size_t OFF_VC = OFF_UC + al256((size_t)16384 * 1024);
constexpr size_t OFF_QUEUE = OFF_VC + al256((size_t)16384 * 1024);
constexpr size_t OFF_SUBK = OFF_QUEUE + al256(2048 * 4);
constexpr size_t OFF_BAR = OFF_SUBK + al256((size_t)16 * 128 * 128 * 2);
constexpr size_t OFF_SS1 = OFF_BAR + al256(4096 * 4);
constexpr size_t OFF_HMAX = OFF_SS1 + al256((size_t)32768 * 4);
constexpr size_t OFF_CSUM = OFF_HMAX + al256((size_t)32768 * 4);
constexpr size_t OFF_SCALE_U = OFF_CSUM + al256((size_t)32768 * 4);
constexpr size_t OFF_SCALE_V = OFF_SCALE_U + al256(16384 * 4);
constexpr size_t OFF_VT = OFF_SCALE_V + al256(16384 * 4);
constexpr size_t OFF_KVT = OFF_VT + al256((size_t)32768 * 512 * 2);
constexpr size_t WS_TOTAL = OFF_KVT + al256((size_t)1024 * 256 * 2);
constexpr size_t OFF_EIDX = OFF_HSTATE;
constexpr size_t OFF_GATE = OFF_HSTATE + (size_t)32768 * 128 * 4;
constexpr size_t OFF_COEF = OFF_HSTATE + (size_t)32768 * 128 * 8;
constexpr size_t OFF_SS = OFF_HSTATE + (size_t)32768 * 128 * 12;
constexpr size_t OFF_PARTIAL = OFF_Z;
constexpr size_t OFF_PEER_OUT = OFF_Z + (size_t)8 * 32768 * 128 * 4;

struct Params {
    const float *x, *mem, *attn_g, *w_in, *rpb, *hg_lb, *hg_g, *mem_g, *w_kv, *w_out, *ffn_g, *w_q, *subk, *pu, *pv, *fin_g;
    float* out;
    char* ws;
#define WSF(type, name, off) __device__ __forceinline__ type* name() const { return (type*)(ws + (off)); }
    WSF(bf16_t, w_in_t, OFF_W_IN_T) WSF(bf16_t, w_out_t, OFF_W_OUT_T) WSF(bf16_t, w_q_t, OFF_W_Q_T) WSF(bf16_t, w_kv_t, OFF_W_KV_T)
    WSF(bf16_t, h, OFF_H)
    WSF(bf16_t, z, OFF_Z)
    WSF(bf16_t, mix, OFF_MIX)
    WSF(bf16_t, memn, OFF_MEMN)
    WSF(bf16_t, kvb, OFF_KVB)
    WSF(float, lb, OFF_LB)
    WSF(float, hstate, OFF_HSTATE)
    WSF(float, hdec, OFF_HDEC)
    WSF(unsigned short, eidx, OFF_EIDX)
    WSF(float, gate, OFF_GATE)
    WSF(signed char, coef, OFF_COEF)
    WSF(bf16_t, x1b, OFF_PEER_OUT)
    WSF(float, ss, OFF_SS)
    WSF(float, partial, OFF_PARTIAL)
    WSF(bf16_t, u_c, OFF_UC) WSF(bf16_t, v_c, OFF_VC)
    WSF(unsigned, queue, OFF_QUEUE)
    WSF(bf16_t, subk_b, OFF_SUBK)
    WSF(unsigned, bar, OFF_BAR)
    WSF(float, ss1, OFF_SS1) WSF(unsigned, hmax, OFF_HMAX) WSF(float, csum, OFF_CSUM)
    WSF(float, scale_u, OFF_SCALE_U) WSF(float, scale_v, OFF_SCALE_V)
    WSF(bf16_t, vT, OFF_VT)
    WSF(bf16_t, kvT, OFF_KVT)
#undef WSF
};

__device__ __forceinline__ float bf2f(bf16_t v) { return __uint_as_float(((unsigned)v) << 16); }
__device__ __forceinline__ bf16_t f2bf(float f) {
    unsigned u = __float_as_uint(f);
    u += 0x7FFFu + ((u >> 16) & 1u);
    return (bf16_t)(u >> 16);
}
__device__ __forceinline__ float bflo(unsigned u) { return __uint_as_float(u << 16); }
__device__ __forceinline__ float bfhi(unsigned u) { return __uint_as_float(u & 0xFFFF0000u); }
typedef __bf16 bf16x2v_t __attribute__((ext_vector_type(2)));
typedef float f32x2v_t __attribute__((ext_vector_type(2)));
__device__ __forceinline__ unsigned pack2(float a, float b) {
    const f32x2v_t v = {a, b};
    return __builtin_bit_cast(unsigned, __builtin_convertvector(v, bf16x2v_t));
}

__device__ __forceinline__ float wave_sum(float v) {
#pragma unroll
    for (int o = 32; o; o >>= 1) v += __shfl_xor(v, o);
    return v;
}
__device__ __forceinline__ float wave_max(float v) {
#pragma unroll
    for (int o = 32; o; o >>= 1) v = fmaxf(v, __shfl_xor(v, o));
    return v;
}


typedef __bf16 bf16x2_t __attribute__((ext_vector_type(2)));
template <int CTRL>
__device__ __forceinline__ float dpp_mov(float v) {
    return __builtin_bit_cast(float, __builtin_amdgcn_update_dpp(0, __builtin_bit_cast(int, v), CTRL, 0xf, 0xf, true));
}
#define DPP_QP_X1 0xB1
#define DPP_QP_X2 0x4E
#define DPP_HMIRROR 0x141
#define DPP_ROR8 0x128
__device__ __forceinline__ unsigned xcc_id() { return (unsigned)__builtin_amdgcn_s_getreg((3 << 11) | 20) & 0xFu; }

__device__ __forceinline__ void transpose_tile(const float* __restrict__ in, bf16_t* __restrict__ out, int K, int N, int tile, char* smem) {
    float* tl = (float*)smem;
    const int ntn = N >> 6;
    const int k0 = (tile / ntn) << 6, n0 = (tile % ntn) << 6;
    const int tid = VTID;
    __syncthreads();
#pragma unroll 4
    for (int i = 0; i < 16; ++i) {
        int idx = tid + 256 * i;
        int r = idx >> 6, c = idx & 63;
        tl[r * 65 + c] = in[(size_t)(k0 + r) * N + n0 + c];
    }
    __syncthreads();
#pragma unroll 4
    for (int i = 0; i < 16; ++i) {
        int idx = tid + 256 * i;
        int r = idx >> 6, c = idx & 63;
        out[(size_t)(n0 + r) * K + k0 + c] = f2bf(tl[c * 65 + r]);
    }
}

__device__ __forceinline__ void rmsnorm_row_bf16(const float* __restrict__ xr, const float* __restrict__ g, bf16_t* __restrict__ o, int lane) {
    float4 v[4];
    float ss = 0.f;
#pragma unroll
    for (int j = 0; j < 4; ++j) {
        v[j] = *(const float4*)(xr + (j * 64 + lane) * 4);
        ss += v[j].x * v[j].x + v[j].y * v[j].y + v[j].z * v[j].z + v[j].w * v[j].w;
    }
    ss = wave_sum(ss);
    const float rs = rsqrtf(ss * (1.0f / 1024.0f) + EPS);
#pragma unroll
    for (int j = 0; j < 4; ++j) {
        const float4 gg = *(const float4*)(g + (j * 64 + lane) * 4);
        uint2 pk;
        pk.x = pack2(v[j].x * rs * gg.x, v[j].y * rs * gg.y);
        pk.y = pack2(v[j].z * rs * gg.z, v[j].w * rs * gg.w);
        *(uint2*)(o + (j * 64 + lane) * 4) = pk;
    }
}

__device__ void phase_prep(const Params& p, char* smem) {
    const int tid = VTID, lane = tid & 63, w = tid >> 6;
    const int gsz = VGRID, bid = VBID;
    const int t_in = (1024 / 64) * (INW / 64);
    const int t_out = 16 * 16;
    const int t_q = 16 * (QW / 64);
    const int t_kv = 16 * 8;
    const int t_all = t_in + t_out + t_q + t_kv;
    for (int it = bid; it < t_all; it += gsz) {
        if (it < t_in) transpose_tile(p.w_in, p.w_in_t(), 1024, INW, it, smem);
        else if (it < t_in + t_out) transpose_tile(p.w_out, p.w_out_t(), 1024, 1024, it - t_in, smem);
        else if (it < t_in + t_out + t_q) transpose_tile(p.w_q, p.w_q_t(), 1024, QW, it - t_in - t_out, smem);
        else transpose_tile(p.w_kv, p.w_kv_t(), 1024, 512, it - t_in - t_out - t_q, smem);
    }
    for (int i = bid * 256 + tid; i < NTOK; i += gsz * 256) { p.ss1()[i] = 0.f; p.hmax()[i] = 0u; }
    if (bid == 0) {
        for (int i = tid; i < 512; i += 256) {
            int dir = i >> 8, k = i & 255;
            float a0 = p.hg_lb[(dir * 2 + 0) * 256 + k], a1 = p.hg_lb[(dir * 2 + 1) * 256 + k];
            float m = fmaxf(a0, a1);
            float e0 = expf(a0 - m), e1 = expf(a1 - m);
            p.lb()[i] = e0 / (e0 + e1);
        }
    }
    const int nrows = NTOK + 1024;
    for (int r0 = bid * 4; r0 < nrows; r0 += gsz * 4) {
        int r = r0 + w;
        if (r < NTOK) rmsnorm_row_bf16(p.x + (size_t)r * D, p.attn_g, p.h() + (size_t)r * D, lane);
        else if (r < nrows) rmsnorm_row_bf16(p.mem + (size_t)(r - NTOK) * D, p.mem_g, p.memn() + (size_t)(r - NTOK) * D, lane);
    }
    for (int i = bid * 256 + tid; i < 16 * 128 * 128 / 4; i += gsz * 256) {
        const float4 v = *(const float4*)(p.subk + (size_t)i * 4);
        uint2 pk; pk.x = pack2(v.x, v.y); pk.y = pack2(v.z, v.w);
        *(uint2*)(p.subk_b() + (size_t)i * 4) = pk;
    }
    for (int r0 = bid * 4; r0 < 2 * 16384; r0 += gsz * 4) {
        const int r = r0 + w;
        const bool isv = r >= 16384;
        const int e = r & 16383;
        const float* srcp = (isv ? p.pv : p.pu) + (size_t)e * D;
        unsigned* dst = (unsigned*)(isv ? p.v_c() : p.u_c());
        float4 v[4];
        float am = 0.f;
#pragma unroll
        for (int j = 0; j < 4; ++j) {
            v[j] = *(const float4*)(srcp + (j * 64 + lane) * 4);
            am = fmaxf(am, fmaxf(fmaxf(fabsf(v[j].x), fabsf(v[j].y)), fmaxf(fabsf(v[j].z), fabsf(v[j].w))));
        }
        am = wave_max(am);
        const float qs = am > 0.f ? 127.0f / am : 0.f;
        if (lane == 0) (isv ? p.scale_v() : p.scale_u())[e] = am * (1.0f / 127.0f);
        const int off = 0;
#pragma unroll
        for (int j = 0; j < 4; ++j) {
            const int q0 = (int)rintf(v[j].x * qs) + off, q1 = (int)rintf(v[j].y * qs) + off;
            const int q2 = (int)rintf(v[j].z * qs) + off, q3 = (int)rintf(v[j].w * qs) + off;
            const unsigned pk = (unsigned)(q0 & 255) | ((unsigned)(q1 & 255) << 8) | ((unsigned)(q2 & 255) << 16) | ((unsigned)(q3 & 255) << 24);
            const int c = j * 2 + (lane >> 5), d = (lane & 31) * 4;
            dst[(((size_t)c * 16384 + e) * 128 + d) >> 2] = pk;
        }
    }
}

struct EpiBf16 {
    bf16_t* C; int ldc;
    __device__ __forceinline__ void operator()(int row, int col, const f32x4& v) const {
        uint2 pk; pk.x = pack2(v[0], v[1]); pk.y = pack2(v[2], v[3]);
        *(uint2*)(C + (size_t)row * ldc + col) = pk;
    }
};
struct EpiBf16T {
    bf16_t* C; int col0, ncols, rows_per_b;
    __device__ __forceinline__ void operator()(int row, int col, const f32x4& v) const {
        const int bb = row / rows_per_b, rr = row - bb * rows_per_b;
        uint2 pk; pk.x = pack2(v[0], v[1]); pk.y = pack2(v[2], v[3]);
        *(uint2*)(C + ((size_t)bb * ncols + (col - col0)) * rows_per_b + rr) = pk;
    }
};
struct EpiBf16RowScale {
    bf16_t* C; int ldc; const float* ssrow;
    __device__ __forceinline__ void operator()(int row, int col, const f32x4& v) const {
        const float rs = rsqrtf(ssrow[row] * (1.0f / 1024.0f) + EPS);
        uint2 pk; pk.x = pack2(v[0] * rs, v[1] * rs); pk.y = pack2(v[2] * rs, v[3] * rs);
        *(uint2*)(C + (size_t)row * ldc + col) = pk;
    }
};
struct EpiResNorm {
    bf16_t* C; const float* R; const float* g; bf16_t* H; int ldc; float* ssrow; unsigned* hmax;
    __device__ __forceinline__ void operator()(int row, int col, const f32x4& v, float& ssq, float& am) const {
        const float4 r = *(const float4*)(R + (size_t)row * ldc + col);
        const float4 gg = *(const float4*)(g + col);
        float4 o; o.x = v[0] + r.x; o.y = v[1] + r.y; o.z = v[2] + r.z; o.w = v[3] + r.w;
        { uint2 xk; xk.x = pack2(o.x, o.y); xk.y = pack2(o.z, o.w); *(uint2*)(C + (size_t)row * ldc + col) = xk; }
        const float h0 = o.x * gg.x, h1 = o.y * gg.y, h2 = o.z * gg.z, h3 = o.w * gg.w;
        uint2 pk; pk.x = pack2(h0, h1); pk.y = pack2(h2, h3);
        *(uint2*)(H + (size_t)row * ldc + col) = pk;
        ssq += o.x * o.x + o.y * o.y + o.z * o.z + o.w * o.w;
        am = fmaxf(am, fmaxf(fmaxf(fabsf(h0), fabsf(h1)), fmaxf(fabsf(h2), fabsf(h3))));
    }
    __device__ __forceinline__ void row_done(int row, float ssq, float am) const {
        atomicAdd(ssrow + row, ssq);
        atomicMax(hmax + row, __float_as_uint(am));
    }
};
struct EpiResF32 {
    float* C; const float* R; int ldc;
    __device__ __forceinline__ void operator()(int row, int col, const f32x4& v) const {
        const float4 r = *(const float4*)(R + (size_t)row * ldc + col);
        float4 o; o.x = v[0] + r.x; o.y = v[1] + r.y; o.z = v[2] + r.z; o.w = v[3] + r.w;
        *(float4*)(C + (size_t)row * ldc + col) = o;
    }
};

template <bool TRANS, class Epi, bool ROWSS = false>
__device__ __forceinline__ void gemm_tile(const bf16_t* __restrict__ A, int lda, const bf16_t* __restrict__ Bt, int ldb, int K,
                                          int m0, int n0, char* smem, const Epi& epi, float* ssrow = nullptr) {
    const int tid = VTID, lane = tid & 63, w = tid >> 6, wr = w >> 1, wc = w & 1;
    const int fr = lane & 15, fq = lane >> 4;
    const int srow = lane >> 3, sslot = lane & 7;
    f32x4 acc[4][4];
#pragma unroll
    for (int mi = 0; mi < 4; ++mi)
#pragma unroll
        for (int ni = 0; ni < 4; ++ni) acc[mi][ni] = (f32x4){0.f, 0.f, 0.f, 0.f};
    const int g0 = (sslot ^ (srow >> 1)) * 8, g1 = (sslot ^ (4 + (srow >> 1))) * 8;
    const bf16_t* Ab = A + (size_t)(m0 + w * 32 + srow) * lda;
    const bf16_t* Bb = Bt + (size_t)(n0 + w * 32 + srow) * ldb;
    const int nk = K >> 6;
    __syncthreads();
#define GEMM_STAGE(kt, buf)                                                                                                  \
    do {                                                                                                                     \
        char* sa = smem + (buf) * 32768 + w * 4096;                                                                          \
        char* sb = sa + 16384;                                                                                               \
        _Pragma("unroll") for (int i = 0; i < 4; ++i) {                                                                      \
            const int gc = (i & 1) ? g1 : g0;                                                                                \
            __builtin_amdgcn_global_load_lds((const unsigned*)(Ab + (size_t)(i * 8) * lda + (kt) * 64 + gc), (unsigned*)(sa + i * 1024), 16, 0, 0); \
            __builtin_amdgcn_global_load_lds((const unsigned*)(Bb + (size_t)(i * 8) * ldb + (kt) * 64 + gc), (unsigned*)(sb + i * 1024), 16, 0, 0); \
        }                                                                                                                    \
    } while (0)
    GEMM_STAGE(0, 0);
    const int key = fr >> 1;
    for (int kt = 0; kt < nk; ++kt) {
        asm volatile("s_waitcnt vmcnt(0)" ::: "memory");
        __syncthreads();
        if (kt + 1 < nk) GEMM_STAGE(kt + 1, (kt + 1) & 1);
        const char* sa = smem + (kt & 1) * 32768;
        const char* sb = sa + 16384;
#pragma unroll
        for (int ks = 0; ks < 2; ++ks) {
            bf16x8 af[4], bfr[4];
            const int co = ((ks * 4 + fq) ^ key) << 4;
#pragma unroll
            for (int mi = 0; mi < 4; ++mi) af[mi] = *(const bf16x8*)(sa + (wr * 64 + mi * 16 + fr) * 128 + co);
#pragma unroll
            for (int ni = 0; ni < 4; ++ni) bfr[ni] = *(const bf16x8*)(sb + (wc * 64 + ni * 16 + fr) * 128 + co);
#pragma unroll
            for (int mi = 0; mi < 4; ++mi)
#pragma unroll
                for (int ni = 0; ni < 4; ++ni)
                    acc[mi][ni] = TRANS ? __builtin_amdgcn_mfma_f32_16x16x32_bf16(af[mi], bfr[ni], acc[mi][ni], 0, 0, 0)
                                        : __builtin_amdgcn_mfma_f32_16x16x32_bf16(bfr[ni], af[mi], acc[mi][ni], 0, 0, 0);
        }
    }
#undef GEMM_STAGE
    if constexpr (ROWSS) {
#pragma unroll
        for (int mi = 0; mi < 4; ++mi) {
            const int row = m0 + wr * 64 + mi * 16 + fr;
            float ssq = 0.f, am = 0.f;
#pragma unroll
            for (int ni = 0; ni < 4; ++ni) epi(row, n0 + wc * 64 + ni * 16 + fq * 4, acc[mi][ni], ssq, am);
            ssq += __shfl_xor(ssq, 16);
            ssq += __shfl_xor(ssq, 32);
            am = fmaxf(am, __shfl_xor(am, 16));
            am = fmaxf(am, __shfl_xor(am, 32));
            if (fq == 0) epi.row_done(row, ssq, am);
        }
    } else {
#pragma unroll
        for (int mi = 0; mi < 4; ++mi)
#pragma unroll
            for (int ni = 0; ni < 4; ++ni) {
                if (TRANS) epi(m0 + wr * 64 + mi * 16 + fq * 4, n0 + wc * 64 + ni * 16 + fr, acc[mi][ni]);
                else epi(m0 + wr * 64 + mi * 16 + fr, n0 + wc * 64 + ni * 16 + fq * 4, acc[mi][ni]);
            }
    }
}


namespace g8 {
constexpr int BM = 256, BK = 64, HALF = 128, HT = HALF * BK;
__device__ __forceinline__ int lds_byte(int r, int c) {
    const int st = (r >> 4) * 2 + (c >> 5), rr = r & 15, cc = c & 31, ob = rr * 64 + cc * 2;
    return st * 1024 + (ob ^ (((ob >> 9) & 1) << 5));
}
__device__ __forceinline__ void stage_rc(int b, int& R, int& C) {
    const int st = b / 1024, sb = b % 1024, swz = sb ^ (((sb >> 9) & 1) << 5);
    R = (st >> 1) * 16 + swz / 64; C = (st & 1) * 32 + (swz % 64) / 2;
}
__device__ __forceinline__ void tile_of(int L, int nM, int nN, int& pm, int& pn) {
    const int nwg = nM * nN;
    int wgid = L;
    { const int q = nwg / 8, r = nwg % 8, xcd = wgid % 8, off = wgid / 8; wgid = (xcd < r ? xcd * (q + 1) : r * (q + 1) + (xcd - r) * q) + off; }
    const int nig = 8 * nN, gid = wgid / nig, fm = gid * 8, gsz = (nM - fm) < 8 ? (nM - fm) : 8;
    pm = fm + ((wgid % nig) % gsz); pn = (wgid % nig) / gsz;
}
}

#define G8_LAS __attribute__((address_space(3)))
template <bool TRANS, bool ROWSS, class Epi>
__device__ __forceinline__ void gemm256_tile(const bf16_t* __restrict__ A, const bf16_t* __restrict__ Bt, int K, int brow, int bcol,
                                             char* shmc, const Epi& epi) {
    using namespace g8;
    G8_LAS unsigned char* lds = (G8_LAS unsigned char*)shmc;
    const int tid = threadIdx.x, wid = __builtin_amdgcn_readfirstlane(tid >> 6), lane = tid & 63, wr = wid >> 2, wc = wid & 3, fr = lane & 15, fq = lane >> 4;
    constexpr int HTB = HALF * BK * 2;
    unsigned voff[2];
#pragma unroll
    for (int i = 0; i < 2; ++i) { int R, C; stage_rc(tid * 16 + i * 8192, R, C); voff[i] = (unsigned)(R * K + C) * 2u; }
    const size_t kstep = (size_t)(BK * 2);
    const size_t hstep = (size_t)HALF * K * 2;
    const unsigned ldsw = (unsigned)wid * 1024u;
    const int aoff = lds_byte(wr * 64 + fr, fq * 8), boff = lds_byte(wc * 32 + fr, fq * 8);
    const char* cA = (const char*)A + (size_t)brow * K * 2;
    const char* cB = (const char*)Bt + (size_t)bcol * K * 2;
#define G8_SA(b, h) (((b) * 2 + (h)) * HTB)
#define G8_SB(b, h) ((4 + (b) * 2 + (h)) * HTB)
#define G8_STAGE(bufoff, gbase) do { _Pragma("unroll") for (int _i = 0; _i < 2; ++_i) \
        __builtin_amdgcn_global_load_lds((const unsigned*)((const char*)(gbase) + voff[_i]), (G8_LAS unsigned*)(lds + (bufoff) + ldsw + _i * 8192), 16, 0, 0); } while (0)
#define G8_LDA(dst, b, h) do { _Pragma("unroll") for (int m = 0; m < 4; ++m) _Pragma("unroll") for (int k = 0; k < 2; ++k) dst[m][k] = *(const G8_LAS bf16x8*)(lds + G8_SA(b, h) + aoff + m * 2048 + k * 1024); } while (0)
#define G8_LDB(dst, b, h) do { _Pragma("unroll") for (int n = 0; n < 2; ++n) _Pragma("unroll") for (int k = 0; k < 2; ++k) dst[n][k] = *(const G8_LAS bf16x8*)(lds + G8_SB(b, h) + boff + n * 2048 + k * 1024); } while (0)
#define G8_MMA(ai, bj, At_, Bt_) do { __builtin_amdgcn_s_setprio(1); _Pragma("unroll") for (int m = 0; m < 4; ++m) _Pragma("unroll") for (int n = 0; n < 2; ++n) _Pragma("unroll") for (int k = 0; k < 2; ++k) \
        acc[ai][bj][m][n] = TRANS ? __builtin_amdgcn_mfma_f32_16x16x32_bf16(At_[m][k], Bt_[n][k], acc[ai][bj][m][n], 0, 0, 0) \
                                  : __builtin_amdgcn_mfma_f32_16x16x32_bf16(Bt_[n][k], At_[m][k], acc[ai][bj][m][n], 0, 0, 0); \
        __builtin_amdgcn_s_setprio(0); } while (0)
#define G8_WAIT_V(n) asm volatile("s_waitcnt vmcnt(" #n ")" ::: "memory")
#define G8_WAIT_L(n) asm volatile("s_waitcnt lgkmcnt(" #n ")" ::: "memory")
#define G8_BAR __builtin_amdgcn_s_barrier()
#define G8_SCHED __builtin_amdgcn_sched_barrier(0)
    f32x4 acc[2][2][4][2];
#pragma unroll
    for (int a = 0; a < 2; ++a)
#pragma unroll
        for (int b = 0; b < 2; ++b)
#pragma unroll
            for (int m = 0; m < 4; ++m)
#pragma unroll
                for (int n = 0; n < 2; ++n) acc[a][b][m][n] = (f32x4){0.f, 0.f, 0.f, 0.f};
    bf16x8 At[4][2], B0[2][2], B1[2][2];
    const int nt = K / BK;
    __syncthreads();
    G8_STAGE(G8_SB(0, 0), cB); G8_STAGE(G8_SA(0, 0), cA); G8_STAGE(G8_SB(0, 1), cB + hstep); G8_STAGE(G8_SA(0, 1), cA + hstep);
    if (wr == 1) G8_BAR;
    G8_WAIT_V(4); G8_BAR;
    G8_STAGE(G8_SB(1, 0), cB + kstep); G8_STAGE(G8_SA(1, 0), cA + kstep); G8_STAGE(G8_SB(1, 1), cB + hstep + kstep);
    G8_WAIT_V(6); G8_BAR;
    for (int t = 0; t < nt - 2; t += 2) {
        const char* a1 = cA + (size_t)(t + 1) * kstep; const char* a2 = a1 + kstep; const char* a3 = a2 + kstep;
        const char* b2 = cB + (size_t)(t + 2) * kstep; const char* b3 = b2 + kstep;
        G8_LDB(B0, 0, 0); G8_SCHED; G8_LDA(At, 0, 0); G8_STAGE(G8_SA(1, 1), a1 + hstep);
        G8_WAIT_L(8); G8_BAR; G8_WAIT_L(0); G8_MMA(0, 0, At, B0); G8_BAR; G8_SCHED;
        G8_LDB(B1, 0, 1); G8_STAGE(G8_SB(0, 0), b2);
        G8_BAR; G8_WAIT_L(0); G8_MMA(0, 1, At, B1); G8_BAR;
        G8_LDA(At, 0, 1); G8_STAGE(G8_SA(0, 0), a2);
        G8_BAR; G8_WAIT_L(0); G8_MMA(1, 0, At, B0); G8_BAR; G8_SCHED;
        G8_STAGE(G8_SB(0, 1), b2 + hstep);
        G8_WAIT_V(6); G8_BAR; G8_MMA(1, 1, At, B1); G8_BAR;
        G8_LDB(B0, 1, 0); G8_SCHED; G8_LDA(At, 1, 0); G8_STAGE(G8_SA(0, 1), a2 + hstep);
        G8_WAIT_L(8); G8_BAR; G8_WAIT_L(0); G8_MMA(0, 0, At, B0); G8_BAR; G8_SCHED;
        G8_LDB(B1, 1, 1); G8_STAGE(G8_SB(1, 0), b3);
        G8_BAR; G8_WAIT_L(0); G8_MMA(0, 1, At, B1); G8_BAR;
        G8_LDA(At, 1, 1); G8_STAGE(G8_SA(1, 0), a3);
        G8_BAR; G8_WAIT_L(0); G8_MMA(1, 0, At, B0); G8_BAR; G8_SCHED;
        G8_STAGE(G8_SB(1, 1), b3 + hstep);
        G8_WAIT_V(6); G8_BAR; G8_MMA(1, 1, At, B1); G8_BAR;
    }
    { G8_LDB(B0, 0, 0); G8_LDA(At, 0, 0); G8_STAGE(G8_SA(1, 1), cA + (size_t)(nt - 1) * kstep + hstep);
      G8_BAR; G8_WAIT_L(0); G8_MMA(0, 0, At, B0); G8_BAR;
      G8_LDB(B1, 0, 1); G8_BAR; G8_WAIT_L(0); G8_MMA(0, 1, At, B1); G8_BAR;
      G8_LDA(At, 0, 1); G8_WAIT_V(4); G8_BAR; G8_WAIT_L(0); G8_MMA(1, 0, At, B0); G8_MMA(1, 1, At, B1); G8_BAR; }
    { G8_LDB(B0, 1, 0); G8_LDA(At, 1, 0); G8_WAIT_V(2); G8_BAR; G8_WAIT_L(0); G8_MMA(0, 0, At, B0); G8_BAR;
      G8_LDB(B1, 1, 1); G8_WAIT_V(0); G8_BAR; G8_WAIT_L(0); G8_MMA(0, 1, At, B1); G8_BAR;
      G8_LDA(At, 1, 1); G8_BAR; G8_WAIT_L(0); G8_MMA(1, 0, At, B0); G8_MMA(1, 1, At, B1); G8_BAR; }
    if (wr == 0) G8_BAR;
    if constexpr (ROWSS) {
#pragma unroll
        for (int ai = 0; ai < 2; ++ai)
#pragma unroll
            for (int m = 0; m < 4; ++m) {
                const int row = brow + ai * HALF + wr * 64 + m * 16 + fr;
                float ssq = 0.f, am = 0.f;
#pragma unroll
                for (int bj = 0; bj < 2; ++bj)
#pragma unroll
                    for (int n = 0; n < 2; ++n) epi(row, bcol + bj * HALF + wc * 32 + n * 16 + fq * 4, acc[ai][bj][m][n], ssq, am);
                ssq += __shfl_xor(ssq, 16);
                ssq += __shfl_xor(ssq, 32);
                am = fmaxf(am, __shfl_xor(am, 16));
                am = fmaxf(am, __shfl_xor(am, 32));
                if (fq == 0) epi.row_done(row, ssq, am);
            }
    } else {
#pragma unroll
        for (int ai = 0; ai < 2; ++ai)
#pragma unroll
            for (int bj = 0; bj < 2; ++bj)
#pragma unroll
                for (int m = 0; m < 4; ++m)
#pragma unroll
                    for (int n = 0; n < 2; ++n) {
                        if (TRANS) epi(brow + ai * HALF + wr * 64 + m * 16 + fq * 4, bcol + bj * HALF + wc * 32 + n * 16 + fr, acc[ai][bj][m][n]);
                        else epi(brow + ai * HALF + wr * 64 + m * 16 + fr, bcol + bj * HALF + wc * 32 + n * 16 + fq * 4, acc[ai][bj][m][n]);
                    }
    }
#undef G8_SA
#undef G8_SB
#undef G8_STAGE
#undef G8_LDA
#undef G8_LDB
#undef G8_MMA
#undef G8_WAIT_V
#undef G8_WAIT_L
#undef G8_BAR
#undef G8_SCHED
}

__device__ void phase_gemm_in(const Params& p, char* smem) {
    const int nM = NTOK / 256, nN = INW / 256;
    EpiBf16 e1{p.z(), INW};
    EpiBf16T e1t{p.vT(), 1024, 512, T};
    for (int i = 0; i * (int)gridDim.x + (int)blockIdx.x < nM * nN; ++i) {
        int pm, pn;
        g8::tile_of(i * gridDim.x + blockIdx.x, nM, nN, pm, pn);
        if (pn >= 4 && pn < 6) gemm256_tile<true, false>(p.h(), p.w_in_t(), D, pm * 256, pn * 256, smem, e1t);
        else gemm256_tile<false, false>(p.h(), p.w_in_t(), D, pm * 256, pn * 256, smem, e1);
    }
}

__device__ void phase_gemm_kv(const Params& p, char* smh) {
    EpiBf16 e2{p.kvb(), 512};
    EpiBf16T e2t{p.kvT(), 256, 256, 256};
    const bool dedicated = gridDim.x >= 64;
    if (dedicated && blockIdx.x >= 16) return;
    for (int it = VBID; it < 32; it += dedicated ? 32 : VGRID) {
        const int pm = it >> 2, pn = it & 3;
        if (pn >= 2) gemm_tile<true>(p.memn(), D, p.w_kv_t(), D, D, pm * 128, pn * 128, smh, e2t);
        else gemm_tile<false>(p.memn(), D, p.w_kv_t(), D, D, pm * 128, pn * 128, smh, e2);
    }
}

__device__ void phase_gemm_out(const Params& p, char* smem) {
    const int nM = NTOK / 256, nN = D / 256;
    EpiResNorm e{p.x1b(), p.x, p.ffn_g, p.h(), D, p.ss1(), p.hmax()};
    for (int i = 0; i * (int)gridDim.x + (int)blockIdx.x < nM * nN; ++i) {
        int pm, pn;
        g8::tile_of(i * gridDim.x + blockIdx.x, nM, nN, pm, pn);
        gemm256_tile<false, true>(p.mix(), p.w_out_t(), D, pm * 256, pn * 256, smem, e);
    }
}

__device__ void phase_gemm_q(const Params& p, char* smem) {
    const int nM = NTOK / 256, nN = QW / 256;
    EpiBf16RowScale e{p.z(), QW, p.ss1()};
    for (int i = 0; i * (int)gridDim.x + (int)blockIdx.x < nM * nN; ++i) {
        int pm, pn;
        g8::tile_of(i * gridDim.x + blockIdx.x, nM, nN, pm, pn);
        gemm256_tile<false, false>(p.h(), p.w_q_t(), D, pm * 256, pn * 256, smem, e);
    }
}

typedef float f32x16 __attribute__((ext_vector_type(16)));
constexpr int HRS = 144;
__device__ __forceinline__ f32x16 tile_mm64(const char* X, const char* Y, int xrow0, int yrow0, int lane, f32x16 acc) {
    const int r = lane & 31, hh = lane >> 5;
#pragma unroll
    for (int ks = 0; ks < 4; ++ks) {
        const bf16x8 a = *(const bf16x8*)(X + (xrow0 + r) * HRS + ks * 32 + hh * 16);
        const bf16x8 b = *(const bf16x8*)(Y + (yrow0 + r) * HRS + ks * 32 + hh * 16);
        acc = __builtin_amdgcn_mfma_f32_32x32x16_bf16(a, b, acc, 0, 0, 0);
    }
    return acc;
}
__device__ __forceinline__ int crow(int reg, int hh) { return (reg & 3) + 8 * (reg >> 2) + 4 * hh; }

__device__ __forceinline__ void hg_load_vt(const Params& p, char* sVT, int tok0, int h, int kcol, int sq) {
    const bf16_t* zp = p.z() + (size_t)(tok0 + sq * 16) * INW + 2304 + h * 64 + kcol;
    unsigned pk[8];
#pragma unroll
    for (int j = 0; j < 8; ++j) {
        const unsigned lo = zp[(size_t)(2 * j) * INW], hi = zp[(size_t)(2 * j + 1) * INW];
        pk[j] = lo | (hi << 16);
    }
    *(uint4*)(sVT + kcol * HRS + sq * 32) = make_uint4(pk[0], pk[1], pk[2], pk[3]);
    *(uint4*)(sVT + kcol * HRS + sq * 32 + 16) = make_uint4(pk[4], pk[5], pk[6], pk[7]);
}

__device__ __forceinline__ float hg_gates(const Params& p, float* sTot, int tok0, int h, int dir, int kcol, int sq, float (&bj)[16], float (&kk)[16]) {
    const bf16_t* zp = p.z() + (size_t)(tok0 + sq * 16) * INW + 1792 + dir * 256 + h * 64 + kcol;
    const float lbv = p.lb()[dir * 256 + h * 64 + kcol];
#pragma unroll
    for (int j = 0; j < 16; ++j) {
        const float pre = bf2f(zp[(size_t)j * INW]);
        const float f = lbv + (1.0f - lbv) * (1.0f / (1.0f + __expf(-pre)));
        bj[j] = __logf(f);
        kk[j] = 1.0f - f;
    }
    if (dir == 0) {
#pragma unroll
        for (int j = 1; j < 16; ++j) bj[j] += bj[j - 1];
        sTot[sq * 64 + kcol] = bj[15];
    } else {
#pragma unroll
        for (int j = 14; j >= 0; --j) bj[j] += bj[j + 1];
        sTot[sq * 64 + kcol] = bj[0];
    }
    __syncthreads();
    const float t0 = sTot[kcol], t1 = sTot[64 + kcol], t2 = sTot[128 + kcol], t3 = sTot[192 + kcol];
    float off;
    if (dir == 0) off = (sq > 0 ? t0 : 0.f) + (sq > 1 ? t1 : 0.f) + (sq > 2 ? t2 : 0.f);
    else off = (sq < 3 ? t3 : 0.f) + (sq < 2 ? t2 : 0.f) + (sq < 1 ? t1 : 0.f);
#pragma unroll
    for (int j = 0; j < 16; ++j) bj[j] += off;
    return t0 + t1 + t2 + t3;
}

__device__ void hg_local(const Params& p, char* smem) {
    char* sVT = smem;
    char* sKT = smem + 9216;
    float* sTot = (float*)(smem + 18432);
    const int tid = VTID, lane = tid & 63, w = tid >> 6;
    const int kcol = tid & 63, sq = tid >> 6;
    for (int item = VBID; item < 4096; item += VGRID) {
        const int c = item & 127, dir = (item >> 7) & 1, h = (item >> 8) & 3, b = item >> 10;
        const int tok0 = b * T + c * 64;
        __syncthreads();
        hg_load_vt(p, sVT, tok0, h, kcol, sq);
        float bj[16], kk[16];
        const float btot = hg_gates(p, sTot, tok0, h, dir, kcol, sq, bj, kk);
        unsigned pk[8];
#pragma unroll
        for (int j = 0; j < 8; ++j)
            pk[j] = pack2(kk[2 * j] * __expf(btot - bj[2 * j]), kk[2 * j + 1] * __expf(btot - bj[2 * j + 1]));
        *(uint4*)(sKT + kcol * HRS + sq * 32) = make_uint4(pk[0], pk[1], pk[2], pk[3]);
        *(uint4*)(sKT + kcol * HRS + sq * 32 + 16) = make_uint4(pk[4], pk[5], pk[6], pk[7]);
        if (sq == 0) p.hdec()[item * 64 + kcol] = __expf(btot);
        __syncthreads();
        const int vi = w >> 1, ki = w & 1, hh = lane >> 5;
        f32x16 acc;
#pragma unroll
        for (int r = 0; r < 16; ++r) acc[r] = 0.f;
        acc = tile_mm64(sVT, sKT, vi * 32, ki * 32, lane, acc);
        bf16_t* dst = (bf16_t*)p.hstate() + (size_t)item * 4096 + ki * 32 + (lane & 31);
#pragma unroll
        for (int r = 0; r < 16; ++r) dst[(vi * 32 + crow(r, hh)) * 64] = f2bf(acc[r]);
    }
}

__device__ __forceinline__ bf16x8 pack8(const f32x16& x, int s8) {
    typedef unsigned u32x4_t __attribute__((ext_vector_type(4)));
    u32x4_t pk;
    pk[0] = pack2(x[s8], x[s8 + 1]); pk[1] = pack2(x[s8 + 2], x[s8 + 3]);
    pk[2] = pack2(x[s8 + 4], x[s8 + 5]); pk[3] = pack2(x[s8 + 6], x[s8 + 7]);
    return __builtin_bit_cast(bf16x8, pk);
}
__device__ __forceinline__ bf16x8 join8(const uint2& lo, const uint2& hi) {
    typedef unsigned u32x4_t __attribute__((ext_vector_type(4)));
    u32x4_t pk; pk[0] = lo.x; pk[1] = lo.y; pk[2] = hi.x; pk[3] = hi.y;
    return __builtin_bit_cast(bf16x8, pk);
}

__device__ __forceinline__ int swap23(int r) { return (r & ~12) | ((r & 4) << 1) | ((r & 8) >> 1); }

__device__ __forceinline__ void mem_attn_wave(const Params& p, int wu, int lane) {
    const int tile = wu & 255, h = (wu >> 8) & 3, b = wu >> 10;
    const int l31 = lane & 31, hh = lane >> 5;
    const int tok = b * T + tile * 32 + l31;
    bf16x8 qf[4];
#pragma unroll
    for (int ks = 0; ks < 4; ++ks) qf[ks] = *(const bf16x8*)(p.z() + (size_t)tok * INW + 2816 + h * 64 + ks * 16 + hh * 8);
    const bf16_t* kb = p.kvb() + (size_t)(b * 256 + swap23(l31)) * 512 + h * 64 + hh * 8;
    float m = -1e30f;
    f32x16 o0, o1;
#pragma unroll
    for (int r = 0; r < 16; ++r) { o0[r] = 0.f; o1[r] = 0.f; }
    float sum = 0.f;
    const bf16_t* vt = p.kvT() + ((size_t)(b * 4 + h) * 64 + l31) * 256 + 8 * hh;
    bf16x8 kf[4], vf[4];
#pragma unroll
    for (int ks = 0; ks < 4; ++ks) kf[ks] = *(const bf16x8*)(kb + ks * 16);
#pragma unroll
    for (int st = 0; st < 2; ++st) { vf[2 * st] = *(const bf16x8*)(vt + st * 16); vf[2 * st + 1] = *(const bf16x8*)(vt + 32 * 256 + st * 16); }
    for (int kt = 0; kt < 8; ++kt) {
        const int ktn = min(kt + 1, 7);
        bf16x8 kn[4], vn[4];
#pragma unroll
        for (int ks = 0; ks < 4; ++ks) kn[ks] = *(const bf16x8*)(kb + (size_t)ktn * 32 * 512 + ks * 16);
#pragma unroll
        for (int st = 0; st < 2; ++st) { vn[2 * st] = *(const bf16x8*)(vt + ktn * 32 + st * 16); vn[2 * st + 1] = *(const bf16x8*)(vt + 32 * 256 + ktn * 32 + st * 16); }
        f32x16 s;
#pragma unroll
        for (int r = 0; r < 16; ++r) s[r] = 0.f;
#pragma unroll
        for (int ks = 0; ks < 4; ++ks) s = __builtin_amdgcn_mfma_f32_32x32x16_bf16(kf[ks], qf[ks], s, 0, 0, 0);
        float tm = s[0];
#pragma unroll
        for (int r = 1; r < 16; ++r) tm = fmaxf(tm, s[r]);
        tm = fmaxf(tm, __shfl_xor(tm, 32));
        const float mn = fmaxf(m, tm);
        if (__any(mn > m)) {
            const float sc = __builtin_amdgcn_exp2f((m - mn) * 0.18033688011112042f);
            sum *= sc;
#pragma unroll
            for (int r = 0; r < 16; ++r) { o0[r] *= sc; o1[r] *= sc; }
        }
        m = mn;
        const float mb = mn * 0.18033688011112042f;
#pragma unroll
        for (int r = 0; r < 16; ++r) { s[r] = __builtin_amdgcn_exp2f(fmaf(s[r], 0.18033688011112042f, -mb)); sum += s[r]; }
#pragma unroll
        for (int st = 0; st < 2; ++st) {
            const bf16x8 pb = pack8(s, st * 8);
            o0 = __builtin_amdgcn_mfma_f32_32x32x16_bf16(vf[2 * st], pb, o0, 0, 0, 0);
            o1 = __builtin_amdgcn_mfma_f32_32x32x16_bf16(vf[2 * st + 1], pb, o1, 0, 0, 0);
        }
#pragma unroll
        for (int ks = 0; ks < 4; ++ks) kf[ks] = kn[ks];
#pragma unroll
        for (int q = 0; q < 4; ++q) vf[q] = vn[q];
    }
    sum += __shfl_xor(sum, 32);
    const float inv = 1.0f / sum;
    bf16_t* mo = p.mix() + (size_t)tok * D + 768 + h * 64 + 4 * hh;
#pragma unroll
    for (int g = 0; g < 4; ++g) {
        uint2 pk;
        pk.x = pack2(o0[4 * g] * inv, o0[4 * g + 1] * inv); pk.y = pack2(o0[4 * g + 2] * inv, o0[4 * g + 3] * inv);
        *(uint2*)(mo + 8 * g) = pk;
        pk.x = pack2(o1[4 * g] * inv, o1[4 * g + 1] * inv); pk.y = pack2(o1[4 * g + 2] * inv, o1[4 * g + 3] * inv);
        *(uint2*)(mo + 32 + 8 * g) = pk;
    }
}

struct NaCtx {
    const bf16_t* kbase; const bf16_t* vbase; const float* bh;
    int rs, r, c, c0, cb, hh;
    bf16x8 qf[4];
    float m, sum;
    f32x16 o0, o1;
};
template <int TI>
__device__ __forceinline__ void na_load(const NaCtx& x, bf16x8 (&kf)[4], bf16x8 (&vf)[4]) {
    constexpr int ip = TI / 3, cg = TI % 3;
    const bf16_t* kp = x.kbase + (size_t)(ip * 128 + cg * 16) * INW;
#pragma unroll
    for (int ks = 0; ks < 4; ++ks) kf[ks] = *(const bf16x8*)(kp + ks * 16);
    const bf16_t* vr = x.vbase + ip * 128 + cg * 16;
#pragma unroll
    for (int st = 0; st < 2; ++st) { vf[2 * st] = *(const bf16x8*)(vr + st * 64); vf[2 * st + 1] = *(const bf16x8*)(vr + (size_t)32 * T + st * 64); }
}
template <int TI>
__device__ __forceinline__ void na_comp(NaCtx& x, const bf16x8 (&kf)[4], const bf16x8 (&vf)[4]) {
    constexpr int ip = TI / 3, cg = TI % 3;
    f32x16 s;
#pragma unroll
    for (int q = 0; q < 16; ++q) s[q] = 0.f;
#pragma unroll
    for (int ks = 0; ks < 4; ++ks) s = __builtin_amdgcn_mfma_f32_32x32x16_bf16(kf[ks], x.qf[ks], s, 0, 0, 0);
    const int kc0 = x.cb + 16 * cg + 8 * x.hh;
    const float* brow = x.bh + (x.rs + 2 * ip - x.r + 7) * 31 + 15 - x.c + kc0;
    const int d0 = kc0 - x.c0;
    float tm = -1e30f;
    float bv[16];
#pragma unroll
    for (int q = 0; q < 16; ++q) bv[q] = brow[(q & 3) + 4 * ((q >> 2) & 1) + 31 * (q >> 3)];
#pragma unroll
    for (int q = 0; q < 16; ++q) asm volatile("" : "+v"(bv[q]));
#pragma unroll
    for (int q = 0; q < 16; ++q) {
        const int cq = (q & 3) + 4 * ((q >> 2) & 1);
        const bool valid = (unsigned)(d0 + cq) < 16u;
        const float sc = valid ? fmaf(s[q], 0.18033688011112042f, bv[q]) : -INFINITY;
        s[q] = sc;
        tm = fmaxf(tm, sc);
    }
    tm = fmaxf(tm, __shfl_xor(tm, 32));
    const float mn = fmaxf(x.m, tm);
    if (__any(mn > x.m)) {
        const float scl = __builtin_amdgcn_exp2f(x.m - mn);
        x.sum *= scl;
#pragma unroll
        for (int q = 0; q < 16; ++q) { x.o0[q] *= scl; x.o1[q] *= scl; }
    }
    x.m = mn;
#pragma unroll
    for (int q = 0; q < 16; ++q) { const float pe = __builtin_amdgcn_exp2f(s[q] - mn); s[q] = pe; x.sum += pe; }
#pragma unroll
    for (int st = 0; st < 2; ++st) {
        const bf16x8 pb = pack8(s, st * 8);
        x.o0 = __builtin_amdgcn_mfma_f32_32x32x16_bf16(vf[2 * st], pb, x.o0, 0, 0, 0);
        x.o1 = __builtin_amdgcn_mfma_f32_32x32x16_bf16(vf[2 * st + 1], pb, x.o1, 0, 0, 0);
    }
}

__device__ __forceinline__ void na_attn_wave(const Params& p, int wu, int lane, const float* sbias) {
    const int j = wu & 1, h = (wu >> 1) & 7, r = (wu >> 4) & 127, b = wu >> 11;
    const int l31 = lane & 31, hh = lane >> 5;
    NaCtx x;
    x.hh = hh; x.r = r;
    x.c = 32 * j + l31;
    x.c0 = min(max(x.c - 8, 0), 48); x.rs = min(max(r - 4, 0), 120);
    const int tokq = b * T + r * 64 + x.c;
    x.cb = 16 * j;
#pragma unroll
    for (int ks = 0; ks < 4; ++ks) x.qf[ks] = *(const bf16x8*)(p.z() + (size_t)tokq * INW + h * 64 + ks * 16 + hh * 8);
    x.bh = sbias + 64 + h * 465;
    const int kap = swap23(l31);
    x.kbase = p.z() + (size_t)(b * T + (x.rs + (kap >> 4)) * 64 + x.cb + (kap & 15)) * INW + 512 + h * 64 + hh * 8;
    x.vbase = p.vT() + ((size_t)(b * 8 + h) * 64 + l31) * T + x.rs * 64 + x.cb + 8 * hh;
    x.m = -1e30f; x.sum = 0.f;
#pragma unroll
    for (int q = 0; q < 16; ++q) { x.o0[q] = 0.f; x.o1[q] = 0.f; }
    bf16x8 k0[4], v0[4], k1[4], v1[4], k2[4], v2[4], k3[4], v3[4];
    na_load<0>(x, k0, v0); na_load<1>(x, k1, v1); na_load<2>(x, k2, v2);
    na_load<3>(x, k3, v3);  na_comp<0>(x, k0, v0);
    na_load<4>(x, k0, v0);  na_comp<1>(x, k1, v1);
    na_load<5>(x, k1, v1);  na_comp<2>(x, k2, v2);
    na_load<6>(x, k2, v2);  na_comp<3>(x, k3, v3);
    na_load<7>(x, k3, v3);  na_comp<4>(x, k0, v0);
    na_load<8>(x, k0, v0);  na_comp<5>(x, k1, v1);
    na_load<9>(x, k1, v1);  na_comp<6>(x, k2, v2);
    na_load<10>(x, k2, v2); na_comp<7>(x, k3, v3);
    na_load<11>(x, k3, v3); na_comp<8>(x, k0, v0);
    na_comp<9>(x, k1, v1);
    na_comp<10>(x, k2, v2);
    na_comp<11>(x, k3, v3);
    float sum = x.sum;
    sum += __shfl_xor(sum, 32);
    const float inv = 1.0f / sum;
    bf16_t* mo = p.mix() + (size_t)tokq * D + h * 64 + 4 * hh;
#pragma unroll
    for (int g = 0; g < 4; ++g) {
        uint2 pk;
        pk.x = pack2(x.o0[4 * g] * inv, x.o0[4 * g + 1] * inv); pk.y = pack2(x.o0[4 * g + 2] * inv, x.o0[4 * g + 3] * inv);
        *(uint2*)(mo + 8 * g) = pk;
        pk.x = pack2(x.o1[4 * g] * inv, x.o1[4 * g + 1] * inv); pk.y = pack2(x.o1[4 * g + 2] * inv, x.o1[4 * g + 3] * inv);
        *(uint2*)(mo + 32 + 8 * g) = pk;
    }
}

__device__ void phase_mixers(const Params& p, char* smem) {
    const int tid = VTID, lane = tid & 63, w = tid >> 6;
    {
        float* sbias = (float*)smem;
        __syncthreads();
        for (int i = tid; i < 8 * 465; i += 256) sbias[64 + i] = p.rpb[i] * 1.4426950408889634f;
        __syncthreads();
        for (int wu = VBID * 4 + w; wu < 8192; wu += VGRID * 4) na_attn_wave(p, wu, lane, sbias);
    }
    __syncthreads();
    hg_local(p, smem);
}

__device__ void phase_hg_scan(const Params& p) {
    const int tid = VTID;
    const int skip = gridDim.x >= 64 ? 32 : 0;
    if (VBID < skip) return;
    for (int item = VBID - skip; item < 512; item += VGRID - skip) {
        const int g = item * 256 + tid;
        const int seq = g >> 12, kv = g & 4095, k = kv & 63;
        const int dir = seq & 1;
        float S = 0.f;
        for (int cc0 = 0; cc0 < 128; cc0 += 8) {
            float L[8], d[8];
#pragma unroll
            for (int u = 0; u < 8; ++u) {
                const int c = dir ? 127 - (cc0 + u) : cc0 + u;
                const size_t it = (size_t)seq * 128 + c;
                L[u] = bf2f(((const bf16_t*)p.hstate())[it * 4096 + kv]);
                d[u] = p.hdec()[it * 64 + k];
            }
#pragma unroll
            for (int u = 0; u < 8; ++u) {
                const int c = dir ? 127 - (cc0 + u) : cc0 + u;
                const size_t it = (size_t)seq * 128 + c;
                ((bf16_t*)p.h())[it * 4096 + kv] = f2bf(S);
                S = d[u] * S + L[u];
            }
        }
    }
}

__device__ void phase_hg_out(const Params& p, char* smem) {
    char* sQt = smem;
    char* sKt = smem + 9216;
    char* sQh = smem + 18432;
    char* sVT = smem + 27648;
    char* sST = smem + 36864;
    char* sP = smem + 46080;
    float* sTot = (float*)(smem + 55296);
    float* sSS = sTot + 256;
    const int tid = VTID, lane = tid & 63, w = tid >> 6;
    const int kcol = tid & 63, sq = tid >> 6;
    const int l31 = lane & 31, hh = lane >> 5;
    for (int item = VBID; item < 2048; item += VGRID) {
        const int c = item & 127, h = (item >> 7) & 3, b = item >> 9;
        const int tok0 = b * T + c * 64;
        __syncthreads();
        hg_load_vt(p, sVT, tok0, h, kcol, sq);
        float qv[16];
        {
            const bf16_t* zp = p.z() + (size_t)(tok0 + sq * 16) * INW + 1536 + h * 64 + kcol;
#pragma unroll
            for (int j = 0; j < 16; ++j) qv[j] = bf2f(zp[(size_t)j * INW]);
        }
        f32x16 accO;
#pragma unroll
        for (int r = 0; r < 16; ++r) accO[r] = 0.f;
        for (int dir = 0; dir < 2; ++dir) {
            float bj[16], kk[16];
            const float btot = hg_gates(p, sTot, tok0, h, dir, kcol, sq, bj, kk);
            const float bref = 0.5f * btot;
#pragma unroll
            for (int j = 0; j < 16; ++j) {
                const int s = sq * 16 + j;
                *(bf16_t*)(sQt + s * HRS + kcol * 2) = f2bf(qv[j] * __expf(bj[j] - bref));
                *(bf16_t*)(sKt + s * HRS + kcol * 2) = f2bf(kk[j] * __expf(bref - bj[j]));
                *(bf16_t*)(sQh + s * HRS + kcol * 2) = f2bf(qv[j] * __expf(bj[j]));
            }
            {
                const bf16_t* sp = (const bf16_t*)p.h() + ((size_t)(((b * 4 + h) * 2 + dir) * 128 + c)) * 4096;
#pragma unroll
                for (int i = 0; i < 4; ++i) {
                    const int idx = tid * 4 + 1024 * i;
                    *(uint2*)(sST + (idx >> 6) * HRS + (idx & 63) * 2) = *(const uint2*)(sp + idx);
                }
            }
            __syncthreads();
            {
                const int si = w >> 1, ti = w & 1;
                const bool live = dir == 0 ? (si <= ti) : (si >= ti);
                f32x16 pt;
#pragma unroll
                for (int r = 0; r < 16; ++r) pt[r] = 0.f;
                if (live) pt = tile_mm64(sKt, sQt, si * 32, ti * 32, lane, pt);
                const int t = ti * 32 + l31;
#pragma unroll
                for (int g = 0; g < 4; ++g) {
                    const int s0 = si * 32 + 8 * g + 4 * hh;
                    float v0 = pt[4 * g], v1 = pt[4 * g + 1], v2 = pt[4 * g + 2], v3 = pt[4 * g + 3];
                    if (dir == 0) {
                        if (s0 > t) v0 = 0.f; if (s0 + 1 > t) v1 = 0.f; if (s0 + 2 > t) v2 = 0.f; if (s0 + 3 > t) v3 = 0.f;
                    } else {
                        if (s0 < t) v0 = 0.f; if (s0 + 1 < t) v1 = 0.f; if (s0 + 2 < t) v2 = 0.f; if (s0 + 3 < t) v3 = 0.f;
                    }
                    uint2 pk; pk.x = pack2(v0, v1); pk.y = pack2(v2, v3);
                    *(uint2*)(sP + t * HRS + s0 * 2) = pk;
                }
            }
            __syncthreads();
            {
                const int vi = w >> 1, ti = w & 1;
                accO = tile_mm64(sVT, sP, vi * 32, ti * 32, lane, accO);
                accO = tile_mm64(sST, sQh, vi * 32, ti * 32, lane, accO);
            }
            __syncthreads();
        }
        const int vi = w >> 1, ti = w & 1;
        float ssq = 0.f;
#pragma unroll
        for (int r = 0; r < 16; ++r) ssq += accO[r] * accO[r];
        ssq += __shfl_xor(ssq, 32);
        sSS[w * 64 + lane] = ssq;
        __syncthreads();
        const float tot = sSS[ti * 64 + l31] + sSS[(2 + ti) * 64 + l31];
        const float rs = rsqrtf(tot * (1.0f / 64.0f) + EPS);
        const int tok = tok0 + ti * 32 + l31;
#pragma unroll
        for (int g = 0; g < 4; ++g) {
            const int v0 = vi * 32 + 8 * g + 4 * hh;
            const uint2 gz = *(const uint2*)(p.z() + (size_t)tok * INW + 2560 + h * 64 + v0);
            const float4 gn = *(const float4*)(p.hg_g + h * 64 + v0);
            const float g0 = bflo(gz.x), g1 = bfhi(gz.x), g2 = bflo(gz.y), g3 = bfhi(gz.y);
            const float o0 = accO[4 * g] * rs * gn.x * (g0 / (1.0f + __expf(-g0)));
            const float o1 = accO[4 * g + 1] * rs * gn.y * (g1 / (1.0f + __expf(-g1)));
            const float o2 = accO[4 * g + 2] * rs * gn.z * (g2 / (1.0f + __expf(-g2)));
            const float o3 = accO[4 * g + 3] * rs * gn.w * (g3 / (1.0f + __expf(-g3)));
            uint2 pk; pk.x = pack2(o0, o1); pk.y = pack2(o2, o3);
            *(uint2*)(p.mix() + (size_t)tok * D + 512 + h * 64 + v0) = pk;
        }
    }
    for (int wu = VBID * 4 + w; wu < 4096; wu += VGRID * 4) mem_attn_wave(p, wu, lane);
}


__device__ __forceinline__ int ord_key(int fb) { return fb ^ ((fb >> 31) & 0x7FFFFFFF); }

template <int N>
__device__ __forceinline__ void bitonic_sort_desc(int (&v)[N]) {
#pragma unroll
    for (int k = 2; k <= N; k <<= 1) {
#pragma unroll
        for (int j = k >> 1; j > 0; j >>= 1) {
#pragma unroll
            for (int i = 0; i < N; ++i) {
                const int l = i ^ j;
                if (l > i) {
                    const bool desc = ((i & k) == 0);
                    const int a = v[i], b = v[l];
                    const int mx = max(a, b), mn = min(a, b);
                    v[i] = desc ? mx : mn;
                    v[l] = desc ? mn : mx;
                }
            }
        }
    }
}
template <int N>
__device__ __forceinline__ void bitonic_merge_desc(int (&v)[N]) {
#pragma unroll
    for (int j = N >> 1; j > 0; j >>= 1) {
#pragma unroll
        for (int i = 0; i < N; ++i) {
            const int l = i ^ j;
            if (l > i) {
                const int a = v[i], b = v[l];
                v[i] = max(a, b);
                v[l] = min(a, b);
            }
        }
    }
}
__device__ __forceinline__ void merge_prune16(int (&r)[16], const int (&o)[16]) {
#pragma unroll
    for (int i = 0; i < 16; ++i) r[i] = max(r[i], o[15 - i]);
    bitonic_merge_desc<16>(r);
}

__device__ void phase_route(const Params& p, char* smem) {
    char* sk = smem;
    const int tid = VTID, lane = tid & 63, w = tid >> 6;
    int* sA = (int*)(smem + 32768) + w * 2048;
    int* sB = (int*)(smem + 65536) + w * 512;
    const int tl = lane & 31, hh = lane >> 5;
    const int h = VBID & 7, tg0 = VBID >> 3, tgs = VGRID >> 3;
    for (int base = tg0; base < 256; base += 4 * tgs)
    for (int c = 0; c < 2; ++c) {
        const int hc = h * 2 + c;
        __syncthreads();
        {
            const bf16_t* sp = p.subk_b() + (size_t)hc * 16384;
#pragma unroll
            for (int i = 0; i < 8; ++i) {
                const int ch = tid + 256 * i;
                const int row = ch >> 4, cc = ch & 15;
                const uint4 v = *(const uint4*)(sp + row * 128 + cc * 8);
                *(uint4*)(sk + row * 256 + ((cc ^ (row & 15)) << 4)) = v;
            }
        }
        __syncthreads();
        bf16x8 qf[8];
        if (base < 256) {
            const bf16_t* qr = p.z() + (size_t)(base * 128 + w * 32 + tl) * QW + hc * 128 + hh * 8;
#pragma unroll
            for (int ks = 0; ks < 8; ++ks) qf[ks] = *(const bf16x8*)(qr + ks * 16);
        }
        for (int it = 0; it < 4; ++it) {
            const int tgp = base + it * tgs;
            if (tgp >= 256) break;
            const int tok = tgp * 128 + w * 32 + tl;
            int* sidx = sA + it * 512;
            f32x16 acc4[4];
#pragma unroll
            for (int kb = 0; kb < 4; ++kb) {
#pragma unroll
                for (int r = 0; r < 16; ++r) acc4[kb][r] = 0.f;
                const int row = kb * 32 + tl;
#pragma unroll
                for (int ks = 0; ks < 8; ++ks) {
                    const bf16x8 af = *(const bf16x8*)(sk + row * 256 + (((ks * 2 + hh) ^ (row & 15)) << 4));
                    acc4[kb] = __builtin_amdgcn_mfma_f32_32x32x16_bf16(af, qf[ks], acc4[kb], 0, 0, 0);
                }
            }
            if (it + 1 < 4 && tgp + tgs < 256) {
                const bf16_t* qr = p.z() + (size_t)((tgp + tgs) * 128 + w * 32 + tl) * QW + hc * 128 + hh * 8;
#pragma unroll
                for (int ks = 0; ks < 8; ++ks) qf[ks] = *(const bf16x8*)(qr + ks * 16);
            }
            int cur[16];
#pragma unroll
            for (int kb = 0; kb < 4; ++kb) {
                int v[16];
#pragma unroll
                for (int r = 0; r < 16; ++r) {
                    const int key = kb * 32 + (r & 3) + 8 * (r >> 2) + 4 * hh;
                    const int fb = (__float_as_int(acc4[kb][r]) & ~127) | (127 - key);
                    v[r] = ord_key(fb);
                }
                bitonic_sort_desc<16>(v);
                if (kb == 0) {
#pragma unroll
                    for (int r = 0; r < 16; ++r) cur[r] = v[r];
                } else {
                    merge_prune16(cur, v);
                }
            }
            {
                int o[16];
#pragma unroll
                for (int r = 0; r < 16; ++r) o[r] = __shfl_xor(cur[r], 32);
                merge_prune16(cur, o);
            }
            if (c == 0) {
#pragma unroll
                for (int r = 0; r < 16; ++r) sidx[r * 32 + tl] = cur[r];
                continue;
            }
#pragma unroll
            for (int r = 0; r < 16; ++r) sB[r * 32 + tl] = cur[r];
        float va[16], vb[16];
#pragma unroll
        for (int r = 0; r < 16; ++r) {
            const int fa = ord_key(sidx[r * 32 + tl]), fb = ord_key(sB[r * 32 + tl]);
            va[r] = __int_as_float(fa & ~127);
            vb[r] = __int_as_float(fb & ~127);
        }
        int best[16];
#pragma unroll
        for (int j = 0; j < 16; ++j) best[j] = ord_key((__float_as_int(va[0] + vb[j]) & ~255) | (255 - j));
#pragma unroll
        for (int i = 1; i < 8; ++i) {
            const int n = 16 / (i + 1);
            int row[16];
#pragma unroll
            for (int j = 0; j < 16; ++j)
                row[j] = (j < n) ? ord_key((__float_as_int(va[i] + vb[j]) & ~255) | (255 - (i * 16 + j))) : (int)0x80000000;
            merge_prune16(best, row);
        }
        {
            int row[16];
#pragma unroll
            for (int j = 0; j < 16; ++j)
                row[j] = (j < 8) ? ord_key((__float_as_int(va[8 + j] + vb[0]) & ~255) | (255 - ((8 + j) * 16))) : (int)0x80000000;
            merge_prune16(best, row);
        }
        float sv[16];
        int pid[16];
#pragma unroll
        for (int r = 0; r < 16; ++r) {
            const int cb = ord_key(best[r]);
            sv[r] = __int_as_float(cb & ~255);
            pid[r] = 255 - (cb & 255);
        }
        float tot = 0.f;
        const float smax = sv[0];
#pragma unroll
        for (int r = 0; r < 16; ++r) { sv[r] = __expf(sv[r] - smax); tot += sv[r]; }
        const float inv = 1.0f / tot;
        if (hh == 0) {
#pragma unroll
            for (int r = 0; r < 16; ++r) {
                const int ia = 127 - (ord_key(sidx[(pid[r] >> 4) * 32 + tl]) & 127);
                const int ib = 127 - (ord_key(sB[(pid[r] & 15) * 32 + tl]) & 127);
                const int pos = (r & 7) * 16 + h * 2 + (r >> 3);
                p.eidx()[(size_t)tok * 128 + pos] = (unsigned short)(ia * 128 + ib);
                p.gate()[(size_t)tok * 128 + pos] = sv[r] * inv;
            }
        }
        }
    }
}

constexpr int PEER_TG = 512;
constexpr int PEER_TPW = PEER_TG / 8;
constexpr int PEER_NTG = NTOK / PEER_TG;
constexpr int PEER_NCH = 8;

#define PEER_G1(base, wv, hi) (*(const uint4*)((base) + (unsigned)((((hi) ? ((wv) >> 16) : ((wv) & 0xFFFFu)) << 7) + dlo)))
#define PEER_GATHER16(dst, base, ia, ib)                                                             \
    dst[0] = PEER_G1(base, (ia).x, 0);  dst[1] = PEER_G1(base, (ia).x, 1);  dst[2] = PEER_G1(base, (ia).y, 0);  dst[3] = PEER_G1(base, (ia).y, 1);   \
    dst[4] = PEER_G1(base, (ia).z, 0);  dst[5] = PEER_G1(base, (ia).z, 1);  dst[6] = PEER_G1(base, (ia).w, 0);  dst[7] = PEER_G1(base, (ia).w, 1);   \
    dst[8] = PEER_G1(base, (ib).x, 0);  dst[9] = PEER_G1(base, (ib).x, 1);  dst[10] = PEER_G1(base, (ib).y, 0); dst[11] = PEER_G1(base, (ib).y, 1);  \
    dst[12] = PEER_G1(base, (ib).z, 0); dst[13] = PEER_G1(base, (ib).z, 1); dst[14] = PEER_G1(base, (ib).w, 0); dst[15] = PEER_G1(base, (ib).w, 1);

__device__ __forceinline__ unsigned quant4(float a, float b, float c, float d, float qs) {
    const int q0 = (int)rintf(__builtin_amdgcn_fmed3f(a * qs, -127.f, 127.f)), q1 = (int)rintf(__builtin_amdgcn_fmed3f(b * qs, -127.f, 127.f));
    const int q2 = (int)rintf(__builtin_amdgcn_fmed3f(c * qs, -127.f, 127.f)), q3 = (int)rintf(__builtin_amdgcn_fmed3f(d * qs, -127.f, 127.f));
    return (unsigned)(q0 & 255) | ((unsigned)(q1 & 255) << 8) | ((unsigned)(q2 & 255) << 16) | ((unsigned)(q3 & 255) << 24);
}
template <int CTRL>
__device__ __forceinline__ int dpp_movi(int v) { return __builtin_amdgcn_update_dpp(0, v, CTRL, 0xf, 0xf, true); }

struct DotTok { uint4 ia, ib; uint4 ha, hb; float hm; };
__device__ __forceinline__ void dots_load(const Params& p, DotTok& t, int tok, int c, int g, int d8) {
    const uint4* idp = (const uint4*)(p.eidx() + (size_t)tok * 128 + g * 16);
    t.ia = idp[0]; t.ib = idp[1];
    const uint4* hp = (const uint4*)(p.h() + (size_t)tok * D + c * 128 + d8 * 16);
    t.ha = hp[0]; t.hb = hp[1];
    t.hm = __uint_as_float(p.hmax()[tok]);
}
__device__ __forceinline__ void dotsf_load(const Params& p, DotTok& t, int tokb, int s, int g, int d8) {
    dots_load(p, t, tokb + 8 * (s & 15), s >> 4, g, d8);
}
__device__ __forceinline__ void dotsf_finish(const uint4 (&uu)[16], const DotTok& t, int* part, int g, int d8) {
    const float qs = t.hm > 0.f ? 127.0f / t.hm : 0.f;
    const int h0 = (int)quant4(bflo(t.ha.x), bfhi(t.ha.x), bflo(t.ha.y), bfhi(t.ha.y), qs);
    const int h1 = (int)quant4(bflo(t.ha.z), bfhi(t.ha.z), bflo(t.ha.w), bfhi(t.ha.w), qs);
    const int h2 = (int)quant4(bflo(t.hb.x), bfhi(t.hb.x), bflo(t.hb.y), bfhi(t.hb.y), qs);
    const int h3 = (int)quant4(bflo(t.hb.z), bfhi(t.hb.z), bflo(t.hb.w), bfhi(t.hb.w), qs);
    int acc[16];
#pragma unroll
    for (int i = 0; i < 16; ++i) {
        int a = __builtin_amdgcn_sdot4((int)uu[i].x, h0, 0, false);
        a = __builtin_amdgcn_sdot4((int)uu[i].y, h1, a, false);
        a = __builtin_amdgcn_sdot4((int)uu[i].z, h2, a, false);
        a = __builtin_amdgcn_sdot4((int)uu[i].w, h3, a, false);
        a += dpp_movi<DPP_QP_X1>(a);
        a += dpp_movi<DPP_QP_X2>(a);
        a += dpp_movi<DPP_HMIRROR>(a);
        acc[i] = a;
    }
    if (d8 == 0) {
        int4* dst = (int4*)(part + g * 16);
#pragma unroll
        for (int q = 0; q < 4; ++q) {
            int4 v = dst[q];
            v.x += acc[4 * q]; v.y += acc[4 * q + 1]; v.z += acc[4 * q + 2]; v.w += acc[4 * q + 3];
            dst[q] = v;
        }
    }
}

__device__ __forceinline__ float gelu_erf(float v);

__device__ void phase_peer_dots(const Params& p, char* smem) {
    const int tid = threadIdx.x, lane = tid & 63, w = tid >> 6;
    const int g = lane >> 3, d8 = lane & 7;
    int* part = (int*)smem + w * 2048;
    for (int tgp = blockIdx.x; tgp < NTOK / 128; tgp += gridDim.x) {
        const int tokb = tgp * 128 + w;
        __syncthreads();
        for (int i = lane; i < 2048; i += 64) part[i] = 0;
        __syncthreads();
        const char* ubase = (const char*)p.u_c();
        const unsigned dlo = d8 * 16;
        DotTok ta, tb, tn;
        uint4 ua[16], ubuf[16];
        dotsf_load(p, ta, tokb, 0, g, d8);
        dotsf_load(p, tb, tokb, 1, g, d8);
        PEER_GATHER16(ua, ubase, ta.ia, ta.ib)
        PEER_GATHER16(ubuf, ubase, tb.ia, tb.ib)
        dotsf_load(p, tn, tokb, 2, g, d8);
        for (int s = 0; s < 128; s += 2) {
            dotsf_finish(ua, ta, part + (s & 15) * 128, g, d8);
            if (s + 2 < 128) {
                ta = tn;
                const char* ub = ubase + (size_t)((s + 2) >> 4) * 16384 * 128;
                PEER_GATHER16(ua, ub, ta.ia, ta.ib)
                dotsf_load(p, tn, tokb, min(s + 3, 127), g, d8);
            }
            dotsf_finish(ubuf, tb, part + ((s + 1) & 15) * 128, g, d8);
            if (s + 3 < 128) {
                tb = tn;
                const char* ub = ubase + (size_t)((s + 3) >> 4) * 16384 * 128;
                PEER_GATHER16(ubuf, ub, tb.ia, tb.ib)
                dotsf_load(p, tn, tokb, min(s + 4, 127), g, d8);
            }
        }
        __syncthreads();
        for (int k0 = 0; k0 < 16; k0 += 4) {
            int ps[4][2], e[4][2];
            float gt[4][2], sh[4];
#pragma unroll
            for (int q = 0; q < 4; ++q) {
                const int tok = tokb + 8 * (k0 + q);
                sh[q] = __uint_as_float(p.hmax()[tok]) * (1.0f / 127.0f) * rsqrtf(p.ss1()[tok] * (1.0f / 1024.0f) + EPS);
#pragma unroll
                for (int u = 0; u < 2; ++u) {
                    const int slot = lane + 64 * u;
                    ps[q][u] = part[(k0 + q) * 128 + slot];
                    e[q][u] = p.eidx()[(size_t)tok * 128 + slot];
                    gt[q][u] = p.gate()[(size_t)tok * 128 + slot];
                }
            }
            float su[4][2], sv[4][2];
#pragma unroll
            for (int q = 0; q < 4; ++q)
#pragma unroll
                for (int u = 0; u < 2; ++u) { su[q][u] = p.scale_u()[e[q][u]]; sv[q][u] = p.scale_v()[e[q][u]]; }
#pragma unroll
            for (int q = 0; q < 4; ++q) {
                const int tok = tokb + 8 * (k0 + q);
                float cf[2];
#pragma unroll
                for (int u = 0; u < 2; ++u) cf[u] = gelu_erf((float)ps[q][u] * su[q][u] * sh[q]) * gt[q][u] * sv[q][u];
                const float cm = wave_max(fmaxf(fabsf(cf[0]), fabsf(cf[1])));
                const float qs = cm > 0.f ? 127.0f / cm : 0.f;
                p.coef()[(size_t)tok * 128 + lane] = (signed char)(int)rintf(cf[0] * qs);
                p.coef()[(size_t)tok * 128 + lane + 64] = (signed char)(int)rintf(cf[1] * qs);
                if (lane == 0) p.csum()[tok] = cm * (1.0f / 127.0f);
            }
        }
    }
}

__device__ __forceinline__ float gelu_erf(float v) {
    const float av = fabsf(v);
    const float t = __builtin_amdgcn_rcpf(fmaf(av, 0.2316418882f, 1.0f));
    float q = fmaf(t, 0.5307027145f, -0.7265760135f);
    q = fmaf(q, t, 0.7107068705f);
    q = fmaf(q, t, -0.142248368f);
    q = fmaf(q, t, 0.127414796f);
    q = q * t;
    const float e = __builtin_amdgcn_exp2f(v * v * -0.72134752044f);
    const float m = v * (q * e);
    return v < 0.f ? m : v - m;
}
struct AccTok { uint4 ia, ib; uint4 cq; float cs; };
__device__ __forceinline__ void acc_load(const Params& p, AccTok& t, int tok, int g) {
    const uint4* idp = (const uint4*)(p.eidx() + (size_t)tok * 128 + g * 16);
    t.ia = idp[0]; t.ib = idp[1];
    t.cq = *(const uint4*)(p.coef() + (size_t)tok * 128 + g * 16);
    t.cs = p.csum()[tok];
}
#define PEER_T4DOT(acc, B, r0, r1, r2, r3, cq)                                   \
    {                                                                            \
        const unsigned t0 = __builtin_amdgcn_perm(r1, r0, 0x05010400u), t1 = __builtin_amdgcn_perm(r1, r0, 0x07030602u); \
        const unsigned t2 = __builtin_amdgcn_perm(r3, r2, 0x05010400u), t3 = __builtin_amdgcn_perm(r3, r2, 0x07030602u); \
        acc[(B) + 0] = __builtin_amdgcn_sdot4((int)__builtin_amdgcn_perm(t2, t0, 0x05040100u), (int)(cq), acc[(B) + 0], false); \
        acc[(B) + 1] = __builtin_amdgcn_sdot4((int)__builtin_amdgcn_perm(t2, t0, 0x07060302u), (int)(cq), acc[(B) + 1], false); \
        acc[(B) + 2] = __builtin_amdgcn_sdot4((int)__builtin_amdgcn_perm(t3, t1, 0x05040100u), (int)(cq), acc[(B) + 2], false); \
        acc[(B) + 3] = __builtin_amdgcn_sdot4((int)__builtin_amdgcn_perm(t3, t1, 0x07060302u), (int)(cq), acc[(B) + 3], false); \
    }
__device__ __forceinline__ void accf_finish(const uint4 (&vv)[16], const AccTok& t, char* rowp, int g) {
    const unsigned cw[4] = {t.cq.x, t.cq.y, t.cq.z, t.cq.w};
    int acc[16];
#pragma unroll
    for (int j = 0; j < 16; ++j) acc[j] = 0;
#pragma unroll
    for (int j = 0; j < 4; ++j) {
        PEER_T4DOT(acc, 0, vv[4 * j].x, vv[4 * j + 1].x, vv[4 * j + 2].x, vv[4 * j + 3].x, cw[j])
        PEER_T4DOT(acc, 4, vv[4 * j].y, vv[4 * j + 1].y, vv[4 * j + 2].y, vv[4 * j + 3].y, cw[j])
        PEER_T4DOT(acc, 8, vv[4 * j].z, vv[4 * j + 1].z, vv[4 * j + 2].z, vv[4 * j + 3].z, cw[j])
        PEER_T4DOT(acc, 12, vv[4 * j].w, vv[4 * j + 1].w, vv[4 * j + 2].w, vv[4 * j + 3].w, cw[j])
    }
    int t8[8], u4[4];
#pragma unroll
    for (int j = 0; j < 8; ++j) {
        const auto r = __builtin_amdgcn_permlane32_swap((unsigned)acc[j], (unsigned)acc[j + 8], false, false);
        t8[j] = (int)(r[0] + r[1]);
    }
#pragma unroll
    for (int j = 0; j < 4; ++j) {
        const auto r = __builtin_amdgcn_permlane16_swap((unsigned)t8[j], (unsigned)t8[j + 4], false, false);
        u4[j] = (int)(r[0] + r[1]);
    }
    float o[4];
#pragma unroll
    for (int j = 0; j < 4; ++j) {
        int v = u4[j];
        v += dpp_movi<DPP_ROR8>(v);
        o[j] = (float)v * t.cs;
    }
    if ((g & 1) == 0) {
        const int rho = g >> 1;
        uint2 w0; w0.x = pack2(o[0], o[1]); w0.y = pack2(o[2], o[3]);
        *(uint2*)(rowp + (4 * (rho & 1) + 8 * (rho >> 1)) * 2) = w0;
    }
}

__device__ void phase_peer_accum(const Params& p, char* smem) {
    const int tid = threadIdx.x, lane = tid & 63, w = tid >> 6;
    const int g = lane >> 3, d8 = lane & 7;
    char* rowbuf = smem + w * 16384;
    for (int tgp = blockIdx.x; tgp < NTOK / 64; tgp += gridDim.x) {
        const int tokb = tgp * 64 + w;
        __syncthreads();
        const char* vbase = (const char*)p.v_c();
        const unsigned dlo = d8 * 16;
        AccTok ta, tb, tn;
        uint4 va[16], vbuf[16];
        acc_load(p, ta, tokb, g);
        acc_load(p, tb, tokb + 8, g);
        PEER_GATHER16(va, vbase, ta.ia, ta.ib)
        PEER_GATHER16(vbuf, vbase, tb.ia, tb.ib)
        acc_load(p, tn, tokb + 16, g);
        for (int s = 0; s < 64; s += 2) {
            accf_finish(va, ta, rowbuf + (s & 7) * 2048 + (s >> 3) * 256 + d8 * 32, g);
            if (s + 2 < 64) {
                ta = tn;
                const char* vb = vbase + (size_t)((s + 2) >> 3) * 16384 * 128;
                PEER_GATHER16(va, vb, ta.ia, ta.ib)
                acc_load(p, tn, tokb + 8 * (min(s + 3, 63) & 7), g);
            }
            accf_finish(vbuf, tb, rowbuf + ((s + 1) & 7) * 2048 + ((s + 1) >> 3) * 256 + d8 * 32, g);
            if (s + 3 < 64) {
                tb = tn;
                const char* vb = vbase + (size_t)((s + 3) >> 3) * 16384 * 128;
                PEER_GATHER16(vbuf, vb, tb.ia, tb.ib)
                acc_load(p, tn, tokb + 8 * (min(s + 4, 63) & 7), g);
            }
        }
        __syncthreads();
        for (int k0 = 0; k0 < 8; k0 += 2) {
            float4 v[2][4];
#pragma unroll
            for (int q = 0; q < 2; ++q) {
                const bf16_t* xrow = p.x1b() + (size_t)(tokb + 8 * (k0 + q)) * D;
#pragma unroll
                for (int j = 0; j < 4; ++j) {
                    const uint2 xk = *(const uint2*)(xrow + (j * 64 + lane) * 4);
                    v[q][j] = make_float4(bflo(xk.x), bfhi(xk.x), bflo(xk.y), bfhi(xk.y));
                }
            }
#pragma unroll
            for (int q = 0; q < 2; ++q) {
                float* orow = p.out + (size_t)(tokb + 8 * (k0 + q)) * D;
                const char* prow = rowbuf + (k0 + q) * 2048;
                float ss = 0.f;
#pragma unroll
                for (int j = 0; j < 4; ++j) {
                    const uint2 pk = *(const uint2*)(prow + (j * 64 + lane) * 8);
                    v[q][j].x += bflo(pk.x); v[q][j].y += bfhi(pk.x); v[q][j].z += bflo(pk.y); v[q][j].w += bfhi(pk.y);
                    ss += v[q][j].x * v[q][j].x + v[q][j].y * v[q][j].y + v[q][j].z * v[q][j].z + v[q][j].w * v[q][j].w;
                }
                ss = wave_sum(ss);
                const float rs = rsqrtf(ss * (1.0f / 1024.0f) + EPS);
#pragma unroll
                for (int j = 0; j < 4; ++j) {
                    const float4 gg = *(const float4*)(p.fin_g + (j * 64 + lane) * 4);
                    float4 o;
                    o.x = v[q][j].x * rs * gg.x; o.y = v[q][j].y * rs * gg.y; o.z = v[q][j].z * rs * gg.z; o.w = v[q][j].w * rs * gg.w;
                    *(float4*)(orow + (j * 64 + lane) * 4) = o;
                }
            }
        }
    }
}

#define XB_TMO      128
#define XB_XCNT(j)  (256  + 64 * (j))
#define XB_XSUB(j)  (1280 + 64 * (j))
#define XB_XGEN(j)  (2304 + 64 * (j))
#define XB_TOP      3328
#define XB_TOPGEN   3392
#define XCD_BAR_WORDS 3456
#define XB_SPIN_CAP (1u << 18)
__device__ __forceinline__ unsigned xb_ld(unsigned* p)              { return __hip_atomic_load(p, __ATOMIC_RELAXED, __HIP_MEMORY_SCOPE_AGENT); }
__device__ __forceinline__ unsigned xb_add(unsigned* p, unsigned v) { return __hip_atomic_fetch_add(p, v, __ATOMIC_RELAXED, __HIP_MEMORY_SCOPE_AGENT); }
#define XB_SPIN(cond, bar) do { unsigned _sp = 0; while (cond) { __builtin_amdgcn_s_sleep(1); \
    if ((++_sp & 255u) == 0u) { if (xb_ld(&(bar)[XB_TMO])) break; if (_sp > XB_SPIN_CAP) { atomicAdd(&(bar)[XB_TMO], 1u); break; } } } } while (0)

struct XcdBarrier { unsigned* bar; unsigned x; volatile unsigned* st; };

__device__ __forceinline__ XcdBarrier xcd_barrier_post(unsigned* bar, volatile unsigned* st) {
    XcdBarrier b; b.bar = bar; b.x = xcc_id(); b.st = st;
    if (threadIdx.x == 0) (void)xb_add(&bar[XB_XCNT(b.x)], 1u);
    return b;
}
__device__ __forceinline__ void xcd_barrier_complete(unsigned* bar, unsigned x, unsigned& nloc, unsigned& nx) {
    const unsigned G = gridDim.x * gridDim.y * gridDim.z;
    unsigned sum, cnt, mine, sp = 0u;
    for (;;) {
        sum = 0u; cnt = 0u; mine = 0u;
#pragma unroll
        for (unsigned j = 0; j < 16; ++j) { const unsigned c = xb_ld(&bar[XB_XCNT(j)]); sum += c; cnt += (c > 0u) ? 1u : 0u; mine = (j == x) ? c : mine; }
        if (sum == G) break;
        __builtin_amdgcn_s_sleep(1);
        if ((++sp & 255u) == 0u) { if (xb_ld(&bar[XB_TMO])) break; if (sp > XB_SPIN_CAP) { atomicAdd(&bar[XB_TMO], 1u); break; } }
    }
    nloc = mine > 0u ? mine : 1u; nx = cnt > 0u ? cnt : 1u;
}
__device__ __forceinline__ void xcd_barrier(const XcdBarrier& b) {
    asm volatile("s_waitcnt vmcnt(0)" ::: "memory");
    __syncthreads();
    if (threadIdx.x == 0) {
        unsigned* bar = b.bar;
        __builtin_amdgcn_s_waitcnt(0);
        unsigned nloc = b.st[0], nx = b.st[1];
        if (nloc == 0u) { xcd_barrier_complete(bar, b.x, nloc, nx); b.st[0] = nloc; b.st[1] = nx; }
        const unsigned old = xb_add(&bar[XB_XSUB(b.x)], 1u);
        const unsigned gen = old / nloc;
        if (old + 1u == (gen + 1u) * nloc) {
            __builtin_amdgcn_fence(__ATOMIC_RELEASE, "agent");
            asm volatile("s_waitcnt vmcnt(0)" ::: "memory");
            const unsigned og = xb_add(&bar[XB_TOP], 1u);
            const unsigned tg = og / nx;
            if (og + 1u == (tg + 1u) * nx) xb_add(&bar[XB_TOPGEN], 1u);
            else XB_SPIN(xb_ld(&bar[XB_TOPGEN]) == tg, bar);
            __builtin_amdgcn_fence(__ATOMIC_ACQUIRE, "agent");
            xb_add(&bar[XB_XGEN(b.x)], 1u);
            asm volatile("s_waitcnt vmcnt(0)" ::: "memory");
        } else {
            XB_SPIN(xb_ld(&bar[XB_XGEN(b.x)]) == gen, bar);
            __builtin_amdgcn_fence(__ATOMIC_ACQUIRE, "agent");
            asm volatile("s_waitcnt vmcnt(0)" ::: "memory");
        }
    }
    __syncthreads();
}

#define RUN_PHASE(K, CALL)                                              \
    if (ph_lo <= (K) && (K) < ph_hi) {                                  \
        CALL;                                                           \
        if (COOP) { if ((K) + 1 < ph_hi) { xcd_barrier(xb); } } \
    }

template <bool COOP>
__global__ void __launch_bounds__(512, 2) fwd_kernel(Params p, int ph_lo, int ph_hi) {
    __shared__ __attribute__((aligned(16))) char smem[SMEM_BYTES + 16];
    char* smh = smem + VHB * HALF_SMEM;
    XcdBarrier xb;
    if (COOP) {
        if (threadIdx.x == 0) *(uint4*)(smem + SMEM_BYTES) = make_uint4(0u, 0u, 0u, 0u);
        __syncthreads();
        xb = xcd_barrier_post(p.bar(), (volatile unsigned*)(smem + SMEM_BYTES));
    }
    if (COOP) { if (ph_lo < 0) cg::this_grid().sync(); }
    RUN_PHASE(0, phase_prep(p, smh))
    RUN_PHASE(1, phase_gemm_in(p, smem))
    RUN_PHASE(2, phase_mixers(p, smh))
    RUN_PHASE(3, (phase_gemm_kv(p, smh), phase_hg_scan(p)))
    RUN_PHASE(4, phase_hg_out(p, smh))
    RUN_PHASE(5, phase_gemm_out(p, smem))
    RUN_PHASE(7, phase_gemm_q(p, smem))
    RUN_PHASE(8, phase_route(p, smh))
    RUN_PHASE(10, phase_peer_dots(p, smem))
    RUN_PHASE(12, phase_peer_accum(p, smem))
}

extern "C" void kernel_launch(void* const* d_in, const int* in_sizes, int n_in, void* d_out, int out_size, void* d_ws, size_t ws_size,
                              hipStream_t stream) {
    Params p{};
    p.x = (const float*)d_in[0]; p.mem = (const float*)d_in[1]; p.attn_g = (const float*)d_in[2]; p.w_in = (const float*)d_in[3];
    p.rpb = (const float*)d_in[4]; p.hg_lb = (const float*)d_in[5]; p.hg_g = (const float*)d_in[6]; p.mem_g = (const float*)d_in[7];
    p.w_kv = (const float*)d_in[8]; p.w_out = (const float*)d_in[9]; p.ffn_g = (const float*)d_in[10]; p.w_q = (const float*)d_in[11];
    p.subk = (const float*)d_in[12]; p.pu = (const float*)d_in[13]; p.pv = (const float*)d_in[14]; p.fin_g = (const float*)d_in[15];
    p.out = (float*)d_out;
    p.ws = (char*)d_ws;
    if (WS_TOTAL > ws_size) { fprintf(stderr, "workspace too small: need %zu have %zu\n", (size_t)WS_TOTAL, ws_size); return; }

#if defined(MULTI_LAUNCH)
    for (int ph = 0; ph < NPHASE; ++ph) fwd_kernel<false><<<dim3(512), dim3(512), 0, stream>>>(p, ph, ph + 1);
#else
    static int grid_blocks = 0;
    if (!grid_blocks) {
        int dev = 0, cus = 0, per_cu = 0;
        hipGetDevice(&dev);
        hipDeviceGetAttribute(&cus, hipDeviceAttributeMultiprocessorCount, dev);
        hipOccupancyMaxActiveBlocksPerMultiprocessor(&per_cu, fwd_kernel<true>, 512, 0);
        if (per_cu > 1) per_cu = 1;
        grid_blocks = (cus * per_cu) & ~3;
    }
    (void)hipMemsetAsync((char*)d_ws + OFF_BAR, 0, XCD_BAR_WORDS * 4, stream);
    int lo = 0, hi = NPHASE;
    void* args[] = {&p, &lo, &hi};
    hipError_t e = hipLaunchCooperativeKernel((void*)fwd_kernel<true>, dim3(grid_blocks), dim3(512), args, 0, stream);
    if (e != hipSuccess) fprintf(stderr, "cooperative launch failed: %s (grid %d)\n", hipGetErrorString(e), grid_blocks);
#endif
}
```

```cpp
#include <hip/hip_runtime.h>
#include <hip/hip_cooperative_groups.h>
#include <stdint.h>
#include <cstdio>

namespace cg = cooperative_groups;

#define VTID ((int)(threadIdx.x & 255))
#define VHB ((int)(threadIdx.x >> 8))
#define VBID ((int)(blockIdx.x * 2 + (threadIdx.x >> 8)))
#define VGRID ((int)(gridDim.x * 2))
constexpr int HALF_SMEM = 73728;

typedef unsigned short bf16_t;
typedef short bf16x8 __attribute__((ext_vector_type(8)));
typedef float f32x4 __attribute__((ext_vector_type(4)));

constexpr int D = 1024;
constexpr int NB = 4;
constexpr int T = 8192;
constexpr int NTOK = NB * T;
constexpr int INW = 3072;
constexpr int QW = 2048;
constexpr float EPS = 1e-6f;
constexpr int SMEM_BYTES = 2 * 73728;
constexpr int NPHASE = 14;

constexpr size_t al256(size_t x) { return (x + 255) & ~(size_t)255; }
constexpr size_t OFF_W_IN_T = 0;
constexpr size_t OFF_W_OUT_T = OFF_W_IN_T + al256((size_t)3072 * 1024 * 2);
constexpr size_t OFF_W_Q_T = OFF_W_OUT_T + al256((size_t)1024 * 1024 * 2);
constexpr size_t OFF_W_KV_T = OFF_W_Q_T + al256((size_t)2048 * 1024 * 2);
constexpr size_t OFF_H = OFF_W_KV_T + al256((size_t)512 * 1024 * 2);
constexpr size_t OFF_Z = OFF_H + al256((size_t)32768 * 1024 * 2);
constexpr size_t OFF_MIX = OFF_Z + al256((size_t)32768 * 3072 * 2);
constexpr size_t OFF_MEMN = OFF_MIX + al256((size_t)32768 * 1024 * 2);
constexpr size_t OFF_KVB = OFF_MEMN + al256((size_t)1024 * 1024 * 2);
constexpr size_t OFF_LB = OFF_KVB + al256((size_t)1024 * 512 * 2);
constexpr size_t OFF_HSTATE = OFF_LB + al256(512 * 4);
constexpr size_t OFF_HDEC = OFF_HSTATE + al256((size_t)4096 * 4096 * 4);
constexpr size_t OFF_UC = OFF_HDEC + al256((size_t)4096 * 64 * 4);
constexpr size_t OFF_VC = OFF_UC + al256((size_t)16384 * 1024);
constexpr size_t OFF_QUEUE = OFF_VC + al256((size_t)16384 * 1024);
constexpr size_t OFF_SUBK = OFF_QUEUE + al256(2048 * 4);
constexpr size_t OFF_BAR = OFF_SUBK + al256((size_t)16 * 128 * 128 * 2);
constexpr size_t OFF_SS1 = OFF_BAR + al256(4096 * 4);
constexpr size_t OFF_HMAX = OFF_SS1 + al256((size_t)32768 * 4);
constexpr size_t OFF_CSUM = OFF_HMAX + al256((size_t)32768 * 4);
constexpr size_t OFF_SCALE_U = OFF_CSUM + al256((size_t)32768 * 4);
constexpr size_t OFF_SCALE_V = OFF_SCALE_U + al256(16384 * 4);
constexpr size_t OFF_VT = OFF_SCALE_V + al256(16384 * 4);
constexpr size_t OFF_KVT = OFF_VT + al256((size_t)32768 * 512 * 2);
constexpr size_t WS_TOTAL = OFF_KVT + al256((size_t)1024 * 256 * 2);
constexpr size_t OFF_EIDX = OFF_HSTATE;
constexpr size_t OFF_GATE = OFF_HSTATE + (size_t)32768 * 128 * 4;
constexpr size_t OFF_COEF = OFF_HSTATE + (size_t)32768 * 128 * 8;
constexpr size_t OFF_SS = OFF_HSTATE + (size_t)32768 * 128 * 12;
constexpr size_t OFF_PARTIAL = OFF_Z;
constexpr size_t OFF_PEER_OUT = OFF_Z + (size_t)8 * 32768 * 128 * 4;

struct Params {
    const float *x, *mem, *attn_g, *w_in, *rpb, *hg_lb, *hg_g, *mem_g, *w_kv, *w_out, *ffn_g, *w_q, *subk, *pu, *pv, *fin_g;
    float* out;
    char* ws;
#define WSF(type, name, off) __device__ __forceinline__ type* name() const { return (type*)(ws + (off)); }
    WSF(bf16_t, w_in_t, OFF_W_IN_T) WSF(bf16_t, w_out_t, OFF_W_OUT_T) WSF(bf16_t, w_q_t, OFF_W_Q_T) WSF(bf16_t, w_kv_t, OFF_W_KV_T)
    WSF(bf16_t, h, OFF_H)
    WSF(bf16_t, z, OFF_Z)
    WSF(bf16_t, mix, OFF_MIX)
    WSF(bf16_t, memn, OFF_MEMN)
    WSF(bf16_t, kvb, OFF_KVB)
    WSF(float, lb, OFF_LB)
    WSF(float, hstate, OFF_HSTATE)
    WSF(float, hdec, OFF_HDEC)
    WSF(unsigned short, eidx, OFF_EIDX)
    WSF(float, gate, OFF_GATE)
    WSF(signed char, coef, OFF_COEF)
    WSF(bf16_t, x1b, OFF_PEER_OUT)
    WSF(float, ss, OFF_SS)
    WSF(float, partial, OFF_PARTIAL)
    WSF(bf16_t, u_c, OFF_UC) WSF(bf16_t, v_c, OFF_VC)
    WSF(unsigned, queue, OFF_QUEUE)
    WSF(bf16_t, subk_b, OFF_SUBK)
    WSF(unsigned, bar, OFF_BAR)
    WSF(float, ss1, OFF_SS1) WSF(unsigned, hmax, OFF_HMAX) WSF(float, csum, OFF_CSUM)
    WSF(float, scale_u, OFF_SCALE_U) WSF(float, scale_v, OFF_SCALE_V)
    WSF(bf16_t, vT, OFF_VT)
    WSF(bf16_t, kvT, OFF_KVT)
#undef WSF
};

__device__ __forceinline__ float bf2f(bf16_t v) { return __uint_as_float(((unsigned)v) << 16); }
__device__ __forceinline__ bf16_t f2bf(float f) {
    unsigned u = __float_as_uint(f);
    u += 0x7FFFu + ((u >> 16) & 1u);
    return (bf16_t)(u >> 16);
}
__device__ __forceinline__ float bflo(unsigned u) { return __uint_as_float(u << 16); }
__device__ __forceinline__ float bfhi(unsigned u) { return __uint_as_float(u & 0xFFFF0000u); }
typedef __bf16 bf16x2v_t __attribute__((ext_vector_type(2)));
typedef float f32x2v_t __attribute__((ext_vector_type(2)));
__device__ __forceinline__ unsigned pack2(float a, float b) {
    const f32x2v_t v = {a, b};
    return __builtin_bit_cast(unsigned, __builtin_convertvector(v, bf16x2v_t));
}

__device__ __forceinline__ float wave_sum(float v) {
#pragma unroll
    for (int o = 32; o; o >>= 1) v += __shfl_xor(v, o);
    return v;
}
__device__ __forceinline__ float wave_max(float v) {
#pragma unroll
    for (int o = 32; o; o >>= 1) v = fmaxf(v, __shfl_xor(v, o));
    return v;
}


typedef __bf16 bf16x2_t __attribute__((ext_vector_type(2)));
template <int CTRL>
__device__ __forceinline__ float dpp_mov(float v) {
    return __builtin_bit_cast(float, __builtin_amdgcn_update_dpp(0, __builtin_bit_cast(int, v), CTRL, 0xf, 0xf, true));
}
#define DPP_QP_X1 0xB1
#define DPP_QP_X2 0x4E
#define DPP_HMIRROR 0x141
#define DPP_ROR8 0x128
__device__ __forceinline__ unsigned xcc_id() { return (unsigned)__builtin_amdgcn_s_getreg((3 << 11) | 20) & 0xFu; }

__device__ __forceinline__ void transpose_tile(const float* __restrict__ in, bf16_t* __restrict__ out, int K, int N, int tile, char* smem) {
    float* tl = (float*)smem;
    const int ntn = N >> 6;
    const int k0 = (tile / ntn) << 6, n0 = (tile % ntn) << 6;
    const int tid = VTID;
    __syncthreads();
#pragma unroll 4
    for (int i = 0; i < 16; ++i) {
        int idx = tid + 256 * i;
        int r = idx >> 6, c = idx & 63;
        tl[r * 65 + c] = in[(size_t)(k0 + r) * N + n0 + c];
    }
    __syncthreads();
#pragma unroll 4
    for (int i = 0; i < 16; ++i) {
        int idx = tid + 256 * i;
        int r = idx >> 6, c = idx & 63;
        out[(size_t)(n0 + r) * K + k0 + c] = f2bf(tl[c * 65 + r]);
    }
}

__device__ __forceinline__ void rmsnorm_row_bf16(const float* __restrict__ xr, const float* __restrict__ g, bf16_t* __restrict__ o, int lane) {
    float4 v[4];
    float ss = 0.f;
#pragma unroll
    for (int j = 0; j < 4; ++j) {
        v[j] = *(const float4*)(xr + (j * 64 + lane) * 4);
        ss += v[j].x * v[j].x + v[j].y * v[j].y + v[j].z * v[j].z + v[j].w * v[j].w;
    }
    ss = wave_sum(ss);
    const float rs = rsqrtf(ss * (1.0f / 1024.0f) + EPS);
#pragma unroll
    for (int j = 0; j < 4; ++j) {
        const float4 gg = *(const float4*)(g + (j * 64 + lane) * 4);
        uint2 pk;
        pk.x = pack2(v[j].x * rs * gg.x, v[j].y * rs * gg.y);
        pk.y = pack2(v[j].z * rs * gg.z, v[j].w * rs * gg.w);
        *(uint2*)(o + (j * 64 + lane) * 4) = pk;
    }
}

__device__ void phase_prep(const Params& p, char* smem) {
    const int tid = VTID, lane = tid & 63, w = tid >> 6;
    const int gsz = VGRID, bid = VBID;
    const int t_in = (1024 / 64) * (INW / 64);
    const int t_out = 16 * 16;
    const int t_q = 16 * (QW / 64);
    const int t_kv = 16 * 8;
    const int t_all = t_in + t_out + t_q + t_kv;
    for (int it = bid; it < t_all; it += gsz) {
        if (it < t_in) transpose_tile(p.w_in, p.w_in_t(), 1024, INW, it, smem);
        else if (it < t_in + t_out) transpose_tile(p.w_out, p.w_out_t(), 1024, 1024, it - t_in, smem);
        else if (it < t_in + t_out + t_q) transpose_tile(p.w_q, p.w_q_t(), 1024, QW, it - t_in - t_out, smem);
        else transpose_tile(p.w_kv, p.w_kv_t(), 1024, 512, it - t_in - t_out - t_q, smem);
    }
    for (int i = bid * 256 + tid; i < NTOK; i += gsz * 256) { p.ss1()[i] = 0.f; p.hmax()[i] = 0u; }
    if (bid == 0) {
        for (int i = tid; i < 512; i += 256) {
            int dir = i >> 8, k = i & 255;
            float a0 = p.hg_lb[(dir * 2 + 0) * 256 + k], a1 = p.hg_lb[(dir * 2 + 1) * 256 + k];
            float m = fmaxf(a0, a1);
            float e0 = expf(a0 - m), e1 = expf(a1 - m);
            p.lb()[i] = e0 / (e0 + e1);
        }
    }
    const int nrows = NTOK + 1024;
    for (int r0 = bid * 4; r0 < nrows; r0 += gsz * 4) {
        int r = r0 + w;
        if (r < NTOK) rmsnorm_row_bf16(p.x + (size_t)r * D, p.attn_g, p.h() + (size_t)r * D, lane);
        else if (r < nrows) rmsnorm_row_bf16(p.mem + (size_t)(r - NTOK) * D, p.mem_g, p.memn() + (size_t)(r - NTOK) * D, lane);
    }
    for (int i = bid * 256 + tid; i < 16 * 128 * 128 / 4; i += gsz * 256) {
        const float4 v = *(const float4*)(p.subk + (size_t)i * 4);
        uint2 pk; pk.x = pack2(v.x, v.y); pk.y = pack2(v.z, v.w);
        *(uint2*)(p.subk_b() + (size_t)i * 4) = pk;
    }
    for (int r0 = bid * 4; r0 < 2 * 16384; r0 += gsz * 4) {
        const int r = r0 + w;
        const bool isv = r >= 16384;
        const int e = r & 16383;
        const float* srcp = (isv ? p.pv : p.pu) + (size_t)e * D;
        unsigned* dst = (unsigned*)(isv ? p.v_c() : p.u_c());
        float4 v[4];
        float am = 0.f;
#pragma unroll
        for (int j = 0; j < 4; ++j) {
            v[j] = *(const float4*)(srcp + (j * 64 + lane) * 4);
            am = fmaxf(am, fmaxf(fmaxf(fabsf(v[j].x), fabsf(v[j].y)), fmaxf(fabsf(v[j].z), fabsf(v[j].w))));
        }
        am = wave_max(am);
        const float qs = am > 0.f ? 127.0f / am : 0.f;
        if (lane == 0) (isv ? p.scale_v() : p.scale_u())[e] = am * (1.0f / 127.0f);
        const int off = 0;
#pragma unroll
        for (int j = 0; j < 4; ++j) {
            const int q0 = (int)rintf(v[j].x * qs) + off, q1 = (int)rintf(v[j].y * qs) + off;
            const int q2 = (int)rintf(v[j].z * qs) + off, q3 = (int)rintf(v[j].w * qs) + off;
            const unsigned pk = (unsigned)(q0 & 255) | ((unsigned)(q1 & 255) << 8) | ((unsigned)(q2 & 255) << 16) | ((unsigned)(q3 & 255) << 24);
            const int c = j * 2 + (lane >> 5), d = (lane & 31) * 4;
            dst[(((size_t)c * 16384 + e) * 128 + d) >> 2] = pk;
        }
    }
}

struct EpiBf16 {
    bf16_t* C; int ldc;
    __device__ __forceinline__ void operator()(int row, int col, const f32x4& v) const {
        uint2 pk; pk.x = pack2(v[0], v[1]); pk.y = pack2(v[2], v[3]);
        *(uint2*)(C + (size_t)row * ldc + col) = pk;
    }
};
struct EpiBf16T {
    bf16_t* C; int col0, ncols, rows_per_b;
    __device__ __forceinline__ void operator()(int row, int col, const f32x4& v) const {
        const int bb = row / rows_per_b, rr = row - bb * rows_per_b;
        uint2 pk; pk.x = pack2(v[0], v[1]); pk.y = pack2(v[2], v[3]);
        *(uint2*)(C + ((size_t)bb * ncols + (col - col0)) * rows_per_b + rr) = pk;
    }
};
struct EpiBf16RowScale {
    bf16_t* C; int ldc; const float* ssrow;
    __device__ __forceinline__ void operator()(int row, int col, const f32x4& v) const {
        const float rs = rsqrtf(ssrow[row] * (1.0f / 1024.0f) + EPS);
        uint2 pk; pk.x = pack2(v[0] * rs, v[1] * rs); pk.y = pack2(v[2] * rs, v[3] * rs);
        *(uint2*)(C + (size_t)row * ldc + col) = pk;
    }
};
struct EpiResNorm {
    bf16_t* C; const float* R; const float* g; bf16_t* H; int ldc; float* ssrow; unsigned* hmax;
    __device__ __forceinline__ void operator()(int row, int col, const f32x4& v, float& ssq, float& am) const {
        const float4 r = *(const float4*)(R + (size_t)row * ldc + col);
        const float4 gg = *(const float4*)(g + col);
        float4 o; o.x = v[0] + r.x; o.y = v[1] + r.y; o.z = v[2] + r.z; o.w = v[3] + r.w;
        { uint2 xk; xk.x = pack2(o.x, o.y); xk.y = pack2(o.z, o.w); *(uint2*)(C + (size_t)row * ldc + col) = xk; }
        const float h0 = o.x * gg.x, h1 = o.y * gg.y, h2 = o.z * gg.z, h3 = o.w * gg.w;
        uint2 pk; pk.x = pack2(h0, h1); pk.y = pack2(h2, h3);
        *(uint2*)(H + (size_t)row * ldc + col) = pk;
        ssq += o.x * o.x + o.y * o.y + o.z * o.z + o.w * o.w;
        am = fmaxf(am, fmaxf(fmaxf(fabsf(h0), fabsf(h1)), fmaxf(fabsf(h2), fabsf(h3))));
    }
    __device__ __forceinline__ void row_done(int row, float ssq, float am) const {
        atomicAdd(ssrow + row, ssq);
        atomicMax(hmax + row, __float_as_uint(am));
    }
};
struct EpiResF32 {
    float* C; const float* R; int ldc;
    __device__ __forceinline__ void operator()(int row, int col, const f32x4& v) const {
        const float4 r = *(const float4*)(R + (size_t)row * ldc + col);
        float4 o; o.x = v[0] + r.x; o.y = v[1] + r.y; o.z = v[2] + r.z; o.w = v[3] + r.w;
        *(float4*)(C + (size_t)row * ldc + col) = o;
    }
};

template <bool TRANS, class Epi, bool ROWSS = false>
__device__ __forceinline__ void gemm_tile(const bf16_t* __restrict__ A, int lda, const bf16_t* __restrict__ Bt, int ldb, int K,
                                          int m0, int n0, char* smem, const Epi& epi, float* ssrow = nullptr) {
    const int tid = VTID, lane = tid & 63, w = tid >> 6, wr = w >> 1, wc = w & 1;
    const int fr = lane & 15, fq = lane >> 4;
    const int srow = lane >> 3, sslot = lane & 7;
    f32x4 acc[4][4];
#pragma unroll
    for (int mi = 0; mi < 4; ++mi)
#pragma unroll
        for (int ni = 0; ni < 4; ++ni) acc[mi][ni] = (f32x4){0.f, 0.f, 0.f, 0.f};
    const int g0 = (sslot ^ (srow >> 1)) * 8, g1 = (sslot ^ (4 + (srow >> 1))) * 8;
    const bf16_t* Ab = A + (size_t)(m0 + w * 32 + srow) * lda;
    const bf16_t* Bb = Bt + (size_t)(n0 + w * 32 + srow) * ldb;
    const int nk = K >> 6;
    __syncthreads();
#define GEMM_STAGE(kt, buf)                                                                                                  \
    do {                                                                                                                     \
        char* sa = smem + (buf) * 32768 + w * 4096;                                                                          \
        char* sb = sa + 16384;                                                                                               \
        _Pragma("unroll") for (int i = 0; i < 4; ++i) {                                                                      \
            const int gc = (i & 1) ? g1 : g0;                                                                                \
            __builtin_amdgcn_global_load_lds((const unsigned*)(Ab + (size_t)(i * 8) * lda + (kt) * 64 + gc), (unsigned*)(sa + i * 1024), 16, 0, 0); \
            __builtin_amdgcn_global_load_lds((const unsigned*)(Bb + (size_t)(i * 8) * ldb + (kt) * 64 + gc), (unsigned*)(sb + i * 1024), 16, 0, 0); \
        }                                                                                                                    \
    } while (0)
    GEMM_STAGE(0, 0);
    const int key = fr >> 1;
    for (int kt = 0; kt < nk; ++kt) {
        asm volatile("s_waitcnt vmcnt(0)" ::: "memory");
        __syncthreads();
        if (kt + 1 < nk) GEMM_STAGE(kt + 1, (kt + 1) & 1);
        const char* sa = smem + (kt & 1) * 32768;
        const char* sb = sa + 16384;
#pragma unroll
        for (int ks = 0; ks < 2; ++ks) {
            bf16x8 af[4], bfr[4];
            const int co = ((ks * 4 + fq) ^ key) << 4;
#pragma unroll
            for (int mi = 0; mi < 4; ++mi) af[mi] = *(const bf16x8*)(sa + (wr * 64 + mi * 16 + fr) * 128 + co);
#pragma unroll
            for (int ni = 0; ni < 4; ++ni) bfr[ni] = *(const bf16x8*)(sb + (wc * 64 + ni * 16 + fr) * 128 + co);
#pragma unroll
            for (int mi = 0; mi < 4; ++mi)
#pragma unroll
                for (int ni = 0; ni < 4; ++ni)
                    acc[mi][ni] = TRANS ? __builtin_amdgcn_mfma_f32_16x16x32_bf16(af[mi], bfr[ni], acc[mi][ni], 0, 0, 0)
                                        : __builtin_amdgcn_mfma_f32_16x16x32_bf16(bfr[ni], af[mi], acc[mi][ni], 0, 0, 0);
        }
    }
#undef GEMM_STAGE
    if constexpr (ROWSS) {
#pragma unroll
        for (int mi = 0; mi < 4; ++mi) {
            const int row = m0 + wr * 64 + mi * 16 + fr;
            float ssq = 0.f, am = 0.f;
#pragma unroll
            for (int ni = 0; ni < 4; ++ni) epi(row, n0 + wc * 64 + ni * 16 + fq * 4, acc[mi][ni], ssq, am);
            ssq += __shfl_xor(ssq, 16);
            ssq += __shfl_xor(ssq, 32);
            am = fmaxf(am, __shfl_xor(am, 16));
            am = fmaxf(am, __shfl_xor(am, 32));
            if (fq == 0) epi.row_done(row, ssq, am);
        }
    } else {
#pragma unroll
        for (int mi = 0; mi < 4; ++mi)
#pragma unroll
            for (int ni = 0; ni < 4; ++ni) {
                if (TRANS) epi(m0 + wr * 64 + mi * 16 + fq * 4, n0 + wc * 64 + ni * 16 + fr, acc[mi][ni]);
                else epi(m0 + wr * 64 + mi * 16 + fr, n0 + wc * 64 + ni * 16 + fq * 4, acc[mi][ni]);
            }
    }
}


namespace g8 {
constexpr int BM = 256, BK = 64, HALF = 128, HT = HALF * BK;
__device__ __forceinline__ int lds_byte(int r, int c) {
    const int st = (r >> 4) * 2 + (c >> 5), rr = r & 15, cc = c & 31, ob = rr * 64 + cc * 2;
    return st * 1024 + (ob ^ (((ob >> 9) & 1) << 5));
}
__device__ __forceinline__ void stage_rc(int b, int& R, int& C) {
    const int st = b / 1024, sb = b % 1024, swz = sb ^ (((sb >> 9) & 1) << 5);
    R = (st >> 1) * 16 + swz / 64; C = (st & 1) * 32 + (swz % 64) / 2;
}
__device__ __forceinline__ void tile_of(int L, int nM, int nN, int& pm, int& pn) {
    const int nwg = nM * nN;
    int wgid = L;
    { const int q = nwg / 8, r = nwg % 8, xcd = wgid % 8, off = wgid / 8; wgid = (xcd < r ? xcd * (q + 1) : r * (q + 1) + (xcd - r) * q) + off; }
    const int nig = 8 * nN, gid = wgid / nig, fm = gid * 8, gsz = (nM - fm) < 8 ? (nM - fm) : 8;
    pm = fm + ((wgid % nig) % gsz); pn = (wgid % nig) / gsz;
}
}

#define G8_LAS __attribute__((address_space(3)))
template <bool TRANS, bool ROWSS, class Epi>
__device__ __forceinline__ void gemm256_tile(const bf16_t* __restrict__ A, const bf16_t* __restrict__ Bt, int K, int brow, int bcol,
                                             char* shmc, const Epi& epi) {
    using namespace g8;
    G8_LAS unsigned char* lds = (G8_LAS unsigned char*)shmc;
    const int tid = threadIdx.x, wid = __builtin_amdgcn_readfirstlane(tid >> 6), lane = tid & 63, wr = wid >> 2, wc = wid & 3, fr = lane & 15, fq = lane >> 4;
    constexpr int HTB = HALF * BK * 2;
    unsigned voff[2];
#pragma unroll
    for (int i = 0; i < 2; ++i) { int R, C; stage_rc(tid * 16 + i * 8192, R, C); voff[i] = (unsigned)(R * K + C) * 2u; }
    const size_t kstep = (size_t)(BK * 2);
    const size_t hstep = (size_t)HALF * K * 2;
    const unsigned ldsw = (unsigned)wid * 1024u;
    const int aoff = lds_byte(wr * 64 + fr, fq * 8), boff = lds_byte(wc * 32 + fr, fq * 8);
    const char* cA = (const char*)A + (size_t)brow * K * 2;
    const char* cB = (const char*)Bt + (size_t)bcol * K * 2;
#define G8_SA(b, h) (((b) * 2 + (h)) * HTB)
#define G8_SB(b, h) ((4 + (b) * 2 + (h)) * HTB)
#define G8_STAGE(bufoff, gbase) do { _Pragma("unroll") for (int _i = 0; _i < 2; ++_i) \
        __builtin_amdgcn_global_load_lds((const unsigned*)((const char*)(gbase) + voff[_i]), (G8_LAS unsigned*)(lds + (bufoff) + ldsw + _i * 8192), 16, 0, 0); } while (0)
#define G8_LDA(dst, b, h) do { _Pragma("unroll") for (int m = 0; m < 4; ++m) _Pragma("unroll") for (int k = 0; k < 2; ++k) dst[m][k] = *(const G8_LAS bf16x8*)(lds + G8_SA(b, h) + aoff + m * 2048 + k * 1024); } while (0)
#define G8_LDB(dst, b, h) do { _Pragma("unroll") for (int n = 0; n < 2; ++n) _Pragma("unroll") for (int k = 0; k < 2; ++k) dst[n][k] = *(const G8_LAS bf16x8*)(lds + G8_SB(b, h) + boff + n * 2048 + k * 1024); } while (0)
#define G8_MMA(ai, bj, At_, Bt_) do { __builtin_amdgcn_s_setprio(1); _Pragma("unroll") for (int m = 0; m < 4; ++m) _Pragma("unroll") for (int n = 0; n < 2; ++n) _Pragma("unroll") for (int k = 0; k < 2; ++k) \
        acc[ai][bj][m][n] = TRANS ? __builtin_amdgcn_mfma_f32_16x16x32_bf16(At_[m][k], Bt_[n][k], acc[ai][bj][m][n], 0, 0, 0) \
                                  : __builtin_amdgcn_mfma_f32_16x16x32_bf16(Bt_[n][k], At_[m][k], acc[ai][bj][m][n], 0, 0, 0); \
        __builtin_amdgcn_s_setprio(0); } while (0)
#define G8_WAIT_V(n) asm volatile("s_waitcnt vmcnt(" #n ")" ::: "memory")
#define G8_WAIT_L(n) asm volatile("s_waitcnt lgkmcnt(" #n ")" ::: "memory")
#define G8_BAR __builtin_amdgcn_s_barrier()
#define G8_SCHED __builtin_amdgcn_sched_barrier(0)
    f32x4 acc[2][2][4][2];
#pragma unroll
    for (int a = 0; a < 2; ++a)
#pragma unroll
        for (int b = 0; b < 2; ++b)
#pragma unroll
            for (int m = 0; m < 4; ++m)
#pragma unroll
                for (int n = 0; n < 2; ++n) acc[a][b][m][n] = (f32x4){0.f, 0.f, 0.f, 0.f};
    bf16x8 At[4][2], B0[2][2], B1[2][2];
    const int nt = K / BK;
    __syncthreads();
    G8_STAGE(G8_SB(0, 0), cB); G8_STAGE(G8_SA(0, 0), cA); G8_STAGE(G8_SB(0, 1), cB + hstep); G8_STAGE(G8_SA(0, 1), cA + hstep);
    if (wr == 1) G8_BAR;
    G8_WAIT_V(4); G8_BAR;
    G8_STAGE(G8_SB(1, 0), cB + kstep); G8_STAGE(G8_SA(1, 0), cA + kstep); G8_STAGE(G8_SB(1, 1), cB + hstep + kstep);
    G8_WAIT_V(6); G8_BAR;
    for (int t = 0; t < nt - 2; t += 2) {
        const char* a1 = cA + (size_t)(t + 1) * kstep; const char* a2 = a1 + kstep; const char* a3 = a2 + kstep;
        const char* b2 = cB + (size_t)(t + 2) * kstep; const char* b3 = b2 + kstep;
        G8_LDB(B0, 0, 0); G8_SCHED; G8_LDA(At, 0, 0); G8_STAGE(G8_SA(1, 1), a1 + hstep);
        G8_WAIT_L(8); G8_BAR; G8_WAIT_L(0); G8_MMA(0, 0, At, B0); G8_BAR; G8_SCHED;
        G8_LDB(B1, 0, 1); G8_STAGE(G8_SB(0, 0), b2);
        G8_BAR; G8_WAIT_L(0); G8_MMA(0, 1, At, B1); G8_BAR;
        G8_LDA(At, 0, 1); G8_STAGE(G8_SA(0, 0), a2);
        G8_BAR; G8_WAIT_L(0); G8_MMA(1, 0, At, B0); G8_BAR; G8_SCHED;
        G8_STAGE(G8_SB(0, 1), b2 + hstep);
        G8_WAIT_V(6); G8_BAR; G8_MMA(1, 1, At, B1); G8_BAR;
        G8_LDB(B0, 1, 0); G8_SCHED; G8_LDA(At, 1, 0); G8_STAGE(G8_SA(0, 1), a2 + hstep);
        G8_WAIT_L(8); G8_BAR; G8_WAIT_L(0); G8_MMA(0, 0, At, B0); G8_BAR; G8_SCHED;
        G8_LDB(B1, 1, 1); G8_STAGE(G8_SB(1, 0), b3);
        G8_BAR; G8_WAIT_L(0); G8_MMA(0, 1, At, B1); G8_BAR;
        G8_LDA(At, 1, 1); G8_STAGE(G8_SA(1, 0), a3);
        G8_BAR; G8_WAIT_L(0); G8_MMA(1, 0, At, B0); G8_BAR; G8_SCHED;
        G8_STAGE(G8_SB(1, 1), b3 + hstep);
        G8_WAIT_V(6); G8_BAR; G8_MMA(1, 1, At, B1); G8_BAR;
    }
    { G8_LDB(B0, 0, 0); G8_LDA(At, 0, 0); G8_STAGE(G8_SA(1, 1), cA + (size_t)(nt - 1) * kstep + hstep);
      G8_BAR; G8_WAIT_L(0); G8_MMA(0, 0, At, B0); G8_BAR;
      G8_LDB(B1, 0, 1); G8_BAR; G8_WAIT_L(0); G8_MMA(0, 1, At, B1); G8_BAR;
      G8_LDA(At, 0, 1); G8_WAIT_V(4); G8_BAR; G8_WAIT_L(0); G8_MMA(1, 0, At, B0); G8_MMA(1, 1, At, B1); G8_BAR; }
    { G8_LDB(B0, 1, 0); G8_LDA(At, 1, 0); G8_WAIT_V(2); G8_BAR; G8_WAIT_L(0); G8_MMA(0, 0, At, B0); G8_BAR;
      G8_LDB(B1, 1, 1); G8_WAIT_V(0); G8_BAR; G8_WAIT_L(0); G8_MMA(0, 1, At, B1); G8_BAR;
      G8_LDA(At, 1, 1); G8_BAR; G8_WAIT_L(0); G8_MMA(1, 0, At, B0); G8_MMA(1, 1, At, B1); G8_BAR; }
    if (wr == 0) G8_BAR;
    if constexpr (ROWSS) {
#pragma unroll
        for (int ai = 0; ai < 2; ++ai)
#pragma unroll
            for (int m = 0; m < 4; ++m) {
                const int row = brow + ai * HALF + wr * 64 + m * 16 + fr;
                float ssq = 0.f, am = 0.f;
#pragma unroll
                for (int bj = 0; bj < 2; ++bj)
#pragma unroll
                    for (int n = 0; n < 2; ++n) epi(row, bcol + bj * HALF + wc * 32 + n * 16 + fq * 4, acc[ai][bj][m][n], ssq, am);
                ssq += __shfl_xor(ssq, 16);
                ssq += __shfl_xor(ssq, 32);
                am = fmaxf(am, __shfl_xor(am, 16));
                am = fmaxf(am, __shfl_xor(am, 32));
                if (fq == 0) epi.row_done(row, ssq, am);
            }
    } else {
#pragma unroll
        for (int ai = 0; ai < 2; ++ai)
#pragma unroll
            for (int bj = 0; bj < 2; ++bj)
#pragma unroll
                for (int m = 0; m < 4; ++m)
#pragma unroll
                    for (int n = 0; n < 2; ++n) {
                        if (TRANS) epi(brow + ai * HALF + wr * 64 + m * 16 + fq * 4, bcol + bj * HALF + wc * 32 + n * 16 + fr, acc[ai][bj][m][n]);
                        else epi(brow + ai * HALF + wr * 64 + m * 16 + fr, bcol + bj * HALF + wc * 32 + n * 16 + fq * 4, acc[ai][bj][m][n]);
                    }
    }
#undef G8_SA
#undef G8_SB
#undef G8_STAGE
#undef G8_LDA
#undef G8_LDB
#undef G8_MMA
#undef G8_WAIT_V
#undef G8_WAIT_L
#undef G8_BAR
#undef G8_SCHED
}

__device__ void phase_gemm_in(const Params& p, char* smem) {
    const int nM = NTOK / 256, nN = INW / 256;
    EpiBf16 e1{p.z(), INW};
    EpiBf16T e1t{p.vT(), 1024, 512, T};
    for (int i = 0; i * (int)gridDim.x + (int)blockIdx.x < nM * nN; ++i) {
        int pm, pn;
        g8::tile_of(i * gridDim.x + blockIdx.x, nM, nN, pm, pn);
        if (pn >= 4 && pn < 6) gemm256_tile<true, false>(p.h(), p.w_in_t(), D, pm * 256, pn * 256, smem, e1t);
        else gemm256_tile<false, false>(p.h(), p.w_in_t(), D, pm * 256, pn * 256, smem, e1);
    }
}

__device__ void phase_gemm_kv(const Params& p, char* smh) {
    EpiBf16 e2{p.kvb(), 512};
    EpiBf16T e2t{p.kvT(), 256, 256, 256};
    const bool dedicated = gridDim.x >= 64;
    if (dedicated && blockIdx.x >= 16) return;
    for (int it = VBID; it < 32; it += dedicated ? 32 : VGRID) {
        const int pm = it >> 2, pn = it & 3;
        if (pn >= 2) gemm_tile<true>(p.memn(), D, p.w_kv_t(), D, D, pm * 128, pn * 128, smh, e2t);
        else gemm_tile<false>(p.memn(), D, p.w_kv_t(), D, D, pm * 128, pn * 128, smh, e2);
    }
}

__device__ void phase_gemm_out(const Params& p, char* smem) {
    const int nM = NTOK / 256, nN = D / 256;
    EpiResNorm e{p.x1b(), p.x, p.ffn_g, p.h(), D, p.ss1(), p.hmax()};
    for (int i = 0; i * (int)gridDim.x + (int)blockIdx.x < nM * nN; ++i) {
        int pm, pn;
        g8::tile_of(i * gridDim.x + blockIdx.x, nM, nN, pm, pn);
        gemm256_tile<false, true>(p.mix(), p.w_out_t(), D, pm * 256, pn * 256, smem, e);
    }
}

__device__ void phase_gemm_q(const Params& p, char* smem) {
    const int nM = NTOK / 256, nN = QW / 256;
    EpiBf16RowScale e{p.z(), QW, p.ss1()};
    for (int i = 0; i * (int)gridDim.x + (int)blockIdx.x < nM * nN; ++i) {
        int pm, pn;
        g8::tile_of(i * gridDim.x + blockIdx.x, nM, nN, pm, pn);
        gemm256_tile<false, false>(p.h(), p.w_q_t(), D, pm * 256, pn * 256, smem, e);
    }
}

typedef float f32x16 __attribute__((ext_vector_type(16)));
constexpr int HRS = 144;
__device__ __forceinline__ f32x16 tile_mm64(const char* X, const char* Y, int xrow0, int yrow0, int lane, f32x16 acc) {
    const int r = lane & 31, hh = lane >> 5;
#pragma unroll
    for (int ks = 0; ks < 4; ++ks) {
        const bf16x8 a = *(const bf16x8*)(X + (xrow0 + r) * HRS + ks * 32 + hh * 16);
        const bf16x8 b = *(const bf16x8*)(Y + (yrow0 + r) * HRS + ks * 32 + hh * 16);
        acc = __builtin_amdgcn_mfma_f32_32x32x16_bf16(a, b, acc, 0, 0, 0);
    }
    return acc;
}
__device__ __forceinline__ int crow(int reg, int hh) { return (reg & 3) + 8 * (reg >> 2) + 4 * hh; }

__device__ __forceinline__ void hg_load_vt(const Params& p, char* sVT, int tok0, int h, int kcol, int sq) {
    const bf16_t* zp = p.z() + (size_t)(tok0 + sq * 16) * INW + 2304 + h * 64 + kcol;
    unsigned pk[8];
#pragma unroll
    for (int j = 0; j < 8; ++j) {
        const unsigned lo = zp[(size_t)(2 * j) * INW], hi = zp[(size_t)(2 * j + 1) * INW];
        pk[j] = lo | (hi << 16);
    }
    *(uint4*)(sVT + kcol * HRS + sq * 32) = make_uint4(pk[0], pk[1], pk[2], pk[3]);
    *(uint4*)(sVT + kcol * HRS + sq * 32 + 16) = make_uint4(pk[4], pk[5], pk[6], pk[7]);
}

__device__ __forceinline__ float hg_gates(const Params& p, float* sTot, int tok0, int h, int dir, int kcol, int sq, float (&bj)[16], float (&kk)[16]) {
    const bf16_t* zp = p.z() + (size_t)(tok0 + sq * 16) * INW + 1792 + dir * 256 + h * 64 + kcol;
    const float lbv = p.lb()[dir * 256 + h * 64 + kcol];
#pragma unroll
    for (int j = 0; j < 16; ++j) {
        const float pre = bf2f(zp[(size_t)j * INW]);
        const float f = lbv + (1.0f - lbv) * (1.0f / (1.0f + __expf(-pre)));
        bj[j] = __logf(f);
        kk[j] = 1.0f - f;
    }
    if (dir == 0) {
#pragma unroll
        for (int j = 1; j < 16; ++j) bj[j] += bj[j - 1];
        sTot[sq * 64 + kcol] = bj[15];
    } else {
#pragma unroll
        for (int j = 14; j >= 0; --j) bj[j] += bj[j + 1];
        sTot[sq * 64 + kcol] = bj[0];
    }
    __syncthreads();
    const float t0 = sTot[kcol], t1 = sTot[64 + kcol], t2 = sTot[128 + kcol], t3 = sTot[192 + kcol];
    float off;
    if (dir == 0) off = (sq > 0 ? t0 : 0.f) + (sq > 1 ? t1 : 0.f) + (sq > 2 ? t2 : 0.f);
    else off = (sq < 3 ? t3 : 0.f) + (sq < 2 ? t2 : 0.f) + (sq < 1 ? t1 : 0.f);
#pragma unroll
    for (int j = 0; j < 16; ++j) bj[j] += off;
    return t0 + t1 + t2 + t3;
}

__device__ void hg_local(const Params& p, char* smem) {
    char* sVT = smem;
    char* sKT = smem + 9216;
    float* sTot = (float*)(smem + 18432);
    const int tid = VTID, lane = tid & 63, w = tid >> 6;
    const int kcol = tid & 63, sq = tid >> 6;
    for (int item = VBID; item < 4096; item += VGRID) {
        const int c = item & 127, dir = (item >> 7) & 1, h = (item >> 8) & 3, b = item >> 10;
        const int tok0 = b * T + c * 64;
        __syncthreads();
        hg_load_vt(p, sVT, tok0, h, kcol, sq);
        float bj[16], kk[16];
        const float btot = hg_gates(p, sTot, tok0, h, dir, kcol, sq, bj, kk);
        unsigned pk[8];
#pragma unroll
        for (int j = 0; j < 8; ++j)
            pk[j] = pack2(kk[2 * j] * __expf(btot - bj[2 * j]), kk[2 * j + 1] * __expf(btot - bj[2 * j + 1]));
        *(uint4*)(sKT + kcol * HRS + sq * 32) = make_uint4(pk[0], pk[1], pk[2], pk[3]);
        *(uint4*)(sKT + kcol * HRS + sq * 32 + 16) = make_uint4(pk[4], pk[5], pk[6], pk[7]);
        if (sq == 0) p.hdec()[item * 64 + kcol] = __expf(btot);
        __syncthreads();
        const int vi = w >> 1, ki = w & 1, hh = lane >> 5;
        f32x16 acc;
#pragma unroll
        for (int r = 0; r < 16; ++r) acc[r] = 0.f;
        acc = tile_mm64(sVT, sKT, vi * 32, ki * 32, lane, acc);
        bf16_t* dst = (bf16_t*)p.hstate() + (size_t)item * 4096 + ki * 32 + (lane & 31);
#pragma unroll
        for (int r = 0; r < 16; ++r) dst[(vi * 32 + crow(r, hh)) * 64] = f2bf(acc[r]);
    }
}

__device__ __forceinline__ bf16x8 pack8(const f32x16& x, int s8) {
    typedef unsigned u32x4_t __attribute__((ext_vector_type(4)));
    u32x4_t pk;
    pk[0] = pack2(x[s8], x[s8 + 1]); pk[1] = pack2(x[s8 + 2], x[s8 + 3]);
    pk[2] = pack2(x[s8 + 4], x[s8 + 5]); pk[3] = pack2(x[s8 + 6], x[s8 + 7]);
    return __builtin_bit_cast(bf16x8, pk);
}
__device__ __forceinline__ bf16x8 join8(const uint2& lo, const uint2& hi) {
    typedef unsigned u32x4_t __attribute__((ext_vector_type(4)));
    u32x4_t pk; pk[0] = lo.x; pk[1] = lo.y; pk[2] = hi.x; pk[3] = hi.y;
    return __builtin_bit_cast(bf16x8, pk);
}

__device__ __forceinline__ int swap23(int r) { return (r & ~12) | ((r & 4) << 1) | ((r & 8) >> 1); }

__device__ __forceinline__ void mem_attn_wave(const Params& p, int wu, int lane) {
    const int tile = wu & 255, h = (wu >> 8) & 3, b = wu >> 10;
    const int l31 = lane & 31, hh = lane >> 5;
    const int tok = b * T + tile * 32 + l31;
    bf16x8 qf[4];
#pragma unroll
    for (int ks = 0; ks < 4; ++ks) qf[ks] = *(const bf16x8*)(p.z() + (size_t)tok * INW + 2816 + h * 64 + ks * 16 + hh * 8);
    const bf16_t* kb = p.kvb() + (size_t)(b * 256 + swap23(l31)) * 512 + h * 64 + hh * 8;
    float m = -1e30f;
    f32x16 o0, o1;
#pragma unroll
    for (int r = 0; r < 16; ++r) { o0[r] = 0.f; o1[r] = 0.f; }
    float sum = 0.f;
    const bf16_t* vt = p.kvT() + ((size_t)(b * 4 + h) * 64 + l31) * 256 + 8 * hh;
    bf16x8 kf[4], vf[4];
#pragma unroll
    for (int ks = 0; ks < 4; ++ks) kf[ks] = *(const bf16x8*)(kb + ks * 16);
#pragma unroll
    for (int st = 0; st < 2; ++st) { vf[2 * st] = *(const bf16x8*)(vt + st * 16); vf[2 * st + 1] = *(const bf16x8*)(vt + 32 * 256 + st * 16); }
    for (int kt = 0; kt < 8; ++kt) {
        const int ktn = min(kt + 1, 7);
        bf16x8 kn[4], vn[4];
#pragma unroll
        for (int ks = 0; ks < 4; ++ks) kn[ks] = *(const bf16x8*)(kb + (size_t)ktn * 32 * 512 + ks * 16);
#pragma unroll
        for (int st = 0; st < 2; ++st) { vn[2 * st] = *(const bf16x8*)(vt + ktn * 32 + st * 16); vn[2 * st + 1] = *(const bf16x8*)(vt + 32 * 256 + ktn * 32 + st * 16); }
        f32x16 s;
#pragma unroll
        for (int r = 0; r < 16; ++r) s[r] = 0.f;
#pragma unroll
        for (int ks = 0; ks < 4; ++ks) s = __builtin_amdgcn_mfma_f32_32x32x16_bf16(kf[ks], qf[ks], s, 0, 0, 0);
        float tm = s[0];
#pragma unroll
        for (int r = 1; r < 16; ++r) tm = fmaxf(tm, s[r]);
        tm = fmaxf(tm, __shfl_xor(tm, 32));
        const float mn = fmaxf(m, tm);
        if (__any(mn > m)) {
            const float sc = __builtin_amdgcn_exp2f((m - mn) * 0.18033688011112042f);
            sum *= sc;
#pragma unroll
            for (int r = 0; r < 16; ++r) { o0[r] *= sc; o1[r] *= sc; }
        }
        m = mn;
        const float mb = mn * 0.18033688011112042f;
#pragma unroll
        for (int r = 0; r < 16; ++r) { s[r] = __builtin_amdgcn_exp2f(fmaf(s[r], 0.18033688011112042f, -mb)); sum += s[r]; }
#pragma unroll
        for (int st = 0; st < 2; ++st) {
            const bf16x8 pb = pack8(s, st * 8);
            o0 = __builtin_amdgcn_mfma_f32_32x32x16_bf16(vf[2 * st], pb, o0, 0, 0, 0);
            o1 = __builtin_amdgcn_mfma_f32_32x32x16_bf16(vf[2 * st + 1], pb, o1, 0, 0, 0);
        }
#pragma unroll
        for (int ks = 0; ks < 4; ++ks) kf[ks] = kn[ks];
#pragma unroll
        for (int q = 0; q < 4; ++q) vf[q] = vn[q];
    }
    sum += __shfl_xor(sum, 32);
    const float inv = 1.0f / sum;
    bf16_t* mo = p.mix() + (size_t)tok * D + 768 + h * 64 + 4 * hh;
#pragma unroll
    for (int g = 0; g < 4; ++g) {
        uint2 pk;
        pk.x = pack2(o0[4 * g] * inv, o0[4 * g + 1] * inv); pk.y = pack2(o0[4 * g + 2] * inv, o0[4 * g + 3] * inv);
        *(uint2*)(mo + 8 * g) = pk;
        pk.x = pack2(o1[4 * g] * inv, o1[4 * g + 1] * inv); pk.y = pack2(o1[4 * g + 2] * inv, o1[4 * g + 3] * inv);
        *(uint2*)(mo + 32 + 8 * g) = pk;
    }
}

struct NaCtx {
    const bf16_t* kbase; const bf16_t* vbase; const float* bh;
    int rs, r, c, c0, cb, hh;
    bf16x8 qf[4];
    float m, sum;
    f32x16 o0, o1;
};
template <int TI>
__device__ __forceinline__ void na_load(const NaCtx& x, bf16x8 (&kf)[4], bf16x8 (&vf)[4]) {
    constexpr int ip = TI / 3, cg = TI % 3;
    const bf16_t* kp = x.kbase + (size_t)(ip * 128 + cg * 16) * INW;
#pragma unroll
    for (int ks = 0; ks < 4; ++ks) kf[ks] = *(const bf16x8*)(kp + ks * 16);
    const bf16_t* vr = x.vbase + ip * 128 + cg * 16;
#pragma unroll
    for (int st = 0; st < 2; ++st) { vf[2 * st] = *(const bf16x8*)(vr + st * 64); vf[2 * st + 1] = *(const bf16x8*)(vr + (size_t)32 * T + st * 64); }
}
template <int TI>
__device__ __forceinline__ void na_comp(NaCtx& x, const bf16x8 (&kf)[4], const bf16x8 (&vf)[4]) {
    constexpr int ip = TI / 3, cg = TI % 3;
    f32x16 s;
#pragma unroll
    for (int q = 0; q < 16; ++q) s[q] = 0.f;
#pragma unroll
    for (int ks = 0; ks < 4; ++ks) s = __builtin_amdgcn_mfma_f32_32x32x16_bf16(kf[ks], x.qf[ks], s, 0, 0, 0);
    const int kc0 = x.cb + 16 * cg + 8 * x.hh;
    const float* brow = x.bh + (x.rs + 2 * ip - x.r + 7) * 31 + 15 - x.c + kc0;
    const int d0 = kc0 - x.c0;
    float tm = -1e30f;
    float bv[16];
#pragma unroll
    for (int q = 0; q < 16; ++q) bv[q] = brow[(q & 3) + 4 * ((q >> 2) & 1) + 31 * (q >> 3)];
#pragma unroll
    for (int q = 0; q < 16; ++q) asm volatile("" : "+v"(bv[q]));
#pragma unroll
    for (int q = 0; q < 16; ++q) {
        const int cq = (q & 3) + 4 * ((q >> 2) & 1);
        const bool valid = (unsigned)(d0 + cq) < 16u;
        const float sc = valid ? fmaf(s[q], 0.18033688011112042f, bv[q]) : -INFINITY;
        s[q] = sc;
        tm = fmaxf(tm, sc);
    }
    tm = fmaxf(tm, __shfl_xor(tm, 32));
    const float mn = fmaxf(x.m, tm);
    if (__any(mn > x.m)) {
        const float scl = __builtin_amdgcn_exp2f(x.m - mn);
        x.sum *= scl;
#pragma unroll
        for (int q = 0; q < 16; ++q) { x.o0[q] *= scl; x.o1[q] *= scl; }
    }
    x.m = mn;
#pragma unroll
    for (int q = 0; q < 16; ++q) { const float pe = __builtin_amdgcn_exp2f(s[q] - mn); s[q] = pe; x.sum += pe; }
#pragma unroll
    for (int st = 0; st < 2; ++st) {
        const bf16x8 pb = pack8(s, st * 8);
        x.o0 = __builtin_amdgcn_mfma_f32_32x32x16_bf16(vf[2 * st], pb, x.o0, 0, 0, 0);
        x.o1 = __builtin_amdgcn_mfma_f32_32x32x16_bf16(vf[2 * st + 1], pb, x.o1, 0, 0, 0);
    }
}

__device__ __forceinline__ void na_attn_wave(const Params& p, int wu, int lane, const float* sbias) {
    const int j = wu & 1, h = (wu >> 1) & 7, r = (wu >> 4) & 127, b = wu >> 11;
    const int l31 = lane & 31, hh = lane >> 5;
    NaCtx x;
    x.hh = hh; x.r = r;
    x.c = 32 * j + l31;
    x.c0 = min(max(x.c - 8, 0), 48); x.rs = min(max(r - 4, 0), 120);
    const int tokq = b * T + r * 64 + x.c;
    x.cb = 16 * j;
#pragma unroll
    for (int ks = 0; ks < 4; ++ks) x.qf[ks] = *(const bf16x8*)(p.z() + (size_t)tokq * INW + h * 64 + ks * 16 + hh * 8);
    x.bh = sbias + 64 + h * 465;
    const int kap = swap23(l31);
    x.kbase = p.z() + (size_t)(b * T + (x.rs + (kap >> 4)) * 64 + x.cb + (kap & 15)) * INW + 512 + h * 64 + hh * 8;
    x.vbase = p.vT() + ((size_t)(b * 8 + h) * 64 + l31) * T + x.rs * 64 + x.cb + 8 * hh;
    x.m = -1e30f; x.sum = 0.f;
#pragma unroll
    for (int q = 0; q < 16; ++q) { x.o0[q] = 0.f; x.o1[q] = 0.f; }
    bf16x8 k0[4], v0[4], k1[4], v1[4], k2[4], v2[4], k3[4], v3[4];
    na_load<0>(x, k0, v0); na_load<1>(x, k1, v1); na_load<2>(x, k2, v2);
    na_load<3>(x, k3, v3);  na_comp<0>(x, k0, v0);
    na_load<4>(x, k0, v0);  na_comp<1>(x, k1, v1);
    na_load<5>(x, k1, v1);  na_comp<2>(x, k2, v2);
    na_load<6>(x, k2, v2);  na_comp<3>(x, k3, v3);
    na_load<7>(x, k3, v3);  na_comp<4>(x, k0, v0);
    na_load<8>(x, k0, v0);  na_comp<5>(x, k1, v1);
    na_load<9>(x, k1, v1);  na_comp<6>(x, k2, v2);
    na_load<10>(x, k2, v2); na_comp<7>(x, k3, v3);
    na_load<11>(x, k3, v3); na_comp<8>(x, k0, v0);
    na_comp<9>(x, k1, v1);
    na_comp<10>(x, k2, v2);
    na_comp<11>(x, k3, v3);
    float sum = x.sum;
    sum += __shfl_xor(sum, 32);
    const float inv = 1.0f / sum;
    bf16_t* mo = p.mix() + (size_t)tokq * D + h * 64 + 4 * hh;
#pragma unroll
    for (int g = 0; g < 4; ++g) {
        uint2 pk;
        pk.x = pack2(x.o0[4 * g] * inv, x.o0[4 * g + 1] * inv); pk.y = pack2(x.o0[4 * g + 2] * inv, x.o0[4 * g + 3] * inv);
        *(uint2*)(mo + 8 * g) = pk;
        pk.x = pack2(x.o1[4 * g] * inv, x.o1[4 * g + 1] * inv); pk.y = pack2(x.o1[4 * g + 2] * inv, x.o1[4 * g + 3] * inv);
        *(uint2*)(mo + 32 + 8 * g) = pk;
    }
}

__device__ void phase_mixers(const Params& p, char* smem) {
    const int tid = VTID, lane = tid & 63, w = tid >> 6;
    {
        float* sbias = (float*)smem;
        __syncthreads();
        for (int i = tid; i < 8 * 465; i += 256) sbias[64 + i] = p.rpb[i] * 1.4426950408889634f;
        __syncthreads();
        for (int wu = VBID * 4 + w; wu < 8192; wu += VGRID * 4) na_attn_wave(p, wu, lane, sbias);
    }
    __syncthreads();
    hg_local(p, smem);
}

__device__ void phase_hg_scan(const Params& p) {
    const int tid = VTID;
    const int skip = gridDim.x >= 64 ? 32 : 0;
    if (VBID < skip) return;
    for (int item = VBID - skip; item < 512; item += VGRID - skip) {
        const int g = item * 256 + tid;
        const int seq = g >> 12, kv = g & 4095, k = kv & 63;
        const int dir = seq & 1;
        float S = 0.f;
        for (int cc0 = 0; cc0 < 128; cc0 += 8) {
            float L[8], d[8];
#pragma unroll
            for (int u = 0; u < 8; ++u) {
                const int c = dir ? 127 - (cc0 + u) : cc0 + u;
                const size_t it = (size_t)seq * 128 + c;
                L[u] = bf2f(((const bf16_t*)p.hstate())[it * 4096 + kv]);
                d[u] = p.hdec()[it * 64 + k];
            }
#pragma unroll
            for (int u = 0; u < 8; ++u) {
                const int c = dir ? 127 - (cc0 + u) : cc0 + u;
                const size_t it = (size_t)seq * 128 + c;
                ((bf16_t*)p.h())[it * 4096 + kv] = f2bf(S);
                S = d[u] * S + L[u];
            }
        }
    }
}

__device__ void phase_hg_out(const Params& p, char* smem) {
    char* sQt = smem;
    char* sKt = smem + 9216;
    char* sQh = smem + 18432;
    char* sVT = smem + 27648;
    char* sST = smem + 36864;
    char* sP = smem + 46080;
    float* sTot = (float*)(smem + 55296);
    float* sSS = sTot + 256;
    const int tid = VTID, lane = tid & 63, w = tid >> 6;
    const int kcol = tid & 63, sq = tid >> 6;
    const int l31 = lane & 31, hh = lane >> 5;
    for (int item = VBID; item < 2048; item += VGRID) {
        const int c = item & 127, h = (item >> 7) & 3, b = item >> 9;
        const int tok0 = b * T + c * 64;
        __syncthreads();
        hg_load_vt(p, sVT, tok0, h, kcol, sq);
        float qv[16];
        {
            const bf16_t* zp = p.z() + (size_t)(tok0 + sq * 16) * INW + 1536 + h * 64 + kcol;
#pragma unroll
            for (int j = 0; j < 16; ++j) qv[j] = bf2f(zp[(size_t)j * INW]);
        }
        f32x16 accO;
#pragma unroll
        for (int r = 0; r < 16; ++r) accO[r] = 0.f;
        for (int dir = 0; dir < 2; ++dir) {
            float bj[16], kk[16];
            const float btot = hg_gates(p, sTot, tok0, h, dir, kcol, sq, bj, kk);
            const float bref = 0.5f * btot;
#pragma unroll
            for (int j = 0; j < 16; ++j) {
                const int s = sq * 16 + j;
                *(bf16_t*)(sQt + s * HRS + kcol * 2) = f2bf(qv[j] * __expf(bj[j] - bref));
                *(bf16_t*)(sKt + s * HRS + kcol * 2) = f2bf(kk[j] * __expf(bref - bj[j]));
                *(bf16_t*)(sQh + s * HRS + kcol * 2) = f2bf(qv[j] * __expf(bj[j]));
            }
            {
                const bf16_t* sp = (const bf16_t*)p.h() + ((size_t)(((b * 4 + h) * 2 + dir) * 128 + c)) * 4096;
#pragma unroll
                for (int i = 0; i < 4; ++i) {
                    const int idx = tid * 4 + 1024 * i;
                    *(uint2*)(sST + (idx >> 6) * HRS + (idx & 63) * 2) = *(const uint2*)(sp + idx);
                }
            }
            __syncthreads();
            {
                const int si = w >> 1, ti = w & 1;
                const bool live = dir == 0 ? (si <= ti) : (si >= ti);
                f32x16 pt;
#pragma unroll
                for (int r = 0; r < 16; ++r) pt[r] = 0.f;
                if (live) pt = tile_mm64(sKt, sQt, si * 32, ti * 32, lane, pt);
                const int t = ti * 32 + l31;
#pragma unroll
                for (int g = 0; g < 4; ++g) {
                    const int s0 = si * 32 + 8 * g + 4 * hh;
                    float v0 = pt[4 * g], v1 = pt[4 * g + 1], v2 = pt[4 * g + 2], v3 = pt[4 * g + 3];
                    if (dir == 0) {
                        if (s0 > t) v0 = 0.f; if (s0 + 1 > t) v1 = 0.f; if (s0 + 2 > t) v2 = 0.f; if (s0 + 3 > t) v3 = 0.f;
                    } else {
                        if (s0 < t) v0 = 0.f; if (s0 + 1 < t) v1 = 0.f; if (s0 + 2 < t) v2 = 0.f; if (s0 + 3 < t) v3 = 0.f;
                    }
                    uint2 pk; pk.x = pack2(v0, v1); pk.y = pack2(v2, v3);
                    *(uint2*)(sP + t * HRS + s0 * 2) = pk;
                }
            }
            __syncthreads();
            {
                const int vi = w >> 1, ti = w & 1;
                accO = tile_mm64(sVT, sP, vi * 32, ti * 32, lane, accO);
                accO = tile_mm64(sST, sQh, vi * 32, ti * 32, lane, accO);
            }
            __syncthreads();
        }
        const int vi = w >> 1, ti = w & 1;
        float ssq = 0.f;
#pragma unroll
        for (int r = 0; r < 16; ++r) ssq += accO[r] * accO[r];
        ssq += __shfl_xor(ssq, 32);
        sSS[w * 64 + lane] = ssq;
        __syncthreads();
        const float tot = sSS[ti * 64 + l31] + sSS[(2 + ti) * 64 + l31];
        const float rs = rsqrtf(tot * (1.0f / 64.0f) + EPS);
        const int tok = tok0 + ti * 32 + l31;
#pragma unroll
        for (int g = 0; g < 4; ++g) {
            const int v0 = vi * 32 + 8 * g + 4 * hh;
            const uint2 gz = *(const uint2*)(p.z() + (size_t)tok * INW + 2560 + h * 64 + v0);
            const float4 gn = *(const float4*)(p.hg_g + h * 64 + v0);
            const float g0 = bflo(gz.x), g1 = bfhi(gz.x), g2 = bflo(gz.y), g3 = bfhi(gz.y);
            const float o0 = accO[4 * g] * rs * gn.x * (g0 / (1.0f + __expf(-g0)));
            const float o1 = accO[4 * g + 1] * rs * gn.y * (g1 / (1.0f + __expf(-g1)));
            const float o2 = accO[4 * g + 2] * rs * gn.z * (g2 / (1.0f + __expf(-g2)));
            const float o3 = accO[4 * g + 3] * rs * gn.w * (g3 / (1.0f + __expf(-g3)));
            uint2 pk; pk.x = pack2(o0, o1); pk.y = pack2(o2, o3);
            *(uint2*)(p.mix() + (size_t)tok * D + 512 + h * 64 + v0) = pk;
        }
    }
    for (int wu = VBID * 4 + w; wu < 4096; wu += VGRID * 4) mem_attn_wave(p, wu, lane);
}


__device__ __forceinline__ int ord_key(int fb) { return fb ^ ((fb >> 31) & 0x7FFFFFFF); }

template <int N>
__device__ __forceinline__ void bitonic_sort_desc(int (&v)[N]) {
#pragma unroll
    for (int k = 2; k <= N; k <<= 1) {
#pragma unroll
        for (int j = k >> 1; j > 0; j >>= 1) {
#pragma unroll
            for (int i = 0; i < N; ++i) {
                const int l = i ^ j;
                if (l > i) {
                    const bool desc = ((i & k) == 0);
                    const int a = v[i], b = v[l];
                    const int mx = max(a, b), mn = min(a, b);
                    v[i] = desc ? mx : mn;
                    v[l] = desc ? mn : mx;
                }
            }
        }
    }
}
template <int N>
__device__ __forceinline__ void bitonic_merge_desc(int (&v)[N]) {
#pragma unroll
    for (int j = N >> 1; j > 0; j >>= 1) {
#pragma unroll
        for (int i = 0; i < N; ++i) {
            const int l = i ^ j;
            if (l > i) {
                const int a = v[i], b = v[l];
                v[i] = max(a, b);
                v[l] = min(a, b);
            }
        }
    }
}
__device__ __forceinline__ void merge_prune16(int (&r)[16], const int (&o)[16]) {
#pragma unroll
    for (int i = 0; i < 16; ++i) r[i] = max(r[i], o[15 - i]);
    bitonic_merge_desc<16>(r);
}

__device__ void phase_route(const Params& p, char* smem) {
    char* sk = smem;
    const int tid = VTID, lane = tid & 63, w = tid >> 6;
    int* sA = (int*)(smem + 32768) + w * 2048;
    int* sB = (int*)(smem + 65536) + w * 512;
    const int tl = lane & 31, hh = lane >> 5;
    const int h = VBID & 7, tg0 = VBID >> 3, tgs = VGRID >> 3;
    for (int base = tg0; base < 256; base += 4 * tgs)
    for (int c = 0; c < 2; ++c) {
        const int hc = h * 2 + c;
        __syncthreads();
        {
            const bf16_t* sp = p.subk_b() + (size_t)hc * 16384;
#pragma unroll
            for (int i = 0; i < 8; ++i) {
                const int ch = tid + 256 * i;
                const int row = ch >> 4, cc = ch & 15;
                const uint4 v = *(const uint4*)(sp + row * 128 + cc * 8);
                *(uint4*)(sk + row * 256 + ((cc ^ (row & 15)) << 4)) = v;
            }
        }
        __syncthreads();
        bf16x8 qf[8];
        if (base < 256) {
            const bf16_t* qr = p.z() + (size_t)(base * 128 + w * 32 + tl) * QW + hc * 128 + hh * 8;
#pragma unroll
            for (int ks = 0; ks < 8; ++ks) qf[ks] = *(const bf16x8*)(qr + ks * 16);
        }
        for (int it = 0; it < 4; ++it) {
            const int tgp = base + it * tgs;
            if (tgp >= 256) break;
            const int tok = tgp * 128 + w * 32 + tl;
            int* sidx = sA + it * 512;
            f32x16 acc4[4];
#pragma unroll
            for (int kb = 0; kb < 4; ++kb) {
#pragma unroll
                for (int r = 0; r < 16; ++r) acc4[kb][r] = 0.f;
                const int row = kb * 32 + tl;
#pragma unroll
                for (int ks = 0; ks < 8; ++ks) {
                    const bf16x8 af = *(const bf16x8*)(sk + row * 256 + (((ks * 2 + hh) ^ (row & 15)) << 4));
                    acc4[kb] = __builtin_amdgcn_mfma_f32_32x32x16_bf16(af, qf[ks], acc4[kb], 0, 0, 0);
                }
            }
            if (it + 1 < 4 && tgp + tgs < 256) {
                const bf16_t* qr = p.z() + (size_t)((tgp + tgs) * 128 + w * 32 + tl) * QW + hc * 128 + hh * 8;
#pragma unroll
                for (int ks = 0; ks < 8; ++ks) qf[ks] = *(const bf16x8*)(qr + ks * 16);
            }
            int cur[16];
#pragma unroll
            for (int kb = 0; kb < 4; ++kb) {
                int v[16];
#pragma unroll
                for (int r = 0; r < 16; ++r) {
                    const int key = kb * 32 + (r & 3) + 8 * (r >> 2) + 4 * hh;
                    const int fb = (__float_as_int(acc4[kb][r]) & ~127) | (127 - key);
                    v[r] = ord_key(fb);
                }
                bitonic_sort_desc<16>(v);
                if (kb == 0) {
#pragma unroll
                    for (int r = 0; r < 16; ++r) cur[r] = v[r];
                } else {
                    merge_prune16(cur, v);
                }
            }
            {
                int o[16];
#pragma unroll
                for (int r = 0; r < 16; ++r) o[r] = __shfl_xor(cur[r], 32);
                merge_prune16(cur, o);
            }
            if (c == 0) {
#pragma unroll
                for (int r = 0; r < 16; ++r) sidx[r * 32 + tl] = cur[r];
                continue;
            }
#pragma unroll
            for (int r = 0; r < 16; ++r) sB[r * 32 + tl] = cur[r];
        float va[16], vb[16];
#pragma unroll
        for (int r = 0; r < 16; ++r) {
            const int fa = ord_key(sidx[r * 32 + tl]), fb = ord_key(sB[r * 32 + tl]);
            va[r] = __int_as_float(fa & ~127);
            vb[r] = __int_as_float(fb & ~127);
        }
        int best[16];
#pragma unroll
        for (int j = 0; j < 16; ++j) best[j] = ord_key((__float_as_int(va[0] + vb[j]) & ~255) | (255 - j));
#pragma unroll
        for (int i = 1; i < 8; ++i) {
            const int n = 16 / (i + 1);
            int row[16];
#pragma unroll
            for (int j = 0; j < 16; ++j)
                row[j] = (j < n) ? ord_key((__float_as_int(va[i] + vb[j]) & ~255) | (255 - (i * 16 + j))) : (int)0x80000000;
            merge_prune16(best, row);
        }
        {
            int row[16];
#pragma unroll
            for (int j = 0; j < 16; ++j)
                row[j] = (j < 8) ? ord_key((__float_as_int(va[8 + j] + vb[0]) & ~255) | (255 - ((8 + j) * 16))) : (int)0x80000000;
            merge_prune16(best, row);
        }
        float sv[16];
        int pid[16];
#pragma unroll
        for (int r = 0; r < 16; ++r) {
            const int cb = ord_key(best[r]);
            sv[r] = __int_as_float(cb & ~255);
            pid[r] = 255 - (cb & 255);
        }
        float tot = 0.f;
        const float smax = sv[0];
#pragma unroll
        for (int r = 0; r < 16; ++r) { sv[r] = __expf(sv[r] - smax); tot += sv[r]; }
        const float inv = 1.0f / tot;
        if (hh == 0) {
#pragma unroll
            for (int r = 0; r < 16; ++r) {
                const int ia = 127 - (ord_key(sidx[(pid[r] >> 4) * 32 + tl]) & 127);
                const int ib = 127 - (ord_key(sB[(pid[r] & 15) * 32 + tl]) & 127);
                const int pos = (r & 7) * 16 + h * 2 + (r >> 3);
                p.eidx()[(size_t)tok * 128 + pos] = (unsigned short)(ia * 128 + ib);
                p.gate()[(size_t)tok * 128 + pos] = sv[r] * inv;
            }
        }
        }
    }
}

constexpr int PEER_TG = 512;
constexpr int PEER_TPW = PEER_TG / 8;
constexpr int PEER_NTG = NTOK / PEER_TG;
constexpr int PEER_NCH = 8;

#define PEER_G1(base, wv, hi) (*(const uint4*)((base) + (unsigned)((((hi) ? ((wv) >> 16) : ((wv) & 0xFFFFu)) << 7) + dlo)))
#define PEER_GATHER16(dst, base, ia, ib)                                                             \
    dst[0] = PEER_G1(base, (ia).x, 0);  dst[1] = PEER_G1(base, (ia).x, 1);  dst[2] = PEER_G1(base, (ia).y, 0);  dst[3] = PEER_G1(base, (ia).y, 1);   \
    dst[4] = PEER_G1(base, (ia).z, 0);  dst[5] = PEER_G1(base, (ia).z, 1);  dst[6] = PEER_G1(base, (ia).w, 0);  dst[7] = PEER_G1(base, (ia).w, 1);   \
    dst[8] = PEER_G1(base, (ib).x, 0);  dst[9] = PEER_G1(base, (ib).x, 1);  dst[10] = PEER_G1(base, (ib).y, 0); dst[11] = PEER_G1(base, (ib).y, 1);  \
    dst[12] = PEER_G1(base, (ib).z, 0); dst[13] = PEER_G1(base, (ib).z, 1); dst[14] = PEER_G1(base, (ib).w, 0); dst[15] = PEER_G1(base, (ib).w, 1);

__device__ __forceinline__ unsigned quant4(float a, float b, float c, float d, float qs) {
    const int q0 = (int)rintf(__builtin_amdgcn_fmed3f(a * qs, -127.f, 127.f)), q1 = (int)rintf(__builtin_amdgcn_fmed3f(b * qs, -127.f, 127.f));
    const int q2 = (int)rintf(__builtin_amdgcn_fmed3f(c * qs, -127.f, 127.f)), q3 = (int)rintf(__builtin_amdgcn_fmed3f(d * qs, -127.f, 127.f));
    return (unsigned)(q0 & 255) | ((unsigned)(q1 & 255) << 8) | ((unsigned)(q2 & 255) << 16) | ((unsigned)(q3 & 255) << 24);
}
template <int CTRL>
__device__ __forceinline__ int dpp_movi(int v) { return __builtin_amdgcn_update_dpp(0, v, CTRL, 0xf, 0xf, true); }

struct DotTok { uint4 ia, ib; uint4 ha, hb; float hm; };
__device__ __forceinline__ void dots_load(const Params& p, DotTok& t, int tok, int c, int g, int d8) {
    const uint4* idp = (const uint4*)(p.eidx() + (size_t)tok * 128 + g * 16);
    t.ia = idp[0]; t.ib = idp[1];
    const uint4* hp = (const uint4*)(p.h() + (size_t)tok * D + c * 128 + d8 * 16);
    t.ha = hp[0]; t.hb = hp[1];
    t.hm = __uint_as_float(p.hmax()[tok]);
}
__device__ __forceinline__ void dotsf_load(const Params& p, DotTok& t, int tokb, int s, int g, int d8) {
    dots_load(p, t, tokb + 8 * (s & 15), s >> 4, g, d8);
}
__device__ __forceinline__ void dotsf_finish(const uint4 (&uu)[16], const DotTok& t, int* part, int g, int d8) {
    const float qs = t.hm > 0.f ? 127.0f / t.hm : 0.f;
    const int h0 = (int)quant4(bflo(t.ha.x), bfhi(t.ha.x), bflo(t.ha.y), bfhi(t.ha.y), qs);
    const int h1 = (int)quant4(bflo(t.ha.z), bfhi(t.ha.z), bflo(t.ha.w), bfhi(t.ha.w), qs);
    const int h2 = (int)quant4(bflo(t.hb.x), bfhi(t.hb.x), bflo(t.hb.y), bfhi(t.hb.y), qs);
    const int h3 = (int)quant4(bflo(t.hb.z), bfhi(t.hb.z), bflo(t.hb.w), bfhi(t.hb.w), qs);
    int acc[16];
#pragma unroll
    for (int i = 0; i < 16; ++i) {
        int a = __builtin_amdgcn_sdot4((int)uu[i].x, h0, 0, false);
        a = __builtin_amdgcn_sdot4((int)uu[i].y, h1, a, false);
        a = __builtin_amdgcn_sdot4((int)uu[i].z, h2, a, false);
        a = __builtin_amdgcn_sdot4((int)uu[i].w, h3, a, false);
        a += dpp_movi<DPP_QP_X1>(a);
        a += dpp_movi<DPP_QP_X2>(a);
        a += dpp_movi<DPP_HMIRROR>(a);
        acc[i] = a;
    }
    if (d8 == 0) {
#pragma unroll
        for (int i = 0; i < 16; ++i) (void)__hip_atomic_fetch_add(part + g * 16 + i, acc[i], __ATOMIC_RELAXED, __HIP_MEMORY_SCOPE_WORKGROUP);
    }
}

__device__ __forceinline__ float gelu_erf(float v);

__device__ void phase_peer_dots(const Params& p, char* smem) {
    const int tid = threadIdx.x, lane = tid & 63, w = tid >> 6;
    const int g = lane >> 3, d8 = lane & 7;
    int* part = (int*)smem + w * 2048;
    for (int tgp = blockIdx.x; tgp < NTOK / 128; tgp += gridDim.x) {
        const int tokb = tgp * 128 + w;
        __syncthreads();
        for (int i = lane; i < 2048; i += 64) part[i] = 0;
        __syncthreads();
        const char* ubase = (const char*)p.u_c();
        const unsigned dlo = d8 * 16;
        DotTok ta, tb, tn;
        uint4 ua[16], ubuf[16];
        dotsf_load(p, ta, tokb, 0, g, d8);
        dotsf_load(p, tb, tokb, 1, g, d8);
        PEER_GATHER16(ua, ubase, ta.ia, ta.ib)
        PEER_GATHER16(ubuf, ubase, tb.ia, tb.ib)
        dotsf_load(p, tn, tokb, 2, g, d8);
        for (int s = 0; s < 128; s += 2) {
            dotsf_finish(ua, ta, part + (s & 15) * 128, g, d8);
            if (s + 2 < 128) {
                ta = tn;
                const char* ub = ubase + (size_t)((s + 2) >> 4) * 16384 * 128;
                PEER_GATHER16(ua, ub, ta.ia, ta.ib)
                dotsf_load(p, tn, tokb, min(s + 3, 127), g, d8);
            }
            dotsf_finish(ubuf, tb, part + ((s + 1) & 15) * 128, g, d8);
            if (s + 3 < 128) {
                tb = tn;
                const char* ub = ubase + (size_t)((s + 3) >> 4) * 16384 * 128;
                PEER_GATHER16(ubuf, ub, tb.ia, tb.ib)
                dotsf_load(p, tn, tokb, min(s + 4, 127), g, d8);
            }
        }
        __syncthreads();
        for (int k0 = 0; k0 < 16; k0 += 4) {
            int ps[4][2], e[4][2];
            float gt[4][2], sh[4];
#pragma unroll
            for (int q = 0; q < 4; ++q) {
                const int tok = tokb + 8 * (k0 + q);
                sh[q] = __uint_as_float(p.hmax()[tok]) * (1.0f / 127.0f) * rsqrtf(p.ss1()[tok] * (1.0f / 1024.0f) + EPS);
#pragma unroll
                for (int u = 0; u < 2; ++u) {
                    const int slot = lane + 64 * u;
                    ps[q][u] = part[(k0 + q) * 128 + slot];
                    e[q][u] = p.eidx()[(size_t)tok * 128 + slot];
                    gt[q][u] = p.gate()[(size_t)tok * 128 + slot];
                }
            }
            float su[4][2], sv[4][2];
#pragma unroll
            for (int q = 0; q < 4; ++q)
#pragma unroll
                for (int u = 0; u < 2; ++u) { su[q][u] = p.scale_u()[e[q][u]]; sv[q][u] = p.scale_v()[e[q][u]]; }
#pragma unroll
            for (int q = 0; q < 4; ++q) {
                const int tok = tokb + 8 * (k0 + q);
                float cf[2];
#pragma unroll
                for (int u = 0; u < 2; ++u) cf[u] = gelu_erf((float)ps[q][u] * su[q][u] * sh[q]) * gt[q][u] * sv[q][u];
                const float cm = wave_max(fmaxf(fabsf(cf[0]), fabsf(cf[1])));
                const float qs = cm > 0.f ? 127.0f / cm : 0.f;
                p.coef()[(size_t)tok * 128 + lane] = (signed char)(int)rintf(cf[0] * qs);
                p.coef()[(size_t)tok * 128 + lane + 64] = (signed char)(int)rintf(cf[1] * qs);
                if (lane == 0) p.csum()[tok] = cm * (1.0f / 127.0f);
            }
        }
    }
}

__device__ __forceinline__ float gelu_erf(float v) {
    const float av = fabsf(v);
    const float t = __builtin_amdgcn_rcpf(fmaf(av, 0.2316418882f, 1.0f));
    float q = fmaf(t, 0.5307027145f, -0.7265760135f);
    q = fmaf(q, t, 0.7107068705f);
    q = fmaf(q, t, -0.142248368f);
    q = fmaf(q, t, 0.127414796f);
    q = q * t;
    const float e = __builtin_amdgcn_exp2f(v * v * -0.72134752044f);
    const float m = v * (q * e);
    return v < 0.f ? m : v - m;
}
struct AccTok { uint4 ia, ib; uint4 cq; float cs; };
__device__ __forceinline__ void acc_load(const Params& p, AccTok& t, int tok, int g) {
    const uint4* idp = (const uint4*)(p.eidx() + (size_t)tok * 128 + g * 16);
    t.ia = idp[0]; t.ib = idp[1];
    t.cq = *(const uint4*)(p.coef() + (size_t)tok * 128 + g * 16);
    t.cs = p.csum()[tok];
}
#define PEER_T4DOT(acc, B, r0, r1, r2, r3, cq)                                   \
    {                                                                            \
        const unsigned t0 = __builtin_amdgcn_perm(r1, r0, 0x05010400u), t1 = __builtin_amdgcn_perm(r1, r0, 0x07030602u); \
        const unsigned t2 = __builtin_amdgcn_perm(r3, r2, 0x05010400u), t3 = __builtin_amdgcn_perm(r3, r2, 0x07030602u); \
        acc[(B) + 0] = __builtin_amdgcn_sdot4((int)__builtin_amdgcn_perm(t2, t0, 0x05040100u), (int)(cq), acc[(B) + 0], false); \
        acc[(B) + 1] = __builtin_amdgcn_sdot4((int)__builtin_amdgcn_perm(t2, t0, 0x07060302u), (int)(cq), acc[(B) + 1], false); \
        acc[(B) + 2] = __builtin_amdgcn_sdot4((int)__builtin_amdgcn_perm(t3, t1, 0x05040100u), (int)(cq), acc[(B) + 2], false); \
        acc[(B) + 3] = __builtin_amdgcn_sdot4((int)__builtin_amdgcn_perm(t3, t1, 0x07060302u), (int)(cq), acc[(B) + 3], false); \
    }
__device__ __forceinline__ void accf_finish(const uint4 (&vv)[16], const AccTok& t, char* rowp, int g) {
    const unsigned cw[4] = {t.cq.x, t.cq.y, t.cq.z, t.cq.w};
    int acc[16];
#pragma unroll
    for (int j = 0; j < 16; ++j) acc[j] = 0;
#pragma unroll
    for (int j = 0; j < 4; ++j) {
        PEER_T4DOT(acc, 0, vv[4 * j].x, vv[4 * j + 1].x, vv[4 * j + 2].x, vv[4 * j + 3].x, cw[j])
        PEER_T4DOT(acc, 4, vv[4 * j].y, vv[4 * j + 1].y, vv[4 * j + 2].y, vv[4 * j + 3].y, cw[j])
        PEER_T4DOT(acc, 8, vv[4 * j].z, vv[4 * j + 1].z, vv[4 * j + 2].z, vv[4 * j + 3].z, cw[j])
        PEER_T4DOT(acc, 12, vv[4 * j].w, vv[4 * j + 1].w, vv[4 * j + 2].w, vv[4 * j + 3].w, cw[j])
    }
    int t8[8], u4[4];
#pragma unroll
    for (int j = 0; j < 8; ++j) {
        const auto r = __builtin_amdgcn_permlane32_swap((unsigned)acc[j], (unsigned)acc[j + 8], false, false);
        t8[j] = (int)(r[0] + r[1]);
    }
#pragma unroll
    for (int j = 0; j < 4; ++j) {
        const auto r = __builtin_amdgcn_permlane16_swap((unsigned)t8[j], (unsigned)t8[j + 4], false, false);
        u4[j] = (int)(r[0] + r[1]);
    }
    float o[4];
#pragma unroll
    for (int j = 0; j < 4; ++j) {
        int v = u4[j];
        v += dpp_movi<DPP_ROR8>(v);
        o[j] = (float)v * t.cs;
    }
    if ((g & 1) == 0) {
        const int rho = g >> 1;
        uint2 w0; w0.x = pack2(o[0], o[1]); w0.y = pack2(o[2], o[3]);
        *(uint2*)(rowp + (4 * (rho & 1) + 8 * (rho >> 1)) * 2) = w0;
    }
}

__device__ void phase_peer_accum(const Params& p, char* smem) {
    const int tid = threadIdx.x, lane = tid & 63, w = tid >> 6;
    const int g = lane >> 3, d8 = lane & 7;
    char* rowbuf = smem + w * 16384;
    for (int tgp = blockIdx.x; tgp < NTOK / 64; tgp += gridDim.x) {
        const int tokb = tgp * 64 + w;
        __syncthreads();
        const char* vbase = (const char*)p.v_c();
        const unsigned dlo = d8 * 16;
        AccTok ta, tb, tn;
        uint4 va[16], vbuf[16];
        acc_load(p, ta, tokb, g);
        acc_load(p, tb, tokb + 8, g);
        PEER_GATHER16(va, vbase, ta.ia, ta.ib)
        PEER_GATHER16(vbuf, vbase, tb.ia, tb.ib)
        acc_load(p, tn, tokb + 16, g);
        for (int s = 0; s < 64; s += 2) {
            accf_finish(va, ta, rowbuf + (s & 7) * 2048 + (s >> 3) * 256 + d8 * 32, g);
            if (s + 2 < 64) {
                ta = tn;
                const char* vb = vbase + (size_t)((s + 2) >> 3) * 16384 * 128;
                PEER_GATHER16(va, vb, ta.ia, ta.ib)
                acc_load(p, tn, tokb + 8 * (min(s + 3, 63) & 7), g);
            }
            accf_finish(vbuf, tb, rowbuf + ((s + 1) & 7) * 2048 + ((s + 1) >> 3) * 256 + d8 * 32, g);
            if (s + 3 < 64) {
                tb = tn;
                const char* vb = vbase + (size_t)((s + 3) >> 3) * 16384 * 128;
                PEER_GATHER16(vbuf, vb, tb.ia, tb.ib)
                acc_load(p, tn, tokb + 8 * (min(s + 4, 63) & 7), g);
            }
        }
        __syncthreads();
        for (int k0 = 0; k0 < 8; k0 += 2) {
            float4 v[2][4];
#pragma unroll
            for (int q = 0; q < 2; ++q) {
                const bf16_t* xrow = p.x1b() + (size_t)(tokb + 8 * (k0 + q)) * D;
#pragma unroll
                for (int j = 0; j < 4; ++j) {
                    const uint2 xk = *(const uint2*)(xrow + (j * 64 + lane) * 4);
                    v[q][j] = make_float4(bflo(xk.x), bfhi(xk.x), bflo(xk.y), bfhi(xk.y));
                }
            }
#pragma unroll
            for (int q = 0; q < 2; ++q) {
                float* orow = p.out + (size_t)(tokb + 8 * (k0 + q)) * D;
                const char* prow = rowbuf + (k0 + q) * 2048;
                float ss = 0.f;
#pragma unroll
                for (int j = 0; j < 4; ++j) {
                    const uint2 pk = *(const uint2*)(prow + (j * 64 + lane) * 8);
                    v[q][j].x += bflo(pk.x); v[q][j].y += bfhi(pk.x); v[q][j].z += bflo(pk.y); v[q][j].w += bfhi(pk.y);
                    ss += v[q][j].x * v[q][j].x + v[q][j].y * v[q][j].y + v[q][j].z * v[q][j].z + v[q][j].w * v[q][j].w;
                }
                ss = wave_sum(ss);
                const float rs = rsqrtf(ss * (1.0f / 1024.0f) + EPS);
#pragma unroll
                for (int j = 0; j < 4; ++j) {
                    const float4 gg = *(const float4*)(p.fin_g + (j * 64 + lane) * 4);
                    float4 o;
                    o.x = v[q][j].x * rs * gg.x; o.y = v[q][j].y * rs * gg.y; o.z = v[q][j].z * rs * gg.z; o.w = v[q][j].w * rs * gg.w;
                    *(float4*)(orow + (j * 64 + lane) * 4) = o;
                }
            }
        }
    }
}

#define XB_TMO      128
#define XB_XCNT(j)  (256  + 64 * (j))
#define XB_XSUB(j)  (1280 + 64 * (j))
#define XB_XGEN(j)  (2304 + 64 * (j))
#define XB_TOP      3328
#define XB_TOPGEN   3392
#define XCD_BAR_WORDS 3456
#define XB_SPIN_CAP (1u << 18)
__device__ __forceinline__ unsigned xb_ld(unsigned* p)              { return __hip_atomic_load(p, __ATOMIC_RELAXED, __HIP_MEMORY_SCOPE_AGENT); }
__device__ __forceinline__ unsigned xb_add(unsigned* p, unsigned v) { return __hip_atomic_fetch_add(p, v, __ATOMIC_RELAXED, __HIP_MEMORY_SCOPE_AGENT); }
#define XB_SPIN(cond, bar) do { unsigned _sp = 0; while (cond) { __builtin_amdgcn_s_sleep(1); \
    if ((++_sp & 255u) == 0u) { if (xb_ld(&(bar)[XB_TMO])) break; if (_sp > XB_SPIN_CAP) { atomicAdd(&(bar)[XB_TMO], 1u); break; } } } } while (0)

struct XcdBarrier { unsigned* bar; unsigned x; volatile unsigned* st; };

__device__ __forceinline__ XcdBarrier xcd_barrier_post(unsigned* bar, volatile unsigned* st) {
    XcdBarrier b; b.bar = bar; b.x = xcc_id(); b.st = st;
    if (threadIdx.x == 0) (void)xb_add(&bar[XB_XCNT(b.x)], 1u);
    return b;
}
__device__ __forceinline__ void xcd_barrier_complete(unsigned* bar, unsigned x, unsigned& nloc, unsigned& nx) {
    const unsigned G = gridDim.x * gridDim.y * gridDim.z;
    unsigned sum, cnt, mine, sp = 0u;
    for (;;) {
        sum = 0u; cnt = 0u; mine = 0u;
#pragma unroll
        for (unsigned j = 0; j < 16; ++j) { const unsigned c = xb_ld(&bar[XB_XCNT(j)]); sum += c; cnt += (c > 0u) ? 1u : 0u; mine = (j == x) ? c : mine; }
        if (sum == G) break;
        __builtin_amdgcn_s_sleep(1);
        if ((++sp & 255u) == 0u) { if (xb_ld(&bar[XB_TMO])) break; if (sp > XB_SPIN_CAP) { atomicAdd(&bar[XB_TMO], 1u); break; } }
    }
    nloc = mine > 0u ? mine : 1u; nx = cnt > 0u ? cnt : 1u;
}
__device__ __forceinline__ void xcd_barrier(const XcdBarrier& b) {
    asm volatile("s_waitcnt vmcnt(0)" ::: "memory");
    __syncthreads();
    if (threadIdx.x == 0) {
        unsigned* bar = b.bar;
        __builtin_amdgcn_s_waitcnt(0);
        unsigned nloc = b.st[0], nx = b.st[1];
        if (nloc == 0u) { xcd_barrier_complete(bar, b.x, nloc, nx); b.st[0] = nloc; b.st[1] = nx; }
        const unsigned old = xb_add(&bar[XB_XSUB(b.x)], 1u);
        const unsigned gen = old / nloc;
        if (old + 1u == (gen + 1u) * nloc) {
            __builtin_amdgcn_fence(__ATOMIC_RELEASE, "agent");
            asm volatile("s_waitcnt vmcnt(0)" ::: "memory");
            const unsigned og = xb_add(&bar[XB_TOP], 1u);
            const unsigned tg = og / nx;
            if (og + 1u == (tg + 1u) * nx) xb_add(&bar[XB_TOPGEN], 1u);
            else XB_SPIN(xb_ld(&bar[XB_TOPGEN]) == tg, bar);
            __builtin_amdgcn_fence(__ATOMIC_ACQUIRE, "agent");
            xb_add(&bar[XB_XGEN(b.x)], 1u);
            asm volatile("s_waitcnt vmcnt(0)" ::: "memory");
        } else {
            XB_SPIN(xb_ld(&bar[XB_XGEN(b.x)]) == gen, bar);
            __builtin_amdgcn_fence(__ATOMIC_ACQUIRE, "agent");
            asm volatile("s_waitcnt vmcnt(0)" ::: "memory");
        }
    }
    __syncthreads();
}

#define RUN_PHASE(K, CALL)                                              \
    if (ph_lo <= (K) && (K) < ph_hi) {                                  \
        CALL;                                                           \
        if (COOP) { if ((K) + 1 < ph_hi) { xcd_barrier(xb); } } \
    }

template <bool COOP>
__global__ void __launch_bounds__(512, 2) fwd_kernel(Params p, int ph_lo, int ph_hi) {
    __shared__ __attribute__((aligned(16))) char smem[SMEM_BYTES + 16];
    char* smh = smem + VHB * HALF_SMEM;
    XcdBarrier xb;
    if (COOP) {
        if (threadIdx.x == 0) *(uint4*)(smem + SMEM_BYTES) = make_uint4(0u, 0u, 0u, 0u);
        __syncthreads();
        xb = xcd_barrier_post(p.bar(), (volatile unsigned*)(smem + SMEM_BYTES));
    }
    if (COOP) { if (ph_lo < 0) cg::this_grid().sync(); }
    RUN_PHASE(0, phase_prep(p, smh))
    RUN_PHASE(1, phase_gemm_in(p, smem))
    RUN_PHASE(2, phase_mixers(p, smh))
    RUN_PHASE(3, (phase_gemm_kv(p, smh), phase_hg_scan(p)))
    RUN_PHASE(4, phase_hg_out(p, smh))
    RUN_PHASE(5, phase_gemm_out(p, smem))
    RUN_PHASE(7, phase_gemm_q(p, smem))
    RUN_PHASE(8, phase_route(p, smh))
    RUN_PHASE(10, phase_peer_dots(p, smem))
    RUN_PHASE(12, phase_peer_accum(p, smem))
}

extern "C" void kernel_launch(void* const* d_in, const int* in_sizes, int n_in, void* d_out, int out_size, void* d_ws, size_t ws_size,
                              hipStream_t stream) {
    Params p{};
    p.x = (const float*)d_in[0]; p.mem = (const float*)d_in[1]; p.attn_g = (const float*)d_in[2]; p.w_in = (const float*)d_in[3];
    p.rpb = (const float*)d_in[4]; p.hg_lb = (const float*)d_in[5]; p.hg_g = (const float*)d_in[6]; p.mem_g = (const float*)d_in[7];
    p.w_kv = (const float*)d_in[8]; p.w_out = (const float*)d_in[9]; p.ffn_g = (const float*)d_in[10]; p.w_q = (const float*)d_in[11];
    p.subk = (const float*)d_in[12]; p.pu = (const float*)d_in[13]; p.pv = (const float*)d_in[14]; p.fin_g = (const float*)d_in[15];
    p.out = (float*)d_out;
    p.ws = (char*)d_ws;
    if (WS_TOTAL > ws_size) { fprintf(stderr, "workspace too small: need %zu have %zu\n", (size_t)WS_TOTAL, ws_size); return; }

#if defined(MULTI_LAUNCH)
    for (int ph = 0; ph < NPHASE; ++ph) fwd_kernel<false><<<dim3(512), dim3(512), 0, stream>>>(p, ph, ph + 1);
#else
    static int grid_blocks = 0;
    if (!grid_blocks) {
        int dev = 0, cus = 0, per_cu = 0;
        hipGetDevice(&dev);
        hipDeviceGetAttribute(&cus, hipDeviceAttributeMultiprocessorCount, dev);
        hipOccupancyMaxActiveBlocksPerMultiprocessor(&per_cu, fwd_kernel<true>, 512, 0);
        if (per_cu > 1) per_cu = 1;
        grid_blocks = (cus * per_cu) & ~3;
    }
    (void)hipMemsetAsync((char*)d_ws + OFF_BAR, 0, XCD_BAR_WORDS * 4, stream);
    int lo = 0, hi = NPHASE;
    void* args[] = {&p, &lo, &hi};
    hipError_t e = hipLaunchCooperativeKernel((void*)fwd_kernel<true>, dim3(grid_blocks), dim3(512), args, 0, stream);
    if (e != hipSuccess) fprintf(stderr, "cooperative launch failed: %s (grid %d)\n", hipGetErrorString(e), grid_blocks);
#endif
}
```

```cpp
#include <hip/hip_runtime.h>
#include <hip/hip_cooperative_groups.h>
#include <stdint.h>
#include <cstdio>

namespace cg = cooperative_groups;

#define VTID ((int)(threadIdx.x & 255))
#define VHB ((int)(threadIdx.x >> 8))
#define VBID ((int)(blockIdx.x * 2 + (threadIdx.x >> 8)))
#define VGRID ((int)(gridDim.x * 2))
constexpr int HALF_SMEM = 73728;

typedef unsigned short bf16_t;
typedef short bf16x8 __attribute__((ext_vector_type(8)));
typedef float f32x4 __attribute__((ext_vector_type(4)));

constexpr int D = 1024;
constexpr int NB = 4;
constexpr int T = 8192;
constexpr int NTOK = NB * T;
constexpr int INW = 3072;
constexpr int QW = 2048;
constexpr float EPS = 1e-6f;
constexpr int SMEM_BYTES = 2 * 73728;
constexpr int NPHASE = 14;

constexpr size_t al256(size_t x) { return (x + 255) & ~(size_t)255; }
constexpr size_t OFF_W_IN_T = 0;
constexpr size_t OFF_W_OUT_T = OFF_W_IN_T + al256((size_t)3072 * 1024 * 2);
constexpr size_t OFF_W_Q_T = OFF_W_OUT_T + al256((size_t)1024 * 1024 * 2);
constexpr size_t OFF_W_KV_T = OFF_W_Q_T + al256((size_t)2048 * 1024 * 2);
constexpr size_t OFF_H = OFF_W_KV_T + al256((size_t)512 * 1024 * 2);
constexpr size_t OFF_Z = OFF_H + al256((size_t)32768 * 1024 * 2);
constexpr size_t OFF_MIX = OFF_Z + al256((size_t)32768 * 3072 * 2);
constexpr size_t OFF_MEMN = OFF_MIX + al256((size_t)32768 * 1024 * 2);
constexpr size_t OFF_KVB = OFF_MEMN + al256((size_t)1024 * 1024 * 2);
constexpr size_t OFF_LB = OFF_KVB + al256((size_t)1024 * 512 * 2);
constexpr size_t OFF_HSTATE = OFF_LB + al256(512 * 4);
constexpr size_t OFF_HDEC = OFF_HSTATE + al256((size_t)4096 * 4096 * 4);
constexpr size_t OFF_UC = OFF_HDEC + al256((size_t)4096 * 64 * 4);
constexpr size_t OFF_VC = OFF_UC + al256((size_t)16384 * 1024);
constexpr size_t OFF_QUEUE = OFF_VC + al256((size_t)16384 * 1024);
constexpr size_t OFF_SUBK = OFF_QUEUE + al256(2048 * 4);
constexpr size_t OFF_BAR = OFF_SUBK + al256((size_t)16 * 128 * 128 * 2);
constexpr size_t OFF_SS1 = OFF_BAR + al256(4096 * 4);
constexpr size_t OFF_HMAX = OFF_SS1 + al256((size_t)32768 * 4);
constexpr size_t OFF_CSUM = OFF_HMAX + al256((size_t)32768 * 4);
constexpr size_t OFF_SCALE_U = OFF_CSUM + al256((size_t)32768 * 4);
constexpr size_t OFF_SCALE_V = OFF_SCALE_U + al256(16384 * 4);
constexpr size_t OFF_VT = OFF_SCALE_V + al256(16384 * 4);
constexpr size_t OFF_KVT = OFF_VT + al256((size_t)32768 * 512 * 2);
constexpr size_t WS_TOTAL = OFF_KVT + al256((size_t)1024 * 256 * 2);
constexpr size_t OFF_EIDX = OFF_HSTATE;
constexpr size_t OFF_GATE = OFF_HSTATE + (size_t)32768 * 128 * 4;
constexpr size_t OFF_COEF = OFF_HSTATE + (size_t)32768 * 128 * 8;
constexpr size_t OFF_SS = OFF_HSTATE + (size_t)32768 * 128 * 12;
constexpr size_t OFF_PARTIAL = OFF_Z;
constexpr size_t OFF_PEER_OUT = OFF_Z + (size_t)8 * 32768 * 128 * 4;

struct Params {
    const float *x, *mem, *attn_g, *w_in, *rpb, *hg_lb, *hg_g, *mem_g, *w_kv, *w_out, *ffn_g, *w_q, *subk, *pu, *pv, *fin_g;
    float* out;
    char* ws;
#define WSF(type, name, off) __device__ __forceinline__ type* name() const { return (type*)(ws + (off)); }
    WSF(bf16_t, w_in_t, OFF_W_IN_T) WSF(bf16_t, w_out_t, OFF_W_OUT_T) WSF(bf16_t, w_q_t, OFF_W_Q_T) WSF(bf16_t, w_kv_t, OFF_W_KV_T)
    WSF(bf16_t, h, OFF_H)
    WSF(bf16_t, z, OFF_Z)
    WSF(bf16_t, mix, OFF_MIX)
    WSF(bf16_t, memn, OFF_MEMN)
    WSF(bf16_t, kvb, OFF_KVB)
    WSF(float, lb, OFF_LB)
    WSF(float, hstate, OFF_HSTATE)
    WSF(float, hdec, OFF_HDEC)
    WSF(unsigned short, eidx, OFF_EIDX)
    WSF(float, gate, OFF_GATE)
    WSF(signed char, coef, OFF_COEF)
    WSF(bf16_t, x1b, OFF_PEER_OUT)
    WSF(float, ss, OFF_SS)
    WSF(float, partial, OFF_PARTIAL)
    WSF(bf16_t, u_c, OFF_UC) WSF(bf16_t, v_c, OFF_VC)
    WSF(unsigned, queue, OFF_QUEUE)
    WSF(bf16_t, subk_b, OFF_SUBK)
    WSF(unsigned, bar, OFF_BAR)
    WSF(float, ss1, OFF_SS1) WSF(unsigned, hmax, OFF_HMAX) WSF(float, csum, OFF_CSUM)
    WSF(float, scale_u, OFF_SCALE_U) WSF(float, scale_v, OFF_SCALE_V)
    WSF(bf16_t, vT, OFF_VT)
    WSF(bf16_t, kvT, OFF_KVT)
#undef WSF
};

__device__ __forceinline__ float bf2f(bf16_t v) { return __uint_as_float(((unsigned)v) << 16); }
__device__ __forceinline__ bf16_t f2bf(float f) {
    unsigned u = __float_as_uint(f);
    u += 0x7FFFu + ((u >> 16) & 1u);
    return (bf16_t)(u >> 16);
}
__device__ __forceinline__ float bflo(unsigned u) { return __uint_as_float(u << 16); }
__device__ __forceinline__ float bfhi(unsigned u) { return __uint_as_float(u & 0xFFFF0000u); }
typedef __bf16 bf16x2v_t __attribute__((ext_vector_type(2)));
typedef float f32x2v_t __attribute__((ext_vector_type(2)));
__device__ __forceinline__ unsigned pack2(float a, float b) {
    const f32x2v_t v = {a, b};
    return __builtin_bit_cast(unsigned, __builtin_convertvector(v, bf16x2v_t));
}

__device__ __forceinline__ float wave_sum(float v) {
#pragma unroll
    for (int o = 32; o; o >>= 1) v += __shfl_xor(v, o);
    return v;
}
__device__ __forceinline__ float wave_max(float v) {
#pragma unroll
    for (int o = 32; o; o >>= 1) v = fmaxf(v, __shfl_xor(v, o));
    return v;
}


typedef __bf16 bf16x2_t __attribute__((ext_vector_type(2)));
template <int CTRL>
__device__ __forceinline__ float dpp_mov(float v) {
    return __builtin_bit_cast(float, __builtin_amdgcn_update_dpp(0, __builtin_bit_cast(int, v), CTRL, 0xf, 0xf, true));
}
#define DPP_QP_X1 0xB1
#define DPP_QP_X2 0x4E
#define DPP_HMIRROR 0x141
#define DPP_ROR8 0x128
__device__ __forceinline__ unsigned xcc_id() { return (unsigned)__builtin_amdgcn_s_getreg((3 << 11) | 20) & 0xFu; }

__device__ __forceinline__ void transpose_tile(const float* __restrict__ in, bf16_t* __restrict__ out, int K, int N, int tile, char* smem) {
    float* tl = (float*)smem;
    const int ntn = N >> 6;
    const int k0 = (tile / ntn) << 6, n0 = (tile % ntn) << 6;
    const int tid = VTID;
    __syncthreads();
#pragma unroll 4
    for (int i = 0; i < 16; ++i) {
        int idx = tid + 256 * i;
        int r = idx >> 6, c = idx & 63;
        tl[r * 65 + c] = in[(size_t)(k0 + r) * N + n0 + c];
    }
    __syncthreads();
#pragma unroll 4
    for (int i = 0; i < 16; ++i) {
        int idx = tid + 256 * i;
        int r = idx >> 6, c = idx & 63;
        out[(size_t)(n0 + r) * K + k0 + c] = f2bf(tl[c * 65 + r]);
    }
}

__device__ __forceinline__ void rmsnorm_row_bf16(const float* __restrict__ xr, const float* __restrict__ g, bf16_t* __restrict__ o, int lane) {
    float4 v[4];
    float ss = 0.f;
#pragma unroll
    for (int j = 0; j < 4; ++j) {
        v[j] = *(const float4*)(xr + (j * 64 + lane) * 4);
        ss += v[j].x * v[j].x + v[j].y * v[j].y + v[j].z * v[j].z + v[j].w * v[j].w;
    }
    ss = wave_sum(ss);
    const float rs = rsqrtf(ss * (1.0f / 1024.0f) + EPS);
#pragma unroll
    for (int j = 0; j < 4; ++j) {
        const float4 gg = *(const float4*)(g + (j * 64 + lane) * 4);
        uint2 pk;
        pk.x = pack2(v[j].x * rs * gg.x, v[j].y * rs * gg.y);
        pk.y = pack2(v[j].z * rs * gg.z, v[j].w * rs * gg.w);
        *(uint2*)(o + (j * 64 + lane) * 4) = pk;
    }
}

__device__ void phase_prep(const Params& p, char* smem) {
    const int tid = VTID, lane = tid & 63, w = tid >> 6;
    const int gsz = VGRID, bid = VBID;
    const int t_in = (1024 / 64) * (INW / 64);
    const int t_out = 16 * 16;
    const int t_q = 16 * (QW / 64);
    const int t_kv = 16 * 8;
    const int t_all = t_in + t_out + t_q + t_kv;
    for (int it = bid; it < t_all; it += gsz) {
        if (it < t_in) transpose_tile(p.w_in, p.w_in_t(), 1024, INW, it, smem);
        else if (it < t_in + t_out) transpose_tile(p.w_out, p.w_out_t(), 1024, 1024, it - t_in, smem);
        else if (it < t_in + t_out + t_q) transpose_tile(p.w_q, p.w_q_t(), 1024, QW, it - t_in - t_out, smem);
        else transpose_tile(p.w_kv, p.w_kv_t(), 1024, 512, it - t_in - t_out - t_q, smem);
    }
    for (int i = bid * 256 + tid; i < NTOK; i += gsz * 256) { p.ss1()[i] = 0.f; p.hmax()[i] = 0u; }
    if (bid == 0) {
        for (int i = tid; i < 512; i += 256) {
            int dir = i >> 8, k = i & 255;
            float a0 = p.hg_lb[(dir * 2 + 0) * 256 + k], a1 = p.hg_lb[(dir * 2 + 1) * 256 + k];
            float m = fmaxf(a0, a1);
            float e0 = expf(a0 - m), e1 = expf(a1 - m);
            p.lb()[i] = e0 / (e0 + e1);
        }
    }
    const int nrows = NTOK + 1024;
    for (int r0 = bid * 4; r0 < nrows; r0 += gsz * 4) {
        int r = r0 + w;
        if (r < NTOK) rmsnorm_row_bf16(p.x + (size_t)r * D, p.attn_g, p.h() + (size_t)r * D, lane);
        else if (r < nrows) rmsnorm_row_bf16(p.mem + (size_t)(r - NTOK) * D, p.mem_g, p.memn() + (size_t)(r - NTOK) * D, lane);
    }
    for (int i = bid * 256 + tid; i < 16 * 128 * 128 / 4; i += gsz * 256) {
        const float4 v = *(const float4*)(p.subk + (size_t)i * 4);
        uint2 pk; pk.x = pack2(v.x, v.y); pk.y = pack2(v.z, v.w);
        *(uint2*)(p.subk_b() + (size_t)i * 4) = pk;
    }
    for (int r0 = bid * 4; r0 < 2 * 16384; r0 += gsz * 4) {
        const int r = r0 + w;
        const bool isv = r >= 16384;
        const int e = r & 16383;
        const float* srcp = (isv ? p.pv : p.pu) + (size_t)e * D;
        unsigned* dst = (unsigned*)(isv ? p.v_c() : p.u_c());
        float4 v[4];
        float am = 0.f;
#pragma unroll
        for (int j = 0; j < 4; ++j) {
            v[j] = *(const float4*)(srcp + (j * 64 + lane) * 4);
            am = fmaxf(am, fmaxf(fmaxf(fabsf(v[j].x), fabsf(v[j].y)), fmaxf(fabsf(v[j].z), fabsf(v[j].w))));
        }
        am = wave_max(am);
        const float qs = am > 0.f ? 127.0f / am : 0.f;
        if (lane == 0) (isv ? p.scale_v() : p.scale_u())[e] = am * (1.0f / 127.0f);
        const int off = 0;
#pragma unroll
        for (int j = 0; j < 4; ++j) {
            const int q0 = (int)rintf(v[j].x * qs) + off, q1 = (int)rintf(v[j].y * qs) + off;
            const int q2 = (int)rintf(v[j].z * qs) + off, q3 = (int)rintf(v[j].w * qs) + off;
            const unsigned pk = (unsigned)(q0 & 255) | ((unsigned)(q1 & 255) << 8) | ((unsigned)(q2 & 255) << 16) | ((unsigned)(q3 & 255) << 24);
            const int c = j * 2 + (lane >> 5), d = (lane & 31) * 4;
            dst[(((size_t)c * 16384 + e) * 128 + d) >> 2] = pk;
        }
    }
}

struct EpiBf16 {
    bf16_t* C; int ldc;
    __device__ __forceinline__ void operator()(int row, int col, const f32x4& v) const {
        uint2 pk; pk.x = pack2(v[0], v[1]); pk.y = pack2(v[2], v[3]);
        *(uint2*)(C + (size_t)row * ldc + col) = pk;
    }
};
struct EpiBf16T {
    bf16_t* C; int col0, ncols, rows_per_b;
    __device__ __forceinline__ void operator()(int row, int col, const f32x4& v) const {
        const int bb = row / rows_per_b, rr = row - bb * rows_per_b;
        uint2 pk; pk.x = pack2(v[0], v[1]); pk.y = pack2(v[2], v[3]);
        *(uint2*)(C + ((size_t)bb * ncols + (col - col0)) * rows_per_b + rr) = pk;
    }
};
struct EpiBf16RowScale {
    bf16_t* C; int ldc; const float* ssrow;
    __device__ __forceinline__ void operator()(int row, int col, const f32x4& v) const {
        const float rs = rsqrtf(ssrow[row] * (1.0f / 1024.0f) + EPS);
        uint2 pk; pk.x = pack2(v[0] * rs, v[1] * rs); pk.y = pack2(v[2] * rs, v[3] * rs);
        *(uint2*)(C + (size_t)row * ldc + col) = pk;
    }
};
struct EpiResNorm {
    bf16_t* C; const float* R; const float* g; bf16_t* H; int ldc; float* ssrow; unsigned* hmax;
    __device__ __forceinline__ void operator()(int row, int col, const f32x4& v, float& ssq, float& am) const {
        const float4 r = *(const float4*)(R + (size_t)row * ldc + col);
        const float4 gg = *(const float4*)(g + col);
        float4 o; o.x = v[0] + r.x; o.y = v[1] + r.y; o.z = v[2] + r.z; o.w = v[3] + r.w;
        { uint2 xk; xk.x = pack2(o.x, o.y); xk.y = pack2(o.z, o.w); *(uint2*)(C + (size_t)row * ldc + col) = xk; }
        const float h0 = o.x * gg.x, h1 = o.y * gg.y, h2 = o.z * gg.z, h3 = o.w * gg.w;
        uint2 pk; pk.x = pack2(h0, h1); pk.y = pack2(h2, h3);
        *(uint2*)(H + (size_t)row * ldc + col) = pk;
        ssq += o.x * o.x + o.y * o.y + o.z * o.z + o.w * o.w;
        am = fmaxf(am, fmaxf(fmaxf(fabsf(h0), fabsf(h1)), fmaxf(fabsf(h2), fabsf(h3))));
    }
    __device__ __forceinline__ void row_done(int row, float ssq, float am) const {
        atomicAdd(ssrow + row, ssq);
        atomicMax(hmax + row, __float_as_uint(am));
    }
};
struct EpiResF32 {
    float* C; const float* R; int ldc;
    __device__ __forceinline__ void operator()(int row, int col, const f32x4& v) const {
        const float4 r = *(const float4*)(R + (size_t)row * ldc + col);
        float4 o; o.x = v[0] + r.x; o.y = v[1] + r.y; o.z = v[2] + r.z; o.w = v[3] + r.w;
        *(float4*)(C + (size_t)row * ldc + col) = o;
    }
};

template <bool TRANS, class Epi, bool ROWSS = false>
__device__ __forceinline__ void gemm_tile(const bf16_t* __restrict__ A, int lda, const bf16_t* __restrict__ Bt, int ldb, int K,
                                          int m0, int n0, char* smem, const Epi& epi, float* ssrow = nullptr) {
    const int tid = VTID, lane = tid & 63, w = tid >> 6, wr = w >> 1, wc = w & 1;
    const int fr = lane & 15, fq = lane >> 4;
    const int srow = lane >> 3, sslot = lane & 7;
    f32x4 acc[4][4];
#pragma unroll
    for (int mi = 0; mi < 4; ++mi)
#pragma unroll
        for (int ni = 0; ni < 4; ++ni) acc[mi][ni] = (f32x4){0.f, 0.f, 0.f, 0.f};
    const int g0 = (sslot ^ (srow >> 1)) * 8, g1 = (sslot ^ (4 + (srow >> 1))) * 8;
    const bf16_t* Ab = A + (size_t)(m0 + w * 32 + srow) * lda;
    const bf16_t* Bb = Bt + (size_t)(n0 + w * 32 + srow) * ldb;
    const int nk = K >> 6;
    __syncthreads();
#define GEMM_STAGE(kt, buf)                                                                                                  \
    do {                                                                                                                     \
        char* sa = smem + (buf) * 32768 + w * 4096;                                                                          \
        char* sb = sa + 16384;                                                                                               \
        _Pragma("unroll") for (int i = 0; i < 4; ++i) {                                                                      \
            const int gc = (i & 1) ? g1 : g0;                                                                                \
            __builtin_amdgcn_global_load_lds((const unsigned*)(Ab + (size_t)(i * 8) * lda + (kt) * 64 + gc), (unsigned*)(sa + i * 1024), 16, 0, 0); \
            __builtin_amdgcn_global_load_lds((const unsigned*)(Bb + (size_t)(i * 8) * ldb + (kt) * 64 + gc), (unsigned*)(sb + i * 1024), 16, 0, 0); \
        }                                                                                                                    \
    } while (0)
    GEMM_STAGE(0, 0);
    const int key = fr >> 1;
    for (int kt = 0; kt < nk; ++kt) {
        asm volatile("s_waitcnt vmcnt(0)" ::: "memory");
        __syncthreads();
        if (kt + 1 < nk) GEMM_STAGE(kt + 1, (kt + 1) & 1);
        const char* sa = smem + (kt & 1) * 32768;
        const char* sb = sa + 16384;
#pragma unroll
        for (int ks = 0; ks < 2; ++ks) {
            bf16x8 af[4], bfr[4];
            const int co = ((ks * 4 + fq) ^ key) << 4;
#pragma unroll
            for (int mi = 0; mi < 4; ++mi) af[mi] = *(const bf16x8*)(sa + (wr * 64 + mi * 16 + fr) * 128 + co);
#pragma unroll
            for (int ni = 0; ni < 4; ++ni) bfr[ni] = *(const bf16x8*)(sb + (wc * 64 + ni * 16 + fr) * 128 + co);
#pragma unroll
            for (int mi = 0; mi < 4; ++mi)
#pragma unroll
                for (int ni = 0; ni < 4; ++ni)
                    acc[mi][ni] = TRANS ? __builtin_amdgcn_mfma_f32_16x16x32_bf16(af[mi], bfr[ni], acc[mi][ni], 0, 0, 0)
                                        : __builtin_amdgcn_mfma_f32_16x16x32_bf16(bfr[ni], af[mi], acc[mi][ni], 0, 0, 0);
        }
    }
#undef GEMM_STAGE
    if constexpr (ROWSS) {
#pragma unroll
        for (int mi = 0; mi < 4; ++mi) {
            const int row = m0 + wr * 64 + mi * 16 + fr;
            float ssq = 0.f, am = 0.f;
#pragma unroll
            for (int ni = 0; ni < 4; ++ni) epi(row, n0 + wc * 64 + ni * 16 + fq * 4, acc[mi][ni], ssq, am);
            ssq += __shfl_xor(ssq, 16);
            ssq += __shfl_xor(ssq, 32);
            am = fmaxf(am, __shfl_xor(am, 16));
            am = fmaxf(am, __shfl_xor(am, 32));
            if (fq == 0) epi.row_done(row, ssq, am);
        }
    } else {
#pragma unroll
        for (int mi = 0; mi < 4; ++mi)
#pragma unroll
            for (int ni = 0; ni < 4; ++ni) {
                if (TRANS) epi(m0 + wr * 64 + mi * 16 + fq * 4, n0 + wc * 64 + ni * 16 + fr, acc[mi][ni]);
                else epi(m0 + wr * 64 + mi * 16 + fr, n0 + wc * 64 + ni * 16 + fq * 4, acc[mi][ni]);
            }
    }
}


namespace g8 {
constexpr int BM = 256, BK = 64, HALF = 128, HT = HALF * BK;
__device__ __forceinline__ int lds_byte(int r, int c) {
    const int st = (r >> 4) * 2 + (c >> 5), rr = r & 15, cc = c & 31, ob = rr * 64 + cc * 2;
    return st * 1024 + (ob ^ (((ob >> 9) & 1) << 5));
}
__device__ __forceinline__ void stage_rc(int b, int& R, int& C) {
    const int st = b / 1024, sb = b % 1024, swz = sb ^ (((sb >> 9) & 1) << 5);
    R = (st >> 1) * 16 + swz / 64; C = (st & 1) * 32 + (swz % 64) / 2;
}
__device__ __forceinline__ void tile_of(int L, int nM, int nN, int& pm, int& pn) {
    const int nwg = nM * nN;
    int wgid = L;
    { const int q = nwg / 8, r = nwg % 8, xcd = wgid % 8, off = wgid / 8; wgid = (xcd < r ? xcd * (q + 1) : r * (q + 1) + (xcd - r) * q) + off; }
    const int nig = 8 * nN, gid = wgid / nig, fm = gid * 8, gsz = (nM - fm) < 8 ? (nM - fm) : 8;
    pm = fm + ((wgid % nig) % gsz); pn = (wgid % nig) / gsz;
}
}

#define G8_LAS __attribute__((address_space(3)))
template <bool TRANS, bool ROWSS, class Epi>
__device__ __forceinline__ void gemm256_tile(const bf16_t* __restrict__ A, const bf16_t* __restrict__ Bt, int K, int brow, int bcol,
                                             char* shmc, const Epi& epi) {
    using namespace g8;
    G8_LAS unsigned char* lds = (G8_LAS unsigned char*)shmc;
    const int tid = threadIdx.x, wid = __builtin_amdgcn_readfirstlane(tid >> 6), lane = tid & 63, wr = wid >> 2, wc = wid & 3, fr = lane & 15, fq = lane >> 4;
    constexpr int HTB = HALF * BK * 2;
    unsigned voff[2];
#pragma unroll
    for (int i = 0; i < 2; ++i) { int R, C; stage_rc(tid * 16 + i * 8192, R, C); voff[i] = (unsigned)(R * K + C) * 2u; }
    const size_t kstep = (size_t)(BK * 2);
    const size_t hstep = (size_t)HALF * K * 2;
    const unsigned ldsw = (unsigned)wid * 1024u;
    const int aoff = lds_byte(wr * 64 + fr, fq * 8), boff = lds_byte(wc * 32 + fr, fq * 8);
    const char* cA = (const char*)A + (size_t)brow * K * 2;
    const char* cB = (const char*)Bt + (size_t)bcol * K * 2;
#define G8_SA(b, h) (((b) * 2 + (h)) * HTB)
#define G8_SB(b, h) ((4 + (b) * 2 + (h)) * HTB)
#define G8_STAGE(bufoff, gbase) do { _Pragma("unroll") for (int _i = 0; _i < 2; ++_i) \
        __builtin_amdgcn_global_load_lds((const unsigned*)((const char*)(gbase) + voff[_i]), (G8_LAS unsigned*)(lds + (bufoff) + ldsw + _i * 8192), 16, 0, 0); } while (0)
#define G8_LDA(dst, b, h) do { _Pragma("unroll") for (int m = 0; m < 4; ++m) _Pragma("unroll") for (int k = 0; k < 2; ++k) dst[m][k] = *(const G8_LAS bf16x8*)(lds + G8_SA(b, h) + aoff + m * 2048 + k * 1024); } while (0)
#define G8_LDB(dst, b, h) do { _Pragma("unroll") for (int n = 0; n < 2; ++n) _Pragma("unroll") for (int k = 0; k < 2; ++k) dst[n][k] = *(const G8_LAS bf16x8*)(lds + G8_SB(b, h) + boff + n * 2048 + k * 1024); } while (0)
#define G8_MMA(ai, bj, At_, Bt_) do { __builtin_amdgcn_s_setprio(1); _Pragma("unroll") for (int m = 0; m < 4; ++m) _Pragma("unroll") for (int n = 0; n < 2; ++n) _Pragma("unroll") for (int k = 0; k < 2; ++k) \
        acc[ai][bj][m][n] = TRANS ? __builtin_amdgcn_mfma_f32_16x16x32_bf16(At_[m][k], Bt_[n][k], acc[ai][bj][m][n], 0, 0, 0) \
                                  : __builtin_amdgcn_mfma_f32_16x16x32_bf16(Bt_[n][k], At_[m][k], acc[ai][bj][m][n], 0, 0, 0); \
        __builtin_amdgcn_s_setprio(0); } while (0)
#define G8_WAIT_V(n) asm volatile("s_waitcnt vmcnt(" #n ")" ::: "memory")
#define G8_WAIT_L(n) asm volatile("s_waitcnt lgkmcnt(" #n ")" ::: "memory")
#define G8_BAR __builtin_amdgcn_s_barrier()
#define G8_SCHED __builtin_amdgcn_sched_barrier(0)
    f32x4 acc[2][2][4][2];
#pragma unroll
    for (int a = 0; a < 2; ++a)
#pragma unroll
        for (int b = 0; b < 2; ++b)
#pragma unroll
            for (int m = 0; m < 4; ++m)
#pragma unroll
                for (int n = 0; n < 2; ++n) acc[a][b][m][n] = (f32x4){0.f, 0.f, 0.f, 0.f};
    bf16x8 At[4][2], B0[2][2], B1[2][2];
    const int nt = K / BK;
    __syncthreads();
    G8_STAGE(G8_SB(0, 0), cB); G8_STAGE(G8_SA(0, 0), cA); G8_STAGE(G8_SB(0, 1), cB + hstep); G8_STAGE(G8_SA(0, 1), cA + hstep);
    if (wr == 1) G8_BAR;
    G8_WAIT_V(4); G8_BAR;
    G8_STAGE(G8_SB(1, 0), cB + kstep); G8_STAGE(G8_SA(1, 0), cA + kstep); G8_STAGE(G8_SB(1, 1), cB + hstep + kstep);
    G8_WAIT_V(6); G8_BAR;
    for (int t = 0; t < nt - 2; t += 2) {
        const char* a1 = cA + (size_t)(t + 1) * kstep; const char* a2 = a1 + kstep; const char* a3 = a2 + kstep;
        const char* b2 = cB + (size_t)(t + 2) * kstep; const char* b3 = b2 + kstep;
        G8_LDB(B0, 0, 0); G8_SCHED; G8_LDA(At, 0, 0); G8_STAGE(G8_SA(1, 1), a1 + hstep);
        G8_WAIT_L(8); G8_BAR; G8_WAIT_L(0); G8_MMA(0, 0, At, B0); G8_BAR; G8_SCHED;
        G8_LDB(B1, 0, 1); G8_STAGE(G8_SB(0, 0), b2);
        G8_BAR; G8_WAIT_L(0); G8_MMA(0, 1, At, B1); G8_BAR;
        G8_LDA(At, 0, 1); G8_STAGE(G8_SA(0, 0), a2);
        G8_BAR; G8_WAIT_L(0); G8_MMA(1, 0, At, B0); G8_BAR; G8_SCHED;
        G8_STAGE(G8_SB(0, 1), b2 + hstep);
        G8_WAIT_V(6); G8_BAR; G8_MMA(1, 1, At, B1); G8_BAR;
        G8_LDB(B0, 1, 0); G8_SCHED; G8_LDA(At, 1, 0); G8_STAGE(G8_SA(0, 1), a2 + hstep);
        G8_WAIT_L(8); G8_BAR; G8_WAIT_L(0); G8_MMA(0, 0, At, B0); G8_BAR; G8_SCHED;
        G8_LDB(B1, 1, 1); G8_STAGE(G8_SB(1, 0), b3);
        G8_BAR; G8_WAIT_L(0); G8_MMA(0, 1, At, B1); G8_BAR;
        G8_LDA(At, 1, 1); G8_STAGE(G8_SA(1, 0), a3);
        G8_BAR; G8_WAIT_L(0); G8_MMA(1, 0, At, B0); G8_BAR; G8_SCHED;
        G8_STAGE(G8_SB(1, 1), b3 + hstep);
        G8_WAIT_V(6); G8_BAR; G8_MMA(1, 1, At, B1); G8_BAR;
    }
    { G8_LDB(B0, 0, 0); G8_LDA(At, 0, 0); G8_STAGE(G8_SA(1, 1), cA + (size_t)(nt - 1) * kstep + hstep);
      G8_BAR; G8_WAIT_L(0); G8_MMA(0, 0, At, B0); G8_BAR;
      G8_LDB(B1, 0, 1); G8_BAR; G8_WAIT_L(0); G8_MMA(0, 1, At, B1); G8_BAR;
      G8_LDA(At, 0, 1); G8_WAIT_V(4); G8_BAR; G8_WAIT_L(0); G8_MMA(1, 0, At, B0); G8_MMA(1, 1, At, B1); G8_BAR; }
    { G8_LDB(B0, 1, 0); G8_LDA(At, 1, 0); G8_WAIT_V(2); G8_BAR; G8_WAIT_L(0); G8_MMA(0, 0, At, B0); G8_BAR;
      G8_LDB(B1, 1, 1); G8_WAIT_V(0); G8_BAR; G8_WAIT_L(0); G8_MMA(0, 1, At, B1); G8_BAR;
      G8_LDA(At, 1, 1); G8_BAR; G8_WAIT_L(0); G8_MMA(1, 0, At, B0); G8_MMA(1, 1, At, B1); G8_BAR; }
    if (wr == 0) G8_BAR;
    if constexpr (ROWSS) {
#pragma unroll
        for (int ai = 0; ai < 2; ++ai)
#pragma unroll
            for (int m = 0; m < 4; ++m) {
                const int row = brow + ai * HALF + wr * 64 + m * 16 + fr;
                float ssq = 0.f, am = 0.f;
#pragma unroll
                for (int bj = 0; bj < 2; ++bj)
#pragma unroll
                    for (int n = 0; n < 2; ++n) epi(row, bcol + bj * HALF + wc * 32 + n * 16 + fq * 4, acc[ai][bj][m][n], ssq, am);
                ssq += __shfl_xor(ssq, 16);
                ssq += __shfl_xor(ssq, 32);
                am = fmaxf(am, __shfl_xor(am, 16));
                am = fmaxf(am, __shfl_xor(am, 32));
                if (fq == 0) epi.row_done(row, ssq, am);
            }
    } else {
#pragma unroll
        for (int ai = 0; ai < 2; ++ai)
#pragma unroll
            for (int bj = 0; bj < 2; ++bj)
#pragma unroll
                for (int m = 0; m < 4; ++m)
#pragma unroll
                    for (int n = 0; n < 2; ++n) {
                        if (TRANS) epi(brow + ai * HALF + wr * 64 + m * 16 + fq * 4, bcol + bj * HALF + wc * 32 + n * 16 + fr, acc[ai][bj][m][n]);
                        else epi(brow + ai * HALF + wr * 64 + m * 16 + fr, bcol + bj * HALF + wc * 32 + n * 16 + fq * 4, acc[ai][bj][m][n]);
                    }
    }
#undef G8_SA
#undef G8_SB
#undef G8_STAGE
#undef G8_LDA
#undef G8_LDB
#undef G8_MMA
#undef G8_WAIT_V
#undef G8_WAIT_L
#undef G8_BAR
#undef G8_SCHED
}

__device__ void phase_gemm_in(const Params& p, char* smem) {
    const int nM = NTOK / 256, nN = INW / 256;
    EpiBf16 e1{p.z(), INW};
    EpiBf16T e1t{p.vT(), 1024, 512, T};
    for (int i = 0; i * (int)gridDim.x + (int)blockIdx.x < nM * nN; ++i) {
        int pm, pn;
        g8::tile_of(i * gridDim.x + blockIdx.x, nM, nN, pm, pn);
        if (pn >= 4 && pn < 6) gemm256_tile<true, false>(p.h(), p.w_in_t(), D, pm * 256, pn * 256, smem, e1t);
        else gemm256_tile<false, false>(p.h(), p.w_in_t(), D, pm * 256, pn * 256, smem, e1);
    }
}

__device__ void phase_gemm_kv(const Params& p, char* smh) {
    EpiBf16 e2{p.kvb(), 512};
    EpiBf16T e2t{p.kvT(), 256, 256, 256};
    const bool dedicated = gridDim.x >= 64;
    if (dedicated && blockIdx.x >= 16) return;
    for (int it = VBID; it < 32; it += dedicated ? 32 : VGRID) {
        const int pm = it >> 2, pn = it & 3;
        if (pn >= 2) gemm_tile<true>(p.memn(), D, p.w_kv_t(), D, D, pm * 128, pn * 128, smh, e2t);
        else gemm_tile<false>(p.memn(), D, p.w_kv_t(), D, D, pm * 128, pn * 128, smh, e2);
    }
}

__device__ void phase_gemm_out(const Params& p, char* smem) {
    const int nM = NTOK / 256, nN = D / 256;
    EpiResNorm e{p.x1b(), p.x, p.ffn_g, p.h(), D, p.ss1(), p.hmax()};
    for (int i = 0; i * (int)gridDim.x + (int)blockIdx.x < nM * nN; ++i) {
        int pm, pn;
        g8::tile_of(i * gridDim.x + blockIdx.x, nM, nN, pm, pn);
        gemm256_tile<false, true>(p.mix(), p.w_out_t(), D, pm * 256, pn * 256, smem, e);
    }
}

__device__ void phase_gemm_q(const Params& p, char* smem) {
    const int nM = NTOK / 256, nN = QW / 256;
    EpiBf16RowScale e{p.z(), QW, p.ss1()};
    for (int i = 0; i * (int)gridDim.x + (int)blockIdx.x < nM * nN; ++i) {
        int pm, pn;
        g8::tile_of(i * gridDim.x + blockIdx.x, nM, nN, pm, pn);
        gemm256_tile<false, false>(p.h(), p.w_q_t(), D, pm * 256, pn * 256, smem, e);
    }
}

typedef float f32x16 __attribute__((ext_vector_type(16)));
constexpr int HRS = 144;
__device__ __forceinline__ f32x16 tile_mm64(const char* X, const char* Y, int xrow0, int yrow0, int lane, f32x16 acc) {
    const int r = lane & 31, hh = lane >> 5;
#pragma unroll
    for (int ks = 0; ks < 4; ++ks) {
        const bf16x8 a = *(const bf16x8*)(X + (xrow0 + r) * HRS + ks * 32 + hh * 16);
        const bf16x8 b = *(const bf16x8*)(Y + (yrow0 + r) * HRS + ks * 32 + hh * 16);
        acc = __builtin_amdgcn_mfma_f32_32x32x16_bf16(a, b, acc, 0, 0, 0);
    }
    return acc;
}
__device__ __forceinline__ int crow(int reg, int hh) { return (reg & 3) + 8 * (reg >> 2) + 4 * hh; }

__device__ __forceinline__ void hg_load_vt(const Params& p, char* sVT, int tok0, int h, int kcol, int sq) {
    const bf16_t* zp = p.z() + (size_t)(tok0 + sq * 16) * INW + 2304 + h * 64 + kcol;
    unsigned pk[8];
#pragma unroll
    for (int j = 0; j < 8; ++j) {
        const unsigned lo = zp[(size_t)(2 * j) * INW], hi = zp[(size_t)(2 * j + 1) * INW];
        pk[j] = lo | (hi << 16);
    }
    *(uint4*)(sVT + kcol * HRS + sq * 32) = make_uint4(pk[0], pk[1], pk[2], pk[3]);
    *(uint4*)(sVT + kcol * HRS + sq * 32 + 16) = make_uint4(pk[4], pk[5], pk[6], pk[7]);
}

__device__ __forceinline__ float hg_gates(const Params& p, float* sTot, int tok0, int h, int dir, int kcol, int sq, float (&bj)[16], float (&kk)[16]) {
    const bf16_t* zp = p.z() + (size_t)(tok0 + sq * 16) * INW + 1792 + dir * 256 + h * 64 + kcol;
    const float lbv = p.lb()[dir * 256 + h * 64 + kcol];
#pragma unroll
    for (int j = 0; j < 16; ++j) {
        const float pre = bf2f(zp[(size_t)j * INW]);
        const float f = lbv + (1.0f - lbv) * (1.0f / (1.0f + __expf(-pre)));
        bj[j] = __logf(f);
        kk[j] = 1.0f - f;
    }
    if (dir == 0) {
#pragma unroll
        for (int j = 1; j < 16; ++j) bj[j] += bj[j - 1];
        sTot[sq * 64 + kcol] = bj[15];
    } else {
#pragma unroll
        for (int j = 14; j >= 0; --j) bj[j] += bj[j + 1];
        sTot[sq * 64 + kcol] = bj[0];
    }
    __syncthreads();
    const float t0 = sTot[kcol], t1 = sTot[64 + kcol], t2 = sTot[128 + kcol], t3 = sTot[192 + kcol];
    float off;
    if (dir == 0) off = (sq > 0 ? t0 : 0.f) + (sq > 1 ? t1 : 0.f) + (sq > 2 ? t2 : 0.f);
    else off = (sq < 3 ? t3 : 0.f) + (sq < 2 ? t2 : 0.f) + (sq < 1 ? t1 : 0.f);
#pragma unroll
    for (int j = 0; j < 16; ++j) bj[j] += off;
    return t0 + t1 + t2 + t3;
}

__device__ void hg_local(const Params& p, char* smem) {
    char* sVT = smem;
    char* sKT = smem + 9216;
    float* sTot = (float*)(smem + 18432);
    const int tid = VTID, lane = tid & 63, w = tid >> 6;
    const int kcol = tid & 63, sq = tid >> 6;
    for (int item = VBID; item < 4096; item += VGRID) {
        const int c = item & 127, dir = (item >> 7) & 1, h = (item >> 8) & 3, b = item >> 10;
        const int tok0 = b * T + c * 64;
        __syncthreads();
        hg_load_vt(p, sVT, tok0, h, kcol, sq);
        float bj[16], kk[16];
        const float btot = hg_gates(p, sTot, tok0, h, dir, kcol, sq, bj, kk);
        unsigned pk[8];
#pragma unroll
        for (int j = 0; j < 8; ++j)
            pk[j] = pack2(kk[2 * j] * __expf(btot - bj[2 * j]), kk[2 * j + 1] * __expf(btot - bj[2 * j + 1]));
        *(uint4*)(sKT + kcol * HRS + sq * 32) = make_uint4(pk[0], pk[1], pk[2], pk[3]);
        *(uint4*)(sKT + kcol * HRS + sq * 32 + 16) = make_uint4(pk[4], pk[5], pk[6], pk[7]);
        if (sq == 0) p.hdec()[item * 64 + kcol] = __expf(btot);
        __syncthreads();
        const int vi = w >> 1, ki = w & 1, hh = lane >> 5;
        f32x16 acc;
#pragma unroll
        for (int r = 0; r < 16; ++r) acc[r] = 0.f;
        acc = tile_mm64(sVT, sKT, vi * 32, ki * 32, lane, acc);
        bf16_t* dst = (bf16_t*)p.hstate() + (size_t)item * 4096 + ki * 32 + (lane & 31);
#pragma unroll
        for (int r = 0; r < 16; ++r) dst[(vi * 32 + crow(r, hh)) * 64] = f2bf(acc[r]);
    }
}

__device__ __forceinline__ bf16x8 pack8(const f32x16& x, int s8) {
    typedef unsigned u32x4_t __attribute__((ext_vector_type(4)));
    u32x4_t pk;
    pk[0] = pack2(x[s8], x[s8 + 1]); pk[1] = pack2(x[s8 + 2], x[s8 + 3]);
    pk[2] = pack2(x[s8 + 4], x[s8 + 5]); pk[3] = pack2(x[s8 + 6], x[s8 + 7]);
    return __builtin_bit_cast(bf16x8, pk);
}
__device__ __forceinline__ bf16x8 join8(const uint2& lo, const uint2& hi) {
    typedef unsigned u32x4_t __attribute__((ext_vector_type(4)));
    u32x4_t pk; pk[0] = lo.x; pk[1] = lo.y; pk[2] = hi.x; pk[3] = hi.y;
    return __builtin_bit_cast(bf16x8, pk);
}

__device__ __forceinline__ int swap23(int r) { return (r & ~12) | ((r & 4) << 1) | ((r & 8) >> 1); }

__device__ __forceinline__ void mem_attn_wave(const Params& p, int wu, int lane) {
    const int tile = wu & 255, h = (wu >> 8) & 3, b = wu >> 10;
    const int l31 = lane & 31, hh = lane >> 5;
    const int tok = b * T + tile * 32 + l31;
    bf16x8 qf[4];
#pragma unroll
    for (int ks = 0; ks < 4; ++ks) qf[ks] = *(const bf16x8*)(p.z() + (size_t)tok * INW + 2816 + h * 64 + ks * 16 + hh * 8);
    const bf16_t* kb = p.kvb() + (size_t)(b * 256 + swap23(l31)) * 512 + h * 64 + hh * 8;
    float m = -1e30f;
    f32x16 o0, o1;
#pragma unroll
    for (int r = 0; r < 16; ++r) { o0[r] = 0.f; o1[r] = 0.f; }
    float sum = 0.f;
    const bf16_t* vt = p.kvT() + ((size_t)(b * 4 + h) * 64 + l31) * 256 + 8 * hh;
    bf16x8 kf[4], vf[4];
#pragma unroll
    for (int ks = 0; ks < 4; ++ks) kf[ks] = *(const bf16x8*)(kb + ks * 16);
#pragma unroll
    for (int st = 0; st < 2; ++st) { vf[2 * st] = *(const bf16x8*)(vt + st * 16); vf[2 * st + 1] = *(const bf16x8*)(vt + 32 * 256 + st * 16); }
    for (int kt = 0; kt < 8; ++kt) {
        const int ktn = min(kt + 1, 7);
        bf16x8 kn[4], vn[4];
#pragma unroll
        for (int ks = 0; ks < 4; ++ks) kn[ks] = *(const bf16x8*)(kb + (size_t)ktn * 32 * 512 + ks * 16);
#pragma unroll
        for (int st = 0; st < 2; ++st) { vn[2 * st] = *(const bf16x8*)(vt + ktn * 32 + st * 16); vn[2 * st + 1] = *(const bf16x8*)(vt + 32 * 256 + ktn * 32 + st * 16); }
        f32x16 s;
#pragma unroll
        for (int r = 0; r < 16; ++r) s[r] = 0.f;
#pragma unroll
        for (int ks = 0; ks < 4; ++ks) s = __builtin_amdgcn_mfma_f32_32x32x16_bf16(kf[ks], qf[ks], s, 0, 0, 0);
        float tm = s[0];
#pragma unroll
        for (int r = 1; r < 16; ++r) tm = fmaxf(tm, s[r]);
        tm = fmaxf(tm, __shfl_xor(tm, 32));
        const float mn = fmaxf(m, tm);
        if (__any(mn > m)) {
            const float sc = __builtin_amdgcn_exp2f((m - mn) * 0.18033688011112042f);
            sum *= sc;
#pragma unroll
            for (int r = 0; r < 16; ++r) { o0[r] *= sc; o1[r] *= sc; }
        }
        m = mn;
        const float mb = mn * 0.18033688011112042f;
#pragma unroll
        for (int r = 0; r < 16; ++r) { s[r] = __builtin_amdgcn_exp2f(fmaf(s[r], 0.18033688011112042f, -mb)); sum += s[r]; }
#pragma unroll
        for (int st = 0; st < 2; ++st) {
            const bf16x8 pb = pack8(s, st * 8);
            o0 = __builtin_amdgcn_mfma_f32_32x32x16_bf16(vf[2 * st], pb, o0, 0, 0, 0);
            o1 = __builtin_amdgcn_mfma_f32_32x32x16_bf16(vf[2 * st + 1], pb, o1, 0, 0, 0);
        }
#pragma unroll
        for (int ks = 0; ks < 4; ++ks) kf[ks] = kn[ks];
#pragma unroll
        for (int q = 0; q < 4; ++q) vf[q] = vn[q];
    }
    sum += __shfl_xor(sum, 32);
    const float inv = 1.0f / sum;
    bf16_t* mo = p.mix() + (size_t)tok * D + 768 + h * 64 + 4 * hh;
#pragma unroll
    for (int g = 0; g < 4; ++g) {
        uint2 pk;
        pk.x = pack2(o0[4 * g] * inv, o0[4 * g + 1] * inv); pk.y = pack2(o0[4 * g + 2] * inv, o0[4 * g + 3] * inv);
        *(uint2*)(mo + 8 * g) = pk;
        pk.x = pack2(o1[4 * g] * inv, o1[4 * g + 1] * inv); pk.y = pack2(o1[4 * g + 2] * inv, o1[4 * g + 3] * inv);
        *(uint2*)(mo + 32 + 8 * g) = pk;
    }
}

struct NaCtx {
    const bf16_t* kbase; const bf16_t* vbase; const float* bh;
    int rs, r, c, c0, cb, hh;
    bf16x8 qf[4];
    float m, sum;
    f32x16 o0, o1;
};
template <int TI>
__device__ __forceinline__ void na_load(const NaCtx& x, bf16x8 (&kf)[4], bf16x8 (&vf)[4]) {
    constexpr int ip = TI / 3, cg = TI % 3;
    const bf16_t* kp = x.kbase + (size_t)(ip * 128 + cg * 16) * INW;
#pragma unroll
    for (int ks = 0; ks < 4; ++ks) kf[ks] = *(const bf16x8*)(kp + ks * 16);
    const bf16_t* vr = x.vbase + ip * 128 + cg * 16;
#pragma unroll
    for (int st = 0; st < 2; ++st) { vf[2 * st] = *(const bf16x8*)(vr + st * 64); vf[2 * st + 1] = *(const bf16x8*)(vr + (size_t)32 * T + st * 64); }
}
template <int TI>
__device__ __forceinline__ void na_comp(NaCtx& x, const bf16x8 (&kf)[4], const bf16x8 (&vf)[4]) {
    constexpr int ip = TI / 3, cg = TI % 3;
    f32x16 s;
#pragma unroll
    for (int q = 0; q < 16; ++q) s[q] = 0.f;
#pragma unroll
    for (int ks = 0; ks < 4; ++ks) s = __builtin_amdgcn_mfma_f32_32x32x16_bf16(kf[ks], x.qf[ks], s, 0, 0, 0);
    const int kc0 = x.cb + 16 * cg + 8 * x.hh;
    const float* brow = x.bh + (x.rs + 2 * ip - x.r + 7) * 31 + 15 - x.c + kc0;
    const int d0 = kc0 - x.c0;
    float tm = -1e30f;
    float bv[16];
#pragma unroll
    for (int q = 0; q < 16; ++q) bv[q] = brow[(q & 3) + 4 * ((q >> 2) & 1) + 31 * (q >> 3)];
#pragma unroll
    for (int q = 0; q < 16; ++q) asm volatile("" : "+v"(bv[q]));
#pragma unroll
    for (int q = 0; q < 16; ++q) {
        const int cq = (q & 3) + 4 * ((q >> 2) & 1);
        const bool valid = (unsigned)(d0 + cq) < 16u;
        const float sc = valid ? fmaf(s[q], 0.18033688011112042f, bv[q]) : -INFINITY;
        s[q] = sc;
        tm = fmaxf(tm, sc);
    }
    tm = fmaxf(tm, __shfl_xor(tm, 32));
    const float mn = fmaxf(x.m, tm);
    if (__any(mn > x.m)) {
        const float scl = __builtin_amdgcn_exp2f(x.m - mn);
        x.sum *= scl;
#pragma unroll
        for (int q = 0; q < 16; ++q) { x.o0[q] *= scl; x.o1[q] *= scl; }
    }
    x.m = mn;
#pragma unroll
    for (int q = 0; q < 16; ++q) { const float pe = __builtin_amdgcn_exp2f(s[q] - mn); s[q] = pe; x.sum += pe; }
#pragma unroll
    for (int st = 0; st < 2; ++st) {
        const bf16x8 pb = pack8(s, st * 8);
        x.o0 = __builtin_amdgcn_mfma_f32_32x32x16_bf16(vf[2 * st], pb, x.o0, 0, 0, 0);
        x.o1 = __builtin_amdgcn_mfma_f32_32x32x16_bf16(vf[2 * st + 1], pb, x.o1, 0, 0, 0);
    }
}

__device__ __forceinline__ void na_attn_wave(const Params& p, int wu, int lane, const float* sbias) {
    const int j = wu & 1, h = (wu >> 1) & 7, r = (wu >> 4) & 127, b = wu >> 11;
    const int l31 = lane & 31, hh = lane >> 5;
    NaCtx x;
    x.hh = hh; x.r = r;
    x.c = 32 * j + l31;
    x.c0 = min(max(x.c - 8, 0), 48); x.rs = min(max(r - 4, 0), 120);
    const int tokq = b * T + r * 64 + x.c;
    x.cb = 16 * j;
#pragma unroll
    for (int ks = 0; ks < 4; ++ks) x.qf[ks] = *(const bf16x8*)(p.z() + (size_t)tokq * INW + h * 64 + ks * 16 + hh * 8);
    x.bh = sbias + 64 + h * 465;
    const int kap = swap23(l31);
    x.kbase = p.z() + (size_t)(b * T + (x.rs + (kap >> 4)) * 64 + x.cb + (kap & 15)) * INW + 512 + h * 64 + hh * 8;
    x.vbase = p.vT() + ((size_t)(b * 8 + h) * 64 + l31) * T + x.rs * 64 + x.cb + 8 * hh;
    x.m = -1e30f; x.sum = 0.f;
#pragma unroll
    for (int q = 0; q < 16; ++q) { x.o0[q] = 0.f; x.o1[q] = 0.f; }
    bf16x8 k0[4], v0[4], k1[4], v1[4], k2[4], v2[4], k3[4], v3[4];
    na_load<0>(x, k0, v0); na_load<1>(x, k1, v1); na_load<2>(x, k2, v2);
    na_load<3>(x, k3, v3);  na_comp<0>(x, k0, v0);
    na_load<4>(x, k0, v0);  na_comp<1>(x, k1, v1);
    na_load<5>(x, k1, v1);  na_comp<2>(x, k2, v2);
    na_load<6>(x, k2, v2);  na_comp<3>(x, k3, v3);
    na_load<7>(x, k3, v3);  na_comp<4>(x, k0, v0);
    na_load<8>(x, k0, v0);  na_comp<5>(x, k1, v1);
    na_load<9>(x, k1, v1);  na_comp<6>(x, k2, v2);
    na_load<10>(x, k2, v2); na_comp<7>(x, k3, v3);
    na_load<11>(x, k3, v3); na_comp<8>(x, k0, v0);
    na_comp<9>(x, k1, v1);
    na_comp<10>(x, k2, v2);
    na_comp<11>(x, k3, v3);
    float sum = x.sum;
    sum += __shfl_xor(sum, 32);
    const float inv = 1.0f / sum;
    bf16_t* mo = p.mix() + (size_t)tokq * D + h * 64 + 4 * hh;
#pragma unroll
    for (int g = 0; g < 4; ++g) {
        uint2 pk;
        pk.x = pack2(x.o0[4 * g] * inv, x.o0[4 * g + 1] * inv); pk.y = pack2(x.o0[4 * g + 2] * inv, x.o0[4 * g + 3] * inv);
        *(uint2*)(mo + 8 * g) = pk;
        pk.x = pack2(x.o1[4 * g] * inv, x.o1[4 * g + 1] * inv); pk.y = pack2(x.o1[4 * g + 2] * inv, x.o1[4 * g + 3] * inv);
        *(uint2*)(mo + 32 + 8 * g) = pk;
    }
}

__device__ void phase_mixers(const Params& p, char* smem) {
    const int tid = VTID, lane = tid & 63, w = tid >> 6;
    {
        float* sbias = (float*)smem;
        __syncthreads();
        for (int i = tid; i < 8 * 465; i += 256) sbias[64 + i] = p.rpb[i] * 1.4426950408889634f;
        __syncthreads();
        for (int wu = VBID * 4 + w; wu < 8192; wu += VGRID * 4) na_attn_wave(p, wu, lane, sbias);
    }
    __syncthreads();
    hg_local(p, smem);
}

__device__ void phase_hg_scan(const Params& p) {
    const int tid = VTID;
    const int skip = gridDim.x >= 64 ? 32 : 0;
    if (VBID < skip) return;
    for (int item = VBID - skip; item < 512; item += VGRID - skip) {
        const int g = item * 256 + tid;
        const int seq = g >> 12, kv = g & 4095, k = kv & 63;
        const int dir = seq & 1;
        float S = 0.f;
        for (int cc0 = 0; cc0 < 128; cc0 += 8) {
            float L[8], d[8];
#pragma unroll
            for (int u = 0; u < 8; ++u) {
                const int c = dir ? 127 - (cc0 + u) : cc0 + u;
                const size_t it = (size_t)seq * 128 + c;
                L[u] = bf2f(((const bf16_t*)p.hstate())[it * 4096 + kv]);
                d[u] = p.hdec()[it * 64 + k];
            }
#pragma unroll
            for (int u = 0; u < 8; ++u) {
                const int c = dir ? 127 - (cc0 + u) : cc0 + u;
                const size_t it = (size_t)seq * 128 + c;
                ((bf16_t*)p.h())[it * 4096 + kv] = f2bf(S);
                S = d[u] * S + L[u];
            }
        }
    }
}

__device__ void phase_hg_out(const Params& p, char* smem) {
    char* sQt = smem;
    char* sKt = smem + 9216;
    char* sQh = smem + 18432;
    char* sVT = smem + 27648;
    char* sST = smem + 36864;
    char* sP = smem + 46080;
    float* sTot = (float*)(smem + 55296);
    float* sSS = sTot + 256;
    const int tid = VTID, lane = tid & 63, w = tid >> 6;
    const int kcol = tid & 63, sq = tid >> 6;
    const int l31 = lane & 31, hh = lane >> 5;
    for (int item = VBID; item < 2048; item += VGRID) {
        const int c = item & 127, h = (item >> 7) & 3, b = item >> 9;
        const int tok0 = b * T + c * 64;
        __syncthreads();
        hg_load_vt(p, sVT, tok0, h, kcol, sq);
        float qv[16];
        {
            const bf16_t* zp = p.z() + (size_t)(tok0 + sq * 16) * INW + 1536 + h * 64 + kcol;
#pragma unroll
            for (int j = 0; j < 16; ++j) qv[j] = bf2f(zp[(size_t)j * INW]);
        }
        f32x16 accO;
#pragma unroll
        for (int r = 0; r < 16; ++r) accO[r] = 0.f;
        for (int dir = 0; dir < 2; ++dir) {
            float bj[16], kk[16];
            const float btot = hg_gates(p, sTot, tok0, h, dir, kcol, sq, bj, kk);
            const float bref = 0.5f * btot;
#pragma unroll
            for (int j = 0; j < 16; ++j) {
                const int s = sq * 16 + j;
                *(bf16_t*)(sQt + s * HRS + kcol * 2) = f2bf(qv[j] * __expf(bj[j] - bref));
                *(bf16_t*)(sKt + s * HRS + kcol * 2) = f2bf(kk[j] * __expf(bref - bj[j]));
                *(bf16_t*)(sQh + s * HRS + kcol * 2) = f2bf(qv[j] * __expf(bj[j]));
            }
            {
                const bf16_t* sp = (const bf16_t*)p.h() + ((size_t)(((b * 4 + h) * 2 + dir) * 128 + c)) * 4096;
#pragma unroll
                for (int i = 0; i < 4; ++i) {
                    const int idx = tid * 4 + 1024 * i;
                    *(uint2*)(sST + (idx >> 6) * HRS + (idx & 63) * 2) = *(const uint2*)(sp + idx);
                }
            }
            __syncthreads();
            {
                const int si = w >> 1, ti = w & 1;
                const bool live = dir == 0 ? (si <= ti) : (si >= ti);
                f32x16 pt;
#pragma unroll
                for (int r = 0; r < 16; ++r) pt[r] = 0.f;
                if (live) pt = tile_mm64(sKt, sQt, si * 32, ti * 32, lane, pt);
                const int t = ti * 32 + l31;
#pragma unroll
                for (int g = 0; g < 4; ++g) {
                    const int s0 = si * 32 + 8 * g + 4 * hh;
                    float v0 = pt[4 * g], v1 = pt[4 * g + 1], v2 = pt[4 * g + 2], v3 = pt[4 * g + 3];
                    if (dir == 0) {
                        if (s0 > t) v0 = 0.f; if (s0 + 1 > t) v1 = 0.f; if (s0 + 2 > t) v2 = 0.f; if (s0 + 3 > t) v3 = 0.f;
                    } else {
                        if (s0 < t) v0 = 0.f; if (s0 + 1 < t) v1 = 0.f; if (s0 + 2 < t) v2 = 0.f; if (s0 + 3 < t) v3 = 0.f;
                    }
                    uint2 pk; pk.x = pack2(v0, v1); pk.y = pack2(v2, v3);
                    *(uint2*)(sP + t * HRS + s0 * 2) = pk;
                }
            }
            __syncthreads();
            {
                const int vi = w >> 1, ti = w & 1;
                accO = tile_mm64(sVT, sP, vi * 32, ti * 32, lane, accO);
                accO = tile_mm64(sST, sQh, vi * 32, ti * 32, lane, accO);
            }
            __syncthreads();
        }
        const int vi = w >> 1, ti = w & 1;
        float ssq = 0.f;
#pragma unroll
        for (int r = 0; r < 16; ++r) ssq += accO[r] * accO[r];
        ssq += __shfl_xor(ssq, 32);
        sSS[w * 64 + lane] = ssq;
        __syncthreads();
        const float tot = sSS[ti * 64 + l31] + sSS[(2 + ti) * 64 + l31];
        const float rs = rsqrtf(tot * (1.0f / 64.0f) + EPS);
        const int tok = tok0 + ti * 32 + l31;
#pragma unroll
        for (int g = 0; g < 4; ++g) {
            const int v0 = vi * 32 + 8 * g + 4 * hh;
            const uint2 gz = *(const uint2*)(p.z() + (size_t)tok * INW + 2560 + h * 64 + v0);
            const float4 gn = *(const float4*)(p.hg_g + h * 64 + v0);
            const float g0 = bflo(gz.x), g1 = bfhi(gz.x), g2 = bflo(gz.y), g3 = bfhi(gz.y);
            const float o0 = accO[4 * g] * rs * gn.x * (g0 / (1.0f + __expf(-g0)));
            const float o1 = accO[4 * g + 1] * rs * gn.y * (g1 / (1.0f + __expf(-g1)));
            const float o2 = accO[4 * g + 2] * rs * gn.z * (g2 / (1.0f + __expf(-g2)));
            const float o3 = accO[4 * g + 3] * rs * gn.w * (g3 / (1.0f + __expf(-g3)));
            uint2 pk; pk.x = pack2(o0, o1); pk.y = pack2(o2, o3);
            *(uint2*)(p.mix() + (size_t)tok * D + 512 + h * 64 + v0) = pk;
        }
    }
    for (int wu = VBID * 4 + w; wu < 4096; wu += VGRID * 4) mem_attn_wave(p, wu, lane);
}


__device__ __forceinline__ int ord_key(int fb) { return fb ^ ((fb >> 31) & 0x7FFFFFFF); }

template <int N>
__device__ __forceinline__ void bitonic_sort_desc(int (&v)[N]) {
#pragma unroll
    for (int k = 2; k <= N; k <<= 1) {
#pragma unroll
        for (int j = k >> 1; j > 0; j >>= 1) {
#pragma unroll
            for (int i = 0; i < N; ++i) {
                const int l = i ^ j;
                if (l > i) {
                    const bool desc = ((i & k) == 0);
                    const int a = v[i], b = v[l];
                    const int mx = max(a, b), mn = min(a, b);
                    v[i] = desc ? mx : mn;
                    v[l] = desc ? mn : mx;
                }
            }
        }
    }
}
template <int N>
__device__ __forceinline__ void bitonic_merge_desc(int (&v)[N]) {
#pragma unroll
    for (int j = N >> 1; j > 0; j >>= 1) {
#pragma unroll
        for (int i = 0; i < N; ++i) {
            const int l = i ^ j;
            if (l > i) {
                const int a = v[i], b = v[l];
                v[i] = max(a, b);
                v[l] = min(a, b);
            }
        }
    }
}
__device__ __forceinline__ void merge_prune16(int (&r)[16], const int (&o)[16]) {
#pragma unroll
    for (int i = 0; i < 16; ++i) r[i] = max(r[i], o[15 - i]);
    bitonic_merge_desc<16>(r);
}

constexpr int QRS = 528;
struct EpiQpLds {
    char* qt; const float* ssrow; int brow, bcol;
    __device__ __forceinline__ void operator()(int row, int col, const f32x4& v) const {
        const float rs = rsqrtf(ssrow[row] * (1.0f / 1024.0f) + EPS);
        uint2 pk; pk.x = pack2(v[0] * rs, v[1] * rs); pk.y = pack2(v[2] * rs, v[3] * rs);
        *(uint2*)(qt + (row - brow) * QRS + (col - bcol) * 2) = pk;
    }
};
__device__ __forceinline__ int* route_slot(char* wrows, int e) { return (int*)(wrows + (e >> 6) * QRS + (e & 63) * 4); }

__device__ __forceinline__ void route_tile(const Params& p, char* qt, int tok0, int h) {
    const int tid = threadIdx.x, lane = tid & 63, w = tid >> 6;
    const int tl = lane & 31, hh = lane >> 5;
    char* wrows = qt + (w * 32) * QRS;
    const int tok = tok0 + w * 32 + tl;
    const bf16_t* sp = p.subk_b() + (size_t)(h * 2) * 16384 + tl * 128 + hh * 8;
    bf16x8 an[8];
#pragma unroll
    for (int ks = 0; ks < 8; ++ks) an[ks] = *(const bf16x8*)(sp + ks * 16);
#pragma unroll
    for (int c = 0; c < 2; ++c) {
        bf16x8 qf[8];
#pragma unroll
        for (int ks = 0; ks < 8; ++ks) qf[ks] = *(const bf16x8*)(wrows + tl * QRS + (c * 128 + ks * 16 + hh * 8) * 2);
        int cur[16];
#pragma unroll
        for (int kb = 0; kb < 4; ++kb) {
            bf16x8 af[8];
#pragma unroll
            for (int ks = 0; ks < 8; ++ks) af[ks] = an[ks];
            if (c * 4 + kb + 1 < 8) {
                const bf16_t* sn = sp + (c * 4 + kb + 1) * 4096;
#pragma unroll
                for (int ks = 0; ks < 8; ++ks) an[ks] = *(const bf16x8*)(sn + ks * 16);
            }
            f32x16 acc;
#pragma unroll
            for (int r = 0; r < 16; ++r) acc[r] = 0.f;
#pragma unroll
            for (int ks = 0; ks < 8; ++ks) acc = __builtin_amdgcn_mfma_f32_32x32x16_bf16(af[ks], qf[ks], acc, 0, 0, 0);
            int v[16];
#pragma unroll
            for (int r = 0; r < 16; ++r) {
                const int key = kb * 32 + (r & 3) + 8 * (r >> 2) + 4 * hh;
                const int fb = (__float_as_int(acc[r]) & ~127) | (127 - key);
                v[r] = ord_key(fb);
            }
            bitonic_sort_desc<16>(v);
            if (kb == 0) {
#pragma unroll
                for (int r = 0; r < 16; ++r) cur[r] = v[r];
            } else {
                merge_prune16(cur, v);
            }
            __builtin_amdgcn_sched_barrier(0);
        }
        {
            int o[16];
#pragma unroll
            for (int r = 0; r < 16; ++r) o[r] = __shfl_xor(cur[r], 32);
            merge_prune16(cur, o);
        }
#pragma unroll
        for (int r = 0; r < 16; ++r) *route_slot(wrows, c * 512 + r * 32 + tl) = cur[r];
        __builtin_amdgcn_sched_barrier(0);
    }
    float va[16], vb[16];
#pragma unroll
    for (int r = 0; r < 16; ++r) {
        const int fa = ord_key(*route_slot(wrows, r * 32 + tl)), fb = ord_key(*route_slot(wrows, 512 + r * 32 + tl));
        va[r] = __int_as_float(fa & ~127);
        vb[r] = __int_as_float(fb & ~127);
    }
    int best[16];
#pragma unroll
    for (int j = 0; j < 16; ++j) best[j] = ord_key((__float_as_int(va[0] + vb[j]) & ~255) | (255 - j));
#pragma unroll
    for (int i = 1; i < 8; ++i) {
        const int n = 16 / (i + 1);
        int row[16];
#pragma unroll
        for (int j = 0; j < 16; ++j)
            row[j] = (j < n) ? ord_key((__float_as_int(va[i] + vb[j]) & ~255) | (255 - (i * 16 + j))) : (int)0x80000000;
        merge_prune16(best, row);
    }
    {
        int row[16];
#pragma unroll
        for (int j = 0; j < 16; ++j)
            row[j] = (j < 8) ? ord_key((__float_as_int(va[8 + j] + vb[0]) & ~255) | (255 - ((8 + j) * 16))) : (int)0x80000000;
        merge_prune16(best, row);
    }
    float sv[16];
    int pid[16];
#pragma unroll
    for (int r = 0; r < 16; ++r) {
        const int cb = ord_key(best[r]);
        sv[r] = __int_as_float(cb & ~255);
        pid[r] = 255 - (cb & 255);
    }
    float tot = 0.f;
    const float smax = sv[0];
#pragma unroll
    for (int r = 0; r < 16; ++r) { sv[r] = __expf(sv[r] - smax); tot += sv[r]; }
    const float inv = 1.0f / tot;
    if (hh == 0) {
#pragma unroll
        for (int r = 0; r < 16; ++r) {
            const int ia = 127 - (ord_key(*route_slot(wrows, (pid[r] >> 4) * 32 + tl)) & 127);
            const int ib = 127 - (ord_key(*route_slot(wrows, 512 + (pid[r] & 15) * 32 + tl)) & 127);
            const int pos = (r & 7) * 16 + h * 2 + (r >> 3);
            p.eidx()[(size_t)tok * 128 + pos] = (unsigned short)(ia * 128 + ib);
            p.gate()[(size_t)tok * 128 + pos] = sv[r] * inv;
        }
    }
}

__device__ void phase_gemm_q_route(const Params& p, char* smem) {
    const int nM = NTOK / 256, nN = QW / 256;
    for (int i = 0; i * (int)gridDim.x + (int)blockIdx.x < nM * nN; ++i) {
        int pm, pn;
        g8::tile_of(i * gridDim.x + blockIdx.x, nM, nN, pm, pn);
        EpiQpLds e{smem, p.ss1(), pm * 256, pn * 256};
        gemm256_tile<false, false>(p.h(), p.w_q_t(), D, pm * 256, pn * 256, smem, e);
        __syncthreads();
        route_tile(p, smem, pm * 256, pn);
    }
}

__device__ void phase_route(const Params& p, char* smem) {
    char* sk = smem;
    const int tid = VTID, lane = tid & 63, w = tid >> 6;
    int* sA = (int*)(smem + 32768) + w * 2048;
    int* sB = (int*)(smem + 65536) + w * 512;
    const int tl = lane & 31, hh = lane >> 5;
    const int h = VBID & 7, tg0 = VBID >> 3, tgs = VGRID >> 3;
    for (int base = tg0; base < 256; base += 4 * tgs)
    for (int c = 0; c < 2; ++c) {
        const int hc = h * 2 + c;
        __syncthreads();
        {
            const bf16_t* sp = p.subk_b() + (size_t)hc * 16384;
#pragma unroll
            for (int i = 0; i < 8; ++i) {
                const int ch = tid + 256 * i;
                const int row = ch >> 4, cc = ch & 15;
                const uint4 v = *(const uint4*)(sp + row * 128 + cc * 8);
                *(uint4*)(sk + row * 256 + ((cc ^ (row & 15)) << 4)) = v;
            }
        }
        __syncthreads();
        bf16x8 qf[8];
        if (base < 256) {
            const bf16_t* qr = p.z() + (size_t)(base * 128 + w * 32 + tl) * QW + hc * 128 + hh * 8;
#pragma unroll
            for (int ks = 0; ks < 8; ++ks) qf[ks] = *(const bf16x8*)(qr + ks * 16);
        }
        for (int it = 0; it < 4; ++it) {
            const int tgp = base + it * tgs;
            if (tgp >= 256) break;
            const int tok = tgp * 128 + w * 32 + tl;
            int* sidx = sA + it * 512;
            f32x16 acc4[4];
#pragma unroll
            for (int kb = 0; kb < 4; ++kb) {
#pragma unroll
                for (int r = 0; r < 16; ++r) acc4[kb][r] = 0.f;
                const int row = kb * 32 + tl;
#pragma unroll
                for (int ks = 0; ks < 8; ++ks) {
                    const bf16x8 af = *(const bf16x8*)(sk + row * 256 + (((ks * 2 + hh) ^ (row & 15)) << 4));
                    acc4[kb] = __builtin_amdgcn_mfma_f32_32x32x16_bf16(af, qf[ks], acc4[kb], 0, 0, 0);
                }
            }
            if (it + 1 < 4 && tgp + tgs < 256) {
                const bf16_t* qr = p.z() + (size_t)((tgp + tgs) * 128 + w * 32 + tl) * QW + hc * 128 + hh * 8;
#pragma unroll
                for (int ks = 0; ks < 8; ++ks) qf[ks] = *(const bf16x8*)(qr + ks * 16);
            }
            int cur[16];
#pragma unroll
            for (int kb = 0; kb < 4; ++kb) {
                int v[16];
#pragma unroll
                for (int r = 0; r < 16; ++r) {
                    const int key = kb * 32 + (r & 3) + 8 * (r >> 2) + 4 * hh;
                    const int fb = (__float_as_int(acc4[kb][r]) & ~127) | (127 - key);
                    v[r] = ord_key(fb);
                }
                bitonic_sort_desc<16>(v);
                if (kb == 0) {
#pragma unroll
                    for (int r = 0; r < 16; ++r) cur[r] = v[r];
                } else {
                    merge_prune16(cur, v);
                }
            }
            {
                int o[16];
#pragma unroll
                for (int r = 0; r < 16; ++r) o[r] = __shfl_xor(cur[r], 32);
                merge_prune16(cur, o);
            }
            if (c == 0) {
#pragma unroll
                for (int r = 0; r < 16; ++r) sidx[r * 32 + tl] = cur[r];
                continue;
            }
#pragma unroll
            for (int r = 0; r < 16; ++r) sB[r * 32 + tl] = cur[r];
        float va[16], vb[16];
#pragma unroll
        for (int r = 0; r < 16; ++r) {
            const int fa = ord_key(sidx[r * 32 + tl]), fb = ord_key(sB[r * 32 + tl]);
            va[r] = __int_as_float(fa & ~127);
            vb[r] = __int_as_float(fb & ~127);
        }
        int best[16];
#pragma unroll
        for (int j = 0; j < 16; ++j) best[j] = ord_key((__float_as_int(va[0] + vb[j]) & ~255) | (255 - j));
#pragma unroll
        for (int i = 1; i < 8; ++i) {
            const int n = 16 / (i + 1);
            int row[16];
#pragma unroll
            for (int j = 0; j < 16; ++j)
                row[j] = (j < n) ? ord_key((__float_as_int(va[i] + vb[j]) & ~255) | (255 - (i * 16 + j))) : (int)0x80000000;
            merge_prune16(best, row);
        }
        {
            int row[16];
#pragma unroll
            for (int j = 0; j < 16; ++j)
                row[j] = (j < 8) ? ord_key((__float_as_int(va[8 + j] + vb[0]) & ~255) | (255 - ((8 + j) * 16))) : (int)0x80000000;
            merge_prune16(best, row);
        }
        float sv[16];
        int pid[16];
#pragma unroll
        for (int r = 0; r < 16; ++r) {
            const int cb = ord_key(best[r]);
            sv[r] = __int_as_float(cb & ~255);
            pid[r] = 255 - (cb & 255);
        }
        float tot = 0.f;
        const float smax = sv[0];
#pragma unroll
        for (int r = 0; r < 16; ++r) { sv[r] = __expf(sv[r] - smax); tot += sv[r]; }
        const float inv = 1.0f / tot;
        if (hh == 0) {
#pragma unroll
            for (int r = 0; r < 16; ++r) {
                const int ia = 127 - (ord_key(sidx[(pid[r] >> 4) * 32 + tl]) & 127);
                const int ib = 127 - (ord_key(sB[(pid[r] & 15) * 32 + tl]) & 127);
                const int pos = (r & 7) * 16 + h * 2 + (r >> 3);
                p.eidx()[(size_t)tok * 128 + pos] = (unsigned short)(ia * 128 + ib);
                p.gate()[(size_t)tok * 128 + pos] = sv[r] * inv;
            }
        }
        }
    }
}

constexpr int PEER_TG = 512;
constexpr int PEER_TPW = PEER_TG / 8;
constexpr int PEER_NTG = NTOK / PEER_TG;
constexpr int PEER_NCH = 8;

#define PEER_G1(base, wv, hi) (*(const uint4*)((base) + (unsigned)((((hi) ? ((wv) >> 16) : ((wv) & 0xFFFFu)) << 7) + dlo)))
#define PEER_GATHER16(dst, base, ia, ib)                                                             \
    dst[0] = PEER_G1(base, (ia).x, 0);  dst[1] = PEER_G1(base, (ia).x, 1);  dst[2] = PEER_G1(base, (ia).y, 0);  dst[3] = PEER_G1(base, (ia).y, 1);   \
    dst[4] = PEER_G1(base, (ia).z, 0);  dst[5] = PEER_G1(base, (ia).z, 1);  dst[6] = PEER_G1(base, (ia).w, 0);  dst[7] = PEER_G1(base, (ia).w, 1);   \
    dst[8] = PEER_G1(base, (ib).x, 0);  dst[9] = PEER_G1(base, (ib).x, 1);  dst[10] = PEER_G1(base, (ib).y, 0); dst[11] = PEER_G1(base, (ib).y, 1);  \
    dst[12] = PEER_G1(base, (ib).z, 0); dst[13] = PEER_G1(base, (ib).z, 1); dst[14] = PEER_G1(base, (ib).w, 0); dst[15] = PEER_G1(base, (ib).w, 1);

__device__ __forceinline__ unsigned quant4(float a, float b, float c, float d, float qs) {
    const int q0 = (int)rintf(__builtin_amdgcn_fmed3f(a * qs, -127.f, 127.f)), q1 = (int)rintf(__builtin_amdgcn_fmed3f(b * qs, -127.f, 127.f));
    const int q2 = (int)rintf(__builtin_amdgcn_fmed3f(c * qs, -127.f, 127.f)), q3 = (int)rintf(__builtin_amdgcn_fmed3f(d * qs, -127.f, 127.f));
    return (unsigned)(q0 & 255) | ((unsigned)(q1 & 255) << 8) | ((unsigned)(q2 & 255) << 16) | ((unsigned)(q3 & 255) << 24);
}
template <int CTRL>
__device__ __forceinline__ int dpp_movi(int v) { return __builtin_amdgcn_update_dpp(0, v, CTRL, 0xf, 0xf, true); }

struct DotTok { uint4 ia, ib; uint4 ha, hb; float hm; };
__device__ __forceinline__ void dots_load(const Params& p, DotTok& t, int tok, int c, int g, int d8) {
    const uint4* idp = (const uint4*)(p.eidx() + (size_t)tok * 128 + g * 16);
    t.ia = idp[0]; t.ib = idp[1];
    const uint4* hp = (const uint4*)(p.h() + (size_t)tok * D + c * 128 + d8 * 16);
    t.ha = hp[0]; t.hb = hp[1];
    t.hm = __uint_as_float(p.hmax()[tok]);
}
__device__ __forceinline__ void dotsf_load(const Params& p, DotTok& t, int tokb, int s, int g, int d8) {
    dots_load(p, t, tokb + 8 * (s & 15), s >> 4, g, d8);
}
__device__ __forceinline__ void dotsf_finish(const uint4 (&uu)[16], const DotTok& t, int* part, int g, int d8) {
    const float qs = t.hm > 0.f ? 127.0f / t.hm : 0.f;
    const int h0 = (int)quant4(bflo(t.ha.x), bfhi(t.ha.x), bflo(t.ha.y), bfhi(t.ha.y), qs);
    const int h1 = (int)quant4(bflo(t.ha.z), bfhi(t.ha.z), bflo(t.ha.w), bfhi(t.ha.w), qs);
    const int h2 = (int)quant4(bflo(t.hb.x), bfhi(t.hb.x), bflo(t.hb.y), bfhi(t.hb.y), qs);
    const int h3 = (int)quant4(bflo(t.hb.z), bfhi(t.hb.z), bflo(t.hb.w), bfhi(t.hb.w), qs);
    int acc[16];
#pragma unroll
    for (int i = 0; i < 16; ++i) {
        int a = __builtin_amdgcn_sdot4((int)uu[i].x, h0, 0, false);
        a = __builtin_amdgcn_sdot4((int)uu[i].y, h1, a, false);
        a = __builtin_amdgcn_sdot4((int)uu[i].z, h2, a, false);
        a = __builtin_amdgcn_sdot4((int)uu[i].w, h3, a, false);
        a += dpp_movi<DPP_QP_X1>(a);
        a += dpp_movi<DPP_QP_X2>(a);
        a += dpp_movi<DPP_HMIRROR>(a);
        acc[i] = a;
    }
    if (d8 == 0) {
#pragma unroll
        for (int i = 0; i < 16; ++i) (void)__hip_atomic_fetch_add(part + g * 16 + i, acc[i], __ATOMIC_RELAXED, __HIP_MEMORY_SCOPE_WORKGROUP);
    }
}

__device__ __forceinline__ float gelu_erf(float v);

__device__ void phase_peer_dots(const Params& p, char* smem) {
    const int tid = threadIdx.x, lane = tid & 63, w = tid >> 6;
    const int g = lane >> 3, d8 = lane & 7;
    int* part = (int*)smem + w * 2048;
    for (int tgp = blockIdx.x; tgp < NTOK / 128; tgp += gridDim.x) {
        const int tokb = tgp * 128 + w;
        __syncthreads();
        for (int i = lane; i < 2048; i += 64) part[i] = 0;
        __syncthreads();
        const char* ubase = (const char*)p.u_c();
        const unsigned dlo = d8 * 16;
        DotTok ta, tb, tn;
        uint4 ua[16], ubuf[16];
        dotsf_load(p, ta, tokb, 0, g, d8);
        dotsf_load(p, tb, tokb, 1, g, d8);
        PEER_GATHER16(ua, ubase, ta.ia, ta.ib)
        PEER_GATHER16(ubuf, ubase, tb.ia, tb.ib)
        dotsf_load(p, tn, tokb, 2, g, d8);
        for (int s = 0; s < 128; s += 2) {
            dotsf_finish(ua, ta, part + (s & 15) * 128, g, d8);
            if (s + 2 < 128) {
                ta = tn;
                const char* ub = ubase + (size_t)((s + 2) >> 4) * 16384 * 128;
                PEER_GATHER16(ua, ub, ta.ia, ta.ib)
                dotsf_load(p, tn, tokb, min(s + 3, 127), g, d8);
            }
            dotsf_finish(ubuf, tb, part + ((s + 1) & 15) * 128, g, d8);
            if (s + 3 < 128) {
                tb = tn;
                const char* ub = ubase + (size_t)((s + 3) >> 4) * 16384 * 128;
                PEER_GATHER16(ubuf, ub, tb.ia, tb.ib)
                dotsf_load(p, tn, tokb, min(s + 4, 127), g, d8);
            }
        }
        __syncthreads();
        for (int k0 = 0; k0 < 16; k0 += 4) {
            int ps[4][2], e[4][2];
            float gt[4][2], sh[4];
#pragma unroll
            for (int q = 0; q < 4; ++q) {
                const int tok = tokb + 8 * (k0 + q);
                sh[q] = __uint_as_float(p.hmax()[tok]) * (1.0f / 127.0f) * rsqrtf(p.ss1()[tok] * (1.0f / 1024.0f) + EPS);
#pragma unroll
                for (int u = 0; u < 2; ++u) {
                    const int slot = lane + 64 * u;
                    ps[q][u] = part[(k0 + q) * 128 + slot];
                    e[q][u] = p.eidx()[(size_t)tok * 128 + slot];
                    gt[q][u] = p.gate()[(size_t)tok * 128 + slot];
                }
            }
            float su[4][2], sv[4][2];
#pragma unroll
            for (int q = 0; q < 4; ++q)
#pragma unroll
                for (int u = 0; u < 2; ++u) { su[q][u] = p.scale_u()[e[q][u]]; sv[q][u] = p.scale_v()[e[q][u]]; }
#pragma unroll
            for (int q = 0; q < 4; ++q) {
                const int tok = tokb + 8 * (k0 + q);
                float cf[2];
#pragma unroll
                for (int u = 0; u < 2; ++u) cf[u] = gelu_erf((float)ps[q][u] * su[q][u] * sh[q]) * gt[q][u] * sv[q][u];
                const float cm = wave_max(fmaxf(fabsf(cf[0]), fabsf(cf[1])));
                const float qs = cm > 0.f ? 127.0f / cm : 0.f;
                p.coef()[(size_t)tok * 128 + lane] = (signed char)(int)rintf(cf[0] * qs);
                p.coef()[(size_t)tok * 128 + lane + 64] = (signed char)(int)rintf(cf[1] * qs);
                if (lane == 0) p.csum()[tok] = cm * (1.0f / 127.0f);
            }
        }
    }
}

__device__ __forceinline__ float gelu_erf(float v) {
    const float av = fabsf(v);
    const float t = __builtin_amdgcn_rcpf(fmaf(av, 0.2316418882f, 1.0f));
    float q = fmaf(t, 0.5307027145f, -0.7265760135f);
    q = fmaf(q, t, 0.7107068705f);
    q = fmaf(q, t, -0.142248368f);
    q = fmaf(q, t, 0.127414796f);
    q = q * t;
    const float e = __builtin_amdgcn_exp2f(v * v * -0.72134752044f);
    const float m = v * (q * e);
    return v < 0.f ? m : v - m;
}
struct AccTok { uint4 ia, ib; uint4 cq; float cs; };
__device__ __forceinline__ void acc_load(const Params& p, AccTok& t, int tok, int g) {
    const uint4* idp = (const uint4*)(p.eidx() + (size_t)tok * 128 + g * 16);
    t.ia = idp[0]; t.ib = idp[1];
    t.cq = *(const uint4*)(p.coef() + (size_t)tok * 128 + g * 16);
    t.cs = p.csum()[tok];
}
#define PEER_T4DOT(acc, B, r0, r1, r2, r3, cq)                                   \
    {                                                                            \
        const unsigned t0 = __builtin_amdgcn_perm(r1, r0, 0x05010400u), t1 = __builtin_amdgcn_perm(r1, r0, 0x07030602u); \
        const unsigned t2 = __builtin_amdgcn_perm(r3, r2, 0x05010400u), t3 = __builtin_amdgcn_perm(r3, r2, 0x07030602u); \
        acc[(B) + 0] = __builtin_amdgcn_sdot4((int)__builtin_amdgcn_perm(t2, t0, 0x05040100u), (int)(cq), acc[(B) + 0], false); \
        acc[(B) + 1] = __builtin_amdgcn_sdot4((int)__builtin_amdgcn_perm(t2, t0, 0x07060302u), (int)(cq), acc[(B) + 1], false); \
        acc[(B) + 2] = __builtin_amdgcn_sdot4((int)__builtin_amdgcn_perm(t3, t1, 0x05040100u), (int)(cq), acc[(B) + 2], false); \
        acc[(B) + 3] = __builtin_amdgcn_sdot4((int)__builtin_amdgcn_perm(t3, t1, 0x07060302u), (int)(cq), acc[(B) + 3], false); \
    }
__device__ __forceinline__ void accf_finish(const uint4 (&vv)[16], const AccTok& t, char* rowp, int g) {
    const unsigned cw[4] = {t.cq.x, t.cq.y, t.cq.z, t.cq.w};
    int acc[16];
#pragma unroll
    for (int j = 0; j < 16; ++j) acc[j] = 0;
#pragma unroll
    for (int j = 0; j < 4; ++j) {
        PEER_T4DOT(acc, 0, vv[4 * j].x, vv[4 * j + 1].x, vv[4 * j + 2].x, vv[4 * j + 3].x, cw[j])
        PEER_T4DOT(acc, 4, vv[4 * j].y, vv[4 * j + 1].y, vv[4 * j + 2].y, vv[4 * j + 3].y, cw[j])
        PEER_T4DOT(acc, 8, vv[4 * j].z, vv[4 * j + 1].z, vv[4 * j + 2].z, vv[4 * j + 3].z, cw[j])
        PEER_T4DOT(acc, 12, vv[4 * j].w, vv[4 * j + 1].w, vv[4 * j + 2].w, vv[4 * j + 3].w, cw[j])
    }
    int t8[8], u4[4];
#pragma unroll
    for (int j = 0; j < 8; ++j) {
        const auto r = __builtin_amdgcn_permlane32_swap((unsigned)acc[j], (unsigned)acc[j + 8], false, false);
        t8[j] = (int)(r[0] + r[1]);
    }
#pragma unroll
    for (int j = 0; j < 4; ++j) {
        const auto r = __builtin_amdgcn_permlane16_swap((unsigned)t8[j], (unsigned)t8[j + 4], false, false);
        u4[j] = (int)(r[0] + r[1]);
    }
    float o[4];
#pragma unroll
    for (int j = 0; j < 4; ++j) {
        int v = u4[j];
        v += dpp_movi<DPP_ROR8>(v);
        o[j] = (float)v * t.cs;
    }
    if ((g & 1) == 0) {
        const int rho = g >> 1;
        uint2 w0; w0.x = pack2(o[0], o[1]); w0.y = pack2(o[2], o[3]);
        *(uint2*)(rowp + (4 * (rho & 1) + 8 * (rho >> 1)) * 2) = w0;
    }
}

__device__ void phase_peer_accum(const Params& p, char* smem) {
    const int tid = threadIdx.x, lane = tid & 63, w = tid >> 6;
    const int g = lane >> 3, d8 = lane & 7;
    char* rowbuf = smem + w * 16384;
    for (int tgp = blockIdx.x; tgp < NTOK / 64; tgp += gridDim.x) {
        const int tokb = tgp * 64 + w;
        __syncthreads();
        const char* vbase = (const char*)p.v_c();
        const unsigned dlo = d8 * 16;
        AccTok ta, tb, tn;
        uint4 va[16], vbuf[16];
        acc_load(p, ta, tokb, g);
        acc_load(p, tb, tokb + 8, g);
        PEER_GATHER16(va, vbase, ta.ia, ta.ib)
        PEER_GATHER16(vbuf, vbase, tb.ia, tb.ib)
        acc_load(p, tn, tokb + 16, g);
        for (int s = 0; s < 64; s += 2) {
            accf_finish(va, ta, rowbuf + (s & 7) * 2048 + (s >> 3) * 256 + d8 * 32, g);
            if (s + 2 < 64) {
                ta = tn;
                const char* vb = vbase + (size_t)((s + 2) >> 3) * 16384 * 128;
                PEER_GATHER16(va, vb, ta.ia, ta.ib)
                acc_load(p, tn, tokb + 8 * (min(s + 3, 63) & 7), g);
            }
            accf_finish(vbuf, tb, rowbuf + ((s + 1) & 7) * 2048 + ((s + 1) >> 3) * 256 + d8 * 32, g);
            if (s + 3 < 64) {
                tb = tn;
                const char* vb = vbase + (size_t)((s + 3) >> 3) * 16384 * 128;
                PEER_GATHER16(vbuf, vb, tb.ia, tb.ib)
                acc_load(p, tn, tokb + 8 * (min(s + 4, 63) & 7), g);
            }
        }
        __syncthreads();
        for (int k0 = 0; k0 < 8; k0 += 2) {
            float4 v[2][4];
#pragma unroll
            for (int q = 0; q < 2; ++q) {
                const bf16_t* xrow = p.x1b() + (size_t)(tokb + 8 * (k0 + q)) * D;
#pragma unroll
                for (int j = 0; j < 4; ++j) {
                    const uint2 xk = *(const uint2*)(xrow + (j * 64 + lane) * 4);
                    v[q][j] = make_float4(bflo(xk.x), bfhi(xk.x), bflo(xk.y), bfhi(xk.y));
                }
            }
#pragma unroll
            for (int q = 0; q < 2; ++q) {
                float* orow = p.out + (size_t)(tokb + 8 * (k0 + q)) * D;
                const char* prow = rowbuf + (k0 + q) * 2048;
                float ss = 0.f;
#pragma unroll
                for (int j = 0; j < 4; ++j) {
                    const uint2 pk = *(const uint2*)(prow + (j * 64 + lane) * 8);
                    v[q][j].x += bflo(pk.x); v[q][j].y += bfhi(pk.x); v[q][j].z += bflo(pk.y); v[q][j].w += bfhi(pk.y);
                    ss += v[q][j].x * v[q][j].x + v[q][j].y * v[q][j].y + v[q][j].z * v[q][j].z + v[q][j].w * v[q][j].w;
                }
                ss = wave_sum(ss);
                const float rs = rsqrtf(ss * (1.0f / 1024.0f) + EPS);
#pragma unroll
                for (int j = 0; j < 4; ++j) {
                    const float4 gg = *(const float4*)(p.fin_g + (j * 64 + lane) * 4);
                    float4 o;
                    o.x = v[q][j].x * rs * gg.x; o.y = v[q][j].y * rs * gg.y; o.z = v[q][j].z * rs * gg.z; o.w = v[q][j].w * rs * gg.w;
                    *(float4*)(orow + (j * 64 + lane) * 4) = o;
                }
            }
        }
    }
}

#define XB_TMO      128
#define XB_XCNT(j)  (256  + 64 * (j))
#define XB_XSUB(j)  (1280 + 64 * (j))
#define XB_XGEN(j)  (2304 + 64 * (j))
#define XB_TOP      3328
#define XB_TOPGEN   3392
#define XCD_BAR_WORDS 3456
#define XB_SPIN_CAP (1u << 18)
__device__ __forceinline__ unsigned xb_ld(unsigned* p)              { return __hip_atomic_load(p, __ATOMIC_RELAXED, __HIP_MEMORY_SCOPE_AGENT); }
__device__ __forceinline__ unsigned xb_add(unsigned* p, unsigned v) { return __hip_atomic_fetch_add(p, v, __ATOMIC_RELAXED, __HIP_MEMORY_SCOPE_AGENT); }
#define XB_SPIN(cond, bar) do { unsigned _sp = 0; while (cond) { __builtin_amdgcn_s_sleep(1); \
    if ((++_sp & 255u) == 0u) { if (xb_ld(&(bar)[XB_TMO])) break; if (_sp > XB_SPIN_CAP) { atomicAdd(&(bar)[XB_TMO], 1u); break; } } } } while (0)

struct XcdBarrier { unsigned* bar; unsigned x; volatile unsigned* st; };

__device__ __forceinline__ XcdBarrier xcd_barrier_post(unsigned* bar, volatile unsigned* st) {
    XcdBarrier b; b.bar = bar; b.x = xcc_id(); b.st = st;
    if (threadIdx.x == 0) (void)xb_add(&bar[XB_XCNT(b.x)], 1u);
    return b;
}
__device__ __forceinline__ void xcd_barrier_complete(unsigned* bar, unsigned x, unsigned& nloc, unsigned& nx) {
    const unsigned G = gridDim.x * gridDim.y * gridDim.z;
    unsigned sum, cnt, mine, sp = 0u;
    for (;;) {
        sum = 0u; cnt = 0u; mine = 0u;
#pragma unroll
        for (unsigned j = 0; j < 16; ++j) { const unsigned c = xb_ld(&bar[XB_XCNT(j)]); sum += c; cnt += (c > 0u) ? 1u : 0u; mine = (j == x) ? c : mine; }
        if (sum == G) break;
        __builtin_amdgcn_s_sleep(1);
        if ((++sp & 255u) == 0u) { if (xb_ld(&bar[XB_TMO])) break; if (sp > XB_SPIN_CAP) { atomicAdd(&bar[XB_TMO], 1u); break; } }
    }
    nloc = mine > 0u ? mine : 1u; nx = cnt > 0u ? cnt : 1u;
}
__device__ __forceinline__ void xcd_barrier(const XcdBarrier& b) {
    asm volatile("s_waitcnt vmcnt(0)" ::: "memory");
    __syncthreads();
    if (threadIdx.x == 0) {
        unsigned* bar = b.bar;
        __builtin_amdgcn_s_waitcnt(0);
        unsigned nloc = b.st[0], nx = b.st[1];
        if (nloc == 0u) { xcd_barrier_complete(bar, b.x, nloc, nx); b.st[0] = nloc; b.st[1] = nx; }
        const unsigned old = xb_add(&bar[XB_XSUB(b.x)], 1u);
        const unsigned gen = old / nloc;
        if (old + 1u == (gen + 1u) * nloc) {
            __builtin_amdgcn_fence(__ATOMIC_RELEASE, "agent");
            asm volatile("s_waitcnt vmcnt(0)" ::: "memory");
            const unsigned og = xb_add(&bar[XB_TOP], 1u);
            const unsigned tg = og / nx;
            if (og + 1u == (tg + 1u) * nx) xb_add(&bar[XB_TOPGEN], 1u);
            else XB_SPIN(xb_ld(&bar[XB_TOPGEN]) == tg, bar);
            __builtin_amdgcn_fence(__ATOMIC_ACQUIRE, "agent");
            xb_add(&bar[XB_XGEN(b.x)], 1u);
            asm volatile("s_waitcnt vmcnt(0)" ::: "memory");
        } else {
            XB_SPIN(xb_ld(&bar[XB_XGEN(b.x)]) == gen, bar);
            __builtin_amdgcn_fence(__ATOMIC_ACQUIRE, "agent");
            asm volatile("s_waitcnt vmcnt(0)" ::: "memory");
        }
    }
    __syncthreads();
}

#define RUN_PHASE(K, CALL)                                              \
    if (ph_lo <= (K) && (K) < ph_hi) {                                  \
        CALL;                                                           \
        if (COOP) { if ((K) + 1 < ph_hi) { xcd_barrier(xb); } } \
    }

template <bool COOP>
__global__ void __launch_bounds__(512, 2) fwd_kernel(Params p, int ph_lo, int ph_hi) {
    __shared__ __attribute__((aligned(16))) char smem[SMEM_BYTES + 16];
    char* smh = smem + VHB * HALF_SMEM;
    XcdBarrier xb;
    if (COOP) {
        if (threadIdx.x == 0) *(uint4*)(smem + SMEM_BYTES) = make_uint4(0u, 0u, 0u, 0u);
        __syncthreads();
        xb = xcd_barrier_post(p.bar(), (volatile unsigned*)(smem + SMEM_BYTES));
    }
    if (COOP) { if (ph_lo < 0) cg::this_grid().sync(); }
    RUN_PHASE(0, phase_prep(p, smh))
    RUN_PHASE(1, phase_gemm_in(p, smem))
    RUN_PHASE(2, phase_mixers(p, smh))
    RUN_PHASE(3, (phase_gemm_kv(p, smh), phase_hg_scan(p)))
    RUN_PHASE(4, phase_hg_out(p, smh))
    RUN_PHASE(5, phase_gemm_out(p, smem))
    RUN_PHASE(7, phase_gemm_q_route(p, smem))
    RUN_PHASE(10, phase_peer_dots(p, smem))
    RUN_PHASE(12, phase_peer_accum(p, smem))
}

extern "C" void kernel_launch(void* const* d_in, const int* in_sizes, int n_in, void* d_out, int out_size, void* d_ws, size_t ws_size,
                              hipStream_t stream) {
    Params p{};
    p.x = (const float*)d_in[0]; p.mem = (const float*)d_in[1]; p.attn_g = (const float*)d_in[2]; p.w_in = (const float*)d_in[3];
    p.rpb = (const float*)d_in[4]; p.hg_lb = (const float*)d_in[5]; p.hg_g = (const float*)d_in[6]; p.mem_g = (const float*)d_in[7];
    p.w_kv = (const float*)d_in[8]; p.w_out = (const float*)d_in[9]; p.ffn_g = (const float*)d_in[10]; p.w_q = (const float*)d_in[11];
    p.subk = (const float*)d_in[12]; p.pu = (const float*)d_in[13]; p.pv = (const float*)d_in[14]; p.fin_g = (const float*)d_in[15];
    p.out = (float*)d_out;
    p.ws = (char*)d_ws;
    if (WS_TOTAL > ws_size) { fprintf(stderr, "workspace too small: need %zu have %zu\n", (size_t)WS_TOTAL, ws_size); return; }

#if defined(MULTI_LAUNCH)
    for (int ph = 0; ph < NPHASE; ++ph) fwd_kernel<false><<<dim3(512), dim3(512), 0, stream>>>(p, ph, ph + 1);
#else
    static int grid_blocks = 0;
    if (!grid_blocks) {
        int dev = 0, cus = 0, per_cu = 0;
        hipGetDevice(&dev);
        hipDeviceGetAttribute(&cus, hipDeviceAttributeMultiprocessorCount, dev);
        hipOccupancyMaxActiveBlocksPerMultiprocessor(&per_cu, fwd_kernel<true>, 512, 0);
        if (per_cu > 1) per_cu = 1;
        grid_blocks = (cus * per_cu) & ~3;
    }
    (void)hipMemsetAsync((char*)d_ws + OFF_BAR, 0, XCD_BAR_WORDS * 4, stream);
    int lo = 0, hi = NPHASE;
    void* args[] = {&p, &lo, &hi};
    hipError_t e = hipLaunchCooperativeKernel((void*)fwd_kernel<true>, dim3(grid_blocks), dim3(512), args, 0, stream);
    if (e != hipSuccess) fprintf(stderr, "cooperative launch failed: %s (grid %d)\n", hipGetErrorString(e), grid_blocks);
#endif
}
```

```cpp
#include <hip/hip_runtime.h>
#include <hip/hip_cooperative_groups.h>
#include <stdint.h>
#include <cstdio>

namespace cg = cooperative_groups;

#define VTID ((int)(threadIdx.x & 255))
#define VHB ((int)(threadIdx.x >> 8))
#define VBID ((int)(blockIdx.x * 2 + (threadIdx.x >> 8)))
#define VGRID ((int)(gridDim.x * 2))
constexpr int HALF_SMEM = 73728;

typedef unsigned short bf16_t;
typedef short bf16x8 __attribute__((ext_vector_type(8)));
typedef float f32x4 __attribute__((ext_vector_type(4)));
typedef int i32x4 __attribute__((ext_vector_type(4)));

constexpr int D = 1024;
constexpr int NB = 4;
constexpr int T = 8192;
constexpr int NTOK = NB * T;
constexpr int INW = 3072;
constexpr int QW = 2048;
constexpr float EPS = 1e-6f;
constexpr int SMEM_BYTES = 2 * 73728;
constexpr int NPHASE = 14;

constexpr size_t al256(size_t x) { return (x + 255) & ~(size_t)255; }
constexpr size_t OFF_W_IN_T = 0;
constexpr size_t OFF_W_OUT_T = OFF_W_IN_T + al256((size_t)3072 * 1024 * 2);
constexpr size_t OFF_W_Q_T = OFF_W_OUT_T + al256((size_t)1024 * 1024 * 2);
constexpr size_t OFF_W_KV_T = OFF_W_Q_T + al256((size_t)2048 * 1024 * 2);
constexpr size_t OFF_H = OFF_W_KV_T + al256((size_t)512 * 1024 * 2);
constexpr size_t OFF_Z = OFF_H + al256((size_t)32768 * 1024 * 2);
constexpr size_t OFF_MIX = OFF_Z + al256((size_t)32768 * 3072 * 2);
constexpr size_t OFF_MEMN = OFF_MIX + al256((size_t)32768 * 1024 * 2);
constexpr size_t OFF_KVB = OFF_MEMN + al256((size_t)1024 * 1024 * 2);
constexpr size_t OFF_LB = OFF_KVB + al256((size_t)1024 * 512 * 2);
constexpr size_t OFF_HSTATE = OFF_LB + al256(512 * 4);
constexpr size_t OFF_HDEC = OFF_HSTATE + al256((size_t)4096 * 4096 * 4);
constexpr size_t OFF_UC = OFF_HDEC + al256((size_t)4096 * 64 * 4);
constexpr size_t OFF_VC = OFF_UC + al256((size_t)16384 * 1024);
constexpr size_t OFF_QUEUE = OFF_VC + al256((size_t)16384 * 1024);
constexpr size_t OFF_SUBK = OFF_QUEUE + al256(2048 * 4);
constexpr size_t OFF_BAR = OFF_SUBK + al256((size_t)16 * 128 * 128 * 2);
constexpr size_t OFF_SS1 = OFF_BAR + al256(4096 * 4);
constexpr size_t OFF_HMAX = OFF_SS1 + al256((size_t)32768 * 4);
constexpr size_t OFF_CSUM = OFF_HMAX + al256((size_t)32768 * 4);
constexpr size_t OFF_SCALE_U = OFF_CSUM + al256((size_t)32768 * 4);
constexpr size_t OFF_SCALE_V = OFF_SCALE_U + al256(16384 * 4);
constexpr size_t OFF_VT = OFF_SCALE_V + al256(16384 * 4);
constexpr size_t OFF_KVT = OFF_VT + al256((size_t)32768 * 512 * 2);
constexpr size_t OFF_SA = OFF_KVT + al256((size_t)1024 * 256 * 2);
constexpr size_t OFF_SB = OFF_SA + al256((size_t)32768 * 4);
constexpr size_t WS_TOTAL = OFF_SB + al256((size_t)8192 * 4);
constexpr size_t OFF_EIDX = OFF_HSTATE;
constexpr size_t OFF_GATE = OFF_HSTATE + (size_t)32768 * 128 * 4;
constexpr size_t OFF_COEF = OFF_HSTATE + (size_t)32768 * 128 * 8;
constexpr size_t OFF_SS = OFF_HSTATE + (size_t)32768 * 128 * 12;
constexpr size_t OFF_PARTIAL = OFF_Z;
constexpr size_t OFF_PEER_OUT = OFF_Z + (size_t)8 * 32768 * 128 * 4;

struct Params {
    const float *x, *mem, *attn_g, *w_in, *rpb, *hg_lb, *hg_g, *mem_g, *w_kv, *w_out, *ffn_g, *w_q, *subk, *pu, *pv, *fin_g;
    float* out;
    char* ws;
#define WSF(type, name, off) __device__ __forceinline__ type* name() const { return (type*)(ws + (off)); }
    WSF(bf16_t, w_in_t, OFF_W_IN_T) WSF(bf16_t, w_out_t, OFF_W_OUT_T) WSF(bf16_t, w_q_t, OFF_W_Q_T) WSF(bf16_t, w_kv_t, OFF_W_KV_T)
    WSF(bf16_t, h, OFF_H)
    WSF(bf16_t, z, OFF_Z)
    WSF(bf16_t, mix, OFF_MIX)
    WSF(bf16_t, memn, OFF_MEMN)
    WSF(bf16_t, kvb, OFF_KVB)
    WSF(float, lb, OFF_LB)
    WSF(float, hstate, OFF_HSTATE)
    WSF(float, hdec, OFF_HDEC)
    WSF(unsigned short, eidx, OFF_EIDX)
    WSF(float, gate, OFF_GATE)
    WSF(signed char, coef, OFF_COEF)
    WSF(bf16_t, x1b, OFF_PEER_OUT)
    WSF(float, ss, OFF_SS)
    WSF(float, partial, OFF_PARTIAL)
    WSF(bf16_t, u_c, OFF_UC) WSF(bf16_t, v_c, OFF_VC)
    WSF(unsigned, queue, OFF_QUEUE)
    WSF(bf16_t, subk_b, OFF_SUBK)
    WSF(unsigned, bar, OFF_BAR)
    WSF(float, ss1, OFF_SS1) WSF(unsigned, hmax, OFF_HMAX) WSF(float, csum, OFF_CSUM)
    WSF(float, scale_u, OFF_SCALE_U) WSF(float, scale_v, OFF_SCALE_V)
    WSF(bf16_t, vT, OFF_VT)
    WSF(signed char, hq, OFF_H)
    WSF(signed char, w_in_q, OFF_W_IN_T)
    WSF(float, sa, OFF_SA) WSF(float, sb, OFF_SB)
    WSF(bf16_t, kvT, OFF_KVT)
#undef WSF
};

__device__ __forceinline__ float bf2f(bf16_t v) { return __uint_as_float(((unsigned)v) << 16); }
__device__ __forceinline__ bf16_t f2bf(float f) {
    unsigned u = __float_as_uint(f);
    u += 0x7FFFu + ((u >> 16) & 1u);
    return (bf16_t)(u >> 16);
}
__device__ __forceinline__ float bflo(unsigned u) { return __uint_as_float(u << 16); }
__device__ __forceinline__ float bfhi(unsigned u) { return __uint_as_float(u & 0xFFFF0000u); }
typedef __bf16 bf16x2v_t __attribute__((ext_vector_type(2)));
typedef float f32x2v_t __attribute__((ext_vector_type(2)));
__device__ __forceinline__ unsigned pack2(float a, float b) {
    const f32x2v_t v = {a, b};
    return __builtin_bit_cast(unsigned, __builtin_convertvector(v, bf16x2v_t));
}

__device__ __forceinline__ float wave_sum(float v) {
#pragma unroll
    for (int o = 32; o; o >>= 1) v += __shfl_xor(v, o);
    return v;
}
__device__ __forceinline__ float wave_max(float v) {
#pragma unroll
    for (int o = 32; o; o >>= 1) v = fmaxf(v, __shfl_xor(v, o));
    return v;
}


typedef __bf16 bf16x2_t __attribute__((ext_vector_type(2)));
template <int CTRL>
__device__ __forceinline__ float dpp_mov(float v) {
    return __builtin_bit_cast(float, __builtin_amdgcn_update_dpp(0, __builtin_bit_cast(int, v), CTRL, 0xf, 0xf, true));
}
#define DPP_QP_X1 0xB1
#define DPP_QP_X2 0x4E
#define DPP_HMIRROR 0x141
#define DPP_ROR8 0x128
__device__ __forceinline__ unsigned xcc_id() { return (unsigned)__builtin_amdgcn_s_getreg((3 << 11) | 20) & 0xFu; }

__device__ __forceinline__ void transpose_tile(const float* __restrict__ in, bf16_t* __restrict__ out, int K, int N, int tile, char* smem) {
    float* tl = (float*)smem;
    const int ntn = N >> 6;
    const int k0 = (tile / ntn) << 6, n0 = (tile % ntn) << 6;
    const int tid = VTID;
    __syncthreads();
#pragma unroll 4
    for (int i = 0; i < 16; ++i) {
        int idx = tid + 256 * i;
        int r = idx >> 6, c = idx & 63;
        tl[r * 65 + c] = in[(size_t)(k0 + r) * N + n0 + c];
    }
    __syncthreads();
#pragma unroll 4
    for (int i = 0; i < 16; ++i) {
        int idx = tid + 256 * i;
        int r = idx >> 6, c = idx & 63;
        out[(size_t)(n0 + r) * K + k0 + c] = f2bf(tl[c * 65 + r]);
    }
}

__device__ __forceinline__ void rmsnorm_row_bf16(const float* __restrict__ xr, const float* __restrict__ g, bf16_t* __restrict__ o, int lane) {
    float4 v[4];
    float ss = 0.f;
#pragma unroll
    for (int j = 0; j < 4; ++j) {
        v[j] = *(const float4*)(xr + (j * 64 + lane) * 4);
        ss += v[j].x * v[j].x + v[j].y * v[j].y + v[j].z * v[j].z + v[j].w * v[j].w;
    }
    ss = wave_sum(ss);
    const float rs = rsqrtf(ss * (1.0f / 1024.0f) + EPS);
#pragma unroll
    for (int j = 0; j < 4; ++j) {
        const float4 gg = *(const float4*)(g + (j * 64 + lane) * 4);
        uint2 pk;
        pk.x = pack2(v[j].x * rs * gg.x, v[j].y * rs * gg.y);
        pk.y = pack2(v[j].z * rs * gg.z, v[j].w * rs * gg.w);
        *(uint2*)(o + (j * 64 + lane) * 4) = pk;
    }
}

__device__ __forceinline__ void rmsnorm_row_i8(const float* __restrict__ xr, const float* __restrict__ g, signed char* __restrict__ o, float* __restrict__ sa, int lane) {
    float4 v[4];
    float ss = 0.f;
#pragma unroll
    for (int j = 0; j < 4; ++j) {
        v[j] = *(const float4*)(xr + (j * 64 + lane) * 4);
        ss += v[j].x * v[j].x + v[j].y * v[j].y + v[j].z * v[j].z + v[j].w * v[j].w;
    }
    ss = wave_sum(ss);
    const float rs = rsqrtf(ss * (1.0f / 1024.0f) + EPS);
    float am = 0.f;
#pragma unroll
    for (int j = 0; j < 4; ++j) {
        const float4 gg = *(const float4*)(g + (j * 64 + lane) * 4);
        v[j].x *= rs * gg.x; v[j].y *= rs * gg.y; v[j].z *= rs * gg.z; v[j].w *= rs * gg.w;
        am = fmaxf(am, fmaxf(fmaxf(fabsf(v[j].x), fabsf(v[j].y)), fmaxf(fabsf(v[j].z), fabsf(v[j].w))));
    }
    am = wave_max(am);
    const float qs = am > 0.f ? 127.0f / am : 0.f;
    if (lane == 0) *sa = am * (1.0f / 127.0f);
#pragma unroll
    for (int j = 0; j < 4; ++j) {
        const int q0 = (int)rintf(v[j].x * qs), q1 = (int)rintf(v[j].y * qs), q2 = (int)rintf(v[j].z * qs), q3 = (int)rintf(v[j].w * qs);
        *(unsigned*)(o + (j * 64 + lane) * 4) = (unsigned)(q0 & 255) | ((unsigned)(q1 & 255) << 8) | ((unsigned)(q2 & 255) << 16) | ((unsigned)(q3 & 255) << 24);
    }
}
__device__ __forceinline__ void transpose_cols_i8(const float* __restrict__ in, signed char* __restrict__ out, float* __restrict__ sb, int N, int item, char* smem) {
    float* tl = (float*)smem;
    const int n0 = item << 4;
    const int tid = VTID;
    __syncthreads();
    {
        float4 v[16];
#pragma unroll
        for (int i = 0; i < 16; ++i) {
            const int idx = tid + 256 * i;
            v[i] = *(const float4*)(in + (size_t)(idx >> 2) * N + n0 + (idx & 3) * 4);
        }
#pragma unroll
        for (int i = 0; i < 16; ++i) {
            const int idx = tid + 256 * i;
            const int k = idx >> 2, c = (idx & 3) * 4;
            tl[(c + 0) * 1028 + k] = v[i].x; tl[(c + 1) * 1028 + k] = v[i].y; tl[(c + 2) * 1028 + k] = v[i].z; tl[(c + 3) * 1028 + k] = v[i].w;
        }
    }
    __syncthreads();
    float qs;
    {
        const int c = tid >> 4, l = tid & 15;
        float am = 0.f;
#pragma unroll 8
        for (int i = 0; i < 64; ++i) am = fmaxf(am, fabsf(tl[c * 1028 + l + 16 * i]));
        am = fmaxf(am, __shfl_xor(am, 1)); am = fmaxf(am, __shfl_xor(am, 2)); am = fmaxf(am, __shfl_xor(am, 4)); am = fmaxf(am, __shfl_xor(am, 8));
        if (l == 0) sb[n0 + c] = am * (1.0f / 127.0f);
        qs = am > 0.f ? 127.0f / am : 0.f;
    }
    __syncthreads();
    float* qt = tl + 16 * 1028;
    if ((tid & 15) == 0) qt[tid >> 4] = qs;
    __syncthreads();
#pragma unroll
    for (int i = 0; i < 16; ++i) {
        const int kq = tid * 4;
        const float q = qt[i];
        const float4 v = *(const float4*)(tl + i * 1028 + kq);
        const int q0 = (int)rintf(v.x * q), q1 = (int)rintf(v.y * q), q2 = (int)rintf(v.z * q), q3 = (int)rintf(v.w * q);
        *(unsigned*)(out + (size_t)(n0 + i) * 1024 + kq) = (unsigned)(q0 & 255) | ((unsigned)(q1 & 255) << 8) | ((unsigned)(q2 & 255) << 16) | ((unsigned)(q3 & 255) << 24);
    }
}

__device__ void phase_prep(const Params& p, char* smem) {
    const int tid = VTID, lane = tid & 63, w = tid >> 6;
    const int gsz = VGRID, bid = VBID;
    const int t_in = INW / 16;
    const int t_out = 16 * 16;
    const int t_q = 16 * (QW / 64);
    const int t_kv = 16 * 8;
    const int t_all = t_in + t_out + t_q + t_kv;
    for (int it = bid; it < t_all; it += gsz) {
        if (it < t_in) transpose_cols_i8(p.w_in, p.w_in_q(), p.sb(), INW, it, smem);
        else if (it < t_in + t_out) transpose_tile(p.w_out, p.w_out_t(), 1024, 1024, it - t_in, smem);
        else if (it < t_in + t_out + t_q) transpose_tile(p.w_q, p.w_q_t(), 1024, QW, it - t_in - t_out, smem);
        else transpose_tile(p.w_kv, p.w_kv_t(), 1024, 512, it - t_in - t_out - t_q, smem);
    }
    for (int i = bid * 256 + tid; i < NTOK; i += gsz * 256) { p.ss1()[i] = 0.f; p.hmax()[i] = 0u; }
    if (bid == 0) {
        for (int i = tid; i < 512; i += 256) {
            int dir = i >> 8, k = i & 255;
            float a0 = p.hg_lb[(dir * 2 + 0) * 256 + k], a1 = p.hg_lb[(dir * 2 + 1) * 256 + k];
            float m = fmaxf(a0, a1);
            float e0 = expf(a0 - m), e1 = expf(a1 - m);
            p.lb()[i] = e0 / (e0 + e1);
        }
    }
    const int nrows = NTOK + 1024;
    for (int r0 = bid * 4; r0 < nrows; r0 += gsz * 4) {
        int r = r0 + w;
        if (r < NTOK) rmsnorm_row_i8(p.x + (size_t)r * D, p.attn_g, p.hq() + (size_t)r * D, p.sa() + r, lane);
        else if (r < nrows) rmsnorm_row_bf16(p.mem + (size_t)(r - NTOK) * D, p.mem_g, p.memn() + (size_t)(r - NTOK) * D, lane);
    }
    for (int i = bid * 256 + tid; i < 16 * 128 * 128 / 4; i += gsz * 256) {
        const float4 v = *(const float4*)(p.subk + (size_t)i * 4);
        uint2 pk; pk.x = pack2(v.x, v.y); pk.y = pack2(v.z, v.w);
        *(uint2*)(p.subk_b() + (size_t)i * 4) = pk;
    }
    for (int r0 = bid * 4; r0 < 2 * 16384; r0 += gsz * 4) {
        const int r = r0 + w;
        const bool isv = r >= 16384;
        const int e = r & 16383;
        const float* srcp = (isv ? p.pv : p.pu) + (size_t)e * D;
        unsigned* dst = (unsigned*)(isv ? p.v_c() : p.u_c());
        float4 v[4];
        float am = 0.f;
#pragma unroll
        for (int j = 0; j < 4; ++j) {
            v[j] = *(const float4*)(srcp + (j * 64 + lane) * 4);
            am = fmaxf(am, fmaxf(fmaxf(fabsf(v[j].x), fabsf(v[j].y)), fmaxf(fabsf(v[j].z), fabsf(v[j].w))));
        }
        am = wave_max(am);
        const float qs = am > 0.f ? 127.0f / am : 0.f;
        if (lane == 0) (isv ? p.scale_v() : p.scale_u())[e] = am * (1.0f / 127.0f);
        const int off = 0;
#pragma unroll
        for (int j = 0; j < 4; ++j) {
            const int q0 = (int)rintf(v[j].x * qs) + off, q1 = (int)rintf(v[j].y * qs) + off;
            const int q2 = (int)rintf(v[j].z * qs) + off, q3 = (int)rintf(v[j].w * qs) + off;
            const unsigned pk = (unsigned)(q0 & 255) | ((unsigned)(q1 & 255) << 8) | ((unsigned)(q2 & 255) << 16) | ((unsigned)(q3 & 255) << 24);
            const int c = j * 2 + (lane >> 5), d = (lane & 31) * 4;
            dst[(((size_t)c * 16384 + e) * 128 + d) >> 2] = pk;
        }
    }
}

struct EpiBf16 {
    bf16_t* C; int ldc;
    __device__ __forceinline__ void operator()(int row, int col, const f32x4& v) const {
        uint2 pk; pk.x = pack2(v[0], v[1]); pk.y = pack2(v[2], v[3]);
        *(uint2*)(C + (size_t)row * ldc + col) = pk;
    }
};
struct EpiBf16T {
    bf16_t* C; int col0, ncols, rows_per_b;
    __device__ __forceinline__ void operator()(int row, int col, const f32x4& v) const {
        const int bb = row / rows_per_b, rr = row - bb * rows_per_b;
        uint2 pk; pk.x = pack2(v[0], v[1]); pk.y = pack2(v[2], v[3]);
        *(uint2*)(C + ((size_t)bb * ncols + (col - col0)) * rows_per_b + rr) = pk;
    }
};
struct EpiBf16S {
    bf16_t* C; int ldc; const float* sa; const float* sb;
    __device__ __forceinline__ void operator()(int row, int col, const f32x4& v) const {
        const float s = sa[row];
        const float4 b = *(const float4*)(sb + col);
        uint2 pk; pk.x = pack2(v[0] * s * b.x, v[1] * s * b.y); pk.y = pack2(v[2] * s * b.z, v[3] * s * b.w);
        *(uint2*)(C + (size_t)row * ldc + col) = pk;
    }
};
struct EpiBf16TS {
    bf16_t* C; int col0, ncols, rows_per_b; const float* sa; const float* sb;
    __device__ __forceinline__ void operator()(int row, int col, const f32x4& v) const {
        const int bb = row / rows_per_b, rr = row - bb * rows_per_b;
        const float4 a = *(const float4*)(sa + row);
        const float b = sb[col];
        uint2 pk; pk.x = pack2(v[0] * a.x * b, v[1] * a.y * b); pk.y = pack2(v[2] * a.z * b, v[3] * a.w * b);
        *(uint2*)(C + ((size_t)bb * ncols + (col - col0)) * rows_per_b + rr) = pk;
    }
};
struct EpiBf16RowScale {
    bf16_t* C; int ldc; const float* ssrow;
    __device__ __forceinline__ void operator()(int row, int col, const f32x4& v) const {
        const float rs = rsqrtf(ssrow[row] * (1.0f / 1024.0f) + EPS);
        uint2 pk; pk.x = pack2(v[0] * rs, v[1] * rs); pk.y = pack2(v[2] * rs, v[3] * rs);
        *(uint2*)(C + (size_t)row * ldc + col) = pk;
    }
};
struct EpiResNorm {
    bf16_t* C; const float* R; const float* g; bf16_t* H; int ldc; float* ssrow; unsigned* hmax;
    __device__ __forceinline__ void operator()(int row, int col, const f32x4& v, float& ssq, float& am) const {
        const float4 r = *(const float4*)(R + (size_t)row * ldc + col);
        const float4 gg = *(const float4*)(g + col);
        float4 o; o.x = v[0] + r.x; o.y = v[1] + r.y; o.z = v[2] + r.z; o.w = v[3] + r.w;
        { uint2 xk; xk.x = pack2(o.x, o.y); xk.y = pack2(o.z, o.w); *(uint2*)(C + (size_t)row * ldc + col) = xk; }
        const float h0 = o.x * gg.x, h1 = o.y * gg.y, h2 = o.z * gg.z, h3 = o.w * gg.w;
        uint2 pk; pk.x = pack2(h0, h1); pk.y = pack2(h2, h3);
        *(uint2*)(H + (size_t)row * ldc + col) = pk;
        ssq += o.x * o.x + o.y * o.y + o.z * o.z + o.w * o.w;
        am = fmaxf(am, fmaxf(fmaxf(fabsf(h0), fabsf(h1)), fmaxf(fabsf(h2), fabsf(h3))));
    }
    __device__ __forceinline__ void row_done(int row, float ssq, float am) const {
        atomicAdd(ssrow + row, ssq);
        atomicMax(hmax + row, __float_as_uint(am));
    }
};
struct EpiResF32 {
    float* C; const float* R; int ldc;
    __device__ __forceinline__ void operator()(int row, int col, const f32x4& v) const {
        const float4 r = *(const float4*)(R + (size_t)row * ldc + col);
        float4 o; o.x = v[0] + r.x; o.y = v[1] + r.y; o.z = v[2] + r.z; o.w = v[3] + r.w;
        *(float4*)(C + (size_t)row * ldc + col) = o;
    }
};

template <bool TRANS, class Epi, bool ROWSS = false>
__device__ __forceinline__ void gemm_tile(const bf16_t* __restrict__ A, int lda, const bf16_t* __restrict__ Bt, int ldb, int K,
                                          int m0, int n0, char* smem, const Epi& epi, float* ssrow = nullptr) {
    const int tid = VTID, lane = tid & 63, w = tid >> 6, wr = w >> 1, wc = w & 1;
    const int fr = lane & 15, fq = lane >> 4;
    const int srow = lane >> 3, sslot = lane & 7;
    f32x4 acc[4][4];
#pragma unroll
    for (int mi = 0; mi < 4; ++mi)
#pragma unroll
        for (int ni = 0; ni < 4; ++ni) acc[mi][ni] = (f32x4){0.f, 0.f, 0.f, 0.f};
    const int g0 = (sslot ^ (srow >> 1)) * 8, g1 = (sslot ^ (4 + (srow >> 1))) * 8;
    const bf16_t* Ab = A + (size_t)(m0 + w * 32 + srow) * lda;
    const bf16_t* Bb = Bt + (size_t)(n0 + w * 32 + srow) * ldb;
    const int nk = K >> 6;
    __syncthreads();
#define GEMM_STAGE(kt, buf)                                                                                                  \
    do {                                                                                                                     \
        char* sa = smem + (buf) * 32768 + w * 4096;                                                                          \
        char* sb = sa + 16384;                                                                                               \
        _Pragma("unroll") for (int i = 0; i < 4; ++i) {                                                                      \
            const int gc = (i & 1) ? g1 : g0;                                                                                \
            __builtin_amdgcn_global_load_lds((const unsigned*)(Ab + (size_t)(i * 8) * lda + (kt) * 64 + gc), (unsigned*)(sa + i * 1024), 16, 0, 0); \
            __builtin_amdgcn_global_load_lds((const unsigned*)(Bb + (size_t)(i * 8) * ldb + (kt) * 64 + gc), (unsigned*)(sb + i * 1024), 16, 0, 0); \
        }                                                                                                                    \
    } while (0)
    GEMM_STAGE(0, 0);
    const int key = fr >> 1;
    for (int kt = 0; kt < nk; ++kt) {
        asm volatile("s_waitcnt vmcnt(0)" ::: "memory");
        __syncthreads();
        if (kt + 1 < nk) GEMM_STAGE(kt + 1, (kt + 1) & 1);
        const char* sa = smem + (kt & 1) * 32768;
        const char* sb = sa + 16384;
#pragma unroll
        for (int ks = 0; ks < 2; ++ks) {
            bf16x8 af[4], bfr[4];
            const int co = ((ks * 4 + fq) ^ key) << 4;
#pragma unroll
            for (int mi = 0; mi < 4; ++mi) af[mi] = *(const bf16x8*)(sa + (wr * 64 + mi * 16 + fr) * 128 + co);
#pragma unroll
            for (int ni = 0; ni < 4; ++ni) bfr[ni] = *(const bf16x8*)(sb + (wc * 64 + ni * 16 + fr) * 128 + co);
#pragma unroll
            for (int mi = 0; mi < 4; ++mi)
#pragma unroll
                for (int ni = 0; ni < 4; ++ni)
                    acc[mi][ni] = TRANS ? __builtin_amdgcn_mfma_f32_16x16x32_bf16(af[mi], bfr[ni], acc[mi][ni], 0, 0, 0)
                                        : __builtin_amdgcn_mfma_f32_16x16x32_bf16(bfr[ni], af[mi], acc[mi][ni], 0, 0, 0);
        }
    }
#undef GEMM_STAGE
    if constexpr (ROWSS) {
#pragma unroll
        for (int mi = 0; mi < 4; ++mi) {
            const int row = m0 + wr * 64 + mi * 16 + fr;
            float ssq = 0.f, am = 0.f;
#pragma unroll
            for (int ni = 0; ni < 4; ++ni) epi(row, n0 + wc * 64 + ni * 16 + fq * 4, acc[mi][ni], ssq, am);
            ssq += __shfl_xor(ssq, 16);
            ssq += __shfl_xor(ssq, 32);
            am = fmaxf(am, __shfl_xor(am, 16));
            am = fmaxf(am, __shfl_xor(am, 32));
            if (fq == 0) epi.row_done(row, ssq, am);
        }
    } else {
#pragma unroll
        for (int mi = 0; mi < 4; ++mi)
#pragma unroll
            for (int ni = 0; ni < 4; ++ni) {
                if (TRANS) epi(m0 + wr * 64 + mi * 16 + fq * 4, n0 + wc * 64 + ni * 16 + fr, acc[mi][ni]);
                else epi(m0 + wr * 64 + mi * 16 + fr, n0 + wc * 64 + ni * 16 + fq * 4, acc[mi][ni]);
            }
    }
}


namespace g8 {
constexpr int BM = 256, BK = 64, HALF = 128, HT = HALF * BK;
__device__ __forceinline__ int lds_byte(int r, int c) {
    const int st = (r >> 4) * 2 + (c >> 5), rr = r & 15, cc = c & 31, ob = rr * 64 + cc * 2;
    return st * 1024 + (ob ^ (((ob >> 9) & 1) << 5));
}
__device__ __forceinline__ void stage_rc(int b, int& R, int& C) {
    const int st = b / 1024, sb = b % 1024, swz = sb ^ (((sb >> 9) & 1) << 5);
    R = (st >> 1) * 16 + swz / 64; C = (st & 1) * 32 + (swz % 64) / 2;
}
__device__ __forceinline__ void tile_of(int L, int nM, int nN, int& pm, int& pn) {
    const int nwg = nM * nN;
    int wgid = L;
    { const int q = nwg / 8, r = nwg % 8, xcd = wgid % 8, off = wgid / 8; wgid = (xcd < r ? xcd * (q + 1) : r * (q + 1) + (xcd - r) * q) + off; }
    const int nig = 8 * nN, gid = wgid / nig, fm = gid * 8, gsz = (nM - fm) < 8 ? (nM - fm) : 8;
    pm = fm + ((wgid % nig) % gsz); pn = (wgid % nig) / gsz;
}
}

#define G8_LAS __attribute__((address_space(3)))
template <bool I8, bool TRANS, class Acc>
__device__ __forceinline__ void g8_mma(Acc& c, const bf16x8& a, const bf16x8& b) {
    if constexpr (I8) {
        const i32x4 ai = __builtin_bit_cast(i32x4, a), bi = __builtin_bit_cast(i32x4, b);
        c = TRANS ? __builtin_amdgcn_mfma_i32_16x16x64_i8(ai, bi, c, 0, 0, 0) : __builtin_amdgcn_mfma_i32_16x16x64_i8(bi, ai, c, 0, 0, 0);
    } else {
        c = TRANS ? __builtin_amdgcn_mfma_f32_16x16x32_bf16(a, b, c, 0, 0, 0) : __builtin_amdgcn_mfma_f32_16x16x32_bf16(b, a, c, 0, 0, 0);
    }
}
template <bool I8> struct g8_acc { using type = f32x4; };
template <> struct g8_acc<true> { using type = i32x4; };
template <bool I8, class Acc> __device__ __forceinline__ f32x4 g8_cvt(const Acc& a) {
    if constexpr (I8) return (f32x4){(float)a[0], (float)a[1], (float)a[2], (float)a[3]};
    else return a;
}
template <bool TRANS, bool ROWSS, bool I8, class Epi>
__device__ __forceinline__ void gemm256_tile(const void* __restrict__ A, const void* __restrict__ Bt, int K, int brow, int bcol,
                                             char* shmc, const Epi& epi) {
    using namespace g8;
    constexpr int ES = I8 ? 1 : 2;
    using acc_t = typename g8_acc<I8>::type;
    G8_LAS unsigned char* lds = (G8_LAS unsigned char*)shmc;
    const int tid = threadIdx.x, wid = __builtin_amdgcn_readfirstlane(tid >> 6), lane = tid & 63, wr = wid >> 2, wc = wid & 3, fr = lane & 15, fq = lane >> 4;
    constexpr int HTB = HALF * BK * 2;
    unsigned voff[2];
#pragma unroll
    for (int i = 0; i < 2; ++i) { int R, C; stage_rc(tid * 16 + i * 8192, R, C); voff[i] = (unsigned)(R * K * ES + C * 2); }
    const size_t kstep = (size_t)(BK * 2);
    const size_t hstep = (size_t)HALF * K * ES;
    const unsigned ldsw = (unsigned)wid * 1024u;
    const int aoff = lds_byte(wr * 64 + fr, fq * 8), boff = lds_byte(wc * 32 + fr, fq * 8);
    const char* cA = (const char*)A + (size_t)brow * K * ES;
    const char* cB = (const char*)Bt + (size_t)bcol * K * ES;
#define G8_SA(b, h) (((b) * 2 + (h)) * HTB)
#define G8_SB(b, h) ((4 + (b) * 2 + (h)) * HTB)
#define G8_STAGE(bufoff, gbase) do { _Pragma("unroll") for (int _i = 0; _i < 2; ++_i) \
        __builtin_amdgcn_global_load_lds((const unsigned*)((const char*)(gbase) + voff[_i]), (G8_LAS unsigned*)(lds + (bufoff) + ldsw + _i * 8192), 16, 0, 0); } while (0)
#define G8_LDA(dst, b, h) do { _Pragma("unroll") for (int m = 0; m < 4; ++m) _Pragma("unroll") for (int k = 0; k < 2; ++k) dst[m][k] = *(const G8_LAS bf16x8*)(lds + G8_SA(b, h) + aoff + m * 2048 + k * 1024); } while (0)
#define G8_LDB(dst, b, h) do { _Pragma("unroll") for (int n = 0; n < 2; ++n) _Pragma("unroll") for (int k = 0; k < 2; ++k) dst[n][k] = *(const G8_LAS bf16x8*)(lds + G8_SB(b, h) + boff + n * 2048 + k * 1024); } while (0)
#define G8_MMA(ai, bj, At_, Bt_) do { __builtin_amdgcn_s_setprio(1); _Pragma("unroll") for (int m = 0; m < 4; ++m) _Pragma("unroll") for (int n = 0; n < 2; ++n) _Pragma("unroll") for (int k = 0; k < 2; ++k) \
        g8_mma<I8, TRANS>(acc[ai][bj][m][n], At_[m][k], Bt_[n][k]); \
        __builtin_amdgcn_s_setprio(0); } while (0)
#define G8_WAIT_V(n) asm volatile("s_waitcnt vmcnt(" #n ")" ::: "memory")
#define G8_WAIT_L(n) asm volatile("s_waitcnt lgkmcnt(" #n ")" ::: "memory")
#define G8_BAR __builtin_amdgcn_s_barrier()
#define G8_SCHED __builtin_amdgcn_sched_barrier(0)
    acc_t acc[2][2][4][2];
#pragma unroll
    for (int a = 0; a < 2; ++a)
#pragma unroll
        for (int b = 0; b < 2; ++b)
#pragma unroll
            for (int m = 0; m < 4; ++m)
#pragma unroll
                for (int n = 0; n < 2; ++n) acc[a][b][m][n] = (acc_t){0, 0, 0, 0};
    bf16x8 At[4][2], B0[2][2], B1[2][2];
    const int nt = K * ES / (BK * 2);
    __syncthreads();
    G8_STAGE(G8_SB(0, 0), cB); G8_STAGE(G8_SA(0, 0), cA); G8_STAGE(G8_SB(0, 1), cB + hstep); G8_STAGE(G8_SA(0, 1), cA + hstep);
    if (wr == 1) G8_BAR;
    G8_WAIT_V(4); G8_BAR;
    G8_STAGE(G8_SB(1, 0), cB + kstep); G8_STAGE(G8_SA(1, 0), cA + kstep); G8_STAGE(G8_SB(1, 1), cB + hstep + kstep);
    G8_WAIT_V(6); G8_BAR;
    for (int t = 0; t < nt - 2; t += 2) {
        const char* a1 = cA + (size_t)(t + 1) * kstep; const char* a2 = a1 + kstep; const char* a3 = a2 + kstep;
        const char* b2 = cB + (size_t)(t + 2) * kstep; const char* b3 = b2 + kstep;
        G8_LDB(B0, 0, 0); G8_SCHED; G8_LDA(At, 0, 0); G8_STAGE(G8_SA(1, 1), a1 + hstep);
        G8_WAIT_L(8); G8_BAR; G8_WAIT_L(0); G8_MMA(0, 0, At, B0); G8_BAR; G8_SCHED;
        G8_LDB(B1, 0, 1); G8_STAGE(G8_SB(0, 0), b2);
        G8_BAR; G8_WAIT_L(0); G8_MMA(0, 1, At, B1); G8_BAR;
        G8_LDA(At, 0, 1); G8_STAGE(G8_SA(0, 0), a2);
        G8_BAR; G8_WAIT_L(0); G8_MMA(1, 0, At, B0); G8_BAR; G8_SCHED;
        G8_STAGE(G8_SB(0, 1), b2 + hstep);
        G8_WAIT_V(6); G8_BAR; G8_MMA(1, 1, At, B1); G8_BAR;
        G8_LDB(B0, 1, 0); G8_SCHED; G8_LDA(At, 1, 0); G8_STAGE(G8_SA(0, 1), a2 + hstep);
        G8_WAIT_L(8); G8_BAR; G8_WAIT_L(0); G8_MMA(0, 0, At, B0); G8_BAR; G8_SCHED;
        G8_LDB(B1, 1, 1); G8_STAGE(G8_SB(1, 0), b3);
        G8_BAR; G8_WAIT_L(0); G8_MMA(0, 1, At, B1); G8_BAR;
        G8_LDA(At, 1, 1); G8_STAGE(G8_SA(1, 0), a3);
        G8_BAR; G8_WAIT_L(0); G8_MMA(1, 0, At, B0); G8_BAR; G8_SCHED;
        G8_STAGE(G8_SB(1, 1), b3 + hstep);
        G8_WAIT_V(6); G8_BAR; G8_MMA(1, 1, At, B1); G8_BAR;
    }
    { G8_LDB(B0, 0, 0); G8_LDA(At, 0, 0); G8_STAGE(G8_SA(1, 1), cA + (size_t)(nt - 1) * kstep + hstep);
      G8_BAR; G8_WAIT_L(0); G8_MMA(0, 0, At, B0); G8_BAR;
      G8_LDB(B1, 0, 1); G8_BAR; G8_WAIT_L(0); G8_MMA(0, 1, At, B1); G8_BAR;
      G8_LDA(At, 0, 1); G8_WAIT_V(4); G8_BAR; G8_WAIT_L(0); G8_MMA(1, 0, At, B0); G8_MMA(1, 1, At, B1); G8_BAR; }
    { G8_LDB(B0, 1, 0); G8_LDA(At, 1, 0); G8_WAIT_V(2); G8_BAR; G8_WAIT_L(0); G8_MMA(0, 0, At, B0); G8_BAR;
      G8_LDB(B1, 1, 1); G8_WAIT_V(0); G8_BAR; G8_WAIT_L(0); G8_MMA(0, 1, At, B1); G8_BAR;
      G8_LDA(At, 1, 1); G8_BAR; G8_WAIT_L(0); G8_MMA(1, 0, At, B0); G8_MMA(1, 1, At, B1); G8_BAR; }
    if (wr == 0) G8_BAR;
    if constexpr (ROWSS) {
#pragma unroll
        for (int ai = 0; ai < 2; ++ai)
#pragma unroll
            for (int m = 0; m < 4; ++m) {
                const int row = brow + ai * HALF + wr * 64 + m * 16 + fr;
                float ssq = 0.f, am = 0.f;
#pragma unroll
                for (int bj = 0; bj < 2; ++bj)
#pragma unroll
                    for (int n = 0; n < 2; ++n) epi(row, bcol + bj * HALF + wc * 32 + n * 16 + fq * 4, g8_cvt<I8>(acc[ai][bj][m][n]), ssq, am);
                ssq += __shfl_xor(ssq, 16);
                ssq += __shfl_xor(ssq, 32);
                am = fmaxf(am, __shfl_xor(am, 16));
                am = fmaxf(am, __shfl_xor(am, 32));
                if (fq == 0) epi.row_done(row, ssq, am);
            }
    } else {
#pragma unroll
        for (int ai = 0; ai < 2; ++ai)
#pragma unroll
            for (int bj = 0; bj < 2; ++bj)
#pragma unroll
                for (int m = 0; m < 4; ++m)
#pragma unroll
                    for (int n = 0; n < 2; ++n) {
                        if (TRANS) epi(brow + ai * HALF + wr * 64 + m * 16 + fq * 4, bcol + bj * HALF + wc * 32 + n * 16 + fr, g8_cvt<I8>(acc[ai][bj][m][n]));
                        else epi(brow + ai * HALF + wr * 64 + m * 16 + fr, bcol + bj * HALF + wc * 32 + n * 16 + fq * 4, g8_cvt<I8>(acc[ai][bj][m][n]));
                    }
    }
#undef G8_SA
#undef G8_SB
#undef G8_STAGE
#undef G8_LDA
#undef G8_LDB
#undef G8_MMA
#undef G8_WAIT_V
#undef G8_WAIT_L
#undef G8_BAR
#undef G8_SCHED
}

__device__ void phase_gemm_in(const Params& p, char* smem) {
    const int nM = NTOK / 256, nN = INW / 256;
    EpiBf16S e1{p.z(), INW, p.sa(), p.sb()};
    EpiBf16TS e1t{p.vT(), 1024, 512, T, p.sa(), p.sb()};
    for (int i = 0; i * (int)gridDim.x + (int)blockIdx.x < nM * nN; ++i) {
        int pm, pn;
        g8::tile_of(i * gridDim.x + blockIdx.x, nM, nN, pm, pn);
        if (pn >= 4 && pn < 6) gemm256_tile<true, false, true>(p.hq(), p.w_in_q(), D, pm * 256, pn * 256, smem, e1t);
        else gemm256_tile<false, false, true>(p.hq(), p.w_in_q(), D, pm * 256, pn * 256, smem, e1);
    }
}

__device__ void phase_gemm_kv(const Params& p, char* smh) {
    EpiBf16 e2{p.kvb(), 512};
    EpiBf16T e2t{p.kvT(), 256, 256, 256};
    const bool dedicated = gridDim.x >= 64;
    if (dedicated && blockIdx.x >= 16) return;
    for (int it = VBID; it < 32; it += dedicated ? 32 : VGRID) {
        const int pm = it >> 2, pn = it & 3;
        if (pn >= 2) gemm_tile<true>(p.memn(), D, p.w_kv_t(), D, D, pm * 128, pn * 128, smh, e2t);
        else gemm_tile<false>(p.memn(), D, p.w_kv_t(), D, D, pm * 128, pn * 128, smh, e2);
    }
}

__device__ void phase_gemm_out(const Params& p, char* smem) {
    const int nM = NTOK / 256, nN = D / 256;
    EpiResNorm e{p.x1b(), p.x, p.ffn_g, p.h(), D, p.ss1(), p.hmax()};
    for (int i = 0; i * (int)gridDim.x + (int)blockIdx.x < nM * nN; ++i) {
        int pm, pn;
        g8::tile_of(i * gridDim.x + blockIdx.x, nM, nN, pm, pn);
        gemm256_tile<false, true, false>(p.mix(), p.w_out_t(), D, pm * 256, pn * 256, smem, e);
    }
}

__device__ void phase_gemm_q(const Params& p, char* smem) {
    const int nM = NTOK / 256, nN = QW / 256;
    EpiBf16RowScale e{p.z(), QW, p.ss1()};
    for (int i = 0; i * (int)gridDim.x + (int)blockIdx.x < nM * nN; ++i) {
        int pm, pn;
        g8::tile_of(i * gridDim.x + blockIdx.x, nM, nN, pm, pn);
        gemm256_tile<false, false, false>(p.h(), p.w_q_t(), D, pm * 256, pn * 256, smem, e);
    }
}

typedef float f32x16 __attribute__((ext_vector_type(16)));
constexpr int HRS = 144;
__device__ __forceinline__ f32x16 tile_mm64(const char* X, const char* Y, int xrow0, int yrow0, int lane, f32x16 acc) {
    const int r = lane & 31, hh = lane >> 5;
#pragma unroll
    for (int ks = 0; ks < 4; ++ks) {
        const bf16x8 a = *(const bf16x8*)(X + (xrow0 + r) * HRS + ks * 32 + hh * 16);
        const bf16x8 b = *(const bf16x8*)(Y + (yrow0 + r) * HRS + ks * 32 + hh * 16);
        acc = __builtin_amdgcn_mfma_f32_32x32x16_bf16(a, b, acc, 0, 0, 0);
    }
    return acc;
}
__device__ __forceinline__ int crow(int reg, int hh) { return (reg & 3) + 8 * (reg >> 2) + 4 * hh; }

__device__ __forceinline__ void hg_load_vt(const Params& p, char* sVT, int tok0, int h, int kcol, int sq) {
    const bf16_t* zp = p.z() + (size_t)(tok0 + sq * 16) * INW + 2304 + h * 64 + kcol;
    unsigned pk[8];
#pragma unroll
    for (int j = 0; j < 8; ++j) {
        const unsigned lo = zp[(size_t)(2 * j) * INW], hi = zp[(size_t)(2 * j + 1) * INW];
        pk[j] = lo | (hi << 16);
    }
    *(uint4*)(sVT + kcol * HRS + sq * 32) = make_uint4(pk[0], pk[1], pk[2], pk[3]);
    *(uint4*)(sVT + kcol * HRS + sq * 32 + 16) = make_uint4(pk[4], pk[5], pk[6], pk[7]);
}

__device__ __forceinline__ float hg_gates(const Params& p, float* sTot, int tok0, int h, int dir, int kcol, int sq, float (&bj)[16], float (&kk)[16]) {
    const bf16_t* zp = p.z() + (size_t)(tok0 + sq * 16) * INW + 1792 + dir * 256 + h * 64 + kcol;
    const float lbv = p.lb()[dir * 256 + h * 64 + kcol];
#pragma unroll
    for (int j = 0; j < 16; ++j) {
        const float pre = bf2f(zp[(size_t)j * INW]);
        const float f = lbv + (1.0f - lbv) * (1.0f / (1.0f + __expf(-pre)));
        bj[j] = __logf(f);
        kk[j] = 1.0f - f;
    }
    if (dir == 0) {
#pragma unroll
        for (int j = 1; j < 16; ++j) bj[j] += bj[j - 1];
        sTot[sq * 64 + kcol] = bj[15];
    } else {
#pragma unroll
        for (int j = 14; j >= 0; --j) bj[j] += bj[j + 1];
        sTot[sq * 64 + kcol] = bj[0];
    }
    __syncthreads();
    const float t0 = sTot[kcol], t1 = sTot[64 + kcol], t2 = sTot[128 + kcol], t3 = sTot[192 + kcol];
    float off;
    if (dir == 0) off = (sq > 0 ? t0 : 0.f) + (sq > 1 ? t1 : 0.f) + (sq > 2 ? t2 : 0.f);
    else off = (sq < 3 ? t3 : 0.f) + (sq < 2 ? t2 : 0.f) + (sq < 1 ? t1 : 0.f);
#pragma unroll
    for (int j = 0; j < 16; ++j) bj[j] += off;
    return t0 + t1 + t2 + t3;
}

__device__ void hg_local(const Params& p, char* smem) {
    char* sVT = smem;
    char* sKT = smem + 9216;
    float* sTot = (float*)(smem + 18432);
    const int tid = VTID, lane = tid & 63, w = tid >> 6;
    const int kcol = tid & 63, sq = tid >> 6;
    for (int item = VBID; item < 4096; item += VGRID) {
        const int c = item & 127, dir = (item >> 7) & 1, h = (item >> 8) & 3, b = item >> 10;
        const int tok0 = b * T + c * 64;
        __syncthreads();
        hg_load_vt(p, sVT, tok0, h, kcol, sq);
        float bj[16], kk[16];
        const float btot = hg_gates(p, sTot, tok0, h, dir, kcol, sq, bj, kk);
        unsigned pk[8];
#pragma unroll
        for (int j = 0; j < 8; ++j)
            pk[j] = pack2(kk[2 * j] * __expf(btot - bj[2 * j]), kk[2 * j + 1] * __expf(btot - bj[2 * j + 1]));
        *(uint4*)(sKT + kcol * HRS + sq * 32) = make_uint4(pk[0], pk[1], pk[2], pk[3]);
        *(uint4*)(sKT + kcol * HRS + sq * 32 + 16) = make_uint4(pk[4], pk[5], pk[6], pk[7]);
        if (sq == 0) p.hdec()[item * 64 + kcol] = __expf(btot);
        __syncthreads();
        const int vi = w >> 1, ki = w & 1, hh = lane >> 5;
        f32x16 acc;
#pragma unroll
        for (int r = 0; r < 16; ++r) acc[r] = 0.f;
        acc = tile_mm64(sVT, sKT, vi * 32, ki * 32, lane, acc);
        bf16_t* dst = (bf16_t*)p.hstate() + (size_t)item * 4096 + ki * 32 + (lane & 31);
#pragma unroll
        for (int r = 0; r < 16; ++r) dst[(vi * 32 + crow(r, hh)) * 64] = f2bf(acc[r]);
    }
}

__device__ __forceinline__ bf16x8 pack8(const f32x16& x, int s8) {
    typedef unsigned u32x4_t __attribute__((ext_vector_type(4)));
    u32x4_t pk;
    pk[0] = pack2(x[s8], x[s8 + 1]); pk[1] = pack2(x[s8 + 2], x[s8 + 3]);
    pk[2] = pack2(x[s8 + 4], x[s8 + 5]); pk[3] = pack2(x[s8 + 6], x[s8 + 7]);
    return __builtin_bit_cast(bf16x8, pk);
}
__device__ __forceinline__ bf16x8 join8(const uint2& lo, const uint2& hi) {
    typedef unsigned u32x4_t __attribute__((ext_vector_type(4)));
    u32x4_t pk; pk[0] = lo.x; pk[1] = lo.y; pk[2] = hi.x; pk[3] = hi.y;
    return __builtin_bit_cast(bf16x8, pk);
}

__device__ __forceinline__ int swap23(int r) { return (r & ~12) | ((r & 4) << 1) | ((r & 8) >> 1); }

__device__ __forceinline__ void mem_attn_wave(const Params& p, int wu, int lane) {
    const int tile = wu & 255, h = (wu >> 8) & 3, b = wu >> 10;
    const int l31 = lane & 31, hh = lane >> 5;
    const int tok = b * T + tile * 32 + l31;
    bf16x8 qf[4];
#pragma unroll
    for (int ks = 0; ks < 4; ++ks) qf[ks] = *(const bf16x8*)(p.z() + (size_t)tok * INW + 2816 + h * 64 + ks * 16 + hh * 8);
    const bf16_t* kb = p.kvb() + (size_t)(b * 256 + swap23(l31)) * 512 + h * 64 + hh * 8;
    float m = -1e30f;
    f32x16 o0, o1;
#pragma unroll
    for (int r = 0; r < 16; ++r) { o0[r] = 0.f; o1[r] = 0.f; }
    float sum = 0.f;
    const bf16_t* vt = p.kvT() + ((size_t)(b * 4 + h) * 64 + l31) * 256 + 8 * hh;
    bf16x8 kf[4], vf[4];
#pragma unroll
    for (int ks = 0; ks < 4; ++ks) kf[ks] = *(const bf16x8*)(kb + ks * 16);
#pragma unroll
    for (int st = 0; st < 2; ++st) { vf[2 * st] = *(const bf16x8*)(vt + st * 16); vf[2 * st + 1] = *(const bf16x8*)(vt + 32 * 256 + st * 16); }
    for (int kt = 0; kt < 8; ++kt) {
        const int ktn = min(kt + 1, 7);
        bf16x8 kn[4], vn[4];
#pragma unroll
        for (int ks = 0; ks < 4; ++ks) kn[ks] = *(const bf16x8*)(kb + (size_t)ktn * 32 * 512 + ks * 16);
#pragma unroll
        for (int st = 0; st < 2; ++st) { vn[2 * st] = *(const bf16x8*)(vt + ktn * 32 + st * 16); vn[2 * st + 1] = *(const bf16x8*)(vt + 32 * 256 + ktn * 32 + st * 16); }
        f32x16 s;
#pragma unroll
        for (int r = 0; r < 16; ++r) s[r] = 0.f;
#pragma unroll
        for (int ks = 0; ks < 4; ++ks) s = __builtin_amdgcn_mfma_f32_32x32x16_bf16(kf[ks], qf[ks], s, 0, 0, 0);
        float tm = s[0];
#pragma unroll
        for (int r = 1; r < 16; ++r) tm = fmaxf(tm, s[r]);
        tm = fmaxf(tm, __shfl_xor(tm, 32));
        const float mn = fmaxf(m, tm);
        if (__any(mn > m)) {
            const float sc = __builtin_amdgcn_exp2f((m - mn) * 0.18033688011112042f);
            sum *= sc;
#pragma unroll
            for (int r = 0; r < 16; ++r) { o0[r] *= sc; o1[r] *= sc; }
        }
        m = mn;
        const float mb = mn * 0.18033688011112042f;
#pragma unroll
        for (int r = 0; r < 16; ++r) { s[r] = __builtin_amdgcn_exp2f(fmaf(s[r], 0.18033688011112042f, -mb)); sum += s[r]; }
#pragma unroll
        for (int st = 0; st < 2; ++st) {
            const bf16x8 pb = pack8(s, st * 8);
            o0 = __builtin_amdgcn_mfma_f32_32x32x16_bf16(vf[2 * st], pb, o0, 0, 0, 0);
            o1 = __builtin_amdgcn_mfma_f32_32x32x16_bf16(vf[2 * st + 1], pb, o1, 0, 0, 0);
        }
#pragma unroll
        for (int ks = 0; ks < 4; ++ks) kf[ks] = kn[ks];
#pragma unroll
        for (int q = 0; q < 4; ++q) vf[q] = vn[q];
    }
    sum += __shfl_xor(sum, 32);
    const float inv = 1.0f / sum;
    bf16_t* mo = p.mix() + (size_t)tok * D + 768 + h * 64 + 4 * hh;
#pragma unroll
    for (int g = 0; g < 4; ++g) {
        uint2 pk;
        pk.x = pack2(o0[4 * g] * inv, o0[4 * g + 1] * inv); pk.y = pack2(o0[4 * g + 2] * inv, o0[4 * g + 3] * inv);
        *(uint2*)(mo + 8 * g) = pk;
        pk.x = pack2(o1[4 * g] * inv, o1[4 * g + 1] * inv); pk.y = pack2(o1[4 * g + 2] * inv, o1[4 * g + 3] * inv);
        *(uint2*)(mo + 32 + 8 * g) = pk;
    }
}

struct NaCtx {
    const bf16_t* kbase; const bf16_t* vbase; const float* bh;
    int rs, r, c, c0, cb, hh;
    bf16x8 qf[4];
    float m, sum;
    f32x16 o0, o1;
};
template <int TI>
__device__ __forceinline__ void na_load(const NaCtx& x, bf16x8 (&kf)[4], bf16x8 (&vf)[4]) {
    constexpr int ip = TI / 3, cg = TI % 3;
    const bf16_t* kp = x.kbase + (size_t)(ip * 128 + cg * 16) * INW;
#pragma unroll
    for (int ks = 0; ks < 4; ++ks) kf[ks] = *(const bf16x8*)(kp + ks * 16);
    const bf16_t* vr = x.vbase + ip * 128 + cg * 16;
#pragma unroll
    for (int st = 0; st < 2; ++st) { vf[2 * st] = *(const bf16x8*)(vr + st * 64); vf[2 * st + 1] = *(const bf16x8*)(vr + (size_t)32 * T + st * 64); }
}
template <int TI>
__device__ __forceinline__ void na_comp(NaCtx& x, const bf16x8 (&kf)[4], const bf16x8 (&vf)[4]) {
    constexpr int ip = TI / 3, cg = TI % 3;
    f32x16 s;
#pragma unroll
    for (int q = 0; q < 16; ++q) s[q] = 0.f;
#pragma unroll
    for (int ks = 0; ks < 4; ++ks) s = __builtin_amdgcn_mfma_f32_32x32x16_bf16(kf[ks], x.qf[ks], s, 0, 0, 0);
    const int kc0 = x.cb + 16 * cg + 8 * x.hh;
    const float* brow = x.bh + (x.rs + 2 * ip - x.r + 7) * 31 + 15 - x.c + kc0;
    const int d0 = kc0 - x.c0;
    float tm = -1e30f;
    float bv[16];
#pragma unroll
    for (int q = 0; q < 16; ++q) bv[q] = brow[(q & 3) + 4 * ((q >> 2) & 1) + 31 * (q >> 3)];
#pragma unroll
    for (int q = 0; q < 16; ++q) asm volatile("" : "+v"(bv[q]));
#pragma unroll
    for (int q = 0; q < 16; ++q) {
        const int cq = (q & 3) + 4 * ((q >> 2) & 1);
        const bool valid = (unsigned)(d0 + cq) < 16u;
        const float sc = valid ? fmaf(s[q], 0.18033688011112042f, bv[q]) : -INFINITY;
        s[q] = sc;
        tm = fmaxf(tm, sc);
    }
    tm = fmaxf(tm, __shfl_xor(tm, 32));
    const float mn = fmaxf(x.m, tm);
    if (__any(mn > x.m)) {
        const float scl = __builtin_amdgcn_exp2f(x.m - mn);
        x.sum *= scl;
#pragma unroll
        for (int q = 0; q < 16; ++q) { x.o0[q] *= scl; x.o1[q] *= scl; }
    }
    x.m = mn;
#pragma unroll
    for (int q = 0; q < 16; ++q) { const float pe = __builtin_amdgcn_exp2f(s[q] - mn); s[q] = pe; x.sum += pe; }
#pragma unroll
    for (int st = 0; st < 2; ++st) {
        const bf16x8 pb = pack8(s, st * 8);
        x.o0 = __builtin_amdgcn_mfma_f32_32x32x16_bf16(vf[2 * st], pb, x.o0, 0, 0, 0);
        x.o1 = __builtin_amdgcn_mfma_f32_32x32x16_bf16(vf[2 * st + 1], pb, x.o1, 0, 0, 0);
    }
}

__device__ __forceinline__ void na_attn_wave(const Params& p, int wu, int lane, const float* sbias) {
    const int j = wu & 1, h = (wu >> 1) & 7, r = (wu >> 4) & 127, b = wu >> 11;
    const int l31 = lane & 31, hh = lane >> 5;
    NaCtx x;
    x.hh = hh; x.r = r;
    x.c = 32 * j + l31;
    x.c0 = min(max(x.c - 8, 0), 48); x.rs = min(max(r - 4, 0), 120);
    const int tokq = b * T + r * 64 + x.c;
    x.cb = 16 * j;
#pragma unroll
    for (int ks = 0; ks < 4; ++ks) x.qf[ks] = *(const bf16x8*)(p.z() + (size_t)tokq * INW + h * 64 + ks * 16 + hh * 8);
    x.bh = sbias + 64 + h * 465;
    const int kap = swap23(l31);
    x.kbase = p.z() + (size_t)(b * T + (x.rs + (kap >> 4)) * 64 + x.cb + (kap & 15)) * INW + 512 + h * 64 + hh * 8;
    x.vbase = p.vT() + ((size_t)(b * 8 + h) * 64 + l31) * T + x.rs * 64 + x.cb + 8 * hh;
    x.m = -1e30f; x.sum = 0.f;
#pragma unroll
    for (int q = 0; q < 16; ++q) { x.o0[q] = 0.f; x.o1[q] = 0.f; }
    bf16x8 k0[4], v0[4], k1[4], v1[4], k2[4], v2[4], k3[4], v3[4];
    na_load<0>(x, k0, v0); na_load<1>(x, k1, v1); na_load<2>(x, k2, v2);
    na_load<3>(x, k3, v3);  na_comp<0>(x, k0, v0);
    na_load<4>(x, k0, v0);  na_comp<1>(x, k1, v1);
    na_load<5>(x, k1, v1);  na_comp<2>(x, k2, v2);
    na_load<6>(x, k2, v2);  na_comp<3>(x, k3, v3);
    na_load<7>(x, k3, v3);  na_comp<4>(x, k0, v0);
    na_load<8>(x, k0, v0);  na_comp<5>(x, k1, v1);
    na_load<9>(x, k1, v1);  na_comp<6>(x, k2, v2);
    na_load<10>(x, k2, v2); na_comp<7>(x, k3, v3);
    na_load<11>(x, k3, v3); na_comp<8>(x, k0, v0);
    na_comp<9>(x, k1, v1);
    na_comp<10>(x, k2, v2);
    na_comp<11>(x, k3, v3);
    float sum = x.sum;
    sum += __shfl_xor(sum, 32);
    const float inv = 1.0f / sum;
    bf16_t* mo = p.mix() + (size_t)tokq * D + h * 64 + 4 * hh;
#pragma unroll
    for (int g = 0; g < 4; ++g) {
        uint2 pk;
        pk.x = pack2(x.o0[4 * g] * inv, x.o0[4 * g + 1] * inv); pk.y = pack2(x.o0[4 * g + 2] * inv, x.o0[4 * g + 3] * inv);
        *(uint2*)(mo + 8 * g) = pk;
        pk.x = pack2(x.o1[4 * g] * inv, x.o1[4 * g + 1] * inv); pk.y = pack2(x.o1[4 * g + 2] * inv, x.o1[4 * g + 3] * inv);
        *(uint2*)(mo + 32 + 8 * g) = pk;
    }
}

__device__ void phase_mixers(const Params& p, char* smem) {
    const int tid = VTID, lane = tid & 63, w = tid >> 6;
    {
        float* sbias = (float*)smem;
        __syncthreads();
        for (int i = tid; i < 8 * 465; i += 256) sbias[64 + i] = p.rpb[i] * 1.4426950408889634f;
        __syncthreads();
        for (int wu = VBID * 4 + w; wu < 8192; wu += VGRID * 4) na_attn_wave(p, wu, lane, sbias);
    }
    __syncthreads();
    hg_local(p, smem);
}

__device__ void phase_hg_scan(const Params& p) {
    const int tid = VTID;
    const int skip = gridDim.x >= 64 ? 32 : 0;
    if (VBID < skip) return;
    for (int item = VBID - skip; item < 512; item += VGRID - skip) {
        const int g = item * 256 + tid;
        const int seq = g >> 12, kv = g & 4095, k = kv & 63;
        const int dir = seq & 1;
        float S = 0.f;
        for (int cc0 = 0; cc0 < 128; cc0 += 8) {
            float L[8], d[8];
#pragma unroll
            for (int u = 0; u < 8; ++u) {
                const int c = dir ? 127 - (cc0 + u) : cc0 + u;
                const size_t it = (size_t)seq * 128 + c;
                L[u] = bf2f(((const bf16_t*)p.hstate())[it * 4096 + kv]);
                d[u] = p.hdec()[it * 64 + k];
            }
#pragma unroll
            for (int u = 0; u < 8; ++u) {
                const int c = dir ? 127 - (cc0 + u) : cc0 + u;
                const size_t it = (size_t)seq * 128 + c;
                ((bf16_t*)p.h())[it * 4096 + kv] = f2bf(S);
                S = d[u] * S + L[u];
            }
        }
    }
}

__device__ void phase_hg_out(const Params& p, char* smem) {
    char* sQt = smem;
    char* sKt = smem + 9216;
    char* sQh = smem + 18432;
    char* sVT = smem + 27648;
    char* sST = smem + 36864;
    char* sP = smem + 46080;
    float* sTot = (float*)(smem + 55296);
    float* sSS = sTot + 256;
    const int tid = VTID, lane = tid & 63, w = tid >> 6;
    const int kcol = tid & 63, sq = tid >> 6;
    const int l31 = lane & 31, hh = lane >> 5;
    for (int item = VBID; item < 2048; item += VGRID) {
        const int c = item & 127, h = (item >> 7) & 3, b = item >> 9;
        const int tok0 = b * T + c * 64;
        __syncthreads();
        hg_load_vt(p, sVT, tok0, h, kcol, sq);
        float qv[16];
        {
            const bf16_t* zp = p.z() + (size_t)(tok0 + sq * 16) * INW + 1536 + h * 64 + kcol;
#pragma unroll
            for (int j = 0; j < 16; ++j) qv[j] = bf2f(zp[(size_t)j * INW]);
        }
        f32x16 accO;
#pragma unroll
        for (int r = 0; r < 16; ++r) accO[r] = 0.f;
        for (int dir = 0; dir < 2; ++dir) {
            float bj[16], kk[16];
            const float btot = hg_gates(p, sTot, tok0, h, dir, kcol, sq, bj, kk);
            const float bref = 0.5f * btot;
#pragma unroll
            for (int j = 0; j < 16; ++j) {
                const int s = sq * 16 + j;
                *(bf16_t*)(sQt + s * HRS + kcol * 2) = f2bf(qv[j] * __expf(bj[j] - bref));
                *(bf16_t*)(sKt + s * HRS + kcol * 2) = f2bf(kk[j] * __expf(bref - bj[j]));
                *(bf16_t*)(sQh + s * HRS + kcol * 2) = f2bf(qv[j] * __expf(bj[j]));
            }
            {
                const bf16_t* sp = (const bf16_t*)p.h() + ((size_t)(((b * 4 + h) * 2 + dir) * 128 + c)) * 4096;
#pragma unroll
                for (int i = 0; i < 4; ++i) {
                    const int idx = tid * 4 + 1024 * i;
                    *(uint2*)(sST + (idx >> 6) * HRS + (idx & 63) * 2) = *(const uint2*)(sp + idx);
                }
            }
            __syncthreads();
            {
                const int si = w >> 1, ti = w & 1;
                const bool live = dir == 0 ? (si <= ti) : (si >= ti);
                f32x16 pt;
#pragma unroll
                for (int r = 0; r < 16; ++r) pt[r] = 0.f;
                if (live) pt = tile_mm64(sKt, sQt, si * 32, ti * 32, lane, pt);
                const int t = ti * 32 + l31;
#pragma unroll
                for (int g = 0; g < 4; ++g) {
                    const int s0 = si * 32 + 8 * g + 4 * hh;
                    float v0 = pt[4 * g], v1 = pt[4 * g + 1], v2 = pt[4 * g + 2], v3 = pt[4 * g + 3];
                    if (dir == 0) {
                        if (s0 > t) v0 = 0.f; if (s0 + 1 > t) v1 = 0.f; if (s0 + 2 > t) v2 = 0.f; if (s0 + 3 > t) v3 = 0.f;
                    } else {
                        if (s0 < t) v0 = 0.f; if (s0 + 1 < t) v1 = 0.f; if (s0 + 2 < t) v2 = 0.f; if (s0 + 3 < t) v3 = 0.f;
                    }
                    uint2 pk; pk.x = pack2(v0, v1); pk.y = pack2(v2, v3);
                    *(uint2*)(sP + t * HRS + s0 * 2) = pk;
                }
            }
            __syncthreads();
            {
                const int vi = w >> 1, ti = w & 1;
                accO = tile_mm64(sVT, sP, vi * 32, ti * 32, lane, accO);
                accO = tile_mm64(sST, sQh, vi * 32, ti * 32, lane, accO);
            }
            __syncthreads();
        }
        const int vi = w >> 1, ti = w & 1;
        float ssq = 0.f;
#pragma unroll
        for (int r = 0; r < 16; ++r) ssq += accO[r] * accO[r];
        ssq += __shfl_xor(ssq, 32);
        sSS[w * 64 + lane] = ssq;
        __syncthreads();
        const float tot = sSS[ti * 64 + l31] + sSS[(2 + ti) * 64 + l31];
        const float rs = rsqrtf(tot * (1.0f / 64.0f) + EPS);
        const int tok = tok0 + ti * 32 + l31;
#pragma unroll
        for (int g = 0; g < 4; ++g) {
            const int v0 = vi * 32 + 8 * g + 4 * hh;
            const uint2 gz = *(const uint2*)(p.z() + (size_t)tok * INW + 2560 + h * 64 + v0);
            const float4 gn = *(const float4*)(p.hg_g + h * 64 + v0);
            const float g0 = bflo(gz.x), g1 = bfhi(gz.x), g2 = bflo(gz.y), g3 = bfhi(gz.y);
            const float o0 = accO[4 * g] * rs * gn.x * (g0 / (1.0f + __expf(-g0)));
            const float o1 = accO[4 * g + 1] * rs * gn.y * (g1 / (1.0f + __expf(-g1)));
            const float o2 = accO[4 * g + 2] * rs * gn.z * (g2 / (1.0f + __expf(-g2)));
            const float o3 = accO[4 * g + 3] * rs * gn.w * (g3 / (1.0f + __expf(-g3)));
            uint2 pk; pk.x = pack2(o0, o1); pk.y = pack2(o2, o3);
            *(uint2*)(p.mix() + (size_t)tok * D + 512 + h * 64 + v0) = pk;
        }
    }
    for (int wu = VBID * 4 + w; wu < 4096; wu += VGRID * 4) mem_attn_wave(p, wu, lane);
}


__device__ __forceinline__ int ord_key(int fb) { return fb ^ ((fb >> 31) & 0x7FFFFFFF); }

template <int N>
__device__ __forceinline__ void bitonic_sort_desc(int (&v)[N]) {
#pragma unroll
    for (int k = 2; k <= N; k <<= 1) {
#pragma unroll
        for (int j = k >> 1; j > 0; j >>= 1) {
#pragma unroll
            for (int i = 0; i < N; ++i) {
                const int l = i ^ j;
                if (l > i) {
                    const bool desc = ((i & k) == 0);
                    const int a = v[i], b = v[l];
                    const int mx = max(a, b), mn = min(a, b);
                    v[i] = desc ? mx : mn;
                    v[l] = desc ? mn : mx;
                }
            }
        }
    }
}
template <int N>
__device__ __forceinline__ void bitonic_merge_desc(int (&v)[N]) {
#pragma unroll
    for (int j = N >> 1; j > 0; j >>= 1) {
#pragma unroll
        for (int i = 0; i < N; ++i) {
            const int l = i ^ j;
            if (l > i) {
                const int a = v[i], b = v[l];
                v[i] = max(a, b);
                v[l] = min(a, b);
            }
        }
    }
}
__device__ __forceinline__ void merge_prune16(int (&r)[16], const int (&o)[16]) {
#pragma unroll
    for (int i = 0; i < 16; ++i) r[i] = max(r[i], o[15 - i]);
    bitonic_merge_desc<16>(r);
}

constexpr int QRS = 528;
struct EpiQpLds {
    char* qt; const float* ssrow; int brow, bcol;
    __device__ __forceinline__ void operator()(int row, int col, const f32x4& v) const {
        const float rs = rsqrtf(ssrow[row] * (1.0f / 1024.0f) + EPS);
        uint2 pk; pk.x = pack2(v[0] * rs, v[1] * rs); pk.y = pack2(v[2] * rs, v[3] * rs);
        *(uint2*)(qt + (row - brow) * QRS + (col - bcol) * 2) = pk;
    }
};
__device__ __forceinline__ int* route_slot(char* wrows, int e) { return (int*)(wrows + (e >> 6) * QRS + (e & 63) * 4); }

__device__ __forceinline__ void route_tile(const Params& p, char* qt, int tok0, int h) {
    const int tid = threadIdx.x, lane = tid & 63, w = tid >> 6;
    const int tl = lane & 31, hh = lane >> 5;
    char* wrows = qt + (w * 32) * QRS;
    const int tok = tok0 + w * 32 + tl;
    const bf16_t* sp = p.subk_b() + (size_t)(h * 2) * 16384 + tl * 128 + hh * 8;
    bf16x8 an[8];
#pragma unroll
    for (int ks = 0; ks < 8; ++ks) an[ks] = *(const bf16x8*)(sp + ks * 16);
#pragma unroll
    for (int c = 0; c < 2; ++c) {
        bf16x8 qf[8];
#pragma unroll
        for (int ks = 0; ks < 8; ++ks) qf[ks] = *(const bf16x8*)(wrows + tl * QRS + (c * 128 + ks * 16 + hh * 8) * 2);
        int cur[16];
#pragma unroll
        for (int kb = 0; kb < 4; ++kb) {
            bf16x8 af[8];
#pragma unroll
            for (int ks = 0; ks < 8; ++ks) af[ks] = an[ks];
            if (c * 4 + kb + 1 < 8) {
                const bf16_t* sn = sp + (c * 4 + kb + 1) * 4096;
#pragma unroll
                for (int ks = 0; ks < 8; ++ks) an[ks] = *(const bf16x8*)(sn + ks * 16);
            }
            f32x16 acc;
#pragma unroll
            for (int r = 0; r < 16; ++r) acc[r] = 0.f;
#pragma unroll
            for (int ks = 0; ks < 8; ++ks) acc = __builtin_amdgcn_mfma_f32_32x32x16_bf16(af[ks], qf[ks], acc, 0, 0, 0);
            int v[16];
#pragma unroll
            for (int r = 0; r < 16; ++r) {
                const int key = kb * 32 + (r & 3) + 8 * (r >> 2) + 4 * hh;
                const int fb = (__float_as_int(acc[r]) & ~127) | (127 - key);
                v[r] = ord_key(fb);
            }
            bitonic_sort_desc<16>(v);
            if (kb == 0) {
#pragma unroll
                for (int r = 0; r < 16; ++r) cur[r] = v[r];
            } else {
                merge_prune16(cur, v);
            }
            __builtin_amdgcn_sched_barrier(0);
        }
        {
            int o[16];
#pragma unroll
            for (int r = 0; r < 16; ++r) o[r] = __shfl_xor(cur[r], 32);
            merge_prune16(cur, o);
        }
#pragma unroll
        for (int r = 0; r < 16; ++r) *route_slot(wrows, c * 512 + r * 32 + tl) = cur[r];
        __builtin_amdgcn_sched_barrier(0);
    }
    float va[16], vb[16];
#pragma unroll
    for (int r = 0; r < 16; ++r) {
        const int fa = ord_key(*route_slot(wrows, r * 32 + tl)), fb = ord_key(*route_slot(wrows, 512 + r * 32 + tl));
        va[r] = __int_as_float(fa & ~127);
        vb[r] = __int_as_float(fb & ~127);
    }
    int best[16];
#pragma unroll
    for (int j = 0; j < 16; ++j) best[j] = ord_key((__float_as_int(va[0] + vb[j]) & ~255) | (255 - j));
#pragma unroll
    for (int i = 1; i < 8; ++i) {
        const int n = 16 / (i + 1);
        int row[16];
#pragma unroll
        for (int j = 0; j < 16; ++j)
            row[j] = (j < n) ? ord_key((__float_as_int(va[i] + vb[j]) & ~255) | (255 - (i * 16 + j))) : (int)0x80000000;
        merge_prune16(best, row);
    }
    {
        int row[16];
#pragma unroll
        for (int j = 0; j < 16; ++j)
            row[j] = (j < 8) ? ord_key((__float_as_int(va[8 + j] + vb[0]) & ~255) | (255 - ((8 + j) * 16))) : (int)0x80000000;
        merge_prune16(best, row);
    }
    float sv[16];
    int pid[16];
#pragma unroll
    for (int r = 0; r < 16; ++r) {
        const int cb = ord_key(best[r]);
        sv[r] = __int_as_float(cb & ~255);
        pid[r] = 255 - (cb & 255);
    }
    float tot = 0.f;
    const float smax = sv[0];
#pragma unroll
    for (int r = 0; r < 16; ++r) { sv[r] = __expf(sv[r] - smax); tot += sv[r]; }
    const float inv = 1.0f / tot;
    if (hh == 0) {
#pragma unroll
        for (int r = 0; r < 16; ++r) {
            const int ia = 127 - (ord_key(*route_slot(wrows, (pid[r] >> 4) * 32 + tl)) & 127);
            const int ib = 127 - (ord_key(*route_slot(wrows, 512 + (pid[r] & 15) * 32 + tl)) & 127);
            const int pos = (r & 7) * 16 + h * 2 + (r >> 3);
            p.eidx()[(size_t)tok * 128 + pos] = (unsigned short)(ia * 128 + ib);
            p.gate()[(size_t)tok * 128 + pos] = sv[r] * inv;
        }
    }
}

__device__ void phase_gemm_q_route(const Params& p, char* smem) {
    const int nM = NTOK / 256, nN = QW / 256;
    for (int i = 0; i * (int)gridDim.x + (int)blockIdx.x < nM * nN; ++i) {
        int pm, pn;
        g8::tile_of(i * gridDim.x + blockIdx.x, nM, nN, pm, pn);
        EpiQpLds e{smem, p.ss1(), pm * 256, pn * 256};
        gemm256_tile<false, false, false>(p.h(), p.w_q_t(), D, pm * 256, pn * 256, smem, e);
        __syncthreads();
        route_tile(p, smem, pm * 256, pn);
    }
}

__device__ void phase_route(const Params& p, char* smem) {
    char* sk = smem;
    const int tid = VTID, lane = tid & 63, w = tid >> 6;
    int* sA = (int*)(smem + 32768) + w * 2048;
    int* sB = (int*)(smem + 65536) + w * 512;
    const int tl = lane & 31, hh = lane >> 5;
    const int h = VBID & 7, tg0 = VBID >> 3, tgs = VGRID >> 3;
    for (int base = tg0; base < 256; base += 4 * tgs)
    for (int c = 0; c < 2; ++c) {
        const int hc = h * 2 + c;
        __syncthreads();
        {
            const bf16_t* sp = p.subk_b() + (size_t)hc * 16384;
#pragma unroll
            for (int i = 0; i < 8; ++i) {
                const int ch = tid + 256 * i;
                const int row = ch >> 4, cc = ch & 15;
                const uint4 v = *(const uint4*)(sp + row * 128 + cc * 8);
                *(uint4*)(sk + row * 256 + ((cc ^ (row & 15)) << 4)) = v;
            }
        }
        __syncthreads();
        bf16x8 qf[8];
        if (base < 256) {
            const bf16_t* qr = p.z() + (size_t)(base * 128 + w * 32 + tl) * QW + hc * 128 + hh * 8;
#pragma unroll
            for (int ks = 0; ks < 8; ++ks) qf[ks] = *(const bf16x8*)(qr + ks * 16);
        }
        for (int it = 0; it < 4; ++it) {
            const int tgp = base + it * tgs;
            if (tgp >= 256) break;
            const int tok = tgp * 128 + w * 32 + tl;
            int* sidx = sA + it * 512;
            f32x16 acc4[4];
#pragma unroll
            for (int kb = 0; kb < 4; ++kb) {
#pragma unroll
                for (int r = 0; r < 16; ++r) acc4[kb][r] = 0.f;
                const int row = kb * 32 + tl;
#pragma unroll
                for (int ks = 0; ks < 8; ++ks) {
                    const bf16x8 af = *(const bf16x8*)(sk + row * 256 + (((ks * 2 + hh) ^ (row & 15)) << 4));
                    acc4[kb] = __builtin_amdgcn_mfma_f32_32x32x16_bf16(af, qf[ks], acc4[kb], 0, 0, 0);
                }
            }
            if (it + 1 < 4 && tgp + tgs < 256) {
                const bf16_t* qr = p.z() + (size_t)((tgp + tgs) * 128 + w * 32 + tl) * QW + hc * 128 + hh * 8;
#pragma unroll
                for (int ks = 0; ks < 8; ++ks) qf[ks] = *(const bf16x8*)(qr + ks * 16);
            }
            int cur[16];
#pragma unroll
            for (int kb = 0; kb < 4; ++kb) {
                int v[16];
#pragma unroll
                for (int r = 0; r < 16; ++r) {
                    const int key = kb * 32 + (r & 3) + 8 * (r >> 2) + 4 * hh;
                    const int fb = (__float_as_int(acc4[kb][r]) & ~127) | (127 - key);
                    v[r] = ord_key(fb);
                }
                bitonic_sort_desc<16>(v);
                if (kb == 0) {
#pragma unroll
                    for (int r = 0; r < 16; ++r) cur[r] = v[r];
                } else {
                    merge_prune16(cur, v);
                }
            }
            {
                int o[16];
#pragma unroll
                for (int r = 0; r < 16; ++r) o[r] = __shfl_xor(cur[r], 32);
                merge_prune16(cur, o);
            }
            if (c == 0) {
#pragma unroll
                for (int r = 0; r < 16; ++r) sidx[r * 32 + tl] = cur[r];
                continue;
            }
#pragma unroll
            for (int r = 0; r < 16; ++r) sB[r * 32 + tl] = cur[r];
        float va[16], vb[16];
#pragma unroll
        for (int r = 0; r < 16; ++r) {
            const int fa = ord_key(sidx[r * 32 + tl]), fb = ord_key(sB[r * 32 + tl]);
            va[r] = __int_as_float(fa & ~127);
            vb[r] = __int_as_float(fb & ~127);
        }
        int best[16];
#pragma unroll
        for (int j = 0; j < 16; ++j) best[j] = ord_key((__float_as_int(va[0] + vb[j]) & ~255) | (255 - j));
#pragma unroll
        for (int i = 1; i < 8; ++i) {
            const int n = 16 / (i + 1);
            int row[16];
#pragma unroll
            for (int j = 0; j < 16; ++j)
                row[j] = (j < n) ? ord_key((__float_as_int(va[i] + vb[j]) & ~255) | (255 - (i * 16 + j))) : (int)0x80000000;
            merge_prune16(best, row);
        }
        {
            int row[16];
#pragma unroll
            for (int j = 0; j < 16; ++j)
                row[j] = (j < 8) ? ord_key((__float_as_int(va[8 + j] + vb[0]) & ~255) | (255 - ((8 + j) * 16))) : (int)0x80000000;
            merge_prune16(best, row);
        }
        float sv[16];
        int pid[16];
#pragma unroll
        for (int r = 0; r < 16; ++r) {
            const int cb = ord_key(best[r]);
            sv[r] = __int_as_float(cb & ~255);
            pid[r] = 255 - (cb & 255);
        }
        float tot = 0.f;
        const float smax = sv[0];
#pragma unroll
        for (int r = 0; r < 16; ++r) { sv[r] = __expf(sv[r] - smax); tot += sv[r]; }
        const float inv = 1.0f / tot;
        if (hh == 0) {
#pragma unroll
            for (int r = 0; r < 16; ++r) {
                const int ia = 127 - (ord_key(sidx[(pid[r] >> 4) * 32 + tl]) & 127);
                const int ib = 127 - (ord_key(sB[(pid[r] & 15) * 32 + tl]) & 127);
                const int pos = (r & 7) * 16 + h * 2 + (r >> 3);
                p.eidx()[(size_t)tok * 128 + pos] = (unsigned short)(ia * 128 + ib);
                p.gate()[(size_t)tok * 128 + pos] = sv[r] * inv;
            }
        }
        }
    }
}

constexpr int PEER_TG = 512;
constexpr int PEER_TPW = PEER_TG / 8;
constexpr int PEER_NTG = NTOK / PEER_TG;
constexpr int PEER_NCH = 8;

#define PEER_G1(base, wv, hi) (*(const uint4*)((base) + (unsigned)((((hi) ? ((wv) >> 16) : ((wv) & 0xFFFFu)) << 7) + dlo)))
#define PEER_GATHER16(dst, base, ia, ib)                                                             \
    dst[0] = PEER_G1(base, (ia).x, 0);  dst[1] = PEER_G1(base, (ia).x, 1);  dst[2] = PEER_G1(base, (ia).y, 0);  dst[3] = PEER_G1(base, (ia).y, 1);   \
    dst[4] = PEER_G1(base, (ia).z, 0);  dst[5] = PEER_G1(base, (ia).z, 1);  dst[6] = PEER_G1(base, (ia).w, 0);  dst[7] = PEER_G1(base, (ia).w, 1);   \
    dst[8] = PEER_G1(base, (ib).x, 0);  dst[9] = PEER_G1(base, (ib).x, 1);  dst[10] = PEER_G1(base, (ib).y, 0); dst[11] = PEER_G1(base, (ib).y, 1);  \
    dst[12] = PEER_G1(base, (ib).z, 0); dst[13] = PEER_G1(base, (ib).z, 1); dst[14] = PEER_G1(base, (ib).w, 0); dst[15] = PEER_G1(base, (ib).w, 1);

__device__ __forceinline__ unsigned quant4(float a, float b, float c, float d, float qs) {
    const int q0 = (int)rintf(__builtin_amdgcn_fmed3f(a * qs, -127.f, 127.f)), q1 = (int)rintf(__builtin_amdgcn_fmed3f(b * qs, -127.f, 127.f));
    const int q2 = (int)rintf(__builtin_amdgcn_fmed3f(c * qs, -127.f, 127.f)), q3 = (int)rintf(__builtin_amdgcn_fmed3f(d * qs, -127.f, 127.f));
    return (unsigned)(q0 & 255) | ((unsigned)(q1 & 255) << 8) | ((unsigned)(q2 & 255) << 16) | ((unsigned)(q3 & 255) << 24);
}
template <int CTRL>
__device__ __forceinline__ int dpp_movi(int v) { return __builtin_amdgcn_update_dpp(0, v, CTRL, 0xf, 0xf, true); }

struct DotTok { uint4 ia, ib; uint4 ha, hb; float hm; };
__device__ __forceinline__ void dots_load(const Params& p, DotTok& t, int tok, int c, int g, int d8) {
    const uint4* idp = (const uint4*)(p.eidx() + (size_t)tok * 128 + g * 16);
    t.ia = idp[0]; t.ib = idp[1];
    const uint4* hp = (const uint4*)(p.h() + (size_t)tok * D + c * 128 + d8 * 16);
    t.ha = hp[0]; t.hb = hp[1];
    t.hm = __uint_as_float(p.hmax()[tok]);
}
__device__ __forceinline__ void dotsf_load(const Params& p, DotTok& t, int tokb, int s, int g, int d8) {
    dots_load(p, t, tokb + 8 * (s & 15), s >> 4, g, d8);
}
__device__ __forceinline__ void dotsf_finish(const uint4 (&uu)[16], const DotTok& t, int* part, int g, int d8) {
    const float qs = t.hm > 0.f ? 127.0f / t.hm : 0.f;
    const int h0 = (int)quant4(bflo(t.ha.x), bfhi(t.ha.x), bflo(t.ha.y), bfhi(t.ha.y), qs);
    const int h1 = (int)quant4(bflo(t.ha.z), bfhi(t.ha.z), bflo(t.ha.w), bfhi(t.ha.w), qs);
    const int h2 = (int)quant4(bflo(t.hb.x), bfhi(t.hb.x), bflo(t.hb.y), bfhi(t.hb.y), qs);
    const int h3 = (int)quant4(bflo(t.hb.z), bfhi(t.hb.z), bflo(t.hb.w), bfhi(t.hb.w), qs);
    int acc[16];
#pragma unroll
    for (int i = 0; i < 16; ++i) {
        int a = __builtin_amdgcn_sdot4((int)uu[i].x, h0, 0, false);
        a = __builtin_amdgcn_sdot4((int)uu[i].y, h1, a, false);
        a = __builtin_amdgcn_sdot4((int)uu[i].z, h2, a, false);
        a = __builtin_amdgcn_sdot4((int)uu[i].w, h3, a, false);
        a += dpp_movi<DPP_QP_X1>(a);
        a += dpp_movi<DPP_QP_X2>(a);
        a += dpp_movi<DPP_HMIRROR>(a);
        acc[i] = a;
    }
    if (d8 == 0) {
#pragma unroll
        for (int i = 0; i < 16; ++i) (void)__hip_atomic_fetch_add(part + g * 16 + i, acc[i], __ATOMIC_RELAXED, __HIP_MEMORY_SCOPE_WORKGROUP);
    }
}

__device__ __forceinline__ float gelu_erf(float v);

__device__ void phase_peer_dots(const Params& p, char* smem) {
    const int tid = threadIdx.x, lane = tid & 63, w = tid >> 6;
    const int g = lane >> 3, d8 = lane & 7;
    int* part = (int*)smem + w * 2048;
    for (int tgp = blockIdx.x; tgp < NTOK / 128; tgp += gridDim.x) {
        const int tokb = tgp * 128 + w;
        __syncthreads();
        for (int i = lane; i < 2048; i += 64) part[i] = 0;
        __syncthreads();
        const char* ubase = (const char*)p.u_c();
        const unsigned dlo = d8 * 16;
        DotTok ta, tb, tn;
        uint4 ua[16], ubuf[16];
        dotsf_load(p, ta, tokb, 0, g, d8);
        dotsf_load(p, tb, tokb, 1, g, d8);
        PEER_GATHER16(ua, ubase, ta.ia, ta.ib)
        PEER_GATHER16(ubuf, ubase, tb.ia, tb.ib)
        dotsf_load(p, tn, tokb, 2, g, d8);
        for (int s = 0; s < 128; s += 2) {
            dotsf_finish(ua, ta, part + (s & 15) * 128, g, d8);
            if (s + 2 < 128) {
                ta = tn;
                const char* ub = ubase + (size_t)((s + 2) >> 4) * 16384 * 128;
                PEER_GATHER16(ua, ub, ta.ia, ta.ib)
                dotsf_load(p, tn, tokb, min(s + 3, 127), g, d8);
            }
            dotsf_finish(ubuf, tb, part + ((s + 1) & 15) * 128, g, d8);
            if (s + 3 < 128) {
                tb = tn;
                const char* ub = ubase + (size_t)((s + 3) >> 4) * 16384 * 128;
                PEER_GATHER16(ubuf, ub, tb.ia, tb.ib)
                dotsf_load(p, tn, tokb, min(s + 4, 127), g, d8);
            }
        }
        __syncthreads();
        for (int k0 = 0; k0 < 16; k0 += 4) {
            int ps[4][2], e[4][2];
            float gt[4][2], sh[4];
#pragma unroll
            for (int q = 0; q < 4; ++q) {
                const int tok = tokb + 8 * (k0 + q);
                sh[q] = __uint_as_float(p.hmax()[tok]) * (1.0f / 127.0f) * rsqrtf(p.ss1()[tok] * (1.0f / 1024.0f) + EPS);
#pragma unroll
                for (int u = 0; u < 2; ++u) {
                    const int slot = lane + 64 * u;
                    ps[q][u] = part[(k0 + q) * 128 + slot];
                    e[q][u] = p.eidx()[(size_t)tok * 128 + slot];
                    gt[q][u] = p.gate()[(size_t)tok * 128 + slot];
                }
            }
            float su[4][2], sv[4][2];
#pragma unroll
            for (int q = 0; q < 4; ++q)
#pragma unroll
                for (int u = 0; u < 2; ++u) { su[q][u] = p.scale_u()[e[q][u]]; sv[q][u] = p.scale_v()[e[q][u]]; }
#pragma unroll
            for (int q = 0; q < 4; ++q) {
                const int tok = tokb + 8 * (k0 + q);
                float cf[2];
#pragma unroll
                for (int u = 0; u < 2; ++u) cf[u] = gelu_erf((float)ps[q][u] * su[q][u] * sh[q]) * gt[q][u] * sv[q][u];
                const float cm = wave_max(fmaxf(fabsf(cf[0]), fabsf(cf[1])));
                const float qs = cm > 0.f ? 127.0f / cm : 0.f;
                p.coef()[(size_t)tok * 128 + lane] = (signed char)(int)rintf(cf[0] * qs);
                p.coef()[(size_t)tok * 128 + lane + 64] = (signed char)(int)rintf(cf[1] * qs);
                if (lane == 0) p.csum()[tok] = cm * (1.0f / 127.0f);
            }
        }
    }
}

__device__ __forceinline__ float gelu_erf(float v) {
    const float av = fabsf(v);
    const float t = __builtin_amdgcn_rcpf(fmaf(av, 0.2316418882f, 1.0f));
    float q = fmaf(t, 0.5307027145f, -0.7265760135f);
    q = fmaf(q, t, 0.7107068705f);
    q = fmaf(q, t, -0.142248368f);
    q = fmaf(q, t, 0.127414796f);
    q = q * t;
    const float e = __builtin_amdgcn_exp2f(v * v * -0.72134752044f);
    const float m = v * (q * e);
    return v < 0.f ? m : v - m;
}
struct AccTok { uint4 ia, ib; uint4 cq; float cs; };
__device__ __forceinline__ void acc_load(const Params& p, AccTok& t, int tok, int g) {
    const uint4* idp = (const uint4*)(p.eidx() + (size_t)tok * 128 + g * 16);
    t.ia = idp[0]; t.ib = idp[1];
    t.cq = *(const uint4*)(p.coef() + (size_t)tok * 128 + g * 16);
    t.cs = p.csum()[tok];
}
#define PEER_T4DOT(acc, B, r0, r1, r2, r3, cq)                                   \
    {                                                                            \
        const unsigned t0 = __builtin_amdgcn_perm(r1, r0, 0x05010400u), t1 = __builtin_amdgcn_perm(r1, r0, 0x07030602u); \
        const unsigned t2 = __builtin_amdgcn_perm(r3, r2, 0x05010400u), t3 = __builtin_amdgcn_perm(r3, r2, 0x07030602u); \
        acc[(B) + 0] = __builtin_amdgcn_sdot4((int)__builtin_amdgcn_perm(t2, t0, 0x05040100u), (int)(cq), acc[(B) + 0], false); \
        acc[(B) + 1] = __builtin_amdgcn_sdot4((int)__builtin_amdgcn_perm(t2, t0, 0x07060302u), (int)(cq), acc[(B) + 1], false); \
        acc[(B) + 2] = __builtin_amdgcn_sdot4((int)__builtin_amdgcn_perm(t3, t1, 0x05040100u), (int)(cq), acc[(B) + 2], false); \
        acc[(B) + 3] = __builtin_amdgcn_sdot4((int)__builtin_amdgcn_perm(t3, t1, 0x07060302u), (int)(cq), acc[(B) + 3], false); \
    }
__device__ __forceinline__ void accf_finish(const uint4 (&vv)[16], const AccTok& t, char* rowp, int g) {
    const unsigned cw[4] = {t.cq.x, t.cq.y, t.cq.z, t.cq.w};
    int acc[16];
#pragma unroll
    for (int j = 0; j < 16; ++j) acc[j] = 0;
#pragma unroll
    for (int j = 0; j < 4; ++j) {
        PEER_T4DOT(acc, 0, vv[4 * j].x, vv[4 * j + 1].x, vv[4 * j + 2].x, vv[4 * j + 3].x, cw[j])
        PEER_T4DOT(acc, 4, vv[4 * j].y, vv[4 * j + 1].y, vv[4 * j + 2].y, vv[4 * j + 3].y, cw[j])
        PEER_T4DOT(acc, 8, vv[4 * j].z, vv[4 * j + 1].z, vv[4 * j + 2].z, vv[4 * j + 3].z, cw[j])
        PEER_T4DOT(acc, 12, vv[4 * j].w, vv[4 * j + 1].w, vv[4 * j + 2].w, vv[4 * j + 3].w, cw[j])
    }
    int t8[8], u4[4];
#pragma unroll
    for (int j = 0; j < 8; ++j) {
        const auto r = __builtin_amdgcn_permlane32_swap((unsigned)acc[j], (unsigned)acc[j + 8], false, false);
        t8[j] = (int)(r[0] + r[1]);
    }
#pragma unroll
    for (int j = 0; j < 4; ++j) {
        const auto r = __builtin_amdgcn_permlane16_swap((unsigned)t8[j], (unsigned)t8[j + 4], false, false);
        u4[j] = (int)(r[0] + r[1]);
    }
    float o[4];
#pragma unroll
    for (int j = 0; j < 4; ++j) {
        int v = u4[j];
        v += dpp_movi<DPP_ROR8>(v);
        o[j] = (float)v * t.cs;
    }
    if ((g & 1) == 0) {
        const int rho = g >> 1;
        uint2 w0; w0.x = pack2(o[0], o[1]); w0.y = pack2(o[2], o[3]);
        *(uint2*)(rowp + (4 * (rho & 1) + 8 * (rho >> 1)) * 2) = w0;
    }
}

__device__ void phase_peer_accum(const Params& p, char* smem) {
    const int tid = threadIdx.x, lane = tid & 63, w = tid >> 6;
    const int g = lane >> 3, d8 = lane & 7;
    char* rowbuf = smem + w * 16384;
    for (int tgp = blockIdx.x; tgp < NTOK / 64; tgp += gridDim.x) {
        const int tokb = tgp * 64 + w;
        __syncthreads();
        const char* vbase = (const char*)p.v_c();
        const unsigned dlo = d8 * 16;
        AccTok ta, tb, tn;
        uint4 va[16], vbuf[16];
        acc_load(p, ta, tokb, g);
        acc_load(p, tb, tokb + 8, g);
        PEER_GATHER16(va, vbase, ta.ia, ta.ib)
        PEER_GATHER16(vbuf, vbase, tb.ia, tb.ib)
        acc_load(p, tn, tokb + 16, g);
        for (int s = 0; s < 64; s += 2) {
            accf_finish(va, ta, rowbuf + (s & 7) * 2048 + (s >> 3) * 256 + d8 * 32, g);
            if (s + 2 < 64) {
                ta = tn;
                const char* vb = vbase + (size_t)((s + 2) >> 3) * 16384 * 128;
                PEER_GATHER16(va, vb, ta.ia, ta.ib)
                acc_load(p, tn, tokb + 8 * (min(s + 3, 63) & 7), g);
            }
            accf_finish(vbuf, tb, rowbuf + ((s + 1) & 7) * 2048 + ((s + 1) >> 3) * 256 + d8 * 32, g);
            if (s + 3 < 64) {
                tb = tn;
                const char* vb = vbase + (size_t)((s + 3) >> 3) * 16384 * 128;
                PEER_GATHER16(vbuf, vb, tb.ia, tb.ib)
                acc_load(p, tn, tokb + 8 * (min(s + 4, 63) & 7), g);
            }
        }
        __syncthreads();
        for (int k0 = 0; k0 < 8; k0 += 2) {
            float4 v[2][4];
#pragma unroll
            for (int q = 0; q < 2; ++q) {
                const bf16_t* xrow = p.x1b() + (size_t)(tokb + 8 * (k0 + q)) * D;
#pragma unroll
                for (int j = 0; j < 4; ++j) {
                    const uint2 xk = *(const uint2*)(xrow + (j * 64 + lane) * 4);
                    v[q][j] = make_float4(bflo(xk.x), bfhi(xk.x), bflo(xk.y), bfhi(xk.y));
                }
            }
#pragma unroll
            for (int q = 0; q < 2; ++q) {
                float* orow = p.out + (size_t)(tokb + 8 * (k0 + q)) * D;
                const char* prow = rowbuf + (k0 + q) * 2048;
                float ss = 0.f;
#pragma unroll
                for (int j = 0; j < 4; ++j) {
                    const uint2 pk = *(const uint2*)(prow + (j * 64 + lane) * 8);
                    v[q][j].x += bflo(pk.x); v[q][j].y += bfhi(pk.x); v[q][j].z += bflo(pk.y); v[q][j].w += bfhi(pk.y);
                    ss += v[q][j].x * v[q][j].x + v[q][j].y * v[q][j].y + v[q][j].z * v[q][j].z + v[q][j].w * v[q][j].w;
                }
                ss = wave_sum(ss);
                const float rs = rsqrtf(ss * (1.0f / 1024.0f) + EPS);
#pragma unroll
                for (int j = 0; j < 4; ++j) {
                    const float4 gg = *(const float4*)(p.fin_g + (j * 64 + lane) * 4);
                    float4 o;
                    o.x = v[q][j].x * rs * gg.x; o.y = v[q][j].y * rs * gg.y; o.z = v[q][j].z * rs * gg.z; o.w = v[q][j].w * rs * gg.w;
                    *(float4*)(orow + (j * 64 + lane) * 4) = o;
                }
            }
        }
    }
}

#define XB_TMO      128
#define XB_XCNT(j)  (256  + 64 * (j))
#define XB_XSUB(j)  (1280 + 64 * (j))
#define XB_XGEN(j)  (2304 + 64 * (j))
#define XB_TOP      3328
#define XB_TOPGEN   3392
#define XCD_BAR_WORDS 3456
#define XB_SPIN_CAP (1u << 18)
__device__ __forceinline__ unsigned xb_ld(unsigned* p)              { return __hip_atomic_load(p, __ATOMIC_RELAXED, __HIP_MEMORY_SCOPE_AGENT); }
__device__ __forceinline__ unsigned xb_add(unsigned* p, unsigned v) { return __hip_atomic_fetch_add(p, v, __ATOMIC_RELAXED, __HIP_MEMORY_SCOPE_AGENT); }
#define XB_SPIN(cond, bar) do { unsigned _sp = 0; while (cond) { __builtin_amdgcn_s_sleep(1); \
    if ((++_sp & 255u) == 0u) { if (xb_ld(&(bar)[XB_TMO])) break; if (_sp > XB_SPIN_CAP) { atomicAdd(&(bar)[XB_TMO], 1u); break; } } } } while (0)

struct XcdBarrier { unsigned* bar; unsigned x; volatile unsigned* st; };

__device__ __forceinline__ XcdBarrier xcd_barrier_post(unsigned* bar, volatile unsigned* st) {
    XcdBarrier b; b.bar = bar; b.x = xcc_id(); b.st = st;
    if (threadIdx.x == 0) (void)xb_add(&bar[XB_XCNT(b.x)], 1u);
    return b;
}
__device__ __forceinline__ void xcd_barrier_complete(unsigned* bar, unsigned x, unsigned& nloc, unsigned& nx) {
    const unsigned G = gridDim.x * gridDim.y * gridDim.z;
    unsigned sum, cnt, mine, sp = 0u;
    for (;;) {
        sum = 0u; cnt = 0u; mine = 0u;
#pragma unroll
        for (unsigned j = 0; j < 16; ++j) { const unsigned c = xb_ld(&bar[XB_XCNT(j)]); sum += c; cnt += (c > 0u) ? 1u : 0u; mine = (j == x) ? c : mine; }
        if (sum == G) break;
        __builtin_amdgcn_s_sleep(1);
        if ((++sp & 255u) == 0u) { if (xb_ld(&bar[XB_TMO])) break; if (sp > XB_SPIN_CAP) { atomicAdd(&bar[XB_TMO], 1u); break; } }
    }
    nloc = mine > 0u ? mine : 1u; nx = cnt > 0u ? cnt : 1u;
}
__device__ __forceinline__ void xcd_barrier(const XcdBarrier& b) {
    asm volatile("s_waitcnt vmcnt(0)" ::: "memory");
    __syncthreads();
    if (threadIdx.x == 0) {
        unsigned* bar = b.bar;
        __builtin_amdgcn_s_waitcnt(0);
        unsigned nloc = b.st[0], nx = b.st[1];
        if (nloc == 0u) { xcd_barrier_complete(bar, b.x, nloc, nx); b.st[0] = nloc; b.st[1] = nx; }
        const unsigned old = xb_add(&bar[XB_XSUB(b.x)], 1u);
        const unsigned gen = old / nloc;
        if (old + 1u == (gen + 1u) * nloc) {
            __builtin_amdgcn_fence(__ATOMIC_RELEASE, "agent");
            asm volatile("s_waitcnt vmcnt(0)" ::: "memory");
            const unsigned og = xb_add(&bar[XB_TOP], 1u);
            const unsigned tg = og / nx;
            if (og + 1u == (tg + 1u) * nx) xb_add(&bar[XB_TOPGEN], 1u);
            else XB_SPIN(xb_ld(&bar[XB_TOPGEN]) == tg, bar);
            __builtin_amdgcn_fence(__ATOMIC_ACQUIRE, "agent");
            xb_add(&bar[XB_XGEN(b.x)], 1u);
            asm volatile("s_waitcnt vmcnt(0)" ::: "memory");
        } else {
            XB_SPIN(xb_ld(&bar[XB_XGEN(b.x)]) == gen, bar);
            __builtin_amdgcn_fence(__ATOMIC_ACQUIRE, "agent");
            asm volatile("s_waitcnt vmcnt(0)" ::: "memory");
        }
    }
    __syncthreads();
}

#define RUN_PHASE(K, CALL)                                              \
    if (ph_lo <= (K) && (K) < ph_hi) {                                  \
        CALL;                                                           \
        if (COOP) { if ((K) + 1 < ph_hi) { xcd_barrier(xb); } } \
    }

template <bool COOP>
__global__ void __launch_bounds__(512, 2) fwd_kernel(Params p, int ph_lo, int ph_hi) {
    __shared__ __attribute__((aligned(16))) char smem[SMEM_BYTES + 16];
    char* smh = smem + VHB * HALF_SMEM;
    XcdBarrier xb;
    if (COOP) {
        if (threadIdx.x == 0) *(uint4*)(smem + SMEM_BYTES) = make_uint4(0u, 0u, 0u, 0u);
        __syncthreads();
        xb = xcd_barrier_post(p.bar(), (volatile unsigned*)(smem + SMEM_BYTES));
    }
    if (COOP) { if (ph_lo < 0) cg::this_grid().sync(); }
    RUN_PHASE(0, phase_prep(p, smh))
    RUN_PHASE(1, phase_gemm_in(p, smem))
    RUN_PHASE(2, phase_mixers(p, smh))
    RUN_PHASE(3, (phase_gemm_kv(p, smh), phase_hg_scan(p)))
    RUN_PHASE(4, phase_hg_out(p, smh))
    RUN_PHASE(5, phase_gemm_out(p, smem))
    RUN_PHASE(7, phase_gemm_q_route(p, smem))
    RUN_PHASE(10, phase_peer_dots(p, smem))
    RUN_PHASE(12, phase_peer_accum(p, smem))
}

extern "C" void kernel_launch(void* const* d_in, const int* in_sizes, int n_in, void* d_out, int out_size, void* d_ws, size_t ws_size,
                              hipStream_t stream) {
    Params p{};
    p.x = (const float*)d_in[0]; p.mem = (const float*)d_in[1]; p.attn_g = (const float*)d_in[2]; p.w_in = (const float*)d_in[3];
    p.rpb = (const float*)d_in[4]; p.hg_lb = (const float*)d_in[5]; p.hg_g = (const float*)d_in[6]; p.mem_g = (const float*)d_in[7];
    p.w_kv = (const float*)d_in[8]; p.w_out = (const float*)d_in[9]; p.ffn_g = (const float*)d_in[10]; p.w_q = (const float*)d_in[11];
    p.subk = (const float*)d_in[12]; p.pu = (const float*)d_in[13]; p.pv = (const float*)d_in[14]; p.fin_g = (const float*)d_in[15];
    p.out = (float*)d_out;
    p.ws = (char*)d_ws;
    if (WS_TOTAL > ws_size) { fprintf(stderr, "workspace too small: need %zu have %zu\n", (size_t)WS_TOTAL, ws_size); return; }

#if defined(MULTI_LAUNCH)
    for (int ph = 0; ph < NPHASE; ++ph) fwd_kernel<false><<<dim3(512), dim3(512), 0, stream>>>(p, ph, ph + 1);
#else
    static int grid_blocks = 0;
    if (!grid_blocks) {
        int dev = 0, cus = 0, per_cu = 0;
        hipGetDevice(&dev);
        hipDeviceGetAttribute(&cus, hipDeviceAttributeMultiprocessorCount, dev);
        hipOccupancyMaxActiveBlocksPerMultiprocessor(&per_cu, fwd_kernel<true>, 512, 0);
        if (per_cu > 1) per_cu = 1;
        grid_blocks = (cus * per_cu) & ~3;
    }
    (void)hipMemsetAsync((char*)d_ws + OFF_BAR, 0, XCD_BAR_WORDS * 4, stream);
    int lo = 0, hi = NPHASE;
    void* args[] = {&p, &lo, &hi};
    hipError_t e = hipLaunchCooperativeKernel((void*)fwd_kernel<true>, dim3(grid_blocks), dim3(512), args, 0, stream);
    if (e != hipSuccess) fprintf(stderr, "cooperative launch failed: %s (grid %d)\n", hipGetErrorString(e), grid_blocks);
#endif
}
```

```cpp
#include <hip/hip_runtime.h>
#include <hip/hip_cooperative_groups.h>
#include <stdint.h>
#include <cstdio>

namespace cg = cooperative_groups;

#define VTID ((int)(threadIdx.x & 255))
#define VHB ((int)(threadIdx.x >> 8))
#define VBID ((int)(blockIdx.x * 2 + (threadIdx.x >> 8)))
#define VGRID ((int)(gridDim.x * 2))
constexpr int HALF_SMEM = 73728;

typedef unsigned short bf16_t;
typedef short bf16x8 __attribute__((ext_vector_type(8)));
typedef float f32x4 __attribute__((ext_vector_type(4)));
typedef int i32x4 __attribute__((ext_vector_type(4)));

constexpr int D = 1024;
constexpr int NB = 4;
constexpr int T = 8192;
constexpr int NTOK = NB * T;
constexpr int INW = 3072;
constexpr int QW = 2048;
constexpr float EPS = 1e-6f;
constexpr int SMEM_BYTES = 2 * 73728;
constexpr int NPHASE = 14;

constexpr size_t al256(size_t x) { return (x + 255) & ~(size_t)255; }
constexpr size_t OFF_W_IN_T = 0;
constexpr size_t OFF_W_OUT_T = OFF_W_IN_T + al256((size_t)3072 * 1024 * 2);
constexpr size_t OFF_W_Q_T = OFF_W_OUT_T + al256((size_t)1024 * 1024 * 2);
constexpr size_t OFF_W_KV_T = OFF_W_Q_T + al256((size_t)2048 * 1024 * 2);
constexpr size_t OFF_H = OFF_W_KV_T + al256((size_t)512 * 1024 * 2);
constexpr size_t OFF_Z = OFF_H + al256((size_t)32768 * 1024 * 2);
constexpr size_t OFF_MIX = OFF_Z + al256((size_t)32768 * 3072 * 2);
constexpr size_t OFF_MEMN = OFF_MIX + al256((size_t)32768 * 1024 * 2);
constexpr size_t OFF_KVB = OFF_MEMN + al256((size_t)1024 * 1024 * 2);
constexpr size_t OFF_LB = OFF_KVB + al256((size_t)1024 * 512 * 2);
constexpr size_t OFF_HSTATE = OFF_LB + al256(512 * 4);
constexpr size_t OFF_HDEC = OFF_HSTATE + al256((size_t)4096 * 4096 * 4);
constexpr size_t OFF_UC = OFF_HDEC + al256((size_t)4096 * 64 * 4);
constexpr size_t OFF_VC = OFF_UC + al256((size_t)16384 * 1024);
constexpr size_t OFF_QUEUE = OFF_VC + al256((size_t)16384 * 1024);
constexpr size_t OFF_SUBK = OFF_QUEUE + al256(2048 * 4);
constexpr size_t OFF_BAR = OFF_SUBK + al256((size_t)16 * 128 * 128 * 2);
constexpr size_t OFF_SS1 = OFF_BAR + al256(4096 * 4);
constexpr size_t OFF_HMAX = OFF_SS1 + al256((size_t)32768 * 4);
constexpr size_t OFF_CSUM = OFF_HMAX + al256((size_t)32768 * 4);
constexpr size_t OFF_SCALE_U = OFF_CSUM + al256((size_t)32768 * 4);
constexpr size_t OFF_SCALE_V = OFF_SCALE_U + al256(16384 * 4);
constexpr size_t OFF_VT = OFF_SCALE_V + al256(16384 * 4);
constexpr size_t OFF_KVT = OFF_VT + al256((size_t)32768 * 512 * 2);
constexpr size_t OFF_SA = OFF_KVT + al256((size_t)1024 * 256 * 2);
constexpr size_t OFF_SB = OFF_SA + al256((size_t)32768 * 4);
constexpr size_t WS_TOTAL = OFF_SB + al256((size_t)8192 * 4);
constexpr size_t OFF_EIDX = OFF_HSTATE;
constexpr size_t OFF_GATE = OFF_HSTATE + (size_t)32768 * 128 * 4;
constexpr size_t OFF_COEF = OFF_HSTATE + (size_t)32768 * 128 * 8;
constexpr size_t OFF_SS = OFF_HSTATE + (size_t)32768 * 128 * 12;
constexpr size_t OFF_PARTIAL = OFF_Z;
constexpr size_t OFF_PEER_OUT = OFF_Z + (size_t)8 * 32768 * 128 * 4;

struct Params {
    const float *x, *mem, *attn_g, *w_in, *rpb, *hg_lb, *hg_g, *mem_g, *w_kv, *w_out, *ffn_g, *w_q, *subk, *pu, *pv, *fin_g;
    float* out;
    char* ws;
#define WSF(type, name, off) __device__ __forceinline__ type* name() const { return (type*)(ws + (off)); }
    WSF(bf16_t, w_in_t, OFF_W_IN_T) WSF(bf16_t, w_out_t, OFF_W_OUT_T) WSF(bf16_t, w_q_t, OFF_W_Q_T) WSF(bf16_t, w_kv_t, OFF_W_KV_T)
    WSF(bf16_t, h, OFF_H)
    WSF(bf16_t, z, OFF_Z)
    WSF(bf16_t, mix, OFF_MIX)
    WSF(bf16_t, memn, OFF_MEMN)
    WSF(bf16_t, kvb, OFF_KVB)
    WSF(float, lb, OFF_LB)
    WSF(float, hstate, OFF_HSTATE)
    WSF(float, hdec, OFF_HDEC)
    WSF(unsigned short, eidx, OFF_EIDX)
    WSF(float, gate, OFF_GATE)
    WSF(signed char, coef, OFF_COEF)
    WSF(bf16_t, x1b, OFF_PEER_OUT)
    WSF(float, ss, OFF_SS)
    WSF(float, partial, OFF_PARTIAL)
    WSF(bf16_t, u_c, OFF_UC) WSF(bf16_t, v_c, OFF_VC)
    WSF(unsigned, queue, OFF_QUEUE)
    WSF(bf16_t, subk_b, OFF_SUBK)
    WSF(unsigned, bar, OFF_BAR)
    WSF(float, ss1, OFF_SS1) WSF(unsigned, hmax, OFF_HMAX) WSF(float, csum, OFF_CSUM)
    WSF(float, scale_u, OFF_SCALE_U) WSF(float, scale_v, OFF_SCALE_V)
    WSF(bf16_t, vT, OFF_VT)
    WSF(signed char, hq, OFF_H)
    WSF(signed char, w_in_q, OFF_W_IN_T)
    WSF(float, sa, OFF_SA) WSF(float, sb, OFF_SB)
    WSF(signed char, h2q, OFF_MIX)
    WSF(signed char, w_q_q, OFF_W_Q_T)
    WSF(bf16_t, kvT, OFF_KVT)
#undef WSF
};

__device__ __forceinline__ float bf2f(bf16_t v) { return __uint_as_float(((unsigned)v) << 16); }
__device__ __forceinline__ bf16_t f2bf(float f) {
    unsigned u = __float_as_uint(f);
    u += 0x7FFFu + ((u >> 16) & 1u);
    return (bf16_t)(u >> 16);
}
__device__ __forceinline__ float bflo(unsigned u) { return __uint_as_float(u << 16); }
__device__ __forceinline__ float bfhi(unsigned u) { return __uint_as_float(u & 0xFFFF0000u); }
typedef __bf16 bf16x2v_t __attribute__((ext_vector_type(2)));
typedef float f32x2v_t __attribute__((ext_vector_type(2)));
__device__ __forceinline__ unsigned pack2(float a, float b) {
    const f32x2v_t v = {a, b};
    return __builtin_bit_cast(unsigned, __builtin_convertvector(v, bf16x2v_t));
}

__device__ __forceinline__ float wave_sum(float v) {
#pragma unroll
    for (int o = 32; o; o >>= 1) v += __shfl_xor(v, o);
    return v;
}
__device__ __forceinline__ float wave_max(float v) {
#pragma unroll
    for (int o = 32; o; o >>= 1) v = fmaxf(v, __shfl_xor(v, o));
    return v;
}


typedef __bf16 bf16x2_t __attribute__((ext_vector_type(2)));
template <int CTRL>
__device__ __forceinline__ float dpp_mov(float v) {
    return __builtin_bit_cast(float, __builtin_amdgcn_update_dpp(0, __builtin_bit_cast(int, v), CTRL, 0xf, 0xf, true));
}
#define DPP_QP_X1 0xB1
#define DPP_QP_X2 0x4E
#define DPP_HMIRROR 0x141
#define DPP_ROR8 0x128
__device__ __forceinline__ unsigned xcc_id() { return (unsigned)__builtin_amdgcn_s_getreg((3 << 11) | 20) & 0xFu; }

__device__ __forceinline__ void transpose_tile(const float* __restrict__ in, bf16_t* __restrict__ out, int K, int N, int tile, char* smem) {
    float* tl = (float*)smem;
    const int ntn = N >> 6;
    const int k0 = (tile / ntn) << 6, n0 = (tile % ntn) << 6;
    const int tid = VTID;
    __syncthreads();
#pragma unroll 4
    for (int i = 0; i < 16; ++i) {
        int idx = tid + 256 * i;
        int r = idx >> 6, c = idx & 63;
        tl[r * 65 + c] = in[(size_t)(k0 + r) * N + n0 + c];
    }
    __syncthreads();
#pragma unroll 4
    for (int i = 0; i < 16; ++i) {
        int idx = tid + 256 * i;
        int r = idx >> 6, c = idx & 63;
        out[(size_t)(n0 + r) * K + k0 + c] = f2bf(tl[c * 65 + r]);
    }
}

__device__ __forceinline__ void rmsnorm_row_bf16(const float* __restrict__ xr, const float* __restrict__ g, bf16_t* __restrict__ o, int lane) {
    float4 v[4];
    float ss = 0.f;
#pragma unroll
    for (int j = 0; j < 4; ++j) {
        v[j] = *(const float4*)(xr + (j * 64 + lane) * 4);
        ss += v[j].x * v[j].x + v[j].y * v[j].y + v[j].z * v[j].z + v[j].w * v[j].w;
    }
    ss = wave_sum(ss);
    const float rs = rsqrtf(ss * (1.0f / 1024.0f) + EPS);
#pragma unroll
    for (int j = 0; j < 4; ++j) {
        const float4 gg = *(const float4*)(g + (j * 64 + lane) * 4);
        uint2 pk;
        pk.x = pack2(v[j].x * rs * gg.x, v[j].y * rs * gg.y);
        pk.y = pack2(v[j].z * rs * gg.z, v[j].w * rs * gg.w);
        *(uint2*)(o + (j * 64 + lane) * 4) = pk;
    }
}

__device__ __forceinline__ void rmsnorm_row_i8(const float* __restrict__ xr, const float* __restrict__ g, signed char* __restrict__ o, float* __restrict__ sa, int lane) {
    float4 v[4];
    float ss = 0.f;
#pragma unroll
    for (int j = 0; j < 4; ++j) {
        v[j] = *(const float4*)(xr + (j * 64 + lane) * 4);
        ss += v[j].x * v[j].x + v[j].y * v[j].y + v[j].z * v[j].z + v[j].w * v[j].w;
    }
    ss = wave_sum(ss);
    const float rs = rsqrtf(ss * (1.0f / 1024.0f) + EPS);
    float am = 0.f;
#pragma unroll
    for (int j = 0; j < 4; ++j) {
        const float4 gg = *(const float4*)(g + (j * 64 + lane) * 4);
        v[j].x *= rs * gg.x; v[j].y *= rs * gg.y; v[j].z *= rs * gg.z; v[j].w *= rs * gg.w;
        am = fmaxf(am, fmaxf(fmaxf(fabsf(v[j].x), fabsf(v[j].y)), fmaxf(fabsf(v[j].z), fabsf(v[j].w))));
    }
    am = wave_max(am);
    const float qs = am > 0.f ? 127.0f / am : 0.f;
    if (lane == 0) *sa = am * (1.0f / 127.0f);
#pragma unroll
    for (int j = 0; j < 4; ++j) {
        const int q0 = (int)rintf(v[j].x * qs), q1 = (int)rintf(v[j].y * qs), q2 = (int)rintf(v[j].z * qs), q3 = (int)rintf(v[j].w * qs);
        *(unsigned*)(o + (j * 64 + lane) * 4) = (unsigned)(q0 & 255) | ((unsigned)(q1 & 255) << 8) | ((unsigned)(q2 & 255) << 16) | ((unsigned)(q3 & 255) << 24);
    }
}
__device__ __forceinline__ void transpose_cols_i8(const float* __restrict__ in, signed char* __restrict__ out, float* __restrict__ sb, int N, int item, char* smem) {
    float* tl = (float*)smem;
    const int n0 = item << 4;
    const int tid = VTID;
    __syncthreads();
    {
        float4 v[16];
#pragma unroll
        for (int i = 0; i < 16; ++i) {
            const int idx = tid + 256 * i;
            v[i] = *(const float4*)(in + (size_t)(idx >> 2) * N + n0 + (idx & 3) * 4);
        }
#pragma unroll
        for (int i = 0; i < 16; ++i) {
            const int idx = tid + 256 * i;
            const int k = idx >> 2, c = (idx & 3) * 4;
            tl[(c + 0) * 1028 + k] = v[i].x; tl[(c + 1) * 1028 + k] = v[i].y; tl[(c + 2) * 1028 + k] = v[i].z; tl[(c + 3) * 1028 + k] = v[i].w;
        }
    }
    __syncthreads();
    float qs;
    {
        const int c = tid >> 4, l = tid & 15;
        float am = 0.f;
#pragma unroll 8
        for (int i = 0; i < 64; ++i) am = fmaxf(am, fabsf(tl[c * 1028 + l + 16 * i]));
        am = fmaxf(am, __shfl_xor(am, 1)); am = fmaxf(am, __shfl_xor(am, 2)); am = fmaxf(am, __shfl_xor(am, 4)); am = fmaxf(am, __shfl_xor(am, 8));
        if (l == 0) sb[n0 + c] = am * (1.0f / 127.0f);
        qs = am > 0.f ? 127.0f / am : 0.f;
    }
    __syncthreads();
    float* qt = tl + 16 * 1028;
    if ((tid & 15) == 0) qt[tid >> 4] = qs;
    __syncthreads();
#pragma unroll
    for (int i = 0; i < 16; ++i) {
        const int kq = tid * 4;
        const float q = qt[i];
        const float4 v = *(const float4*)(tl + i * 1028 + kq);
        const int q0 = (int)rintf(v.x * q), q1 = (int)rintf(v.y * q), q2 = (int)rintf(v.z * q), q3 = (int)rintf(v.w * q);
        *(unsigned*)(out + (size_t)(n0 + i) * 1024 + kq) = (unsigned)(q0 & 255) | ((unsigned)(q1 & 255) << 8) | ((unsigned)(q2 & 255) << 16) | ((unsigned)(q3 & 255) << 24);
    }
}

__device__ void phase_prep(const Params& p, char* smem) {
    const int tid = VTID, lane = tid & 63, w = tid >> 6;
    const int gsz = VGRID, bid = VBID;
    const int t_in = INW / 16;
    const int t_out = 16 * 16;
    const int t_q = QW / 16;
    const int t_kv = 16 * 8;
    const int t_all = t_in + t_out + t_q + t_kv;
    for (int it = bid; it < t_all; it += gsz) {
        if (it < t_in) transpose_cols_i8(p.w_in, p.w_in_q(), p.sb(), INW, it, smem);
        else if (it < t_in + t_out) transpose_tile(p.w_out, p.w_out_t(), 1024, 1024, it - t_in, smem);
        else if (it < t_in + t_out + t_q) transpose_cols_i8(p.w_q, p.w_q_q(), p.sb() + INW, QW, it - t_in - t_out, smem);
        else transpose_tile(p.w_kv, p.w_kv_t(), 1024, 512, it - t_in - t_out - t_q, smem);
    }
    for (int i = bid * 256 + tid; i < NTOK; i += gsz * 256) { p.ss1()[i] = 0.f; p.hmax()[i] = 0u; }
    if (bid == 0) {
        for (int i = tid; i < 512; i += 256) {
            int dir = i >> 8, k = i & 255;
            float a0 = p.hg_lb[(dir * 2 + 0) * 256 + k], a1 = p.hg_lb[(dir * 2 + 1) * 256 + k];
            float m = fmaxf(a0, a1);
            float e0 = expf(a0 - m), e1 = expf(a1 - m);
            p.lb()[i] = e0 / (e0 + e1);
        }
    }
    const int nrows = NTOK + 1024;
    for (int r0 = bid * 4; r0 < nrows; r0 += gsz * 4) {
        int r = r0 + w;
        if (r < NTOK) rmsnorm_row_i8(p.x + (size_t)r * D, p.attn_g, p.hq() + (size_t)r * D, p.sa() + r, lane);
        else if (r < nrows) rmsnorm_row_bf16(p.mem + (size_t)(r - NTOK) * D, p.mem_g, p.memn() + (size_t)(r - NTOK) * D, lane);
    }
    for (int i = bid * 256 + tid; i < 16 * 128 * 128 / 4; i += gsz * 256) {
        const float4 v = *(const float4*)(p.subk + (size_t)i * 4);
        uint2 pk; pk.x = pack2(v.x, v.y); pk.y = pack2(v.z, v.w);
        *(uint2*)(p.subk_b() + (size_t)i * 4) = pk;
    }
    for (int r0 = bid * 4; r0 < 2 * 16384; r0 += gsz * 4) {
        const int r = r0 + w;
        const bool isv = r >= 16384;
        const int e = r & 16383;
        const float* srcp = (isv ? p.pv : p.pu) + (size_t)e * D;
        unsigned* dst = (unsigned*)(isv ? p.v_c() : p.u_c());
        float4 v[4];
        float am = 0.f;
#pragma unroll
        for (int j = 0; j < 4; ++j) {
            v[j] = *(const float4*)(srcp + (j * 64 + lane) * 4);
            am = fmaxf(am, fmaxf(fmaxf(fabsf(v[j].x), fabsf(v[j].y)), fmaxf(fabsf(v[j].z), fabsf(v[j].w))));
        }
        am = wave_max(am);
        const float qs = am > 0.f ? 127.0f / am : 0.f;
        if (lane == 0) (isv ? p.scale_v() : p.scale_u())[e] = am * (1.0f / 127.0f);
        const int off = 0;
#pragma unroll
        for (int j = 0; j < 4; ++j) {
            const int q0 = (int)rintf(v[j].x * qs) + off, q1 = (int)rintf(v[j].y * qs) + off;
            const int q2 = (int)rintf(v[j].z * qs) + off, q3 = (int)rintf(v[j].w * qs) + off;
            const unsigned pk = (unsigned)(q0 & 255) | ((unsigned)(q1 & 255) << 8) | ((unsigned)(q2 & 255) << 16) | ((unsigned)(q3 & 255) << 24);
            const int c = j * 2 + (lane >> 5), d = (lane & 31) * 4;
            dst[(((size_t)c * 16384 + e) * 128 + d) >> 2] = pk;
        }
    }
}

struct EpiBf16 {
    bf16_t* C; int ldc;
    __device__ __forceinline__ void operator()(int row, int col, const f32x4& v) const {
        uint2 pk; pk.x = pack2(v[0], v[1]); pk.y = pack2(v[2], v[3]);
        *(uint2*)(C + (size_t)row * ldc + col) = pk;
    }
};
struct EpiBf16T {
    bf16_t* C; int col0, ncols, rows_per_b;
    __device__ __forceinline__ void operator()(int row, int col, const f32x4& v) const {
        const int bb = row / rows_per_b, rr = row - bb * rows_per_b;
        uint2 pk; pk.x = pack2(v[0], v[1]); pk.y = pack2(v[2], v[3]);
        *(uint2*)(C + ((size_t)bb * ncols + (col - col0)) * rows_per_b + rr) = pk;
    }
};
struct EpiBf16S {
    bf16_t* C; int ldc; const float* sa; const float* sb;
    __device__ __forceinline__ void operator()(int row, int col, const f32x4& v) const {
        const float s = sa[row];
        const float4 b = *(const float4*)(sb + col);
        uint2 pk; pk.x = pack2(v[0] * s * b.x, v[1] * s * b.y); pk.y = pack2(v[2] * s * b.z, v[3] * s * b.w);
        *(uint2*)(C + (size_t)row * ldc + col) = pk;
    }
};
struct EpiBf16TS {
    bf16_t* C; int col0, ncols, rows_per_b; const float* sa; const float* sb;
    __device__ __forceinline__ void operator()(int row, int col, const f32x4& v) const {
        const int bb = row / rows_per_b, rr = row - bb * rows_per_b;
        const float4 a = *(const float4*)(sa + row);
        const float b = sb[col];
        uint2 pk; pk.x = pack2(v[0] * a.x * b, v[1] * a.y * b); pk.y = pack2(v[2] * a.z * b, v[3] * a.w * b);
        *(uint2*)(C + ((size_t)bb * ncols + (col - col0)) * rows_per_b + rr) = pk;
    }
};
struct EpiBf16RowScale {
    bf16_t* C; int ldc; const float* ssrow;
    __device__ __forceinline__ void operator()(int row, int col, const f32x4& v) const {
        const float rs = rsqrtf(ssrow[row] * (1.0f / 1024.0f) + EPS);
        uint2 pk; pk.x = pack2(v[0] * rs, v[1] * rs); pk.y = pack2(v[2] * rs, v[3] * rs);
        *(uint2*)(C + (size_t)row * ldc + col) = pk;
    }
};
struct EpiResNorm {
    bf16_t* C; const float* R; const float* g; int ldc; float* ssrow; unsigned* hmax;
    __device__ __forceinline__ void operator()(int row, int col, const f32x4& v, float& ssq, float& am) const {
        const float4 r = *(const float4*)(R + (size_t)row * ldc + col);
        const float4 gg = *(const float4*)(g + col);
        float4 o; o.x = v[0] + r.x; o.y = v[1] + r.y; o.z = v[2] + r.z; o.w = v[3] + r.w;
        uint2 xk; xk.x = pack2(o.x, o.y); xk.y = pack2(o.z, o.w);
        *(uint2*)(C + (size_t)row * ldc + col) = xk;
        const float h0 = bflo(xk.x) * gg.x, h1 = bfhi(xk.x) * gg.y, h2 = bflo(xk.y) * gg.z, h3 = bfhi(xk.y) * gg.w;
        ssq += o.x * o.x + o.y * o.y + o.z * o.z + o.w * o.w;
        am = fmaxf(am, fmaxf(fmaxf(fabsf(h0), fabsf(h1)), fmaxf(fabsf(h2), fabsf(h3))));
    }
    __device__ __forceinline__ void row_done(int row, float ssq, float am) const {
        atomicAdd(ssrow + row, ssq);
        atomicMax(hmax + row, __float_as_uint(am));
    }
};
struct EpiResF32 {
    float* C; const float* R; int ldc;
    __device__ __forceinline__ void operator()(int row, int col, const f32x4& v) const {
        const float4 r = *(const float4*)(R + (size_t)row * ldc + col);
        float4 o; o.x = v[0] + r.x; o.y = v[1] + r.y; o.z = v[2] + r.z; o.w = v[3] + r.w;
        *(float4*)(C + (size_t)row * ldc + col) = o;
    }
};

template <bool TRANS, class Epi, bool ROWSS = false>
__device__ __forceinline__ void gemm_tile(const bf16_t* __restrict__ A, int lda, const bf16_t* __restrict__ Bt, int ldb, int K,
                                          int m0, int n0, char* smem, const Epi& epi, float* ssrow = nullptr) {
    const int tid = VTID, lane = tid & 63, w = tid >> 6, wr = w >> 1, wc = w & 1;
    const int fr = lane & 15, fq = lane >> 4;
    const int srow = lane >> 3, sslot = lane & 7;
    f32x4 acc[4][4];
#pragma unroll
    for (int mi = 0; mi < 4; ++mi)
#pragma unroll
        for (int ni = 0; ni < 4; ++ni) acc[mi][ni] = (f32x4){0.f, 0.f, 0.f, 0.f};
    const int g0 = (sslot ^ (srow >> 1)) * 8, g1 = (sslot ^ (4 + (srow >> 1))) * 8;
    const bf16_t* Ab = A + (size_t)(m0 + w * 32 + srow) * lda;
    const bf16_t* Bb = Bt + (size_t)(n0 + w * 32 + srow) * ldb;
    const int nk = K >> 6;
    __syncthreads();
#define GEMM_STAGE(kt, buf)                                                                                                  \
    do {                                                                                                                     \
        char* sa = smem + (buf) * 32768 + w * 4096;                                                                          \
        char* sb = sa + 16384;                                                                                               \
        _Pragma("unroll") for (int i = 0; i < 4; ++i) {                                                                      \
            const int gc = (i & 1) ? g1 : g0;                                                                                \
            __builtin_amdgcn_global_load_lds((const unsigned*)(Ab + (size_t)(i * 8) * lda + (kt) * 64 + gc), (unsigned*)(sa + i * 1024), 16, 0, 0); \
            __builtin_amdgcn_global_load_lds((const unsigned*)(Bb + (size_t)(i * 8) * ldb + (kt) * 64 + gc), (unsigned*)(sb + i * 1024), 16, 0, 0); \
        }                                                                                                                    \
    } while (0)
    GEMM_STAGE(0, 0);
    const int key = fr >> 1;
    for (int kt = 0; kt < nk; ++kt) {
        asm volatile("s_waitcnt vmcnt(0)" ::: "memory");
        __syncthreads();
        if (kt + 1 < nk) GEMM_STAGE(kt + 1, (kt + 1) & 1);
        const char* sa = smem + (kt & 1) * 32768;
        const char* sb = sa + 16384;
#pragma unroll
        for (int ks = 0; ks < 2; ++ks) {
            bf16x8 af[4], bfr[4];
            const int co = ((ks * 4 + fq) ^ key) << 4;
#pragma unroll
            for (int mi = 0; mi < 4; ++mi) af[mi] = *(const bf16x8*)(sa + (wr * 64 + mi * 16 + fr) * 128 + co);
#pragma unroll
            for (int ni = 0; ni < 4; ++ni) bfr[ni] = *(const bf16x8*)(sb + (wc * 64 + ni * 16 + fr) * 128 + co);
#pragma unroll
            for (int mi = 0; mi < 4; ++mi)
#pragma unroll
                for (int ni = 0; ni < 4; ++ni)
                    acc[mi][ni] = TRANS ? __builtin_amdgcn_mfma_f32_16x16x32_bf16(af[mi], bfr[ni], acc[mi][ni], 0, 0, 0)
                                        : __builtin_amdgcn_mfma_f32_16x16x32_bf16(bfr[ni], af[mi], acc[mi][ni], 0, 0, 0);
        }
    }
#undef GEMM_STAGE
    if constexpr (ROWSS) {
#pragma unroll
        for (int mi = 0; mi < 4; ++mi) {
            const int row = m0 + wr * 64 + mi * 16 + fr;
            float ssq = 0.f, am = 0.f;
#pragma unroll
            for (int ni = 0; ni < 4; ++ni) epi(row, n0 + wc * 64 + ni * 16 + fq * 4, acc[mi][ni], ssq, am);
            ssq += __shfl_xor(ssq, 16);
            ssq += __shfl_xor(ssq, 32);
            am = fmaxf(am, __shfl_xor(am, 16));
            am = fmaxf(am, __shfl_xor(am, 32));
            if (fq == 0) epi.row_done(row, ssq, am);
        }
    } else {
#pragma unroll
        for (int mi = 0; mi < 4; ++mi)
#pragma unroll
            for (int ni = 0; ni < 4; ++ni) {
                if (TRANS) epi(m0 + wr * 64 + mi * 16 + fq * 4, n0 + wc * 64 + ni * 16 + fr, acc[mi][ni]);
                else epi(m0 + wr * 64 + mi * 16 + fr, n0 + wc * 64 + ni * 16 + fq * 4, acc[mi][ni]);
            }
    }
}


namespace g8 {
constexpr int BM = 256, BK = 64, HALF = 128, HT = HALF * BK;
__device__ __forceinline__ int lds_byte(int r, int c) {
    const int st = (r >> 4) * 2 + (c >> 5), rr = r & 15, cc = c & 31, ob = rr * 64 + cc * 2;
    return st * 1024 + (ob ^ (((ob >> 9) & 1) << 5));
}
__device__ __forceinline__ void stage_rc(int b, int& R, int& C) {
    const int st = b / 1024, sb = b % 1024, swz = sb ^ (((sb >> 9) & 1) << 5);
    R = (st >> 1) * 16 + swz / 64; C = (st & 1) * 32 + (swz % 64) / 2;
}
__device__ __forceinline__ void tile_of(int L, int nM, int nN, int& pm, int& pn) {
    const int nwg = nM * nN;
    int wgid = L;
    { const int q = nwg / 8, r = nwg % 8, xcd = wgid % 8, off = wgid / 8; wgid = (xcd < r ? xcd * (q + 1) : r * (q + 1) + (xcd - r) * q) + off; }
    const int nig = 8 * nN, gid = wgid / nig, fm = gid * 8, gsz = (nM - fm) < 8 ? (nM - fm) : 8;
    pm = fm + ((wgid % nig) % gsz); pn = (wgid % nig) / gsz;
}
}

#define G8_LAS __attribute__((address_space(3)))
template <bool I8, bool TRANS, class Acc>
__device__ __forceinline__ void g8_mma(Acc& c, const bf16x8& a, const bf16x8& b) {
    if constexpr (I8) {
        const i32x4 ai = __builtin_bit_cast(i32x4, a), bi = __builtin_bit_cast(i32x4, b);
        c = TRANS ? __builtin_amdgcn_mfma_i32_16x16x64_i8(ai, bi, c, 0, 0, 0) : __builtin_amdgcn_mfma_i32_16x16x64_i8(bi, ai, c, 0, 0, 0);
    } else {
        c = TRANS ? __builtin_amdgcn_mfma_f32_16x16x32_bf16(a, b, c, 0, 0, 0) : __builtin_amdgcn_mfma_f32_16x16x32_bf16(b, a, c, 0, 0, 0);
    }
}
template <bool I8> struct g8_acc { using type = f32x4; };
template <> struct g8_acc<true> { using type = i32x4; };
template <bool I8, class Acc> __device__ __forceinline__ f32x4 g8_cvt(const Acc& a) {
    if constexpr (I8) return (f32x4){(float)a[0], (float)a[1], (float)a[2], (float)a[3]};
    else return a;
}
template <bool TRANS, bool ROWSS, bool I8, class Epi>
__device__ __forceinline__ void gemm256_tile(const void* __restrict__ A, const void* __restrict__ Bt, int K, int brow, int bcol,
                                             char* shmc, const Epi& epi) {
    using namespace g8;
    constexpr int ES = I8 ? 1 : 2;
    using acc_t = typename g8_acc<I8>::type;
    G8_LAS unsigned char* lds = (G8_LAS unsigned char*)shmc;
    const int tid = threadIdx.x, wid = __builtin_amdgcn_readfirstlane(tid >> 6), lane = tid & 63, wr = wid >> 2, wc = wid & 3, fr = lane & 15, fq = lane >> 4;
    constexpr int HTB = HALF * BK * 2;
    unsigned voff[2];
#pragma unroll
    for (int i = 0; i < 2; ++i) { int R, C; stage_rc(tid * 16 + i * 8192, R, C); voff[i] = (unsigned)(R * K * ES + C * 2); }
    const size_t kstep = (size_t)(BK * 2);
    const size_t hstep = (size_t)HALF * K * ES;
    const unsigned ldsw = (unsigned)wid * 1024u;
    const int aoff = lds_byte(wr * 64 + fr, fq * 8), boff = lds_byte(wc * 32 + fr, fq * 8);
    const char* cA = (const char*)A + (size_t)brow * K * ES;
    const char* cB = (const char*)Bt + (size_t)bcol * K * ES;
#define G8_SA(b, h) (((b) * 2 + (h)) * HTB)
#define G8_SB(b, h) ((4 + (b) * 2 + (h)) * HTB)
#define G8_STAGE(bufoff, gbase) do { _Pragma("unroll") for (int _i = 0; _i < 2; ++_i) \
        __builtin_amdgcn_global_load_lds((const unsigned*)((const char*)(gbase) + voff[_i]), (G8_LAS unsigned*)(lds + (bufoff) + ldsw + _i * 8192), 16, 0, 0); } while (0)
#define G8_LDA(dst, b, h) do { _Pragma("unroll") for (int m = 0; m < 4; ++m) _Pragma("unroll") for (int k = 0; k < 2; ++k) dst[m][k] = *(const G8_LAS bf16x8*)(lds + G8_SA(b, h) + aoff + m * 2048 + k * 1024); } while (0)
#define G8_LDB(dst, b, h) do { _Pragma("unroll") for (int n = 0; n < 2; ++n) _Pragma("unroll") for (int k = 0; k < 2; ++k) dst[n][k] = *(const G8_LAS bf16x8*)(lds + G8_SB(b, h) + boff + n * 2048 + k * 1024); } while (0)
#define G8_MMA(ai, bj, At_, Bt_) do { __builtin_amdgcn_s_setprio(1); _Pragma("unroll") for (int m = 0; m < 4; ++m) _Pragma("unroll") for (int n = 0; n < 2; ++n) _Pragma("unroll") for (int k = 0; k < 2; ++k) \
        g8_mma<I8, TRANS>(acc[ai][bj][m][n], At_[m][k], Bt_[n][k]); \
        __builtin_amdgcn_s_setprio(0); } while (0)
#define G8_WAIT_V(n) asm volatile("s_waitcnt vmcnt(" #n ")" ::: "memory")
#define G8_WAIT_L(n) asm volatile("s_waitcnt lgkmcnt(" #n ")" ::: "memory")
#define G8_BAR __builtin_amdgcn_s_barrier()
#define G8_SCHED __builtin_amdgcn_sched_barrier(0)
    acc_t acc[2][2][4][2];
#pragma unroll
    for (int a = 0; a < 2; ++a)
#pragma unroll
        for (int b = 0; b < 2; ++b)
#pragma unroll
            for (int m = 0; m < 4; ++m)
#pragma unroll
                for (int n = 0; n < 2; ++n) acc[a][b][m][n] = (acc_t){0, 0, 0, 0};
    bf16x8 At[4][2], B0[2][2], B1[2][2];
    const int nt = K * ES / (BK * 2);
    __syncthreads();
    G8_STAGE(G8_SB(0, 0), cB); G8_STAGE(G8_SA(0, 0), cA); G8_STAGE(G8_SB(0, 1), cB + hstep); G8_STAGE(G8_SA(0, 1), cA + hstep);
    if (wr == 1) G8_BAR;
    G8_WAIT_V(4); G8_BAR;
    G8_STAGE(G8_SB(1, 0), cB + kstep); G8_STAGE(G8_SA(1, 0), cA + kstep); G8_STAGE(G8_SB(1, 1), cB + hstep + kstep);
    G8_WAIT_V(6); G8_BAR;
    for (int t = 0; t < nt - 2; t += 2) {
        const char* a1 = cA + (size_t)(t + 1) * kstep; const char* a2 = a1 + kstep; const char* a3 = a2 + kstep;
        const char* b2 = cB + (size_t)(t + 2) * kstep; const char* b3 = b2 + kstep;
        G8_LDB(B0, 0, 0); G8_SCHED; G8_LDA(At, 0, 0); G8_STAGE(G8_SA(1, 1), a1 + hstep);
        G8_WAIT_L(8); G8_BAR; G8_WAIT_L(0); G8_MMA(0, 0, At, B0); G8_BAR; G8_SCHED;
        G8_LDB(B1, 0, 1); G8_STAGE(G8_SB(0, 0), b2);
        G8_BAR; G8_WAIT_L(0); G8_MMA(0, 1, At, B1); G8_BAR;
        G8_LDA(At, 0, 1); G8_STAGE(G8_SA(0, 0), a2);
        G8_BAR; G8_WAIT_L(0); G8_MMA(1, 0, At, B0); G8_BAR; G8_SCHED;
        G8_STAGE(G8_SB(0, 1), b2 + hstep);
        G8_WAIT_V(6); G8_BAR; G8_MMA(1, 1, At, B1); G8_BAR;
        G8_LDB(B0, 1, 0); G8_SCHED; G8_LDA(At, 1, 0); G8_STAGE(G8_SA(0, 1), a2 + hstep);
        G8_WAIT_L(8); G8_BAR; G8_WAIT_L(0); G8_MMA(0, 0, At, B0); G8_BAR; G8_SCHED;
        G8_LDB(B1, 1, 1); G8_STAGE(G8_SB(1, 0), b3);
        G8_BAR; G8_WAIT_L(0); G8_MMA(0, 1, At, B1); G8_BAR;
        G8_LDA(At, 1, 1); G8_STAGE(G8_SA(1, 0), a3);
        G8_BAR; G8_WAIT_L(0); G8_MMA(1, 0, At, B0); G8_BAR; G8_SCHED;
        G8_STAGE(G8_SB(1, 1), b3 + hstep);
        G8_WAIT_V(6); G8_BAR; G8_MMA(1, 1, At, B1); G8_BAR;
    }
    { G8_LDB(B0, 0, 0); G8_LDA(At, 0, 0); G8_STAGE(G8_SA(1, 1), cA + (size_t)(nt - 1) * kstep + hstep);
      G8_BAR; G8_WAIT_L(0); G8_MMA(0, 0, At, B0); G8_BAR;
      G8_LDB(B1, 0, 1); G8_BAR; G8_WAIT_L(0); G8_MMA(0, 1, At, B1); G8_BAR;
      G8_LDA(At, 0, 1); G8_WAIT_V(4); G8_BAR; G8_WAIT_L(0); G8_MMA(1, 0, At, B0); G8_MMA(1, 1, At, B1); G8_BAR; }
    { G8_LDB(B0, 1, 0); G8_LDA(At, 1, 0); G8_WAIT_V(2); G8_BAR; G8_WAIT_L(0); G8_MMA(0, 0, At, B0); G8_BAR;
      G8_LDB(B1, 1, 1); G8_WAIT_V(0); G8_BAR; G8_WAIT_L(0); G8_MMA(0, 1, At, B1); G8_BAR;
      G8_LDA(At, 1, 1); G8_BAR; G8_WAIT_L(0); G8_MMA(1, 0, At, B0); G8_MMA(1, 1, At, B1); G8_BAR; }
    if (wr == 0) G8_BAR;
    if constexpr (ROWSS) {
#pragma unroll
        for (int ai = 0; ai < 2; ++ai)
#pragma unroll
            for (int m = 0; m < 4; ++m) {
                const int row = brow + ai * HALF + wr * 64 + m * 16 + fr;
                float ssq = 0.f, am = 0.f;
#pragma unroll
                for (int bj = 0; bj < 2; ++bj)
#pragma unroll
                    for (int n = 0; n < 2; ++n) epi(row, bcol + bj * HALF + wc * 32 + n * 16 + fq * 4, g8_cvt<I8>(acc[ai][bj][m][n]), ssq, am);
                ssq += __shfl_xor(ssq, 16);
                ssq += __shfl_xor(ssq, 32);
                am = fmaxf(am, __shfl_xor(am, 16));
                am = fmaxf(am, __shfl_xor(am, 32));
                if (fq == 0) epi.row_done(row, ssq, am);
            }
    } else {
#pragma unroll
        for (int ai = 0; ai < 2; ++ai)
#pragma unroll
            for (int bj = 0; bj < 2; ++bj)
#pragma unroll
                for (int m = 0; m < 4; ++m)
#pragma unroll
                    for (int n = 0; n < 2; ++n) {
                        if (TRANS) epi(brow + ai * HALF + wr * 64 + m * 16 + fq * 4, bcol + bj * HALF + wc * 32 + n * 16 + fr, g8_cvt<I8>(acc[ai][bj][m][n]));
                        else epi(brow + ai * HALF + wr * 64 + m * 16 + fr, bcol + bj * HALF + wc * 32 + n * 16 + fq * 4, g8_cvt<I8>(acc[ai][bj][m][n]));
                    }
    }
#undef G8_SA
#undef G8_SB
#undef G8_STAGE
#undef G8_LDA
#undef G8_LDB
#undef G8_MMA
#undef G8_WAIT_V
#undef G8_WAIT_L
#undef G8_BAR
#undef G8_SCHED
}

__device__ void phase_gemm_in(const Params& p, char* smem) {
    const int nM = NTOK / 256, nN = INW / 256;
    EpiBf16S e1{p.z(), INW, p.sa(), p.sb()};
    EpiBf16TS e1t{p.vT(), 1024, 512, T, p.sa(), p.sb()};
    for (int i = 0; i * (int)gridDim.x + (int)blockIdx.x < nM * nN; ++i) {
        int pm, pn;
        g8::tile_of(i * gridDim.x + blockIdx.x, nM, nN, pm, pn);
        if (pn >= 4 && pn < 6) gemm256_tile<true, false, true>(p.hq(), p.w_in_q(), D, pm * 256, pn * 256, smem, e1t);
        else gemm256_tile<false, false, true>(p.hq(), p.w_in_q(), D, pm * 256, pn * 256, smem, e1);
    }
}

__device__ void phase_gemm_kv(const Params& p, char* smh) {
    EpiBf16 e2{p.kvb(), 512};
    EpiBf16T e2t{p.kvT(), 256, 256, 256};
    const bool dedicated = gridDim.x >= 64;
    if (dedicated && blockIdx.x >= 16) return;
    for (int it = VBID; it < 32; it += dedicated ? 32 : VGRID) {
        const int pm = it >> 2, pn = it & 3;
        if (pn >= 2) gemm_tile<true>(p.memn(), D, p.w_kv_t(), D, D, pm * 128, pn * 128, smh, e2t);
        else gemm_tile<false>(p.memn(), D, p.w_kv_t(), D, D, pm * 128, pn * 128, smh, e2);
    }
}

__device__ void phase_gemm_out(const Params& p, char* smem) {
    const int nM = NTOK / 256, nN = D / 256;
    EpiResNorm e{p.x1b(), p.x, p.ffn_g, D, p.ss1(), p.hmax()};
    for (int i = 0; i * (int)gridDim.x + (int)blockIdx.x < nM * nN; ++i) {
        int pm, pn;
        g8::tile_of(i * gridDim.x + blockIdx.x, nM, nN, pm, pn);
        gemm256_tile<false, true, false>(p.mix(), p.w_out_t(), D, pm * 256, pn * 256, smem, e);
    }
}

__device__ void phase_gemm_q(const Params& p, char* smem) {
    const int nM = NTOK / 256, nN = QW / 256;
    EpiBf16RowScale e{p.z(), QW, p.ss1()};
    for (int i = 0; i * (int)gridDim.x + (int)blockIdx.x < nM * nN; ++i) {
        int pm, pn;
        g8::tile_of(i * gridDim.x + blockIdx.x, nM, nN, pm, pn);
        gemm256_tile<false, false, false>(p.h(), p.w_q_t(), D, pm * 256, pn * 256, smem, e);
    }
}

typedef float f32x16 __attribute__((ext_vector_type(16)));
constexpr int HRS = 144;
__device__ __forceinline__ f32x16 tile_mm64(const char* X, const char* Y, int xrow0, int yrow0, int lane, f32x16 acc) {
    const int r = lane & 31, hh = lane >> 5;
#pragma unroll
    for (int ks = 0; ks < 4; ++ks) {
        const bf16x8 a = *(const bf16x8*)(X + (xrow0 + r) * HRS + ks * 32 + hh * 16);
        const bf16x8 b = *(const bf16x8*)(Y + (yrow0 + r) * HRS + ks * 32 + hh * 16);
        acc = __builtin_amdgcn_mfma_f32_32x32x16_bf16(a, b, acc, 0, 0, 0);
    }
    return acc;
}
__device__ __forceinline__ int crow(int reg, int hh) { return (reg & 3) + 8 * (reg >> 2) + 4 * hh; }

__device__ __forceinline__ void hg_load_vt(const Params& p, char* sVT, int tok0, int h, int kcol, int sq) {
    const bf16_t* zp = p.z() + (size_t)(tok0 + sq * 16) * INW + 2304 + h * 64 + kcol;
    unsigned pk[8];
#pragma unroll
    for (int j = 0; j < 8; ++j) {
        const unsigned lo = zp[(size_t)(2 * j) * INW], hi = zp[(size_t)(2 * j + 1) * INW];
        pk[j] = lo | (hi << 16);
    }
    *(uint4*)(sVT + kcol * HRS + sq * 32) = make_uint4(pk[0], pk[1], pk[2], pk[3]);
    *(uint4*)(sVT + kcol * HRS + sq * 32 + 16) = make_uint4(pk[4], pk[5], pk[6], pk[7]);
}

__device__ __forceinline__ float hg_gates(const Params& p, float* sTot, int tok0, int h, int dir, int kcol, int sq, float (&bj)[16], float (&kk)[16]) {
    const bf16_t* zp = p.z() + (size_t)(tok0 + sq * 16) * INW + 1792 + dir * 256 + h * 64 + kcol;
    const float lbv = p.lb()[dir * 256 + h * 64 + kcol];
#pragma unroll
    for (int j = 0; j < 16; ++j) {
        const float pre = bf2f(zp[(size_t)j * INW]);
        const float f = lbv + (1.0f - lbv) * (1.0f / (1.0f + __expf(-pre)));
        bj[j] = __logf(f);
        kk[j] = 1.0f - f;
    }
    if (dir == 0) {
#pragma unroll
        for (int j = 1; j < 16; ++j) bj[j] += bj[j - 1];
        sTot[sq * 64 + kcol] = bj[15];
    } else {
#pragma unroll
        for (int j = 14; j >= 0; --j) bj[j] += bj[j + 1];
        sTot[sq * 64 + kcol] = bj[0];
    }
    __syncthreads();
    const float t0 = sTot[kcol], t1 = sTot[64 + kcol], t2 = sTot[128 + kcol], t3 = sTot[192 + kcol];
    float off;
    if (dir == 0) off = (sq > 0 ? t0 : 0.f) + (sq > 1 ? t1 : 0.f) + (sq > 2 ? t2 : 0.f);
    else off = (sq < 3 ? t3 : 0.f) + (sq < 2 ? t2 : 0.f) + (sq < 1 ? t1 : 0.f);
#pragma unroll
    for (int j = 0; j < 16; ++j) bj[j] += off;
    return t0 + t1 + t2 + t3;
}

__device__ void hg_local(const Params& p, char* smem) {
    char* sVT = smem;
    char* sKT = smem + 9216;
    float* sTot = (float*)(smem + 18432);
    const int tid = VTID, lane = tid & 63, w = tid >> 6;
    const int kcol = tid & 63, sq = tid >> 6;
    for (int item = VBID; item < 4096; item += VGRID) {
        const int c = item & 127, dir = (item >> 7) & 1, h = (item >> 8) & 3, b = item >> 10;
        const int tok0 = b * T + c * 64;
        __syncthreads();
        hg_load_vt(p, sVT, tok0, h, kcol, sq);
        float bj[16], kk[16];
        const float btot = hg_gates(p, sTot, tok0, h, dir, kcol, sq, bj, kk);
        unsigned pk[8];
#pragma unroll
        for (int j = 0; j < 8; ++j)
            pk[j] = pack2(kk[2 * j] * __expf(btot - bj[2 * j]), kk[2 * j + 1] * __expf(btot - bj[2 * j + 1]));
        *(uint4*)(sKT + kcol * HRS + sq * 32) = make_uint4(pk[0], pk[1], pk[2], pk[3]);
        *(uint4*)(sKT + kcol * HRS + sq * 32 + 16) = make_uint4(pk[4], pk[5], pk[6], pk[7]);
        if (sq == 0) p.hdec()[item * 64 + kcol] = __expf(btot);
        __syncthreads();
        const int vi = w >> 1, ki = w & 1, hh = lane >> 5;
        f32x16 acc;
#pragma unroll
        for (int r = 0; r < 16; ++r) acc[r] = 0.f;
        acc = tile_mm64(sVT, sKT, vi * 32, ki * 32, lane, acc);
        bf16_t* dst = (bf16_t*)p.hstate() + (size_t)item * 4096 + ki * 32 + (lane & 31);
#pragma unroll
        for (int r = 0; r < 16; ++r) dst[(vi * 32 + crow(r, hh)) * 64] = f2bf(acc[r]);
    }
}

__device__ __forceinline__ bf16x8 pack8(const f32x16& x, int s8) {
    typedef unsigned u32x4_t __attribute__((ext_vector_type(4)));
    u32x4_t pk;
    pk[0] = pack2(x[s8], x[s8 + 1]); pk[1] = pack2(x[s8 + 2], x[s8 + 3]);
    pk[2] = pack2(x[s8 + 4], x[s8 + 5]); pk[3] = pack2(x[s8 + 6], x[s8 + 7]);
    return __builtin_bit_cast(bf16x8, pk);
}
__device__ __forceinline__ bf16x8 join8(const uint2& lo, const uint2& hi) {
    typedef unsigned u32x4_t __attribute__((ext_vector_type(4)));
    u32x4_t pk; pk[0] = lo.x; pk[1] = lo.y; pk[2] = hi.x; pk[3] = hi.y;
    return __builtin_bit_cast(bf16x8, pk);
}

__device__ __forceinline__ int swap23(int r) { return (r & ~12) | ((r & 4) << 1) | ((r & 8) >> 1); }

__device__ __forceinline__ void mem_attn_wave(const Params& p, int wu, int lane) {
    const int tile = wu & 255, h = (wu >> 8) & 3, b = wu >> 10;
    const int l31 = lane & 31, hh = lane >> 5;
    const int tok = b * T + tile * 32 + l31;
    bf16x8 qf[4];
#pragma unroll
    for (int ks = 0; ks < 4; ++ks) qf[ks] = *(const bf16x8*)(p.z() + (size_t)tok * INW + 2816 + h * 64 + ks * 16 + hh * 8);
    const bf16_t* kb = p.kvb() + (size_t)(b * 256 + swap23(l31)) * 512 + h * 64 + hh * 8;
    float m = -1e30f;
    f32x16 o0, o1;
#pragma unroll
    for (int r = 0; r < 16; ++r) { o0[r] = 0.f; o1[r] = 0.f; }
    float sum = 0.f;
    const bf16_t* vt = p.kvT() + ((size_t)(b * 4 + h) * 64 + l31) * 256 + 8 * hh;
    bf16x8 kf[4], vf[4];
#pragma unroll
    for (int ks = 0; ks < 4; ++ks) kf[ks] = *(const bf16x8*)(kb + ks * 16);
#pragma unroll
    for (int st = 0; st < 2; ++st) { vf[2 * st] = *(const bf16x8*)(vt + st * 16); vf[2 * st + 1] = *(const bf16x8*)(vt + 32 * 256 + st * 16); }
    for (int kt = 0; kt < 8; ++kt) {
        const int ktn = min(kt + 1, 7);
        bf16x8 kn[4], vn[4];
#pragma unroll
        for (int ks = 0; ks < 4; ++ks) kn[ks] = *(const bf16x8*)(kb + (size_t)ktn * 32 * 512 + ks * 16);
#pragma unroll
        for (int st = 0; st < 2; ++st) { vn[2 * st] = *(const bf16x8*)(vt + ktn * 32 + st * 16); vn[2 * st + 1] = *(const bf16x8*)(vt + 32 * 256 + ktn * 32 + st * 16); }
        f32x16 s;
#pragma unroll
        for (int r = 0; r < 16; ++r) s[r] = 0.f;
#pragma unroll
        for (int ks = 0; ks < 4; ++ks) s = __builtin_amdgcn_mfma_f32_32x32x16_bf16(kf[ks], qf[ks], s, 0, 0, 0);
        float tm = s[0];
#pragma unroll
        for (int r = 1; r < 16; ++r) tm = fmaxf(tm, s[r]);
        tm = fmaxf(tm, __shfl_xor(tm, 32));
        const float mn = fmaxf(m, tm);
        if (__any(mn > m)) {
            const float sc = __builtin_amdgcn_exp2f((m - mn) * 0.18033688011112042f);
            sum *= sc;
#pragma unroll
            for (int r = 0; r < 16; ++r) { o0[r] *= sc; o1[r] *= sc; }
        }
        m = mn;
        const float mb = mn * 0.18033688011112042f;
#pragma unroll
        for (int r = 0; r < 16; ++r) { s[r] = __builtin_amdgcn_exp2f(fmaf(s[r], 0.18033688011112042f, -mb)); sum += s[r]; }
#pragma unroll
        for (int st = 0; st < 2; ++st) {
            const bf16x8 pb = pack8(s, st * 8);
            o0 = __builtin_amdgcn_mfma_f32_32x32x16_bf16(vf[2 * st], pb, o0, 0, 0, 0);
            o1 = __builtin_amdgcn_mfma_f32_32x32x16_bf16(vf[2 * st + 1], pb, o1, 0, 0, 0);
        }
#pragma unroll
        for (int ks = 0; ks < 4; ++ks) kf[ks] = kn[ks];
#pragma unroll
        for (int q = 0; q < 4; ++q) vf[q] = vn[q];
    }
    sum += __shfl_xor(sum, 32);
    const float inv = 1.0f / sum;
    bf16_t* mo = p.mix() + (size_t)tok * D + 768 + h * 64 + 4 * hh;
#pragma unroll
    for (int g = 0; g < 4; ++g) {
        uint2 pk;
        pk.x = pack2(o0[4 * g] * inv, o0[4 * g + 1] * inv); pk.y = pack2(o0[4 * g + 2] * inv, o0[4 * g + 3] * inv);
        *(uint2*)(mo + 8 * g) = pk;
        pk.x = pack2(o1[4 * g] * inv, o1[4 * g + 1] * inv); pk.y = pack2(o1[4 * g + 2] * inv, o1[4 * g + 3] * inv);
        *(uint2*)(mo + 32 + 8 * g) = pk;
    }
}

struct NaCtx {
    const bf16_t* kbase; const bf16_t* vbase; const float* bh;
    int rs, r, c, c0, cb, hh;
    bf16x8 qf[4];
    float m, sum;
    f32x16 o0, o1;
};
template <int TI>
__device__ __forceinline__ void na_load(const NaCtx& x, bf16x8 (&kf)[4], bf16x8 (&vf)[4]) {
    constexpr int ip = TI / 3, cg = TI % 3;
    const bf16_t* kp = x.kbase + (size_t)(ip * 128 + cg * 16) * INW;
#pragma unroll
    for (int ks = 0; ks < 4; ++ks) kf[ks] = *(const bf16x8*)(kp + ks * 16);
    const bf16_t* vr = x.vbase + ip * 128 + cg * 16;
#pragma unroll
    for (int st = 0; st < 2; ++st) { vf[2 * st] = *(const bf16x8*)(vr + st * 64); vf[2 * st + 1] = *(const bf16x8*)(vr + (size_t)32 * T + st * 64); }
}
template <int TI>
__device__ __forceinline__ void na_comp(NaCtx& x, const bf16x8 (&kf)[4], const bf16x8 (&vf)[4]) {
    constexpr int ip = TI / 3, cg = TI % 3;
    f32x16 s;
#pragma unroll
    for (int q = 0; q < 16; ++q) s[q] = 0.f;
#pragma unroll
    for (int ks = 0; ks < 4; ++ks) s = __builtin_amdgcn_mfma_f32_32x32x16_bf16(kf[ks], x.qf[ks], s, 0, 0, 0);
    const int kc0 = x.cb + 16 * cg + 8 * x.hh;
    const float* brow = x.bh + (x.rs + 2 * ip - x.r + 7) * 31 + 15 - x.c + kc0;
    const int d0 = kc0 - x.c0;
    float tm = -1e30f;
    float bv[16];
#pragma unroll
    for (int q = 0; q < 16; ++q) bv[q] = brow[(q & 3) + 4 * ((q >> 2) & 1) + 31 * (q >> 3)];
#pragma unroll
    for (int q = 0; q < 16; ++q) asm volatile("" : "+v"(bv[q]));
#pragma unroll
    for (int q = 0; q < 16; ++q) {
        const int cq = (q & 3) + 4 * ((q >> 2) & 1);
        const bool valid = (unsigned)(d0 + cq) < 16u;
        const float sc = valid ? fmaf(s[q], 0.18033688011112042f, bv[q]) : -INFINITY;
        s[q] = sc;
        tm = fmaxf(tm, sc);
    }
    tm = fmaxf(tm, __shfl_xor(tm, 32));
    const float mn = fmaxf(x.m, tm);
    if (__any(mn > x.m)) {
        const float scl = __builtin_amdgcn_exp2f(x.m - mn);
        x.sum *= scl;
#pragma unroll
        for (int q = 0; q < 16; ++q) { x.o0[q] *= scl; x.o1[q] *= scl; }
    }
    x.m = mn;
#pragma unroll
    for (int q = 0; q < 16; ++q) { const float pe = __builtin_amdgcn_exp2f(s[q] - mn); s[q] = pe; x.sum += pe; }
#pragma unroll
    for (int st = 0; st < 2; ++st) {
        const bf16x8 pb = pack8(s, st * 8);
        x.o0 = __builtin_amdgcn_mfma_f32_32x32x16_bf16(vf[2 * st], pb, x.o0, 0, 0, 0);
        x.o1 = __builtin_amdgcn_mfma_f32_32x32x16_bf16(vf[2 * st + 1], pb, x.o1, 0, 0, 0);
    }
}

__device__ __forceinline__ void na_attn_wave(const Params& p, int wu, int lane, const float* sbias) {
    const int j = wu & 1, h = (wu >> 1) & 7, r = (wu >> 4) & 127, b = wu >> 11;
    const int l31 = lane & 31, hh = lane >> 5;
    NaCtx x;
    x.hh = hh; x.r = r;
    x.c = 32 * j + l31;
    x.c0 = min(max(x.c - 8, 0), 48); x.rs = min(max(r - 4, 0), 120);
    const int tokq = b * T + r * 64 + x.c;
    x.cb = 16 * j;
#pragma unroll
    for (int ks = 0; ks < 4; ++ks) x.qf[ks] = *(const bf16x8*)(p.z() + (size_t)tokq * INW + h * 64 + ks * 16 + hh * 8);
    x.bh = sbias + 64 + h * 465;
    const int kap = swap23(l31);
    x.kbase = p.z() + (size_t)(b * T + (x.rs + (kap >> 4)) * 64 + x.cb + (kap & 15)) * INW + 512 + h * 64 + hh * 8;
    x.vbase = p.vT() + ((size_t)(b * 8 + h) * 64 + l31) * T + x.rs * 64 + x.cb + 8 * hh;
    x.m = -1e30f; x.sum = 0.f;
#pragma unroll
    for (int q = 0; q < 16; ++q) { x.o0[q] = 0.f; x.o1[q] = 0.f; }
    bf16x8 k0[4], v0[4], k1[4], v1[4], k2[4], v2[4], k3[4], v3[4];
    na_load<0>(x, k0, v0); na_load<1>(x, k1, v1); na_load<2>(x, k2, v2);
    na_load<3>(x, k3, v3);  na_comp<0>(x, k0, v0);
    na_load<4>(x, k0, v0);  na_comp<1>(x, k1, v1);
    na_load<5>(x, k1, v1);  na_comp<2>(x, k2, v2);
    na_load<6>(x, k2, v2);  na_comp<3>(x, k3, v3);
    na_load<7>(x, k3, v3);  na_comp<4>(x, k0, v0);
    na_load<8>(x, k0, v0);  na_comp<5>(x, k1, v1);
    na_load<9>(x, k1, v1);  na_comp<6>(x, k2, v2);
    na_load<10>(x, k2, v2); na_comp<7>(x, k3, v3);
    na_load<11>(x, k3, v3); na_comp<8>(x, k0, v0);
    na_comp<9>(x, k1, v1);
    na_comp<10>(x, k2, v2);
    na_comp<11>(x, k3, v3);
    float sum = x.sum;
    sum += __shfl_xor(sum, 32);
    const float inv = 1.0f / sum;
    bf16_t* mo = p.mix() + (size_t)tokq * D + h * 64 + 4 * hh;
#pragma unroll
    for (int g = 0; g < 4; ++g) {
        uint2 pk;
        pk.x = pack2(x.o0[4 * g] * inv, x.o0[4 * g + 1] * inv); pk.y = pack2(x.o0[4 * g + 2] * inv, x.o0[4 * g + 3] * inv);
        *(uint2*)(mo + 8 * g) = pk;
        pk.x = pack2(x.o1[4 * g] * inv, x.o1[4 * g + 1] * inv); pk.y = pack2(x.o1[4 * g + 2] * inv, x.o1[4 * g + 3] * inv);
        *(uint2*)(mo + 32 + 8 * g) = pk;
    }
}

__device__ void phase_mixers(const Params& p, char* smem) {
    const int tid = VTID, lane = tid & 63, w = tid >> 6;
    {
        float* sbias = (float*)smem;
        __syncthreads();
        for (int i = tid; i < 8 * 465; i += 256) sbias[64 + i] = p.rpb[i] * 1.4426950408889634f;
        __syncthreads();
        for (int wu = VBID * 4 + w; wu < 8192; wu += VGRID * 4) na_attn_wave(p, wu, lane, sbias);
    }
    __syncthreads();
    hg_local(p, smem);
}

__device__ void phase_hg_scan(const Params& p) {
    const int tid = VTID;
    const int skip = gridDim.x >= 64 ? 32 : 0;
    if (VBID < skip) return;
    for (int item = VBID - skip; item < 512; item += VGRID - skip) {
        const int g = item * 256 + tid;
        const int seq = g >> 12, kv = g & 4095, k = kv & 63;
        const int dir = seq & 1;
        float S = 0.f;
        for (int cc0 = 0; cc0 < 128; cc0 += 8) {
            float L[8], d[8];
#pragma unroll
            for (int u = 0; u < 8; ++u) {
                const int c = dir ? 127 - (cc0 + u) : cc0 + u;
                const size_t it = (size_t)seq * 128 + c;
                L[u] = bf2f(((const bf16_t*)p.hstate())[it * 4096 + kv]);
                d[u] = p.hdec()[it * 64 + k];
            }
#pragma unroll
            for (int u = 0; u < 8; ++u) {
                const int c = dir ? 127 - (cc0 + u) : cc0 + u;
                const size_t it = (size_t)seq * 128 + c;
                ((bf16_t*)p.h())[it * 4096 + kv] = f2bf(S);
                S = d[u] * S + L[u];
            }
        }
    }
}

__device__ void phase_hg_out(const Params& p, char* smem) {
    char* sQt = smem;
    char* sKt = smem + 9216;
    char* sQh = smem + 18432;
    char* sVT = smem + 27648;
    char* sST = smem + 36864;
    char* sP = smem + 46080;
    float* sTot = (float*)(smem + 55296);
    float* sSS = sTot + 256;
    const int tid = VTID, lane = tid & 63, w = tid >> 6;
    const int kcol = tid & 63, sq = tid >> 6;
    const int l31 = lane & 31, hh = lane >> 5;
    for (int item = VBID; item < 2048; item += VGRID) {
        const int c = item & 127, h = (item >> 7) & 3, b = item >> 9;
        const int tok0 = b * T + c * 64;
        __syncthreads();
        hg_load_vt(p, sVT, tok0, h, kcol, sq);
        float qv[16];
        {
            const bf16_t* zp = p.z() + (size_t)(tok0 + sq * 16) * INW + 1536 + h * 64 + kcol;
#pragma unroll
            for (int j = 0; j < 16; ++j) qv[j] = bf2f(zp[(size_t)j * INW]);
        }
        f32x16 accO;
#pragma unroll
        for (int r = 0; r < 16; ++r) accO[r] = 0.f;
        for (int dir = 0; dir < 2; ++dir) {
            float bj[16], kk[16];
            const float btot = hg_gates(p, sTot, tok0, h, dir, kcol, sq, bj, kk);
            const float bref = 0.5f * btot;
#pragma unroll
            for (int j = 0; j < 16; ++j) {
                const int s = sq * 16 + j;
                *(bf16_t*)(sQt + s * HRS + kcol * 2) = f2bf(qv[j] * __expf(bj[j] - bref));
                *(bf16_t*)(sKt + s * HRS + kcol * 2) = f2bf(kk[j] * __expf(bref - bj[j]));
                *(bf16_t*)(sQh + s * HRS + kcol * 2) = f2bf(qv[j] * __expf(bj[j]));
            }
            {
                const bf16_t* sp = (const bf16_t*)p.h() + ((size_t)(((b * 4 + h) * 2 + dir) * 128 + c)) * 4096;
#pragma unroll
                for (int i = 0; i < 4; ++i) {
                    const int idx = tid * 4 + 1024 * i;
                    *(uint2*)(sST + (idx >> 6) * HRS + (idx & 63) * 2) = *(const uint2*)(sp + idx);
                }
            }
            __syncthreads();
            {
                const int si = w >> 1, ti = w & 1;
                const bool live = dir == 0 ? (si <= ti) : (si >= ti);
                f32x16 pt;
#pragma unroll
                for (int r = 0; r < 16; ++r) pt[r] = 0.f;
                if (live) pt = tile_mm64(sKt, sQt, si * 32, ti * 32, lane, pt);
                const int t = ti * 32 + l31;
#pragma unroll
                for (int g = 0; g < 4; ++g) {
                    const int s0 = si * 32 + 8 * g + 4 * hh;
                    float v0 = pt[4 * g], v1 = pt[4 * g + 1], v2 = pt[4 * g + 2], v3 = pt[4 * g + 3];
                    if (dir == 0) {
                        if (s0 > t) v0 = 0.f; if (s0 + 1 > t) v1 = 0.f; if (s0 + 2 > t) v2 = 0.f; if (s0 + 3 > t) v3 = 0.f;
                    } else {
                        if (s0 < t) v0 = 0.f; if (s0 + 1 < t) v1 = 0.f; if (s0 + 2 < t) v2 = 0.f; if (s0 + 3 < t) v3 = 0.f;
                    }
                    uint2 pk; pk.x = pack2(v0, v1); pk.y = pack2(v2, v3);
                    *(uint2*)(sP + t * HRS + s0 * 2) = pk;
                }
            }
            __syncthreads();
            {
                const int vi = w >> 1, ti = w & 1;
                accO = tile_mm64(sVT, sP, vi * 32, ti * 32, lane, accO);
                accO = tile_mm64(sST, sQh, vi * 32, ti * 32, lane, accO);
            }
            __syncthreads();
        }
        const int vi = w >> 1, ti = w & 1;
        float ssq = 0.f;
#pragma unroll
        for (int r = 0; r < 16; ++r) ssq += accO[r] * accO[r];
        ssq += __shfl_xor(ssq, 32);
        sSS[w * 64 + lane] = ssq;
        __syncthreads();
        const float tot = sSS[ti * 64 + l31] + sSS[(2 + ti) * 64 + l31];
        const float rs = rsqrtf(tot * (1.0f / 64.0f) + EPS);
        const int tok = tok0 + ti * 32 + l31;
#pragma unroll
        for (int g = 0; g < 4; ++g) {
            const int v0 = vi * 32 + 8 * g + 4 * hh;
            const uint2 gz = *(const uint2*)(p.z() + (size_t)tok * INW + 2560 + h * 64 + v0);
            const float4 gn = *(const float4*)(p.hg_g + h * 64 + v0);
            const float g0 = bflo(gz.x), g1 = bfhi(gz.x), g2 = bflo(gz.y), g3 = bfhi(gz.y);
            const float o0 = accO[4 * g] * rs * gn.x * (g0 / (1.0f + __expf(-g0)));
            const float o1 = accO[4 * g + 1] * rs * gn.y * (g1 / (1.0f + __expf(-g1)));
            const float o2 = accO[4 * g + 2] * rs * gn.z * (g2 / (1.0f + __expf(-g2)));
            const float o3 = accO[4 * g + 3] * rs * gn.w * (g3 / (1.0f + __expf(-g3)));
            uint2 pk; pk.x = pack2(o0, o1); pk.y = pack2(o2, o3);
            *(uint2*)(p.mix() + (size_t)tok * D + 512 + h * 64 + v0) = pk;
        }
    }
    for (int wu = VBID * 4 + w; wu < 4096; wu += VGRID * 4) mem_attn_wave(p, wu, lane);
}


__device__ __forceinline__ int ord_key(int fb) { return fb ^ ((fb >> 31) & 0x7FFFFFFF); }

template <int N>
__device__ __forceinline__ void bitonic_sort_desc(int (&v)[N]) {
#pragma unroll
    for (int k = 2; k <= N; k <<= 1) {
#pragma unroll
        for (int j = k >> 1; j > 0; j >>= 1) {
#pragma unroll
            for (int i = 0; i < N; ++i) {
                const int l = i ^ j;
                if (l > i) {
                    const bool desc = ((i & k) == 0);
                    const int a = v[i], b = v[l];
                    const int mx = max(a, b), mn = min(a, b);
                    v[i] = desc ? mx : mn;
                    v[l] = desc ? mn : mx;
                }
            }
        }
    }
}
template <int N>
__device__ __forceinline__ void bitonic_merge_desc(int (&v)[N]) {
#pragma unroll
    for (int j = N >> 1; j > 0; j >>= 1) {
#pragma unroll
        for (int i = 0; i < N; ++i) {
            const int l = i ^ j;
            if (l > i) {
                const int a = v[i], b = v[l];
                v[i] = max(a, b);
                v[l] = min(a, b);
            }
        }
    }
}
__device__ __forceinline__ void merge_prune16(int (&r)[16], const int (&o)[16]) {
#pragma unroll
    for (int i = 0; i < 16; ++i) r[i] = max(r[i], o[15 - i]);
    bitonic_merge_desc<16>(r);
}

constexpr int QRS = 528;
struct EpiQpLds {
    char* qt; const float* ssrow; const unsigned* hmax; const float* sb; int brow, bcol;
    __device__ __forceinline__ void operator()(int row, int col, const f32x4& v) const {
        const float rs = rsqrtf(ssrow[row] * (1.0f / 1024.0f) + EPS) * __uint_as_float(hmax[row]) * (1.0f / 127.0f);
        const float4 b = *(const float4*)(sb + col);
        uint2 pk; pk.x = pack2(v[0] * rs * b.x, v[1] * rs * b.y); pk.y = pack2(v[2] * rs * b.z, v[3] * rs * b.w);
        *(uint2*)(qt + (row - brow) * QRS + (col - bcol) * 2) = pk;
    }
};
__device__ __forceinline__ int* route_slot(char* wrows, int e) { return (int*)(wrows + (e >> 6) * QRS + (e & 63) * 4); }

__device__ __forceinline__ void route_tile(const Params& p, char* qt, int tok0, int h) {
    const int tid = threadIdx.x, lane = tid & 63, w = tid >> 6;
    const int tl = lane & 31, hh = lane >> 5;
    char* wrows = qt + (w * 32) * QRS;
    const int tok = tok0 + w * 32 + tl;
    const bf16_t* sp = p.subk_b() + (size_t)(h * 2) * 16384 + tl * 128 + hh * 8;
    bf16x8 an[8];
#pragma unroll
    for (int ks = 0; ks < 8; ++ks) an[ks] = *(const bf16x8*)(sp + ks * 16);
#pragma unroll
    for (int c = 0; c < 2; ++c) {
        bf16x8 qf[8];
#pragma unroll
        for (int ks = 0; ks < 8; ++ks) qf[ks] = *(const bf16x8*)(wrows + tl * QRS + (c * 128 + ks * 16 + hh * 8) * 2);
        int cur[16];
#pragma unroll
        for (int kb = 0; kb < 4; ++kb) {
            bf16x8 af[8];
#pragma unroll
            for (int ks = 0; ks < 8; ++ks) af[ks] = an[ks];
            if (c * 4 + kb + 1 < 8) {
                const bf16_t* sn = sp + (c * 4 + kb + 1) * 4096;
#pragma unroll
                for (int ks = 0; ks < 8; ++ks) an[ks] = *(const bf16x8*)(sn + ks * 16);
            }
            f32x16 acc;
#pragma unroll
            for (int r = 0; r < 16; ++r) acc[r] = 0.f;
#pragma unroll
            for (int ks = 0; ks < 8; ++ks) acc = __builtin_amdgcn_mfma_f32_32x32x16_bf16(af[ks], qf[ks], acc, 0, 0, 0);
            int v[16];
#pragma unroll
            for (int r = 0; r < 16; ++r) {
                const int key = kb * 32 + (r & 3) + 8 * (r >> 2) + 4 * hh;
                const int fb = (__float_as_int(acc[r]) & ~127) | (127 - key);
                v[r] = ord_key(fb);
            }
            bitonic_sort_desc<16>(v);
            if (kb == 0) {
#pragma unroll
                for (int r = 0; r < 16; ++r) cur[r] = v[r];
            } else {
                merge_prune16(cur, v);
            }
            __builtin_amdgcn_sched_barrier(0);
        }
        {
            int o[16];
#pragma unroll
            for (int r = 0; r < 16; ++r) o[r] = __shfl_xor(cur[r], 32);
            merge_prune16(cur, o);
        }
#pragma unroll
        for (int r = 0; r < 16; ++r) *route_slot(wrows, c * 512 + r * 32 + tl) = cur[r];
        __builtin_amdgcn_sched_barrier(0);
    }
    float va[16], vb[16];
#pragma unroll
    for (int r = 0; r < 16; ++r) {
        const int fa = ord_key(*route_slot(wrows, r * 32 + tl)), fb = ord_key(*route_slot(wrows, 512 + r * 32 + tl));
        va[r] = __int_as_float(fa & ~127);
        vb[r] = __int_as_float(fb & ~127);
    }
    int best[16];
#pragma unroll
    for (int j = 0; j < 16; ++j) best[j] = ord_key((__float_as_int(va[0] + vb[j]) & ~255) | (255 - j));
#pragma unroll
    for (int i = 1; i < 8; ++i) {
        const int n = 16 / (i + 1);
        int row[16];
#pragma unroll
        for (int j = 0; j < 16; ++j)
            row[j] = (j < n) ? ord_key((__float_as_int(va[i] + vb[j]) & ~255) | (255 - (i * 16 + j))) : (int)0x80000000;
        merge_prune16(best, row);
    }
    {
        int row[16];
#pragma unroll
        for (int j = 0; j < 16; ++j)
            row[j] = (j < 8) ? ord_key((__float_as_int(va[8 + j] + vb[0]) & ~255) | (255 - ((8 + j) * 16))) : (int)0x80000000;
        merge_prune16(best, row);
    }
    float sv[16];
    int pid[16];
#pragma unroll
    for (int r = 0; r < 16; ++r) {
        const int cb = ord_key(best[r]);
        sv[r] = __int_as_float(cb & ~255);
        pid[r] = 255 - (cb & 255);
    }
    float tot = 0.f;
    const float smax = sv[0];
#pragma unroll
    for (int r = 0; r < 16; ++r) { sv[r] = __expf(sv[r] - smax); tot += sv[r]; }
    const float inv = 1.0f / tot;
    if (hh == 0) {
#pragma unroll
        for (int r = 0; r < 16; ++r) {
            const int ia = 127 - (ord_key(*route_slot(wrows, (pid[r] >> 4) * 32 + tl)) & 127);
            const int ib = 127 - (ord_key(*route_slot(wrows, 512 + (pid[r] & 15) * 32 + tl)) & 127);
            const int pos = (r & 7) * 16 + h * 2 + (r >> 3);
            p.eidx()[(size_t)tok * 128 + pos] = (unsigned short)(ia * 128 + ib);
            p.gate()[(size_t)tok * 128 + pos] = sv[r] * inv;
        }
    }
}

__device__ void phase_gemm_q_route(const Params& p, char* smem) {
    const int nM = NTOK / 256, nN = QW / 256;
    for (int i = 0; i * (int)gridDim.x + (int)blockIdx.x < nM * nN; ++i) {
        int pm, pn;
        g8::tile_of(i * gridDim.x + blockIdx.x, nM, nN, pm, pn);
        EpiQpLds e{smem, p.ss1(), p.hmax(), p.sb() + INW, pm * 256, pn * 256};
        gemm256_tile<false, false, true>(p.h2q(), p.w_q_q(), D, pm * 256, pn * 256, smem, e);
        __syncthreads();
        route_tile(p, smem, pm * 256, pn);
    }
}

__device__ void phase_route(const Params& p, char* smem) {
    char* sk = smem;
    const int tid = VTID, lane = tid & 63, w = tid >> 6;
    int* sA = (int*)(smem + 32768) + w * 2048;
    int* sB = (int*)(smem + 65536) + w * 512;
    const int tl = lane & 31, hh = lane >> 5;
    const int h = VBID & 7, tg0 = VBID >> 3, tgs = VGRID >> 3;
    for (int base = tg0; base < 256; base += 4 * tgs)
    for (int c = 0; c < 2; ++c) {
        const int hc = h * 2 + c;
        __syncthreads();
        {
            const bf16_t* sp = p.subk_b() + (size_t)hc * 16384;
#pragma unroll
            for (int i = 0; i < 8; ++i) {
                const int ch = tid + 256 * i;
                const int row = ch >> 4, cc = ch & 15;
                const uint4 v = *(const uint4*)(sp + row * 128 + cc * 8);
                *(uint4*)(sk + row * 256 + ((cc ^ (row & 15)) << 4)) = v;
            }
        }
        __syncthreads();
        bf16x8 qf[8];
        if (base < 256) {
            const bf16_t* qr = p.z() + (size_t)(base * 128 + w * 32 + tl) * QW + hc * 128 + hh * 8;
#pragma unroll
            for (int ks = 0; ks < 8; ++ks) qf[ks] = *(const bf16x8*)(qr + ks * 16);
        }
        for (int it = 0; it < 4; ++it) {
            const int tgp = base + it * tgs;
            if (tgp >= 256) break;
            const int tok = tgp * 128 + w * 32 + tl;
            int* sidx = sA + it * 512;
            f32x16 acc4[4];
#pragma unroll
            for (int kb = 0; kb < 4; ++kb) {
#pragma unroll
                for (int r = 0; r < 16; ++r) acc4[kb][r] = 0.f;
                const int row = kb * 32 + tl;
#pragma unroll
                for (int ks = 0; ks < 8; ++ks) {
                    const bf16x8 af = *(const bf16x8*)(sk + row * 256 + (((ks * 2 + hh) ^ (row & 15)) << 4));
                    acc4[kb] = __builtin_amdgcn_mfma_f32_32x32x16_bf16(af, qf[ks], acc4[kb], 0, 0, 0);
                }
            }
            if (it + 1 < 4 && tgp + tgs < 256) {
                const bf16_t* qr = p.z() + (size_t)((tgp + tgs) * 128 + w * 32 + tl) * QW + hc * 128 + hh * 8;
#pragma unroll
                for (int ks = 0; ks < 8; ++ks) qf[ks] = *(const bf16x8*)(qr + ks * 16);
            }
            int cur[16];
#pragma unroll
            for (int kb = 0; kb < 4; ++kb) {
                int v[16];
#pragma unroll
                for (int r = 0; r < 16; ++r) {
                    const int key = kb * 32 + (r & 3) + 8 * (r >> 2) + 4 * hh;
                    const int fb = (__float_as_int(acc4[kb][r]) & ~127) | (127 - key);
                    v[r] = ord_key(fb);
                }
                bitonic_sort_desc<16>(v);
                if (kb == 0) {
#pragma unroll
                    for (int r = 0; r < 16; ++r) cur[r] = v[r];
                } else {
                    merge_prune16(cur, v);
                }
            }
            {
                int o[16];
#pragma unroll
                for (int r = 0; r < 16; ++r) o[r] = __shfl_xor(cur[r], 32);
                merge_prune16(cur, o);
            }
            if (c == 0) {
#pragma unroll
                for (int r = 0; r < 16; ++r) sidx[r * 32 + tl] = cur[r];
                continue;
            }
#pragma unroll
            for (int r = 0; r < 16; ++r) sB[r * 32 + tl] = cur[r];
        float va[16], vb[16];
#pragma unroll
        for (int r = 0; r < 16; ++r) {
            const int fa = ord_key(sidx[r * 32 + tl]), fb = ord_key(sB[r * 32 + tl]);
            va[r] = __int_as_float(fa & ~127);
            vb[r] = __int_as_float(fb & ~127);
        }
        int best[16];
#pragma unroll
        for (int j = 0; j < 16; ++j) best[j] = ord_key((__float_as_int(va[0] + vb[j]) & ~255) | (255 - j));
#pragma unroll
        for (int i = 1; i < 8; ++i) {
            const int n = 16 / (i + 1);
            int row[16];
#pragma unroll
            for (int j = 0; j < 16; ++j)
                row[j] = (j < n) ? ord_key((__float_as_int(va[i] + vb[j]) & ~255) | (255 - (i * 16 + j))) : (int)0x80000000;
            merge_prune16(best, row);
        }
        {
            int row[16];
#pragma unroll
            for (int j = 0; j < 16; ++j)
                row[j] = (j < 8) ? ord_key((__float_as_int(va[8 + j] + vb[0]) & ~255) | (255 - ((8 + j) * 16))) : (int)0x80000000;
            merge_prune16(best, row);
        }
        float sv[16];
        int pid[16];
#pragma unroll
        for (int r = 0; r < 16; ++r) {
            const int cb = ord_key(best[r]);
            sv[r] = __int_as_float(cb & ~255);
            pid[r] = 255 - (cb & 255);
        }
        float tot = 0.f;
        const float smax = sv[0];
#pragma unroll
        for (int r = 0; r < 16; ++r) { sv[r] = __expf(sv[r] - smax); tot += sv[r]; }
        const float inv = 1.0f / tot;
        if (hh == 0) {
#pragma unroll
            for (int r = 0; r < 16; ++r) {
                const int ia = 127 - (ord_key(sidx[(pid[r] >> 4) * 32 + tl]) & 127);
                const int ib = 127 - (ord_key(sB[(pid[r] & 15) * 32 + tl]) & 127);
                const int pos = (r & 7) * 16 + h * 2 + (r >> 3);
                p.eidx()[(size_t)tok * 128 + pos] = (unsigned short)(ia * 128 + ib);
                p.gate()[(size_t)tok * 128 + pos] = sv[r] * inv;
            }
        }
        }
    }
}

constexpr int PEER_TG = 512;
constexpr int PEER_TPW = PEER_TG / 8;
constexpr int PEER_NTG = NTOK / PEER_TG;
constexpr int PEER_NCH = 8;

#define PEER_G1(base, wv, hi) (*(const uint4*)((base) + (unsigned)((((hi) ? ((wv) >> 16) : ((wv) & 0xFFFFu)) << 7) + dlo)))
#define PEER_GATHER16(dst, base, ia, ib)                                                             \
    dst[0] = PEER_G1(base, (ia).x, 0);  dst[1] = PEER_G1(base, (ia).x, 1);  dst[2] = PEER_G1(base, (ia).y, 0);  dst[3] = PEER_G1(base, (ia).y, 1);   \
    dst[4] = PEER_G1(base, (ia).z, 0);  dst[5] = PEER_G1(base, (ia).z, 1);  dst[6] = PEER_G1(base, (ia).w, 0);  dst[7] = PEER_G1(base, (ia).w, 1);   \
    dst[8] = PEER_G1(base, (ib).x, 0);  dst[9] = PEER_G1(base, (ib).x, 1);  dst[10] = PEER_G1(base, (ib).y, 0); dst[11] = PEER_G1(base, (ib).y, 1);  \
    dst[12] = PEER_G1(base, (ib).z, 0); dst[13] = PEER_G1(base, (ib).z, 1); dst[14] = PEER_G1(base, (ib).w, 0); dst[15] = PEER_G1(base, (ib).w, 1);

__device__ __forceinline__ unsigned quant4(float a, float b, float c, float d, float qs) {
    const int q0 = (int)rintf(__builtin_amdgcn_fmed3f(a * qs, -127.f, 127.f)), q1 = (int)rintf(__builtin_amdgcn_fmed3f(b * qs, -127.f, 127.f));
    const int q2 = (int)rintf(__builtin_amdgcn_fmed3f(c * qs, -127.f, 127.f)), q3 = (int)rintf(__builtin_amdgcn_fmed3f(d * qs, -127.f, 127.f));
    return (unsigned)(q0 & 255) | ((unsigned)(q1 & 255) << 8) | ((unsigned)(q2 & 255) << 16) | ((unsigned)(q3 & 255) << 24);
}
__device__ void phase_quant_h2(const Params& p) {
    const int tid = VTID, lane = tid & 63, w = tid >> 6;
    for (int r0 = VBID * 4; r0 < NTOK; r0 += VGRID * 4) {
        const int r = r0 + w;
        const uint4* xp = (const uint4*)(p.x1b() + (size_t)r * D + lane * 16);
        const uint4 xa = xp[0], xb = xp[1];
        const float4* gp = (const float4*)(p.ffn_g + lane * 16);
        const float4 g0 = gp[0], g1 = gp[1], g2 = gp[2], g3 = gp[3];
        const float hm = __uint_as_float(p.hmax()[r]);
        const float qs = hm > 0.f ? 127.0f / hm : 0.f;
        uint4 o;
        o.x = quant4(bflo(xa.x) * g0.x, bfhi(xa.x) * g0.y, bflo(xa.y) * g0.z, bfhi(xa.y) * g0.w, qs);
        o.y = quant4(bflo(xa.z) * g1.x, bfhi(xa.z) * g1.y, bflo(xa.w) * g1.z, bfhi(xa.w) * g1.w, qs);
        o.z = quant4(bflo(xb.x) * g2.x, bfhi(xb.x) * g2.y, bflo(xb.y) * g2.z, bfhi(xb.y) * g2.w, qs);
        o.w = quant4(bflo(xb.z) * g3.x, bfhi(xb.z) * g3.y, bflo(xb.w) * g3.z, bfhi(xb.w) * g3.w, qs);
        *(uint4*)(p.h2q() + (size_t)r * D + lane * 16) = o;
    }
}

template <int CTRL>
__device__ __forceinline__ int dpp_movi(int v) { return __builtin_amdgcn_update_dpp(0, v, CTRL, 0xf, 0xf, true); }

struct DotTok { uint4 ia, ib; uint4 ha; };
__device__ __forceinline__ void dots_load(const Params& p, DotTok& t, int tok, int c, int g, int d8) {
    const uint4* idp = (const uint4*)(p.eidx() + (size_t)tok * 128 + g * 16);
    t.ia = idp[0]; t.ib = idp[1];
    t.ha = *(const uint4*)(p.h2q() + (size_t)tok * D + c * 128 + d8 * 16);
}
__device__ __forceinline__ void dotsf_load(const Params& p, DotTok& t, int tokb, int s, int g, int d8) {
    dots_load(p, t, tokb + 8 * (s & 15), s >> 4, g, d8);
}
__device__ __forceinline__ void dotsf_finish(const uint4 (&uu)[16], const DotTok& t, int* part, int g, int d8) {
    const int h0 = (int)t.ha.x, h1 = (int)t.ha.y, h2 = (int)t.ha.z, h3 = (int)t.ha.w;
    int acc[16];
#pragma unroll
    for (int i = 0; i < 16; ++i) {
        int a = __builtin_amdgcn_sdot4((int)uu[i].x, h0, 0, false);
        a = __builtin_amdgcn_sdot4((int)uu[i].y, h1, a, false);
        a = __builtin_amdgcn_sdot4((int)uu[i].z, h2, a, false);
        a = __builtin_amdgcn_sdot4((int)uu[i].w, h3, a, false);
        a += dpp_movi<DPP_QP_X1>(a);
        a += dpp_movi<DPP_QP_X2>(a);
        a += dpp_movi<DPP_HMIRROR>(a);
        acc[i] = a;
    }
    if (d8 == 0) {
#pragma unroll
        for (int i = 0; i < 16; ++i) (void)__hip_atomic_fetch_add(part + g * 16 + i, acc[i], __ATOMIC_RELAXED, __HIP_MEMORY_SCOPE_WORKGROUP);
    }
}

__device__ __forceinline__ float gelu_erf(float v);

__device__ void phase_peer_dots(const Params& p, char* smem) {
    const int tid = threadIdx.x, lane = tid & 63, w = tid >> 6;
    const int g = lane >> 3, d8 = lane & 7;
    int* part = (int*)smem + w * 2048;
    for (int tgp = blockIdx.x; tgp < NTOK / 128; tgp += gridDim.x) {
        const int tokb = tgp * 128 + w;
        __syncthreads();
        for (int i = lane; i < 2048; i += 64) part[i] = 0;
        __syncthreads();
        const char* ubase = (const char*)p.u_c();
        const unsigned dlo = d8 * 16;
        DotTok ta, tb, tn;
        uint4 ua[16], ubuf[16];
        dotsf_load(p, ta, tokb, 0, g, d8);
        dotsf_load(p, tb, tokb, 1, g, d8);
        PEER_GATHER16(ua, ubase, ta.ia, ta.ib)
        PEER_GATHER16(ubuf, ubase, tb.ia, tb.ib)
        dotsf_load(p, tn, tokb, 2, g, d8);
        for (int s = 0; s < 128; s += 2) {
            dotsf_finish(ua, ta, part + (s & 15) * 128, g, d8);
            if (s + 2 < 128) {
                ta = tn;
                const char* ub = ubase + (size_t)((s + 2) >> 4) * 16384 * 128;
                PEER_GATHER16(ua, ub, ta.ia, ta.ib)
                dotsf_load(p, tn, tokb, min(s + 3, 127), g, d8);
            }
            dotsf_finish(ubuf, tb, part + ((s + 1) & 15) * 128, g, d8);
            if (s + 3 < 128) {
                tb = tn;
                const char* ub = ubase + (size_t)((s + 3) >> 4) * 16384 * 128;
                PEER_GATHER16(ubuf, ub, tb.ia, tb.ib)
                dotsf_load(p, tn, tokb, min(s + 4, 127), g, d8);
            }
        }
        __syncthreads();
        for (int k0 = 0; k0 < 16; k0 += 4) {
            int ps[4][2], e[4][2];
            float gt[4][2], sh[4];
#pragma unroll
            for (int q = 0; q < 4; ++q) {
                const int tok = tokb + 8 * (k0 + q);
                sh[q] = __uint_as_float(p.hmax()[tok]) * (1.0f / 127.0f) * rsqrtf(p.ss1()[tok] * (1.0f / 1024.0f) + EPS);
#pragma unroll
                for (int u = 0; u < 2; ++u) {
                    const int slot = lane + 64 * u;
                    ps[q][u] = part[(k0 + q) * 128 + slot];
                    e[q][u] = p.eidx()[(size_t)tok * 128 + slot];
                    gt[q][u] = p.gate()[(size_t)tok * 128 + slot];
                }
            }
            float su[4][2], sv[4][2];
#pragma unroll
            for (int q = 0; q < 4; ++q)
#pragma unroll
                for (int u = 0; u < 2; ++u) { su[q][u] = p.scale_u()[e[q][u]]; sv[q][u] = p.scale_v()[e[q][u]]; }
#pragma unroll
            for (int q = 0; q < 4; ++q) {
                const int tok = tokb + 8 * (k0 + q);
                float cf[2];
#pragma unroll
                for (int u = 0; u < 2; ++u) cf[u] = gelu_erf((float)ps[q][u] * su[q][u] * sh[q]) * gt[q][u] * sv[q][u];
                const float cm = wave_max(fmaxf(fabsf(cf[0]), fabsf(cf[1])));
                const float qs = cm > 0.f ? 127.0f / cm : 0.f;
                p.coef()[(size_t)tok * 128 + lane] = (signed char)(int)rintf(cf[0] * qs);
                p.coef()[(size_t)tok * 128 + lane + 64] = (signed char)(int)rintf(cf[1] * qs);
                if (lane == 0) p.csum()[tok] = cm * (1.0f / 127.0f);
            }
        }
    }
}

__device__ __forceinline__ float gelu_erf(float v) {
    const float av = fabsf(v);
    const float t = __builtin_amdgcn_rcpf(fmaf(av, 0.2316418882f, 1.0f));
    float q = fmaf(t, 0.5307027145f, -0.7265760135f);
    q = fmaf(q, t, 0.7107068705f);
    q = fmaf(q, t, -0.142248368f);
    q = fmaf(q, t, 0.127414796f);
    q = q * t;
    const float e = __builtin_amdgcn_exp2f(v * v * -0.72134752044f);
    const float m = v * (q * e);
    return v < 0.f ? m : v - m;
}
struct AccTok { uint4 ia, ib; uint4 cq; float cs; };
__device__ __forceinline__ void acc_load(const Params& p, AccTok& t, int tok, int g) {
    const uint4* idp = (const uint4*)(p.eidx() + (size_t)tok * 128 + g * 16);
    t.ia = idp[0]; t.ib = idp[1];
    t.cq = *(const uint4*)(p.coef() + (size_t)tok * 128 + g * 16);
    t.cs = p.csum()[tok];
}
#define PEER_T4DOT(acc, B, r0, r1, r2, r3, cq)                                   \
    {                                                                            \
        const unsigned t0 = __builtin_amdgcn_perm(r1, r0, 0x05010400u), t1 = __builtin_amdgcn_perm(r1, r0, 0x07030602u); \
        const unsigned t2 = __builtin_amdgcn_perm(r3, r2, 0x05010400u), t3 = __builtin_amdgcn_perm(r3, r2, 0x07030602u); \
        acc[(B) + 0] = __builtin_amdgcn_sdot4((int)__builtin_amdgcn_perm(t2, t0, 0x05040100u), (int)(cq), acc[(B) + 0], false); \
        acc[(B) + 1] = __builtin_amdgcn_sdot4((int)__builtin_amdgcn_perm(t2, t0, 0x07060302u), (int)(cq), acc[(B) + 1], false); \
        acc[(B) + 2] = __builtin_amdgcn_sdot4((int)__builtin_amdgcn_perm(t3, t1, 0x05040100u), (int)(cq), acc[(B) + 2], false); \
        acc[(B) + 3] = __builtin_amdgcn_sdot4((int)__builtin_amdgcn_perm(t3, t1, 0x07060302u), (int)(cq), acc[(B) + 3], false); \
    }
__device__ __forceinline__ void accf_finish(const uint4 (&vv)[16], const AccTok& t, char* rowp, int g) {
    const unsigned cw[4] = {t.cq.x, t.cq.y, t.cq.z, t.cq.w};
    int acc[16];
#pragma unroll
    for (int j = 0; j < 16; ++j) acc[j] = 0;
#pragma unroll
    for (int j = 0; j < 4; ++j) {
        PEER_T4DOT(acc, 0, vv[4 * j].x, vv[4 * j + 1].x, vv[4 * j + 2].x, vv[4 * j + 3].x, cw[j])
        PEER_T4DOT(acc, 4, vv[4 * j].y, vv[4 * j + 1].y, vv[4 * j + 2].y, vv[4 * j + 3].y, cw[j])
        PEER_T4DOT(acc, 8, vv[4 * j].z, vv[4 * j + 1].z, vv[4 * j + 2].z, vv[4 * j + 3].z, cw[j])
        PEER_T4DOT(acc, 12, vv[4 * j].w, vv[4 * j + 1].w, vv[4 * j + 2].w, vv[4 * j + 3].w, cw[j])
    }
    int t8[8], u4[4];
#pragma unroll
    for (int j = 0; j < 8; ++j) {
        const auto r = __builtin_amdgcn_permlane32_swap((unsigned)acc[j], (unsigned)acc[j + 8], false, false);
        t8[j] = (int)(r[0] + r[1]);
    }
#pragma unroll
    for (int j = 0; j < 4; ++j) {
        const auto r = __builtin_amdgcn_permlane16_swap((unsigned)t8[j], (unsigned)t8[j + 4], false, false);
        u4[j] = (int)(r[0] + r[1]);
    }
    float o[4];
#pragma unroll
    for (int j = 0; j < 4; ++j) {
        int v = u4[j];
        v += dpp_movi<DPP_ROR8>(v);
        o[j] = (float)v * t.cs;
    }
    if ((g & 1) == 0) {
        const int rho = g >> 1;
        uint2 w0; w0.x = pack2(o[0], o[1]); w0.y = pack2(o[2], o[3]);
        *(uint2*)(rowp + (4 * (rho & 1) + 8 * (rho >> 1)) * 2) = w0;
    }
}

__device__ void phase_peer_accum(const Params& p, char* smem) {
    const int tid = threadIdx.x, lane = tid & 63, w = tid >> 6;
    const int g = lane >> 3, d8 = lane & 7;
    char* rowbuf = smem + w * 16384;
    for (int tgp = blockIdx.x; tgp < NTOK / 64; tgp += gridDim.x) {
        const int tokb = tgp * 64 + w;
        __syncthreads();
        const char* vbase = (const char*)p.v_c();
        const unsigned dlo = d8 * 16;
        AccTok ta, tb, tn;
        uint4 va[16], vbuf[16];
        acc_load(p, ta, tokb, g);
        acc_load(p, tb, tokb + 8, g);
        PEER_GATHER16(va, vbase, ta.ia, ta.ib)
        PEER_GATHER16(vbuf, vbase, tb.ia, tb.ib)
        acc_load(p, tn, tokb + 16, g);
        for (int s = 0; s < 64; s += 2) {
            accf_finish(va, ta, rowbuf + (s & 7) * 2048 + (s >> 3) * 256 + d8 * 32, g);
            if (s + 2 < 64) {
                ta = tn;
                const char* vb = vbase + (size_t)((s + 2) >> 3) * 16384 * 128;
                PEER_GATHER16(va, vb, ta.ia, ta.ib)
                acc_load(p, tn, tokb + 8 * (min(s + 3, 63) & 7), g);
            }
            accf_finish(vbuf, tb, rowbuf + ((s + 1) & 7) * 2048 + ((s + 1) >> 3) * 256 + d8 * 32, g);
            if (s + 3 < 64) {
                tb = tn;
                const char* vb = vbase + (size_t)((s + 3) >> 3) * 16384 * 128;
                PEER_GATHER16(vbuf, vb, tb.ia, tb.ib)
                acc_load(p, tn, tokb + 8 * (min(s + 4, 63) & 7), g);
            }
        }
        __syncthreads();
        for (int k0 = 0; k0 < 8; k0 += 2) {
            float4 v[2][4];
#pragma unroll
            for (int q = 0; q < 2; ++q) {
                const bf16_t* xrow = p.x1b() + (size_t)(tokb + 8 * (k0 + q)) * D;
#pragma unroll
                for (int j = 0; j < 4; ++j) {
                    const uint2 xk = *(const uint2*)(xrow + (j * 64 + lane) * 4);
                    v[q][j] = make_float4(bflo(xk.x), bfhi(xk.x), bflo(xk.y), bfhi(xk.y));
                }
            }
#pragma unroll
            for (int q = 0; q < 2; ++q) {
                float* orow = p.out + (size_t)(tokb + 8 * (k0 + q)) * D;
                const char* prow = rowbuf + (k0 + q) * 2048;
                float ss = 0.f;
#pragma unroll
                for (int j = 0; j < 4; ++j) {
                    const uint2 pk = *(const uint2*)(prow + (j * 64 + lane) * 8);
                    v[q][j].x += bflo(pk.x); v[q][j].y += bfhi(pk.x); v[q][j].z += bflo(pk.y); v[q][j].w += bfhi(pk.y);
                    ss += v[q][j].x * v[q][j].x + v[q][j].y * v[q][j].y + v[q][j].z * v[q][j].z + v[q][j].w * v[q][j].w;
                }
                ss = wave_sum(ss);
                const float rs = rsqrtf(ss * (1.0f / 1024.0f) + EPS);
#pragma unroll
                for (int j = 0; j < 4; ++j) {
                    const float4 gg = *(const float4*)(p.fin_g + (j * 64 + lane) * 4);
                    float4 o;
                    o.x = v[q][j].x * rs * gg.x; o.y = v[q][j].y * rs * gg.y; o.z = v[q][j].z * rs * gg.z; o.w = v[q][j].w * rs * gg.w;
                    *(float4*)(orow + (j * 64 + lane) * 4) = o;
                }
            }
        }
    }
}

#define XB_TMO      128
#define XB_XCNT(j)  (256  + 64 * (j))
#define XB_XSUB(j)  (1280 + 64 * (j))
#define XB_XGEN(j)  (2304 + 64 * (j))
#define XB_TOP      3328
#define XB_TOPGEN   3392
#define XCD_BAR_WORDS 3456
#define XB_SPIN_CAP (1u << 18)
__device__ __forceinline__ unsigned xb_ld(unsigned* p)              { return __hip_atomic_load(p, __ATOMIC_RELAXED, __HIP_MEMORY_SCOPE_AGENT); }
__device__ __forceinline__ unsigned xb_add(unsigned* p, unsigned v) { return __hip_atomic_fetch_add(p, v, __ATOMIC_RELAXED, __HIP_MEMORY_SCOPE_AGENT); }
#define XB_SPIN(cond, bar) do { unsigned _sp = 0; while (cond) { __builtin_amdgcn_s_sleep(1); \
    if ((++_sp & 255u) == 0u) { if (xb_ld(&(bar)[XB_TMO])) break; if (_sp > XB_SPIN_CAP) { atomicAdd(&(bar)[XB_TMO], 1u); break; } } } } while (0)

struct XcdBarrier { unsigned* bar; unsigned x; volatile unsigned* st; };

__device__ __forceinline__ XcdBarrier xcd_barrier_post(unsigned* bar, volatile unsigned* st) {
    XcdBarrier b; b.bar = bar; b.x = xcc_id(); b.st = st;
    if (threadIdx.x == 0) (void)xb_add(&bar[XB_XCNT(b.x)], 1u);
    return b;
}
__device__ __forceinline__ void xcd_barrier_complete(unsigned* bar, unsigned x, unsigned& nloc, unsigned& nx) {
    const unsigned G = gridDim.x * gridDim.y * gridDim.z;
    unsigned sum, cnt, mine, sp = 0u;
    for (;;) {
        sum = 0u; cnt = 0u; mine = 0u;
#pragma unroll
        for (unsigned j = 0; j < 16; ++j) { const unsigned c = xb_ld(&bar[XB_XCNT(j)]); sum += c; cnt += (c > 0u) ? 1u : 0u; mine = (j == x) ? c : mine; }
        if (sum == G) break;
        __builtin_amdgcn_s_sleep(1);
        if ((++sp & 255u) == 0u) { if (xb_ld(&bar[XB_TMO])) break; if (sp > XB_SPIN_CAP) { atomicAdd(&bar[XB_TMO], 1u); break; } }
    }
    nloc = mine > 0u ? mine : 1u; nx = cnt > 0u ? cnt : 1u;
}
__device__ __forceinline__ void xcd_barrier(const XcdBarrier& b) {
    asm volatile("s_waitcnt vmcnt(0)" ::: "memory");
    __syncthreads();
    if (threadIdx.x == 0) {
        unsigned* bar = b.bar;
        __builtin_amdgcn_s_waitcnt(0);
        unsigned nloc = b.st[0], nx = b.st[1];
        if (nloc == 0u) { xcd_barrier_complete(bar, b.x, nloc, nx); b.st[0] = nloc; b.st[1] = nx; }
        const unsigned old = xb_add(&bar[XB_XSUB(b.x)], 1u);
        const unsigned gen = old / nloc;
        if (old + 1u == (gen + 1u) * nloc) {
            __builtin_amdgcn_fence(__ATOMIC_RELEASE, "agent");
            asm volatile("s_waitcnt vmcnt(0)" ::: "memory");
            const unsigned og = xb_add(&bar[XB_TOP], 1u);
            const unsigned tg = og / nx;
            if (og + 1u == (tg + 1u) * nx) xb_add(&bar[XB_TOPGEN], 1u);
            else XB_SPIN(xb_ld(&bar[XB_TOPGEN]) == tg, bar);
            __builtin_amdgcn_fence(__ATOMIC_ACQUIRE, "agent");
            xb_add(&bar[XB_XGEN(b.x)], 1u);
            asm volatile("s_waitcnt vmcnt(0)" ::: "memory");
        } else {
            XB_SPIN(xb_ld(&bar[XB_XGEN(b.x)]) == gen, bar);
            __builtin_amdgcn_fence(__ATOMIC_ACQUIRE, "agent");
            asm volatile("s_waitcnt vmcnt(0)" ::: "memory");
        }
    }
    __syncthreads();
}

#define RUN_PHASE(K, CALL)                                              \
    if (ph_lo <= (K) && (K) < ph_hi) {                                  \
        CALL;                                                           \
        if (COOP) { if ((K) + 1 < ph_hi) { xcd_barrier(xb); } } \
    }

template <bool COOP>
__global__ void __launch_bounds__(512, 2) fwd_kernel(Params p, int ph_lo, int ph_hi) {
    __shared__ __attribute__((aligned(16))) char smem[SMEM_BYTES + 16];
    char* smh = smem + VHB * HALF_SMEM;
    XcdBarrier xb;
    if (COOP) {
        if (threadIdx.x == 0) *(uint4*)(smem + SMEM_BYTES) = make_uint4(0u, 0u, 0u, 0u);
        __syncthreads();
        xb = xcd_barrier_post(p.bar(), (volatile unsigned*)(smem + SMEM_BYTES));
    }
    if (COOP) { if (ph_lo < 0) cg::this_grid().sync(); }
    RUN_PHASE(0, phase_prep(p, smh))
    RUN_PHASE(1, phase_gemm_in(p, smem))
    RUN_PHASE(2, phase_mixers(p, smh))
    RUN_PHASE(3, (phase_gemm_kv(p, smh), phase_hg_scan(p)))
    RUN_PHASE(4, phase_hg_out(p, smh))
    RUN_PHASE(5, phase_gemm_out(p, smem))
    RUN_PHASE(6, phase_quant_h2(p))
    RUN_PHASE(7, phase_gemm_q_route(p, smem))
    RUN_PHASE(10, phase_peer_dots(p, smem))
    RUN_PHASE(12, phase_peer_accum(p, smem))
}

extern "C" void kernel_launch(void* const* d_in, const int* in_sizes, int n_in, void* d_out, int out_size, void* d_ws, size_t ws_size,
                              hipStream_t stream) {
    Params p{};
    p.x = (const float*)d_in[0]; p.mem = (const float*)d_in[1]; p.attn_g = (const float*)d_in[2]; p.w_in = (const float*)d_in[3];
    p.rpb = (const float*)d_in[4]; p.hg_lb = (const float*)d_in[5]; p.hg_g = (const float*)d_in[6]; p.mem_g = (const float*)d_in[7];
    p.w_kv = (const float*)d_in[8]; p.w_out = (const float*)d_in[9]; p.ffn_g = (const float*)d_in[10]; p.w_q = (const float*)d_in[11];
    p.subk = (const float*)d_in[12]; p.pu = (const float*)d_in[13]; p.pv = (const float*)d_in[14]; p.fin_g = (const float*)d_in[15];
    p.out = (float*)d_out;
    p.ws = (char*)d_ws;
    if (WS_TOTAL > ws_size) { fprintf(stderr, "workspace too small: need %zu have %zu\n", (size_t)WS_TOTAL, ws_size); return; }

#if defined(MULTI_LAUNCH)
    for (int ph = 0; ph < NPHASE; ++ph) fwd_kernel<false><<<dim3(512), dim3(512), 0, stream>>>(p, ph, ph + 1);
#else
    static int grid_blocks = 0;
    if (!grid_blocks) {
        int dev = 0, cus = 0, per_cu = 0;
        hipGetDevice(&dev);
        hipDeviceGetAttribute(&cus, hipDeviceAttributeMultiprocessorCount, dev);
        hipOccupancyMaxActiveBlocksPerMultiprocessor(&per_cu, fwd_kernel<true>, 512, 0);
        if (per_cu > 1) per_cu = 1;
        grid_blocks = (cus * per_cu) & ~3;
    }
    (void)hipMemsetAsync((char*)d_ws + OFF_BAR, 0, XCD_BAR_WORDS * 4, stream);
    int lo = 0, hi = NPHASE;
    void* args[] = {&p, &lo, &hi};
    hipError_t e = hipLaunchCooperativeKernel((void*)fwd_kernel<true>, dim3(grid_blocks), dim3(512), args, 0, stream);
    if (e != hipSuccess) fprintf(stderr, "cooperative launch failed: %s (grid %d)\n", hipGetErrorString(e), grid_blocks);
#endif
}
```

```cpp
#include <hip/hip_runtime.h>
#include <hip/hip_cooperative_groups.h>
#include <stdint.h>
#include <cstdio>

namespace cg = cooperative_groups;

#define VTID ((int)(threadIdx.x & 255))
#define VHB ((int)(threadIdx.x >> 8))
#define VBID ((int)(blockIdx.x * 2 + (threadIdx.x >> 8)))
#define VGRID ((int)(gridDim.x * 2))
constexpr int HALF_SMEM = 73728;

typedef unsigned short bf16_t;
typedef short bf16x8 __attribute__((ext_vector_type(8)));
typedef float f32x4 __attribute__((ext_vector_type(4)));
typedef int i32x4 __attribute__((ext_vector_type(4)));

constexpr int D = 1024;
constexpr int NB = 4;
constexpr int T = 8192;
constexpr int NTOK = NB * T;
constexpr int INW = 3072;
constexpr int QW = 2048;
constexpr float EPS = 1e-6f;
constexpr int SMEM_BYTES = 2 * 73728;
constexpr int NPHASE = 14;

constexpr size_t al256(size_t x) { return (x + 255) & ~(size_t)255; }
constexpr size_t OFF_W_IN_T = 0;
constexpr size_t OFF_W_OUT_T = OFF_W_IN_T + al256((size_t)3072 * 1024 * 2);
constexpr size_t OFF_W_Q_T = OFF_W_OUT_T + al256((size_t)1024 * 1024 * 2);
constexpr size_t OFF_W_KV_T = OFF_W_Q_T + al256((size_t)2048 * 1024 * 2);
constexpr size_t OFF_H = OFF_W_KV_T + al256((size_t)512 * 1024 * 2);
constexpr size_t OFF_Z = OFF_H + al256((size_t)32768 * 1024 * 2);
constexpr size_t OFF_MIX = OFF_Z + al256((size_t)32768 * 3072 * 2);
constexpr size_t OFF_MEMN = OFF_MIX + al256((size_t)32768 * 1024 * 2);
constexpr size_t OFF_KVB = OFF_MEMN + al256((size_t)1024 * 1024 * 2);
constexpr size_t OFF_LB = OFF_KVB + al256((size_t)1024 * 512 * 2);
constexpr size_t OFF_HSTATE = OFF_LB + al256(512 * 4);
constexpr size_t OFF_HDEC = OFF_HSTATE + al256((size_t)4096 * 4096 * 4);
constexpr size_t OFF_UC = OFF_HDEC + al256((size_t)4096 * 64 * 4);
constexpr size_t OFF_VC = OFF_UC + al256((size_t)16384 * 1024);
constexpr size_t OFF_QUEUE = OFF_VC + al256((size_t)16384 * 1024);
constexpr size_t OFF_SUBK = OFF_QUEUE + al256(2048 * 4);
constexpr size_t OFF_BAR = OFF_SUBK + al256((size_t)16 * 128 * 128 * 2);
constexpr size_t OFF_SS1 = OFF_BAR + al256(4096 * 4);
constexpr size_t OFF_HMAX = OFF_SS1 + al256((size_t)32768 * 4);
constexpr size_t OFF_CSUM = OFF_HMAX + al256((size_t)32768 * 4);
constexpr size_t OFF_SCALE_U = OFF_CSUM + al256((size_t)32768 * 4);
constexpr size_t OFF_SCALE_V = OFF_SCALE_U + al256(16384 * 4);
constexpr size_t OFF_VT = OFF_SCALE_V + al256(16384 * 4);
constexpr size_t OFF_KVT = OFF_VT + al256((size_t)32768 * 512 * 2);
constexpr size_t OFF_SA = OFF_KVT + al256((size_t)1024 * 256 * 2);
constexpr size_t OFF_SB = OFF_SA + al256((size_t)32768 * 4);
constexpr size_t WS_TOTAL = OFF_SB + al256((size_t)8192 * 4);
constexpr size_t OFF_EIDX = OFF_HSTATE;
constexpr size_t OFF_GATE = OFF_HSTATE + (size_t)32768 * 128 * 4;
constexpr size_t OFF_COEF = OFF_HSTATE + (size_t)32768 * 128 * 8;
constexpr size_t OFF_SS = OFF_HSTATE + (size_t)32768 * 128 * 12;
constexpr size_t OFF_PARTIAL = OFF_Z;
constexpr size_t OFF_PEER_OUT = OFF_Z + (size_t)8 * 32768 * 128 * 4;

struct Params {
    const float *x, *mem, *attn_g, *w_in, *rpb, *hg_lb, *hg_g, *mem_g, *w_kv, *w_out, *ffn_g, *w_q, *subk, *pu, *pv, *fin_g;
    float* out;
    char* ws;
#define WSF(type, name, off) __device__ __forceinline__ type* name() const { return (type*)(ws + (off)); }
    WSF(bf16_t, w_in_t, OFF_W_IN_T) WSF(bf16_t, w_out_t, OFF_W_OUT_T) WSF(bf16_t, w_q_t, OFF_W_Q_T) WSF(bf16_t, w_kv_t, OFF_W_KV_T)
    WSF(bf16_t, h, OFF_H)
    WSF(bf16_t, z, OFF_Z)
    WSF(bf16_t, mix, OFF_MIX)
    WSF(bf16_t, memn, OFF_MEMN)
    WSF(bf16_t, kvb, OFF_KVB)
    WSF(float, lb, OFF_LB)
    WSF(float, hstate, OFF_HSTATE)
    WSF(float, hdec, OFF_HDEC)
    WSF(unsigned short, eidx, OFF_EIDX)
    WSF(float, gate, OFF_GATE)
    WSF(signed char, coef, OFF_COEF)
    WSF(bf16_t, x1b, OFF_PEER_OUT)
    WSF(float, ss, OFF_SS)
    WSF(float, partial, OFF_PARTIAL)
    WSF(bf16_t, u_c, OFF_UC) WSF(bf16_t, v_c, OFF_VC)
    WSF(unsigned, queue, OFF_QUEUE)
    WSF(bf16_t, subk_b, OFF_SUBK)
    WSF(unsigned, bar, OFF_BAR)
    WSF(float, ss1, OFF_SS1) WSF(unsigned, hmax, OFF_HMAX) WSF(float, csum, OFF_CSUM)
    WSF(float, scale_u, OFF_SCALE_U) WSF(float, scale_v, OFF_SCALE_V)
    WSF(bf16_t, vT, OFF_VT)
    WSF(signed char, hq, OFF_H)
    WSF(signed char, w_in_q, OFF_W_IN_T)
    WSF(float, sa, OFF_SA) WSF(float, sb, OFF_SB)
    WSF(signed char, h2q, OFF_MIX)
    WSF(signed char, w_q_q, OFF_W_Q_T)
    WSF(bf16_t, kvT, OFF_KVT)
#undef WSF
};

__device__ __forceinline__ float bf2f(bf16_t v) { return __uint_as_float(((unsigned)v) << 16); }
__device__ __forceinline__ bf16_t f2bf(float f) {
    unsigned u = __float_as_uint(f);
    u += 0x7FFFu + ((u >> 16) & 1u);
    return (bf16_t)(u >> 16);
}
__device__ __forceinline__ float bflo(unsigned u) { return __uint_as_float(u << 16); }
__device__ __forceinline__ float bfhi(unsigned u) { return __uint_as_float(u & 0xFFFF0000u); }
typedef __bf16 bf16x2v_t __attribute__((ext_vector_type(2)));
typedef float f32x2v_t __attribute__((ext_vector_type(2)));
__device__ __forceinline__ unsigned pack2(float a, float b) {
    const f32x2v_t v = {a, b};
    return __builtin_bit_cast(unsigned, __builtin_convertvector(v, bf16x2v_t));
}

__device__ __forceinline__ float wave_sum(float v) {
#pragma unroll
    for (int o = 32; o; o >>= 1) v += __shfl_xor(v, o);
    return v;
}
__device__ __forceinline__ float wave_max(float v) {
#pragma unroll
    for (int o = 32; o; o >>= 1) v = fmaxf(v, __shfl_xor(v, o));
    return v;
}


typedef __bf16 bf16x2_t __attribute__((ext_vector_type(2)));
template <int CTRL>
__device__ __forceinline__ float dpp_mov(float v) {
    return __builtin_bit_cast(float, __builtin_amdgcn_update_dpp(0, __builtin_bit_cast(int, v), CTRL, 0xf, 0xf, true));
}
#define DPP_QP_X1 0xB1
#define DPP_QP_X2 0x4E
#define DPP_HMIRROR 0x141
#define DPP_ROR8 0x128
__device__ __forceinline__ unsigned xcc_id() { return (unsigned)__builtin_amdgcn_s_getreg((3 << 11) | 20) & 0xFu; }

__device__ __forceinline__ void transpose_tile(const float* __restrict__ in, bf16_t* __restrict__ out, int K, int N, int tile, char* smem) {
    float* tl = (float*)smem;
    const int ntn = N >> 6;
    const int k0 = (tile / ntn) << 6, n0 = (tile % ntn) << 6;
    const int tid = VTID;
    __syncthreads();
#pragma unroll 4
    for (int i = 0; i < 16; ++i) {
        int idx = tid + 256 * i;
        int r = idx >> 6, c = idx & 63;
        tl[r * 65 + c] = in[(size_t)(k0 + r) * N + n0 + c];
    }
    __syncthreads();
#pragma unroll 4
    for (int i = 0; i < 16; ++i) {
        int idx = tid + 256 * i;
        int r = idx >> 6, c = idx & 63;
        out[(size_t)(n0 + r) * K + k0 + c] = f2bf(tl[c * 65 + r]);
    }
}

__device__ __forceinline__ void rmsnorm_row_bf16(const float* __restrict__ xr, const float* __restrict__ g, bf16_t* __restrict__ o, int lane) {
    float4 v[4];
    float ss = 0.f;
#pragma unroll
    for (int j = 0; j < 4; ++j) {
        v[j] = *(const float4*)(xr + (j * 64 + lane) * 4);
        ss += v[j].x * v[j].x + v[j].y * v[j].y + v[j].z * v[j].z + v[j].w * v[j].w;
    }
    ss = wave_sum(ss);
    const float rs = rsqrtf(ss * (1.0f / 1024.0f) + EPS);
#pragma unroll
    for (int j = 0; j < 4; ++j) {
        const float4 gg = *(const float4*)(g + (j * 64 + lane) * 4);
        uint2 pk;
        pk.x = pack2(v[j].x * rs * gg.x, v[j].y * rs * gg.y);
        pk.y = pack2(v[j].z * rs * gg.z, v[j].w * rs * gg.w);
        *(uint2*)(o + (j * 64 + lane) * 4) = pk;
    }
}

__device__ __forceinline__ void rmsnorm_row_i8(const float* __restrict__ xr, const float* __restrict__ g, signed char* __restrict__ o, float* __restrict__ sa, int lane) {
    float4 v[4];
    float ss = 0.f;
#pragma unroll
    for (int j = 0; j < 4; ++j) {
        v[j] = *(const float4*)(xr + (j * 64 + lane) * 4);
        ss += v[j].x * v[j].x + v[j].y * v[j].y + v[j].z * v[j].z + v[j].w * v[j].w;
    }
    ss = wave_sum(ss);
    const float rs = rsqrtf(ss * (1.0f / 1024.0f) + EPS);
    float am = 0.f;
#pragma unroll
    for (int j = 0; j < 4; ++j) {
        const float4 gg = *(const float4*)(g + (j * 64 + lane) * 4);
        v[j].x *= rs * gg.x; v[j].y *= rs * gg.y; v[j].z *= rs * gg.z; v[j].w *= rs * gg.w;
        am = fmaxf(am, fmaxf(fmaxf(fabsf(v[j].x), fabsf(v[j].y)), fmaxf(fabsf(v[j].z), fabsf(v[j].w))));
    }
    am = wave_max(am);
    const float qs = am > 0.f ? 127.0f / am : 0.f;
    if (lane == 0) *sa = am * (1.0f / 127.0f);
#pragma unroll
    for (int j = 0; j < 4; ++j) {
        const int q0 = (int)rintf(v[j].x * qs), q1 = (int)rintf(v[j].y * qs), q2 = (int)rintf(v[j].z * qs), q3 = (int)rintf(v[j].w * qs);
        *(unsigned*)(o + (j * 64 + lane) * 4) = (unsigned)(q0 & 255) | ((unsigned)(q1 & 255) << 8) | ((unsigned)(q2 & 255) << 16) | ((unsigned)(q3 & 255) << 24);
    }
}
__device__ __forceinline__ void transpose_cols_i8(const float* __restrict__ in, signed char* __restrict__ out, float* __restrict__ sb, int N, int item, char* smem) {
    float* tl = (float*)smem;
    const int n0 = item << 4;
    const int tid = VTID;
    __syncthreads();
    {
        float4 v[16];
#pragma unroll
        for (int i = 0; i < 16; ++i) {
            const int idx = tid + 256 * i;
            v[i] = *(const float4*)(in + (size_t)(idx >> 2) * N + n0 + (idx & 3) * 4);
        }
#pragma unroll
        for (int i = 0; i < 16; ++i) {
            const int idx = tid + 256 * i;
            const int k = idx >> 2, c = (idx & 3) * 4;
            tl[(c + 0) * 1028 + k] = v[i].x; tl[(c + 1) * 1028 + k] = v[i].y; tl[(c + 2) * 1028 + k] = v[i].z; tl[(c + 3) * 1028 + k] = v[i].w;
        }
    }
    __syncthreads();
    float qs;
    {
        const int c = tid >> 4, l = tid & 15;
        float am = 0.f;
#pragma unroll 8
        for (int i = 0; i < 64; ++i) am = fmaxf(am, fabsf(tl[c * 1028 + l + 16 * i]));
        am = fmaxf(am, __shfl_xor(am, 1)); am = fmaxf(am, __shfl_xor(am, 2)); am = fmaxf(am, __shfl_xor(am, 4)); am = fmaxf(am, __shfl_xor(am, 8));
        if (l == 0) sb[n0 + c] = am * (1.0f / 127.0f);
        qs = am > 0.f ? 127.0f / am : 0.f;
    }
    __syncthreads();
    float* qt = tl + 16 * 1028;
    if ((tid & 15) == 0) qt[tid >> 4] = qs;
    __syncthreads();
#pragma unroll
    for (int i = 0; i < 16; ++i) {
        const int kq = tid * 4;
        const float q = qt[i];
        const float4 v = *(const float4*)(tl + i * 1028 + kq);
        const int q0 = (int)rintf(v.x * q), q1 = (int)rintf(v.y * q), q2 = (int)rintf(v.z * q), q3 = (int)rintf(v.w * q);
        *(unsigned*)(out + (size_t)(n0 + i) * 1024 + kq) = (unsigned)(q0 & 255) | ((unsigned)(q1 & 255) << 8) | ((unsigned)(q2 & 255) << 16) | ((unsigned)(q3 & 255) << 24);
    }
}

__device__ void phase_prep(const Params& p, char* smem) {
    const int tid = VTID, lane = tid & 63, w = tid >> 6;
    const int gsz = VGRID, bid = VBID;
    const int t_in = INW / 16;
    const int t_out = 16 * 16;
    const int t_q = QW / 16;
    const int t_kv = 16 * 8;
    const int t_all = t_in + t_out + t_q + t_kv;
    for (int it = bid; it < t_all; it += gsz) {
        if (it < t_in) transpose_cols_i8(p.w_in, p.w_in_q(), p.sb(), INW, it, smem);
        else if (it < t_in + t_out) transpose_tile(p.w_out, p.w_out_t(), 1024, 1024, it - t_in, smem);
        else if (it < t_in + t_out + t_q) transpose_cols_i8(p.w_q, p.w_q_q(), p.sb() + INW, QW, it - t_in - t_out, smem);
        else transpose_tile(p.w_kv, p.w_kv_t(), 1024, 512, it - t_in - t_out - t_q, smem);
    }
    for (int i = bid * 256 + tid; i < NTOK; i += gsz * 256) { p.ss1()[i] = 0.f; p.hmax()[i] = 0u; }
    if (bid == 0) {
        for (int i = tid; i < 512; i += 256) {
            int dir = i >> 8, k = i & 255;
            float a0 = p.hg_lb[(dir * 2 + 0) * 256 + k], a1 = p.hg_lb[(dir * 2 + 1) * 256 + k];
            float m = fmaxf(a0, a1);
            float e0 = expf(a0 - m), e1 = expf(a1 - m);
            p.lb()[i] = e0 / (e0 + e1);
        }
    }
    const int nrows = NTOK + 1024;
    for (int r0 = bid * 4; r0 < nrows; r0 += gsz * 4) {
        int r = r0 + w;
        if (r < NTOK) rmsnorm_row_i8(p.x + (size_t)r * D, p.attn_g, p.hq() + (size_t)r * D, p.sa() + r, lane);
        else if (r < nrows) rmsnorm_row_bf16(p.mem + (size_t)(r - NTOK) * D, p.mem_g, p.memn() + (size_t)(r - NTOK) * D, lane);
    }
    for (int i = bid * 256 + tid; i < 16 * 128 * 128 / 4; i += gsz * 256) {
        const float4 v = *(const float4*)(p.subk + (size_t)i * 4);
        uint2 pk; pk.x = pack2(v.x, v.y); pk.y = pack2(v.z, v.w);
        *(uint2*)(p.subk_b() + (size_t)i * 4) = pk;
    }
    for (int r0 = bid * 4; r0 < 2 * 16384; r0 += gsz * 4) {
        const int r = r0 + w;
        const bool isv = r >= 16384;
        const int e = r & 16383;
        const float* srcp = (isv ? p.pv : p.pu) + (size_t)e * D;
        unsigned* dst = (unsigned*)(isv ? p.v_c() : p.u_c());
        float4 v[4];
        float am = 0.f;
#pragma unroll
        for (int j = 0; j < 4; ++j) {
            v[j] = *(const float4*)(srcp + (j * 64 + lane) * 4);
            am = fmaxf(am, fmaxf(fmaxf(fabsf(v[j].x), fabsf(v[j].y)), fmaxf(fabsf(v[j].z), fabsf(v[j].w))));
        }
        am = wave_max(am);
        const float qs = am > 0.f ? 127.0f / am : 0.f;
        if (lane == 0) (isv ? p.scale_v() : p.scale_u())[e] = am * (1.0f / 127.0f);
        const int off = 0;
#pragma unroll
        for (int j = 0; j < 4; ++j) {
            const int q0 = (int)rintf(v[j].x * qs) + off, q1 = (int)rintf(v[j].y * qs) + off;
            const int q2 = (int)rintf(v[j].z * qs) + off, q3 = (int)rintf(v[j].w * qs) + off;
            const unsigned pk = (unsigned)(q0 & 255) | ((unsigned)(q1 & 255) << 8) | ((unsigned)(q2 & 255) << 16) | ((unsigned)(q3 & 255) << 24);
            const int c = j * 2 + (lane >> 5), d = (lane & 31) * 4;
            dst[(((size_t)c * 16384 + e) * 128 + d) >> 2] = pk;
        }
    }
}

struct EpiBf16 {
    bf16_t* C; int ldc;
    __device__ __forceinline__ void operator()(int row, int col, const f32x4& v) const {
        uint2 pk; pk.x = pack2(v[0], v[1]); pk.y = pack2(v[2], v[3]);
        *(uint2*)(C + (size_t)row * ldc + col) = pk;
    }
};
struct EpiBf16T {
    bf16_t* C; int col0, ncols, rows_per_b;
    __device__ __forceinline__ void operator()(int row, int col, const f32x4& v) const {
        const int bb = row / rows_per_b, rr = row - bb * rows_per_b;
        uint2 pk; pk.x = pack2(v[0], v[1]); pk.y = pack2(v[2], v[3]);
        *(uint2*)(C + ((size_t)bb * ncols + (col - col0)) * rows_per_b + rr) = pk;
    }
};
struct EpiBf16S {
    bf16_t* C; int ldc; const float* sa; const float* sb;
    __device__ __forceinline__ void operator()(int row, int col, const f32x4& v) const {
        const float s = sa[row];
        const float4 b = *(const float4*)(sb + col);
        uint2 pk; pk.x = pack2(v[0] * s * b.x, v[1] * s * b.y); pk.y = pack2(v[2] * s * b.z, v[3] * s * b.w);
        *(uint2*)(C + (size_t)row * ldc + col) = pk;
    }
};
struct EpiBf16TS {
    bf16_t* C; int col0, ncols, rows_per_b; const float* sa; const float* sb;
    __device__ __forceinline__ void operator()(int row, int col, const f32x4& v) const {
        const int bb = row / rows_per_b, rr = row - bb * rows_per_b;
        const float4 a = *(const float4*)(sa + row);
        const float b = sb[col];
        uint2 pk; pk.x = pack2(v[0] * a.x * b, v[1] * a.y * b); pk.y = pack2(v[2] * a.z * b, v[3] * a.w * b);
        *(uint2*)(C + ((size_t)bb * ncols + (col - col0)) * rows_per_b + rr) = pk;
    }
};
constexpr int EPS_LD = 528;
struct EpiBf16SStaged {
    static constexpr bool staged = true;
    bf16_t* C; int ldc; const float* sa; const float* sb; char* lt; int brow, bcol;
    __device__ __forceinline__ void operator()(int row, int col, const f32x4& v) const {
        const float s = sa[row];
        const float4 b = *(const float4*)(sb + col);
        uint2 pk; pk.x = pack2(v[0] * s * b.x, v[1] * s * b.y); pk.y = pack2(v[2] * s * b.z, v[3] * s * b.w);
        *(uint2*)(lt + (row - brow) * EPS_LD + (col - bcol) * 2) = pk;
    }
    __device__ __forceinline__ void finish() const {
        int tid = threadIdx.x;
        asm volatile("" : "+v"(tid));
        const int c16 = tid & 31, r0 = tid >> 5;
#pragma unroll
        for (int i = 0; i < 16; ++i) {
            const int r = i * 16 + r0;
            *(uint4*)(C + (size_t)(brow + r) * ldc + bcol + c16 * 8) = *(const uint4*)(lt + r * EPS_LD + c16 * 16);
        }
    }
};
struct EpiBf16TSStaged {
    static constexpr bool staged = true;
    bf16_t* Cb; const float* sa; const float* sb; char* lt; int brow, bcol;
    __device__ __forceinline__ void operator()(int row, int col, const f32x4& v) const {
        const float4 a = *(const float4*)(sa + row);
        const float b = sb[col];
        uint2 pk; pk.x = pack2(v[0] * a.x * b, v[1] * a.y * b); pk.y = pack2(v[2] * a.z * b, v[3] * a.w * b);
        *(uint2*)(lt + (col - bcol) * EPS_LD + (row - brow) * 2) = pk;
    }
    __device__ __forceinline__ void finish() const {
        int tid = threadIdx.x;
        asm volatile("" : "+v"(tid));
        const int c16 = tid & 31, r0 = tid >> 5;
#pragma unroll
        for (int i = 0; i < 16; ++i) {
            const int r = i * 16 + r0;
            *(uint4*)(Cb + (size_t)r * T + c16 * 8) = *(const uint4*)(lt + r * EPS_LD + c16 * 16);
        }
    }
};
struct EpiBf16RowScale {
    bf16_t* C; int ldc; const float* ssrow;
    __device__ __forceinline__ void operator()(int row, int col, const f32x4& v) const {
        const float rs = rsqrtf(ssrow[row] * (1.0f / 1024.0f) + EPS);
        uint2 pk; pk.x = pack2(v[0] * rs, v[1] * rs); pk.y = pack2(v[2] * rs, v[3] * rs);
        *(uint2*)(C + (size_t)row * ldc + col) = pk;
    }
};
struct EpiResNorm {
    bf16_t* C; const float* R; const float* g; int ldc; float* ssrow; unsigned* hmax;
    __device__ __forceinline__ void operator()(int row, int col, const f32x4& v, float& ssq, float& am) const {
        const float4 r = *(const float4*)(R + (size_t)row * ldc + col);
        const float4 gg = *(const float4*)(g + col);
        float4 o; o.x = v[0] + r.x; o.y = v[1] + r.y; o.z = v[2] + r.z; o.w = v[3] + r.w;
        uint2 xk; xk.x = pack2(o.x, o.y); xk.y = pack2(o.z, o.w);
        *(uint2*)(C + (size_t)row * ldc + col) = xk;
        const float h0 = bflo(xk.x) * gg.x, h1 = bfhi(xk.x) * gg.y, h2 = bflo(xk.y) * gg.z, h3 = bfhi(xk.y) * gg.w;
        ssq += o.x * o.x + o.y * o.y + o.z * o.z + o.w * o.w;
        am = fmaxf(am, fmaxf(fmaxf(fabsf(h0), fabsf(h1)), fmaxf(fabsf(h2), fabsf(h3))));
    }
    __device__ __forceinline__ void row_done(int row, float ssq, float am) const {
        atomicAdd(ssrow + row, ssq);
        atomicMax(hmax + row, __float_as_uint(am));
    }
};
struct EpiResF32 {
    float* C; const float* R; int ldc;
    __device__ __forceinline__ void operator()(int row, int col, const f32x4& v) const {
        const float4 r = *(const float4*)(R + (size_t)row * ldc + col);
        float4 o; o.x = v[0] + r.x; o.y = v[1] + r.y; o.z = v[2] + r.z; o.w = v[3] + r.w;
        *(float4*)(C + (size_t)row * ldc + col) = o;
    }
};

template <bool TRANS, class Epi, bool ROWSS = false>
__device__ __forceinline__ void gemm_tile(const bf16_t* __restrict__ A, int lda, const bf16_t* __restrict__ Bt, int ldb, int K,
                                          int m0, int n0, char* smem, const Epi& epi, float* ssrow = nullptr) {
    const int tid = VTID, lane = tid & 63, w = tid >> 6, wr = w >> 1, wc = w & 1;
    const int fr = lane & 15, fq = lane >> 4;
    const int srow = lane >> 3, sslot = lane & 7;
    f32x4 acc[4][4];
#pragma unroll
    for (int mi = 0; mi < 4; ++mi)
#pragma unroll
        for (int ni = 0; ni < 4; ++ni) acc[mi][ni] = (f32x4){0.f, 0.f, 0.f, 0.f};
    const int g0 = (sslot ^ (srow >> 1)) * 8, g1 = (sslot ^ (4 + (srow >> 1))) * 8;
    const bf16_t* Ab = A + (size_t)(m0 + w * 32 + srow) * lda;
    const bf16_t* Bb = Bt + (size_t)(n0 + w * 32 + srow) * ldb;
    const int nk = K >> 6;
    __syncthreads();
#define GEMM_STAGE(kt, buf)                                                                                                  \
    do {                                                                                                                     \
        char* sa = smem + (buf) * 32768 + w * 4096;                                                                          \
        char* sb = sa + 16384;                                                                                               \
        _Pragma("unroll") for (int i = 0; i < 4; ++i) {                                                                      \
            const int gc = (i & 1) ? g1 : g0;                                                                                \
            __builtin_amdgcn_global_load_lds((const unsigned*)(Ab + (size_t)(i * 8) * lda + (kt) * 64 + gc), (unsigned*)(sa + i * 1024), 16, 0, 0); \
            __builtin_amdgcn_global_load_lds((const unsigned*)(Bb + (size_t)(i * 8) * ldb + (kt) * 64 + gc), (unsigned*)(sb + i * 1024), 16, 0, 0); \
        }                                                                                                                    \
    } while (0)
    GEMM_STAGE(0, 0);
    const int key = fr >> 1;
    for (int kt = 0; kt < nk; ++kt) {
        asm volatile("s_waitcnt vmcnt(0)" ::: "memory");
        __syncthreads();
        if (kt + 1 < nk) GEMM_STAGE(kt + 1, (kt + 1) & 1);
        const char* sa = smem + (kt & 1) * 32768;
        const char* sb = sa + 16384;
#pragma unroll
        for (int ks = 0; ks < 2; ++ks) {
            bf16x8 af[4], bfr[4];
            const int co = ((ks * 4 + fq) ^ key) << 4;
#pragma unroll
            for (int mi = 0; mi < 4; ++mi) af[mi] = *(const bf16x8*)(sa + (wr * 64 + mi * 16 + fr) * 128 + co);
#pragma unroll
            for (int ni = 0; ni < 4; ++ni) bfr[ni] = *(const bf16x8*)(sb + (wc * 64 + ni * 16 + fr) * 128 + co);
#pragma unroll
            for (int mi = 0; mi < 4; ++mi)
#pragma unroll
                for (int ni = 0; ni < 4; ++ni)
                    acc[mi][ni] = TRANS ? __builtin_amdgcn_mfma_f32_16x16x32_bf16(af[mi], bfr[ni], acc[mi][ni], 0, 0, 0)
                                        : __builtin_amdgcn_mfma_f32_16x16x32_bf16(bfr[ni], af[mi], acc[mi][ni], 0, 0, 0);
        }
    }
#undef GEMM_STAGE
    if constexpr (ROWSS) {
#pragma unroll
        for (int mi = 0; mi < 4; ++mi) {
            const int row = m0 + wr * 64 + mi * 16 + fr;
            float ssq = 0.f, am = 0.f;
#pragma unroll
            for (int ni = 0; ni < 4; ++ni) epi(row, n0 + wc * 64 + ni * 16 + fq * 4, acc[mi][ni], ssq, am);
            ssq += __shfl_xor(ssq, 16);
            ssq += __shfl_xor(ssq, 32);
            am = fmaxf(am, __shfl_xor(am, 16));
            am = fmaxf(am, __shfl_xor(am, 32));
            if (fq == 0) epi.row_done(row, ssq, am);
        }
    } else {
#pragma unroll
        for (int mi = 0; mi < 4; ++mi)
#pragma unroll
            for (int ni = 0; ni < 4; ++ni) {
                if (TRANS) epi(m0 + wr * 64 + mi * 16 + fq * 4, n0 + wc * 64 + ni * 16 + fr, acc[mi][ni]);
                else epi(m0 + wr * 64 + mi * 16 + fr, n0 + wc * 64 + ni * 16 + fq * 4, acc[mi][ni]);
            }
    }
}


namespace g8 {
constexpr int BM = 256, BK = 64, HALF = 128, HT = HALF * BK;
__device__ __forceinline__ int lds_byte(int r, int c) {
    const int st = (r >> 4) * 2 + (c >> 5), rr = r & 15, cc = c & 31, ob = rr * 64 + cc * 2;
    return st * 1024 + (ob ^ (((ob >> 9) & 1) << 5));
}
__device__ __forceinline__ void stage_rc(int b, int& R, int& C) {
    const int st = b / 1024, sb = b % 1024, swz = sb ^ (((sb >> 9) & 1) << 5);
    R = (st >> 1) * 16 + swz / 64; C = (st & 1) * 32 + (swz % 64) / 2;
}
__device__ __forceinline__ void tile_of(int L, int nM, int nN, int& pm, int& pn) {
    const int nwg = nM * nN;
    int wgid = L;
    { const int q = nwg / 8, r = nwg % 8, xcd = wgid % 8, off = wgid / 8; wgid = (xcd < r ? xcd * (q + 1) : r * (q + 1) + (xcd - r) * q) + off; }
    const int nig = 8 * nN, gid = wgid / nig, fm = gid * 8, gsz = (nM - fm) < 8 ? (nM - fm) : 8;
    pm = fm + ((wgid % nig) % gsz); pn = (wgid % nig) / gsz;
}
}

#define G8_LAS __attribute__((address_space(3)))
template <bool I8, bool TRANS, class Acc>
__device__ __forceinline__ void g8_mma(Acc& c, const bf16x8& a, const bf16x8& b) {
    if constexpr (I8) {
        const i32x4 ai = __builtin_bit_cast(i32x4, a), bi = __builtin_bit_cast(i32x4, b);
        c = TRANS ? __builtin_amdgcn_mfma_i32_16x16x64_i8(ai, bi, c, 0, 0, 0) : __builtin_amdgcn_mfma_i32_16x16x64_i8(bi, ai, c, 0, 0, 0);
    } else {
        c = TRANS ? __builtin_amdgcn_mfma_f32_16x16x32_bf16(a, b, c, 0, 0, 0) : __builtin_amdgcn_mfma_f32_16x16x32_bf16(b, a, c, 0, 0, 0);
    }
}
template <bool I8> struct g8_acc { using type = f32x4; };
template <> struct g8_acc<true> { using type = i32x4; };
template <bool I8, class Acc> __device__ __forceinline__ f32x4 g8_cvt(const Acc& a) {
    if constexpr (I8) return (f32x4){(float)a[0], (float)a[1], (float)a[2], (float)a[3]};
    else return a;
}
template <bool TRANS, bool ROWSS, bool I8, class Epi>
__device__ __forceinline__ void gemm256_tile(const void* __restrict__ A, const void* __restrict__ Bt, int K, int brow, int bcol,
                                             char* shmc, const Epi& epi) {
    using namespace g8;
    constexpr int ES = I8 ? 1 : 2;
    using acc_t = typename g8_acc<I8>::type;
    G8_LAS unsigned char* lds = (G8_LAS unsigned char*)shmc;
    const int tid = threadIdx.x, wid = __builtin_amdgcn_readfirstlane(tid >> 6), lane = tid & 63, wr = wid >> 2, wc = wid & 3, fr = lane & 15, fq = lane >> 4;
    constexpr int HTB = HALF * BK * 2;
    unsigned voff[2];
#pragma unroll
    for (int i = 0; i < 2; ++i) { int R, C; stage_rc(tid * 16 + i * 8192, R, C); voff[i] = (unsigned)(R * K * ES + C * 2); }
    const size_t kstep = (size_t)(BK * 2);
    const size_t hstep = (size_t)HALF * K * ES;
    const unsigned ldsw = (unsigned)wid * 1024u;
    const int aoff = lds_byte(wr * 64 + fr, fq * 8), boff = lds_byte(wc * 32 + fr, fq * 8);
    const char* cA = (const char*)A + (size_t)brow * K * ES;
    const char* cB = (const char*)Bt + (size_t)bcol * K * ES;
#define G8_SA(b, h) (((b) * 2 + (h)) * HTB)
#define G8_SB(b, h) ((4 + (b) * 2 + (h)) * HTB)
#define G8_STAGE(bufoff, gbase) do { _Pragma("unroll") for (int _i = 0; _i < 2; ++_i) \
        __builtin_amdgcn_global_load_lds((const unsigned*)((const char*)(gbase) + voff[_i]), (G8_LAS unsigned*)(lds + (bufoff) + ldsw + _i * 8192), 16, 0, 0); } while (0)
#define G8_LDA(dst, b, h) do { _Pragma("unroll") for (int m = 0; m < 4; ++m) _Pragma("unroll") for (int k = 0; k < 2; ++k) dst[m][k] = *(const G8_LAS bf16x8*)(lds + G8_SA(b, h) + aoff + m * 2048 + k * 1024); } while (0)
#define G8_LDB(dst, b, h) do { _Pragma("unroll") for (int n = 0; n < 2; ++n) _Pragma("unroll") for (int k = 0; k < 2; ++k) dst[n][k] = *(const G8_LAS bf16x8*)(lds + G8_SB(b, h) + boff + n * 2048 + k * 1024); } while (0)
#define G8_MMA(ai, bj, At_, Bt_) do { __builtin_amdgcn_s_setprio(1); _Pragma("unroll") for (int m = 0; m < 4; ++m) _Pragma("unroll") for (int n = 0; n < 2; ++n) _Pragma("unroll") for (int k = 0; k < 2; ++k) \
        g8_mma<I8, TRANS>(acc[ai][bj][m][n], At_[m][k], Bt_[n][k]); \
        __builtin_amdgcn_s_setprio(0); } while (0)
#define G8_WAIT_V(n) asm volatile("s_waitcnt vmcnt(" #n ")" ::: "memory")
#define G8_WAIT_L(n) asm volatile("s_waitcnt lgkmcnt(" #n ")" ::: "memory")
#define G8_BAR __builtin_amdgcn_s_barrier()
#define G8_SCHED __builtin_amdgcn_sched_barrier(0)
    acc_t acc[2][2][4][2];
#pragma unroll
    for (int a = 0; a < 2; ++a)
#pragma unroll
        for (int b = 0; b < 2; ++b)
#pragma unroll
            for (int m = 0; m < 4; ++m)
#pragma unroll
                for (int n = 0; n < 2; ++n) acc[a][b][m][n] = (acc_t){0, 0, 0, 0};
    bf16x8 At[4][2], B0[2][2], B1[2][2];
    const int nt = K * ES / (BK * 2);
    __syncthreads();
    G8_STAGE(G8_SB(0, 0), cB); G8_STAGE(G8_SA(0, 0), cA); G8_STAGE(G8_SB(0, 1), cB + hstep); G8_STAGE(G8_SA(0, 1), cA + hstep);
    if (wr == 1) G8_BAR;
    G8_WAIT_V(4); G8_BAR;
    G8_STAGE(G8_SB(1, 0), cB + kstep); G8_STAGE(G8_SA(1, 0), cA + kstep); G8_STAGE(G8_SB(1, 1), cB + hstep + kstep);
    G8_WAIT_V(6); G8_BAR;
    for (int t = 0; t < nt - 2; t += 2) {
        const char* a1 = cA + (size_t)(t + 1) * kstep; const char* a2 = a1 + kstep; const char* a3 = a2 + kstep;
        const char* b2 = cB + (size_t)(t + 2) * kstep; const char* b3 = b2 + kstep;
        G8_LDB(B0, 0, 0); G8_SCHED; G8_LDA(At, 0, 0); G8_STAGE(G8_SA(1, 1), a1 + hstep);
        G8_WAIT_L(8); G8_BAR; G8_WAIT_L(0); G8_MMA(0, 0, At, B0); G8_BAR; G8_SCHED;
        G8_LDB(B1, 0, 1); G8_STAGE(G8_SB(0, 0), b2);
        G8_BAR; G8_WAIT_L(0); G8_MMA(0, 1, At, B1); G8_BAR;
        G8_LDA(At, 0, 1); G8_STAGE(G8_SA(0, 0), a2);
        G8_BAR; G8_WAIT_L(0); G8_MMA(1, 0, At, B0); G8_BAR; G8_SCHED;
        G8_STAGE(G8_SB(0, 1), b2 + hstep);
        G8_WAIT_V(6); G8_BAR; G8_MMA(1, 1, At, B1); G8_BAR;
        G8_LDB(B0, 1, 0); G8_SCHED; G8_LDA(At, 1, 0); G8_STAGE(G8_SA(0, 1), a2 + hstep);
        G8_WAIT_L(8); G8_BAR; G8_WAIT_L(0); G8_MMA(0, 0, At, B0); G8_BAR; G8_SCHED;
        G8_LDB(B1, 1, 1); G8_STAGE(G8_SB(1, 0), b3);
        G8_BAR; G8_WAIT_L(0); G8_MMA(0, 1, At, B1); G8_BAR;
        G8_LDA(At, 1, 1); G8_STAGE(G8_SA(1, 0), a3);
        G8_BAR; G8_WAIT_L(0); G8_MMA(1, 0, At, B0); G8_BAR; G8_SCHED;
        G8_STAGE(G8_SB(1, 1), b3 + hstep);
        G8_WAIT_V(6); G8_BAR; G8_MMA(1, 1, At, B1); G8_BAR;
    }
    { G8_LDB(B0, 0, 0); G8_LDA(At, 0, 0); G8_STAGE(G8_SA(1, 1), cA + (size_t)(nt - 1) * kstep + hstep);
      G8_BAR; G8_WAIT_L(0); G8_MMA(0, 0, At, B0); G8_BAR;
      G8_LDB(B1, 0, 1); G8_BAR; G8_WAIT_L(0); G8_MMA(0, 1, At, B1); G8_BAR;
      G8_LDA(At, 0, 1); G8_WAIT_V(4); G8_BAR; G8_WAIT_L(0); G8_MMA(1, 0, At, B0); G8_MMA(1, 1, At, B1); G8_BAR; }
    { G8_LDB(B0, 1, 0); G8_LDA(At, 1, 0); G8_WAIT_V(2); G8_BAR; G8_WAIT_L(0); G8_MMA(0, 0, At, B0); G8_BAR;
      G8_LDB(B1, 1, 1); G8_WAIT_V(0); G8_BAR; G8_WAIT_L(0); G8_MMA(0, 1, At, B1); G8_BAR;
      G8_LDA(At, 1, 1); G8_BAR; G8_WAIT_L(0); G8_MMA(1, 0, At, B0); G8_MMA(1, 1, At, B1); G8_BAR; }
    if (wr == 0) G8_BAR;
    if constexpr (ROWSS) {
#pragma unroll
        for (int ai = 0; ai < 2; ++ai)
#pragma unroll
            for (int m = 0; m < 4; ++m) {
                const int row = brow + ai * HALF + wr * 64 + m * 16 + fr;
                float ssq = 0.f, am = 0.f;
#pragma unroll
                for (int bj = 0; bj < 2; ++bj)
#pragma unroll
                    for (int n = 0; n < 2; ++n) epi(row, bcol + bj * HALF + wc * 32 + n * 16 + fq * 4, g8_cvt<I8>(acc[ai][bj][m][n]), ssq, am);
                ssq += __shfl_xor(ssq, 16);
                ssq += __shfl_xor(ssq, 32);
                am = fmaxf(am, __shfl_xor(am, 16));
                am = fmaxf(am, __shfl_xor(am, 32));
                if (fq == 0) epi.row_done(row, ssq, am);
            }
    } else {
#pragma unroll
        for (int ai = 0; ai < 2; ++ai)
#pragma unroll
            for (int bj = 0; bj < 2; ++bj)
#pragma unroll
                for (int m = 0; m < 4; ++m)
#pragma unroll
                    for (int n = 0; n < 2; ++n) {
                        if (TRANS) epi(brow + ai * HALF + wr * 64 + m * 16 + fq * 4, bcol + bj * HALF + wc * 32 + n * 16 + fr, g8_cvt<I8>(acc[ai][bj][m][n]));
                        else epi(brow + ai * HALF + wr * 64 + m * 16 + fr, bcol + bj * HALF + wc * 32 + n * 16 + fq * 4, g8_cvt<I8>(acc[ai][bj][m][n]));
                    }
    }
#undef G8_SA
#undef G8_SB
#undef G8_STAGE
#undef G8_LDA
#undef G8_LDB
#undef G8_MMA
#undef G8_WAIT_V
#undef G8_WAIT_L
#undef G8_BAR
#undef G8_SCHED
}

__device__ void phase_gemm_in(const Params& p, char* smem) {
    const int nM = NTOK / 256, nN = INW / 256;
    for (int i = 0; i * (int)gridDim.x + (int)blockIdx.x < nM * nN; ++i) {
        int pm, pn;
        g8::tile_of(i * gridDim.x + blockIdx.x, nM, nN, pm, pn);
        if (pn >= 4 && pn < 6) {
            const int bb = (pm * 256) / T, rr = (pm * 256) % T;
            EpiBf16TSStaged e1t{p.vT() + ((size_t)bb * 512 + (pn * 256 - 1024)) * T + rr, p.sa(), p.sb(), smem, pm * 256, pn * 256};
            gemm256_tile<true, false, true>(p.hq(), p.w_in_q(), D, pm * 256, pn * 256, smem, e1t);
            __syncthreads();
            e1t.finish();
        } else {
            EpiBf16SStaged e1{p.z(), INW, p.sa(), p.sb(), smem, pm * 256, pn * 256};
            gemm256_tile<false, false, true>(p.hq(), p.w_in_q(), D, pm * 256, pn * 256, smem, e1);
            __syncthreads();
            e1.finish();
        }
    }
}

__device__ void phase_gemm_kv(const Params& p, char* smh) {
    EpiBf16 e2{p.kvb(), 512};
    EpiBf16T e2t{p.kvT(), 256, 256, 256};
    const bool dedicated = gridDim.x >= 64;
    if (dedicated && blockIdx.x >= 16) return;
    for (int it = VBID; it < 32; it += dedicated ? 32 : VGRID) {
        const int pm = it >> 2, pn = it & 3;
        if (pn >= 2) gemm_tile<true>(p.memn(), D, p.w_kv_t(), D, D, pm * 128, pn * 128, smh, e2t);
        else gemm_tile<false>(p.memn(), D, p.w_kv_t(), D, D, pm * 128, pn * 128, smh, e2);
    }
}

__device__ void phase_gemm_out(const Params& p, char* smem) {
    const int nM = NTOK / 256, nN = D / 256;
    EpiResNorm e{p.x1b(), p.x, p.ffn_g, D, p.ss1(), p.hmax()};
    for (int i = 0; i * (int)gridDim.x + (int)blockIdx.x < nM * nN; ++i) {
        int pm, pn;
        g8::tile_of(i * gridDim.x + blockIdx.x, nM, nN, pm, pn);
        gemm256_tile<false, true, false>(p.mix(), p.w_out_t(), D, pm * 256, pn * 256, smem, e);
    }
}

__device__ void phase_gemm_q(const Params& p, char* smem) {
    const int nM = NTOK / 256, nN = QW / 256;
    EpiBf16RowScale e{p.z(), QW, p.ss1()};
    for (int i = 0; i * (int)gridDim.x + (int)blockIdx.x < nM * nN; ++i) {
        int pm, pn;
        g8::tile_of(i * gridDim.x + blockIdx.x, nM, nN, pm, pn);
        gemm256_tile<false, false, false>(p.h(), p.w_q_t(), D, pm * 256, pn * 256, smem, e);
    }
}

typedef float f32x16 __attribute__((ext_vector_type(16)));
constexpr int HRS = 144;
__device__ __forceinline__ f32x16 tile_mm64(const char* X, const char* Y, int xrow0, int yrow0, int lane, f32x16 acc) {
    const int r = lane & 31, hh = lane >> 5;
#pragma unroll
    for (int ks = 0; ks < 4; ++ks) {
        const bf16x8 a = *(const bf16x8*)(X + (xrow0 + r) * HRS + ks * 32 + hh * 16);
        const bf16x8 b = *(const bf16x8*)(Y + (yrow0 + r) * HRS + ks * 32 + hh * 16);
        acc = __builtin_amdgcn_mfma_f32_32x32x16_bf16(a, b, acc, 0, 0, 0);
    }
    return acc;
}
__device__ __forceinline__ int crow(int reg, int hh) { return (reg & 3) + 8 * (reg >> 2) + 4 * hh; }

__device__ __forceinline__ void hg_load_vt(const Params& p, char* sVT, int tok0, int h, int kcol, int sq) {
    const bf16_t* zp = p.z() + (size_t)(tok0 + sq * 16) * INW + 2304 + h * 64 + kcol;
    unsigned pk[8];
#pragma unroll
    for (int j = 0; j < 8; ++j) {
        const unsigned lo = zp[(size_t)(2 * j) * INW], hi = zp[(size_t)(2 * j + 1) * INW];
        pk[j] = lo | (hi << 16);
    }
    *(uint4*)(sVT + kcol * HRS + sq * 32) = make_uint4(pk[0], pk[1], pk[2], pk[3]);
    *(uint4*)(sVT + kcol * HRS + sq * 32 + 16) = make_uint4(pk[4], pk[5], pk[6], pk[7]);
}

__device__ __forceinline__ float hg_gates(const Params& p, float* sTot, int tok0, int h, int dir, int kcol, int sq, float (&bj)[16], float (&kk)[16]) {
    const bf16_t* zp = p.z() + (size_t)(tok0 + sq * 16) * INW + 1792 + dir * 256 + h * 64 + kcol;
    const float lbv = p.lb()[dir * 256 + h * 64 + kcol];
#pragma unroll
    for (int j = 0; j < 16; ++j) {
        const float pre = bf2f(zp[(size_t)j * INW]);
        const float f = lbv + (1.0f - lbv) * (1.0f / (1.0f + __expf(-pre)));
        bj[j] = __logf(f);
        kk[j] = 1.0f - f;
    }
    if (dir == 0) {
#pragma unroll
        for (int j = 1; j < 16; ++j) bj[j] += bj[j - 1];
        sTot[sq * 64 + kcol] = bj[15];
    } else {
#pragma unroll
        for (int j = 14; j >= 0; --j) bj[j] += bj[j + 1];
        sTot[sq * 64 + kcol] = bj[0];
    }
    __syncthreads();
    const float t0 = sTot[kcol], t1 = sTot[64 + kcol], t2 = sTot[128 + kcol], t3 = sTot[192 + kcol];
    float off;
    if (dir == 0) off = (sq > 0 ? t0 : 0.f) + (sq > 1 ? t1 : 0.f) + (sq > 2 ? t2 : 0.f);
    else off = (sq < 3 ? t3 : 0.f) + (sq < 2 ? t2 : 0.f) + (sq < 1 ? t1 : 0.f);
#pragma unroll
    for (int j = 0; j < 16; ++j) bj[j] += off;
    return t0 + t1 + t2 + t3;
}

__device__ void hg_local(const Params& p, char* smem) {
    char* sVT = smem;
    char* sKT = smem + 9216;
    float* sTot = (float*)(smem + 18432);
    const int tid = VTID, lane = tid & 63, w = tid >> 6;
    const int kcol = tid & 63, sq = tid >> 6;
    for (int item = VBID; item < 4096; item += VGRID) {
        const int c = item & 127, dir = (item >> 7) & 1, h = (item >> 8) & 3, b = item >> 10;
        const int tok0 = b * T + c * 64;
        __syncthreads();
        hg_load_vt(p, sVT, tok0, h, kcol, sq);
        float bj[16], kk[16];
        const float btot = hg_gates(p, sTot, tok0, h, dir, kcol, sq, bj, kk);
        unsigned pk[8];
#pragma unroll
        for (int j = 0; j < 8; ++j)
            pk[j] = pack2(kk[2 * j] * __expf(btot - bj[2 * j]), kk[2 * j + 1] * __expf(btot - bj[2 * j + 1]));
        *(uint4*)(sKT + kcol * HRS + sq * 32) = make_uint4(pk[0], pk[1], pk[2], pk[3]);
        *(uint4*)(sKT + kcol * HRS + sq * 32 + 16) = make_uint4(pk[4], pk[5], pk[6], pk[7]);
        if (sq == 0) p.hdec()[item * 64 + kcol] = __expf(btot);
        __syncthreads();
        const int vi = w >> 1, ki = w & 1, hh = lane >> 5;
        f32x16 acc;
#pragma unroll
        for (int r = 0; r < 16; ++r) acc[r] = 0.f;
        acc = tile_mm64(sVT, sKT, vi * 32, ki * 32, lane, acc);
        bf16_t* dst = (bf16_t*)p.hstate() + (size_t)item * 4096 + ki * 32 + (lane & 31);
#pragma unroll
        for (int r = 0; r < 16; ++r) dst[(vi * 32 + crow(r, hh)) * 64] = f2bf(acc[r]);
    }
}

__device__ __forceinline__ bf16x8 pack8(const f32x16& x, int s8) {
    typedef unsigned u32x4_t __attribute__((ext_vector_type(4)));
    u32x4_t pk;
    pk[0] = pack2(x[s8], x[s8 + 1]); pk[1] = pack2(x[s8 + 2], x[s8 + 3]);
    pk[2] = pack2(x[s8 + 4], x[s8 + 5]); pk[3] = pack2(x[s8 + 6], x[s8 + 7]);
    return __builtin_bit_cast(bf16x8, pk);
}
__device__ __forceinline__ bf16x8 join8(const uint2& lo, const uint2& hi) {
    typedef unsigned u32x4_t __attribute__((ext_vector_type(4)));
    u32x4_t pk; pk[0] = lo.x; pk[1] = lo.y; pk[2] = hi.x; pk[3] = hi.y;
    return __builtin_bit_cast(bf16x8, pk);
}

__device__ __forceinline__ int swap23(int r) { return (r & ~12) | ((r & 4) << 1) | ((r & 8) >> 1); }

__device__ __forceinline__ void mem_attn_wave(const Params& p, int wu, int lane) {
    const int tile = wu & 255, h = (wu >> 8) & 3, b = wu >> 10;
    const int l31 = lane & 31, hh = lane >> 5;
    const int tok = b * T + tile * 32 + l31;
    bf16x8 qf[4];
#pragma unroll
    for (int ks = 0; ks < 4; ++ks) qf[ks] = *(const bf16x8*)(p.z() + (size_t)tok * INW + 2816 + h * 64 + ks * 16 + hh * 8);
    const bf16_t* kb = p.kvb() + (size_t)(b * 256 + swap23(l31)) * 512 + h * 64 + hh * 8;
    float m = -1e30f;
    f32x16 o0, o1;
#pragma unroll
    for (int r = 0; r < 16; ++r) { o0[r] = 0.f; o1[r] = 0.f; }
    float sum = 0.f;
    const bf16_t* vt = p.kvT() + ((size_t)(b * 4 + h) * 64 + l31) * 256 + 8 * hh;
    bf16x8 kf[4], vf[4];
#pragma unroll
    for (int ks = 0; ks < 4; ++ks) kf[ks] = *(const bf16x8*)(kb + ks * 16);
#pragma unroll
    for (int st = 0; st < 2; ++st) { vf[2 * st] = *(const bf16x8*)(vt + st * 16); vf[2 * st + 1] = *(const bf16x8*)(vt + 32 * 256 + st * 16); }
    for (int kt = 0; kt < 8; ++kt) {
        const int ktn = min(kt + 1, 7);
        bf16x8 kn[4], vn[4];
#pragma unroll
        for (int ks = 0; ks < 4; ++ks) kn[ks] = *(const bf16x8*)(kb + (size_t)ktn * 32 * 512 + ks * 16);
#pragma unroll
        for (int st = 0; st < 2; ++st) { vn[2 * st] = *(const bf16x8*)(vt + ktn * 32 + st * 16); vn[2 * st + 1] = *(const bf16x8*)(vt + 32 * 256 + ktn * 32 + st * 16); }
        f32x16 s;
#pragma unroll
        for (int r = 0; r < 16; ++r) s[r] = 0.f;
#pragma unroll
        for (int ks = 0; ks < 4; ++ks) s = __builtin_amdgcn_mfma_f32_32x32x16_bf16(kf[ks], qf[ks], s, 0, 0, 0);
        float tm = s[0];
#pragma unroll
        for (int r = 1; r < 16; ++r) tm = fmaxf(tm, s[r]);
        tm = fmaxf(tm, __shfl_xor(tm, 32));
        const float mn = fmaxf(m, tm);
        if (__any(mn > m)) {
            const float sc = __builtin_amdgcn_exp2f((m - mn) * 0.18033688011112042f);
            sum *= sc;
#pragma unroll
            for (int r = 0; r < 16; ++r) { o0[r] *= sc; o1[r] *= sc; }
        }
        m = mn;
        const float mb = mn * 0.18033688011112042f;
#pragma unroll
        for (int r = 0; r < 16; ++r) { s[r] = __builtin_amdgcn_exp2f(fmaf(s[r], 0.18033688011112042f, -mb)); sum += s[r]; }
#pragma unroll
        for (int st = 0; st < 2; ++st) {
            const bf16x8 pb = pack8(s, st * 8);
            o0 = __builtin_amdgcn_mfma_f32_32x32x16_bf16(vf[2 * st], pb, o0, 0, 0, 0);
            o1 = __builtin_amdgcn_mfma_f32_32x32x16_bf16(vf[2 * st + 1], pb, o1, 0, 0, 0);
        }
#pragma unroll
        for (int ks = 0; ks < 4; ++ks) kf[ks] = kn[ks];
#pragma unroll
        for (int q = 0; q < 4; ++q) vf[q] = vn[q];
    }
    sum += __shfl_xor(sum, 32);
    const float inv = 1.0f / sum;
    bf16_t* mo = p.mix() + (size_t)tok * D + 768 + h * 64 + 4 * hh;
#pragma unroll
    for (int g = 0; g < 4; ++g) {
        uint2 pk;
        pk.x = pack2(o0[4 * g] * inv, o0[4 * g + 1] * inv); pk.y = pack2(o0[4 * g + 2] * inv, o0[4 * g + 3] * inv);
        *(uint2*)(mo + 8 * g) = pk;
        pk.x = pack2(o1[4 * g] * inv, o1[4 * g + 1] * inv); pk.y = pack2(o1[4 * g + 2] * inv, o1[4 * g + 3] * inv);
        *(uint2*)(mo + 32 + 8 * g) = pk;
    }
}

struct NaCtx {
    const bf16_t* kbase; const bf16_t* vbase; const float* bh;
    int rs, r, c, c0, cb, hh;
    bf16x8 qf[4];
    float m, sum;
    f32x16 o0, o1;
};
template <int TI>
__device__ __forceinline__ void na_load(const NaCtx& x, bf16x8 (&kf)[4], bf16x8 (&vf)[4]) {
    constexpr int ip = TI / 3, cg = TI % 3;
    const bf16_t* kp = x.kbase + (size_t)(ip * 128 + cg * 16) * INW;
#pragma unroll
    for (int ks = 0; ks < 4; ++ks) kf[ks] = *(const bf16x8*)(kp + ks * 16);
    const bf16_t* vr = x.vbase + ip * 128 + cg * 16;
#pragma unroll
    for (int st = 0; st < 2; ++st) { vf[2 * st] = *(const bf16x8*)(vr + st * 64); vf[2 * st + 1] = *(const bf16x8*)(vr + (size_t)32 * T + st * 64); }
}
template <int TI>
__device__ __forceinline__ void na_comp(NaCtx& x, const bf16x8 (&kf)[4], const bf16x8 (&vf)[4]) {
    constexpr int ip = TI / 3, cg = TI % 3;
    f32x16 s;
#pragma unroll
    for (int q = 0; q < 16; ++q) s[q] = 0.f;
#pragma unroll
    for (int ks = 0; ks < 4; ++ks) s = __builtin_amdgcn_mfma_f32_32x32x16_bf16(kf[ks], x.qf[ks], s, 0, 0, 0);
    const int kc0 = x.cb + 16 * cg + 8 * x.hh;
    const float* brow = x.bh + (x.rs + 2 * ip - x.r + 7) * 31 + 15 - x.c + kc0;
    const int d0 = kc0 - x.c0;
    float tm = -1e30f;
    float bv[16];
#pragma unroll
    for (int q = 0; q < 16; ++q) bv[q] = brow[(q & 3) + 4 * ((q >> 2) & 1) + 31 * (q >> 3)];
#pragma unroll
    for (int q = 0; q < 16; ++q) asm volatile("" : "+v"(bv[q]));
#pragma unroll
    for (int q = 0; q < 16; ++q) {
        const int cq = (q & 3) + 4 * ((q >> 2) & 1);
        const bool valid = (unsigned)(d0 + cq) < 16u;
        const float sc = valid ? fmaf(s[q], 0.18033688011112042f, bv[q]) : -INFINITY;
        s[q] = sc;
        tm = fmaxf(tm, sc);
    }
    tm = fmaxf(tm, __shfl_xor(tm, 32));
    const float mn = fmaxf(x.m, tm);
    if (__any(mn > x.m)) {
        const float scl = __builtin_amdgcn_exp2f(x.m - mn);
        x.sum *= scl;
#pragma unroll
        for (int q = 0; q < 16; ++q) { x.o0[q] *= scl; x.o1[q] *= scl; }
    }
    x.m = mn;
#pragma unroll
    for (int q = 0; q < 16; ++q) { const float pe = __builtin_amdgcn_exp2f(s[q] - mn); s[q] = pe; x.sum += pe; }
#pragma unroll
    for (int st = 0; st < 2; ++st) {
        const bf16x8 pb = pack8(s, st * 8);
        x.o0 = __builtin_amdgcn_mfma_f32_32x32x16_bf16(vf[2 * st], pb, x.o0, 0, 0, 0);
        x.o1 = __builtin_amdgcn_mfma_f32_32x32x16_bf16(vf[2 * st + 1], pb, x.o1, 0, 0, 0);
    }
}

__device__ __forceinline__ void na_attn_wave(const Params& p, int wu, int lane, const float* sbias) {
    const int j = wu & 1, h = (wu >> 1) & 7, r = (wu >> 4) & 127, b = wu >> 11;
    const int l31 = lane & 31, hh = lane >> 5;
    NaCtx x;
    x.hh = hh; x.r = r;
    x.c = 32 * j + l31;
    x.c0 = min(max(x.c - 8, 0), 48); x.rs = min(max(r - 4, 0), 120);
    const int tokq = b * T + r * 64 + x.c;
    x.cb = 16 * j;
#pragma unroll
    for (int ks = 0; ks < 4; ++ks) x.qf[ks] = *(const bf16x8*)(p.z() + (size_t)tokq * INW + h * 64 + ks * 16 + hh * 8);
    x.bh = sbias + 64 + h * 465;
    const int kap = swap23(l31);
    x.kbase = p.z() + (size_t)(b * T + (x.rs + (kap >> 4)) * 64 + x.cb + (kap & 15)) * INW + 512 + h * 64 + hh * 8;
    x.vbase = p.vT() + ((size_t)(b * 8 + h) * 64 + l31) * T + x.rs * 64 + x.cb + 8 * hh;
    x.m = -1e30f; x.sum = 0.f;
#pragma unroll
    for (int q = 0; q < 16; ++q) { x.o0[q] = 0.f; x.o1[q] = 0.f; }
    bf16x8 k0[4], v0[4], k1[4], v1[4], k2[4], v2[4], k3[4], v3[4];
    na_load<0>(x, k0, v0); na_load<1>(x, k1, v1); na_load<2>(x, k2, v2);
    na_load<3>(x, k3, v3);  na_comp<0>(x, k0, v0);
    na_load<4>(x, k0, v0);  na_comp<1>(x, k1, v1);
    na_load<5>(x, k1, v1);  na_comp<2>(x, k2, v2);
    na_load<6>(x, k2, v2);  na_comp<3>(x, k3, v3);
    na_load<7>(x, k3, v3);  na_comp<4>(x, k0, v0);
    na_load<8>(x, k0, v0);  na_comp<5>(x, k1, v1);
    na_load<9>(x, k1, v1);  na_comp<6>(x, k2, v2);
    na_load<10>(x, k2, v2); na_comp<7>(x, k3, v3);
    na_load<11>(x, k3, v3); na_comp<8>(x, k0, v0);
    na_comp<9>(x, k1, v1);
    na_comp<10>(x, k2, v2);
    na_comp<11>(x, k3, v3);
    float sum = x.sum;
    sum += __shfl_xor(sum, 32);
    const float inv = 1.0f / sum;
    bf16_t* mo = p.mix() + (size_t)tokq * D + h * 64 + 4 * hh;
#pragma unroll
    for (int g = 0; g < 4; ++g) {
        uint2 pk;
        pk.x = pack2(x.o0[4 * g] * inv, x.o0[4 * g + 1] * inv); pk.y = pack2(x.o0[4 * g + 2] * inv, x.o0[4 * g + 3] * inv);
        *(uint2*)(mo + 8 * g) = pk;
        pk.x = pack2(x.o1[4 * g] * inv, x.o1[4 * g + 1] * inv); pk.y = pack2(x.o1[4 * g + 2] * inv, x.o1[4 * g + 3] * inv);
        *(uint2*)(mo + 32 + 8 * g) = pk;
    }
}

__device__ void phase_mixers(const Params& p, char* smem) {
    const int tid = VTID, lane = tid & 63, w = tid >> 6;
    {
        float* sbias = (float*)smem;
        __syncthreads();
        for (int i = tid; i < 8 * 465; i += 256) sbias[64 + i] = p.rpb[i] * 1.4426950408889634f;
        __syncthreads();
        for (int wu = VBID * 4 + w; wu < 8192; wu += VGRID * 4) na_attn_wave(p, wu, lane, sbias);
    }
    __syncthreads();
    hg_local(p, smem);
}

__device__ void phase_hg_scan(const Params& p) {
    const int tid = VTID;
    const int skip = gridDim.x >= 64 ? 32 : 0;
    if (VBID < skip) return;
    for (int item = VBID - skip; item < 512; item += VGRID - skip) {
        const int g = item * 256 + tid;
        const int seq = g >> 12, kv = g & 4095, k = kv & 63;
        const int dir = seq & 1;
        float S = 0.f;
        for (int cc0 = 0; cc0 < 128; cc0 += 8) {
            float L[8], d[8];
#pragma unroll
            for (int u = 0; u < 8; ++u) {
                const int c = dir ? 127 - (cc0 + u) : cc0 + u;
                const size_t it = (size_t)seq * 128 + c;
                L[u] = bf2f(((const bf16_t*)p.hstate())[it * 4096 + kv]);
                d[u] = p.hdec()[it * 64 + k];
            }
#pragma unroll
            for (int u = 0; u < 8; ++u) {
                const int c = dir ? 127 - (cc0 + u) : cc0 + u;
                const size_t it = (size_t)seq * 128 + c;
                ((bf16_t*)p.h())[it * 4096 + kv] = f2bf(S);
                S = d[u] * S + L[u];
            }
        }
    }
}

__device__ void phase_hg_out(const Params& p, char* smem) {
    char* sQt = smem;
    char* sKt = smem + 9216;
    char* sQh = smem + 18432;
    char* sVT = smem + 27648;
    char* sST = smem + 36864;
    char* sP = smem + 46080;
    float* sTot = (float*)(smem + 55296);
    float* sSS = sTot + 256;
    const int tid = VTID, lane = tid & 63, w = tid >> 6;
    const int kcol = tid & 63, sq = tid >> 6;
    const int l31 = lane & 31, hh = lane >> 5;
    for (int item = VBID; item < 2048; item += VGRID) {
        const int c = item & 127, h = (item >> 7) & 3, b = item >> 9;
        const int tok0 = b * T + c * 64;
        __syncthreads();
        hg_load_vt(p, sVT, tok0, h, kcol, sq);
        float qv[16];
        {
            const bf16_t* zp = p.z() + (size_t)(tok0 + sq * 16) * INW + 1536 + h * 64 + kcol;
#pragma unroll
            for (int j = 0; j < 16; ++j) qv[j] = bf2f(zp[(size_t)j * INW]);
        }
        f32x16 accO;
#pragma unroll
        for (int r = 0; r < 16; ++r) accO[r] = 0.f;
        for (int dir = 0; dir < 2; ++dir) {
            float bj[16], kk[16];
            const float btot = hg_gates(p, sTot, tok0, h, dir, kcol, sq, bj, kk);
            const float bref = 0.5f * btot;
#pragma unroll
            for (int j = 0; j < 16; ++j) {
                const int s = sq * 16 + j;
                *(bf16_t*)(sQt + s * HRS + kcol * 2) = f2bf(qv[j] * __expf(bj[j] - bref));
                *(bf16_t*)(sKt + s * HRS + kcol * 2) = f2bf(kk[j] * __expf(bref - bj[j]));
                *(bf16_t*)(sQh + s * HRS + kcol * 2) = f2bf(qv[j] * __expf(bj[j]));
            }
            {
                const bf16_t* sp = (const bf16_t*)p.h() + ((size_t)(((b * 4 + h) * 2 + dir) * 128 + c)) * 4096;
#pragma unroll
                for (int i = 0; i < 4; ++i) {
                    const int idx = tid * 4 + 1024 * i;
                    *(uint2*)(sST + (idx >> 6) * HRS + (idx & 63) * 2) = *(const uint2*)(sp + idx);
                }
            }
            __syncthreads();
            {
                const int si = w >> 1, ti = w & 1;
                const bool live = dir == 0 ? (si <= ti) : (si >= ti);
                f32x16 pt;
#pragma unroll
                for (int r = 0; r < 16; ++r) pt[r] = 0.f;
                if (live) pt = tile_mm64(sKt, sQt, si * 32, ti * 32, lane, pt);
                const int t = ti * 32 + l31;
#pragma unroll
                for (int g = 0; g < 4; ++g) {
                    const int s0 = si * 32 + 8 * g + 4 * hh;
                    float v0 = pt[4 * g], v1 = pt[4 * g + 1], v2 = pt[4 * g + 2], v3 = pt[4 * g + 3];
                    if (dir == 0) {
                        if (s0 > t) v0 = 0.f; if (s0 + 1 > t) v1 = 0.f; if (s0 + 2 > t) v2 = 0.f; if (s0 + 3 > t) v3 = 0.f;
                    } else {
                        if (s0 < t) v0 = 0.f; if (s0 + 1 < t) v1 = 0.f; if (s0 + 2 < t) v2 = 0.f; if (s0 + 3 < t) v3 = 0.f;
                    }
                    uint2 pk; pk.x = pack2(v0, v1); pk.y = pack2(v2, v3);
                    *(uint2*)(sP + t * HRS + s0 * 2) = pk;
                }
            }
            __syncthreads();
            {
                const int vi = w >> 1, ti = w & 1;
                accO = tile_mm64(sVT, sP, vi * 32, ti * 32, lane, accO);
                accO = tile_mm64(sST, sQh, vi * 32, ti * 32, lane, accO);
            }
            __syncthreads();
        }
        const int vi = w >> 1, ti = w & 1;
        float ssq = 0.f;
#pragma unroll
        for (int r = 0; r < 16; ++r) ssq += accO[r] * accO[r];
        ssq += __shfl_xor(ssq, 32);
        sSS[w * 64 + lane] = ssq;
        __syncthreads();
        const float tot = sSS[ti * 64 + l31] + sSS[(2 + ti) * 64 + l31];
        const float rs = rsqrtf(tot * (1.0f / 64.0f) + EPS);
        const int tok = tok0 + ti * 32 + l31;
#pragma unroll
        for (int g = 0; g < 4; ++g) {
            const int v0 = vi * 32 + 8 * g + 4 * hh;
            const uint2 gz = *(const uint2*)(p.z() + (size_t)tok * INW + 2560 + h * 64 + v0);
            const float4 gn = *(const float4*)(p.hg_g + h * 64 + v0);
            const float g0 = bflo(gz.x), g1 = bfhi(gz.x), g2 = bflo(gz.y), g3 = bfhi(gz.y);
            const float o0 = accO[4 * g] * rs * gn.x * (g0 / (1.0f + __expf(-g0)));
            const float o1 = accO[4 * g + 1] * rs * gn.y * (g1 / (1.0f + __expf(-g1)));
            const float o2 = accO[4 * g + 2] * rs * gn.z * (g2 / (1.0f + __expf(-g2)));
            const float o3 = accO[4 * g + 3] * rs * gn.w * (g3 / (1.0f + __expf(-g3)));
            uint2 pk; pk.x = pack2(o0, o1); pk.y = pack2(o2, o3);
            *(uint2*)(p.mix() + (size_t)tok * D + 512 + h * 64 + v0) = pk;
        }
    }
    for (int wu = VBID * 4 + w; wu < 4096; wu += VGRID * 4) mem_attn_wave(p, wu, lane);
}


__device__ __forceinline__ int ord_key(int fb) { return fb ^ ((fb >> 31) & 0x7FFFFFFF); }

template <int N>
__device__ __forceinline__ void bitonic_sort_desc(int (&v)[N]) {
#pragma unroll
    for (int k = 2; k <= N; k <<= 1) {
#pragma unroll
        for (int j = k >> 1; j > 0; j >>= 1) {
#pragma unroll
            for (int i = 0; i < N; ++i) {
                const int l = i ^ j;
                if (l > i) {
                    const bool desc = ((i & k) == 0);
                    const int a = v[i], b = v[l];
                    const int mx = max(a, b), mn = min(a, b);
                    v[i] = desc ? mx : mn;
                    v[l] = desc ? mn : mx;
                }
            }
        }
    }
}
template <int N>
__device__ __forceinline__ void bitonic_merge_desc(int (&v)[N]) {
#pragma unroll
    for (int j = N >> 1; j > 0; j >>= 1) {
#pragma unroll
        for (int i = 0; i < N; ++i) {
            const int l = i ^ j;
            if (l > i) {
                const int a = v[i], b = v[l];
                v[i] = max(a, b);
                v[l] = min(a, b);
            }
        }
    }
}
__device__ __forceinline__ void merge_prune16(int (&r)[16], const int (&o)[16]) {
#pragma unroll
    for (int i = 0; i < 16; ++i) r[i] = max(r[i], o[15 - i]);
    bitonic_merge_desc<16>(r);
}

constexpr int QRS = 528;
struct EpiQpLds {
    char* qt; const float* ssrow; const unsigned* hmax; const float* sb; int brow, bcol;
    __device__ __forceinline__ void operator()(int row, int col, const f32x4& v) const {
        const float rs = rsqrtf(ssrow[row] * (1.0f / 1024.0f) + EPS) * __uint_as_float(hmax[row]) * (1.0f / 127.0f);
        const float4 b = *(const float4*)(sb + col);
        uint2 pk; pk.x = pack2(v[0] * rs * b.x, v[1] * rs * b.y); pk.y = pack2(v[2] * rs * b.z, v[3] * rs * b.w);
        *(uint2*)(qt + (row - brow) * QRS + (col - bcol) * 2) = pk;
    }
};
__device__ __forceinline__ int* route_slot(char* wrows, int e) { return (int*)(wrows + (e >> 6) * QRS + (e & 63) * 4); }

__device__ __forceinline__ void route_tile(const Params& p, char* qt, int tok0, int h) {
    const int tid = threadIdx.x, lane = tid & 63, w = tid >> 6;
    const int tl = lane & 31, hh = lane >> 5;
    char* wrows = qt + (w * 32) * QRS;
    const int tok = tok0 + w * 32 + tl;
    const bf16_t* sp = p.subk_b() + (size_t)(h * 2) * 16384 + tl * 128 + hh * 8;
    bf16x8 an[8];
#pragma unroll
    for (int ks = 0; ks < 8; ++ks) an[ks] = *(const bf16x8*)(sp + ks * 16);
#pragma unroll
    for (int c = 0; c < 2; ++c) {
        bf16x8 qf[8];
#pragma unroll
        for (int ks = 0; ks < 8; ++ks) qf[ks] = *(const bf16x8*)(wrows + tl * QRS + (c * 128 + ks * 16 + hh * 8) * 2);
        int cur[16];
#pragma unroll
        for (int kb = 0; kb < 4; ++kb) {
            bf16x8 af[8];
#pragma unroll
            for (int ks = 0; ks < 8; ++ks) af[ks] = an[ks];
            if (c * 4 + kb + 1 < 8) {
                const bf16_t* sn = sp + (c * 4 + kb + 1) * 4096;
#pragma unroll
                for (int ks = 0; ks < 8; ++ks) an[ks] = *(const bf16x8*)(sn + ks * 16);
            }
            f32x16 acc;
#pragma unroll
            for (int r = 0; r < 16; ++r) acc[r] = 0.f;
#pragma unroll
            for (int ks = 0; ks < 8; ++ks) acc = __builtin_amdgcn_mfma_f32_32x32x16_bf16(af[ks], qf[ks], acc, 0, 0, 0);
            int v[16];
#pragma unroll
            for (int r = 0; r < 16; ++r) {
                const int key = kb * 32 + (r & 3) + 8 * (r >> 2) + 4 * hh;
                const int fb = (__float_as_int(acc[r]) & ~127) | (127 - key);
                v[r] = ord_key(fb);
            }
            bitonic_sort_desc<16>(v);
            if (kb == 0) {
#pragma unroll
                for (int r = 0; r < 16; ++r) cur[r] = v[r];
            } else {
                merge_prune16(cur, v);
            }
            __builtin_amdgcn_sched_barrier(0);
        }
        {
            int o[16];
#pragma unroll
            for (int r = 0; r < 16; ++r) o[r] = __shfl_xor(cur[r], 32);
            merge_prune16(cur, o);
        }
#pragma unroll
        for (int r = 0; r < 16; ++r) *route_slot(wrows, c * 512 + r * 32 + tl) = cur[r];
        __builtin_amdgcn_sched_barrier(0);
    }
    float va[16], vb[16];
#pragma unroll
    for (int r = 0; r < 16; ++r) {
        const int fa = ord_key(*route_slot(wrows, r * 32 + tl)), fb = ord_key(*route_slot(wrows, 512 + r * 32 + tl));
        va[r] = __int_as_float(fa & ~127);
        vb[r] = __int_as_float(fb & ~127);
    }
    int best[16];
#pragma unroll
    for (int j = 0; j < 16; ++j) best[j] = ord_key((__float_as_int(va[0] + vb[j]) & ~255) | (255 - j));
#pragma unroll
    for (int i = 1; i < 8; ++i) {
        const int n = 16 / (i + 1);
        int row[16];
#pragma unroll
        for (int j = 0; j < 16; ++j)
            row[j] = (j < n) ? ord_key((__float_as_int(va[i] + vb[j]) & ~255) | (255 - (i * 16 + j))) : (int)0x80000000;
        merge_prune16(best, row);
    }
    {
        int row[16];
#pragma unroll
        for (int j = 0; j < 16; ++j)
            row[j] = (j < 8) ? ord_key((__float_as_int(va[8 + j] + vb[0]) & ~255) | (255 - ((8 + j) * 16))) : (int)0x80000000;
        merge_prune16(best, row);
    }
    float sv[16];
    int pid[16];
#pragma unroll
    for (int r = 0; r < 16; ++r) {
        const int cb = ord_key(best[r]);
        sv[r] = __int_as_float(cb & ~255);
        pid[r] = 255 - (cb & 255);
    }
    float tot = 0.f;
    const float smax = sv[0];
#pragma unroll
    for (int r = 0; r < 16; ++r) { sv[r] = __expf(sv[r] - smax); tot += sv[r]; }
    const float inv = 1.0f / tot;
    if (hh == 0) {
#pragma unroll
        for (int r = 0; r < 16; ++r) {
            const int ia = 127 - (ord_key(*route_slot(wrows, (pid[r] >> 4) * 32 + tl)) & 127);
            const int ib = 127 - (ord_key(*route_slot(wrows, 512 + (pid[r] & 15) * 32 + tl)) & 127);
            const int pos = (r & 7) * 16 + h * 2 + (r >> 3);
            p.eidx()[(size_t)tok * 128 + pos] = (unsigned short)(ia * 128 + ib);
            p.gate()[(size_t)tok * 128 + pos] = sv[r] * inv;
        }
    }
}

__device__ void phase_gemm_q_route(const Params& p, char* smem) {
    const int nM = NTOK / 256, nN = QW / 256;
    for (int i = 0; i * (int)gridDim.x + (int)blockIdx.x < nM * nN; ++i) {
        int pm, pn;
        g8::tile_of(i * gridDim.x + blockIdx.x, nM, nN, pm, pn);
        EpiQpLds e{smem, p.ss1(), p.hmax(), p.sb() + INW, pm * 256, pn * 256};
        gemm256_tile<false, false, true>(p.h2q(), p.w_q_q(), D, pm * 256, pn * 256, smem, e);
        __syncthreads();
        route_tile(p, smem, pm * 256, pn);
    }
}

__device__ void phase_route(const Params& p, char* smem) {
    char* sk = smem;
    const int tid = VTID, lane = tid & 63, w = tid >> 6;
    int* sA = (int*)(smem + 32768) + w * 2048;
    int* sB = (int*)(smem + 65536) + w * 512;
    const int tl = lane & 31, hh = lane >> 5;
    const int h = VBID & 7, tg0 = VBID >> 3, tgs = VGRID >> 3;
    for (int base = tg0; base < 256; base += 4 * tgs)
    for (int c = 0; c < 2; ++c) {
        const int hc = h * 2 + c;
        __syncthreads();
        {
            const bf16_t* sp = p.subk_b() + (size_t)hc * 16384;
#pragma unroll
            for (int i = 0; i < 8; ++i) {
                const int ch = tid + 256 * i;
                const int row = ch >> 4, cc = ch & 15;
                const uint4 v = *(const uint4*)(sp + row * 128 + cc * 8);
                *(uint4*)(sk + row * 256 + ((cc ^ (row & 15)) << 4)) = v;
            }
        }
        __syncthreads();
        bf16x8 qf[8];
        if (base < 256) {
            const bf16_t* qr = p.z() + (size_t)(base * 128 + w * 32 + tl) * QW + hc * 128 + hh * 8;
#pragma unroll
            for (int ks = 0; ks < 8; ++ks) qf[ks] = *(const bf16x8*)(qr + ks * 16);
        }
        for (int it = 0; it < 4; ++it) {
            const int tgp = base + it * tgs;
            if (tgp >= 256) break;
            const int tok = tgp * 128 + w * 32 + tl;
            int* sidx = sA + it * 512;
            f32x16 acc4[4];
#pragma unroll
            for (int kb = 0; kb < 4; ++kb) {
#pragma unroll
                for (int r = 0; r < 16; ++r) acc4[kb][r] = 0.f;
                const int row = kb * 32 + tl;
#pragma unroll
                for (int ks = 0; ks < 8; ++ks) {
                    const bf16x8 af = *(const bf16x8*)(sk + row * 256 + (((ks * 2 + hh) ^ (row & 15)) << 4));
                    acc4[kb] = __builtin_amdgcn_mfma_f32_32x32x16_bf16(af, qf[ks], acc4[kb], 0, 0, 0);
                }
            }
            if (it + 1 < 4 && tgp + tgs < 256) {
                const bf16_t* qr = p.z() + (size_t)((tgp + tgs) * 128 + w * 32 + tl) * QW + hc * 128 + hh * 8;
#pragma unroll
                for (int ks = 0; ks < 8; ++ks) qf[ks] = *(const bf16x8*)(qr + ks * 16);
            }
            int cur[16];
#pragma unroll
            for (int kb = 0; kb < 4; ++kb) {
                int v[16];
#pragma unroll
                for (int r = 0; r < 16; ++r) {
                    const int key = kb * 32 + (r & 3) + 8 * (r >> 2) + 4 * hh;
                    const int fb = (__float_as_int(acc4[kb][r]) & ~127) | (127 - key);
                    v[r] = ord_key(fb);
                }
                bitonic_sort_desc<16>(v);
                if (kb == 0) {
#pragma unroll
                    for (int r = 0; r < 16; ++r) cur[r] = v[r];
                } else {
                    merge_prune16(cur, v);
                }
            }
            {
                int o[16];
#pragma unroll
                for (int r = 0; r < 16; ++r) o[r] = __shfl_xor(cur[r], 32);
                merge_prune16(cur, o);
            }
            if (c == 0) {
#pragma unroll
                for (int r = 0; r < 16; ++r) sidx[r * 32 + tl] = cur[r];
                continue;
            }
#pragma unroll
            for (int r = 0; r < 16; ++r) sB[r * 32 + tl] = cur[r];
        float va[16], vb[16];
#pragma unroll
        for (int r = 0; r < 16; ++r) {
            const int fa = ord_key(sidx[r * 32 + tl]), fb = ord_key(sB[r * 32 + tl]);
            va[r] = __int_as_float(fa & ~127);
            vb[r] = __int_as_float(fb & ~127);
        }
        int best[16];
#pragma unroll
        for (int j = 0; j < 16; ++j) best[j] = ord_key((__float_as_int(va[0] + vb[j]) & ~255) | (255 - j));
#pragma unroll
        for (int i = 1; i < 8; ++i) {
            const int n = 16 / (i + 1);
            int row[16];
#pragma unroll
            for (int j = 0; j < 16; ++j)
                row[j] = (j < n) ? ord_key((__float_as_int(va[i] + vb[j]) & ~255) | (255 - (i * 16 + j))) : (int)0x80000000;
            merge_prune16(best, row);
        }
        {
            int row[16];
#pragma unroll
            for (int j = 0; j < 16; ++j)
                row[j] = (j < 8) ? ord_key((__float_as_int(va[8 + j] + vb[0]) & ~255) | (255 - ((8 + j) * 16))) : (int)0x80000000;
            merge_prune16(best, row);
        }
        float sv[16];
        int pid[16];
#pragma unroll
        for (int r = 0; r < 16; ++r) {
            const int cb = ord_key(best[r]);
            sv[r] = __int_as_float(cb & ~255);
            pid[r] = 255 - (cb & 255);
        }
        float tot = 0.f;
        const float smax = sv[0];
#pragma unroll
        for (int r = 0; r < 16; ++r) { sv[r] = __expf(sv[r] - smax); tot += sv[r]; }
        const float inv = 1.0f / tot;
        if (hh == 0) {
#pragma unroll
            for (int r = 0; r < 16; ++r) {
                const int ia = 127 - (ord_key(sidx[(pid[r] >> 4) * 32 + tl]) & 127);
                const int ib = 127 - (ord_key(sB[(pid[r] & 15) * 32 + tl]) & 127);
                const int pos = (r & 7) * 16 + h * 2 + (r >> 3);
                p.eidx()[(size_t)tok * 128 + pos] = (unsigned short)(ia * 128 + ib);
                p.gate()[(size_t)tok * 128 + pos] = sv[r] * inv;
            }
        }
        }
    }
}

constexpr int PEER_TG = 512;
constexpr int PEER_TPW = PEER_TG / 8;
constexpr int PEER_NTG = NTOK / PEER_TG;
constexpr int PEER_NCH = 8;

#define PEER_G1(base, wv, hi) (*(const uint4*)((base) + (unsigned)((((hi) ? ((wv) >> 16) : ((wv) & 0xFFFFu)) << 7) + dlo)))
#define PEER_GATHER16(dst, base, ia, ib)                                                             \
    dst[0] = PEER_G1(base, (ia).x, 0);  dst[1] = PEER_G1(base, (ia).x, 1);  dst[2] = PEER_G1(base, (ia).y, 0);  dst[3] = PEER_G1(base, (ia).y, 1);   \
    dst[4] = PEER_G1(base, (ia).z, 0);  dst[5] = PEER_G1(base, (ia).z, 1);  dst[6] = PEER_G1(base, (ia).w, 0);  dst[7] = PEER_G1(base, (ia).w, 1);   \
    dst[8] = PEER_G1(base, (ib).x, 0);  dst[9] = PEER_G1(base, (ib).x, 1);  dst[10] = PEER_G1(base, (ib).y, 0); dst[11] = PEER_G1(base, (ib).y, 1);  \
    dst[12] = PEER_G1(base, (ib).z, 0); dst[13] = PEER_G1(base, (ib).z, 1); dst[14] = PEER_G1(base, (ib).w, 0); dst[15] = PEER_G1(base, (ib).w, 1);

__device__ __forceinline__ unsigned quant4(float a, float b, float c, float d, float qs) {
    const int q0 = (int)rintf(__builtin_amdgcn_fmed3f(a * qs, -127.f, 127.f)), q1 = (int)rintf(__builtin_amdgcn_fmed3f(b * qs, -127.f, 127.f));
    const int q2 = (int)rintf(__builtin_amdgcn_fmed3f(c * qs, -127.f, 127.f)), q3 = (int)rintf(__builtin_amdgcn_fmed3f(d * qs, -127.f, 127.f));
    return (unsigned)(q0 & 255) | ((unsigned)(q1 & 255) << 8) | ((unsigned)(q2 & 255) << 16) | ((unsigned)(q3 & 255) << 24);
}
__device__ void phase_quant_h2(const Params& p) {
    const int tid = VTID, lane = tid & 63, w = tid >> 6;
    for (int r0 = VBID * 4; r0 < NTOK; r0 += VGRID * 4) {
        const int r = r0 + w;
        const uint4* xp = (const uint4*)(p.x1b() + (size_t)r * D + lane * 16);
        const uint4 xa = xp[0], xb = xp[1];
        const float4* gp = (const float4*)(p.ffn_g + lane * 16);
        const float4 g0 = gp[0], g1 = gp[1], g2 = gp[2], g3 = gp[3];
        const float hm = __uint_as_float(p.hmax()[r]);
        const float qs = hm > 0.f ? 127.0f / hm : 0.f;
        uint4 o;
        o.x = quant4(bflo(xa.x) * g0.x, bfhi(xa.x) * g0.y, bflo(xa.y) * g0.z, bfhi(xa.y) * g0.w, qs);
        o.y = quant4(bflo(xa.z) * g1.x, bfhi(xa.z) * g1.y, bflo(xa.w) * g1.z, bfhi(xa.w) * g1.w, qs);
        o.z = quant4(bflo(xb.x) * g2.x, bfhi(xb.x) * g2.y, bflo(xb.y) * g2.z, bfhi(xb.y) * g2.w, qs);
        o.w = quant4(bflo(xb.z) * g3.x, bfhi(xb.z) * g3.y, bflo(xb.w) * g3.z, bfhi(xb.w) * g3.w, qs);
        *(uint4*)(p.h2q() + (size_t)r * D + lane * 16) = o;
    }
}

template <int CTRL>
__device__ __forceinline__ int dpp_movi(int v) { return __builtin_amdgcn_update_dpp(0, v, CTRL, 0xf, 0xf, true); }

struct DotTok { uint4 ia, ib; uint4 ha; };
__device__ __forceinline__ void dots_load(const Params& p, DotTok& t, int tok, int c, int g, int d8) {
    const uint4* idp = (const uint4*)(p.eidx() + (size_t)tok * 128 + g * 16);
    t.ia = idp[0]; t.ib = idp[1];
    t.ha = *(const uint4*)(p.h2q() + (size_t)tok * D + c * 128 + d8 * 16);
}
__device__ __forceinline__ void dotsf_load(const Params& p, DotTok& t, int tokb, int s, int g, int d8) {
    dots_load(p, t, tokb + 8 * (s & 15), s >> 4, g, d8);
}
__device__ __forceinline__ void dotsf_finish(const uint4 (&uu)[16], const DotTok& t, int* part, int g, int d8) {
    const int h0 = (int)t.ha.x, h1 = (int)t.ha.y, h2 = (int)t.ha.z, h3 = (int)t.ha.w;
    int acc[16];
#pragma unroll
    for (int i = 0; i < 16; ++i) {
        int a = __builtin_amdgcn_sdot4((int)uu[i].x, h0, 0, false);
        a = __builtin_amdgcn_sdot4((int)uu[i].y, h1, a, false);
        a = __builtin_amdgcn_sdot4((int)uu[i].z, h2, a, false);
        a = __builtin_amdgcn_sdot4((int)uu[i].w, h3, a, false);
        a += dpp_movi<DPP_QP_X1>(a);
        a += dpp_movi<DPP_QP_X2>(a);
        a += dpp_movi<DPP_HMIRROR>(a);
        acc[i] = a;
    }
    if (d8 == 0) {
#pragma unroll
        for (int i = 0; i < 16; ++i) (void)__hip_atomic_fetch_add(part + g * 16 + i, acc[i], __ATOMIC_RELAXED, __HIP_MEMORY_SCOPE_WORKGROUP);
    }
}

__device__ __forceinline__ float gelu_erf(float v);

__device__ void phase_peer_dots(const Params& p, char* smem) {
    const int tid = threadIdx.x, lane = tid & 63, w = tid >> 6;
    const int g = lane >> 3, d8 = lane & 7;
    int* part = (int*)smem + w * 2048;
    for (int tgp = blockIdx.x; tgp < NTOK / 128; tgp += gridDim.x) {
        const int tokb = tgp * 128 + w;
        __syncthreads();
        for (int i = lane; i < 2048; i += 64) part[i] = 0;
        __syncthreads();
        const char* ubase = (const char*)p.u_c();
        const unsigned dlo = d8 * 16;
        DotTok ta, tb, tn;
        uint4 ua[16], ubuf[16];
        dotsf_load(p, ta, tokb, 0, g, d8);
        dotsf_load(p, tb, tokb, 1, g, d8);
        PEER_GATHER16(ua, ubase, ta.ia, ta.ib)
        PEER_GATHER16(ubuf, ubase, tb.ia, tb.ib)
        dotsf_load(p, tn, tokb, 2, g, d8);
        for (int s = 0; s < 128; s += 2) {
            dotsf_finish(ua, ta, part + (s & 15) * 128, g, d8);
            if (s + 2 < 128) {
                ta = tn;
                const char* ub = ubase + (size_t)((s + 2) >> 4) * 16384 * 128;
                PEER_GATHER16(ua, ub, ta.ia, ta.ib)
                dotsf_load(p, tn, tokb, min(s + 3, 127), g, d8);
            }
            dotsf_finish(ubuf, tb, part + ((s + 1) & 15) * 128, g, d8);
            if (s + 3 < 128) {
                tb = tn;
                const char* ub = ubase + (size_t)((s + 3) >> 4) * 16384 * 128;
                PEER_GATHER16(ubuf, ub, tb.ia, tb.ib)
                dotsf_load(p, tn, tokb, min(s + 4, 127), g, d8);
            }
        }
        __syncthreads();
        for (int k0 = 0; k0 < 16; k0 += 4) {
            int ps[4][2], e[4][2];
            float gt[4][2], sh[4];
#pragma unroll
            for (int q = 0; q < 4; ++q) {
                const int tok = tokb + 8 * (k0 + q);
                sh[q] = __uint_as_float(p.hmax()[tok]) * (1.0f / 127.0f) * rsqrtf(p.ss1()[tok] * (1.0f / 1024.0f) + EPS);
#pragma unroll
                for (int u = 0; u < 2; ++u) {
                    const int slot = lane + 64 * u;
                    ps[q][u] = part[(k0 + q) * 128 + slot];
                    e[q][u] = p.eidx()[(size_t)tok * 128 + slot];
                    gt[q][u] = p.gate()[(size_t)tok * 128 + slot];
                }
            }
            float su[4][2], sv[4][2];
#pragma unroll
            for (int q = 0; q < 4; ++q)
#pragma unroll
                for (int u = 0; u < 2; ++u) { su[q][u] = p.scale_u()[e[q][u]]; sv[q][u] = p.scale_v()[e[q][u]]; }
#pragma unroll
            for (int q = 0; q < 4; ++q) {
                const int tok = tokb + 8 * (k0 + q);
                float cf[2];
#pragma unroll
                for (int u = 0; u < 2; ++u) cf[u] = gelu_erf((float)ps[q][u] * su[q][u] * sh[q]) * gt[q][u] * sv[q][u];
                const float cm = wave_max(fmaxf(fabsf(cf[0]), fabsf(cf[1])));
                const float qs = cm > 0.f ? 127.0f / cm : 0.f;
                p.coef()[(size_t)tok * 128 + lane] = (signed char)(int)rintf(cf[0] * qs);
                p.coef()[(size_t)tok * 128 + lane + 64] = (signed char)(int)rintf(cf[1] * qs);
                if (lane == 0) p.csum()[tok] = cm * (1.0f / 127.0f);
            }
        }
    }
}

__device__ __forceinline__ float gelu_erf(float v) {
    const float av = fabsf(v);
    const float t = __builtin_amdgcn_rcpf(fmaf(av, 0.2316418882f, 1.0f));
    float q = fmaf(t, 0.5307027145f, -0.7265760135f);
    q = fmaf(q, t, 0.7107068705f);
    q = fmaf(q, t, -0.142248368f);
    q = fmaf(q, t, 0.127414796f);
    q = q * t;
    const float e = __builtin_amdgcn_exp2f(v * v * -0.72134752044f);
    const float m = v * (q * e);
    return v < 0.f ? m : v - m;
}
struct AccTok { uint4 ia, ib; uint4 cq; float cs; };
__device__ __forceinline__ void acc_load(const Params& p, AccTok& t, int tok, int g) {
    const uint4* idp = (const uint4*)(p.eidx() + (size_t)tok * 128 + g * 16);
    t.ia = idp[0]; t.ib = idp[1];
    t.cq = *(const uint4*)(p.coef() + (size_t)tok * 128 + g * 16);
    t.cs = p.csum()[tok];
}
#define PEER_T4DOT(acc, B, r0, r1, r2, r3, cq)                                   \
    {                                                                            \
        const unsigned t0 = __builtin_amdgcn_perm(r1, r0, 0x05010400u), t1 = __builtin_amdgcn_perm(r1, r0, 0x07030602u); \
        const unsigned t2 = __builtin_amdgcn_perm(r3, r2, 0x05010400u), t3 = __builtin_amdgcn_perm(r3, r2, 0x07030602u); \
        acc[(B) + 0] = __builtin_amdgcn_sdot4((int)__builtin_amdgcn_perm(t2, t0, 0x05040100u), (int)(cq), acc[(B) + 0], false); \
        acc[(B) + 1] = __builtin_amdgcn_sdot4((int)__builtin_amdgcn_perm(t2, t0, 0x07060302u), (int)(cq), acc[(B) + 1], false); \
        acc[(B) + 2] = __builtin_amdgcn_sdot4((int)__builtin_amdgcn_perm(t3, t1, 0x05040100u), (int)(cq), acc[(B) + 2], false); \
        acc[(B) + 3] = __builtin_amdgcn_sdot4((int)__builtin_amdgcn_perm(t3, t1, 0x07060302u), (int)(cq), acc[(B) + 3], false); \
    }
__device__ __forceinline__ void accf_finish(const uint4 (&vv)[16], const AccTok& t, char* rowp, int g) {
    const unsigned cw[4] = {t.cq.x, t.cq.y, t.cq.z, t.cq.w};
    int acc[16];
#pragma unroll
    for (int j = 0; j < 16; ++j) acc[j] = 0;
#pragma unroll
    for (int j = 0; j < 4; ++j) {
        PEER_T4DOT(acc, 0, vv[4 * j].x, vv[4 * j + 1].x, vv[4 * j + 2].x, vv[4 * j + 3].x, cw[j])
        PEER_T4DOT(acc, 4, vv[4 * j].y, vv[4 * j + 1].y, vv[4 * j + 2].y, vv[4 * j + 3].y, cw[j])
        PEER_T4DOT(acc, 8, vv[4 * j].z, vv[4 * j + 1].z, vv[4 * j + 2].z, vv[4 * j + 3].z, cw[j])
        PEER_T4DOT(acc, 12, vv[4 * j].w, vv[4 * j + 1].w, vv[4 * j + 2].w, vv[4 * j + 3].w, cw[j])
    }
    int t8[8], u4[4];
#pragma unroll
    for (int j = 0; j < 8; ++j) {
        const auto r = __builtin_amdgcn_permlane32_swap((unsigned)acc[j], (unsigned)acc[j + 8], false, false);
        t8[j] = (int)(r[0] + r[1]);
    }
#pragma unroll
    for (int j = 0; j < 4; ++j) {
        const auto r = __builtin_amdgcn_permlane16_swap((unsigned)t8[j], (unsigned)t8[j + 4], false, false);
        u4[j] = (int)(r[0] + r[1]);
    }
    float o[4];
#pragma unroll
    for (int j = 0; j < 4; ++j) {
        int v = u4[j];
        v += dpp_movi<DPP_ROR8>(v);
        o[j] = (float)v * t.cs;
    }
    if ((g & 1) == 0) {
        const int rho = g >> 1;
        uint2 w0; w0.x = pack2(o[0], o[1]); w0.y = pack2(o[2], o[3]);
        *(uint2*)(rowp + (4 * (rho & 1) + 8 * (rho >> 1)) * 2) = w0;
    }
}

__device__ void phase_peer_accum(const Params& p, char* smem) {
    const int tid = threadIdx.x, lane = tid & 63, w = tid >> 6;
    const int g = lane >> 3, d8 = lane & 7;
    char* rowbuf = smem + w * 16384;
    for (int tgp = blockIdx.x; tgp < NTOK / 64; tgp += gridDim.x) {
        const int tokb = tgp * 64 + w;
        __syncthreads();
        const char* vbase = (const char*)p.v_c();
        const unsigned dlo = d8 * 16;
        AccTok ta, tb, tn;
        uint4 va[16], vbuf[16];
        acc_load(p, ta, tokb, g);
        acc_load(p, tb, tokb + 8, g);
        PEER_GATHER16(va, vbase, ta.ia, ta.ib)
        PEER_GATHER16(vbuf, vbase, tb.ia, tb.ib)
        acc_load(p, tn, tokb + 16, g);
        for (int s = 0; s < 64; s += 2) {
            accf_finish(va, ta, rowbuf + (s & 7) * 2048 + (s >> 3) * 256 + d8 * 32, g);
            if (s + 2 < 64) {
                ta = tn;
                const char* vb = vbase + (size_t)((s + 2) >> 3) * 16384 * 128;
                PEER_GATHER16(va, vb, ta.ia, ta.ib)
                acc_load(p, tn, tokb + 8 * (min(s + 3, 63) & 7), g);
            }
            accf_finish(vbuf, tb, rowbuf + ((s + 1) & 7) * 2048 + ((s + 1) >> 3) * 256 + d8 * 32, g);
            if (s + 3 < 64) {
                tb = tn;
                const char* vb = vbase + (size_t)((s + 3) >> 3) * 16384 * 128;
                PEER_GATHER16(vbuf, vb, tb.ia, tb.ib)
                acc_load(p, tn, tokb + 8 * (min(s + 4, 63) & 7), g);
            }
        }
        __syncthreads();
        for (int k0 = 0; k0 < 8; k0 += 2) {
            float4 v[2][4];
#pragma unroll
            for (int q = 0; q < 2; ++q) {
                const bf16_t* xrow = p.x1b() + (size_t)(tokb + 8 * (k0 + q)) * D;
#pragma unroll
                for (int j = 0; j < 4; ++j) {
                    const uint2 xk = *(const uint2*)(xrow + (j * 64 + lane) * 4);
                    v[q][j] = make_float4(bflo(xk.x), bfhi(xk.x), bflo(xk.y), bfhi(xk.y));
                }
            }
#pragma unroll
            for (int q = 0; q < 2; ++q) {
                float* orow = p.out + (size_t)(tokb + 8 * (k0 + q)) * D;
                const char* prow = rowbuf + (k0 + q) * 2048;
                float ss = 0.f;
#pragma unroll
                for (int j = 0; j < 4; ++j) {
                    const uint2 pk = *(const uint2*)(prow + (j * 64 + lane) * 8);
                    v[q][j].x += bflo(pk.x); v[q][j].y += bfhi(pk.x); v[q][j].z += bflo(pk.y); v[q][j].w += bfhi(pk.y);
                    ss += v[q][j].x * v[q][j].x + v[q][j].y * v[q][j].y + v[q][j].z * v[q][j].z + v[q][j].w * v[q][j].w;
                }
                ss = wave_sum(ss);
                const float rs = rsqrtf(ss * (1.0f / 1024.0f) + EPS);
#pragma unroll
                for (int j = 0; j < 4; ++j) {
                    const float4 gg = *(const float4*)(p.fin_g + (j * 64 + lane) * 4);
                    float4 o;
                    o.x = v[q][j].x * rs * gg.x; o.y = v[q][j].y * rs * gg.y; o.z = v[q][j].z * rs * gg.z; o.w = v[q][j].w * rs * gg.w;
                    *(float4*)(orow + (j * 64 + lane) * 4) = o;
                }
            }
        }
    }
}

#define XB_TMO      128
#define XB_XCNT(j)  (256  + 64 * (j))
#define XB_XSUB(j)  (1280 + 64 * (j))
#define XB_XGEN(j)  (2304 + 64 * (j))
#define XB_TOP      3328
#define XB_TOPGEN   3392
#define XCD_BAR_WORDS 3456
#define XB_SPIN_CAP (1u << 18)
__device__ __forceinline__ unsigned xb_ld(unsigned* p)              { return __hip_atomic_load(p, __ATOMIC_RELAXED, __HIP_MEMORY_SCOPE_AGENT); }
__device__ __forceinline__ unsigned xb_add(unsigned* p, unsigned v) { return __hip_atomic_fetch_add(p, v, __ATOMIC_RELAXED, __HIP_MEMORY_SCOPE_AGENT); }
#define XB_SPIN(cond, bar) do { unsigned _sp = 0; while (cond) { __builtin_amdgcn_s_sleep(1); \
    if ((++_sp & 255u) == 0u) { if (xb_ld(&(bar)[XB_TMO])) break; if (_sp > XB_SPIN_CAP) { atomicAdd(&(bar)[XB_TMO], 1u); break; } } } } while (0)

struct XcdBarrier { unsigned* bar; unsigned x; volatile unsigned* st; };

__device__ __forceinline__ XcdBarrier xcd_barrier_post(unsigned* bar, volatile unsigned* st) {
    XcdBarrier b; b.bar = bar; b.x = xcc_id(); b.st = st;
    if (threadIdx.x == 0) (void)xb_add(&bar[XB_XCNT(b.x)], 1u);
    return b;
}
__device__ __forceinline__ void xcd_barrier_complete(unsigned* bar, unsigned x, unsigned& nloc, unsigned& nx) {
    const unsigned G = gridDim.x * gridDim.y * gridDim.z;
    unsigned sum, cnt, mine, sp = 0u;
    for (;;) {
        sum = 0u; cnt = 0u; mine = 0u;
#pragma unroll
        for (unsigned j = 0; j < 16; ++j) { const unsigned c = xb_ld(&bar[XB_XCNT(j)]); sum += c; cnt += (c > 0u) ? 1u : 0u; mine = (j == x) ? c : mine; }
        if (sum == G) break;
        __builtin_amdgcn_s_sleep(1);
        if ((++sp & 255u) == 0u) { if (xb_ld(&bar[XB_TMO])) break; if (sp > XB_SPIN_CAP) { atomicAdd(&bar[XB_TMO], 1u); break; } }
    }
    nloc = mine > 0u ? mine : 1u; nx = cnt > 0u ? cnt : 1u;
}
__device__ __forceinline__ void xcd_barrier(const XcdBarrier& b) {
    asm volatile("s_waitcnt vmcnt(0)" ::: "memory");
    __syncthreads();
    if (threadIdx.x == 0) {
        unsigned* bar = b.bar;
        __builtin_amdgcn_s_waitcnt(0);
        unsigned nloc = b.st[0], nx = b.st[1];
        if (nloc == 0u) { xcd_barrier_complete(bar, b.x, nloc, nx); b.st[0] = nloc; b.st[1] = nx; }
        const unsigned old = xb_add(&bar[XB_XSUB(b.x)], 1u);
        const unsigned gen = old / nloc;
        if (old + 1u == (gen + 1u) * nloc) {
            __builtin_amdgcn_fence(__ATOMIC_RELEASE, "agent");
            asm volatile("s_waitcnt vmcnt(0)" ::: "memory");
            const unsigned og = xb_add(&bar[XB_TOP], 1u);
            const unsigned tg = og / nx;
            if (og + 1u == (tg + 1u) * nx) xb_add(&bar[XB_TOPGEN], 1u);
            else XB_SPIN(xb_ld(&bar[XB_TOPGEN]) == tg, bar);
            __builtin_amdgcn_fence(__ATOMIC_ACQUIRE, "agent");
            xb_add(&bar[XB_XGEN(b.x)], 1u);
            asm volatile("s_waitcnt vmcnt(0)" ::: "memory");
        } else {
            XB_SPIN(xb_ld(&bar[XB_XGEN(b.x)]) == gen, bar);
            __builtin_amdgcn_fence(__ATOMIC_ACQUIRE, "agent");
            asm volatile("s_waitcnt vmcnt(0)" ::: "memory");
        }
    }
    __syncthreads();
}

#define RUN_PHASE(K, CALL)                                              \
    if (ph_lo <= (K) && (K) < ph_hi) {                                  \
        CALL;                                                           \
        if (COOP) { if ((K) + 1 < ph_hi) { xcd_barrier(xb); } } \
    }

template <bool COOP>
__global__ void __launch_bounds__(512, 2) fwd_kernel(Params p, int ph_lo, int ph_hi) {
    __shared__ __attribute__((aligned(16))) char smem[SMEM_BYTES + 16];
    char* smh = smem + VHB * HALF_SMEM;
    XcdBarrier xb;
    if (COOP) {
        if (threadIdx.x == 0) *(uint4*)(smem + SMEM_BYTES) = make_uint4(0u, 0u, 0u, 0u);
        __syncthreads();
        xb = xcd_barrier_post(p.bar(), (volatile unsigned*)(smem + SMEM_BYTES));
    }
    if (COOP) { if (ph_lo < 0) cg::this_grid().sync(); }
    RUN_PHASE(0, phase_prep(p, smh))
    RUN_PHASE(1, phase_gemm_in(p, smem))
    RUN_PHASE(2, phase_mixers(p, smh))
    RUN_PHASE(3, (phase_gemm_kv(p, smh), phase_hg_scan(p)))
    RUN_PHASE(4, phase_hg_out(p, smh))
    RUN_PHASE(5, phase_gemm_out(p, smem))
    RUN_PHASE(6, phase_quant_h2(p))
    RUN_PHASE(7, phase_gemm_q_route(p, smem))
    RUN_PHASE(10, phase_peer_dots(p, smem))
    RUN_PHASE(12, phase_peer_accum(p, smem))
}

extern "C" void kernel_launch(void* const* d_in, const int* in_sizes, int n_in, void* d_out, int out_size, void* d_ws, size_t ws_size,
                              hipStream_t stream) {
    Params p{};
    p.x = (const float*)d_in[0]; p.mem = (const float*)d_in[1]; p.attn_g = (const float*)d_in[2]; p.w_in = (const float*)d_in[3];
    p.rpb = (const float*)d_in[4]; p.hg_lb = (const float*)d_in[5]; p.hg_g = (const float*)d_in[6]; p.mem_g = (const float*)d_in[7];
    p.w_kv = (const float*)d_in[8]; p.w_out = (const float*)d_in[9]; p.ffn_g = (const float*)d_in[10]; p.w_q = (const float*)d_in[11];
    p.subk = (const float*)d_in[12]; p.pu = (const float*)d_in[13]; p.pv = (const float*)d_in[14]; p.fin_g = (const float*)d_in[15];
    p.out = (float*)d_out;
    p.ws = (char*)d_ws;
    if (WS_TOTAL > ws_size) { fprintf(stderr, "workspace too small: need %zu have %zu\n", (size_t)WS_TOTAL, ws_size); return; }

#if defined(MULTI_LAUNCH)
    for (int ph = 0; ph < NPHASE; ++ph) fwd_kernel<false><<<dim3(512), dim3(512), 0, stream>>>(p, ph, ph + 1);
#else
    static int grid_blocks = 0;
    if (!grid_blocks) {
        int dev = 0, cus = 0, per_cu = 0;
        hipGetDevice(&dev);
        hipDeviceGetAttribute(&cus, hipDeviceAttributeMultiprocessorCount, dev);
        hipOccupancyMaxActiveBlocksPerMultiprocessor(&per_cu, fwd_kernel<true>, 512, 0);
        if (per_cu > 1) per_cu = 1;
        grid_blocks = (cus * per_cu) & ~3;
    }
    (void)hipMemsetAsync((char*)d_ws + OFF_BAR, 0, XCD_BAR_WORDS * 4, stream);
    int lo = 0, hi = NPHASE;
    void* args[] = {&p, &lo, &hi};
    hipError_t e = hipLaunchCooperativeKernel((void*)fwd_kernel<true>, dim3(grid_blocks), dim3(512), args, 0, stream);
    if (e != hipSuccess) fprintf(stderr, "cooperative launch failed: %s (grid %d)\n", hipGetErrorString(e), grid_blocks);
#endif
}
```

```cpp
#include <hip/hip_runtime.h>
#include <hip/hip_cooperative_groups.h>
#include <stdint.h>
#include <cstdio>

namespace cg = cooperative_groups;

#define VTID ((int)(threadIdx.x & 255))
#define VHB ((int)(threadIdx.x >> 8))
#define VBID ((int)(blockIdx.x * 2 + (threadIdx.x >> 8)))
#define VGRID ((int)(gridDim.x * 2))
constexpr int HALF_SMEM = 73728;

typedef unsigned short bf16_t;
typedef short bf16x8 __attribute__((ext_vector_type(8)));
typedef float f32x4 __attribute__((ext_vector_type(4)));
typedef int i32x4 __attribute__((ext_vector_type(4)));

constexpr int D = 1024;
constexpr int NB = 4;
constexpr int T = 8192;
constexpr int NTOK = NB * T;
constexpr int INW = 3072;
constexpr int QW = 2048;
constexpr float EPS = 1e-6f;
constexpr int SMEM_BYTES = 2 * 73728;
constexpr int NPHASE = 14;

constexpr size_t al256(size_t x) { return (x + 255) & ~(size_t)255; }
constexpr size_t OFF_W_IN_T = 0;
constexpr size_t OFF_W_OUT_T = OFF_W_IN_T + al256((size_t)3072 * 1024 * 2);
constexpr size_t OFF_W_Q_T = OFF_W_OUT_T + al256((size_t)1024 * 1024 * 2);
constexpr size_t OFF_W_KV_T = OFF_W_Q_T + al256((size_t)2048 * 1024 * 2);
constexpr size_t OFF_H = OFF_W_KV_T + al256((size_t)512 * 1024 * 2);
constexpr size_t OFF_Z = OFF_H + al256((size_t)32768 * 1024 * 2);
constexpr size_t OFF_MIX = OFF_Z + al256((size_t)32768 * 3072 * 2);
constexpr size_t OFF_MEMN = OFF_MIX + al256((size_t)32768 * 1024 * 2);
constexpr size_t OFF_KVB = OFF_MEMN + al256((size_t)1024 * 1024 * 2);
constexpr size_t OFF_LB = OFF_KVB + al256((size_t)1024 * 512 * 2);
constexpr size_t OFF_HSTATE = OFF_LB + al256(512 * 4);
constexpr size_t OFF_HDEC = OFF_HSTATE + al256((size_t)4096 * 4096 * 4);
constexpr size_t OFF_UC = OFF_HDEC + al256((size_t)4096 * 64 * 4);
constexpr size_t OFF_VC = OFF_UC + al256((size_t)16384 * 1024);
constexpr size_t OFF_QUEUE = OFF_VC + al256((size_t)16384 * 1024);
constexpr size_t OFF_SUBK = OFF_QUEUE + al256(2048 * 4);
constexpr size_t OFF_BAR = OFF_SUBK + al256((size_t)16 * 128 * 128 * 2);
constexpr size_t OFF_SS1 = OFF_BAR + al256(4096 * 4);
constexpr size_t OFF_HMAX = OFF_SS1 + al256((size_t)32768 * 4);
constexpr size_t OFF_CSUM = OFF_HMAX + al256((size_t)32768 * 4);
constexpr size_t OFF_SCALE_U = OFF_CSUM + al256((size_t)32768 * 4);
constexpr size_t OFF_SCALE_V = OFF_SCALE_U + al256(16384 * 4);
constexpr size_t OFF_VT = OFF_SCALE_V + al256(16384 * 4);
constexpr size_t OFF_KVT = OFF_VT + al256((size_t)32768 * 512 * 2);
constexpr size_t OFF_SA = OFF_KVT + al256((size_t)1024 * 256 * 2);
constexpr size_t OFF_SB = OFF_SA + al256((size_t)32768 * 4);
constexpr size_t WS_TOTAL = OFF_SB + al256((size_t)8192 * 4);
constexpr size_t OFF_EIDX = OFF_HSTATE;
constexpr size_t OFF_GATE = OFF_HSTATE + (size_t)32768 * 128 * 4;
constexpr size_t OFF_COEF = OFF_HSTATE + (size_t)32768 * 128 * 8;
constexpr size_t OFF_SS = OFF_HSTATE + (size_t)32768 * 128 * 12;
constexpr size_t OFF_PARTIAL = OFF_Z;
constexpr size_t OFF_PEER_OUT = OFF_Z + (size_t)8 * 32768 * 128 * 4;

struct Params {
    const float *x, *mem, *attn_g, *w_in, *rpb, *hg_lb, *hg_g, *mem_g, *w_kv, *w_out, *ffn_g, *w_q, *subk, *pu, *pv, *fin_g;
    float* out;
    char* ws;
#define WSF(type, name, off) __device__ __forceinline__ type* name() const { return (type*)(ws + (off)); }
    WSF(bf16_t, w_in_t, OFF_W_IN_T) WSF(bf16_t, w_out_t, OFF_W_OUT_T) WSF(bf16_t, w_q_t, OFF_W_Q_T) WSF(bf16_t, w_kv_t, OFF_W_KV_T)
    WSF(bf16_t, h, OFF_H)
    WSF(bf16_t, z, OFF_Z)
    WSF(bf16_t, mix, OFF_MIX)
    WSF(bf16_t, memn, OFF_MEMN)
    WSF(bf16_t, kvb, OFF_KVB)
    WSF(float, lb, OFF_LB)
    WSF(float, hstate, OFF_HSTATE)
    WSF(float, hdec, OFF_HDEC)
    WSF(unsigned short, eidx, OFF_EIDX)
    WSF(float, gate, OFF_GATE)
    WSF(signed char, coef, OFF_COEF)
    WSF(bf16_t, x1b, OFF_PEER_OUT)
    WSF(float, ss, OFF_SS)
    WSF(float, partial, OFF_PARTIAL)
    WSF(bf16_t, u_c, OFF_UC) WSF(bf16_t, v_c, OFF_VC)
    WSF(unsigned, queue, OFF_QUEUE)
    WSF(bf16_t, subk_b, OFF_SUBK)
    WSF(unsigned, bar, OFF_BAR)
    WSF(float, ss1, OFF_SS1) WSF(unsigned, hmax, OFF_HMAX) WSF(float, csum, OFF_CSUM)
    WSF(float, scale_u, OFF_SCALE_U) WSF(float, scale_v, OFF_SCALE_V)
    WSF(bf16_t, vT, OFF_VT)
    WSF(signed char, hq, OFF_H)
    WSF(signed char, w_in_q, OFF_W_IN_T)
    WSF(float, sa, OFF_SA) WSF(float, sb, OFF_SB)
    WSF(signed char, h2q, OFF_MIX)
    WSF(signed char, w_q_q, OFF_W_Q_T)
    WSF(bf16_t, kvT, OFF_KVT)
#undef WSF
};

__device__ __forceinline__ float bf2f(bf16_t v) { return __uint_as_float(((unsigned)v) << 16); }
__device__ __forceinline__ bf16_t f2bf(float f) {
    unsigned u = __float_as_uint(f);
    u += 0x7FFFu + ((u >> 16) & 1u);
    return (bf16_t)(u >> 16);
}
__device__ __forceinline__ float bflo(unsigned u) { return __uint_as_float(u << 16); }
__device__ __forceinline__ float bfhi(unsigned u) { return __uint_as_float(u & 0xFFFF0000u); }
typedef __bf16 bf16x2v_t __attribute__((ext_vector_type(2)));
typedef float f32x2v_t __attribute__((ext_vector_type(2)));
__device__ __forceinline__ unsigned pack2(float a, float b) {
    const f32x2v_t v = {a, b};
    return __builtin_bit_cast(unsigned, __builtin_convertvector(v, bf16x2v_t));
}

__device__ __forceinline__ float wave_sum(float v) {
#pragma unroll
    for (int o = 32; o; o >>= 1) v += __shfl_xor(v, o);
    return v;
}
__device__ __forceinline__ float wave_max(float v) {
#pragma unroll
    for (int o = 32; o; o >>= 1) v = fmaxf(v, __shfl_xor(v, o));
    return v;
}


typedef __bf16 bf16x2_t __attribute__((ext_vector_type(2)));
template <int CTRL>
__device__ __forceinline__ float dpp_mov(float v) {
    return __builtin_bit_cast(float, __builtin_amdgcn_update_dpp(0, __builtin_bit_cast(int, v), CTRL, 0xf, 0xf, true));
}
#define DPP_QP_X1 0xB1
#define DPP_QP_X2 0x4E
#define DPP_HMIRROR 0x141
#define DPP_ROR8 0x128
__device__ __forceinline__ unsigned xcc_id() { return (unsigned)__builtin_amdgcn_s_getreg((3 << 11) | 20) & 0xFu; }

__device__ __forceinline__ void transpose_tile(const float* __restrict__ in, bf16_t* __restrict__ out, int K, int N, int tile, char* smem) {
    float* tl = (float*)smem;
    const int ntn = N >> 6;
    const int k0 = (tile / ntn) << 6, n0 = (tile % ntn) << 6;
    const int tid = VTID;
    __syncthreads();
#pragma unroll 4
    for (int i = 0; i < 16; ++i) {
        int idx = tid + 256 * i;
        int r = idx >> 6, c = idx & 63;
        tl[r * 65 + c] = in[(size_t)(k0 + r) * N + n0 + c];
    }
    __syncthreads();
#pragma unroll 4
    for (int i = 0; i < 16; ++i) {
        int idx = tid + 256 * i;
        int r = idx >> 6, c = idx & 63;
        out[(size_t)(n0 + r) * K + k0 + c] = f2bf(tl[c * 65 + r]);
    }
}

__device__ __forceinline__ void rmsnorm_row_bf16(const float* __restrict__ xr, const float* __restrict__ g, bf16_t* __restrict__ o, int lane) {
    float4 v[4];
    float ss = 0.f;
#pragma unroll
    for (int j = 0; j < 4; ++j) {
        v[j] = *(const float4*)(xr + (j * 64 + lane) * 4);
        ss += v[j].x * v[j].x + v[j].y * v[j].y + v[j].z * v[j].z + v[j].w * v[j].w;
    }
    ss = wave_sum(ss);
    const float rs = rsqrtf(ss * (1.0f / 1024.0f) + EPS);
#pragma unroll
    for (int j = 0; j < 4; ++j) {
        const float4 gg = *(const float4*)(g + (j * 64 + lane) * 4);
        uint2 pk;
        pk.x = pack2(v[j].x * rs * gg.x, v[j].y * rs * gg.y);
        pk.y = pack2(v[j].z * rs * gg.z, v[j].w * rs * gg.w);
        *(uint2*)(o + (j * 64 + lane) * 4) = pk;
    }
}

__device__ __forceinline__ void rmsnorm_row_i8(const float* __restrict__ xr, const float* __restrict__ g, signed char* __restrict__ o, float* __restrict__ sa, int lane) {
    float4 v[4];
    float ss = 0.f;
#pragma unroll
    for (int j = 0; j < 4; ++j) {
        v[j] = *(const float4*)(xr + (j * 64 + lane) * 4);
        ss += v[j].x * v[j].x + v[j].y * v[j].y + v[j].z * v[j].z + v[j].w * v[j].w;
    }
    ss = wave_sum(ss);
    const float rs = rsqrtf(ss * (1.0f / 1024.0f) + EPS);
    float am = 0.f;
#pragma unroll
    for (int j = 0; j < 4; ++j) {
        const float4 gg = *(const float4*)(g + (j * 64 + lane) * 4);
        v[j].x *= rs * gg.x; v[j].y *= rs * gg.y; v[j].z *= rs * gg.z; v[j].w *= rs * gg.w;
        am = fmaxf(am, fmaxf(fmaxf(fabsf(v[j].x), fabsf(v[j].y)), fmaxf(fabsf(v[j].z), fabsf(v[j].w))));
    }
    am = wave_max(am);
    const float qs = am > 0.f ? 127.0f / am : 0.f;
    if (lane == 0) *sa = am * (1.0f / 127.0f);
#pragma unroll
    for (int j = 0; j < 4; ++j) {
        const int q0 = (int)rintf(v[j].x * qs), q1 = (int)rintf(v[j].y * qs), q2 = (int)rintf(v[j].z * qs), q3 = (int)rintf(v[j].w * qs);
        *(unsigned*)(o + (j * 64 + lane) * 4) = (unsigned)(q0 & 255) | ((unsigned)(q1 & 255) << 8) | ((unsigned)(q2 & 255) << 16) | ((unsigned)(q3 & 255) << 24);
    }
}
__device__ __forceinline__ void transpose_cols_i8(const float* __restrict__ in, signed char* __restrict__ out, float* __restrict__ sb, int N, int item, char* smem) {
    float* tl = (float*)smem;
    const int n0 = item << 4;
    const int tid = VTID;
    __syncthreads();
    {
        float4 v[16];
#pragma unroll
        for (int i = 0; i < 16; ++i) {
            const int idx = tid + 256 * i;
            v[i] = *(const float4*)(in + (size_t)(idx >> 2) * N + n0 + (idx & 3) * 4);
        }
#pragma unroll
        for (int i = 0; i < 16; ++i) {
            const int idx = tid + 256 * i;
            const int k = idx >> 2, c = (idx & 3) * 4;
            tl[(c + 0) * 1028 + k] = v[i].x; tl[(c + 1) * 1028 + k] = v[i].y; tl[(c + 2) * 1028 + k] = v[i].z; tl[(c + 3) * 1028 + k] = v[i].w;
        }
    }
    __syncthreads();
    float qs;
    {
        const int c = tid >> 4, l = tid & 15;
        float am = 0.f;
#pragma unroll 8
        for (int i = 0; i < 64; ++i) am = fmaxf(am, fabsf(tl[c * 1028 + l + 16 * i]));
        am = fmaxf(am, __shfl_xor(am, 1)); am = fmaxf(am, __shfl_xor(am, 2)); am = fmaxf(am, __shfl_xor(am, 4)); am = fmaxf(am, __shfl_xor(am, 8));
        if (l == 0) sb[n0 + c] = am * (1.0f / 127.0f);
        qs = am > 0.f ? 127.0f / am : 0.f;
    }
    __syncthreads();
    float* qt = tl + 16 * 1028;
    if ((tid & 15) == 0) qt[tid >> 4] = qs;
    __syncthreads();
#pragma unroll
    for (int i = 0; i < 16; ++i) {
        const int kq = tid * 4;
        const float q = qt[i];
        const float4 v = *(const float4*)(tl + i * 1028 + kq);
        const int q0 = (int)rintf(v.x * q), q1 = (int)rintf(v.y * q), q2 = (int)rintf(v.z * q), q3 = (int)rintf(v.w * q);
        *(unsigned*)(out + (size_t)(n0 + i) * 1024 + kq) = (unsigned)(q0 & 255) | ((unsigned)(q1 & 255) << 8) | ((unsigned)(q2 & 255) << 16) | ((unsigned)(q3 & 255) << 24);
    }
}

__device__ void phase_prep(const Params& p, char* smem) {
    const int tid = VTID, lane = tid & 63, w = tid >> 6;
    const int gsz = VGRID, bid = VBID;
    const int t_in = INW / 16;
    const int t_out = 16 * 16;
    const int t_q = QW / 16;
    const int t_kv = 16 * 8;
    const int t_all = t_in + t_out + t_q + t_kv;
    for (int it = bid; it < t_all; it += gsz) {
        if (it < t_in) transpose_cols_i8(p.w_in, p.w_in_q(), p.sb(), INW, it, smem);
        else if (it < t_in + t_out) transpose_tile(p.w_out, p.w_out_t(), 1024, 1024, it - t_in, smem);
        else if (it < t_in + t_out + t_q) transpose_cols_i8(p.w_q, p.w_q_q(), p.sb() + INW, QW, it - t_in - t_out, smem);
        else transpose_tile(p.w_kv, p.w_kv_t(), 1024, 512, it - t_in - t_out - t_q, smem);
    }
    for (int i = bid * 256 + tid; i < NTOK; i += gsz * 256) { p.ss1()[i] = 0.f; p.hmax()[i] = 0u; }
    if (bid == 0) {
        for (int i = tid; i < 512; i += 256) {
            int dir = i >> 8, k = i & 255;
            float a0 = p.hg_lb[(dir * 2 + 0) * 256 + k], a1 = p.hg_lb[(dir * 2 + 1) * 256 + k];
            float m = fmaxf(a0, a1);
            float e0 = expf(a0 - m), e1 = expf(a1 - m);
            p.lb()[i] = e0 / (e0 + e1);
        }
    }
    const int nrows = NTOK + 1024;
    for (int r0 = bid * 4; r0 < nrows; r0 += gsz * 4) {
        int r = r0 + w;
        if (r < NTOK) rmsnorm_row_i8(p.x + (size_t)r * D, p.attn_g, p.hq() + (size_t)r * D, p.sa() + r, lane);
        else if (r < nrows) rmsnorm_row_bf16(p.mem + (size_t)(r - NTOK) * D, p.mem_g, p.memn() + (size_t)(r - NTOK) * D, lane);
    }
    for (int i = bid * 256 + tid; i < 16 * 128 * 128 / 4; i += gsz * 256) {
        const float4 v = *(const float4*)(p.subk + (size_t)i * 4);
        uint2 pk; pk.x = pack2(v.x, v.y); pk.y = pack2(v.z, v.w);
        *(uint2*)(p.subk_b() + (size_t)i * 4) = pk;
    }
    for (int r0 = bid * 4; r0 < 2 * 16384; r0 += gsz * 4) {
        const int r = r0 + w;
        const bool isv = r >= 16384;
        const int e = r & 16383;
        const float* srcp = (isv ? p.pv : p.pu) + (size_t)e * D;
        unsigned* dst = (unsigned*)(isv ? p.v_c() : p.u_c());
        float4 v[4];
        float am = 0.f;
#pragma unroll
        for (int j = 0; j < 4; ++j) {
            v[j] = *(const float4*)(srcp + (j * 64 + lane) * 4);
            am = fmaxf(am, fmaxf(fmaxf(fabsf(v[j].x), fabsf(v[j].y)), fmaxf(fabsf(v[j].z), fabsf(v[j].w))));
        }
        am = wave_max(am);
        const float qs = am > 0.f ? 127.0f / am : 0.f;
        if (lane == 0) (isv ? p.scale_v() : p.scale_u())[e] = am * (1.0f / 127.0f);
        const int off = 0;
#pragma unroll
        for (int j = 0; j < 4; ++j) {
            const int q0 = (int)rintf(v[j].x * qs) + off, q1 = (int)rintf(v[j].y * qs) + off;
            const int q2 = (int)rintf(v[j].z * qs) + off, q3 = (int)rintf(v[j].w * qs) + off;
            const unsigned pk = (unsigned)(q0 & 255) | ((unsigned)(q1 & 255) << 8) | ((unsigned)(q2 & 255) << 16) | ((unsigned)(q3 & 255) << 24);
            const int c = j * 2 + (lane >> 5), d = (lane & 31) * 4;
            dst[(((size_t)c * 16384 + e) * 128 + d) >> 2] = pk;
        }
    }
}

struct EpiBf16 {
    bf16_t* C; int ldc;
    __device__ __forceinline__ void operator()(int row, int col, const f32x4& v) const {
        uint2 pk; pk.x = pack2(v[0], v[1]); pk.y = pack2(v[2], v[3]);
        *(uint2*)(C + (size_t)row * ldc + col) = pk;
    }
};
struct EpiBf16T {
    bf16_t* C; int col0, ncols, rows_per_b;
    __device__ __forceinline__ void operator()(int row, int col, const f32x4& v) const {
        const int bb = row / rows_per_b, rr = row - bb * rows_per_b;
        uint2 pk; pk.x = pack2(v[0], v[1]); pk.y = pack2(v[2], v[3]);
        *(uint2*)(C + ((size_t)bb * ncols + (col - col0)) * rows_per_b + rr) = pk;
    }
};
struct EpiBf16S {
    bf16_t* C; int ldc; const float* sa; const float* sb;
    __device__ __forceinline__ void operator()(int row, int col, const f32x4& v) const {
        const float s = sa[row];
        const float4 b = *(const float4*)(sb + col);
        uint2 pk; pk.x = pack2(v[0] * s * b.x, v[1] * s * b.y); pk.y = pack2(v[2] * s * b.z, v[3] * s * b.w);
        *(uint2*)(C + (size_t)row * ldc + col) = pk;
    }
};
struct EpiBf16TS {
    bf16_t* C; int col0, ncols, rows_per_b; const float* sa; const float* sb;
    __device__ __forceinline__ void operator()(int row, int col, const f32x4& v) const {
        const int bb = row / rows_per_b, rr = row - bb * rows_per_b;
        const float4 a = *(const float4*)(sa + row);
        const float b = sb[col];
        uint2 pk; pk.x = pack2(v[0] * a.x * b, v[1] * a.y * b); pk.y = pack2(v[2] * a.z * b, v[3] * a.w * b);
        *(uint2*)(C + ((size_t)bb * ncols + (col - col0)) * rows_per_b + rr) = pk;
    }
};
constexpr int EPS_LD = 528;
struct EpiBf16SStaged {
    static constexpr bool staged = true;
    bf16_t* C; int ldc; const float* sa; const float* sb; char* lt; int brow, bcol;
    __device__ __forceinline__ void operator()(int row, int col, const f32x4& v) const {
        const float s = sa[row];
        const float4 b = *(const float4*)(sb + col);
        uint2 pk; pk.x = pack2(v[0] * s * b.x, v[1] * s * b.y); pk.y = pack2(v[2] * s * b.z, v[3] * s * b.w);
        *(uint2*)(lt + (row - brow) * EPS_LD + (col - bcol) * 2) = pk;
    }
    __device__ __forceinline__ void finish() const {
        int tid = threadIdx.x;
        asm volatile("" : "+v"(tid));
        const int c16 = tid & 31, r0 = tid >> 5;
#pragma unroll
        for (int i = 0; i < 16; ++i) {
            const int r = i * 16 + r0;
            *(uint4*)(C + (size_t)(brow + r) * ldc + bcol + c16 * 8) = *(const uint4*)(lt + r * EPS_LD + c16 * 16);
        }
    }
};
struct EpiBf16TSStaged {
    static constexpr bool staged = true;
    bf16_t* Cb; const float* sa; const float* sb; char* lt; int brow, bcol;
    __device__ __forceinline__ void operator()(int row, int col, const f32x4& v) const {
        const float4 a = *(const float4*)(sa + row);
        const float b = sb[col];
        uint2 pk; pk.x = pack2(v[0] * a.x * b, v[1] * a.y * b); pk.y = pack2(v[2] * a.z * b, v[3] * a.w * b);
        *(uint2*)(lt + (col - bcol) * EPS_LD + (row - brow) * 2) = pk;
    }
    __device__ __forceinline__ void finish() const {
        int tid = threadIdx.x;
        asm volatile("" : "+v"(tid));
        const int c16 = tid & 31, r0 = tid >> 5;
#pragma unroll
        for (int i = 0; i < 16; ++i) {
            const int r = i * 16 + r0;
            *(uint4*)(Cb + (size_t)r * T + c16 * 8) = *(const uint4*)(lt + r * EPS_LD + c16 * 16);
        }
    }
};
struct EpiBf16RowScale {
    bf16_t* C; int ldc; const float* ssrow;
    __device__ __forceinline__ void operator()(int row, int col, const f32x4& v) const {
        const float rs = rsqrtf(ssrow[row] * (1.0f / 1024.0f) + EPS);
        uint2 pk; pk.x = pack2(v[0] * rs, v[1] * rs); pk.y = pack2(v[2] * rs, v[3] * rs);
        *(uint2*)(C + (size_t)row * ldc + col) = pk;
    }
};
struct EpiResNorm {
    bf16_t* C; const float* R; const float* g; int ldc; float* ssrow; unsigned* hmax;
    __device__ __forceinline__ void operator()(int row, int col, const f32x4& v, float& ssq, float& am) const {
        const float4 r = *(const float4*)(R + (size_t)row * ldc + col);
        const float4 gg = *(const float4*)(g + col);
        float4 o; o.x = v[0] + r.x; o.y = v[1] + r.y; o.z = v[2] + r.z; o.w = v[3] + r.w;
        uint2 xk; xk.x = pack2(o.x, o.y); xk.y = pack2(o.z, o.w);
        *(uint2*)(C + (size_t)row * ldc + col) = xk;
        const float h0 = bflo(xk.x) * gg.x, h1 = bfhi(xk.x) * gg.y, h2 = bflo(xk.y) * gg.z, h3 = bfhi(xk.y) * gg.w;
        ssq += o.x * o.x + o.y * o.y + o.z * o.z + o.w * o.w;
        am = fmaxf(am, fmaxf(fmaxf(fabsf(h0), fabsf(h1)), fmaxf(fabsf(h2), fabsf(h3))));
    }
    __device__ __forceinline__ void row_done(int row, float ssq, float am) const {
        atomicAdd(ssrow + row, ssq);
        atomicMax(hmax + row, __float_as_uint(am));
    }
};
struct EpiResF32 {
    float* C; const float* R; int ldc;
    __device__ __forceinline__ void operator()(int row, int col, const f32x4& v) const {
        const float4 r = *(const float4*)(R + (size_t)row * ldc + col);
        float4 o; o.x = v[0] + r.x; o.y = v[1] + r.y; o.z = v[2] + r.z; o.w = v[3] + r.w;
        *(float4*)(C + (size_t)row * ldc + col) = o;
    }
};

template <bool TRANS, class Epi, bool ROWSS = false>
__device__ __forceinline__ void gemm_tile(const bf16_t* __restrict__ A, int lda, const bf16_t* __restrict__ Bt, int ldb, int K,
                                          int m0, int n0, char* smem, const Epi& epi, float* ssrow = nullptr) {
    const int tid = VTID, lane = tid & 63, w = tid >> 6, wr = w >> 1, wc = w & 1;
    const int fr = lane & 15, fq = lane >> 4;
    const int srow = lane >> 3, sslot = lane & 7;
    f32x4 acc[4][4];
#pragma unroll
    for (int mi = 0; mi < 4; ++mi)
#pragma unroll
        for (int ni = 0; ni < 4; ++ni) acc[mi][ni] = (f32x4){0.f, 0.f, 0.f, 0.f};
    const int g0 = (sslot ^ (srow >> 1)) * 8, g1 = (sslot ^ (4 + (srow >> 1))) * 8;
    const bf16_t* Ab = A + (size_t)(m0 + w * 32 + srow) * lda;
    const bf16_t* Bb = Bt + (size_t)(n0 + w * 32 + srow) * ldb;
    const int nk = K >> 6;
    __syncthreads();
#define GEMM_STAGE(kt, buf)                                                                                                  \
    do {                                                                                                                     \
        char* sa = smem + (buf) * 32768 + w * 4096;                                                                          \
        char* sb = sa + 16384;                                                                                               \
        _Pragma("unroll") for (int i = 0; i < 4; ++i) {                                                                      \
            const int gc = (i & 1) ? g1 : g0;                                                                                \
            __builtin_amdgcn_global_load_lds((const unsigned*)(Ab + (size_t)(i * 8) * lda + (kt) * 64 + gc), (unsigned*)(sa + i * 1024), 16, 0, 0); \
            __builtin_amdgcn_global_load_lds((const unsigned*)(Bb + (size_t)(i * 8) * ldb + (kt) * 64 + gc), (unsigned*)(sb + i * 1024), 16, 0, 0); \
        }                                                                                                                    \
    } while (0)
    GEMM_STAGE(0, 0);
    const int key = fr >> 1;
    for (int kt = 0; kt < nk; ++kt) {
        asm volatile("s_waitcnt vmcnt(0)" ::: "memory");
        __syncthreads();
        if (kt + 1 < nk) GEMM_STAGE(kt + 1, (kt + 1) & 1);
        const char* sa = smem + (kt & 1) * 32768;
        const char* sb = sa + 16384;
#pragma unroll
        for (int ks = 0; ks < 2; ++ks) {
            bf16x8 af[4], bfr[4];
            const int co = ((ks * 4 + fq) ^ key) << 4;
#pragma unroll
            for (int mi = 0; mi < 4; ++mi) af[mi] = *(const bf16x8*)(sa + (wr * 64 + mi * 16 + fr) * 128 + co);
#pragma unroll
            for (int ni = 0; ni < 4; ++ni) bfr[ni] = *(const bf16x8*)(sb + (wc * 64 + ni * 16 + fr) * 128 + co);
#pragma unroll
            for (int mi = 0; mi < 4; ++mi)
#pragma unroll
                for (int ni = 0; ni < 4; ++ni)
                    acc[mi][ni] = TRANS ? __builtin_amdgcn_mfma_f32_16x16x32_bf16(af[mi], bfr[ni], acc[mi][ni], 0, 0, 0)
                                        : __builtin_amdgcn_mfma_f32_16x16x32_bf16(bfr[ni], af[mi], acc[mi][ni], 0, 0, 0);
        }
    }
#undef GEMM_STAGE
    if constexpr (ROWSS) {
#pragma unroll
        for (int mi = 0; mi < 4; ++mi) {
            const int row = m0 + wr * 64 + mi * 16 + fr;
            float ssq = 0.f, am = 0.f;
#pragma unroll
            for (int ni = 0; ni < 4; ++ni) epi(row, n0 + wc * 64 + ni * 16 + fq * 4, acc[mi][ni], ssq, am);
            ssq += __shfl_xor(ssq, 16);
            ssq += __shfl_xor(ssq, 32);
            am = fmaxf(am, __shfl_xor(am, 16));
            am = fmaxf(am, __shfl_xor(am, 32));
            if (fq == 0) epi.row_done(row, ssq, am);
        }
    } else {
#pragma unroll
        for (int mi = 0; mi < 4; ++mi)
#pragma unroll
            for (int ni = 0; ni < 4; ++ni) {
                if (TRANS) epi(m0 + wr * 64 + mi * 16 + fq * 4, n0 + wc * 64 + ni * 16 + fr, acc[mi][ni]);
                else epi(m0 + wr * 64 + mi * 16 + fr, n0 + wc * 64 + ni * 16 + fq * 4, acc[mi][ni]);
            }
    }
}


namespace g8 {
constexpr int BM = 256, BK = 64, HALF = 128, HT = HALF * BK;
__device__ __forceinline__ int lds_byte(int r, int c) {
    const int st = (r >> 4) * 2 + (c >> 5), rr = r & 15, cc = c & 31, ob = rr * 64 + cc * 2;
    return st * 1024 + (ob ^ (((ob >> 9) & 1) << 5));
}
__device__ __forceinline__ void stage_rc(int b, int& R, int& C) {
    const int st = b / 1024, sb = b % 1024, swz = sb ^ (((sb >> 9) & 1) << 5);
    R = (st >> 1) * 16 + swz / 64; C = (st & 1) * 32 + (swz % 64) / 2;
}
__device__ __forceinline__ void tile_of(int L, int nM, int nN, int& pm, int& pn) {
    const int nwg = nM * nN;
    int wgid = L;
    { const int q = nwg / 8, r = nwg % 8, xcd = wgid % 8, off = wgid / 8; wgid = (xcd < r ? xcd * (q + 1) : r * (q + 1) + (xcd - r) * q) + off; }
    const int nig = 8 * nN, gid = wgid / nig, fm = gid * 8, gsz = (nM - fm) < 8 ? (nM - fm) : 8;
    pm = fm + ((wgid % nig) % gsz); pn = (wgid % nig) / gsz;
}
}

#define G8_LAS __attribute__((address_space(3)))
template <bool I8, bool TRANS, class Acc>
__device__ __forceinline__ void g8_mma(Acc& c, const bf16x8& a, const bf16x8& b) {
    if constexpr (I8) {
        const i32x4 ai = __builtin_bit_cast(i32x4, a), bi = __builtin_bit_cast(i32x4, b);
        c = TRANS ? __builtin_amdgcn_mfma_i32_16x16x64_i8(ai, bi, c, 0, 0, 0) : __builtin_amdgcn_mfma_i32_16x16x64_i8(bi, ai, c, 0, 0, 0);
    } else {
        c = TRANS ? __builtin_amdgcn_mfma_f32_16x16x32_bf16(a, b, c, 0, 0, 0) : __builtin_amdgcn_mfma_f32_16x16x32_bf16(b, a, c, 0, 0, 0);
    }
}
template <bool I8> struct g8_acc { using type = f32x4; };
template <> struct g8_acc<true> { using type = i32x4; };
template <bool I8, class Acc> __device__ __forceinline__ f32x4 g8_cvt(const Acc& a) {
    if constexpr (I8) return (f32x4){(float)a[0], (float)a[1], (float)a[2], (float)a[3]};
    else return a;
}
template <bool TRANS, bool ROWSS, bool I8, class Epi>
__device__ __forceinline__ void gemm256_tile(const void* __restrict__ A, const void* __restrict__ Bt, int K, int brow, int bcol,
                                             char* shmc, const Epi& epi) {
    using namespace g8;
    constexpr int ES = I8 ? 1 : 2;
    using acc_t = typename g8_acc<I8>::type;
    G8_LAS unsigned char* lds = (G8_LAS unsigned char*)shmc;
    const int tid = threadIdx.x, wid = __builtin_amdgcn_readfirstlane(tid >> 6), lane = tid & 63, wr = wid >> 2, wc = wid & 3, fr = lane & 15, fq = lane >> 4;
    constexpr int HTB = HALF * BK * 2;
    unsigned voff[2];
#pragma unroll
    for (int i = 0; i < 2; ++i) { int R, C; stage_rc(tid * 16 + i * 8192, R, C); voff[i] = (unsigned)(R * K * ES + C * 2); }
    const size_t kstep = (size_t)(BK * 2);
    const size_t hstep = (size_t)HALF * K * ES;
    const unsigned ldsw = (unsigned)wid * 1024u;
    const int aoff = lds_byte(wr * 64 + fr, fq * 8), boff = lds_byte(wc * 32 + fr, fq * 8);
    const char* cA = (const char*)A + (size_t)brow * K * ES;
    const char* cB = (const char*)Bt + (size_t)bcol * K * ES;
#define G8_SA(b, h) (((b) * 2 + (h)) * HTB)
#define G8_SB(b, h) ((4 + (b) * 2 + (h)) * HTB)
#define G8_STAGE(bufoff, gbase) do { _Pragma("unroll") for (int _i = 0; _i < 2; ++_i) \
        __builtin_amdgcn_global_load_lds((const unsigned*)((const char*)(gbase) + voff[_i]), (G8_LAS unsigned*)(lds + (bufoff) + ldsw + _i * 8192), 16, 0, 0); } while (0)
#define G8_LDA(dst, b, h) do { _Pragma("unroll") for (int m = 0; m < 4; ++m) _Pragma("unroll") for (int k = 0; k < 2; ++k) dst[m][k] = *(const G8_LAS bf16x8*)(lds + G8_SA(b, h) + aoff + m * 2048 + k * 1024); } while (0)
#define G8_LDB(dst, b, h) do { _Pragma("unroll") for (int n = 0; n < 2; ++n) _Pragma("unroll") for (int k = 0; k < 2; ++k) dst[n][k] = *(const G8_LAS bf16x8*)(lds + G8_SB(b, h) + boff + n * 2048 + k * 1024); } while (0)
#define G8_MMA(ai, bj, At_, Bt_) do { __builtin_amdgcn_s_setprio(1); _Pragma("unroll") for (int m = 0; m < 4; ++m) _Pragma("unroll") for (int n = 0; n < 2; ++n) _Pragma("unroll") for (int k = 0; k < 2; ++k) \
        g8_mma<I8, TRANS>(acc[ai][bj][m][n], At_[m][k], Bt_[n][k]); \
        __builtin_amdgcn_s_setprio(0); } while (0)
#define G8_WAIT_V(n) asm volatile("s_waitcnt vmcnt(" #n ")" ::: "memory")
#define G8_WAIT_L(n) asm volatile("s_waitcnt lgkmcnt(" #n ")" ::: "memory")
#define G8_BAR __builtin_amdgcn_s_barrier()
#define G8_SCHED __builtin_amdgcn_sched_barrier(0)
    acc_t acc[2][2][4][2];
#pragma unroll
    for (int a = 0; a < 2; ++a)
#pragma unroll
        for (int b = 0; b < 2; ++b)
#pragma unroll
            for (int m = 0; m < 4; ++m)
#pragma unroll
                for (int n = 0; n < 2; ++n) acc[a][b][m][n] = (acc_t){0, 0, 0, 0};
    bf16x8 At[4][2], B0[2][2], B1[2][2];
    const int nt = K * ES / (BK * 2);
    __syncthreads();
    G8_STAGE(G8_SB(0, 0), cB); G8_STAGE(G8_SA(0, 0), cA); G8_STAGE(G8_SB(0, 1), cB + hstep); G8_STAGE(G8_SA(0, 1), cA + hstep);
    if (wr == 1) G8_BAR;
    G8_WAIT_V(4); G8_BAR;
    G8_STAGE(G8_SB(1, 0), cB + kstep); G8_STAGE(G8_SA(1, 0), cA + kstep); G8_STAGE(G8_SB(1, 1), cB + hstep + kstep);
    G8_WAIT_V(6); G8_BAR;
    for (int t = 0; t < nt - 2; t += 2) {
        const char* a1 = cA + (size_t)(t + 1) * kstep; const char* a2 = a1 + kstep; const char* a3 = a2 + kstep;
        const char* b2 = cB + (size_t)(t + 2) * kstep; const char* b3 = b2 + kstep;
        G8_LDB(B0, 0, 0); G8_SCHED; G8_LDA(At, 0, 0); G8_STAGE(G8_SA(1, 1), a1 + hstep);
        G8_WAIT_L(8); G8_BAR; G8_WAIT_L(0); G8_MMA(0, 0, At, B0); G8_BAR; G8_SCHED;
        G8_LDB(B1, 0, 1); G8_STAGE(G8_SB(0, 0), b2);
        G8_BAR; G8_WAIT_L(0); G8_MMA(0, 1, At, B1); G8_BAR;
        G8_LDA(At, 0, 1); G8_STAGE(G8_SA(0, 0), a2);
        G8_BAR; G8_WAIT_L(0); G8_MMA(1, 0, At, B0); G8_BAR; G8_SCHED;
        G8_STAGE(G8_SB(0, 1), b2 + hstep);
        G8_WAIT_V(6); G8_BAR; G8_MMA(1, 1, At, B1); G8_BAR;
        G8_LDB(B0, 1, 0); G8_SCHED; G8_LDA(At, 1, 0); G8_STAGE(G8_SA(0, 1), a2 + hstep);
        G8_WAIT_L(8); G8_BAR; G8_WAIT_L(0); G8_MMA(0, 0, At, B0); G8_BAR; G8_SCHED;
        G8_LDB(B1, 1, 1); G8_STAGE(G8_SB(1, 0), b3);
        G8_BAR; G8_WAIT_L(0); G8_MMA(0, 1, At, B1); G8_BAR;
        G8_LDA(At, 1, 1); G8_STAGE(G8_SA(1, 0), a3);
        G8_BAR; G8_WAIT_L(0); G8_MMA(1, 0, At, B0); G8_BAR; G8_SCHED;
        G8_STAGE(G8_SB(1, 1), b3 + hstep);
        G8_WAIT_V(6); G8_BAR; G8_MMA(1, 1, At, B1); G8_BAR;
    }
    { G8_LDB(B0, 0, 0); G8_LDA(At, 0, 0); G8_STAGE(G8_SA(1, 1), cA + (size_t)(nt - 1) * kstep + hstep);
      G8_BAR; G8_WAIT_L(0); G8_MMA(0, 0, At, B0); G8_BAR;
      G8_LDB(B1, 0, 1); G8_BAR; G8_WAIT_L(0); G8_MMA(0, 1, At, B1); G8_BAR;
      G8_LDA(At, 0, 1); G8_WAIT_V(4); G8_BAR; G8_WAIT_L(0); G8_MMA(1, 0, At, B0); G8_MMA(1, 1, At, B1); G8_BAR; }
    { G8_LDB(B0, 1, 0); G8_LDA(At, 1, 0); G8_WAIT_V(2); G8_BAR; G8_WAIT_L(0); G8_MMA(0, 0, At, B0); G8_BAR;
      G8_LDB(B1, 1, 1); G8_WAIT_V(0); G8_BAR; G8_WAIT_L(0); G8_MMA(0, 1, At, B1); G8_BAR;
      G8_LDA(At, 1, 1); G8_BAR; G8_WAIT_L(0); G8_MMA(1, 0, At, B0); G8_MMA(1, 1, At, B1); G8_BAR; }
    if (wr == 0) G8_BAR;
    if constexpr (ROWSS) {
#pragma unroll
        for (int ai = 0; ai < 2; ++ai)
#pragma unroll
            for (int m = 0; m < 4; ++m) {
                const int row = brow + ai * HALF + wr * 64 + m * 16 + fr;
                float ssq = 0.f, am = 0.f;
#pragma unroll
                for (int bj = 0; bj < 2; ++bj)
#pragma unroll
                    for (int n = 0; n < 2; ++n) epi(row, bcol + bj * HALF + wc * 32 + n * 16 + fq * 4, g8_cvt<I8>(acc[ai][bj][m][n]), ssq, am);
                ssq += __shfl_xor(ssq, 16);
                ssq += __shfl_xor(ssq, 32);
                am = fmaxf(am, __shfl_xor(am, 16));
                am = fmaxf(am, __shfl_xor(am, 32));
                if (fq == 0) epi.row_done(row, ssq, am);
            }
    } else {
#pragma unroll
        for (int ai = 0; ai < 2; ++ai)
#pragma unroll
            for (int bj = 0; bj < 2; ++bj)
#pragma unroll
                for (int m = 0; m < 4; ++m)
#pragma unroll
                    for (int n = 0; n < 2; ++n) {
                        if (TRANS) epi(brow + ai * HALF + wr * 64 + m * 16 + fq * 4, bcol + bj * HALF + wc * 32 + n * 16 + fr, g8_cvt<I8>(acc[ai][bj][m][n]));
                        else epi(brow + ai * HALF + wr * 64 + m * 16 + fr, bcol + bj * HALF + wc * 32 + n * 16 + fq * 4, g8_cvt<I8>(acc[ai][bj][m][n]));
                    }
    }
#undef G8_SA
#undef G8_SB
#undef G8_STAGE
#undef G8_LDA
#undef G8_LDB
#undef G8_MMA
#undef G8_WAIT_V
#undef G8_WAIT_L
#undef G8_BAR
#undef G8_SCHED
}

__device__ void phase_gemm_in(const Params& p, char* smem) {
    const int nM = NTOK / 256, nN = INW / 256;
    for (int i = 0; i * (int)gridDim.x + (int)blockIdx.x < nM * nN; ++i) {
        int pm, pn;
        g8::tile_of(i * gridDim.x + blockIdx.x, nM, nN, pm, pn);
        if (pn >= 4 && pn < 6) {
            const int bb = (pm * 256) / T, rr = (pm * 256) % T;
            EpiBf16TSStaged e1t{p.vT() + ((size_t)bb * 512 + (pn * 256 - 1024)) * T + rr, p.sa(), p.sb(), smem, pm * 256, pn * 256};
            gemm256_tile<true, false, true>(p.hq(), p.w_in_q(), D, pm * 256, pn * 256, smem, e1t);
            __syncthreads();
            e1t.finish();
        } else {
            EpiBf16SStaged e1{p.z(), INW, p.sa(), p.sb(), smem, pm * 256, pn * 256};
            gemm256_tile<false, false, true>(p.hq(), p.w_in_q(), D, pm * 256, pn * 256, smem, e1);
            __syncthreads();
            e1.finish();
        }
    }
}

__device__ void phase_gemm_kv(const Params& p, char* smh) {
    EpiBf16 e2{p.kvb(), 512};
    EpiBf16T e2t{p.kvT(), 256, 256, 256};
    const bool dedicated = gridDim.x >= 64;
    if (dedicated && blockIdx.x >= 16) return;
    for (int it = VBID; it < 32; it += dedicated ? 32 : VGRID) {
        const int pm = it >> 2, pn = it & 3;
        if (pn >= 2) gemm_tile<true>(p.memn(), D, p.w_kv_t(), D, D, pm * 128, pn * 128, smh, e2t);
        else gemm_tile<false>(p.memn(), D, p.w_kv_t(), D, D, pm * 128, pn * 128, smh, e2);
    }
}

__device__ void phase_gemm_out(const Params& p, char* smem) {
    const int nM = NTOK / 256, nN = D / 256;
    EpiResNorm e{p.x1b(), p.x, p.ffn_g, D, p.ss1(), p.hmax()};
    for (int i = 0; i * (int)gridDim.x + (int)blockIdx.x < nM * nN; ++i) {
        int pm, pn;
        g8::tile_of(i * gridDim.x + blockIdx.x, nM, nN, pm, pn);
        gemm256_tile<false, true, false>(p.mix(), p.w_out_t(), D, pm * 256, pn * 256, smem, e);
    }
}

__device__ void phase_gemm_q(const Params& p, char* smem) {
    const int nM = NTOK / 256, nN = QW / 256;
    EpiBf16RowScale e{p.z(), QW, p.ss1()};
    for (int i = 0; i * (int)gridDim.x + (int)blockIdx.x < nM * nN; ++i) {
        int pm, pn;
        g8::tile_of(i * gridDim.x + blockIdx.x, nM, nN, pm, pn);
        gemm256_tile<false, false, false>(p.h(), p.w_q_t(), D, pm * 256, pn * 256, smem, e);
    }
}

typedef float f32x16 __attribute__((ext_vector_type(16)));
constexpr int HRS = 144;
__device__ __forceinline__ f32x16 tile_mm64(const char* X, const char* Y, int xrow0, int yrow0, int lane, f32x16 acc) {
    const int r = lane & 31, hh = lane >> 5;
#pragma unroll
    for (int ks = 0; ks < 4; ++ks) {
        const bf16x8 a = *(const bf16x8*)(X + (xrow0 + r) * HRS + ks * 32 + hh * 16);
        const bf16x8 b = *(const bf16x8*)(Y + (yrow0 + r) * HRS + ks * 32 + hh * 16);
        acc = __builtin_amdgcn_mfma_f32_32x32x16_bf16(a, b, acc, 0, 0, 0);
    }
    return acc;
}
__device__ __forceinline__ int crow(int reg, int hh) { return (reg & 3) + 8 * (reg >> 2) + 4 * hh; }

__device__ __forceinline__ void hg_load_vt(const Params& p, char* sVT, int tok0, int h, int kcol, int sq) {
    const bf16_t* zp = p.z() + (size_t)(tok0 + sq * 16) * INW + 2304 + h * 64 + kcol;
    unsigned pk[8];
#pragma unroll
    for (int j = 0; j < 8; ++j) {
        const unsigned lo = zp[(size_t)(2 * j) * INW], hi = zp[(size_t)(2 * j + 1) * INW];
        pk[j] = lo | (hi << 16);
    }
    *(uint4*)(sVT + kcol * HRS + sq * 32) = make_uint4(pk[0], pk[1], pk[2], pk[3]);
    *(uint4*)(sVT + kcol * HRS + sq * 32 + 16) = make_uint4(pk[4], pk[5], pk[6], pk[7]);
}

__device__ __forceinline__ float hg_gates(const Params& p, float* sTot, int tok0, int h, int dir, int kcol, int sq, float (&bj)[16], float (&kk)[16]) {
    const bf16_t* zp = p.z() + (size_t)(tok0 + sq * 16) * INW + 1792 + dir * 256 + h * 64 + kcol;
    const float lbv = p.lb()[dir * 256 + h * 64 + kcol];
#pragma unroll
    for (int j = 0; j < 16; ++j) {
        const float pre = bf2f(zp[(size_t)j * INW]);
        const float f = lbv + (1.0f - lbv) * (1.0f / (1.0f + __expf(-pre)));
        bj[j] = __logf(f);
        kk[j] = 1.0f - f;
    }
    if (dir == 0) {
#pragma unroll
        for (int j = 1; j < 16; ++j) bj[j] += bj[j - 1];
        sTot[sq * 64 + kcol] = bj[15];
    } else {
#pragma unroll
        for (int j = 14; j >= 0; --j) bj[j] += bj[j + 1];
        sTot[sq * 64 + kcol] = bj[0];
    }
    __syncthreads();
    const float t0 = sTot[kcol], t1 = sTot[64 + kcol], t2 = sTot[128 + kcol], t3 = sTot[192 + kcol];
    float off;
    if (dir == 0) off = (sq > 0 ? t0 : 0.f) + (sq > 1 ? t1 : 0.f) + (sq > 2 ? t2 : 0.f);
    else off = (sq < 3 ? t3 : 0.f) + (sq < 2 ? t2 : 0.f) + (sq < 1 ? t1 : 0.f);
#pragma unroll
    for (int j = 0; j < 16; ++j) bj[j] += off;
    return t0 + t1 + t2 + t3;
}

__device__ void hg_local(const Params& p, char* smem) {
    char* sVT = smem;
    char* sKT = smem + 9216;
    float* sTot = (float*)(smem + 18432);
    const int tid = VTID, lane = tid & 63, w = tid >> 6;
    const int kcol = tid & 63, sq = tid >> 6;
    for (int item = VBID; item < 4096; item += VGRID) {
        const int c = item & 127, dir = (item >> 7) & 1, h = (item >> 8) & 3, b = item >> 10;
        const int tok0 = b * T + c * 64;
        __syncthreads();
        hg_load_vt(p, sVT, tok0, h, kcol, sq);
        float bj[16], kk[16];
        const float btot = hg_gates(p, sTot, tok0, h, dir, kcol, sq, bj, kk);
        unsigned pk[8];
#pragma unroll
        for (int j = 0; j < 8; ++j)
            pk[j] = pack2(kk[2 * j] * __expf(btot - bj[2 * j]), kk[2 * j + 1] * __expf(btot - bj[2 * j + 1]));
        *(uint4*)(sKT + kcol * HRS + sq * 32) = make_uint4(pk[0], pk[1], pk[2], pk[3]);
        *(uint4*)(sKT + kcol * HRS + sq * 32 + 16) = make_uint4(pk[4], pk[5], pk[6], pk[7]);
        if (sq == 0) p.hdec()[item * 64 + kcol] = __expf(btot);
        __syncthreads();
        const int vi = w >> 1, ki = w & 1, hh = lane >> 5;
        f32x16 acc;
#pragma unroll
        for (int r = 0; r < 16; ++r) acc[r] = 0.f;
        acc = tile_mm64(sVT, sKT, vi * 32, ki * 32, lane, acc);
        bf16_t* dst = (bf16_t*)p.hstate() + (size_t)item * 4096 + ki * 32 + (lane & 31);
#pragma unroll
        for (int r = 0; r < 16; ++r) dst[(vi * 32 + crow(r, hh)) * 64] = f2bf(acc[r]);
    }
}

__device__ __forceinline__ bf16x8 pack8(const f32x16& x, int s8) {
    typedef unsigned u32x4_t __attribute__((ext_vector_type(4)));
    u32x4_t pk;
    pk[0] = pack2(x[s8], x[s8 + 1]); pk[1] = pack2(x[s8 + 2], x[s8 + 3]);
    pk[2] = pack2(x[s8 + 4], x[s8 + 5]); pk[3] = pack2(x[s8 + 6], x[s8 + 7]);
    return __builtin_bit_cast(bf16x8, pk);
}
__device__ __forceinline__ bf16x8 join8(const uint2& lo, const uint2& hi) {
    typedef unsigned u32x4_t __attribute__((ext_vector_type(4)));
    u32x4_t pk; pk[0] = lo.x; pk[1] = lo.y; pk[2] = hi.x; pk[3] = hi.y;
    return __builtin_bit_cast(bf16x8, pk);
}

__device__ __forceinline__ int swap23(int r) { return (r & ~12) | ((r & 4) << 1) | ((r & 8) >> 1); }

__device__ __forceinline__ void mem_attn_wave(const Params& p, int wu, int lane, const char* sK, const char* sV) {
    const int tile = wu & 255, h = (wu >> 8) & 3, b = wu >> 10;
    const int l31 = lane & 31, hh = lane >> 5;
    const int tok = b * T + tile * 32 + l31;
    bf16x8 qf[4];
#pragma unroll
    for (int ks = 0; ks < 4; ++ks) qf[ks] = *(const bf16x8*)(p.z() + (size_t)tok * INW + 2816 + h * 64 + ks * 16 + hh * 8);
    const char* kb = sK + swap23(l31) * 144 + hh * 16;
    float m = -1e30f;
    f32x16 o0, o1;
#pragma unroll
    for (int r = 0; r < 16; ++r) { o0[r] = 0.f; o1[r] = 0.f; }
    float sum = 0.f;
    const char* vt = sV + l31 * 528 + hh * 16;
#pragma unroll 2
    for (int kt = 0; kt < 8; ++kt) {
        bf16x8 kf[4], vf[4];
#pragma unroll
        for (int ks = 0; ks < 4; ++ks) kf[ks] = *(const bf16x8*)(kb + kt * 32 * 144 + ks * 32);
#pragma unroll
        for (int st = 0; st < 2; ++st) { vf[2 * st] = *(const bf16x8*)(vt + kt * 64 + st * 32); vf[2 * st + 1] = *(const bf16x8*)(vt + 32 * 528 + kt * 64 + st * 32); }
        f32x16 s;
#pragma unroll
        for (int r = 0; r < 16; ++r) s[r] = 0.f;
#pragma unroll
        for (int ks = 0; ks < 4; ++ks) s = __builtin_amdgcn_mfma_f32_32x32x16_bf16(kf[ks], qf[ks], s, 0, 0, 0);
        float tm = s[0];
#pragma unroll
        for (int r = 1; r < 16; ++r) tm = fmaxf(tm, s[r]);
        tm = fmaxf(tm, __shfl_xor(tm, 32));
        const float mn = fmaxf(m, tm);
        if (__any(mn > m)) {
            const float sc = __builtin_amdgcn_exp2f((m - mn) * 0.18033688011112042f);
            sum *= sc;
#pragma unroll
            for (int r = 0; r < 16; ++r) { o0[r] *= sc; o1[r] *= sc; }
        }
        m = mn;
        const float mb = mn * 0.18033688011112042f;
#pragma unroll
        for (int r = 0; r < 16; ++r) { s[r] = __builtin_amdgcn_exp2f(fmaf(s[r], 0.18033688011112042f, -mb)); sum += s[r]; }
#pragma unroll
        for (int st = 0; st < 2; ++st) {
            const bf16x8 pb = pack8(s, st * 8);
            o0 = __builtin_amdgcn_mfma_f32_32x32x16_bf16(vf[2 * st], pb, o0, 0, 0, 0);
            o1 = __builtin_amdgcn_mfma_f32_32x32x16_bf16(vf[2 * st + 1], pb, o1, 0, 0, 0);
        }
    }
    sum += __shfl_xor(sum, 32);
    const float inv = 1.0f / sum;
    bf16_t* mo = p.mix() + (size_t)tok * D + 768 + h * 64 + 4 * hh;
#pragma unroll
    for (int g = 0; g < 4; ++g) {
        uint2 pk;
        pk.x = pack2(o0[4 * g] * inv, o0[4 * g + 1] * inv); pk.y = pack2(o0[4 * g + 2] * inv, o0[4 * g + 3] * inv);
        *(uint2*)(mo + 8 * g) = pk;
        pk.x = pack2(o1[4 * g] * inv, o1[4 * g + 1] * inv); pk.y = pack2(o1[4 * g + 2] * inv, o1[4 * g + 3] * inv);
        *(uint2*)(mo + 32 + 8 * g) = pk;
    }
}

struct NaCtx {
    const bf16_t* kbase; const bf16_t* vbase; const float* bh;
    int rs, r, c, c0, cb, hh;
    bf16x8 qf[4];
    float m, sum;
    f32x16 o0, o1;
};
template <int TI>
__device__ __forceinline__ void na_load(const NaCtx& x, bf16x8 (&kf)[4], bf16x8 (&vf)[4]) {
    constexpr int ip = TI / 3, cg = TI % 3;
    const bf16_t* kp = x.kbase + (size_t)(ip * 128 + cg * 16) * INW;
#pragma unroll
    for (int ks = 0; ks < 4; ++ks) kf[ks] = *(const bf16x8*)(kp + ks * 16);
    const bf16_t* vr = x.vbase + ip * 128 + cg * 16;
#pragma unroll
    for (int st = 0; st < 2; ++st) { vf[2 * st] = *(const bf16x8*)(vr + st * 64); vf[2 * st + 1] = *(const bf16x8*)(vr + (size_t)32 * T + st * 64); }
}
template <int TI>
__device__ __forceinline__ void na_comp(NaCtx& x, const bf16x8 (&kf)[4], const bf16x8 (&vf)[4]) {
    constexpr int ip = TI / 3, cg = TI % 3;
    f32x16 s;
#pragma unroll
    for (int q = 0; q < 16; ++q) s[q] = 0.f;
#pragma unroll
    for (int ks = 0; ks < 4; ++ks) s = __builtin_amdgcn_mfma_f32_32x32x16_bf16(kf[ks], x.qf[ks], s, 0, 0, 0);
    const int kc0 = x.cb + 16 * cg + 8 * x.hh;
    const float* brow = x.bh + (x.rs + 2 * ip - x.r + 7) * 31 + 15 - x.c + kc0;
    const int d0 = kc0 - x.c0;
    float tm = -1e30f;
    float bv[16];
#pragma unroll
    for (int q = 0; q < 16; ++q) bv[q] = brow[(q & 3) + 4 * ((q >> 2) & 1) + 31 * (q >> 3)];
#pragma unroll
    for (int q = 0; q < 16; ++q) asm volatile("" : "+v"(bv[q]));
#pragma unroll
    for (int q = 0; q < 16; ++q) {
        const int cq = (q & 3) + 4 * ((q >> 2) & 1);
        const bool valid = (unsigned)(d0 + cq) < 16u;
        const float sc = valid ? fmaf(s[q], 0.18033688011112042f, bv[q]) : -INFINITY;
        s[q] = sc;
        tm = fmaxf(tm, sc);
    }
    tm = fmaxf(tm, __shfl_xor(tm, 32));
    const float mn = fmaxf(x.m, tm);
    if (__any(mn > x.m)) {
        const float scl = __builtin_amdgcn_exp2f(x.m - mn);
        x.sum *= scl;
#pragma unroll
        for (int q = 0; q < 16; ++q) { x.o0[q] *= scl; x.o1[q] *= scl; }
    }
    x.m = mn;
#pragma unroll
    for (int q = 0; q < 16; ++q) { const float pe = __builtin_amdgcn_exp2f(s[q] - mn); s[q] = pe; x.sum += pe; }
#pragma unroll
    for (int st = 0; st < 2; ++st) {
        const bf16x8 pb = pack8(s, st * 8);
        x.o0 = __builtin_amdgcn_mfma_f32_32x32x16_bf16(vf[2 * st], pb, x.o0, 0, 0, 0);
        x.o1 = __builtin_amdgcn_mfma_f32_32x32x16_bf16(vf[2 * st + 1], pb, x.o1, 0, 0, 0);
    }
}

__device__ __forceinline__ void na_attn_wave(const Params& p, int wu, int lane, const float* sbias) {
    const int j = wu & 1, h = (wu >> 1) & 7, r = (wu >> 4) & 127, b = wu >> 11;
    const int l31 = lane & 31, hh = lane >> 5;
    NaCtx x;
    x.hh = hh; x.r = r;
    x.c = 32 * j + l31;
    x.c0 = min(max(x.c - 8, 0), 48); x.rs = min(max(r - 4, 0), 120);
    const int tokq = b * T + r * 64 + x.c;
    x.cb = 16 * j;
#pragma unroll
    for (int ks = 0; ks < 4; ++ks) x.qf[ks] = *(const bf16x8*)(p.z() + (size_t)tokq * INW + h * 64 + ks * 16 + hh * 8);
    x.bh = sbias + 64 + h * 465;
    const int kap = swap23(l31);
    x.kbase = p.z() + (size_t)(b * T + (x.rs + (kap >> 4)) * 64 + x.cb + (kap & 15)) * INW + 512 + h * 64 + hh * 8;
    x.vbase = p.vT() + ((size_t)(b * 8 + h) * 64 + l31) * T + x.rs * 64 + x.cb + 8 * hh;
    x.m = -1e30f; x.sum = 0.f;
#pragma unroll
    for (int q = 0; q < 16; ++q) { x.o0[q] = 0.f; x.o1[q] = 0.f; }
    bf16x8 k0[4], v0[4], k1[4], v1[4], k2[4], v2[4], k3[4], v3[4];
    na_load<0>(x, k0, v0); na_load<1>(x, k1, v1); na_load<2>(x, k2, v2);
    na_load<3>(x, k3, v3);  na_comp<0>(x, k0, v0);
    na_load<4>(x, k0, v0);  na_comp<1>(x, k1, v1);
    na_load<5>(x, k1, v1);  na_comp<2>(x, k2, v2);
    na_load<6>(x, k2, v2);  na_comp<3>(x, k3, v3);
    na_load<7>(x, k3, v3);  na_comp<4>(x, k0, v0);
    na_load<8>(x, k0, v0);  na_comp<5>(x, k1, v1);
    na_load<9>(x, k1, v1);  na_comp<6>(x, k2, v2);
    na_load<10>(x, k2, v2); na_comp<7>(x, k3, v3);
    na_load<11>(x, k3, v3); na_comp<8>(x, k0, v0);
    na_comp<9>(x, k1, v1);
    na_comp<10>(x, k2, v2);
    na_comp<11>(x, k3, v3);
    float sum = x.sum;
    sum += __shfl_xor(sum, 32);
    const float inv = 1.0f / sum;
    bf16_t* mo = p.mix() + (size_t)tokq * D + h * 64 + 4 * hh;
#pragma unroll
    for (int g = 0; g < 4; ++g) {
        uint2 pk;
        pk.x = pack2(x.o0[4 * g] * inv, x.o0[4 * g + 1] * inv); pk.y = pack2(x.o0[4 * g + 2] * inv, x.o0[4 * g + 3] * inv);
        *(uint2*)(mo + 8 * g) = pk;
        pk.x = pack2(x.o1[4 * g] * inv, x.o1[4 * g + 1] * inv); pk.y = pack2(x.o1[4 * g + 2] * inv, x.o1[4 * g + 3] * inv);
        *(uint2*)(mo + 32 + 8 * g) = pk;
    }
}

__device__ void phase_mixers(const Params& p, char* smem) {
    const int tid = VTID, lane = tid & 63, w = tid >> 6;
    {
        float* sbias = (float*)smem;
        __syncthreads();
        for (int i = tid; i < 8 * 465; i += 256) sbias[64 + i] = p.rpb[i] * 1.4426950408889634f;
        __syncthreads();
        for (int wu = VBID * 4 + w; wu < 8192; wu += VGRID * 4) na_attn_wave(p, wu, lane, sbias);
    }
    __syncthreads();
    hg_local(p, smem);
}

__device__ void phase_hg_scan(const Params& p) {
    const int tid = VTID;
    const int skip = gridDim.x >= 64 ? 32 : 0;
    if (VBID < skip) return;
    for (int item = VBID - skip; item < 512; item += VGRID - skip) {
        const int g = item * 256 + tid;
        const int seq = g >> 12, kv = g & 4095, k = kv & 63;
        const int dir = seq & 1;
        float S = 0.f;
        for (int cc0 = 0; cc0 < 128; cc0 += 8) {
            float L[8], d[8];
#pragma unroll
            for (int u = 0; u < 8; ++u) {
                const int c = dir ? 127 - (cc0 + u) : cc0 + u;
                const size_t it = (size_t)seq * 128 + c;
                L[u] = bf2f(((const bf16_t*)p.hstate())[it * 4096 + kv]);
                d[u] = p.hdec()[it * 64 + k];
            }
#pragma unroll
            for (int u = 0; u < 8; ++u) {
                const int c = dir ? 127 - (cc0 + u) : cc0 + u;
                const size_t it = (size_t)seq * 128 + c;
                ((bf16_t*)p.h())[it * 4096 + kv] = f2bf(S);
                S = d[u] * S + L[u];
            }
        }
    }
}

__device__ void phase_hg_out(const Params& p, char* smem) {
    char* sQt = smem;
    char* sKt = smem + 9216;
    char* sQh = smem + 18432;
    char* sVT = smem + 27648;
    char* sST = smem + 36864;
    char* sP = smem + 46080;
    float* sTot = (float*)(smem + 55296);
    float* sSS = sTot + 256;
    const int tid = VTID, lane = tid & 63, w = tid >> 6;
    const int kcol = tid & 63, sq = tid >> 6;
    const int l31 = lane & 31, hh = lane >> 5;
    for (int item = VBID; item < 2048; item += VGRID) {
        const int c = item & 127, h = (item >> 7) & 3, b = item >> 9;
        const int tok0 = b * T + c * 64;
        __syncthreads();
        hg_load_vt(p, sVT, tok0, h, kcol, sq);
        float qv[16];
        {
            const bf16_t* zp = p.z() + (size_t)(tok0 + sq * 16) * INW + 1536 + h * 64 + kcol;
#pragma unroll
            for (int j = 0; j < 16; ++j) qv[j] = bf2f(zp[(size_t)j * INW]);
        }
        f32x16 accO;
#pragma unroll
        for (int r = 0; r < 16; ++r) accO[r] = 0.f;
        for (int dir = 0; dir < 2; ++dir) {
            float bj[16], kk[16];
            const float btot = hg_gates(p, sTot, tok0, h, dir, kcol, sq, bj, kk);
            const float bref = 0.5f * btot;
#pragma unroll
            for (int j = 0; j < 16; ++j) {
                const int s = sq * 16 + j;
                *(bf16_t*)(sQt + s * HRS + kcol * 2) = f2bf(qv[j] * __expf(bj[j] - bref));
                *(bf16_t*)(sKt + s * HRS + kcol * 2) = f2bf(kk[j] * __expf(bref - bj[j]));
                *(bf16_t*)(sQh + s * HRS + kcol * 2) = f2bf(qv[j] * __expf(bj[j]));
            }
            {
                const bf16_t* sp = (const bf16_t*)p.h() + ((size_t)(((b * 4 + h) * 2 + dir) * 128 + c)) * 4096;
#pragma unroll
                for (int i = 0; i < 4; ++i) {
                    const int idx = tid * 4 + 1024 * i;
                    *(uint2*)(sST + (idx >> 6) * HRS + (idx & 63) * 2) = *(const uint2*)(sp + idx);
                }
            }
            __syncthreads();
            {
                const int si = w >> 1, ti = w & 1;
                const bool live = dir == 0 ? (si <= ti) : (si >= ti);
                f32x16 pt;
#pragma unroll
                for (int r = 0; r < 16; ++r) pt[r] = 0.f;
                if (live) pt = tile_mm64(sKt, sQt, si * 32, ti * 32, lane, pt);
                const int t = ti * 32 + l31;
#pragma unroll
                for (int g = 0; g < 4; ++g) {
                    const int s0 = si * 32 + 8 * g + 4 * hh;
                    float v0 = pt[4 * g], v1 = pt[4 * g + 1], v2 = pt[4 * g + 2], v3 = pt[4 * g + 3];
                    if (dir == 0) {
                        if (s0 > t) v0 = 0.f; if (s0 + 1 > t) v1 = 0.f; if (s0 + 2 > t) v2 = 0.f; if (s0 + 3 > t) v3 = 0.f;
                    } else {
                        if (s0 < t) v0 = 0.f; if (s0 + 1 < t) v1 = 0.f; if (s0 + 2 < t) v2 = 0.f; if (s0 + 3 < t) v3 = 0.f;
                    }
                    uint2 pk; pk.x = pack2(v0, v1); pk.y = pack2(v2, v3);
                    *(uint2*)(sP + t * HRS + s0 * 2) = pk;
                }
            }
            __syncthreads();
            {
                const int vi = w >> 1, ti = w & 1;
                accO = tile_mm64(sVT, sP, vi * 32, ti * 32, lane, accO);
                accO = tile_mm64(sST, sQh, vi * 32, ti * 32, lane, accO);
            }
            __syncthreads();
        }
        const int vi = w >> 1, ti = w & 1;
        float ssq = 0.f;
#pragma unroll
        for (int r = 0; r < 16; ++r) ssq += accO[r] * accO[r];
        ssq += __shfl_xor(ssq, 32);
        sSS[w * 64 + lane] = ssq;
        __syncthreads();
        const float tot = sSS[ti * 64 + l31] + sSS[(2 + ti) * 64 + l31];
        const float rs = rsqrtf(tot * (1.0f / 64.0f) + EPS);
        const int tok = tok0 + ti * 32 + l31;
#pragma unroll
        for (int g = 0; g < 4; ++g) {
            const int v0 = vi * 32 + 8 * g + 4 * hh;
            const uint2 gz = *(const uint2*)(p.z() + (size_t)tok * INW + 2560 + h * 64 + v0);
            const float4 gn = *(const float4*)(p.hg_g + h * 64 + v0);
            const float g0 = bflo(gz.x), g1 = bfhi(gz.x), g2 = bflo(gz.y), g3 = bfhi(gz.y);
            const float o0 = accO[4 * g] * rs * gn.x * (g0 / (1.0f + __expf(-g0)));
            const float o1 = accO[4 * g + 1] * rs * gn.y * (g1 / (1.0f + __expf(-g1)));
            const float o2 = accO[4 * g + 2] * rs * gn.z * (g2 / (1.0f + __expf(-g2)));
            const float o3 = accO[4 * g + 3] * rs * gn.w * (g3 / (1.0f + __expf(-g3)));
            uint2 pk; pk.x = pack2(o0, o1); pk.y = pack2(o2, o3);
            *(uint2*)(p.mix() + (size_t)tok * D + 512 + h * 64 + v0) = pk;
        }
    }
    for (int base = VBID * 4; base < 4096; base += VGRID * 4) {
        const int h = (base >> 8) & 3, b = base >> 10;
        char* sK = smem;
        char* sV = smem + 36864;
        __syncthreads();
        {
            uint4 kk[8], vv[8];
#pragma unroll
            for (int i = 0; i < 8; ++i) {
                const int ch = tid + 256 * i;
                kk[i] = *(const uint4*)(p.kvb() + (size_t)(b * 256 + (ch >> 3)) * 512 + h * 64 + (ch & 7) * 8);
                vv[i] = *(const uint4*)(p.kvT() + ((size_t)(b * 4 + h) * 64 + (ch >> 5)) * 256 + (ch & 31) * 8);
            }
#pragma unroll
            for (int i = 0; i < 8; ++i) {
                const int ch = tid + 256 * i;
                *(uint4*)(sK + (ch >> 3) * 144 + (ch & 7) * 16) = kk[i];
                *(uint4*)(sV + (ch >> 5) * 528 + (ch & 31) * 16) = vv[i];
            }
        }
        __syncthreads();
        mem_attn_wave(p, base + w, lane, sK, sV);
    }
}


__device__ __forceinline__ int ord_key(int fb) { return fb ^ ((fb >> 31) & 0x7FFFFFFF); }

template <int N>
__device__ __forceinline__ void bitonic_sort_desc(int (&v)[N]) {
#pragma unroll
    for (int k = 2; k <= N; k <<= 1) {
#pragma unroll
        for (int j = k >> 1; j > 0; j >>= 1) {
#pragma unroll
            for (int i = 0; i < N; ++i) {
                const int l = i ^ j;
                if (l > i) {
                    const bool desc = ((i & k) == 0);
                    const int a = v[i], b = v[l];
                    const int mx = max(a, b), mn = min(a, b);
                    v[i] = desc ? mx : mn;
                    v[l] = desc ? mn : mx;
                }
            }
        }
    }
}
template <int N>
__device__ __forceinline__ void bitonic_merge_desc(int (&v)[N]) {
#pragma unroll
    for (int j = N >> 1; j > 0; j >>= 1) {
#pragma unroll
        for (int i = 0; i < N; ++i) {
            const int l = i ^ j;
            if (l > i) {
                const int a = v[i], b = v[l];
                v[i] = max(a, b);
                v[l] = min(a, b);
            }
        }
    }
}
__device__ __forceinline__ void merge_prune16(int (&r)[16], const int (&o)[16]) {
#pragma unroll
    for (int i = 0; i < 16; ++i) r[i] = max(r[i], o[15 - i]);
    bitonic_merge_desc<16>(r);
}

constexpr int QRS = 528;
struct EpiQpLds {
    char* qt; const float* ssrow; const unsigned* hmax; const float* sb; int brow, bcol;
    __device__ __forceinline__ void operator()(int row, int col, const f32x4& v) const {
        const float rs = rsqrtf(ssrow[row] * (1.0f / 1024.0f) + EPS) * __uint_as_float(hmax[row]) * (1.0f / 127.0f);
        const float4 b = *(const float4*)(sb + col);
        uint2 pk; pk.x = pack2(v[0] * rs * b.x, v[1] * rs * b.y); pk.y = pack2(v[2] * rs * b.z, v[3] * rs * b.w);
        *(uint2*)(qt + (row - brow) * QRS + (col - bcol) * 2) = pk;
    }
};
__device__ __forceinline__ int* route_slot(char* wrows, int e) { return (int*)(wrows + (e >> 6) * QRS + (e & 63) * 4); }

__device__ __forceinline__ void route_tile(const Params& p, char* qt, int tok0, int h) {
    const int tid = threadIdx.x, lane = tid & 63, w = tid >> 6;
    const int tl = lane & 31, hh = lane >> 5;
    char* wrows = qt + (w * 32) * QRS;
    const int tok = tok0 + w * 32 + tl;
    const bf16_t* sp = p.subk_b() + (size_t)(h * 2) * 16384 + tl * 128 + hh * 8;
    bf16x8 an[8];
#pragma unroll
    for (int ks = 0; ks < 8; ++ks) an[ks] = *(const bf16x8*)(sp + ks * 16);
#pragma unroll
    for (int c = 0; c < 2; ++c) {
        bf16x8 qf[8];
#pragma unroll
        for (int ks = 0; ks < 8; ++ks) qf[ks] = *(const bf16x8*)(wrows + tl * QRS + (c * 128 + ks * 16 + hh * 8) * 2);
        int cur[16];
#pragma unroll
        for (int kb = 0; kb < 4; ++kb) {
            bf16x8 af[8];
#pragma unroll
            for (int ks = 0; ks < 8; ++ks) af[ks] = an[ks];
            if (c * 4 + kb + 1 < 8) {
                const bf16_t* sn = sp + (c * 4 + kb + 1) * 4096;
#pragma unroll
                for (int ks = 0; ks < 8; ++ks) an[ks] = *(const bf16x8*)(sn + ks * 16);
            }
            f32x16 acc;
#pragma unroll
            for (int r = 0; r < 16; ++r) acc[r] = 0.f;
#pragma unroll
            for (int ks = 0; ks < 8; ++ks) acc = __builtin_amdgcn_mfma_f32_32x32x16_bf16(af[ks], qf[ks], acc, 0, 0, 0);
            int v[16];
#pragma unroll
            for (int r = 0; r < 16; ++r) {
                const int key = kb * 32 + (r & 3) + 8 * (r >> 2) + 4 * hh;
                const int fb = (__float_as_int(acc[r]) & ~127) | (127 - key);
                v[r] = ord_key(fb);
            }
            bitonic_sort_desc<16>(v);
            if (kb == 0) {
#pragma unroll
                for (int r = 0; r < 16; ++r) cur[r] = v[r];
            } else {
                merge_prune16(cur, v);
            }
            __builtin_amdgcn_sched_barrier(0);
        }
        {
            int o[16];
#pragma unroll
            for (int r = 0; r < 16; ++r) o[r] = __shfl_xor(cur[r], 32);
            merge_prune16(cur, o);
        }
#pragma unroll
        for (int r = 0; r < 16; ++r) *route_slot(wrows, c * 512 + r * 32 + tl) = cur[r];
        __builtin_amdgcn_sched_barrier(0);
    }
    float va[16], vb[16];
#pragma unroll
    for (int r = 0; r < 16; ++r) {
        const int fa = ord_key(*route_slot(wrows, r * 32 + tl)), fb = ord_key(*route_slot(wrows, 512 + r * 32 + tl));
        va[r] = __int_as_float(fa & ~127);
        vb[r] = __int_as_float(fb & ~127);
    }
    int best[16];
#pragma unroll
    for (int j = 0; j < 16; ++j) best[j] = ord_key((__float_as_int(va[0] + vb[j]) & ~255) | (255 - j));
#pragma unroll
    for (int i = 1; i < 8; ++i) {
        const int n = 16 / (i + 1);
        int row[16];
#pragma unroll
        for (int j = 0; j < 16; ++j)
            row[j] = (j < n) ? ord_key((__float_as_int(va[i] + vb[j]) & ~255) | (255 - (i * 16 + j))) : (int)0x80000000;
        merge_prune16(best, row);
    }
    {
        int row[16];
#pragma unroll
        for (int j = 0; j < 16; ++j)
            row[j] = (j < 8) ? ord_key((__float_as_int(va[8 + j] + vb[0]) & ~255) | (255 - ((8 + j) * 16))) : (int)0x80000000;
        merge_prune16(best, row);
    }
    float sv[16];
    int pid[16];
#pragma unroll
    for (int r = 0; r < 16; ++r) {
        const int cb = ord_key(best[r]);
        sv[r] = __int_as_float(cb & ~255);
        pid[r] = 255 - (cb & 255);
    }
    float tot = 0.f;
    const float smax = sv[0];
#pragma unroll
    for (int r = 0; r < 16; ++r) { sv[r] = __expf(sv[r] - smax); tot += sv[r]; }
    const float inv = 1.0f / tot;
    if (hh == 0) {
#pragma unroll
        for (int r = 0; r < 16; ++r) {
            const int ia = 127 - (ord_key(*route_slot(wrows, (pid[r] >> 4) * 32 + tl)) & 127);
            const int ib = 127 - (ord_key(*route_slot(wrows, 512 + (pid[r] & 15) * 32 + tl)) & 127);
            const int pos = (r & 7) * 16 + h * 2 + (r >> 3);
            p.eidx()[(size_t)tok * 128 + pos] = (unsigned short)(ia * 128 + ib);
            p.gate()[(size_t)tok * 128 + pos] = sv[r] * inv;
        }
    }
}

__device__ void phase_gemm_q_route(const Params& p, char* smem) {
    const int nM = NTOK / 256, nN = QW / 256;
    for (int i = 0; i * (int)gridDim.x + (int)blockIdx.x < nM * nN; ++i) {
        int pm, pn;
        g8::tile_of(i * gridDim.x + blockIdx.x, nM, nN, pm, pn);
        EpiQpLds e{smem, p.ss1(), p.hmax(), p.sb() + INW, pm * 256, pn * 256};
        gemm256_tile<false, false, true>(p.h2q(), p.w_q_q(), D, pm * 256, pn * 256, smem, e);
        __syncthreads();
        route_tile(p, smem, pm * 256, pn);
    }
}

__device__ void phase_route(const Params& p, char* smem) {
    char* sk = smem;
    const int tid = VTID, lane = tid & 63, w = tid >> 6;
    int* sA = (int*)(smem + 32768) + w * 2048;
    int* sB = (int*)(smem + 65536) + w * 512;
    const int tl = lane & 31, hh = lane >> 5;
    const int h = VBID & 7, tg0 = VBID >> 3, tgs = VGRID >> 3;
    for (int base = tg0; base < 256; base += 4 * tgs)
    for (int c = 0; c < 2; ++c) {
        const int hc = h * 2 + c;
        __syncthreads();
        {
            const bf16_t* sp = p.subk_b() + (size_t)hc * 16384;
#pragma unroll
            for (int i = 0; i < 8; ++i) {
                const int ch = tid + 256 * i;
                const int row = ch >> 4, cc = ch & 15;
                const uint4 v = *(const uint4*)(sp + row * 128 + cc * 8);
                *(uint4*)(sk + row * 256 + ((cc ^ (row & 15)) << 4)) = v;
            }
        }
        __syncthreads();
        bf16x8 qf[8];
        if (base < 256) {
            const bf16_t* qr = p.z() + (size_t)(base * 128 + w * 32 + tl) * QW + hc * 128 + hh * 8;
#pragma unroll
            for (int ks = 0; ks < 8; ++ks) qf[ks] = *(const bf16x8*)(qr + ks * 16);
        }
        for (int it = 0; it < 4; ++it) {
            const int tgp = base + it * tgs;
            if (tgp >= 256) break;
            const int tok = tgp * 128 + w * 32 + tl;
            int* sidx = sA + it * 512;
            f32x16 acc4[4];
#pragma unroll
            for (int kb = 0; kb < 4; ++kb) {
#pragma unroll
                for (int r = 0; r < 16; ++r) acc4[kb][r] = 0.f;
                const int row = kb * 32 + tl;
#pragma unroll
                for (int ks = 0; ks < 8; ++ks) {
                    const bf16x8 af = *(const bf16x8*)(sk + row * 256 + (((ks * 2 + hh) ^ (row & 15)) << 4));
                    acc4[kb] = __builtin_amdgcn_mfma_f32_32x32x16_bf16(af, qf[ks], acc4[kb], 0, 0, 0);
                }
            }
            if (it + 1 < 4 && tgp + tgs < 256) {
                const bf16_t* qr = p.z() + (size_t)((tgp + tgs) * 128 + w * 32 + tl) * QW + hc * 128 + hh * 8;
#pragma unroll
                for (int ks = 0; ks < 8; ++ks) qf[ks] = *(const bf16x8*)(qr + ks * 16);
            }
            int cur[16];
#pragma unroll
            for (int kb = 0; kb < 4; ++kb) {
                int v[16];
#pragma unroll
                for (int r = 0; r < 16; ++r) {
                    const int key = kb * 32 + (r & 3) + 8 * (r >> 2) + 4 * hh;
                    const int fb = (__float_as_int(acc4[kb][r]) & ~127) | (127 - key);
                    v[r] = ord_key(fb);
                }
                bitonic_sort_desc<16>(v);
                if (kb == 0) {
#pragma unroll
                    for (int r = 0; r < 16; ++r) cur[r] = v[r];
                } else {
                    merge_prune16(cur, v);
                }
            }
            {
                int o[16];
#pragma unroll
                for (int r = 0; r < 16; ++r) o[r] = __shfl_xor(cur[r], 32);
                merge_prune16(cur, o);
            }
            if (c == 0) {
#pragma unroll
                for (int r = 0; r < 16; ++r) sidx[r * 32 + tl] = cur[r];
                continue;
            }
#pragma unroll
            for (int r = 0; r < 16; ++r) sB[r * 32 + tl] = cur[r];
        float va[16], vb[16];
#pragma unroll
        for (int r = 0; r < 16; ++r) {
            const int fa = ord_key(sidx[r * 32 + tl]), fb = ord_key(sB[r * 32 + tl]);
            va[r] = __int_as_float(fa & ~127);
            vb[r] = __int_as_float(fb & ~127);
        }
        int best[16];
#pragma unroll
        for (int j = 0; j < 16; ++j) best[j] = ord_key((__float_as_int(va[0] + vb[j]) & ~255) | (255 - j));
#pragma unroll
        for (int i = 1; i < 8; ++i) {
            const int n = 16 / (i + 1);
            int row[16];
#pragma unroll
            for (int j = 0; j < 16; ++j)
                row[j] = (j < n) ? ord_key((__float_as_int(va[i] + vb[j]) & ~255) | (255 - (i * 16 + j))) : (int)0x80000000;
            merge_prune16(best, row);
        }
        {
            int row[16];
#pragma unroll
            for (int j = 0; j < 16; ++j)
                row[j] = (j < 8) ? ord_key((__float_as_int(va[8 + j] + vb[0]) & ~255) | (255 - ((8 + j) * 16))) : (int)0x80000000;
            merge_prune16(best, row);
        }
        float sv[16];
        int pid[16];
#pragma unroll
        for (int r = 0; r < 16; ++r) {
            const int cb = ord_key(best[r]);
            sv[r] = __int_as_float(cb & ~255);
            pid[r] = 255 - (cb & 255);
        }
        float tot = 0.f;
        const float smax = sv[0];
#pragma unroll
        for (int r = 0; r < 16; ++r) { sv[r] = __expf(sv[r] - smax); tot += sv[r]; }
        const float inv = 1.0f / tot;
        if (hh == 0) {
#pragma unroll
            for (int r = 0; r < 16; ++r) {
                const int ia = 127 - (ord_key(sidx[(pid[r] >> 4) * 32 + tl]) & 127);
                const int ib = 127 - (ord_key(sB[(pid[r] & 15) * 32 + tl]) & 127);
                const int pos = (r & 7) * 16 + h * 2 + (r >> 3);
                p.eidx()[(size_t)tok * 128 + pos] = (unsigned short)(ia * 128 + ib);
                p.gate()[(size_t)tok * 128 + pos] = sv[r] * inv;
            }
        }
        }
    }
}

constexpr int PEER_TG = 512;
constexpr int PEER_TPW = PEER_TG / 8;
constexpr int PEER_NTG = NTOK / PEER_TG;
constexpr int PEER_NCH = 8;

#define PEER_G1(base, wv, hi) (*(const uint4*)((base) + (unsigned)((((hi) ? ((wv) >> 16) : ((wv) & 0xFFFFu)) << 7) + dlo)))
#define PEER_GATHER16(dst, base, ia, ib)                                                             \
    dst[0] = PEER_G1(base, (ia).x, 0);  dst[1] = PEER_G1(base, (ia).x, 1);  dst[2] = PEER_G1(base, (ia).y, 0);  dst[3] = PEER_G1(base, (ia).y, 1);   \
    dst[4] = PEER_G1(base, (ia).z, 0);  dst[5] = PEER_G1(base, (ia).z, 1);  dst[6] = PEER_G1(base, (ia).w, 0);  dst[7] = PEER_G1(base, (ia).w, 1);   \
    dst[8] = PEER_G1(base, (ib).x, 0);  dst[9] = PEER_G1(base, (ib).x, 1);  dst[10] = PEER_G1(base, (ib).y, 0); dst[11] = PEER_G1(base, (ib).y, 1);  \
    dst[12] = PEER_G1(base, (ib).z, 0); dst[13] = PEER_G1(base, (ib).z, 1); dst[14] = PEER_G1(base, (ib).w, 0); dst[15] = PEER_G1(base, (ib).w, 1);

__device__ __forceinline__ unsigned quant4(float a, float b, float c, float d, float qs) {
    const int q0 = (int)rintf(__builtin_amdgcn_fmed3f(a * qs, -127.f, 127.f)), q1 = (int)rintf(__builtin_amdgcn_fmed3f(b * qs, -127.f, 127.f));
    const int q2 = (int)rintf(__builtin_amdgcn_fmed3f(c * qs, -127.f, 127.f)), q3 = (int)rintf(__builtin_amdgcn_fmed3f(d * qs, -127.f, 127.f));
    return (unsigned)(q0 & 255) | ((unsigned)(q1 & 255) << 8) | ((unsigned)(q2 & 255) << 16) | ((unsigned)(q3 & 255) << 24);
}
__device__ void phase_quant_h2(const Params& p) {
    const int tid = VTID, lane = tid & 63, w = tid >> 6;
    for (int r0 = VBID * 4; r0 < NTOK; r0 += VGRID * 4) {
        const int r = r0 + w;
        const uint4* xp = (const uint4*)(p.x1b() + (size_t)r * D + lane * 16);
        const uint4 xa = xp[0], xb = xp[1];
        const float4* gp = (const float4*)(p.ffn_g + lane * 16);
        const float4 g0 = gp[0], g1 = gp[1], g2 = gp[2], g3 = gp[3];
        const float hm = __uint_as_float(p.hmax()[r]);
        const float qs = hm > 0.f ? 127.0f / hm : 0.f;
        uint4 o;
        o.x = quant4(bflo(xa.x) * g0.x, bfhi(xa.x) * g0.y, bflo(xa.y) * g0.z, bfhi(xa.y) * g0.w, qs);
        o.y = quant4(bflo(xa.z) * g1.x, bfhi(xa.z) * g1.y, bflo(xa.w) * g1.z, bfhi(xa.w) * g1.w, qs);
        o.z = quant4(bflo(xb.x) * g2.x, bfhi(xb.x) * g2.y, bflo(xb.y) * g2.z, bfhi(xb.y) * g2.w, qs);
        o.w = quant4(bflo(xb.z) * g3.x, bfhi(xb.z) * g3.y, bflo(xb.w) * g3.z, bfhi(xb.w) * g3.w, qs);
        *(uint4*)(p.h2q() + (size_t)r * D + lane * 16) = o;
    }
}

template <int CTRL>
__device__ __forceinline__ int dpp_movi(int v) { return __builtin_amdgcn_update_dpp(0, v, CTRL, 0xf, 0xf, true); }

struct DotTok { uint4 ia, ib; uint4 ha; };
__device__ __forceinline__ void dots_load(const Params& p, DotTok& t, int tok, int c, int g, int d8) {
    const uint4* idp = (const uint4*)(p.eidx() + (size_t)tok * 128 + g * 16);
    t.ia = idp[0]; t.ib = idp[1];
    t.ha = *(const uint4*)(p.h2q() + (size_t)tok * D + c * 128 + d8 * 16);
}
__device__ __forceinline__ void dotsf_load(const Params& p, DotTok& t, int tokb, int s, int g, int d8) {
    dots_load(p, t, tokb + 8 * (s & 15), s >> 4, g, d8);
}
__device__ __forceinline__ void dotsf_finish(const uint4 (&uu)[16], const DotTok& t, int* part, int g, int d8) {
    const int h0 = (int)t.ha.x, h1 = (int)t.ha.y, h2 = (int)t.ha.z, h3 = (int)t.ha.w;
    int acc[16];
#pragma unroll
    for (int i = 0; i < 16; ++i) {
        int a = __builtin_amdgcn_sdot4((int)uu[i].x, h0, 0, false);
        a = __builtin_amdgcn_sdot4((int)uu[i].y, h1, a, false);
        a = __builtin_amdgcn_sdot4((int)uu[i].z, h2, a, false);
        a = __builtin_amdgcn_sdot4((int)uu[i].w, h3, a, false);
        a += dpp_movi<DPP_QP_X1>(a);
        a += dpp_movi<DPP_QP_X2>(a);
        a += dpp_movi<DPP_HMIRROR>(a);
        acc[i] = a;
    }
    if (d8 == 0) {
#pragma unroll
        for (int i = 0; i < 16; ++i) (void)__hip_atomic_fetch_add(part + g * 16 + i, acc[i], __ATOMIC_RELAXED, __HIP_MEMORY_SCOPE_WORKGROUP);
    }
}

__device__ __forceinline__ float gelu_erf(float v);

__device__ void phase_peer_dots(const Params& p, char* smem) {
    const int tid = threadIdx.x, lane = tid & 63, w = tid >> 6;
    const int g = lane >> 3, d8 = lane & 7;
    int* part = (int*)smem + w * 2048;
    for (int tgp = blockIdx.x; tgp < NTOK / 128; tgp += gridDim.x) {
        const int tokb = tgp * 128 + w;
        __syncthreads();
        for (int i = lane; i < 2048; i += 64) part[i] = 0;
        __syncthreads();
        const char* ubase = (const char*)p.u_c();
        const unsigned dlo = d8 * 16;
        DotTok ta, tb, tn;
        uint4 ua[16], ubuf[16];
        dotsf_load(p, ta, tokb, 0, g, d8);
        dotsf_load(p, tb, tokb, 1, g, d8);
        PEER_GATHER16(ua, ubase, ta.ia, ta.ib)
        PEER_GATHER16(ubuf, ubase, tb.ia, tb.ib)
        dotsf_load(p, tn, tokb, 2, g, d8);
        for (int s = 0; s < 128; s += 2) {
            dotsf_finish(ua, ta, part + (s & 15) * 128, g, d8);
            if (s + 2 < 128) {
                ta = tn;
                const char* ub = ubase + (size_t)((s + 2) >> 4) * 16384 * 128;
                PEER_GATHER16(ua, ub, ta.ia, ta.ib)
                dotsf_load(p, tn, tokb, min(s + 3, 127), g, d8);
            }
            dotsf_finish(ubuf, tb, part + ((s + 1) & 15) * 128, g, d8);
            if (s + 3 < 128) {
                tb = tn;
                const char* ub = ubase + (size_t)((s + 3) >> 4) * 16384 * 128;
                PEER_GATHER16(ubuf, ub, tb.ia, tb.ib)
                dotsf_load(p, tn, tokb, min(s + 4, 127), g, d8);
            }
        }
        __syncthreads();
        for (int k0 = 0; k0 < 16; k0 += 4) {
            int ps[4][2], e[4][2];
            float gt[4][2], sh[4];
#pragma unroll
            for (int q = 0; q < 4; ++q) {
                const int tok = tokb + 8 * (k0 + q);
                sh[q] = __uint_as_float(p.hmax()[tok]) * (1.0f / 127.0f) * rsqrtf(p.ss1()[tok] * (1.0f / 1024.0f) + EPS);
#pragma unroll
                for (int u = 0; u < 2; ++u) {
                    const int slot = lane + 64 * u;
                    ps[q][u] = part[(k0 + q) * 128 + slot];
                    e[q][u] = p.eidx()[(size_t)tok * 128 + slot];
                    gt[q][u] = p.gate()[(size_t)tok * 128 + slot];
                }
            }
            float su[4][2], sv[4][2];
#pragma unroll
            for (int q = 0; q < 4; ++q)
#pragma unroll
                for (int u = 0; u < 2; ++u) { su[q][u] = p.scale_u()[e[q][u]]; sv[q][u] = p.scale_v()[e[q][u]]; }
#pragma unroll
            for (int q = 0; q < 4; ++q) {
                const int tok = tokb + 8 * (k0 + q);
                float cf[2];
#pragma unroll
                for (int u = 0; u < 2; ++u) cf[u] = gelu_erf((float)ps[q][u] * su[q][u] * sh[q]) * gt[q][u] * sv[q][u];
                const float cm = wave_max(fmaxf(fabsf(cf[0]), fabsf(cf[1])));
                const float qs = cm > 0.f ? 127.0f / cm : 0.f;
                p.coef()[(size_t)tok * 128 + lane] = (signed char)(int)rintf(cf[0] * qs);
                p.coef()[(size_t)tok * 128 + lane + 64] = (signed char)(int)rintf(cf[1] * qs);
                if (lane == 0) p.csum()[tok] = cm * (1.0f / 127.0f);
            }
        }
    }
}

__device__ __forceinline__ float gelu_erf(float v) {
    const float av = fabsf(v);
    const float t = __builtin_amdgcn_rcpf(fmaf(av, 0.2316418882f, 1.0f));
    float q = fmaf(t, 0.5307027145f, -0.7265760135f);
    q = fmaf(q, t, 0.7107068705f);
    q = fmaf(q, t, -0.142248368f);
    q = fmaf(q, t, 0.127414796f);
    q = q * t;
    const float e = __builtin_amdgcn_exp2f(v * v * -0.72134752044f);
    const float m = v * (q * e);
    return v < 0.f ? m : v - m;
}
struct AccTok { uint4 ia, ib; uint4 cq; float cs; };
__device__ __forceinline__ void acc_load(const Params& p, AccTok& t, int tok, int g) {
    const uint4* idp = (const uint4*)(p.eidx() + (size_t)tok * 128 + g * 16);
    t.ia = idp[0]; t.ib = idp[1];
    t.cq = *(const uint4*)(p.coef() + (size_t)tok * 128 + g * 16);
    t.cs = p.csum()[tok];
}
#define PEER_T4DOT(acc, B, r0, r1, r2, r3, cq)                                   \
    {                                                                            \
        const unsigned t0 = __builtin_amdgcn_perm(r1, r0, 0x05010400u), t1 = __builtin_amdgcn_perm(r1, r0, 0x07030602u); \
        const unsigned t2 = __builtin_amdgcn_perm(r3, r2, 0x05010400u), t3 = __builtin_amdgcn_perm(r3, r2, 0x07030602u); \
        acc[(B) + 0] = __builtin_amdgcn_sdot4((int)__builtin_amdgcn_perm(t2, t0, 0x05040100u), (int)(cq), acc[(B) + 0], false); \
        acc[(B) + 1] = __builtin_amdgcn_sdot4((int)__builtin_amdgcn_perm(t2, t0, 0x07060302u), (int)(cq), acc[(B) + 1], false); \
        acc[(B) + 2] = __builtin_amdgcn_sdot4((int)__builtin_amdgcn_perm(t3, t1, 0x05040100u), (int)(cq), acc[(B) + 2], false); \
        acc[(B) + 3] = __builtin_amdgcn_sdot4((int)__builtin_amdgcn_perm(t3, t1, 0x07060302u), (int)(cq), acc[(B) + 3], false); \
    }
__device__ __forceinline__ void accf_finish(const uint4 (&vv)[16], const AccTok& t, char* rowp, int g) {
    const unsigned cw[4] = {t.cq.x, t.cq.y, t.cq.z, t.cq.w};
    int acc[16];
#pragma unroll
    for (int j = 0; j < 16; ++j) acc[j] = 0;
#pragma unroll
    for (int j = 0; j < 4; ++j) {
        PEER_T4DOT(acc, 0, vv[4 * j].x, vv[4 * j + 1].x, vv[4 * j + 2].x, vv[4 * j + 3].x, cw[j])
        PEER_T4DOT(acc, 4, vv[4 * j].y, vv[4 * j + 1].y, vv[4 * j + 2].y, vv[4 * j + 3].y, cw[j])
        PEER_T4DOT(acc, 8, vv[4 * j].z, vv[4 * j + 1].z, vv[4 * j + 2].z, vv[4 * j + 3].z, cw[j])
        PEER_T4DOT(acc, 12, vv[4 * j].w, vv[4 * j + 1].w, vv[4 * j + 2].w, vv[4 * j + 3].w, cw[j])
    }
    int t8[8], u4[4];
#pragma unroll
    for (int j = 0; j < 8; ++j) {
        const auto r = __builtin_amdgcn_permlane32_swap((unsigned)acc[j], (unsigned)acc[j + 8], false, false);
        t8[j] = (int)(r[0] + r[1]);
    }
#pragma unroll
    for (int j = 0; j < 4; ++j) {
        const auto r = __builtin_amdgcn_permlane16_swap((unsigned)t8[j], (unsigned)t8[j + 4], false, false);
        u4[j] = (int)(r[0] + r[1]);
    }
    float o[4];
#pragma unroll
    for (int j = 0; j < 4; ++j) {
        int v = u4[j];
        v += dpp_movi<DPP_ROR8>(v);
        o[j] = (float)v * t.cs;
    }
    if ((g & 1) == 0) {
        const int rho = g >> 1;
        uint2 w0; w0.x = pack2(o[0], o[1]); w0.y = pack2(o[2], o[3]);
        *(uint2*)(rowp + (4 * (rho & 1) + 8 * (rho >> 1)) * 2) = w0;
    }
}

__device__ void phase_peer_accum(const Params& p, char* smem) {
    const int tid = threadIdx.x, lane = tid & 63, w = tid >> 6;
    const int g = lane >> 3, d8 = lane & 7;
    char* rowbuf = smem + w * 16384;
    for (int tgp = blockIdx.x; tgp < NTOK / 64; tgp += gridDim.x) {
        const int tokb = tgp * 64 + w;
        __syncthreads();
        const char* vbase = (const char*)p.v_c();
        const unsigned dlo = d8 * 16;
        AccTok ta, tb, tn;
        uint4 va[16], vbuf[16];
        acc_load(p, ta, tokb, g);
        acc_load(p, tb, tokb + 8, g);
        PEER_GATHER16(va, vbase, ta.ia, ta.ib)
        PEER_GATHER16(vbuf, vbase, tb.ia, tb.ib)
        acc_load(p, tn, tokb + 16, g);
        for (int s = 0; s < 64; s += 2) {
            accf_finish(va, ta, rowbuf + (s & 7) * 2048 + (s >> 3) * 256 + d8 * 32, g);
            if (s + 2 < 64) {
                ta = tn;
                const char* vb = vbase + (size_t)((s + 2) >> 3) * 16384 * 128;
                PEER_GATHER16(va, vb, ta.ia, ta.ib)
                acc_load(p, tn, tokb + 8 * (min(s + 3, 63) & 7), g);
            }
            accf_finish(vbuf, tb, rowbuf + ((s + 1) & 7) * 2048 + ((s + 1) >> 3) * 256 + d8 * 32, g);
            if (s + 3 < 64) {
                tb = tn;
                const char* vb = vbase + (size_t)((s + 3) >> 3) * 16384 * 128;
                PEER_GATHER16(vbuf, vb, tb.ia, tb.ib)
                acc_load(p, tn, tokb + 8 * (min(s + 4, 63) & 7), g);
            }
        }
        __syncthreads();
        for (int k0 = 0; k0 < 8; k0 += 2) {
            float4 v[2][4];
#pragma unroll
            for (int q = 0; q < 2; ++q) {
                const bf16_t* xrow = p.x1b() + (size_t)(tokb + 8 * (k0 + q)) * D;
#pragma unroll
                for (int j = 0; j < 4; ++j) {
                    const uint2 xk = *(const uint2*)(xrow + (j * 64 + lane) * 4);
                    v[q][j] = make_float4(bflo(xk.x), bfhi(xk.x), bflo(xk.y), bfhi(xk.y));
                }
            }
#pragma unroll
            for (int q = 0; q < 2; ++q) {
                float* orow = p.out + (size_t)(tokb + 8 * (k0 + q)) * D;
                const char* prow = rowbuf + (k0 + q) * 2048;
                float ss = 0.f;
#pragma unroll
                for (int j = 0; j < 4; ++j) {
                    const uint2 pk = *(const uint2*)(prow + (j * 64 + lane) * 8);
                    v[q][j].x += bflo(pk.x); v[q][j].y += bfhi(pk.x); v[q][j].z += bflo(pk.y); v[q][j].w += bfhi(pk.y);
                    ss += v[q][j].x * v[q][j].x + v[q][j].y * v[q][j].y + v[q][j].z * v[q][j].z + v[q][j].w * v[q][j].w;
                }
                ss = wave_sum(ss);
                const float rs = rsqrtf(ss * (1.0f / 1024.0f) + EPS);
#pragma unroll
                for (int j = 0; j < 4; ++j) {
                    const float4 gg = *(const float4*)(p.fin_g + (j * 64 + lane) * 4);
                    float4 o;
                    o.x = v[q][j].x * rs * gg.x; o.y = v[q][j].y * rs * gg.y; o.z = v[q][j].z * rs * gg.z; o.w = v[q][j].w * rs * gg.w;
                    *(float4*)(orow + (j * 64 + lane) * 4) = o;
                }
            }
        }
    }
}

#define XB_TMO      128
#define XB_XCNT(j)  (256  + 64 * (j))
#define XB_XSUB(j)  (1280 + 64 * (j))
#define XB_XGEN(j)  (2304 + 64 * (j))
#define XB_TOP      3328
#define XB_TOPGEN   3392
#define XCD_BAR_WORDS 3456
#define XB_SPIN_CAP (1u << 18)
__device__ __forceinline__ unsigned xb_ld(unsigned* p)              { return __hip_atomic_load(p, __ATOMIC_RELAXED, __HIP_MEMORY_SCOPE_AGENT); }
__device__ __forceinline__ unsigned xb_add(unsigned* p, unsigned v) { return __hip_atomic_fetch_add(p, v, __ATOMIC_RELAXED, __HIP_MEMORY_SCOPE_AGENT); }
#define XB_SPIN(cond, bar) do { unsigned _sp = 0; while (cond) { __builtin_amdgcn_s_sleep(1); \
    if ((++_sp & 255u) == 0u) { if (xb_ld(&(bar)[XB_TMO])) break; if (_sp > XB_SPIN_CAP) { atomicAdd(&(bar)[XB_TMO], 1u); break; } } } } while (0)

struct XcdBarrier { unsigned* bar; unsigned x; volatile unsigned* st; };

__device__ __forceinline__ XcdBarrier xcd_barrier_post(unsigned* bar, volatile unsigned* st) {
    XcdBarrier b; b.bar = bar; b.x = xcc_id(); b.st = st;
    if (threadIdx.x == 0) (void)xb_add(&bar[XB_XCNT(b.x)], 1u);
    return b;
}
__device__ __forceinline__ void xcd_barrier_complete(unsigned* bar, unsigned x, unsigned& nloc, unsigned& nx) {
    const unsigned G = gridDim.x * gridDim.y * gridDim.z;
    unsigned sum, cnt, mine, sp = 0u;
    for (;;) {
        sum = 0u; cnt = 0u; mine = 0u;
#pragma unroll
        for (unsigned j = 0; j < 16; ++j) { const unsigned c = xb_ld(&bar[XB_XCNT(j)]); sum += c; cnt += (c > 0u) ? 1u : 0u; mine = (j == x) ? c : mine; }
        if (sum == G) break;
        __builtin_amdgcn_s_sleep(1);
        if ((++sp & 255u) == 0u) { if (xb_ld(&bar[XB_TMO])) break; if (sp > XB_SPIN_CAP) { atomicAdd(&bar[XB_TMO], 1u); break; } }
    }
    nloc = mine > 0u ? mine : 1u; nx = cnt > 0u ? cnt : 1u;
}
__device__ __forceinline__ void xcd_barrier(const XcdBarrier& b) {
    asm volatile("s_waitcnt vmcnt(0)" ::: "memory");
    __syncthreads();
    if (threadIdx.x == 0) {
        unsigned* bar = b.bar;
        __builtin_amdgcn_s_waitcnt(0);
        unsigned nloc = b.st[0], nx = b.st[1];
        if (nloc == 0u) { xcd_barrier_complete(bar, b.x, nloc, nx); b.st[0] = nloc; b.st[1] = nx; }
        const unsigned old = xb_add(&bar[XB_XSUB(b.x)], 1u);
        const unsigned gen = old / nloc;
        if (old + 1u == (gen + 1u) * nloc) {
            __builtin_amdgcn_fence(__ATOMIC_RELEASE, "agent");
            asm volatile("s_waitcnt vmcnt(0)" ::: "memory");
            const unsigned og = xb_add(&bar[XB_TOP], 1u);
            const unsigned tg = og / nx;
            if (og + 1u == (tg + 1u) * nx) xb_add(&bar[XB_TOPGEN], 1u);
            else XB_SPIN(xb_ld(&bar[XB_TOPGEN]) == tg, bar);
            __builtin_amdgcn_fence(__ATOMIC_ACQUIRE, "agent");
            xb_add(&bar[XB_XGEN(b.x)], 1u);
            asm volatile("s_waitcnt vmcnt(0)" ::: "memory");
        } else {
            XB_SPIN(xb_ld(&bar[XB_XGEN(b.x)]) == gen, bar);
            __builtin_amdgcn_fence(__ATOMIC_ACQUIRE, "agent");
            asm volatile("s_waitcnt vmcnt(0)" ::: "memory");
        }
    }
    __syncthreads();
}

#define RUN_PHASE(K, CALL)                                              \
    if (ph_lo <= (K) && (K) < ph_hi) {                                  \
        CALL;                                                           \
        if (COOP) { if ((K) + 1 < ph_hi) { xcd_barrier(xb); } } \
    }

template <bool COOP>
__global__ void __launch_bounds__(512, 2) fwd_kernel(Params p, int ph_lo, int ph_hi) {
    __shared__ __attribute__((aligned(16))) char smem[SMEM_BYTES + 16];
    char* smh = smem + VHB * HALF_SMEM;
    XcdBarrier xb;
    if (COOP) {
        if (threadIdx.x == 0) *(uint4*)(smem + SMEM_BYTES) = make_uint4(0u, 0u, 0u, 0u);
        __syncthreads();
        xb = xcd_barrier_post(p.bar(), (volatile unsigned*)(smem + SMEM_BYTES));
    }
    if (COOP) { if (ph_lo < 0) cg::this_grid().sync(); }
    RUN_PHASE(0, phase_prep(p, smh))
    RUN_PHASE(1, phase_gemm_in(p, smem))
    RUN_PHASE(2, phase_mixers(p, smh))
    RUN_PHASE(3, (phase_gemm_kv(p, smh), phase_hg_scan(p)))
    RUN_PHASE(4, phase_hg_out(p, smh))
    RUN_PHASE(5, phase_gemm_out(p, smem))
    RUN_PHASE(6, phase_quant_h2(p))
    RUN_PHASE(7, phase_gemm_q_route(p, smem))
    RUN_PHASE(10, phase_peer_dots(p, smem))
    RUN_PHASE(12, phase_peer_accum(p, smem))
}

extern "C" void kernel_launch(void* const* d_in, const int* in_sizes, int n_in, void* d_out, int out_size, void* d_ws, size_t ws_size,
                              hipStream_t stream) {
    Params p{};
    p.x = (const float*)d_in[0]; p.mem = (const float*)d_in[1]; p.attn_g = (const float*)d_in[2]; p.w_in = (const float*)d_in[3];
    p.rpb = (const float*)d_in[4]; p.hg_lb = (const float*)d_in[5]; p.hg_g = (const float*)d_in[6]; p.mem_g = (const float*)d_in[7];
    p.w_kv = (const float*)d_in[8]; p.w_out = (const float*)d_in[9]; p.ffn_g = (const float*)d_in[10]; p.w_q = (const float*)d_in[11];
    p.subk = (const float*)d_in[12]; p.pu = (const float*)d_in[13]; p.pv = (const float*)d_in[14]; p.fin_g = (const float*)d_in[15];
    p.out = (float*)d_out;
    p.ws = (char*)d_ws;
    if (WS_TOTAL > ws_size) { fprintf(stderr, "workspace too small: need %zu have %zu\n", (size_t)WS_TOTAL, ws_size); return; }

#if defined(MULTI_LAUNCH)
    for (int ph = 0; ph < NPHASE; ++ph) fwd_kernel<false><<<dim3(512), dim3(512), 0, stream>>>(p, ph, ph + 1);
#else
    static int grid_blocks = 0;
    if (!grid_blocks) {
        int dev = 0, cus = 0, per_cu = 0;
        hipGetDevice(&dev);
        hipDeviceGetAttribute(&cus, hipDeviceAttributeMultiprocessorCount, dev);
        hipOccupancyMaxActiveBlocksPerMultiprocessor(&per_cu, fwd_kernel<true>, 512, 0);
        if (per_cu > 1) per_cu = 1;
        grid_blocks = (cus * per_cu) & ~3;
    }
    (void)hipMemsetAsync((char*)d_ws + OFF_BAR, 0, XCD_BAR_WORDS * 4, stream);
    int lo = 0, hi = NPHASE;
    void* args[] = {&p, &lo, &hi};
    hipError_t e = hipLaunchCooperativeKernel((void*)fwd_kernel<true>, dim3(grid_blocks), dim3(512), args, 0, stream);
    if (e != hipSuccess) fprintf(stderr, "cooperative launch failed: %s (grid %d)\n", hipGetErrorString(e), grid_blocks);
#endif
}
```

```cpp
#include <hip/hip_runtime.h>
#include <hip/hip_cooperative_groups.h>
#include <stdint.h>
#include <cstdio>

namespace cg = cooperative_groups;

#define VTID ((int)(threadIdx.x & 255))
#define VHB ((int)(threadIdx.x >> 8))
#define VBID ((int)(blockIdx.x * 2 + (threadIdx.x >> 8)))
#define VGRID ((int)(gridDim.x * 2))
constexpr int HALF_SMEM = 73728;

typedef unsigned short bf16_t;
typedef short bf16x8 __attribute__((ext_vector_type(8)));
typedef float f32x4 __attribute__((ext_vector_type(4)));
typedef int i32x4 __attribute__((ext_vector_type(4)));

constexpr int D = 1024;
constexpr int NB = 4;
constexpr int T = 8192;
constexpr int NTOK = NB * T;
constexpr int INW = 3072;
constexpr int QW = 2048;
constexpr float EPS = 1e-6f;
constexpr int SMEM_BYTES = 2 * 73728;
constexpr int NPHASE = 14;

constexpr size_t al256(size_t x) { return (x + 255) & ~(size_t)255; }
constexpr size_t OFF_W_IN_T = 0;
constexpr size_t OFF_W_OUT_T = OFF_W_IN_T + al256((size_t)3072 * 1024 * 2);
constexpr size_t OFF_W_Q_T = OFF_W_OUT_T + al256((size_t)1024 * 1024 * 2);
constexpr size_t OFF_W_KV_T = OFF_W_Q_T + al256((size_t)2048 * 1024 * 2);
constexpr size_t OFF_H = OFF_W_KV_T + al256((size_t)512 * 1024 * 2);
constexpr size_t OFF_Z = OFF_H + al256((size_t)32768 * 1024 * 2);
constexpr size_t OFF_MIX = OFF_Z + al256((size_t)32768 * 3072 * 2);
constexpr size_t OFF_MEMN = OFF_MIX + al256((size_t)32768 * 1024 * 2);
constexpr size_t OFF_KVB = OFF_MEMN + al256((size_t)1024 * 1024 * 2);
constexpr size_t OFF_LB = OFF_KVB + al256((size_t)1024 * 512 * 2);
constexpr size_t OFF_HSTATE = OFF_LB + al256(512 * 4);
constexpr size_t OFF_HDEC = OFF_HSTATE + al256((size_t)4096 * 4096 * 4);
constexpr size_t OFF_UC = OFF_HDEC + al256((size_t)4096 * 64 * 4);
constexpr size_t OFF_VC = OFF_UC + al256((size_t)16384 * 1024);
constexpr size_t OFF_QUEUE = OFF_VC + al256((size_t)16384 * 1024);
constexpr size_t OFF_SUBK = OFF_QUEUE + al256(2048 * 4);
constexpr size_t OFF_BAR = OFF_SUBK + al256((size_t)16 * 128 * 128 * 2);
constexpr size_t OFF_SS1 = OFF_BAR + al256(4096 * 4);
constexpr size_t OFF_HMAX = OFF_SS1 + al256((size_t)32768 * 4);
constexpr size_t OFF_CSUM = OFF_HMAX + al256((size_t)32768 * 4);
constexpr size_t OFF_SCALE_U = OFF_CSUM + al256((size_t)32768 * 4);
constexpr size_t OFF_SCALE_V = OFF_SCALE_U + al256(16384 * 4);
constexpr size_t OFF_VT = OFF_SCALE_V + al256(16384 * 4);
constexpr size_t OFF_KVT = OFF_VT + al256((size_t)32768 * 512 * 2);
constexpr size_t OFF_SA = OFF_KVT + al256((size_t)1024 * 256 * 2);
constexpr size_t OFF_SB = OFF_SA + al256((size_t)32768 * 4);
constexpr size_t WS_TOTAL = OFF_SB + al256((size_t)8192 * 4);
constexpr size_t OFF_EIDX = OFF_HSTATE;
constexpr size_t OFF_GATE = OFF_HSTATE + (size_t)32768 * 128 * 4;
constexpr size_t OFF_COEF = OFF_HSTATE + (size_t)32768 * 128 * 8;
constexpr size_t OFF_SS = OFF_HSTATE + (size_t)32768 * 128 * 12;
constexpr size_t OFF_PARTIAL = OFF_Z;
constexpr size_t OFF_PEER_OUT = OFF_Z + (size_t)8 * 32768 * 128 * 4;

struct Params {
    const float *x, *mem, *attn_g, *w_in, *rpb, *hg_lb, *hg_g, *mem_g, *w_kv, *w_out, *ffn_g, *w_q, *subk, *pu, *pv, *fin_g;
    float* out;
    char* ws;
#define WSF(type, name, off) __device__ __forceinline__ type* name() const { return (type*)(ws + (off)); }
    WSF(bf16_t, w_in_t, OFF_W_IN_T) WSF(bf16_t, w_out_t, OFF_W_OUT_T) WSF(bf16_t, w_q_t, OFF_W_Q_T) WSF(bf16_t, w_kv_t, OFF_W_KV_T)
    WSF(bf16_t, h, OFF_H)
    WSF(bf16_t, z, OFF_Z)
    WSF(bf16_t, mix, OFF_MIX)
    WSF(bf16_t, memn, OFF_MEMN)
    WSF(bf16_t, kvb, OFF_KVB)
    WSF(float, lb, OFF_LB)
    WSF(float, hstate, OFF_HSTATE)
    WSF(float, hdec, OFF_HDEC)
    WSF(unsigned short, eidx, OFF_EIDX)
    WSF(float, gate, OFF_GATE)
    WSF(signed char, coef, OFF_COEF)
    WSF(bf16_t, x1b, OFF_PEER_OUT)
    WSF(float, ss, OFF_SS)
    WSF(float, partial, OFF_PARTIAL)
    WSF(bf16_t, u_c, OFF_UC) WSF(bf16_t, v_c, OFF_VC)
    WSF(unsigned, queue, OFF_QUEUE)
    WSF(bf16_t, subk_b, OFF_SUBK)
    WSF(unsigned, bar, OFF_BAR)
    WSF(float, ss1, OFF_SS1) WSF(unsigned, hmax, OFF_HMAX) WSF(float, csum, OFF_CSUM)
    WSF(float, scale_u, OFF_SCALE_U) WSF(float, scale_v, OFF_SCALE_V)
    WSF(bf16_t, vT, OFF_VT)
    WSF(signed char, hq, OFF_H)
    WSF(signed char, w_in_q, OFF_W_IN_T)
    WSF(float, sa, OFF_SA) WSF(float, sb, OFF_SB)
    WSF(signed char, h2q, OFF_MIX)
    WSF(signed char, w_q_q, OFF_W_Q_T)
    WSF(bf16_t, kvT, OFF_KVT)
#undef WSF
};

__device__ __forceinline__ float bf2f(bf16_t v) { return __uint_as_float(((unsigned)v) << 16); }
__device__ __forceinline__ bf16_t f2bf(float f) {
    unsigned u = __float_as_uint(f);
    u += 0x7FFFu + ((u >> 16) & 1u);
    return (bf16_t)(u >> 16);
}
__device__ __forceinline__ float bflo(unsigned u) { return __uint_as_float(u << 16); }
__device__ __forceinline__ float bfhi(unsigned u) { return __uint_as_float(u & 0xFFFF0000u); }
typedef __bf16 bf16x2v_t __attribute__((ext_vector_type(2)));
typedef float f32x2v_t __attribute__((ext_vector_type(2)));
__device__ __forceinline__ unsigned pack2(float a, float b) {
    const f32x2v_t v = {a, b};
    return __builtin_bit_cast(unsigned, __builtin_convertvector(v, bf16x2v_t));
}

__device__ __forceinline__ float wave_sum(float v) {
#pragma unroll
    for (int o = 32; o; o >>= 1) v += __shfl_xor(v, o);
    return v;
}
__device__ __forceinline__ float wave_max(float v) {
#pragma unroll
    for (int o = 32; o; o >>= 1) v = fmaxf(v, __shfl_xor(v, o));
    return v;
}


typedef __bf16 bf16x2_t __attribute__((ext_vector_type(2)));
template <int CTRL>
__device__ __forceinline__ float dpp_mov(float v) {
    return __builtin_bit_cast(float, __builtin_amdgcn_update_dpp(0, __builtin_bit_cast(int, v), CTRL, 0xf, 0xf, true));
}
#define DPP_QP_X1 0xB1
#define DPP_QP_X2 0x4E
#define DPP_HMIRROR 0x141
#define DPP_ROR8 0x128
__device__ __forceinline__ unsigned xcc_id() { return (unsigned)__builtin_amdgcn_s_getreg((3 << 11) | 20) & 0xFu; }

__device__ __forceinline__ void transpose_tile(const float* __restrict__ in, bf16_t* __restrict__ out, int K, int N, int tile, char* smem) {
    float* tl = (float*)smem;
    const int ntn = N >> 6;
    const int k0 = (tile / ntn) << 6, n0 = (tile % ntn) << 6;
    const int tid = VTID;
    __syncthreads();
#pragma unroll 4
    for (int i = 0; i < 16; ++i) {
        int idx = tid + 256 * i;
        int r = idx >> 6, c = idx & 63;
        tl[r * 65 + c] = in[(size_t)(k0 + r) * N + n0 + c];
    }
    __syncthreads();
#pragma unroll 4
    for (int i = 0; i < 16; ++i) {
        int idx = tid + 256 * i;
        int r = idx >> 6, c = idx & 63;
        out[(size_t)(n0 + r) * K + k0 + c] = f2bf(tl[c * 65 + r]);
    }
}

__device__ __forceinline__ void rmsnorm_row_bf16(const float* __restrict__ xr, const float* __restrict__ g, bf16_t* __restrict__ o, int lane) {
    float4 v[4];
    float ss = 0.f;
#pragma unroll
    for (int j = 0; j < 4; ++j) {
        v[j] = *(const float4*)(xr + (j * 64 + lane) * 4);
        ss += v[j].x * v[j].x + v[j].y * v[j].y + v[j].z * v[j].z + v[j].w * v[j].w;
    }
    ss = wave_sum(ss);
    const float rs = rsqrtf(ss * (1.0f / 1024.0f) + EPS);
#pragma unroll
    for (int j = 0; j < 4; ++j) {
        const float4 gg = *(const float4*)(g + (j * 64 + lane) * 4);
        uint2 pk;
        pk.x = pack2(v[j].x * rs * gg.x, v[j].y * rs * gg.y);
        pk.y = pack2(v[j].z * rs * gg.z, v[j].w * rs * gg.w);
        *(uint2*)(o + (j * 64 + lane) * 4) = pk;
    }
}

__device__ __forceinline__ void rmsnorm_row_i8(const float* __restrict__ xr, const float* __restrict__ g, signed char* __restrict__ o, float* __restrict__ sa, int lane) {
    float4 v[4];
    float ss = 0.f;
#pragma unroll
    for (int j = 0; j < 4; ++j) {
        v[j] = *(const float4*)(xr + (j * 64 + lane) * 4);
        ss += v[j].x * v[j].x + v[j].y * v[j].y + v[j].z * v[j].z + v[j].w * v[j].w;
    }
    ss = wave_sum(ss);
    const float rs = rsqrtf(ss * (1.0f / 1024.0f) + EPS);
    float am = 0.f;
#pragma unroll
    for (int j = 0; j < 4; ++j) {
        const float4 gg = *(const float4*)(g + (j * 64 + lane) * 4);
        v[j].x *= rs * gg.x; v[j].y *= rs * gg.y; v[j].z *= rs * gg.z; v[j].w *= rs * gg.w;
        am = fmaxf(am, fmaxf(fmaxf(fabsf(v[j].x), fabsf(v[j].y)), fmaxf(fabsf(v[j].z), fabsf(v[j].w))));
    }
    am = wave_max(am);
    const float qs = am > 0.f ? 127.0f / am : 0.f;
    if (lane == 0) *sa = am * (1.0f / 127.0f);
#pragma unroll
    for (int j = 0; j < 4; ++j) {
        const int q0 = (int)rintf(v[j].x * qs), q1 = (int)rintf(v[j].y * qs), q2 = (int)rintf(v[j].z * qs), q3 = (int)rintf(v[j].w * qs);
        *(unsigned*)(o + (j * 64 + lane) * 4) = (unsigned)(q0 & 255) | ((unsigned)(q1 & 255) << 8) | ((unsigned)(q2 & 255) << 16) | ((unsigned)(q3 & 255) << 24);
    }
}
__device__ __forceinline__ void transpose_cols_i8(const float* __restrict__ in, signed char* __restrict__ out, float* __restrict__ sb, int N, int item, char* smem) {
    float* tl = (float*)smem;
    const int n0 = item << 4;
    const int tid = VTID;
    __syncthreads();
    {
        float4 v[16];
#pragma unroll
        for (int i = 0; i < 16; ++i) {
            const int idx = tid + 256 * i;
            v[i] = *(const float4*)(in + (size_t)(idx >> 2) * N + n0 + (idx & 3) * 4);
        }
#pragma unroll
        for (int i = 0; i < 16; ++i) {
            const int idx = tid + 256 * i;
            const int k = idx >> 2, c = (idx & 3) * 4;
            tl[(c + 0) * 1028 + k] = v[i].x; tl[(c + 1) * 1028 + k] = v[i].y; tl[(c + 2) * 1028 + k] = v[i].z; tl[(c + 3) * 1028 + k] = v[i].w;
        }
    }
    __syncthreads();
    float qs;
    {
        const int c = tid >> 4, l = tid & 15;
        float am = 0.f;
#pragma unroll 8
        for (int i = 0; i < 64; ++i) am = fmaxf(am, fabsf(tl[c * 1028 + l + 16 * i]));
        am = fmaxf(am, __shfl_xor(am, 1)); am = fmaxf(am, __shfl_xor(am, 2)); am = fmaxf(am, __shfl_xor(am, 4)); am = fmaxf(am, __shfl_xor(am, 8));
        if (l == 0) sb[n0 + c] = am * (1.0f / 127.0f);
        qs = am > 0.f ? 127.0f / am : 0.f;
    }
    __syncthreads();
    float* qt = tl + 16 * 1028;
    if ((tid & 15) == 0) qt[tid >> 4] = qs;
    __syncthreads();
#pragma unroll
    for (int i = 0; i < 16; ++i) {
        const int kq = tid * 4;
        const float q = qt[i];
        const float4 v = *(const float4*)(tl + i * 1028 + kq);
        const int q0 = (int)rintf(v.x * q), q1 = (int)rintf(v.y * q), q2 = (int)rintf(v.z * q), q3 = (int)rintf(v.w * q);
        *(unsigned*)(out + (size_t)(n0 + i) * 1024 + kq) = (unsigned)(q0 & 255) | ((unsigned)(q1 & 255) << 8) | ((unsigned)(q2 & 255) << 16) | ((unsigned)(q3 & 255) << 24);
    }
}

__device__ void phase_prep(const Params& p, char* smem) {
    const int tid = VTID, lane = tid & 63, w = tid >> 6;
    const int gsz = VGRID, bid = VBID;
    const int t_in = INW / 16;
    const int t_out = 16 * 16;
    const int t_q = QW / 16;
    const int t_kv = 16 * 8;
    const int t_all = t_in + t_out + t_q + t_kv;
    for (int it = bid; it < t_all; it += gsz) {
        if (it < t_in) transpose_cols_i8(p.w_in, p.w_in_q(), p.sb(), INW, it, smem);
        else if (it < t_in + t_out) transpose_tile(p.w_out, p.w_out_t(), 1024, 1024, it - t_in, smem);
        else if (it < t_in + t_out + t_q) transpose_cols_i8(p.w_q, p.w_q_q(), p.sb() + INW, QW, it - t_in - t_out, smem);
        else transpose_tile(p.w_kv, p.w_kv_t(), 1024, 512, it - t_in - t_out - t_q, smem);
    }
    for (int i = bid * 256 + tid; i < NTOK; i += gsz * 256) { p.ss1()[i] = 0.f; p.hmax()[i] = 0u; }
    if (bid == 0) {
        for (int i = tid; i < 512; i += 256) {
            int dir = i >> 8, k = i & 255;
            float a0 = p.hg_lb[(dir * 2 + 0) * 256 + k], a1 = p.hg_lb[(dir * 2 + 1) * 256 + k];
            float m = fmaxf(a0, a1);
            float e0 = expf(a0 - m), e1 = expf(a1 - m);
            p.lb()[i] = e0 / (e0 + e1);
        }
    }
    const int nrows = NTOK + 1024;
    for (int r0 = bid * 4; r0 < nrows; r0 += gsz * 4) {
        int r = r0 + w;
        if (r < NTOK) rmsnorm_row_i8(p.x + (size_t)r * D, p.attn_g, p.hq() + (size_t)r * D, p.sa() + r, lane);
        else if (r < nrows) rmsnorm_row_bf16(p.mem + (size_t)(r - NTOK) * D, p.mem_g, p.memn() + (size_t)(r - NTOK) * D, lane);
    }
    for (int i = bid * 256 + tid; i < 16 * 128 * 128 / 4; i += gsz * 256) {
        const float4 v = *(const float4*)(p.subk + (size_t)i * 4);
        uint2 pk; pk.x = pack2(v.x, v.y); pk.y = pack2(v.z, v.w);
        *(uint2*)(p.subk_b() + (size_t)i * 4) = pk;
    }
    for (int r0 = bid * 4; r0 < 2 * 16384; r0 += gsz * 4) {
        const int r = r0 + w;
        const bool isv = r >= 16384;
        const int e = r & 16383;
        const float* srcp = (isv ? p.pv : p.pu) + (size_t)e * D;
        unsigned* dst = (unsigned*)(isv ? p.v_c() : p.u_c());
        float4 v[4];
        float am = 0.f;
#pragma unroll
        for (int j = 0; j < 4; ++j) {
            v[j] = *(const float4*)(srcp + (j * 64 + lane) * 4);
            am = fmaxf(am, fmaxf(fmaxf(fabsf(v[j].x), fabsf(v[j].y)), fmaxf(fabsf(v[j].z), fabsf(v[j].w))));
        }
        am = wave_max(am);
        const float qs = am > 0.f ? 127.0f / am : 0.f;
        if (lane == 0) (isv ? p.scale_v() : p.scale_u())[e] = am * (1.0f / 127.0f);
        const int off = 0;
#pragma unroll
        for (int j = 0; j < 4; ++j) {
            const int q0 = (int)rintf(v[j].x * qs) + off, q1 = (int)rintf(v[j].y * qs) + off;
            const int q2 = (int)rintf(v[j].z * qs) + off, q3 = (int)rintf(v[j].w * qs) + off;
            const unsigned pk = (unsigned)(q0 & 255) | ((unsigned)(q1 & 255) << 8) | ((unsigned)(q2 & 255) << 16) | ((unsigned)(q3 & 255) << 24);
            const int c = j * 2 + (lane >> 5), d = (lane & 31) * 4;
            dst[(((size_t)c * 16384 + e) * 128 + d) >> 2] = pk;
        }
    }
}

struct EpiBf16 {
    bf16_t* C; int ldc;
    __device__ __forceinline__ void operator()(int row, int col, const f32x4& v) const {
        uint2 pk; pk.x = pack2(v[0], v[1]); pk.y = pack2(v[2], v[3]);
        *(uint2*)(C + (size_t)row * ldc + col) = pk;
    }
};
struct EpiBf16T {
    bf16_t* C; int col0, ncols, rows_per_b;
    __device__ __forceinline__ void operator()(int row, int col, const f32x4& v) const {
        const int bb = row / rows_per_b, rr = row - bb * rows_per_b;
        uint2 pk; pk.x = pack2(v[0], v[1]); pk.y = pack2(v[2], v[3]);
        *(uint2*)(C + ((size_t)bb * ncols + (col - col0)) * rows_per_b + rr) = pk;
    }
};
struct EpiBf16S {
    bf16_t* C; int ldc; const float* sa; const float* sb;
    __device__ __forceinline__ void operator()(int row, int col, const f32x4& v) const {
        const float s = sa[row];
        const float4 b = *(const float4*)(sb + col);
        uint2 pk; pk.x = pack2(v[0] * s * b.x, v[1] * s * b.y); pk.y = pack2(v[2] * s * b.z, v[3] * s * b.w);
        *(uint2*)(C + (size_t)row * ldc + col) = pk;
    }
};
struct EpiBf16TS {
    bf16_t* C; int col0, ncols, rows_per_b; const float* sa; const float* sb;
    __device__ __forceinline__ void operator()(int row, int col, const f32x4& v) const {
        const int bb = row / rows_per_b, rr = row - bb * rows_per_b;
        const float4 a = *(const float4*)(sa + row);
        const float b = sb[col];
        uint2 pk; pk.x = pack2(v[0] * a.x * b, v[1] * a.y * b); pk.y = pack2(v[2] * a.z * b, v[3] * a.w * b);
        *(uint2*)(C + ((size_t)bb * ncols + (col - col0)) * rows_per_b + rr) = pk;
    }
};
constexpr int EPS_LD = 528;
struct EpiBf16SStaged {
    static constexpr bool staged = true;
    bf16_t* C; int ldc; const float* sa; const float* sb; char* lt; int brow, bcol;
    __device__ __forceinline__ void operator()(int row, int col, const f32x4& v) const {
        const float s = sa[row];
        const float4 b = *(const float4*)(sb + col);
        uint2 pk; pk.x = pack2(v[0] * s * b.x, v[1] * s * b.y); pk.y = pack2(v[2] * s * b.z, v[3] * s * b.w);
        *(uint2*)(lt + (row - brow) * EPS_LD + (col - bcol) * 2) = pk;
    }
    __device__ __forceinline__ void finish() const {
        int tid = threadIdx.x;
        asm volatile("" : "+v"(tid));
        const int c16 = tid & 31, r0 = tid >> 5;
#pragma unroll
        for (int i = 0; i < 16; ++i) {
            const int r = i * 16 + r0;
            *(uint4*)(C + (size_t)(brow + r) * ldc + bcol + c16 * 8) = *(const uint4*)(lt + r * EPS_LD + c16 * 16);
        }
    }
};
struct EpiBf16TSStaged {
    static constexpr bool staged = true;
    bf16_t* Cb; const float* sa; const float* sb; char* lt; int brow, bcol;
    __device__ __forceinline__ void operator()(int row, int col, const f32x4& v) const {
        const float4 a = *(const float4*)(sa + row);
        const float b = sb[col];
        uint2 pk; pk.x = pack2(v[0] * a.x * b, v[1] * a.y * b); pk.y = pack2(v[2] * a.z * b, v[3] * a.w * b);
        *(uint2*)(lt + (col - bcol) * EPS_LD + (row - brow) * 2) = pk;
    }
    __device__ __forceinline__ void finish() const {
        int tid = threadIdx.x;
        asm volatile("" : "+v"(tid));
        const int c16 = tid & 31, r0 = tid >> 5;
#pragma unroll
        for (int i = 0; i < 16; ++i) {
            const int r = i * 16 + r0;
            *(uint4*)(Cb + (size_t)r * T + c16 * 8) = *(const uint4*)(lt + r * EPS_LD + c16 * 16);
        }
    }
};
struct EpiBf16RowScale {
    bf16_t* C; int ldc; const float* ssrow;
    __device__ __forceinline__ void operator()(int row, int col, const f32x4& v) const {
        const float rs = rsqrtf(ssrow[row] * (1.0f / 1024.0f) + EPS);
        uint2 pk; pk.x = pack2(v[0] * rs, v[1] * rs); pk.y = pack2(v[2] * rs, v[3] * rs);
        *(uint2*)(C + (size_t)row * ldc + col) = pk;
    }
};
struct EpiResNorm {
    bf16_t* C; const float* R; const float* g; int ldc; float* ssrow; unsigned* hmax;
    __device__ __forceinline__ void operator()(int row, int col, const f32x4& v, float& ssq, float& am) const {
        const float4 r = *(const float4*)(R + (size_t)row * ldc + col);
        const float4 gg = *(const float4*)(g + col);
        float4 o; o.x = v[0] + r.x; o.y = v[1] + r.y; o.z = v[2] + r.z; o.w = v[3] + r.w;
        uint2 xk; xk.x = pack2(o.x, o.y); xk.y = pack2(o.z, o.w);
        *(uint2*)(C + (size_t)row * ldc + col) = xk;
        const float h0 = bflo(xk.x) * gg.x, h1 = bfhi(xk.x) * gg.y, h2 = bflo(xk.y) * gg.z, h3 = bfhi(xk.y) * gg.w;
        ssq += o.x * o.x + o.y * o.y + o.z * o.z + o.w * o.w;
        am = fmaxf(am, fmaxf(fmaxf(fabsf(h0), fabsf(h1)), fmaxf(fabsf(h2), fabsf(h3))));
    }
    __device__ __forceinline__ void row_done(int row, float ssq, float am) const {
        atomicAdd(ssrow + row, ssq);
        atomicMax(hmax + row, __float_as_uint(am));
    }
};
struct EpiResF32 {
    float* C; const float* R; int ldc;
    __device__ __forceinline__ void operator()(int row, int col, const f32x4& v) const {
        const float4 r = *(const float4*)(R + (size_t)row * ldc + col);
        float4 o; o.x = v[0] + r.x; o.y = v[1] + r.y; o.z = v[2] + r.z; o.w = v[3] + r.w;
        *(float4*)(C + (size_t)row * ldc + col) = o;
    }
};

template <bool TRANS, class Epi, bool ROWSS = false>
__device__ __forceinline__ void gemm_tile(const bf16_t* __restrict__ A, int lda, const bf16_t* __restrict__ Bt, int ldb, int K,
                                          int m0, int n0, char* smem, const Epi& epi, float* ssrow = nullptr) {
    const int tid = VTID, lane = tid & 63, w = tid >> 6, wr = w >> 1, wc = w & 1;
    const int fr = lane & 15, fq = lane >> 4;
    const int srow = lane >> 3, sslot = lane & 7;
    f32x4 acc[4][4];
#pragma unroll
    for (int mi = 0; mi < 4; ++mi)
#pragma unroll
        for (int ni = 0; ni < 4; ++ni) acc[mi][ni] = (f32x4){0.f, 0.f, 0.f, 0.f};
    const int g0 = (sslot ^ (srow >> 1)) * 8, g1 = (sslot ^ (4 + (srow >> 1))) * 8;
    const bf16_t* Ab = A + (size_t)(m0 + w * 32 + srow) * lda;
    const bf16_t* Bb = Bt + (size_t)(n0 + w * 32 + srow) * ldb;
    const int nk = K >> 6;
    __syncthreads();
#define GEMM_STAGE(kt, buf)                                                                                                  \
    do {                                                                                                                     \
        char* sa = smem + (buf) * 32768 + w * 4096;                                                                          \
        char* sb = sa + 16384;                                                                                               \
        _Pragma("unroll") for (int i = 0; i < 4; ++i) {                                                                      \
            const int gc = (i & 1) ? g1 : g0;                                                                                \
            __builtin_amdgcn_global_load_lds((const unsigned*)(Ab + (size_t)(i * 8) * lda + (kt) * 64 + gc), (unsigned*)(sa + i * 1024), 16, 0, 0); \
            __builtin_amdgcn_global_load_lds((const unsigned*)(Bb + (size_t)(i * 8) * ldb + (kt) * 64 + gc), (unsigned*)(sb + i * 1024), 16, 0, 0); \
        }                                                                                                                    \
    } while (0)
    GEMM_STAGE(0, 0);
    const int key = fr >> 1;
    for (int kt = 0; kt < nk; ++kt) {
        asm volatile("s_waitcnt vmcnt(0)" ::: "memory");
        __syncthreads();
        if (kt + 1 < nk) GEMM_STAGE(kt + 1, (kt + 1) & 1);
        const char* sa = smem + (kt & 1) * 32768;
        const char* sb = sa + 16384;
#pragma unroll
        for (int ks = 0; ks < 2; ++ks) {
            bf16x8 af[4], bfr[4];
            const int co = ((ks * 4 + fq) ^ key) << 4;
#pragma unroll
            for (int mi = 0; mi < 4; ++mi) af[mi] = *(const bf16x8*)(sa + (wr * 64 + mi * 16 + fr) * 128 + co);
#pragma unroll
            for (int ni = 0; ni < 4; ++ni) bfr[ni] = *(const bf16x8*)(sb + (wc * 64 + ni * 16 + fr) * 128 + co);
#pragma unroll
            for (int mi = 0; mi < 4; ++mi)
#pragma unroll
                for (int ni = 0; ni < 4; ++ni)
                    acc[mi][ni] = TRANS ? __builtin_amdgcn_mfma_f32_16x16x32_bf16(af[mi], bfr[ni], acc[mi][ni], 0, 0, 0)
                                        : __builtin_amdgcn_mfma_f32_16x16x32_bf16(bfr[ni], af[mi], acc[mi][ni], 0, 0, 0);
        }
    }
#undef GEMM_STAGE
    if constexpr (ROWSS) {
#pragma unroll
        for (int mi = 0; mi < 4; ++mi) {
            const int row = m0 + wr * 64 + mi * 16 + fr;
            float ssq = 0.f, am = 0.f;
#pragma unroll
            for (int ni = 0; ni < 4; ++ni) epi(row, n0 + wc * 64 + ni * 16 + fq * 4, acc[mi][ni], ssq, am);
            ssq += __shfl_xor(ssq, 16);
            ssq += __shfl_xor(ssq, 32);
            am = fmaxf(am, __shfl_xor(am, 16));
            am = fmaxf(am, __shfl_xor(am, 32));
            if (fq == 0) epi.row_done(row, ssq, am);
        }
    } else {
#pragma unroll
        for (int mi = 0; mi < 4; ++mi)
#pragma unroll
            for (int ni = 0; ni < 4; ++ni) {
                if (TRANS) epi(m0 + wr * 64 + mi * 16 + fq * 4, n0 + wc * 64 + ni * 16 + fr, acc[mi][ni]);
                else epi(m0 + wr * 64 + mi * 16 + fr, n0 + wc * 64 + ni * 16 + fq * 4, acc[mi][ni]);
            }
    }
}


namespace g8 {
constexpr int BM = 256, BK = 64, HALF = 128, HT = HALF * BK;
__device__ __forceinline__ int lds_byte(int r, int c) {
    const int st = (r >> 4) * 2 + (c >> 5), rr = r & 15, cc = c & 31, ob = rr * 64 + cc * 2;
    return st * 1024 + (ob ^ (((ob >> 9) & 1) << 5));
}
__device__ __forceinline__ void stage_rc(int b, int& R, int& C) {
    const int st = b / 1024, sb = b % 1024, swz = sb ^ (((sb >> 9) & 1) << 5);
    R = (st >> 1) * 16 + swz / 64; C = (st & 1) * 32 + (swz % 64) / 2;
}
__device__ __forceinline__ void tile_of(int L, int nM, int nN, int& pm, int& pn) {
    const int nwg = nM * nN;
    int wgid = L;
    { const int q = nwg / 8, r = nwg % 8, xcd = wgid % 8, off = wgid / 8; wgid = (xcd < r ? xcd * (q + 1) : r * (q + 1) + (xcd - r) * q) + off; }
    const int nig = 8 * nN, gid = wgid / nig, fm = gid * 8, gsz = (nM - fm) < 8 ? (nM - fm) : 8;
    pm = fm + ((wgid % nig) % gsz); pn = (wgid % nig) / gsz;
}
}

#define G8_LAS __attribute__((address_space(3)))
template <bool I8, bool TRANS, class Acc>
__device__ __forceinline__ void g8_mma(Acc& c, const bf16x8& a, const bf16x8& b) {
    if constexpr (I8) {
        const i32x4 ai = __builtin_bit_cast(i32x4, a), bi = __builtin_bit_cast(i32x4, b);
        c = TRANS ? __builtin_amdgcn_mfma_i32_16x16x64_i8(ai, bi, c, 0, 0, 0) : __builtin_amdgcn_mfma_i32_16x16x64_i8(bi, ai, c, 0, 0, 0);
    } else {
        c = TRANS ? __builtin_amdgcn_mfma_f32_16x16x32_bf16(a, b, c, 0, 0, 0) : __builtin_amdgcn_mfma_f32_16x16x32_bf16(b, a, c, 0, 0, 0);
    }
}
template <bool I8> struct g8_acc { using type = f32x4; };
template <> struct g8_acc<true> { using type = i32x4; };
template <bool I8, class Acc> __device__ __forceinline__ f32x4 g8_cvt(const Acc& a) {
    if constexpr (I8) return (f32x4){(float)a[0], (float)a[1], (float)a[2], (float)a[3]};
    else return a;
}
template <bool TRANS, bool ROWSS, bool I8, class Epi>
__device__ __forceinline__ void gemm256_tile(const void* __restrict__ A, const void* __restrict__ Bt, int K, int brow, int bcol,
                                             char* shmc, const Epi& epi) {
    using namespace g8;
    constexpr int ES = I8 ? 1 : 2;
    using acc_t = typename g8_acc<I8>::type;
    G8_LAS unsigned char* lds = (G8_LAS unsigned char*)shmc;
    const int tid = threadIdx.x, wid = __builtin_amdgcn_readfirstlane(tid >> 6), lane = tid & 63, wr = wid >> 2, wc = wid & 3, fr = lane & 15, fq = lane >> 4;
    constexpr int HTB = HALF * BK * 2;
    unsigned voff[2];
#pragma unroll
    for (int i = 0; i < 2; ++i) { int R, C; stage_rc(tid * 16 + i * 8192, R, C); voff[i] = (unsigned)(R * K * ES + C * 2); }
    const size_t kstep = (size_t)(BK * 2);
    const size_t hstep = (size_t)HALF * K * ES;
    const unsigned ldsw = (unsigned)wid * 1024u;
    const int aoff = lds_byte(wr * 64 + fr, fq * 8), boff = lds_byte(wc * 32 + fr, fq * 8);
    const char* cA = (const char*)A + (size_t)brow * K * ES;
    const char* cB = (const char*)Bt + (size_t)bcol * K * ES;
#define G8_SA(b, h) (((b) * 2 + (h)) * HTB)
#define G8_SB(b, h) ((4 + (b) * 2 + (h)) * HTB)
#define G8_STAGE(bufoff, gbase) do { _Pragma("unroll") for (int _i = 0; _i < 2; ++_i) \
        __builtin_amdgcn_global_load_lds((const unsigned*)((const char*)(gbase) + voff[_i]), (G8_LAS unsigned*)(lds + (bufoff) + ldsw + _i * 8192), 16, 0, 0); } while (0)
#define G8_LDA(dst, b, h) do { _Pragma("unroll") for (int m = 0; m < 4; ++m) _Pragma("unroll") for (int k = 0; k < 2; ++k) dst[m][k] = *(const G8_LAS bf16x8*)(lds + G8_SA(b, h) + aoff + m * 2048 + k * 1024); } while (0)
#define G8_LDB(dst, b, h) do { _Pragma("unroll") for (int n = 0; n < 2; ++n) _Pragma("unroll") for (int k = 0; k < 2; ++k) dst[n][k] = *(const G8_LAS bf16x8*)(lds + G8_SB(b, h) + boff + n * 2048 + k * 1024); } while (0)
#define G8_MMA(ai, bj, At_, Bt_) do { __builtin_amdgcn_s_setprio(1); _Pragma("unroll") for (int m = 0; m < 4; ++m) _Pragma("unroll") for (int n = 0; n < 2; ++n) _Pragma("unroll") for (int k = 0; k < 2; ++k) \
        g8_mma<I8, TRANS>(acc[ai][bj][m][n], At_[m][k], Bt_[n][k]); \
        __builtin_amdgcn_s_setprio(0); } while (0)
#define G8_WAIT_V(n) asm volatile("s_waitcnt vmcnt(" #n ")" ::: "memory")
#define G8_WAIT_L(n) asm volatile("s_waitcnt lgkmcnt(" #n ")" ::: "memory")
#define G8_BAR __builtin_amdgcn_s_barrier()
#define G8_SCHED __builtin_amdgcn_sched_barrier(0)
    acc_t acc[2][2][4][2];
#pragma unroll
    for (int a = 0; a < 2; ++a)
#pragma unroll
        for (int b = 0; b < 2; ++b)
#pragma unroll
            for (int m = 0; m < 4; ++m)
#pragma unroll
                for (int n = 0; n < 2; ++n) acc[a][b][m][n] = (acc_t){0, 0, 0, 0};
    bf16x8 At[4][2], B0[2][2], B1[2][2];
    const int nt = K * ES / (BK * 2);
    __syncthreads();
    G8_STAGE(G8_SB(0, 0), cB); G8_STAGE(G8_SA(0, 0), cA); G8_STAGE(G8_SB(0, 1), cB + hstep); G8_STAGE(G8_SA(0, 1), cA + hstep);
    if (wr == 1) G8_BAR;
    G8_WAIT_V(4); G8_BAR;
    G8_STAGE(G8_SB(1, 0), cB + kstep); G8_STAGE(G8_SA(1, 0), cA + kstep); G8_STAGE(G8_SB(1, 1), cB + hstep + kstep);
    G8_WAIT_V(6); G8_BAR;
    for (int t = 0; t < nt - 2; t += 2) {
        const char* a1 = cA + (size_t)(t + 1) * kstep; const char* a2 = a1 + kstep; const char* a3 = a2 + kstep;
        const char* b2 = cB + (size_t)(t + 2) * kstep; const char* b3 = b2 + kstep;
        G8_LDB(B0, 0, 0); G8_SCHED; G8_LDA(At, 0, 0); G8_STAGE(G8_SA(1, 1), a1 + hstep);
        G8_WAIT_L(8); G8_BAR; G8_WAIT_L(0); G8_MMA(0, 0, At, B0); G8_BAR; G8_SCHED;
        G8_LDB(B1, 0, 1); G8_STAGE(G8_SB(0, 0), b2);
        G8_BAR; G8_WAIT_L(0); G8_MMA(0, 1, At, B1); G8_BAR;
        G8_LDA(At, 0, 1); G8_STAGE(G8_SA(0, 0), a2);
        G8_BAR; G8_WAIT_L(0); G8_MMA(1, 0, At, B0); G8_BAR; G8_SCHED;
        G8_STAGE(G8_SB(0, 1), b2 + hstep);
        G8_WAIT_V(6); G8_BAR; G8_MMA(1, 1, At, B1); G8_BAR;
        G8_LDB(B0, 1, 0); G8_SCHED; G8_LDA(At, 1, 0); G8_STAGE(G8_SA(0, 1), a2 + hstep);
        G8_WAIT_L(8); G8_BAR; G8_WAIT_L(0); G8_MMA(0, 0, At, B0); G8_BAR; G8_SCHED;
        G8_LDB(B1, 1, 1); G8_STAGE(G8_SB(1, 0), b3);
        G8_BAR; G8_WAIT_L(0); G8_MMA(0, 1, At, B1); G8_BAR;
        G8_LDA(At, 1, 1); G8_STAGE(G8_SA(1, 0), a3);
        G8_BAR; G8_WAIT_L(0); G8_MMA(1, 0, At, B0); G8_BAR; G8_SCHED;
        G8_STAGE(G8_SB(1, 1), b3 + hstep);
        G8_WAIT_V(6); G8_BAR; G8_MMA(1, 1, At, B1); G8_BAR;
    }
    { G8_LDB(B0, 0, 0); G8_LDA(At, 0, 0); G8_STAGE(G8_SA(1, 1), cA + (size_t)(nt - 1) * kstep + hstep);
      G8_BAR; G8_WAIT_L(0); G8_MMA(0, 0, At, B0); G8_BAR;
      G8_LDB(B1, 0, 1); G8_BAR; G8_WAIT_L(0); G8_MMA(0, 1, At, B1); G8_BAR;
      G8_LDA(At, 0, 1); G8_WAIT_V(4); G8_BAR; G8_WAIT_L(0); G8_MMA(1, 0, At, B0); G8_MMA(1, 1, At, B1); G8_BAR; }
    { G8_LDB(B0, 1, 0); G8_LDA(At, 1, 0); G8_WAIT_V(2); G8_BAR; G8_WAIT_L(0); G8_MMA(0, 0, At, B0); G8_BAR;
      G8_LDB(B1, 1, 1); G8_WAIT_V(0); G8_BAR; G8_WAIT_L(0); G8_MMA(0, 1, At, B1); G8_BAR;
      G8_LDA(At, 1, 1); G8_BAR; G8_WAIT_L(0); G8_MMA(1, 0, At, B0); G8_MMA(1, 1, At, B1); G8_BAR; }
    if (wr == 0) G8_BAR;
    if constexpr (ROWSS) {
#pragma unroll
        for (int ai = 0; ai < 2; ++ai)
#pragma unroll
            for (int m = 0; m < 4; ++m) {
                const int row = brow + ai * HALF + wr * 64 + m * 16 + fr;
                float ssq = 0.f, am = 0.f;
#pragma unroll
                for (int bj = 0; bj < 2; ++bj)
#pragma unroll
                    for (int n = 0; n < 2; ++n) epi(row, bcol + bj * HALF + wc * 32 + n * 16 + fq * 4, g8_cvt<I8>(acc[ai][bj][m][n]), ssq, am);
                ssq += __shfl_xor(ssq, 16);
                ssq += __shfl_xor(ssq, 32);
                am = fmaxf(am, __shfl_xor(am, 16));
                am = fmaxf(am, __shfl_xor(am, 32));
                if (fq == 0) epi.row_done(row, ssq, am);
            }
    } else {
#pragma unroll
        for (int ai = 0; ai < 2; ++ai)
#pragma unroll
            for (int bj = 0; bj < 2; ++bj)
#pragma unroll
                for (int m = 0; m < 4; ++m)
#pragma unroll
                    for (int n = 0; n < 2; ++n) {
                        if (TRANS) epi(brow + ai * HALF + wr * 64 + m * 16 + fq * 4, bcol + bj * HALF + wc * 32 + n * 16 + fr, g8_cvt<I8>(acc[ai][bj][m][n]));
                        else epi(brow + ai * HALF + wr * 64 + m * 16 + fr, bcol + bj * HALF + wc * 32 + n * 16 + fq * 4, g8_cvt<I8>(acc[ai][bj][m][n]));
                    }
    }
#undef G8_SA
#undef G8_SB
#undef G8_STAGE
#undef G8_LDA
#undef G8_LDB
#undef G8_MMA
#undef G8_WAIT_V
#undef G8_WAIT_L
#undef G8_BAR
#undef G8_SCHED
}

__device__ void phase_gemm_in(const Params& p, char* smem) {
    const int nM = NTOK / 256, nN = INW / 256;
    for (int i = 0; i * (int)gridDim.x + (int)blockIdx.x < nM * nN; ++i) {
        int pm, pn;
        g8::tile_of(i * gridDim.x + blockIdx.x, nM, nN, pm, pn);
        if (pn >= 4 && pn < 6) {
            const int bb = (pm * 256) / T, rr = (pm * 256) % T;
            EpiBf16TSStaged e1t{p.vT() + ((size_t)bb * 512 + (pn * 256 - 1024)) * T + rr, p.sa(), p.sb(), smem, pm * 256, pn * 256};
            gemm256_tile<true, false, true>(p.hq(), p.w_in_q(), D, pm * 256, pn * 256, smem, e1t);
            __syncthreads();
            e1t.finish();
        } else {
            EpiBf16SStaged e1{p.z(), INW, p.sa(), p.sb(), smem, pm * 256, pn * 256};
            gemm256_tile<false, false, true>(p.hq(), p.w_in_q(), D, pm * 256, pn * 256, smem, e1);
            __syncthreads();
            e1.finish();
        }
    }
}

__device__ void phase_gemm_kv(const Params& p, char* smh) {
    EpiBf16 e2{p.kvb(), 512};
    EpiBf16T e2t{p.kvT(), 256, 256, 256};
    const bool dedicated = gridDim.x >= 64;
    if (dedicated && blockIdx.x >= 16) return;
    for (int it = VBID; it < 32; it += dedicated ? 32 : VGRID) {
        const int pm = it >> 2, pn = it & 3;
        if (pn >= 2) gemm_tile<true>(p.memn(), D, p.w_kv_t(), D, D, pm * 128, pn * 128, smh, e2t);
        else gemm_tile<false>(p.memn(), D, p.w_kv_t(), D, D, pm * 128, pn * 128, smh, e2);
    }
}

__device__ void phase_gemm_out(const Params& p, char* smem) {
    const int nM = NTOK / 256, nN = D / 256;
    EpiResNorm e{p.x1b(), p.x, p.ffn_g, D, p.ss1(), p.hmax()};
    for (int i = 0; i * (int)gridDim.x + (int)blockIdx.x < nM * nN; ++i) {
        int pm, pn;
        g8::tile_of(i * gridDim.x + blockIdx.x, nM, nN, pm, pn);
        gemm256_tile<false, true, false>(p.mix(), p.w_out_t(), D, pm * 256, pn * 256, smem, e);
    }
}

__device__ void phase_gemm_q(const Params& p, char* smem) {
    const int nM = NTOK / 256, nN = QW / 256;
    EpiBf16RowScale e{p.z(), QW, p.ss1()};
    for (int i = 0; i * (int)gridDim.x + (int)blockIdx.x < nM * nN; ++i) {
        int pm, pn;
        g8::tile_of(i * gridDim.x + blockIdx.x, nM, nN, pm, pn);
        gemm256_tile<false, false, false>(p.h(), p.w_q_t(), D, pm * 256, pn * 256, smem, e);
    }
}

typedef float f32x16 __attribute__((ext_vector_type(16)));
constexpr int HRS = 144;
__device__ __forceinline__ f32x16 tile_mm64(const char* X, const char* Y, int xrow0, int yrow0, int lane, f32x16 acc) {
    const int r = lane & 31, hh = lane >> 5;
#pragma unroll
    for (int ks = 0; ks < 4; ++ks) {
        const bf16x8 a = *(const bf16x8*)(X + (xrow0 + r) * HRS + ks * 32 + hh * 16);
        const bf16x8 b = *(const bf16x8*)(Y + (yrow0 + r) * HRS + ks * 32 + hh * 16);
        acc = __builtin_amdgcn_mfma_f32_32x32x16_bf16(a, b, acc, 0, 0, 0);
    }
    return acc;
}
__device__ __forceinline__ int crow(int reg, int hh) { return (reg & 3) + 8 * (reg >> 2) + 4 * hh; }

__device__ __forceinline__ void hg_load_vt(const Params& p, char* sVT, int tok0, int h, int kcol, int sq) {
    const bf16_t* zp = p.z() + (size_t)(tok0 + sq * 16) * INW + 2304 + h * 64 + kcol;
    unsigned pk[8];
#pragma unroll
    for (int j = 0; j < 8; ++j) {
        const unsigned lo = zp[(size_t)(2 * j) * INW], hi = zp[(size_t)(2 * j + 1) * INW];
        pk[j] = lo | (hi << 16);
    }
    *(uint4*)(sVT + kcol * HRS + sq * 32) = make_uint4(pk[0], pk[1], pk[2], pk[3]);
    *(uint4*)(sVT + kcol * HRS + sq * 32 + 16) = make_uint4(pk[4], pk[5], pk[6], pk[7]);
}

__device__ __forceinline__ float hg_gates(const Params& p, float* sTot, int tok0, int h, int dir, int kcol, int sq, float (&bj)[16], float (&kk)[16]) {
    const bf16_t* zp = p.z() + (size_t)(tok0 + sq * 16) * INW + 1792 + dir * 256 + h * 64 + kcol;
    const float lbv = p.lb()[dir * 256 + h * 64 + kcol];
#pragma unroll
    for (int j = 0; j < 16; ++j) {
        const float pre = bf2f(zp[(size_t)j * INW]);
        const float f = lbv + (1.0f - lbv) * (1.0f / (1.0f + __expf(-pre)));
        bj[j] = __logf(f);
        kk[j] = 1.0f - f;
    }
    if (dir == 0) {
#pragma unroll
        for (int j = 1; j < 16; ++j) bj[j] += bj[j - 1];
        sTot[sq * 64 + kcol] = bj[15];
    } else {
#pragma unroll
        for (int j = 14; j >= 0; --j) bj[j] += bj[j + 1];
        sTot[sq * 64 + kcol] = bj[0];
    }
    __syncthreads();
    const float t0 = sTot[kcol], t1 = sTot[64 + kcol], t2 = sTot[128 + kcol], t3 = sTot[192 + kcol];
    float off;
    if (dir == 0) off = (sq > 0 ? t0 : 0.f) + (sq > 1 ? t1 : 0.f) + (sq > 2 ? t2 : 0.f);
    else off = (sq < 3 ? t3 : 0.f) + (sq < 2 ? t2 : 0.f) + (sq < 1 ? t1 : 0.f);
#pragma unroll
    for (int j = 0; j < 16; ++j) bj[j] += off;
    return t0 + t1 + t2 + t3;
}

__device__ void hg_local(const Params& p, char* smem) {
    char* sVT = smem;
    char* sKT = smem + 9216;
    float* sTot = (float*)(smem + 18432);
    const int tid = VTID, lane = tid & 63, w = tid >> 6;
    const int kcol = tid & 63, sq = tid >> 6;
    for (int item = VBID; item < 4096; item += VGRID) {
        const int c = item & 127, dir = (item >> 7) & 1, h = (item >> 8) & 3, b = item >> 10;
        const int tok0 = b * T + c * 64;
        __syncthreads();
        hg_load_vt(p, sVT, tok0, h, kcol, sq);
        float bj[16], kk[16];
        const float btot = hg_gates(p, sTot, tok0, h, dir, kcol, sq, bj, kk);
        unsigned pk[8];
#pragma unroll
        for (int j = 0; j < 8; ++j)
            pk[j] = pack2(kk[2 * j] * __expf(btot - bj[2 * j]), kk[2 * j + 1] * __expf(btot - bj[2 * j + 1]));
        *(uint4*)(sKT + kcol * HRS + sq * 32) = make_uint4(pk[0], pk[1], pk[2], pk[3]);
        *(uint4*)(sKT + kcol * HRS + sq * 32 + 16) = make_uint4(pk[4], pk[5], pk[6], pk[7]);
        if (sq == 0) p.hdec()[item * 64 + kcol] = __expf(btot);
        __syncthreads();
        const int vi = w >> 1, ki = w & 1, hh = lane >> 5;
        f32x16 acc;
#pragma unroll
        for (int r = 0; r < 16; ++r) acc[r] = 0.f;
        acc = tile_mm64(sVT, sKT, vi * 32, ki * 32, lane, acc);
        bf16_t* dst = (bf16_t*)p.hstate() + (size_t)item * 4096 + ki * 32 + (lane & 31);
#pragma unroll
        for (int r = 0; r < 16; ++r) dst[(vi * 32 + crow(r, hh)) * 64] = f2bf(acc[r]);
    }
}

__device__ __forceinline__ bf16x8 pack8(const f32x16& x, int s8) {
    typedef unsigned u32x4_t __attribute__((ext_vector_type(4)));
    u32x4_t pk;
    pk[0] = pack2(x[s8], x[s8 + 1]); pk[1] = pack2(x[s8 + 2], x[s8 + 3]);
    pk[2] = pack2(x[s8 + 4], x[s8 + 5]); pk[3] = pack2(x[s8 + 6], x[s8 + 7]);
    return __builtin_bit_cast(bf16x8, pk);
}
__device__ __forceinline__ bf16x8 join8(const uint2& lo, const uint2& hi) {
    typedef unsigned u32x4_t __attribute__((ext_vector_type(4)));
    u32x4_t pk; pk[0] = lo.x; pk[1] = lo.y; pk[2] = hi.x; pk[3] = hi.y;
    return __builtin_bit_cast(bf16x8, pk);
}

__device__ __forceinline__ int swap23(int r) { return (r & ~12) | ((r & 4) << 1) | ((r & 8) >> 1); }

__device__ __forceinline__ void mem_attn_wave(const Params& p, int wu, int lane, const char* sK, const char* sV) {
    const int tile = wu & 255, h = (wu >> 8) & 3, b = wu >> 10;
    const int l31 = lane & 31, hh = lane >> 5;
    const int tok = b * T + tile * 32 + l31;
    bf16x8 qf[4];
#pragma unroll
    for (int ks = 0; ks < 4; ++ks) qf[ks] = *(const bf16x8*)(p.z() + (size_t)tok * INW + 2816 + h * 64 + ks * 16 + hh * 8);
    const char* kb = sK + swap23(l31) * 144 + hh * 16;
    float m = -1e30f;
    f32x16 o0, o1;
#pragma unroll
    for (int r = 0; r < 16; ++r) { o0[r] = 0.f; o1[r] = 0.f; }
    float sum = 0.f;
    const char* vt = sV + l31 * 528 + hh * 16;
#pragma unroll 2
    for (int kt = 0; kt < 8; ++kt) {
        bf16x8 kf[4], vf[4];
#pragma unroll
        for (int ks = 0; ks < 4; ++ks) kf[ks] = *(const bf16x8*)(kb + kt * 32 * 144 + ks * 32);
#pragma unroll
        for (int st = 0; st < 2; ++st) { vf[2 * st] = *(const bf16x8*)(vt + kt * 64 + st * 32); vf[2 * st + 1] = *(const bf16x8*)(vt + 32 * 528 + kt * 64 + st * 32); }
        f32x16 s;
#pragma unroll
        for (int r = 0; r < 16; ++r) s[r] = 0.f;
#pragma unroll
        for (int ks = 0; ks < 4; ++ks) s = __builtin_amdgcn_mfma_f32_32x32x16_bf16(kf[ks], qf[ks], s, 0, 0, 0);
        float tm = s[0];
#pragma unroll
        for (int r = 1; r < 16; ++r) tm = fmaxf(tm, s[r]);
        tm = fmaxf(tm, __shfl_xor(tm, 32));
        const float mn = fmaxf(m, tm);
        if (__any(mn > m)) {
            const float sc = __builtin_amdgcn_exp2f((m - mn) * 0.18033688011112042f);
            sum *= sc;
#pragma unroll
            for (int r = 0; r < 16; ++r) { o0[r] *= sc; o1[r] *= sc; }
        }
        m = mn;
        const float mb = mn * 0.18033688011112042f;
#pragma unroll
        for (int r = 0; r < 16; ++r) { s[r] = __builtin_amdgcn_exp2f(fmaf(s[r], 0.18033688011112042f, -mb)); sum += s[r]; }
#pragma unroll
        for (int st = 0; st < 2; ++st) {
            const bf16x8 pb = pack8(s, st * 8);
            o0 = __builtin_amdgcn_mfma_f32_32x32x16_bf16(vf[2 * st], pb, o0, 0, 0, 0);
            o1 = __builtin_amdgcn_mfma_f32_32x32x16_bf16(vf[2 * st + 1], pb, o1, 0, 0, 0);
        }
    }
    sum += __shfl_xor(sum, 32);
    const float inv = 1.0f / sum;
    bf16_t* mo = p.mix() + (size_t)tok * D + 768 + h * 64 + 4 * hh;
#pragma unroll
    for (int g = 0; g < 4; ++g) {
        uint2 pk;
        pk.x = pack2(o0[4 * g] * inv, o0[4 * g + 1] * inv); pk.y = pack2(o0[4 * g + 2] * inv, o0[4 * g + 3] * inv);
        *(uint2*)(mo + 8 * g) = pk;
        pk.x = pack2(o1[4 * g] * inv, o1[4 * g + 1] * inv); pk.y = pack2(o1[4 * g + 2] * inv, o1[4 * g + 3] * inv);
        *(uint2*)(mo + 32 + 8 * g) = pk;
    }
}

struct NaCtx {
    const bf16_t* kbase; const bf16_t* vbase; const float* bh;
    int rs, r, c, c0, cb, hh;
    bf16x8 qf[4];
    float m, sum;
    f32x16 o0, o1;
};
template <int TI>
__device__ __forceinline__ void na_load(const NaCtx& x, bf16x8 (&kf)[4], bf16x8 (&vf)[4]) {
    constexpr int ip = TI / 3, cg = TI % 3;
    const bf16_t* kp = x.kbase + (size_t)(ip * 128 + cg * 16) * INW;
#pragma unroll
    for (int ks = 0; ks < 4; ++ks) kf[ks] = *(const bf16x8*)(kp + ks * 16);
    const bf16_t* vr = x.vbase + ip * 128 + cg * 16;
#pragma unroll
    for (int st = 0; st < 2; ++st) { vf[2 * st] = *(const bf16x8*)(vr + st * 64); vf[2 * st + 1] = *(const bf16x8*)(vr + (size_t)32 * T + st * 64); }
}
template <int TI>
__device__ __forceinline__ void na_comp(NaCtx& x, const bf16x8 (&kf)[4], const bf16x8 (&vf)[4]) {
    constexpr int ip = TI / 3, cg = TI % 3;
    f32x16 s;
#pragma unroll
    for (int q = 0; q < 16; ++q) s[q] = 0.f;
#pragma unroll
    for (int ks = 0; ks < 4; ++ks) s = __builtin_amdgcn_mfma_f32_32x32x16_bf16(kf[ks], x.qf[ks], s, 0, 0, 0);
    const int kc0 = x.cb + 16 * cg + 8 * x.hh;
    const float* brow = x.bh + (x.rs + 2 * ip - x.r + 7) * 31 + 15 - x.c + kc0;
    const int d0 = kc0 - x.c0;
    float tm = -1e30f;
    float bv[16];
#pragma unroll
    for (int q = 0; q < 16; ++q) bv[q] = brow[(q & 3) + 4 * ((q >> 2) & 1) + 31 * (q >> 3)];
#pragma unroll
    for (int q = 0; q < 16; ++q) asm volatile("" : "+v"(bv[q]));
#pragma unroll
    for (int q = 0; q < 16; ++q) {
        const int cq = (q & 3) + 4 * ((q >> 2) & 1);
        const bool valid = (unsigned)(d0 + cq) < 16u;
        const float sc = valid ? fmaf(s[q], 0.18033688011112042f, bv[q]) : -INFINITY;
        s[q] = sc;
        tm = fmaxf(tm, sc);
    }
    tm = fmaxf(tm, __shfl_xor(tm, 32));
    const float mn = fmaxf(x.m, tm);
    if (__any(mn > x.m)) {
        const float scl = __builtin_amdgcn_exp2f(x.m - mn);
        x.sum *= scl;
#pragma unroll
        for (int q = 0; q < 16; ++q) { x.o0[q] *= scl; x.o1[q] *= scl; }
    }
    x.m = mn;
#pragma unroll
    for (int q = 0; q < 16; ++q) { const float pe = __builtin_amdgcn_exp2f(s[q] - mn); s[q] = pe; x.sum += pe; }
#pragma unroll
    for (int st = 0; st < 2; ++st) {
        const bf16x8 pb = pack8(s, st * 8);
        x.o0 = __builtin_amdgcn_mfma_f32_32x32x16_bf16(vf[2 * st], pb, x.o0, 0, 0, 0);
        x.o1 = __builtin_amdgcn_mfma_f32_32x32x16_bf16(vf[2 * st + 1], pb, x.o1, 0, 0, 0);
    }
}

__device__ __forceinline__ void na_attn_wave(const Params& p, int wu, int lane, const float* sbias) {
    const int j = wu & 1, h = (wu >> 1) & 7, r = (wu >> 4) & 127, b = wu >> 11;
    const int l31 = lane & 31, hh = lane >> 5;
    NaCtx x;
    x.hh = hh; x.r = r;
    x.c = 32 * j + l31;
    x.c0 = min(max(x.c - 8, 0), 48); x.rs = min(max(r - 4, 0), 120);
    const int tokq = b * T + r * 64 + x.c;
    x.cb = 16 * j;
#pragma unroll
    for (int ks = 0; ks < 4; ++ks) x.qf[ks] = *(const bf16x8*)(p.z() + (size_t)tokq * INW + h * 64 + ks * 16 + hh * 8);
    x.bh = sbias + 64 + h * 465;
    const int kap = swap23(l31);
    x.kbase = p.z() + (size_t)(b * T + (x.rs + (kap >> 4)) * 64 + x.cb + (kap & 15)) * INW + 512 + h * 64 + hh * 8;
    x.vbase = p.vT() + ((size_t)(b * 8 + h) * 64 + l31) * T + x.rs * 64 + x.cb + 8 * hh;
    x.m = -1e30f; x.sum = 0.f;
#pragma unroll
    for (int q = 0; q < 16; ++q) { x.o0[q] = 0.f; x.o1[q] = 0.f; }
    bf16x8 k0[4], v0[4], k1[4], v1[4], k2[4], v2[4], k3[4], v3[4];
    na_load<0>(x, k0, v0); na_load<1>(x, k1, v1); na_load<2>(x, k2, v2);
    na_load<3>(x, k3, v3);  na_comp<0>(x, k0, v0);
    na_load<4>(x, k0, v0);  na_comp<1>(x, k1, v1);
    na_load<5>(x, k1, v1);  na_comp<2>(x, k2, v2);
    na_load<6>(x, k2, v2);  na_comp<3>(x, k3, v3);
    na_load<7>(x, k3, v3);  na_comp<4>(x, k0, v0);
    na_load<8>(x, k0, v0);  na_comp<5>(x, k1, v1);
    na_load<9>(x, k1, v1);  na_comp<6>(x, k2, v2);
    na_load<10>(x, k2, v2); na_comp<7>(x, k3, v3);
    na_load<11>(x, k3, v3); na_comp<8>(x, k0, v0);
    na_comp<9>(x, k1, v1);
    na_comp<10>(x, k2, v2);
    na_comp<11>(x, k3, v3);
    float sum = x.sum;
    sum += __shfl_xor(sum, 32);
    const float inv = 1.0f / sum;
    bf16_t* mo = p.mix() + (size_t)tokq * D + h * 64 + 4 * hh;
#pragma unroll
    for (int g = 0; g < 4; ++g) {
        uint2 pk;
        pk.x = pack2(x.o0[4 * g] * inv, x.o0[4 * g + 1] * inv); pk.y = pack2(x.o0[4 * g + 2] * inv, x.o0[4 * g + 3] * inv);
        *(uint2*)(mo + 8 * g) = pk;
        pk.x = pack2(x.o1[4 * g] * inv, x.o1[4 * g + 1] * inv); pk.y = pack2(x.o1[4 * g + 2] * inv, x.o1[4 * g + 3] * inv);
        *(uint2*)(mo + 32 + 8 * g) = pk;
    }
}

__device__ void phase_mixers(const Params& p, char* smem) {
    const int tid = VTID, lane = tid & 63, w = tid >> 6;
    {
        float* sbias = (float*)smem;
        __syncthreads();
        for (int i = tid; i < 8 * 465; i += 256) sbias[64 + i] = p.rpb[i] * 1.4426950408889634f;
        __syncthreads();
        for (int wu = VBID * 4 + w; wu < 8192; wu += VGRID * 4) na_attn_wave(p, wu, lane, sbias);
    }
    __syncthreads();
    hg_local(p, smem);
}

__device__ void phase_hg_scan(const Params& p) {
    const int tid = VTID;
    const int skip = gridDim.x >= 64 ? 32 : 0;
    if (VBID < skip) return;
    for (int item = VBID - skip; item < 512; item += VGRID - skip) {
        const int g = item * 256 + tid;
        const int seq = g >> 12, kv = g & 4095, k = kv & 63;
        const int dir = seq & 1;
        float S = 0.f;
        for (int cc0 = 0; cc0 < 128; cc0 += 8) {
            float L[8], d[8];
#pragma unroll
            for (int u = 0; u < 8; ++u) {
                const int c = dir ? 127 - (cc0 + u) : cc0 + u;
                const size_t it = (size_t)seq * 128 + c;
                L[u] = bf2f(((const bf16_t*)p.hstate())[it * 4096 + kv]);
                d[u] = p.hdec()[it * 64 + k];
            }
#pragma unroll
            for (int u = 0; u < 8; ++u) {
                const int c = dir ? 127 - (cc0 + u) : cc0 + u;
                const size_t it = (size_t)seq * 128 + c;
                ((bf16_t*)p.h())[it * 4096 + kv] = f2bf(S);
                S = d[u] * S + L[u];
            }
        }
    }
}

struct HgIn { unsigned v[8], q[8], f[2][8]; uint2 st[2][4]; uint2 gz[4]; };
__device__ __forceinline__ void hg_in_load(const Params& p, HgIn& d, int item, int tid) {
    const int kcol = tid & 63, sq = tid >> 6, w = tid >> 6, l31 = tid & 31, hh = (tid >> 5) & 1;
    const int c = item & 127, h = (item >> 7) & 3, b = item >> 9;
    const int tok0 = b * T + c * 64;
    const unsigned short* zp = (const unsigned short*)p.z() + (size_t)(tok0 + sq * 16) * INW + h * 64 + kcol;
#pragma unroll
    for (int j = 0; j < 8; ++j) {
        const unsigned short* z0 = zp + (size_t)(2 * j) * INW;
        const unsigned short* z1 = z0 + INW;
        d.q[j] = (unsigned)z0[1536] | ((unsigned)z1[1536] << 16);
        d.f[0][j] = (unsigned)z0[1792] | ((unsigned)z1[1792] << 16);
        d.f[1][j] = (unsigned)z0[2048] | ((unsigned)z1[2048] << 16);
        d.v[j] = (unsigned)z0[2304] | ((unsigned)z1[2304] << 16);
    }
#pragma unroll
    for (int dir = 0; dir < 2; ++dir) {
        const bf16_t* sp = (const bf16_t*)p.h() + ((size_t)(((b * 4 + h) * 2 + dir) * 128 + c)) * 4096;
#pragma unroll
        for (int i = 0; i < 4; ++i) d.st[dir][i] = *(const uint2*)(sp + tid * 4 + 1024 * i);
    }
    const int vi = w >> 1, ti = w & 1;
    const int tok = tok0 + ti * 32 + l31;
#pragma unroll
    for (int g = 0; g < 4; ++g) d.gz[g] = *(const uint2*)(p.z() + (size_t)tok * INW + 2560 + h * 64 + vi * 32 + 8 * g + 4 * hh);
}
__device__ __forceinline__ float hg_gates_r(const Params& p, float* sTot, const unsigned (&fp)[8], int h, int dir, int kcol, int sq, float (&bj)[16], float (&kk)[16]) {
    const float lbv = p.lb()[dir * 256 + h * 64 + kcol];
#pragma unroll
    for (int j = 0; j < 16; ++j) {
        const float pre = (j & 1) ? bfhi(fp[j >> 1]) : bflo(fp[j >> 1]);
        const float f = lbv + (1.0f - lbv) * (1.0f / (1.0f + __expf(-pre)));
        bj[j] = __logf(f);
        kk[j] = 1.0f - f;
    }
    if (dir == 0) {
#pragma unroll
        for (int j = 1; j < 16; ++j) bj[j] += bj[j - 1];
        sTot[sq * 64 + kcol] = bj[15];
    } else {
#pragma unroll
        for (int j = 14; j >= 0; --j) bj[j] += bj[j + 1];
        sTot[sq * 64 + kcol] = bj[0];
    }
    __syncthreads();
    const float t0 = sTot[kcol], t1 = sTot[64 + kcol], t2 = sTot[128 + kcol], t3 = sTot[192 + kcol];
    float off;
    if (dir == 0) off = (sq > 0 ? t0 : 0.f) + (sq > 1 ? t1 : 0.f) + (sq > 2 ? t2 : 0.f);
    else off = (sq < 3 ? t3 : 0.f) + (sq < 2 ? t2 : 0.f) + (sq < 1 ? t1 : 0.f);
#pragma unroll
    for (int j = 0; j < 16; ++j) bj[j] += off;
    return t0 + t1 + t2 + t3;
}

__device__ void phase_hg_out(const Params& p, char* smem) {
    char* sQt = smem;
    char* sKt = smem + 9216;
    char* sQh = smem + 18432;
    char* sVT = smem + 27648;
    char* sST = smem + 36864;
    char* sP = smem + 46080;
    float* sTot = (float*)(smem + 55296);
    float* sSS = sTot + 256;
    const int tid = VTID, lane = tid & 63, w = tid >> 6;
    const int kcol = tid & 63, sq = tid >> 6;
    const int l31 = lane & 31, hh = lane >> 5;
    HgIn cur, nxt;
    if (VBID < 2048) hg_in_load(p, cur, VBID, tid);
    for (int item = VBID; item < 2048; item += VGRID) {
        const int c = item & 127, h = (item >> 7) & 3, b = item >> 9;
        const int tok0 = b * T + c * 64;
        (void)c; (void)b;
        if (item + VGRID < 2048) hg_in_load(p, nxt, item + VGRID, tid);
        __syncthreads();
        *(uint4*)(sVT + kcol * HRS + sq * 32) = make_uint4(cur.v[0], cur.v[1], cur.v[2], cur.v[3]);
        *(uint4*)(sVT + kcol * HRS + sq * 32 + 16) = make_uint4(cur.v[4], cur.v[5], cur.v[6], cur.v[7]);
        float qv[16];
#pragma unroll
        for (int j = 0; j < 16; ++j) qv[j] = (j & 1) ? bfhi(cur.q[j >> 1]) : bflo(cur.q[j >> 1]);
        f32x16 accO;
#pragma unroll
        for (int r = 0; r < 16; ++r) accO[r] = 0.f;
        for (int dir = 0; dir < 2; ++dir) {
            float bj[16], kk[16];
            const float btot = hg_gates_r(p, sTot, cur.f[dir], h, dir, kcol, sq, bj, kk);
            const float bref = 0.5f * btot;
#pragma unroll
            for (int j = 0; j < 16; ++j) {
                const int s = sq * 16 + j;
                *(bf16_t*)(sQt + s * HRS + kcol * 2) = f2bf(qv[j] * __expf(bj[j] - bref));
                *(bf16_t*)(sKt + s * HRS + kcol * 2) = f2bf(kk[j] * __expf(bref - bj[j]));
                *(bf16_t*)(sQh + s * HRS + kcol * 2) = f2bf(qv[j] * __expf(bj[j]));
            }
#pragma unroll
            for (int i = 0; i < 4; ++i) {
                const int idx = tid * 4 + 1024 * i;
                *(uint2*)(sST + (idx >> 6) * HRS + (idx & 63) * 2) = cur.st[dir][i];
            }
            __syncthreads();
            {
                const int si = w >> 1, ti = w & 1;
                const bool live = dir == 0 ? (si <= ti) : (si >= ti);
                f32x16 pt;
#pragma unroll
                for (int r = 0; r < 16; ++r) pt[r] = 0.f;
                if (live) pt = tile_mm64(sKt, sQt, si * 32, ti * 32, lane, pt);
                const int t = ti * 32 + l31;
#pragma unroll
                for (int g = 0; g < 4; ++g) {
                    const int s0 = si * 32 + 8 * g + 4 * hh;
                    float v0 = pt[4 * g], v1 = pt[4 * g + 1], v2 = pt[4 * g + 2], v3 = pt[4 * g + 3];
                    if (dir == 0) {
                        if (s0 > t) v0 = 0.f; if (s0 + 1 > t) v1 = 0.f; if (s0 + 2 > t) v2 = 0.f; if (s0 + 3 > t) v3 = 0.f;
                    } else {
                        if (s0 < t) v0 = 0.f; if (s0 + 1 < t) v1 = 0.f; if (s0 + 2 < t) v2 = 0.f; if (s0 + 3 < t) v3 = 0.f;
                    }
                    uint2 pk; pk.x = pack2(v0, v1); pk.y = pack2(v2, v3);
                    *(uint2*)(sP + t * HRS + s0 * 2) = pk;
                }
            }
            __syncthreads();
            {
                const int vi = w >> 1, ti = w & 1;
                accO = tile_mm64(sVT, sP, vi * 32, ti * 32, lane, accO);
                accO = tile_mm64(sST, sQh, vi * 32, ti * 32, lane, accO);
            }
            __syncthreads();
        }
        const int vi = w >> 1, ti = w & 1;
        float ssq = 0.f;
#pragma unroll
        for (int r = 0; r < 16; ++r) ssq += accO[r] * accO[r];
        ssq += __shfl_xor(ssq, 32);
        sSS[w * 64 + lane] = ssq;
        __syncthreads();
        const float tot = sSS[ti * 64 + l31] + sSS[(2 + ti) * 64 + l31];
        const float rs = rsqrtf(tot * (1.0f / 64.0f) + EPS);
        const int tok = tok0 + ti * 32 + l31;
#pragma unroll
        for (int g = 0; g < 4; ++g) {
            const int v0 = vi * 32 + 8 * g + 4 * hh;
            const uint2 gz = cur.gz[g];
            const float4 gn = *(const float4*)(p.hg_g + h * 64 + v0);
            const float g0 = bflo(gz.x), g1 = bfhi(gz.x), g2 = bflo(gz.y), g3 = bfhi(gz.y);
            const float o0 = accO[4 * g] * rs * gn.x * (g0 / (1.0f + __expf(-g0)));
            const float o1 = accO[4 * g + 1] * rs * gn.y * (g1 / (1.0f + __expf(-g1)));
            const float o2 = accO[4 * g + 2] * rs * gn.z * (g2 / (1.0f + __expf(-g2)));
            const float o3 = accO[4 * g + 3] * rs * gn.w * (g3 / (1.0f + __expf(-g3)));
            uint2 pk; pk.x = pack2(o0, o1); pk.y = pack2(o2, o3);
            *(uint2*)(p.mix() + (size_t)tok * D + 512 + h * 64 + v0) = pk;
        }
        cur = nxt;
    }
    for (int base = VBID * 4; base < 4096; base += VGRID * 4) {
        const int h = (base >> 8) & 3, b = base >> 10;
        char* sK = smem;
        char* sV = smem + 36864;
        __syncthreads();
        {
            uint4 kk[8], vv[8];
#pragma unroll
            for (int i = 0; i < 8; ++i) {
                const int ch = tid + 256 * i;
                kk[i] = *(const uint4*)(p.kvb() + (size_t)(b * 256 + (ch >> 3)) * 512 + h * 64 + (ch & 7) * 8);
                vv[i] = *(const uint4*)(p.kvT() + ((size_t)(b * 4 + h) * 64 + (ch >> 5)) * 256 + (ch & 31) * 8);
            }
#pragma unroll
            for (int i = 0; i < 8; ++i) {
                const int ch = tid + 256 * i;
                *(uint4*)(sK + (ch >> 3) * 144 + (ch & 7) * 16) = kk[i];
                *(uint4*)(sV + (ch >> 5) * 528 + (ch & 31) * 16) = vv[i];
            }
        }
        __syncthreads();
        mem_attn_wave(p, base + w, lane, sK, sV);
    }
}


__device__ __forceinline__ int ord_key(int fb) { return fb ^ ((fb >> 31) & 0x7FFFFFFF); }

template <int N>
__device__ __forceinline__ void bitonic_sort_desc(int (&v)[N]) {
#pragma unroll
    for (int k = 2; k <= N; k <<= 1) {
#pragma unroll
        for (int j = k >> 1; j > 0; j >>= 1) {
#pragma unroll
            for (int i = 0; i < N; ++i) {
                const int l = i ^ j;
                if (l > i) {
                    const bool desc = ((i & k) == 0);
                    const int a = v[i], b = v[l];
                    const int mx = max(a, b), mn = min(a, b);
                    v[i] = desc ? mx : mn;
                    v[l] = desc ? mn : mx;
                }
            }
        }
    }
}
template <int N>
__device__ __forceinline__ void bitonic_merge_desc(int (&v)[N]) {
#pragma unroll
    for (int j = N >> 1; j > 0; j >>= 1) {
#pragma unroll
        for (int i = 0; i < N; ++i) {
            const int l = i ^ j;
            if (l > i) {
                const int a = v[i], b = v[l];
                v[i] = max(a, b);
                v[l] = min(a, b);
            }
        }
    }
}
__device__ __forceinline__ void merge_prune16(int (&r)[16], const int (&o)[16]) {
#pragma unroll
    for (int i = 0; i < 16; ++i) r[i] = max(r[i], o[15 - i]);
    bitonic_merge_desc<16>(r);
}

constexpr int QRS = 528;
struct EpiQpLds {
    char* qt; const float* ssrow; const unsigned* hmax; const float* sb; int brow, bcol;
    __device__ __forceinline__ void operator()(int row, int col, const f32x4& v) const {
        const float rs = rsqrtf(ssrow[row] * (1.0f / 1024.0f) + EPS) * __uint_as_float(hmax[row]) * (1.0f / 127.0f);
        const float4 b = *(const float4*)(sb + col);
        uint2 pk; pk.x = pack2(v[0] * rs * b.x, v[1] * rs * b.y); pk.y = pack2(v[2] * rs * b.z, v[3] * rs * b.w);
        *(uint2*)(qt + (row - brow) * QRS + (col - bcol) * 2) = pk;
    }
};
__device__ __forceinline__ int* route_slot(char* wrows, int e) { return (int*)(wrows + (e >> 6) * QRS + (e & 63) * 4); }

__device__ __forceinline__ void route_tile(const Params& p, char* qt, int tok0, int h) {
    const int tid = threadIdx.x, lane = tid & 63, w = tid >> 6;
    const int tl = lane & 31, hh = lane >> 5;
    char* wrows = qt + (w * 32) * QRS;
    const int tok = tok0 + w * 32 + tl;
    const bf16_t* sp = p.subk_b() + (size_t)(h * 2) * 16384 + tl * 128 + hh * 8;
    bf16x8 an[8];
#pragma unroll
    for (int ks = 0; ks < 8; ++ks) an[ks] = *(const bf16x8*)(sp + ks * 16);
#pragma unroll
    for (int c = 0; c < 2; ++c) {
        bf16x8 qf[8];
#pragma unroll
        for (int ks = 0; ks < 8; ++ks) qf[ks] = *(const bf16x8*)(wrows + tl * QRS + (c * 128 + ks * 16 + hh * 8) * 2);
        int cur[16];
#pragma unroll
        for (int kb = 0; kb < 4; ++kb) {
            bf16x8 af[8];
#pragma unroll
            for (int ks = 0; ks < 8; ++ks) af[ks] = an[ks];
            if (c * 4 + kb + 1 < 8) {
                const bf16_t* sn = sp + (c * 4 + kb + 1) * 4096;
#pragma unroll
                for (int ks = 0; ks < 8; ++ks) an[ks] = *(const bf16x8*)(sn + ks * 16);
            }
            f32x16 acc;
#pragma unroll
            for (int r = 0; r < 16; ++r) acc[r] = 0.f;
#pragma unroll
            for (int ks = 0; ks < 8; ++ks) acc = __builtin_amdgcn_mfma_f32_32x32x16_bf16(af[ks], qf[ks], acc, 0, 0, 0);
            int v[16];
#pragma unroll
            for (int r = 0; r < 16; ++r) {
                const int key = kb * 32 + (r & 3) + 8 * (r >> 2) + 4 * hh;
                const int fb = (__float_as_int(acc[r]) & ~127) | (127 - key);
                v[r] = ord_key(fb);
            }
            bitonic_sort_desc<16>(v);
            if (kb == 0) {
#pragma unroll
                for (int r = 0; r < 16; ++r) cur[r] = v[r];
            } else {
                merge_prune16(cur, v);
            }
            __builtin_amdgcn_sched_barrier(0);
        }
        {
            int o[16];
#pragma unroll
            for (int r = 0; r < 16; ++r) o[r] = __shfl_xor(cur[r], 32);
            merge_prune16(cur, o);
        }
#pragma unroll
        for (int r = 0; r < 16; ++r) *route_slot(wrows, c * 512 + r * 32 + tl) = cur[r];
        __builtin_amdgcn_sched_barrier(0);
    }
    float va[16], vb[16];
#pragma unroll
    for (int r = 0; r < 16; ++r) {
        const int fa = ord_key(*route_slot(wrows, r * 32 + tl)), fb = ord_key(*route_slot(wrows, 512 + r * 32 + tl));
        va[r] = __int_as_float(fa & ~127);
        vb[r] = __int_as_float(fb & ~127);
    }
    int best[16];
#pragma unroll
    for (int j = 0; j < 16; ++j) best[j] = ord_key((__float_as_int(va[0] + vb[j]) & ~255) | (255 - j));
#pragma unroll
    for (int i = 1; i < 8; ++i) {
        const int n = 16 / (i + 1);
        int row[16];
#pragma unroll
        for (int j = 0; j < 16; ++j)
            row[j] = (j < n) ? ord_key((__float_as_int(va[i] + vb[j]) & ~255) | (255 - (i * 16 + j))) : (int)0x80000000;
        merge_prune16(best, row);
    }
    {
        int row[16];
#pragma unroll
        for (int j = 0; j < 16; ++j)
            row[j] = (j < 8) ? ord_key((__float_as_int(va[8 + j] + vb[0]) & ~255) | (255 - ((8 + j) * 16))) : (int)0x80000000;
        merge_prune16(best, row);
    }
    float sv[16];
    int pid[16];
#pragma unroll
    for (int r = 0; r < 16; ++r) {
        const int cb = ord_key(best[r]);
        sv[r] = __int_as_float(cb & ~255);
        pid[r] = 255 - (cb & 255);
    }
    float tot = 0.f;
    const float smax = sv[0];
#pragma unroll
    for (int r = 0; r < 16; ++r) { sv[r] = __expf(sv[r] - smax); tot += sv[r]; }
    const float inv = 1.0f / tot;
    if (hh == 0) {
#pragma unroll
        for (int r = 0; r < 16; ++r) {
            const int ia = 127 - (ord_key(*route_slot(wrows, (pid[r] >> 4) * 32 + tl)) & 127);
            const int ib = 127 - (ord_key(*route_slot(wrows, 512 + (pid[r] & 15) * 32 + tl)) & 127);
            const int pos = (r & 7) * 16 + h * 2 + (r >> 3);
            p.eidx()[(size_t)tok * 128 + pos] = (unsigned short)(ia * 128 + ib);
            p.gate()[(size_t)tok * 128 + pos] = sv[r] * inv;
        }
    }
}

__device__ void phase_gemm_q_route(const Params& p, char* smem) {
    const int nM = NTOK / 256, nN = QW / 256;
    for (int i = 0; i * (int)gridDim.x + (int)blockIdx.x < nM * nN; ++i) {
        int pm, pn;
        g8::tile_of(i * gridDim.x + blockIdx.x, nM, nN, pm, pn);
        EpiQpLds e{smem, p.ss1(), p.hmax(), p.sb() + INW, pm * 256, pn * 256};
        gemm256_tile<false, false, true>(p.h2q(), p.w_q_q(), D, pm * 256, pn * 256, smem, e);
        __syncthreads();
        route_tile(p, smem, pm * 256, pn);
    }
}

__device__ void phase_route(const Params& p, char* smem) {
    char* sk = smem;
    const int tid = VTID, lane = tid & 63, w = tid >> 6;
    int* sA = (int*)(smem + 32768) + w * 2048;
    int* sB = (int*)(smem + 65536) + w * 512;
    const int tl = lane & 31, hh = lane >> 5;
    const int h = VBID & 7, tg0 = VBID >> 3, tgs = VGRID >> 3;
    for (int base = tg0; base < 256; base += 4 * tgs)
    for (int c = 0; c < 2; ++c) {
        const int hc = h * 2 + c;
        __syncthreads();
        {
            const bf16_t* sp = p.subk_b() + (size_t)hc * 16384;
#pragma unroll
            for (int i = 0; i < 8; ++i) {
                const int ch = tid + 256 * i;
                const int row = ch >> 4, cc = ch & 15;
                const uint4 v = *(const uint4*)(sp + row * 128 + cc * 8);
                *(uint4*)(sk + row * 256 + ((cc ^ (row & 15)) << 4)) = v;
            }
        }
        __syncthreads();
        bf16x8 qf[8];
        if (base < 256) {
            const bf16_t* qr = p.z() + (size_t)(base * 128 + w * 32 + tl) * QW + hc * 128 + hh * 8;
#pragma unroll
            for (int ks = 0; ks < 8; ++ks) qf[ks] = *(const bf16x8*)(qr + ks * 16);
        }
        for (int it = 0; it < 4; ++it) {
            const int tgp = base + it * tgs;
            if (tgp >= 256) break;
            const int tok = tgp * 128 + w * 32 + tl;
            int* sidx = sA + it * 512;
            f32x16 acc4[4];
#pragma unroll
            for (int kb = 0; kb < 4; ++kb) {
#pragma unroll
                for (int r = 0; r < 16; ++r) acc4[kb][r] = 0.f;
                const int row = kb * 32 + tl;
#pragma unroll
                for (int ks = 0; ks < 8; ++ks) {
                    const bf16x8 af = *(const bf16x8*)(sk + row * 256 + (((ks * 2 + hh) ^ (row & 15)) << 4));
                    acc4[kb] = __builtin_amdgcn_mfma_f32_32x32x16_bf16(af, qf[ks], acc4[kb], 0, 0, 0);
                }
            }
            if (it + 1 < 4 && tgp + tgs < 256) {
                const bf16_t* qr = p.z() + (size_t)((tgp + tgs) * 128 + w * 32 + tl) * QW + hc * 128 + hh * 8;
#pragma unroll
                for (int ks = 0; ks < 8; ++ks) qf[ks] = *(const bf16x8*)(qr + ks * 16);
            }
            int cur[16];
#pragma unroll
            for (int kb = 0; kb < 4; ++kb) {
                int v[16];
#pragma unroll
                for (int r = 0; r < 16; ++r) {
                    const int key = kb * 32 + (r & 3) + 8 * (r >> 2) + 4 * hh;
                    const int fb = (__float_as_int(acc4[kb][r]) & ~127) | (127 - key);
                    v[r] = ord_key(fb);
                }
                bitonic_sort_desc<16>(v);
                if (kb == 0) {
#pragma unroll
                    for (int r = 0; r < 16; ++r) cur[r] = v[r];
                } else {
                    merge_prune16(cur, v);
                }
            }
            {
                int o[16];
#pragma unroll
                for (int r = 0; r < 16; ++r) o[r] = __shfl_xor(cur[r], 32);
                merge_prune16(cur, o);
            }
            if (c == 0) {
#pragma unroll
                for (int r = 0; r < 16; ++r) sidx[r * 32 + tl] = cur[r];
                continue;
            }
#pragma unroll
            for (int r = 0; r < 16; ++r) sB[r * 32 + tl] = cur[r];
        float va[16], vb[16];
#pragma unroll
        for (int r = 0; r < 16; ++r) {
            const int fa = ord_key(sidx[r * 32 + tl]), fb = ord_key(sB[r * 32 + tl]);
            va[r] = __int_as_float(fa & ~127);
            vb[r] = __int_as_float(fb & ~127);
        }
        int best[16];
#pragma unroll
        for (int j = 0; j < 16; ++j) best[j] = ord_key((__float_as_int(va[0] + vb[j]) & ~255) | (255 - j));
#pragma unroll
        for (int i = 1; i < 8; ++i) {
            const int n = 16 / (i + 1);
            int row[16];
#pragma unroll
            for (int j = 0; j < 16; ++j)
                row[j] = (j < n) ? ord_key((__float_as_int(va[i] + vb[j]) & ~255) | (255 - (i * 16 + j))) : (int)0x80000000;
            merge_prune16(best, row);
        }
        {
            int row[16];
#pragma unroll
            for (int j = 0; j < 16; ++j)
                row[j] = (j < 8) ? ord_key((__float_as_int(va[8 + j] + vb[0]) & ~255) | (255 - ((8 + j) * 16))) : (int)0x80000000;
            merge_prune16(best, row);
        }
        float sv[16];
        int pid[16];
#pragma unroll
        for (int r = 0; r < 16; ++r) {
            const int cb = ord_key(best[r]);
            sv[r] = __int_as_float(cb & ~255);
            pid[r] = 255 - (cb & 255);
        }
        float tot = 0.f;
        const float smax = sv[0];
#pragma unroll
        for (int r = 0; r < 16; ++r) { sv[r] = __expf(sv[r] - smax); tot += sv[r]; }
        const float inv = 1.0f / tot;
        if (hh == 0) {
#pragma unroll
            for (int r = 0; r < 16; ++r) {
                const int ia = 127 - (ord_key(sidx[(pid[r] >> 4) * 32 + tl]) & 127);
                const int ib = 127 - (ord_key(sB[(pid[r] & 15) * 32 + tl]) & 127);
                const int pos = (r & 7) * 16 + h * 2 + (r >> 3);
                p.eidx()[(size_t)tok * 128 + pos] = (unsigned short)(ia * 128 + ib);
                p.gate()[(size_t)tok * 128 + pos] = sv[r] * inv;
            }
        }
        }
    }
}

constexpr int PEER_TG = 512;
constexpr int PEER_TPW = PEER_TG / 8;
constexpr int PEER_NTG = NTOK / PEER_TG;
constexpr int PEER_NCH = 8;

#define PEER_G1(base, wv, hi) (*(const uint4*)((base) + (unsigned)((((hi) ? ((wv) >> 16) : ((wv) & 0xFFFFu)) << 7) + dlo)))
#define PEER_GATHER16(dst, base, ia, ib)                                                             \
    dst[0] = PEER_G1(base, (ia).x, 0);  dst[1] = PEER_G1(base, (ia).x, 1);  dst[2] = PEER_G1(base, (ia).y, 0);  dst[3] = PEER_G1(base, (ia).y, 1);   \
    dst[4] = PEER_G1(base, (ia).z, 0);  dst[5] = PEER_G1(base, (ia).z, 1);  dst[6] = PEER_G1(base, (ia).w, 0);  dst[7] = PEER_G1(base, (ia).w, 1);   \
    dst[8] = PEER_G1(base, (ib).x, 0);  dst[9] = PEER_G1(base, (ib).x, 1);  dst[10] = PEER_G1(base, (ib).y, 0); dst[11] = PEER_G1(base, (ib).y, 1);  \
    dst[12] = PEER_G1(base, (ib).z, 0); dst[13] = PEER_G1(base, (ib).z, 1); dst[14] = PEER_G1(base, (ib).w, 0); dst[15] = PEER_G1(base, (ib).w, 1);

__device__ __forceinline__ unsigned quant4(float a, float b, float c, float d, float qs) {
    const int q0 = (int)rintf(__builtin_amdgcn_fmed3f(a * qs, -127.f, 127.f)), q1 = (int)rintf(__builtin_amdgcn_fmed3f(b * qs, -127.f, 127.f));
    const int q2 = (int)rintf(__builtin_amdgcn_fmed3f(c * qs, -127.f, 127.f)), q3 = (int)rintf(__builtin_amdgcn_fmed3f(d * qs, -127.f, 127.f));
    return (unsigned)(q0 & 255) | ((unsigned)(q1 & 255) << 8) | ((unsigned)(q2 & 255) << 16) | ((unsigned)(q3 & 255) << 24);
}
__device__ void phase_quant_h2(const Params& p) {
    const int tid = VTID, lane = tid & 63, w = tid >> 6;
    for (int r0 = VBID * 4; r0 < NTOK; r0 += VGRID * 4) {
        const int r = r0 + w;
        const uint4* xp = (const uint4*)(p.x1b() + (size_t)r * D + lane * 16);
        const uint4 xa = xp[0], xb = xp[1];
        const float4* gp = (const float4*)(p.ffn_g + lane * 16);
        const float4 g0 = gp[0], g1 = gp[1], g2 = gp[2], g3 = gp[3];
        const float hm = __uint_as_float(p.hmax()[r]);
        const float qs = hm > 0.f ? 127.0f / hm : 0.f;
        uint4 o;
        o.x = quant4(bflo(xa.x) * g0.x, bfhi(xa.x) * g0.y, bflo(xa.y) * g0.z, bfhi(xa.y) * g0.w, qs);
        o.y = quant4(bflo(xa.z) * g1.x, bfhi(xa.z) * g1.y, bflo(xa.w) * g1.z, bfhi(xa.w) * g1.w, qs);
        o.z = quant4(bflo(xb.x) * g2.x, bfhi(xb.x) * g2.y, bflo(xb.y) * g2.z, bfhi(xb.y) * g2.w, qs);
        o.w = quant4(bflo(xb.z) * g3.x, bfhi(xb.z) * g3.y, bflo(xb.w) * g3.z, bfhi(xb.w) * g3.w, qs);
        *(uint4*)(p.h2q() + (size_t)r * D + lane * 16) = o;
    }
}

template <int CTRL>
__device__ __forceinline__ int dpp_movi(int v) { return __builtin_amdgcn_update_dpp(0, v, CTRL, 0xf, 0xf, true); }

struct DotTok { uint4 ia, ib; uint4 ha; };
__device__ __forceinline__ void dots_load(const Params& p, DotTok& t, int tok, int c, int g, int d8) {
    const uint4* idp = (const uint4*)(p.eidx() + (size_t)tok * 128 + g * 16);
    t.ia = idp[0]; t.ib = idp[1];
    t.ha = *(const uint4*)(p.h2q() + (size_t)tok * D + c * 128 + d8 * 16);
}
__device__ __forceinline__ void dotsf_load(const Params& p, DotTok& t, int tokb, int s, int g, int d8) {
    dots_load(p, t, tokb + 8 * (s & 15), s >> 4, g, d8);
}
__device__ __forceinline__ void dotsf_finish(const uint4 (&uu)[16], const DotTok& t, int* part, int g, int d8) {
    const int h0 = (int)t.ha.x, h1 = (int)t.ha.y, h2 = (int)t.ha.z, h3 = (int)t.ha.w;
    int acc[16];
#pragma unroll
    for (int i = 0; i < 16; ++i) {
        int a = __builtin_amdgcn_sdot4((int)uu[i].x, h0, 0, false);
        a = __builtin_amdgcn_sdot4((int)uu[i].y, h1, a, false);
        a = __builtin_amdgcn_sdot4((int)uu[i].z, h2, a, false);
        a = __builtin_amdgcn_sdot4((int)uu[i].w, h3, a, false);
        a += dpp_movi<DPP_QP_X1>(a);
        a += dpp_movi<DPP_QP_X2>(a);
        a += dpp_movi<DPP_HMIRROR>(a);
        acc[i] = a;
    }
    if (d8 == 0) {
#pragma unroll
        for (int i = 0; i < 16; ++i) (void)__hip_atomic_fetch_add(part + g * 16 + i, acc[i], __ATOMIC_RELAXED, __HIP_MEMORY_SCOPE_WORKGROUP);
    }
}

__device__ __forceinline__ float gelu_erf(float v);

__device__ void phase_peer_dots(const Params& p, char* smem) {
    const int tid = threadIdx.x, lane = tid & 63, w = tid >> 6;
    const int g = lane >> 3, d8 = lane & 7;
    int* part = (int*)smem + w * 2048;
    for (int tgp = blockIdx.x; tgp < NTOK / 128; tgp += gridDim.x) {
        const int tokb = tgp * 128 + w;
        __syncthreads();
        for (int i = lane; i < 2048; i += 64) part[i] = 0;
        __syncthreads();
        const char* ubase = (const char*)p.u_c();
        const unsigned dlo = d8 * 16;
        DotTok ta, tb, tn;
        uint4 ua[16], ubuf[16];
        dotsf_load(p, ta, tokb, 0, g, d8);
        dotsf_load(p, tb, tokb, 1, g, d8);
        PEER_GATHER16(ua, ubase, ta.ia, ta.ib)
        PEER_GATHER16(ubuf, ubase, tb.ia, tb.ib)
        dotsf_load(p, tn, tokb, 2, g, d8);
        for (int s = 0; s < 128; s += 2) {
            dotsf_finish(ua, ta, part + (s & 15) * 128, g, d8);
            if (s + 2 < 128) {
                ta = tn;
                const char* ub = ubase + (size_t)((s + 2) >> 4) * 16384 * 128;
                PEER_GATHER16(ua, ub, ta.ia, ta.ib)
                dotsf_load(p, tn, tokb, min(s + 3, 127), g, d8);
            }
            dotsf_finish(ubuf, tb, part + ((s + 1) & 15) * 128, g, d8);
            if (s + 3 < 128) {
                tb = tn;
                const char* ub = ubase + (size_t)((s + 3) >> 4) * 16384 * 128;
                PEER_GATHER16(ubuf, ub, tb.ia, tb.ib)
                dotsf_load(p, tn, tokb, min(s + 4, 127), g, d8);
            }
        }
        __syncthreads();
        for (int k0 = 0; k0 < 16; k0 += 4) {
            int ps[4][2], e[4][2];
            float gt[4][2], sh[4];
#pragma unroll
            for (int q = 0; q < 4; ++q) {
                const int tok = tokb + 8 * (k0 + q);
                sh[q] = __uint_as_float(p.hmax()[tok]) * (1.0f / 127.0f) * rsqrtf(p.ss1()[tok] * (1.0f / 1024.0f) + EPS);
#pragma unroll
                for (int u = 0; u < 2; ++u) {
                    const int slot = lane + 64 * u;
                    ps[q][u] = part[(k0 + q) * 128 + slot];
                    e[q][u] = p.eidx()[(size_t)tok * 128 + slot];
                    gt[q][u] = p.gate()[(size_t)tok * 128 + slot];
                }
            }
            float su[4][2], sv[4][2];
#pragma unroll
            for (int q = 0; q < 4; ++q)
#pragma unroll
                for (int u = 0; u < 2; ++u) { su[q][u] = p.scale_u()[e[q][u]]; sv[q][u] = p.scale_v()[e[q][u]]; }
#pragma unroll
            for (int q = 0; q < 4; ++q) {
                const int tok = tokb + 8 * (k0 + q);
                float cf[2];
#pragma unroll
                for (int u = 0; u < 2; ++u) cf[u] = gelu_erf((float)ps[q][u] * su[q][u] * sh[q]) * gt[q][u] * sv[q][u];
                const float cm = wave_max(fmaxf(fabsf(cf[0]), fabsf(cf[1])));
                const float qs = cm > 0.f ? 127.0f / cm : 0.f;
                p.coef()[(size_t)tok * 128 + lane] = (signed char)(int)rintf(cf[0] * qs);
                p.coef()[(size_t)tok * 128 + lane + 64] = (signed char)(int)rintf(cf[1] * qs);
                if (lane == 0) p.csum()[tok] = cm * (1.0f / 127.0f);
            }
        }
    }
}

__device__ __forceinline__ float gelu_erf(float v) {
    const float av = fabsf(v);
    const float t = __builtin_amdgcn_rcpf(fmaf(av, 0.2316418882f, 1.0f));
    float q = fmaf(t, 0.5307027145f, -0.7265760135f);
    q = fmaf(q, t, 0.7107068705f);
    q = fmaf(q, t, -0.142248368f);
    q = fmaf(q, t, 0.127414796f);
    q = q * t;
    const float e = __builtin_amdgcn_exp2f(v * v * -0.72134752044f);
    const float m = v * (q * e);
    return v < 0.f ? m : v - m;
}
struct AccTok { uint4 ia, ib; uint4 cq; float cs; };
__device__ __forceinline__ void acc_load(const Params& p, AccTok& t, int tok, int g) {
    const uint4* idp = (const uint4*)(p.eidx() + (size_t)tok * 128 + g * 16);
    t.ia = idp[0]; t.ib = idp[1];
    t.cq = *(const uint4*)(p.coef() + (size_t)tok * 128 + g * 16);
    t.cs = p.csum()[tok];
}
#define PEER_T4DOT(acc, B, r0, r1, r2, r3, cq)                                   \
    {                                                                            \
        const unsigned t0 = __builtin_amdgcn_perm(r1, r0, 0x05010400u), t1 = __builtin_amdgcn_perm(r1, r0, 0x07030602u); \
        const unsigned t2 = __builtin_amdgcn_perm(r3, r2, 0x05010400u), t3 = __builtin_amdgcn_perm(r3, r2, 0x07030602u); \
        acc[(B) + 0] = __builtin_amdgcn_sdot4((int)__builtin_amdgcn_perm(t2, t0, 0x05040100u), (int)(cq), acc[(B) + 0], false); \
        acc[(B) + 1] = __builtin_amdgcn_sdot4((int)__builtin_amdgcn_perm(t2, t0, 0x07060302u), (int)(cq), acc[(B) + 1], false); \
        acc[(B) + 2] = __builtin_amdgcn_sdot4((int)__builtin_amdgcn_perm(t3, t1, 0x05040100u), (int)(cq), acc[(B) + 2], false); \
        acc[(B) + 3] = __builtin_amdgcn_sdot4((int)__builtin_amdgcn_perm(t3, t1, 0x07060302u), (int)(cq), acc[(B) + 3], false); \
    }
__device__ __forceinline__ void accf_finish(const uint4 (&vv)[16], const AccTok& t, char* rowp, int g) {
    const unsigned cw[4] = {t.cq.x, t.cq.y, t.cq.z, t.cq.w};
    int acc[16];
#pragma unroll
    for (int j = 0; j < 16; ++j) acc[j] = 0;
#pragma unroll
    for (int j = 0; j < 4; ++j) {
        PEER_T4DOT(acc, 0, vv[4 * j].x, vv[4 * j + 1].x, vv[4 * j + 2].x, vv[4 * j + 3].x, cw[j])
        PEER_T4DOT(acc, 4, vv[4 * j].y, vv[4 * j + 1].y, vv[4 * j + 2].y, vv[4 * j + 3].y, cw[j])
        PEER_T4DOT(acc, 8, vv[4 * j].z, vv[4 * j + 1].z, vv[4 * j + 2].z, vv[4 * j + 3].z, cw[j])
        PEER_T4DOT(acc, 12, vv[4 * j].w, vv[4 * j + 1].w, vv[4 * j + 2].w, vv[4 * j + 3].w, cw[j])
    }
    int t8[8], u4[4];
#pragma unroll
    for (int j = 0; j < 8; ++j) {
        const auto r = __builtin_amdgcn_permlane32_swap((unsigned)acc[j], (unsigned)acc[j + 8], false, false);
        t8[j] = (int)(r[0] + r[1]);
    }
#pragma unroll
    for (int j = 0; j < 4; ++j) {
        const auto r = __builtin_amdgcn_permlane16_swap((unsigned)t8[j], (unsigned)t8[j + 4], false, false);
        u4[j] = (int)(r[0] + r[1]);
    }
    float o[4];
#pragma unroll
    for (int j = 0; j < 4; ++j) {
        int v = u4[j];
        v += dpp_movi<DPP_ROR8>(v);
        o[j] = (float)v * t.cs;
    }
    if ((g & 1) == 0) {
        const int rho = g >> 1;
        uint2 w0; w0.x = pack2(o[0], o[1]); w0.y = pack2(o[2], o[3]);
        *(uint2*)(rowp + (4 * (rho & 1) + 8 * (rho >> 1)) * 2) = w0;
    }
}

__device__ void phase_peer_accum(const Params& p, char* smem) {
    const int tid = threadIdx.x, lane = tid & 63, w = tid >> 6;
    const int g = lane >> 3, d8 = lane & 7;
    char* rowbuf = smem + w * 16384;
    for (int tgp = blockIdx.x; tgp < NTOK / 64; tgp += gridDim.x) {
        const int tokb = tgp * 64 + w;
        __syncthreads();
        const char* vbase = (const char*)p.v_c();
        const unsigned dlo = d8 * 16;
        AccTok ta, tb, tn;
        uint4 va[16], vbuf[16];
        acc_load(p, ta, tokb, g);
        acc_load(p, tb, tokb + 8, g);
        PEER_GATHER16(va, vbase, ta.ia, ta.ib)
        PEER_GATHER16(vbuf, vbase, tb.ia, tb.ib)
        acc_load(p, tn, tokb + 16, g);
        for (int s = 0; s < 64; s += 2) {
            accf_finish(va, ta, rowbuf + (s & 7) * 2048 + (s >> 3) * 256 + d8 * 32, g);
            if (s + 2 < 64) {
                ta = tn;
                const char* vb = vbase + (size_t)((s + 2) >> 3) * 16384 * 128;
                PEER_GATHER16(va, vb, ta.ia, ta.ib)
                acc_load(p, tn, tokb + 8 * (min(s + 3, 63) & 7), g);
            }
            accf_finish(vbuf, tb, rowbuf + ((s + 1) & 7) * 2048 + ((s + 1) >> 3) * 256 + d8 * 32, g);
            if (s + 3 < 64) {
                tb = tn;
                const char* vb = vbase + (size_t)((s + 3) >> 3) * 16384 * 128;
                PEER_GATHER16(vbuf, vb, tb.ia, tb.ib)
                acc_load(p, tn, tokb + 8 * (min(s + 4, 63) & 7), g);
            }
        }
        __syncthreads();
        for (int k0 = 0; k0 < 8; k0 += 2) {
            float4 v[2][4];
#pragma unroll
            for (int q = 0; q < 2; ++q) {
                const bf16_t* xrow = p.x1b() + (size_t)(tokb + 8 * (k0 + q)) * D;
#pragma unroll
                for (int j = 0; j < 4; ++j) {
                    const uint2 xk = *(const uint2*)(xrow + (j * 64 + lane) * 4);
                    v[q][j] = make_float4(bflo(xk.x), bfhi(xk.x), bflo(xk.y), bfhi(xk.y));
                }
            }
#pragma unroll
            for (int q = 0; q < 2; ++q) {
                float* orow = p.out + (size_t)(tokb + 8 * (k0 + q)) * D;
                const char* prow = rowbuf + (k0 + q) * 2048;
                float ss = 0.f;
#pragma unroll
                for (int j = 0; j < 4; ++j) {
                    const uint2 pk = *(const uint2*)(prow + (j * 64 + lane) * 8);
                    v[q][j].x += bflo(pk.x); v[q][j].y += bfhi(pk.x); v[q][j].z += bflo(pk.y); v[q][j].w += bfhi(pk.y);
                    ss += v[q][j].x * v[q][j].x + v[q][j].y * v[q][j].y + v[q][j].z * v[q][j].z + v[q][j].w * v[q][j].w;
                }
                ss = wave_sum(ss);
                const float rs = rsqrtf(ss * (1.0f / 1024.0f) + EPS);
#pragma unroll
                for (int j = 0; j < 4; ++j) {
                    const float4 gg = *(const float4*)(p.fin_g + (j * 64 + lane) * 4);
                    float4 o;
                    o.x = v[q][j].x * rs * gg.x; o.y = v[q][j].y * rs * gg.y; o.z = v[q][j].z * rs * gg.z; o.w = v[q][j].w * rs * gg.w;
                    *(float4*)(orow + (j * 64 + lane) * 4) = o;
                }
            }
        }
    }
}

#define XB_TMO      128
#define XB_XCNT(j)  (256  + 64 * (j))
#define XB_XSUB(j)  (1280 + 64 * (j))
#define XB_XGEN(j)  (2304 + 64 * (j))
#define XB_TOP      3328
#define XB_TOPGEN   3392
#define XCD_BAR_WORDS 3456
#define XB_SPIN_CAP (1u << 18)
__device__ __forceinline__ unsigned xb_ld(unsigned* p)              { return __hip_atomic_load(p, __ATOMIC_RELAXED, __HIP_MEMORY_SCOPE_AGENT); }
__device__ __forceinline__ unsigned xb_add(unsigned* p, unsigned v) { return __hip_atomic_fetch_add(p, v, __ATOMIC_RELAXED, __HIP_MEMORY_SCOPE_AGENT); }
#define XB_SPIN(cond, bar) do { unsigned _sp = 0; while (cond) { __builtin_amdgcn_s_sleep(1); \
    if ((++_sp & 255u) == 0u) { if (xb_ld(&(bar)[XB_TMO])) break; if (_sp > XB_SPIN_CAP) { atomicAdd(&(bar)[XB_TMO], 1u); break; } } } } while (0)

struct XcdBarrier { unsigned* bar; unsigned x; volatile unsigned* st; };

__device__ __forceinline__ XcdBarrier xcd_barrier_post(unsigned* bar, volatile unsigned* st) {
    XcdBarrier b; b.bar = bar; b.x = xcc_id(); b.st = st;
    if (threadIdx.x == 0) (void)xb_add(&bar[XB_XCNT(b.x)], 1u);
    return b;
}
__device__ __forceinline__ void xcd_barrier_complete(unsigned* bar, unsigned x, unsigned& nloc, unsigned& nx) {
    const unsigned G = gridDim.x * gridDim.y * gridDim.z;
    unsigned sum, cnt, mine, sp = 0u;
    for (;;) {
        sum = 0u; cnt = 0u; mine = 0u;
#pragma unroll
        for (unsigned j = 0; j < 16; ++j) { const unsigned c = xb_ld(&bar[XB_XCNT(j)]); sum += c; cnt += (c > 0u) ? 1u : 0u; mine = (j == x) ? c : mine; }
        if (sum == G) break;
        __builtin_amdgcn_s_sleep(1);
        if ((++sp & 255u) == 0u) { if (xb_ld(&bar[XB_TMO])) break; if (sp > XB_SPIN_CAP) { atomicAdd(&bar[XB_TMO], 1u); break; } }
    }
    nloc = mine > 0u ? mine : 1u; nx = cnt > 0u ? cnt : 1u;
}
__device__ __forceinline__ void xcd_barrier(const XcdBarrier& b) {
    asm volatile("s_waitcnt vmcnt(0)" ::: "memory");
    __syncthreads();
    if (threadIdx.x == 0) {
        unsigned* bar = b.bar;
        __builtin_amdgcn_s_waitcnt(0);
        unsigned nloc = b.st[0], nx = b.st[1];
        if (nloc == 0u) { xcd_barrier_complete(bar, b.x, nloc, nx); b.st[0] = nloc; b.st[1] = nx; }
        const unsigned old = xb_add(&bar[XB_XSUB(b.x)], 1u);
        const unsigned gen = old / nloc;
        if (old + 1u == (gen + 1u) * nloc) {
            __builtin_amdgcn_fence(__ATOMIC_RELEASE, "agent");
            asm volatile("s_waitcnt vmcnt(0)" ::: "memory");
            const unsigned og = xb_add(&bar[XB_TOP], 1u);
            const unsigned tg = og / nx;
            if (og + 1u == (tg + 1u) * nx) xb_add(&bar[XB_TOPGEN], 1u);
            else XB_SPIN(xb_ld(&bar[XB_TOPGEN]) == tg, bar);
            __builtin_amdgcn_fence(__ATOMIC_ACQUIRE, "agent");
            xb_add(&bar[XB_XGEN(b.x)], 1u);
            asm volatile("s_waitcnt vmcnt(0)" ::: "memory");
        } else {
            XB_SPIN(xb_ld(&bar[XB_XGEN(b.x)]) == gen, bar);
            __builtin_amdgcn_fence(__ATOMIC_ACQUIRE, "agent");
            asm volatile("s_waitcnt vmcnt(0)" ::: "memory");
        }
    }
    __syncthreads();
}

#define RUN_PHASE(K, CALL)                                              \
    if (ph_lo <= (K) && (K) < ph_hi) {                                  \
        CALL;                                                           \
        if (COOP) { if ((K) + 1 < ph_hi) { xcd_barrier(xb); } } \
    }

template <bool COOP>
__global__ void __launch_bounds__(512, 2) fwd_kernel(Params p, int ph_lo, int ph_hi) {
    __shared__ __attribute__((aligned(16))) char smem[SMEM_BYTES + 16];
    char* smh = smem + VHB * HALF_SMEM;
    XcdBarrier xb;
    if (COOP) {
        if (threadIdx.x == 0) *(uint4*)(smem + SMEM_BYTES) = make_uint4(0u, 0u, 0u, 0u);
        __syncthreads();
        xb = xcd_barrier_post(p.bar(), (volatile unsigned*)(smem + SMEM_BYTES));
    }
    if (COOP) { if (ph_lo < 0) cg::this_grid().sync(); }
    RUN_PHASE(0, phase_prep(p, smh))
    RUN_PHASE(1, phase_gemm_in(p, smem))
    RUN_PHASE(2, phase_mixers(p, smh))
    RUN_PHASE(3, (phase_gemm_kv(p, smh), phase_hg_scan(p)))
    RUN_PHASE(4, phase_hg_out(p, smh))
    RUN_PHASE(5, phase_gemm_out(p, smem))
    RUN_PHASE(6, phase_quant_h2(p))
    RUN_PHASE(7, phase_gemm_q_route(p, smem))
    RUN_PHASE(10, phase_peer_dots(p, smem))
    RUN_PHASE(12, phase_peer_accum(p, smem))
}

extern "C" void kernel_launch(void* const* d_in, const int* in_sizes, int n_in, void* d_out, int out_size, void* d_ws, size_t ws_size,
                              hipStream_t stream) {
    Params p{};
    p.x = (const float*)d_in[0]; p.mem = (const float*)d_in[1]; p.attn_g = (const float*)d_in[2]; p.w_in = (const float*)d_in[3];
    p.rpb = (const float*)d_in[4]; p.hg_lb = (const float*)d_in[5]; p.hg_g = (const float*)d_in[6]; p.mem_g = (const float*)d_in[7];
    p.w_kv = (const float*)d_in[8]; p.w_out = (const float*)d_in[9]; p.ffn_g = (const float*)d_in[10]; p.w_q = (const float*)d_in[11];
    p.subk = (const float*)d_in[12]; p.pu = (const float*)d_in[13]; p.pv = (const float*)d_in[14]; p.fin_g = (const float*)d_in[15];
    p.out = (float*)d_out;
    p.ws = (char*)d_ws;
    if (WS_TOTAL > ws_size) { fprintf(stderr, "workspace too small: need %zu have %zu\n", (size_t)WS_TOTAL, ws_size); return; }

#if defined(MULTI_LAUNCH)
    for (int ph = 0; ph < NPHASE; ++ph) fwd_kernel<false><<<dim3(512), dim3(512), 0, stream>>>(p, ph, ph + 1);
#else
    static int grid_blocks = 0;
    if (!grid_blocks) {
        int dev = 0, cus = 0, per_cu = 0;
        hipGetDevice(&dev);
        hipDeviceGetAttribute(&cus, hipDeviceAttributeMultiprocessorCount, dev);
        hipOccupancyMaxActiveBlocksPerMultiprocessor(&per_cu, fwd_kernel<true>, 512, 0);
        if (per_cu > 1) per_cu = 1;
        grid_blocks = (cus * per_cu) & ~3;
    }
    (void)hipMemsetAsync((char*)d_ws + OFF_BAR, 0, XCD_BAR_WORDS * 4, stream);
    int lo = 0, hi = NPHASE;
    void* args[] = {&p, &lo, &hi};
    hipError_t e = hipLaunchCooperativeKernel((void*)fwd_kernel<true>, dim3(grid_blocks), dim3(512), args, 0, stream);
    if (e != hipSuccess) fprintf(stderr, "cooperative launch failed: %s (grid %d)\n", hipGetErrorString(e), grid_blocks);
#endif
}
```

```cpp
#include <hip/hip_runtime.h>
#include <hip/hip_cooperative_groups.h>
#include <stdint.h>
#include <cstdio>

namespace cg = cooperative_groups;

#define VTID ((int)(threadIdx.x & 255))
#define VHB ((int)(threadIdx.x >> 8))
#define VBID ((int)(blockIdx.x * 2 + (threadIdx.x >> 8)))
#define VGRID ((int)(gridDim.x * 2))
constexpr int HALF_SMEM = 73728;

typedef unsigned short bf16_t;
typedef short bf16x8 __attribute__((ext_vector_type(8)));
typedef float f32x4 __attribute__((ext_vector_type(4)));
typedef int i32x4 __attribute__((ext_vector_type(4)));

constexpr int D = 1024;
constexpr int NB = 4;
constexpr int T = 8192;
constexpr int NTOK = NB * T;
constexpr int INW = 3072;
constexpr int QW = 2048;
constexpr float EPS = 1e-6f;
constexpr int SMEM_BYTES = 2 * 73728;
constexpr int NPHASE = 14;

constexpr size_t al256(size_t x) { return (x + 255) & ~(size_t)255; }
constexpr size_t OFF_W_IN_T = 0;
constexpr size_t OFF_W_OUT_T = OFF_W_IN_T + al256((size_t)3072 * 1024 * 2);
constexpr size_t OFF_W_Q_T = OFF_W_OUT_T + al256((size_t)1024 * 1024 * 2);
constexpr size_t OFF_W_KV_T = OFF_W_Q_T + al256((size_t)2048 * 1024 * 2);
constexpr size_t OFF_H = OFF_W_KV_T + al256((size_t)512 * 1024 * 2);
constexpr size_t OFF_Z = OFF_H + al256((size_t)32768 * 1024 * 2);
constexpr size_t OFF_MIX = OFF_Z + al256((size_t)32768 * 3072 * 2);
constexpr size_t OFF_MEMN = OFF_MIX + al256((size_t)32768 * 1024 * 2);
constexpr size_t OFF_KVB = OFF_MEMN + al256((size_t)1024 * 1024 * 2);
constexpr size_t OFF_LB = OFF_KVB + al256((size_t)1024 * 512 * 2);
constexpr size_t OFF_HSTATE = OFF_LB + al256(512 * 4);
constexpr size_t OFF_HDEC = OFF_HSTATE + al256((size_t)4096 * 4096 * 4);
constexpr size_t OFF_UC = OFF_HDEC + al256((size_t)4096 * 64 * 4);
constexpr size_t OFF_VC = OFF_UC + al256((size_t)16384 * 1024);
constexpr size_t OFF_QUEUE = OFF_VC + al256((size_t)16384 * 1024);
constexpr size_t OFF_SUBK = OFF_QUEUE + al256(2048 * 4);
constexpr size_t OFF_BAR = OFF_SUBK + al256((size_t)16 * 128 * 128 * 2);
constexpr size_t OFF_SS1 = OFF_BAR + al256(4096 * 4);
constexpr size_t OFF_HMAX = OFF_SS1 + al256((size_t)32768 * 4);
constexpr size_t OFF_CSUM = OFF_HMAX + al256((size_t)32768 * 4);
constexpr size_t OFF_SCALE_U = OFF_CSUM + al256((size_t)32768 * 4);
constexpr size_t OFF_SCALE_V = OFF_SCALE_U + al256(16384 * 4);
constexpr size_t OFF_VT = OFF_SCALE_V + al256(16384 * 4);
constexpr size_t OFF_KVT = OFF_VT + al256((size_t)32768 * 512 * 2);
constexpr size_t OFF_SA = OFF_KVT + al256((size_t)1024 * 256 * 2);
constexpr size_t OFF_SB = OFF_SA + al256((size_t)32768 * 4);
constexpr size_t WS_TOTAL = OFF_SB + al256((size_t)8192 * 4);
constexpr size_t OFF_EIDX = OFF_HSTATE;
constexpr size_t OFF_GATE = OFF_HSTATE + (size_t)32768 * 128 * 4;
constexpr size_t OFF_COEF = OFF_HSTATE + (size_t)32768 * 128 * 8;
constexpr size_t OFF_SS = OFF_HSTATE + (size_t)32768 * 128 * 12;
constexpr size_t OFF_PARTIAL = OFF_Z;
constexpr size_t OFF_PEER_OUT = OFF_Z + (size_t)8 * 32768 * 128 * 4;

struct Params {
    const float *x, *mem, *attn_g, *w_in, *rpb, *hg_lb, *hg_g, *mem_g, *w_kv, *w_out, *ffn_g, *w_q, *subk, *pu, *pv, *fin_g;
    float* out;
    char* ws;
#define WSF(type, name, off) __device__ __forceinline__ type* name() const { return (type*)(ws + (off)); }
    WSF(bf16_t, w_in_t, OFF_W_IN_T) WSF(bf16_t, w_out_t, OFF_W_OUT_T) WSF(bf16_t, w_q_t, OFF_W_Q_T) WSF(bf16_t, w_kv_t, OFF_W_KV_T)
    WSF(bf16_t, h, OFF_H)
    WSF(bf16_t, z, OFF_Z)
    WSF(bf16_t, mix, OFF_MIX)
    WSF(bf16_t, memn, OFF_MEMN)
    WSF(bf16_t, kvb, OFF_KVB)
    WSF(float, lb, OFF_LB)
    WSF(float, hstate, OFF_HSTATE)
    WSF(float, hdec, OFF_HDEC)
    WSF(unsigned short, eidx, OFF_EIDX)
    WSF(float, gate, OFF_GATE)
    WSF(signed char, coef, OFF_COEF)
    WSF(bf16_t, x1b, OFF_PEER_OUT)
    WSF(float, ss, OFF_SS)
    WSF(float, partial, OFF_PARTIAL)
    WSF(bf16_t, u_c, OFF_UC) WSF(bf16_t, v_c, OFF_VC)
    WSF(unsigned, queue, OFF_QUEUE)
    WSF(bf16_t, subk_b, OFF_SUBK)
    WSF(unsigned, bar, OFF_BAR)
    WSF(float, ss1, OFF_SS1) WSF(unsigned, hmax, OFF_HMAX) WSF(float, csum, OFF_CSUM)
    WSF(float, scale_u, OFF_SCALE_U) WSF(float, scale_v, OFF_SCALE_V)
    WSF(bf16_t, vT, OFF_VT)
    WSF(signed char, hq, OFF_H)
    WSF(signed char, w_in_q, OFF_W_IN_T)
    WSF(float, sa, OFF_SA) WSF(float, sb, OFF_SB)
    WSF(signed char, h2q, OFF_MIX)
    WSF(signed char, w_q_q, OFF_W_Q_T)
    WSF(bf16_t, kvT, OFF_KVT)
#undef WSF
};

__device__ __forceinline__ float bf2f(bf16_t v) { return __uint_as_float(((unsigned)v) << 16); }
__device__ __forceinline__ bf16_t f2bf(float f) {
    unsigned u = __float_as_uint(f);
    u += 0x7FFFu + ((u >> 16) & 1u);
    return (bf16_t)(u >> 16);
}
__device__ __forceinline__ float bflo(unsigned u) { return __uint_as_float(u << 16); }
__device__ __forceinline__ float bfhi(unsigned u) { return __uint_as_float(u & 0xFFFF0000u); }
typedef __bf16 bf16x2v_t __attribute__((ext_vector_type(2)));
typedef float f32x2v_t __attribute__((ext_vector_type(2)));
__device__ __forceinline__ unsigned pack2(float a, float b) {
    const f32x2v_t v = {a, b};
    return __builtin_bit_cast(unsigned, __builtin_convertvector(v, bf16x2v_t));
}

__device__ __forceinline__ float wave_sum(float v) {
#pragma unroll
    for (int o = 32; o; o >>= 1) v += __shfl_xor(v, o);
    return v;
}
__device__ __forceinline__ float wave_max(float v) {
#pragma unroll
    for (int o = 32; o; o >>= 1) v = fmaxf(v, __shfl_xor(v, o));
    return v;
}


typedef __bf16 bf16x2_t __attribute__((ext_vector_type(2)));
template <int CTRL>
__device__ __forceinline__ float dpp_mov(float v) {
    return __builtin_bit_cast(float, __builtin_amdgcn_update_dpp(0, __builtin_bit_cast(int, v), CTRL, 0xf, 0xf, true));
}
#define DPP_QP_X1 0xB1
#define DPP_QP_X2 0x4E
#define DPP_HMIRROR 0x141
#define DPP_ROR8 0x128
__device__ __forceinline__ unsigned xcc_id() { return (unsigned)__builtin_amdgcn_s_getreg((3 << 11) | 20) & 0xFu; }

__device__ __forceinline__ void transpose_tile(const float* __restrict__ in, bf16_t* __restrict__ out, int K, int N, int tile, char* smem) {
    float* tl = (float*)smem;
    const int ntn = N >> 6;
    const int k0 = (tile / ntn) << 6, n0 = (tile % ntn) << 6;
    const int tid = VTID;
    __syncthreads();
#pragma unroll 4
    for (int i = 0; i < 16; ++i) {
        int idx = tid + 256 * i;
        int r = idx >> 6, c = idx & 63;
        tl[r * 65 + c] = in[(size_t)(k0 + r) * N + n0 + c];
    }
    __syncthreads();
#pragma unroll 4
    for (int i = 0; i < 16; ++i) {
        int idx = tid + 256 * i;
        int r = idx >> 6, c = idx & 63;
        out[(size_t)(n0 + r) * K + k0 + c] = f2bf(tl[c * 65 + r]);
    }
}

__device__ __forceinline__ void rmsnorm_row_bf16(const float* __restrict__ xr, const float* __restrict__ g, bf16_t* __restrict__ o, int lane) {
    float4 v[4];
    float ss = 0.f;
#pragma unroll
    for (int j = 0; j < 4; ++j) {
        v[j] = *(const float4*)(xr + (j * 64 + lane) * 4);
        ss += v[j].x * v[j].x + v[j].y * v[j].y + v[j].z * v[j].z + v[j].w * v[j].w;
    }
    ss = wave_sum(ss);
    const float rs = rsqrtf(ss * (1.0f / 1024.0f) + EPS);
#pragma unroll
    for (int j = 0; j < 4; ++j) {
        const float4 gg = *(const float4*)(g + (j * 64 + lane) * 4);
        uint2 pk;
        pk.x = pack2(v[j].x * rs * gg.x, v[j].y * rs * gg.y);
        pk.y = pack2(v[j].z * rs * gg.z, v[j].w * rs * gg.w);
        *(uint2*)(o + (j * 64 + lane) * 4) = pk;
    }
}

__device__ __forceinline__ void rmsnorm_row_i8(const float* __restrict__ xr, const float* __restrict__ g, signed char* __restrict__ o, float* __restrict__ sa, int lane) {
    float4 v[4];
    float ss = 0.f;
#pragma unroll
    for (int j = 0; j < 4; ++j) {
        v[j] = *(const float4*)(xr + (j * 64 + lane) * 4);
        ss += v[j].x * v[j].x + v[j].y * v[j].y + v[j].z * v[j].z + v[j].w * v[j].w;
    }
    ss = wave_sum(ss);
    const float rs = rsqrtf(ss * (1.0f / 1024.0f) + EPS);
    float am = 0.f;
#pragma unroll
    for (int j = 0; j < 4; ++j) {
        const float4 gg = *(const float4*)(g + (j * 64 + lane) * 4);
        v[j].x *= rs * gg.x; v[j].y *= rs * gg.y; v[j].z *= rs * gg.z; v[j].w *= rs * gg.w;
        am = fmaxf(am, fmaxf(fmaxf(fabsf(v[j].x), fabsf(v[j].y)), fmaxf(fabsf(v[j].z), fabsf(v[j].w))));
    }
    am = wave_max(am);
    const float qs = am > 0.f ? 127.0f / am : 0.f;
    if (lane == 0) *sa = am * (1.0f / 127.0f);
#pragma unroll
    for (int j = 0; j < 4; ++j) {
        const int q0 = (int)rintf(v[j].x * qs), q1 = (int)rintf(v[j].y * qs), q2 = (int)rintf(v[j].z * qs), q3 = (int)rintf(v[j].w * qs);
        *(unsigned*)(o + (j * 64 + lane) * 4) = (unsigned)(q0 & 255) | ((unsigned)(q1 & 255) << 8) | ((unsigned)(q2 & 255) << 16) | ((unsigned)(q3 & 255) << 24);
    }
}
__device__ __forceinline__ void transpose_cols_i8(const float* __restrict__ in, signed char* __restrict__ out, float* __restrict__ sb, int N, int item, char* smem) {
    float* tl = (float*)smem;
    const int n0 = item << 4;
    const int tid = VTID;
    __syncthreads();
    {
        float4 v[16];
#pragma unroll
        for (int i = 0; i < 16; ++i) {
            const int idx = tid + 256 * i;
            v[i] = *(const float4*)(in + (size_t)(idx >> 2) * N + n0 + (idx & 3) * 4);
        }
#pragma unroll
        for (int i = 0; i < 16; ++i) {
            const int idx = tid + 256 * i;
            const int k = idx >> 2, c = (idx & 3) * 4;
            tl[(c + 0) * 1028 + k] = v[i].x; tl[(c + 1) * 1028 + k] = v[i].y; tl[(c + 2) * 1028 + k] = v[i].z; tl[(c + 3) * 1028 + k] = v[i].w;
        }
    }
    __syncthreads();
    float qs;
    {
        const int c = tid >> 4, l = tid & 15;
        float am = 0.f;
#pragma unroll 8
        for (int i = 0; i < 64; ++i) am = fmaxf(am, fabsf(tl[c * 1028 + l + 16 * i]));
        am = fmaxf(am, __shfl_xor(am, 1)); am = fmaxf(am, __shfl_xor(am, 2)); am = fmaxf(am, __shfl_xor(am, 4)); am = fmaxf(am, __shfl_xor(am, 8));
        if (l == 0) sb[n0 + c] = am * (1.0f / 127.0f);
        qs = am > 0.f ? 127.0f / am : 0.f;
    }
    __syncthreads();
    float* qt = tl + 16 * 1028;
    if ((tid & 15) == 0) qt[tid >> 4] = qs;
    __syncthreads();
#pragma unroll
    for (int i = 0; i < 16; ++i) {
        const int kq = tid * 4;
        const float q = qt[i];
        const float4 v = *(const float4*)(tl + i * 1028 + kq);
        const int q0 = (int)rintf(v.x * q), q1 = (int)rintf(v.y * q), q2 = (int)rintf(v.z * q), q3 = (int)rintf(v.w * q);
        *(unsigned*)(out + (size_t)(n0 + i) * 1024 + kq) = (unsigned)(q0 & 255) | ((unsigned)(q1 & 255) << 8) | ((unsigned)(q2 & 255) << 16) | ((unsigned)(q3 & 255) << 24);
    }
}

__device__ void phase_prep(const Params& p, char* smem) {
    const int tid = VTID, lane = tid & 63, w = tid >> 6;
    const int gsz = VGRID, bid = VBID;
    const int t_in = INW / 16;
    const int t_out = 16 * 16;
    const int t_q = QW / 16;
    const int t_kv = 16 * 8;
    const int t_all = t_in + t_out + t_q + t_kv;
    for (int it = bid; it < t_all; it += gsz) {
        if (it < t_in) transpose_cols_i8(p.w_in, p.w_in_q(), p.sb(), INW, it, smem);
        else if (it < t_in + t_out) transpose_tile(p.w_out, p.w_out_t(), 1024, 1024, it - t_in, smem);
        else if (it < t_in + t_out + t_q) transpose_cols_i8(p.w_q, p.w_q_q(), p.sb() + INW, QW, it - t_in - t_out, smem);
        else transpose_tile(p.w_kv, p.w_kv_t(), 1024, 512, it - t_in - t_out - t_q, smem);
    }
    for (int i = bid * 256 + tid; i < NTOK; i += gsz * 256) { p.ss1()[i] = 0.f; p.hmax()[i] = 0u; }
    if (bid == 0) {
        for (int i = tid; i < 512; i += 256) {
            int dir = i >> 8, k = i & 255;
            float a0 = p.hg_lb[(dir * 2 + 0) * 256 + k], a1 = p.hg_lb[(dir * 2 + 1) * 256 + k];
            float m = fmaxf(a0, a1);
            float e0 = expf(a0 - m), e1 = expf(a1 - m);
            p.lb()[i] = e0 / (e0 + e1);
        }
    }
    const int nrows = NTOK + 1024;
    for (int r0 = bid * 4; r0 < nrows; r0 += gsz * 4) {
        int r = r0 + w;
        if (r < NTOK) rmsnorm_row_i8(p.x + (size_t)r * D, p.attn_g, p.hq() + (size_t)r * D, p.sa() + r, lane);
        else if (r < nrows) rmsnorm_row_bf16(p.mem + (size_t)(r - NTOK) * D, p.mem_g, p.memn() + (size_t)(r - NTOK) * D, lane);
    }
    for (int i = bid * 256 + tid; i < 16 * 128 * 128 / 4; i += gsz * 256) {
        const float4 v = *(const float4*)(p.subk + (size_t)i * 4);
        uint2 pk; pk.x = pack2(v.x, v.y); pk.y = pack2(v.z, v.w);
        *(uint2*)(p.subk_b() + (size_t)i * 4) = pk;
    }
    for (int r0 = bid * 4; r0 < 2 * 16384; r0 += gsz * 4) {
        const int r = r0 + w;
        const bool isv = r >= 16384;
        const int e = r & 16383;
        const float* srcp = (isv ? p.pv : p.pu) + (size_t)e * D;
        unsigned* dst = (unsigned*)(isv ? p.v_c() : p.u_c());
        float4 v[4];
        float am = 0.f;
#pragma unroll
        for (int j = 0; j < 4; ++j) {
            v[j] = *(const float4*)(srcp + (j * 64 + lane) * 4);
            am = fmaxf(am, fmaxf(fmaxf(fabsf(v[j].x), fabsf(v[j].y)), fmaxf(fabsf(v[j].z), fabsf(v[j].w))));
        }
        am = wave_max(am);
        const float qs = am > 0.f ? 127.0f / am : 0.f;
        if (lane == 0) (isv ? p.scale_v() : p.scale_u())[e] = am * (1.0f / 127.0f);
        const int off = 0;
#pragma unroll
        for (int j = 0; j < 4; ++j) {
            const int q0 = (int)rintf(v[j].x * qs) + off, q1 = (int)rintf(v[j].y * qs) + off;
            const int q2 = (int)rintf(v[j].z * qs) + off, q3 = (int)rintf(v[j].w * qs) + off;
            const unsigned pk = (unsigned)(q0 & 255) | ((unsigned)(q1 & 255) << 8) | ((unsigned)(q2 & 255) << 16) | ((unsigned)(q3 & 255) << 24);
            const int c = j * 2 + (lane >> 5), d = (lane & 31) * 4;
            dst[(((size_t)c * 16384 + e) * 128 + d) >> 2] = pk;
        }
    }
}

struct EpiBf16 {
    bf16_t* C; int ldc;
    __device__ __forceinline__ void operator()(int row, int col, const f32x4& v) const {
        uint2 pk; pk.x = pack2(v[0], v[1]); pk.y = pack2(v[2], v[3]);
        *(uint2*)(C + (size_t)row * ldc + col) = pk;
    }
};
struct EpiBf16T {
    bf16_t* C; int col0, ncols, rows_per_b;
    __device__ __forceinline__ void operator()(int row, int col, const f32x4& v) const {
        const int bb = row / rows_per_b, rr = row - bb * rows_per_b;
        uint2 pk; pk.x = pack2(v[0], v[1]); pk.y = pack2(v[2], v[3]);
        *(uint2*)(C + ((size_t)bb * ncols + (col - col0)) * rows_per_b + rr) = pk;
    }
};
struct EpiBf16S {
    bf16_t* C; int ldc; const float* sa; const float* sb;
    __device__ __forceinline__ void operator()(int row, int col, const f32x4& v) const {
        const float s = sa[row];
        const float4 b = *(const float4*)(sb + col);
        uint2 pk; pk.x = pack2(v[0] * s * b.x, v[1] * s * b.y); pk.y = pack2(v[2] * s * b.z, v[3] * s * b.w);
        *(uint2*)(C + (size_t)row * ldc + col) = pk;
    }
};
struct EpiBf16TS {
    bf16_t* C; int col0, ncols, rows_per_b; const float* sa; const float* sb;
    __device__ __forceinline__ void operator()(int row, int col, const f32x4& v) const {
        const int bb = row / rows_per_b, rr = row - bb * rows_per_b;
        const float4 a = *(const float4*)(sa + row);
        const float b = sb[col];
        uint2 pk; pk.x = pack2(v[0] * a.x * b, v[1] * a.y * b); pk.y = pack2(v[2] * a.z * b, v[3] * a.w * b);
        *(uint2*)(C + ((size_t)bb * ncols + (col - col0)) * rows_per_b + rr) = pk;
    }
};
constexpr int EPS_LD = 528;
struct EpiBf16SStaged {
    static constexpr bool staged = true;
    bf16_t* C; int ldc; const float* sa; const float* sb; char* lt; int brow, bcol;
    __device__ __forceinline__ void operator()(int row, int col, const f32x4& v) const {
        const float s = sa[row];
        const float4 b = *(const float4*)(sb + col);
        uint2 pk; pk.x = pack2(v[0] * s * b.x, v[1] * s * b.y); pk.y = pack2(v[2] * s * b.z, v[3] * s * b.w);
        *(uint2*)(lt + (row - brow) * EPS_LD + (col - bcol) * 2) = pk;
    }
    __device__ __forceinline__ void finish() const {
        int tid = threadIdx.x;
        asm volatile("" : "+v"(tid));
        const int c16 = tid & 31, r0 = tid >> 5;
#pragma unroll
        for (int i = 0; i < 16; ++i) {
            const int r = i * 16 + r0;
            *(uint4*)(C + (size_t)(brow + r) * ldc + bcol + c16 * 8) = *(const uint4*)(lt + r * EPS_LD + c16 * 16);
        }
    }
};
struct EpiBf16TSStaged {
    static constexpr bool staged = true;
    bf16_t* Cb; const float* sa; const float* sb; char* lt; int brow, bcol;
    __device__ __forceinline__ void operator()(int row, int col, const f32x4& v) const {
        const float4 a = *(const float4*)(sa + row);
        const float b = sb[col];
        uint2 pk; pk.x = pack2(v[0] * a.x * b, v[1] * a.y * b); pk.y = pack2(v[2] * a.z * b, v[3] * a.w * b);
        *(uint2*)(lt + (col - bcol) * EPS_LD + (row - brow) * 2) = pk;
    }
    __device__ __forceinline__ void finish() const {
        int tid = threadIdx.x;
        asm volatile("" : "+v"(tid));
        const int c16 = tid & 31, r0 = tid >> 5;
#pragma unroll
        for (int i = 0; i < 16; ++i) {
            const int r = i * 16 + r0;
            *(uint4*)(Cb + (size_t)r * T + c16 * 8) = *(const uint4*)(lt + r * EPS_LD + c16 * 16);
        }
    }
};
struct EpiBf16RowScale {
    bf16_t* C; int ldc; const float* ssrow;
    __device__ __forceinline__ void operator()(int row, int col, const f32x4& v) const {
        const float rs = rsqrtf(ssrow[row] * (1.0f / 1024.0f) + EPS);
        uint2 pk; pk.x = pack2(v[0] * rs, v[1] * rs); pk.y = pack2(v[2] * rs, v[3] * rs);
        *(uint2*)(C + (size_t)row * ldc + col) = pk;
    }
};
constexpr int ERN_LD = 1040;
template <int CTRL>
__device__ __forceinline__ float dpp_movf(float v) { return __int_as_float(__builtin_amdgcn_update_dpp(0, __float_as_int(v), CTRL, 0xf, 0xf, true)); }
struct EpiResNorm {
    bf16_t* C; const float* R; const float* g; int ldc; float* ssrow; unsigned* hmax;
    __device__ __forceinline__ void rows(const char* lt, int row0, int bcol, int w, int lane) const {
        const float4 gg = *(const float4*)(g + bcol + lane * 4);
        float4 xr[16];
#pragma unroll
        for (int rr = 0; rr < 16; ++rr) xr[rr] = *(const float4*)(R + (size_t)(row0 + w * 16 + rr) * ldc + bcol + lane * 4);
        float ssq[16], am[16];
#pragma unroll
        for (int rr = 0; rr < 16; ++rr) {
            const float4 a = *(const float4*)(lt + (w * 16 + rr) * ERN_LD + lane * 16);
            float4 o; o.x = a.x + xr[rr].x; o.y = a.y + xr[rr].y; o.z = a.z + xr[rr].z; o.w = a.w + xr[rr].w;
            uint2 xk; xk.x = pack2(o.x, o.y); xk.y = pack2(o.z, o.w);
            *(uint2*)(C + (size_t)(row0 + w * 16 + rr) * ldc + bcol + lane * 4) = xk;
            const float h0 = bflo(xk.x) * gg.x, h1 = bfhi(xk.x) * gg.y, h2 = bflo(xk.y) * gg.z, h3 = bfhi(xk.y) * gg.w;
            ssq[rr] = o.x * o.x + o.y * o.y + o.z * o.z + o.w * o.w;
            am[rr] = fmaxf(fmaxf(fabsf(h0), fabsf(h1)), fmaxf(fabsf(h2), fabsf(h3)));
        }
        float s8[8], m8[8], s4[4], m4[4];
#pragma unroll
        for (int j = 0; j < 8; ++j) {
            const auto rs = __builtin_amdgcn_permlane32_swap(__float_as_uint(ssq[j]), __float_as_uint(ssq[j + 8]), false, false);
            s8[j] = __uint_as_float(rs[0]) + __uint_as_float(rs[1]);
            const auto rm = __builtin_amdgcn_permlane32_swap(__float_as_uint(am[j]), __float_as_uint(am[j + 8]), false, false);
            m8[j] = fmaxf(__uint_as_float(rm[0]), __uint_as_float(rm[1]));
        }
#pragma unroll
        for (int j = 0; j < 4; ++j) {
            const auto rs = __builtin_amdgcn_permlane16_swap(__float_as_uint(s8[j]), __float_as_uint(s8[j + 4]), false, false);
            s4[j] = __uint_as_float(rs[0]) + __uint_as_float(rs[1]);
            const auto rm = __builtin_amdgcn_permlane16_swap(__float_as_uint(m8[j]), __float_as_uint(m8[j + 4]), false, false);
            m4[j] = fmaxf(__uint_as_float(rm[0]), __uint_as_float(rm[1]));
        }
#pragma unroll
        for (int j = 0; j < 4; ++j) {
            s4[j] += dpp_movf<DPP_QP_X1>(s4[j]); s4[j] += dpp_movf<DPP_QP_X2>(s4[j]); s4[j] += dpp_movf<DPP_HMIRROR>(s4[j]); s4[j] += dpp_movf<DPP_ROR8>(s4[j]);
            m4[j] = fmaxf(m4[j], dpp_movf<DPP_QP_X1>(m4[j])); m4[j] = fmaxf(m4[j], dpp_movf<DPP_QP_X2>(m4[j]));
            m4[j] = fmaxf(m4[j], dpp_movf<DPP_HMIRROR>(m4[j])); m4[j] = fmaxf(m4[j], dpp_movf<DPP_ROR8>(m4[j]));
        }
        const int j = lane & 15, rho = lane >> 4;
        if (j < 4) {
            const float sv = j == 0 ? s4[0] : j == 1 ? s4[1] : j == 2 ? s4[2] : s4[3];
            const float mv = j == 0 ? m4[0] : j == 1 ? m4[1] : j == 2 ? m4[2] : m4[3];
            const int row = row0 + w * 16 + j + 4 * (rho & 1) + 8 * (rho >> 1);
            atomicAdd(ssrow + row, sv);
            atomicMax(hmax + row, __float_as_uint(mv));
        }
    }
};
struct EpiResF32 {
    float* C; const float* R; int ldc;
    __device__ __forceinline__ void operator()(int row, int col, const f32x4& v) const {
        const float4 r = *(const float4*)(R + (size_t)row * ldc + col);
        float4 o; o.x = v[0] + r.x; o.y = v[1] + r.y; o.z = v[2] + r.z; o.w = v[3] + r.w;
        *(float4*)(C + (size_t)row * ldc + col) = o;
    }
};

template <bool TRANS, class Epi, bool ROWSS = false>
__device__ __forceinline__ void gemm_tile(const bf16_t* __restrict__ A, int lda, const bf16_t* __restrict__ Bt, int ldb, int K,
                                          int m0, int n0, char* smem, const Epi& epi, float* ssrow = nullptr) {
    const int tid = VTID, lane = tid & 63, w = tid >> 6, wr = w >> 1, wc = w & 1;
    const int fr = lane & 15, fq = lane >> 4;
    const int srow = lane >> 3, sslot = lane & 7;
    f32x4 acc[4][4];
#pragma unroll
    for (int mi = 0; mi < 4; ++mi)
#pragma unroll
        for (int ni = 0; ni < 4; ++ni) acc[mi][ni] = (f32x4){0.f, 0.f, 0.f, 0.f};
    const int g0 = (sslot ^ (srow >> 1)) * 8, g1 = (sslot ^ (4 + (srow >> 1))) * 8;
    const bf16_t* Ab = A + (size_t)(m0 + w * 32 + srow) * lda;
    const bf16_t* Bb = Bt + (size_t)(n0 + w * 32 + srow) * ldb;
    const int nk = K >> 6;
    __syncthreads();
#define GEMM_STAGE(kt, buf)                                                                                                  \
    do {                                                                                                                     \
        char* sa = smem + (buf) * 32768 + w * 4096;                                                                          \
        char* sb = sa + 16384;                                                                                               \
        _Pragma("unroll") for (int i = 0; i < 4; ++i) {                                                                      \
            const int gc = (i & 1) ? g1 : g0;                                                                                \
            __builtin_amdgcn_global_load_lds((const unsigned*)(Ab + (size_t)(i * 8) * lda + (kt) * 64 + gc), (unsigned*)(sa + i * 1024), 16, 0, 0); \
            __builtin_amdgcn_global_load_lds((const unsigned*)(Bb + (size_t)(i * 8) * ldb + (kt) * 64 + gc), (unsigned*)(sb + i * 1024), 16, 0, 0); \
        }                                                                                                                    \
    } while (0)
    GEMM_STAGE(0, 0);
    const int key = fr >> 1;
    for (int kt = 0; kt < nk; ++kt) {
        asm volatile("s_waitcnt vmcnt(0)" ::: "memory");
        __syncthreads();
        if (kt + 1 < nk) GEMM_STAGE(kt + 1, (kt + 1) & 1);
        const char* sa = smem + (kt & 1) * 32768;
        const char* sb = sa + 16384;
#pragma unroll
        for (int ks = 0; ks < 2; ++ks) {
            bf16x8 af[4], bfr[4];
            const int co = ((ks * 4 + fq) ^ key) << 4;
#pragma unroll
            for (int mi = 0; mi < 4; ++mi) af[mi] = *(const bf16x8*)(sa + (wr * 64 + mi * 16 + fr) * 128 + co);
#pragma unroll
            for (int ni = 0; ni < 4; ++ni) bfr[ni] = *(const bf16x8*)(sb + (wc * 64 + ni * 16 + fr) * 128 + co);
#pragma unroll
            for (int mi = 0; mi < 4; ++mi)
#pragma unroll
                for (int ni = 0; ni < 4; ++ni)
                    acc[mi][ni] = TRANS ? __builtin_amdgcn_mfma_f32_16x16x32_bf16(af[mi], bfr[ni], acc[mi][ni], 0, 0, 0)
                                        : __builtin_amdgcn_mfma_f32_16x16x32_bf16(bfr[ni], af[mi], acc[mi][ni], 0, 0, 0);
        }
    }
#undef GEMM_STAGE
    if constexpr (ROWSS) {
#pragma unroll
        for (int mi = 0; mi < 4; ++mi) {
            const int row = m0 + wr * 64 + mi * 16 + fr;
            float ssq = 0.f, am = 0.f;
#pragma unroll
            for (int ni = 0; ni < 4; ++ni) epi(row, n0 + wc * 64 + ni * 16 + fq * 4, acc[mi][ni], ssq, am);
            ssq += __shfl_xor(ssq, 16);
            ssq += __shfl_xor(ssq, 32);
            am = fmaxf(am, __shfl_xor(am, 16));
            am = fmaxf(am, __shfl_xor(am, 32));
            if (fq == 0) epi.row_done(row, ssq, am);
        }
    } else {
#pragma unroll
        for (int mi = 0; mi < 4; ++mi)
#pragma unroll
            for (int ni = 0; ni < 4; ++ni) {
                if (TRANS) epi(m0 + wr * 64 + mi * 16 + fq * 4, n0 + wc * 64 + ni * 16 + fr, acc[mi][ni]);
                else epi(m0 + wr * 64 + mi * 16 + fr, n0 + wc * 64 + ni * 16 + fq * 4, acc[mi][ni]);
            }
    }
}


namespace g8 {
constexpr int BM = 256, BK = 64, HALF = 128, HT = HALF * BK;
__device__ __forceinline__ int lds_byte(int r, int c) {
    const int st = (r >> 4) * 2 + (c >> 5), rr = r & 15, cc = c & 31, ob = rr * 64 + cc * 2;
    return st * 1024 + (ob ^ (((ob >> 9) & 1) << 5));
}
__device__ __forceinline__ void stage_rc(int b, int& R, int& C) {
    const int st = b / 1024, sb = b % 1024, swz = sb ^ (((sb >> 9) & 1) << 5);
    R = (st >> 1) * 16 + swz / 64; C = (st & 1) * 32 + (swz % 64) / 2;
}
__device__ __forceinline__ void tile_of(int L, int nM, int nN, int& pm, int& pn) {
    const int nwg = nM * nN;
    int wgid = L;
    { const int q = nwg / 8, r = nwg % 8, xcd = wgid % 8, off = wgid / 8; wgid = (xcd < r ? xcd * (q + 1) : r * (q + 1) + (xcd - r) * q) + off; }
    const int nig = 8 * nN, gid = wgid / nig, fm = gid * 8, gsz = (nM - fm) < 8 ? (nM - fm) : 8;
    pm = fm + ((wgid % nig) % gsz); pn = (wgid % nig) / gsz;
}
}

#define G8_LAS __attribute__((address_space(3)))
template <bool I8, bool TRANS, class Acc>
__device__ __forceinline__ void g8_mma(Acc& c, const bf16x8& a, const bf16x8& b) {
    if constexpr (I8) {
        const i32x4 ai = __builtin_bit_cast(i32x4, a), bi = __builtin_bit_cast(i32x4, b);
        c = TRANS ? __builtin_amdgcn_mfma_i32_16x16x64_i8(ai, bi, c, 0, 0, 0) : __builtin_amdgcn_mfma_i32_16x16x64_i8(bi, ai, c, 0, 0, 0);
    } else {
        c = TRANS ? __builtin_amdgcn_mfma_f32_16x16x32_bf16(a, b, c, 0, 0, 0) : __builtin_amdgcn_mfma_f32_16x16x32_bf16(b, a, c, 0, 0, 0);
    }
}
template <bool I8> struct g8_acc { using type = f32x4; };
template <> struct g8_acc<true> { using type = i32x4; };
template <bool I8, class Acc> __device__ __forceinline__ f32x4 g8_cvt(const Acc& a) {
    if constexpr (I8) return (f32x4){(float)a[0], (float)a[1], (float)a[2], (float)a[3]};
    else return a;
}
template <bool TRANS, bool ROWSS, bool I8, class Epi>
__device__ __forceinline__ void gemm256_tile(const void* __restrict__ A, const void* __restrict__ Bt, int K, int brow, int bcol,
                                             char* shmc, const Epi& epi) {
    using namespace g8;
    constexpr int ES = I8 ? 1 : 2;
    using acc_t = typename g8_acc<I8>::type;
    G8_LAS unsigned char* lds = (G8_LAS unsigned char*)shmc;
    const int tid = threadIdx.x, wid = __builtin_amdgcn_readfirstlane(tid >> 6), lane = tid & 63, wr = wid >> 2, wc = wid & 3, fr = lane & 15, fq = lane >> 4;
    constexpr int HTB = HALF * BK * 2;
    unsigned voff[2];
#pragma unroll
    for (int i = 0; i < 2; ++i) { int R, C; stage_rc(tid * 16 + i * 8192, R, C); voff[i] = (unsigned)(R * K * ES + C * 2); }
    const size_t kstep = (size_t)(BK * 2);
    const size_t hstep = (size_t)HALF * K * ES;
    const unsigned ldsw = (unsigned)wid * 1024u;
    const int aoff = lds_byte(wr * 64 + fr, fq * 8), boff = lds_byte(wc * 32 + fr, fq * 8);
    const char* cA = (const char*)A + (size_t)brow * K * ES;
    const char* cB = (const char*)Bt + (size_t)bcol * K * ES;
#define G8_SA(b, h) (((b) * 2 + (h)) * HTB)
#define G8_SB(b, h) ((4 + (b) * 2 + (h)) * HTB)
#define G8_STAGE(bufoff, gbase) do { _Pragma("unroll") for (int _i = 0; _i < 2; ++_i) \
        __builtin_amdgcn_global_load_lds((const unsigned*)((const char*)(gbase) + voff[_i]), (G8_LAS unsigned*)(lds + (bufoff) + ldsw + _i * 8192), 16, 0, 0); } while (0)
#define G8_LDA(dst, b, h) do { _Pragma("unroll") for (int m = 0; m < 4; ++m) _Pragma("unroll") for (int k = 0; k < 2; ++k) dst[m][k] = *(const G8_LAS bf16x8*)(lds + G8_SA(b, h) + aoff + m * 2048 + k * 1024); } while (0)
#define G8_LDB(dst, b, h) do { _Pragma("unroll") for (int n = 0; n < 2; ++n) _Pragma("unroll") for (int k = 0; k < 2; ++k) dst[n][k] = *(const G8_LAS bf16x8*)(lds + G8_SB(b, h) + boff + n * 2048 + k * 1024); } while (0)
#define G8_MMA(ai, bj, At_, Bt_) do { __builtin_amdgcn_s_setprio(1); _Pragma("unroll") for (int m = 0; m < 4; ++m) _Pragma("unroll") for (int n = 0; n < 2; ++n) _Pragma("unroll") for (int k = 0; k < 2; ++k) \
        g8_mma<I8, TRANS>(acc[ai][bj][m][n], At_[m][k], Bt_[n][k]); \
        __builtin_amdgcn_s_setprio(0); } while (0)
#define G8_WAIT_V(n) asm volatile("s_waitcnt vmcnt(" #n ")" ::: "memory")
#define G8_WAIT_L(n) asm volatile("s_waitcnt lgkmcnt(" #n ")" ::: "memory")
#define G8_BAR __builtin_amdgcn_s_barrier()
#define G8_SCHED __builtin_amdgcn_sched_barrier(0)
    acc_t acc[2][2][4][2];
#pragma unroll
    for (int a = 0; a < 2; ++a)
#pragma unroll
        for (int b = 0; b < 2; ++b)
#pragma unroll
            for (int m = 0; m < 4; ++m)
#pragma unroll
                for (int n = 0; n < 2; ++n) acc[a][b][m][n] = (acc_t){0, 0, 0, 0};
    bf16x8 At[4][2], B0[2][2], B1[2][2];
    const int nt = K * ES / (BK * 2);
    __syncthreads();
    G8_STAGE(G8_SB(0, 0), cB); G8_STAGE(G8_SA(0, 0), cA); G8_STAGE(G8_SB(0, 1), cB + hstep); G8_STAGE(G8_SA(0, 1), cA + hstep);
    if (wr == 1) G8_BAR;
    G8_WAIT_V(4); G8_BAR;
    G8_STAGE(G8_SB(1, 0), cB + kstep); G8_STAGE(G8_SA(1, 0), cA + kstep); G8_STAGE(G8_SB(1, 1), cB + hstep + kstep);
    G8_WAIT_V(6); G8_BAR;
    for (int t = 0; t < nt - 2; t += 2) {
        const char* a1 = cA + (size_t)(t + 1) * kstep; const char* a2 = a1 + kstep; const char* a3 = a2 + kstep;
        const char* b2 = cB + (size_t)(t + 2) * kstep; const char* b3 = b2 + kstep;
        G8_LDB(B0, 0, 0); G8_SCHED; G8_LDA(At, 0, 0); G8_STAGE(G8_SA(1, 1), a1 + hstep);
        G8_WAIT_L(8); G8_BAR; G8_WAIT_L(0); G8_MMA(0, 0, At, B0); G8_BAR; G8_SCHED;
        G8_LDB(B1, 0, 1); G8_STAGE(G8_SB(0, 0), b2);
        G8_BAR; G8_WAIT_L(0); G8_MMA(0, 1, At, B1); G8_BAR;
        G8_LDA(At, 0, 1); G8_STAGE(G8_SA(0, 0), a2);
        G8_BAR; G8_WAIT_L(0); G8_MMA(1, 0, At, B0); G8_BAR; G8_SCHED;
        G8_STAGE(G8_SB(0, 1), b2 + hstep);
        G8_WAIT_V(6); G8_BAR; G8_MMA(1, 1, At, B1); G8_BAR;
        G8_LDB(B0, 1, 0); G8_SCHED; G8_LDA(At, 1, 0); G8_STAGE(G8_SA(0, 1), a2 + hstep);
        G8_WAIT_L(8); G8_BAR; G8_WAIT_L(0); G8_MMA(0, 0, At, B0); G8_BAR; G8_SCHED;
        G8_LDB(B1, 1, 1); G8_STAGE(G8_SB(1, 0), b3);
        G8_BAR; G8_WAIT_L(0); G8_MMA(0, 1, At, B1); G8_BAR;
        G8_LDA(At, 1, 1); G8_STAGE(G8_SA(1, 0), a3);
        G8_BAR; G8_WAIT_L(0); G8_MMA(1, 0, At, B0); G8_BAR; G8_SCHED;
        G8_STAGE(G8_SB(1, 1), b3 + hstep);
        G8_WAIT_V(6); G8_BAR; G8_MMA(1, 1, At, B1); G8_BAR;
    }
    { G8_LDB(B0, 0, 0); G8_LDA(At, 0, 0); G8_STAGE(G8_SA(1, 1), cA + (size_t)(nt - 1) * kstep + hstep);
      G8_BAR; G8_WAIT_L(0); G8_MMA(0, 0, At, B0); G8_BAR;
      G8_LDB(B1, 0, 1); G8_BAR; G8_WAIT_L(0); G8_MMA(0, 1, At, B1); G8_BAR;
      G8_LDA(At, 0, 1); G8_WAIT_V(4); G8_BAR; G8_WAIT_L(0); G8_MMA(1, 0, At, B0); G8_MMA(1, 1, At, B1); G8_BAR; }
    { G8_LDB(B0, 1, 0); G8_LDA(At, 1, 0); G8_WAIT_V(2); G8_BAR; G8_WAIT_L(0); G8_MMA(0, 0, At, B0); G8_BAR;
      G8_LDB(B1, 1, 1); G8_WAIT_V(0); G8_BAR; G8_WAIT_L(0); G8_MMA(0, 1, At, B1); G8_BAR;
      G8_LDA(At, 1, 1); G8_BAR; G8_WAIT_L(0); G8_MMA(1, 0, At, B0); G8_MMA(1, 1, At, B1); G8_BAR; }
    if (wr == 0) G8_BAR;
    if constexpr (ROWSS) {
        int tq = threadIdx.x;
        asm volatile("" : "+v"(tq));
        const int fr2 = tq & 15, fq2 = (tq >> 4) & 3;
        char* lw = shmc + (wr * 64 + fr2) * ERN_LD + (wc * 32 + fq2 * 4) * 4;
#pragma unroll
        for (int ai = 0; ai < 2; ++ai) {
            if (ai) __syncthreads();
#pragma unroll
            for (int bj = 0; bj < 2; ++bj)
#pragma unroll
                for (int m = 0; m < 4; ++m)
#pragma unroll
                    for (int n = 0; n < 2; ++n) *(f32x4*)(lw + m * 16 * ERN_LD + (bj * HALF + n * 16) * 4) = g8_cvt<I8>(acc[ai][bj][m][n]);
            __syncthreads();
            epi.rows(shmc, brow + ai * HALF, bcol, tq >> 6, tq & 63);
        }
    } else {
#pragma unroll
        for (int ai = 0; ai < 2; ++ai)
#pragma unroll
            for (int bj = 0; bj < 2; ++bj)
#pragma unroll
                for (int m = 0; m < 4; ++m)
#pragma unroll
                    for (int n = 0; n < 2; ++n) {
                        if (TRANS) epi(brow + ai * HALF + wr * 64 + m * 16 + fq * 4, bcol + bj * HALF + wc * 32 + n * 16 + fr, g8_cvt<I8>(acc[ai][bj][m][n]));
                        else epi(brow + ai * HALF + wr * 64 + m * 16 + fr, bcol + bj * HALF + wc * 32 + n * 16 + fq * 4, g8_cvt<I8>(acc[ai][bj][m][n]));
                    }
    }
#undef G8_SA
#undef G8_SB
#undef G8_STAGE
#undef G8_LDA
#undef G8_LDB
#undef G8_MMA
#undef G8_WAIT_V
#undef G8_WAIT_L
#undef G8_BAR
#undef G8_SCHED
}

__device__ void phase_gemm_in(const Params& p, char* smem) {
    const int nM = NTOK / 256, nN = INW / 256;
    for (int i = 0; i * (int)gridDim.x + (int)blockIdx.x < nM * nN; ++i) {
        int pm, pn;
        g8::tile_of(i * gridDim.x + blockIdx.x, nM, nN, pm, pn);
        if (pn >= 4 && pn < 6) {
            const int bb = (pm * 256) / T, rr = (pm * 256) % T;
            EpiBf16TSStaged e1t{p.vT() + ((size_t)bb * 512 + (pn * 256 - 1024)) * T + rr, p.sa(), p.sb(), smem, pm * 256, pn * 256};
            gemm256_tile<true, false, true>(p.hq(), p.w_in_q(), D, pm * 256, pn * 256, smem, e1t);
            __syncthreads();
            e1t.finish();
        } else {
            EpiBf16SStaged e1{p.z(), INW, p.sa(), p.sb(), smem, pm * 256, pn * 256};
            gemm256_tile<false, false, true>(p.hq(), p.w_in_q(), D, pm * 256, pn * 256, smem, e1);
            __syncthreads();
            e1.finish();
        }
    }
}

__device__ void phase_gemm_kv(const Params& p, char* smh) {
    EpiBf16 e2{p.kvb(), 512};
    EpiBf16T e2t{p.kvT(), 256, 256, 256};
    const bool dedicated = gridDim.x >= 64;
    if (dedicated && blockIdx.x >= 16) return;
    for (int it = VBID; it < 32; it += dedicated ? 32 : VGRID) {
        const int pm = it >> 2, pn = it & 3;
        if (pn >= 2) gemm_tile<true>(p.memn(), D, p.w_kv_t(), D, D, pm * 128, pn * 128, smh, e2t);
        else gemm_tile<false>(p.memn(), D, p.w_kv_t(), D, D, pm * 128, pn * 128, smh, e2);
    }
}

__device__ void phase_gemm_out(const Params& p, char* smem) {
    const int nM = NTOK / 256, nN = D / 256;
    EpiResNorm e{p.x1b(), p.x, p.ffn_g, D, p.ss1(), p.hmax()};
    for (int i = 0; i * (int)gridDim.x + (int)blockIdx.x < nM * nN; ++i) {
        int pm, pn;
        g8::tile_of(i * gridDim.x + blockIdx.x, nM, nN, pm, pn);
        gemm256_tile<false, true, false>(p.mix(), p.w_out_t(), D, pm * 256, pn * 256, smem, e);
    }
}

__device__ void phase_gemm_q(const Params& p, char* smem) {
    const int nM = NTOK / 256, nN = QW / 256;
    EpiBf16RowScale e{p.z(), QW, p.ss1()};
    for (int i = 0; i * (int)gridDim.x + (int)blockIdx.x < nM * nN; ++i) {
        int pm, pn;
        g8::tile_of(i * gridDim.x + blockIdx.x, nM, nN, pm, pn);
        gemm256_tile<false, false, false>(p.h(), p.w_q_t(), D, pm * 256, pn * 256, smem, e);
    }
}

typedef float f32x16 __attribute__((ext_vector_type(16)));
constexpr int HRS = 144;
__device__ __forceinline__ f32x16 tile_mm64(const char* X, const char* Y, int xrow0, int yrow0, int lane, f32x16 acc) {
    const int r = lane & 31, hh = lane >> 5;
#pragma unroll
    for (int ks = 0; ks < 4; ++ks) {
        const bf16x8 a = *(const bf16x8*)(X + (xrow0 + r) * HRS + ks * 32 + hh * 16);
        const bf16x8 b = *(const bf16x8*)(Y + (yrow0 + r) * HRS + ks * 32 + hh * 16);
        acc = __builtin_amdgcn_mfma_f32_32x32x16_bf16(a, b, acc, 0, 0, 0);
    }
    return acc;
}
__device__ __forceinline__ int crow(int reg, int hh) { return (reg & 3) + 8 * (reg >> 2) + 4 * hh; }

__device__ __forceinline__ void hg_load_vt(const Params& p, char* sVT, int tok0, int h, int kcol, int sq) {
    const bf16_t* zp = p.z() + (size_t)(tok0 + sq * 16) * INW + 2304 + h * 64 + kcol;
    unsigned pk[8];
#pragma unroll
    for (int j = 0; j < 8; ++j) {
        const unsigned lo = zp[(size_t)(2 * j) * INW], hi = zp[(size_t)(2 * j + 1) * INW];
        pk[j] = lo | (hi << 16);
    }
    *(uint4*)(sVT + kcol * HRS + sq * 32) = make_uint4(pk[0], pk[1], pk[2], pk[3]);
    *(uint4*)(sVT + kcol * HRS + sq * 32 + 16) = make_uint4(pk[4], pk[5], pk[6], pk[7]);
}

__device__ __forceinline__ float hg_gates(const Params& p, float* sTot, int tok0, int h, int dir, int kcol, int sq, float (&bj)[16], float (&kk)[16]) {
    const bf16_t* zp = p.z() + (size_t)(tok0 + sq * 16) * INW + 1792 + dir * 256 + h * 64 + kcol;
    const float lbv = p.lb()[dir * 256 + h * 64 + kcol];
#pragma unroll
    for (int j = 0; j < 16; ++j) {
        const float pre = bf2f(zp[(size_t)j * INW]);
        const float f = lbv + (1.0f - lbv) * (1.0f / (1.0f + __expf(-pre)));
        bj[j] = __logf(f);
        kk[j] = 1.0f - f;
    }
    if (dir == 0) {
#pragma unroll
        for (int j = 1; j < 16; ++j) bj[j] += bj[j - 1];
        sTot[sq * 64 + kcol] = bj[15];
    } else {
#pragma unroll
        for (int j = 14; j >= 0; --j) bj[j] += bj[j + 1];
        sTot[sq * 64 + kcol] = bj[0];
    }
    __syncthreads();
    const float t0 = sTot[kcol], t1 = sTot[64 + kcol], t2 = sTot[128 + kcol], t3 = sTot[192 + kcol];
    float off;
    if (dir == 0) off = (sq > 0 ? t0 : 0.f) + (sq > 1 ? t1 : 0.f) + (sq > 2 ? t2 : 0.f);
    else off = (sq < 3 ? t3 : 0.f) + (sq < 2 ? t2 : 0.f) + (sq < 1 ? t1 : 0.f);
#pragma unroll
    for (int j = 0; j < 16; ++j) bj[j] += off;
    return t0 + t1 + t2 + t3;
}

__device__ void hg_local(const Params& p, char* smem) {
    char* sVT = smem;
    char* sKT = smem + 9216;
    float* sTot = (float*)(smem + 18432);
    const int tid = VTID, lane = tid & 63, w = tid >> 6;
    const int kcol = tid & 63, sq = tid >> 6;
    for (int item = VBID; item < 4096; item += VGRID) {
        const int c = item & 127, dir = (item >> 7) & 1, h = (item >> 8) & 3, b = item >> 10;
        const int tok0 = b * T + c * 64;
        __syncthreads();
        hg_load_vt(p, sVT, tok0, h, kcol, sq);
        float bj[16], kk[16];
        const float btot = hg_gates(p, sTot, tok0, h, dir, kcol, sq, bj, kk);
        unsigned pk[8];
#pragma unroll
        for (int j = 0; j < 8; ++j)
            pk[j] = pack2(kk[2 * j] * __expf(btot - bj[2 * j]), kk[2 * j + 1] * __expf(btot - bj[2 * j + 1]));
        *(uint4*)(sKT + kcol * HRS + sq * 32) = make_uint4(pk[0], pk[1], pk[2], pk[3]);
        *(uint4*)(sKT + kcol * HRS + sq * 32 + 16) = make_uint4(pk[4], pk[5], pk[6], pk[7]);
        if (sq == 0) p.hdec()[item * 64 + kcol] = __expf(btot);
        __syncthreads();
        const int vi = w >> 1, ki = w & 1, hh = lane >> 5;
        f32x16 acc;
#pragma unroll
        for (int r = 0; r < 16; ++r) acc[r] = 0.f;
        acc = tile_mm64(sVT, sKT, vi * 32, ki * 32, lane, acc);
        bf16_t* dst = (bf16_t*)p.hstate() + (size_t)item * 4096 + ki * 32 + (lane & 31);
#pragma unroll
        for (int r = 0; r < 16; ++r) dst[(vi * 32 + crow(r, hh)) * 64] = f2bf(acc[r]);
    }
}

__device__ __forceinline__ bf16x8 pack8(const f32x16& x, int s8) {
    typedef unsigned u32x4_t __attribute__((ext_vector_type(4)));
    u32x4_t pk;
    pk[0] = pack2(x[s8], x[s8 + 1]); pk[1] = pack2(x[s8 + 2], x[s8 + 3]);
    pk[2] = pack2(x[s8 + 4], x[s8 + 5]); pk[3] = pack2(x[s8 + 6], x[s8 + 7]);
    return __builtin_bit_cast(bf16x8, pk);
}
__device__ __forceinline__ bf16x8 join8(const uint2& lo, const uint2& hi) {
    typedef unsigned u32x4_t __attribute__((ext_vector_type(4)));
    u32x4_t pk; pk[0] = lo.x; pk[1] = lo.y; pk[2] = hi.x; pk[3] = hi.y;
    return __builtin_bit_cast(bf16x8, pk);
}

__device__ __forceinline__ int swap23(int r) { return (r & ~12) | ((r & 4) << 1) | ((r & 8) >> 1); }

__device__ __forceinline__ void mem_attn_wave(const Params& p, int wu, int lane, const char* sK, const char* sV) {
    const int tile = wu & 255, h = (wu >> 8) & 3, b = wu >> 10;
    const int l31 = lane & 31, hh = lane >> 5;
    const int tok = b * T + tile * 32 + l31;
    bf16x8 qf[4];
#pragma unroll
    for (int ks = 0; ks < 4; ++ks) qf[ks] = *(const bf16x8*)(p.z() + (size_t)tok * INW + 2816 + h * 64 + ks * 16 + hh * 8);
    const char* kb = sK + swap23(l31) * 144 + hh * 16;
    float m = -1e30f;
    f32x16 o0, o1;
#pragma unroll
    for (int r = 0; r < 16; ++r) { o0[r] = 0.f; o1[r] = 0.f; }
    float sum = 0.f;
    const char* vt = sV + l31 * 528 + hh * 16;
#pragma unroll 2
    for (int kt = 0; kt < 8; ++kt) {
        bf16x8 kf[4], vf[4];
#pragma unroll
        for (int ks = 0; ks < 4; ++ks) kf[ks] = *(const bf16x8*)(kb + kt * 32 * 144 + ks * 32);
#pragma unroll
        for (int st = 0; st < 2; ++st) { vf[2 * st] = *(const bf16x8*)(vt + kt * 64 + st * 32); vf[2 * st + 1] = *(const bf16x8*)(vt + 32 * 528 + kt * 64 + st * 32); }
        f32x16 s;
#pragma unroll
        for (int r = 0; r < 16; ++r) s[r] = 0.f;
#pragma unroll
        for (int ks = 0; ks < 4; ++ks) s = __builtin_amdgcn_mfma_f32_32x32x16_bf16(kf[ks], qf[ks], s, 0, 0, 0);
        float tm = s[0];
#pragma unroll
        for (int r = 1; r < 16; ++r) tm = fmaxf(tm, s[r]);
        tm = fmaxf(tm, __shfl_xor(tm, 32));
        const float mn = fmaxf(m, tm);
        if (__any(mn > m)) {
            const float sc = __builtin_amdgcn_exp2f((m - mn) * 0.18033688011112042f);
            sum *= sc;
#pragma unroll
            for (int r = 0; r < 16; ++r) { o0[r] *= sc; o1[r] *= sc; }
        }
        m = mn;
        const float mb = mn * 0.18033688011112042f;
#pragma unroll
        for (int r = 0; r < 16; ++r) { s[r] = __builtin_amdgcn_exp2f(fmaf(s[r], 0.18033688011112042f, -mb)); sum += s[r]; }
#pragma unroll
        for (int st = 0; st < 2; ++st) {
            const bf16x8 pb = pack8(s, st * 8);
            o0 = __builtin_amdgcn_mfma_f32_32x32x16_bf16(vf[2 * st], pb, o0, 0, 0, 0);
            o1 = __builtin_amdgcn_mfma_f32_32x32x16_bf16(vf[2 * st + 1], pb, o1, 0, 0, 0);
        }
    }
    sum += __shfl_xor(sum, 32);
    const float inv = 1.0f / sum;
    bf16_t* mo = p.mix() + (size_t)tok * D + 768 + h * 64 + 4 * hh;
#pragma unroll
    for (int g = 0; g < 4; ++g) {
        uint2 pk;
        pk.x = pack2(o0[4 * g] * inv, o0[4 * g + 1] * inv); pk.y = pack2(o0[4 * g + 2] * inv, o0[4 * g + 3] * inv);
        *(uint2*)(mo + 8 * g) = pk;
        pk.x = pack2(o1[4 * g] * inv, o1[4 * g + 1] * inv); pk.y = pack2(o1[4 * g + 2] * inv, o1[4 * g + 3] * inv);
        *(uint2*)(mo + 32 + 8 * g) = pk;
    }
}

struct NaCtx {
    const bf16_t* kbase; const bf16_t* vbase; const float* bh;
    int rs, r, c, c0, cb, hh;
    bf16x8 qf[4];
    float m, sum;
    f32x16 o0, o1;
};
template <int TI>
__device__ __forceinline__ void na_load(const NaCtx& x, bf16x8 (&kf)[4], bf16x8 (&vf)[4]) {
    constexpr int ip = TI / 3, cg = TI % 3;
    const bf16_t* kp = x.kbase + (size_t)(ip * 128 + cg * 16) * INW;
#pragma unroll
    for (int ks = 0; ks < 4; ++ks) kf[ks] = *(const bf16x8*)(kp + ks * 16);
    const bf16_t* vr = x.vbase + ip * 128 + cg * 16;
#pragma unroll
    for (int st = 0; st < 2; ++st) { vf[2 * st] = *(const bf16x8*)(vr + st * 64); vf[2 * st + 1] = *(const bf16x8*)(vr + (size_t)32 * T + st * 64); }
}
template <int TI>
__device__ __forceinline__ void na_comp(NaCtx& x, const bf16x8 (&kf)[4], const bf16x8 (&vf)[4]) {
    constexpr int ip = TI / 3, cg = TI % 3;
    f32x16 s;
#pragma unroll
    for (int q = 0; q < 16; ++q) s[q] = 0.f;
#pragma unroll
    for (int ks = 0; ks < 4; ++ks) s = __builtin_amdgcn_mfma_f32_32x32x16_bf16(kf[ks], x.qf[ks], s, 0, 0, 0);
    const int kc0 = x.cb + 16 * cg + 8 * x.hh;
    const float* brow = x.bh + (x.rs + 2 * ip - x.r + 7) * 31 + 15 - x.c + kc0;
    const int d0 = kc0 - x.c0;
    float tm = -1e30f;
    float bv[16];
#pragma unroll
    for (int q = 0; q < 16; ++q) bv[q] = brow[(q & 3) + 4 * ((q >> 2) & 1) + 31 * (q >> 3)];
#pragma unroll
    for (int q = 0; q < 16; ++q) asm volatile("" : "+v"(bv[q]));
#pragma unroll
    for (int q = 0; q < 16; ++q) {
        const int cq = (q & 3) + 4 * ((q >> 2) & 1);
        const bool valid = (unsigned)(d0 + cq) < 16u;
        const float sc = valid ? fmaf(s[q], 0.18033688011112042f, bv[q]) : -INFINITY;
        s[q] = sc;
        tm = fmaxf(tm, sc);
    }
    tm = fmaxf(tm, __shfl_xor(tm, 32));
    const float mn = fmaxf(x.m, tm);
    if (__any(mn > x.m)) {
        const float scl = __builtin_amdgcn_exp2f(x.m - mn);
        x.sum *= scl;
#pragma unroll
        for (int q = 0; q < 16; ++q) { x.o0[q] *= scl; x.o1[q] *= scl; }
    }
    x.m = mn;
#pragma unroll
    for (int q = 0; q < 16; ++q) { const float pe = __builtin_amdgcn_exp2f(s[q] - mn); s[q] = pe; x.sum += pe; }
#pragma unroll
    for (int st = 0; st < 2; ++st) {
        const bf16x8 pb = pack8(s, st * 8);
        x.o0 = __builtin_amdgcn_mfma_f32_32x32x16_bf16(vf[2 * st], pb, x.o0, 0, 0, 0);
        x.o1 = __builtin_amdgcn_mfma_f32_32x32x16_bf16(vf[2 * st + 1], pb, x.o1, 0, 0, 0);
    }
}

__device__ __forceinline__ void na_attn_wave(const Params& p, int wu, int lane, const float* sbias) {
    const int j = wu & 1, h = (wu >> 1) & 7, r = (wu >> 4) & 127, b = wu >> 11;
    const int l31 = lane & 31, hh = lane >> 5;
    NaCtx x;
    x.hh = hh; x.r = r;
    x.c = 32 * j + l31;
    x.c0 = min(max(x.c - 8, 0), 48); x.rs = min(max(r - 4, 0), 120);
    const int tokq = b * T + r * 64 + x.c;
    x.cb = 16 * j;
#pragma unroll
    for (int ks = 0; ks < 4; ++ks) x.qf[ks] = *(const bf16x8*)(p.z() + (size_t)tokq * INW + h * 64 + ks * 16 + hh * 8);
    x.bh = sbias + 64 + h * 465;
    const int kap = swap23(l31);
    x.kbase = p.z() + (size_t)(b * T + (x.rs + (kap >> 4)) * 64 + x.cb + (kap & 15)) * INW + 512 + h * 64 + hh * 8;
    x.vbase = p.vT() + ((size_t)(b * 8 + h) * 64 + l31) * T + x.rs * 64 + x.cb + 8 * hh;
    x.m = -1e30f; x.sum = 0.f;
#pragma unroll
    for (int q = 0; q < 16; ++q) { x.o0[q] = 0.f; x.o1[q] = 0.f; }
    bf16x8 k0[4], v0[4], k1[4], v1[4], k2[4], v2[4], k3[4], v3[4];
    na_load<0>(x, k0, v0); na_load<1>(x, k1, v1); na_load<2>(x, k2, v2);
    na_load<3>(x, k3, v3);  na_comp<0>(x, k0, v0);
    na_load<4>(x, k0, v0);  na_comp<1>(x, k1, v1);
    na_load<5>(x, k1, v1);  na_comp<2>(x, k2, v2);
    na_load<6>(x, k2, v2);  na_comp<3>(x, k3, v3);
    na_load<7>(x, k3, v3);  na_comp<4>(x, k0, v0);
    na_load<8>(x, k0, v0);  na_comp<5>(x, k1, v1);
    na_load<9>(x, k1, v1);  na_comp<6>(x, k2, v2);
    na_load<10>(x, k2, v2); na_comp<7>(x, k3, v3);
    na_load<11>(x, k3, v3); na_comp<8>(x, k0, v0);
    na_comp<9>(x, k1, v1);
    na_comp<10>(x, k2, v2);
    na_comp<11>(x, k3, v3);
    float sum = x.sum;
    sum += __shfl_xor(sum, 32);
    const float inv = 1.0f / sum;
    bf16_t* mo = p.mix() + (size_t)tokq * D + h * 64 + 4 * hh;
#pragma unroll
    for (int g = 0; g < 4; ++g) {
        uint2 pk;
        pk.x = pack2(x.o0[4 * g] * inv, x.o0[4 * g + 1] * inv); pk.y = pack2(x.o0[4 * g + 2] * inv, x.o0[4 * g + 3] * inv);
        *(uint2*)(mo + 8 * g) = pk;
        pk.x = pack2(x.o1[4 * g] * inv, x.o1[4 * g + 1] * inv); pk.y = pack2(x.o1[4 * g + 2] * inv, x.o1[4 * g + 3] * inv);
        *(uint2*)(mo + 32 + 8 * g) = pk;
    }
}

__device__ void phase_mixers(const Params& p, char* smem) {
    const int tid = VTID, lane = tid & 63, w = tid >> 6;
    {
        float* sbias = (float*)smem;
        __syncthreads();
        for (int i = tid; i < 8 * 465; i += 256) sbias[64 + i] = p.rpb[i] * 1.4426950408889634f;
        __syncthreads();
        for (int wu = VBID * 4 + w; wu < 8192; wu += VGRID * 4) na_attn_wave(p, wu, lane, sbias);
    }
    __syncthreads();
    hg_local(p, smem);
}

__device__ void phase_hg_scan(const Params& p) {
    const int tid = VTID;
    const int skip = gridDim.x >= 64 ? 32 : 0;
    if (VBID < skip) return;
    for (int item = VBID - skip; item < 512; item += VGRID - skip) {
        const int g = item * 256 + tid;
        const int seq = g >> 12, kv = g & 4095, k = kv & 63;
        const int dir = seq & 1;
        float S = 0.f;
        for (int cc0 = 0; cc0 < 128; cc0 += 8) {
            float L[8], d[8];
#pragma unroll
            for (int u = 0; u < 8; ++u) {
                const int c = dir ? 127 - (cc0 + u) : cc0 + u;
                const size_t it = (size_t)seq * 128 + c;
                L[u] = bf2f(((const bf16_t*)p.hstate())[it * 4096 + kv]);
                d[u] = p.hdec()[it * 64 + k];
            }
#pragma unroll
            for (int u = 0; u < 8; ++u) {
                const int c = dir ? 127 - (cc0 + u) : cc0 + u;
                const size_t it = (size_t)seq * 128 + c;
                ((bf16_t*)p.h())[it * 4096 + kv] = f2bf(S);
                S = d[u] * S + L[u];
            }
        }
    }
}

struct HgIn { unsigned v[8], q[8], f[2][8]; uint2 st[2][4]; uint2 gz[4]; };
__device__ __forceinline__ void hg_in_load(const Params& p, HgIn& d, int item, int tid) {
    const int kcol = tid & 63, sq = tid >> 6, w = tid >> 6, l31 = tid & 31, hh = (tid >> 5) & 1;
    const int c = item & 127, h = (item >> 7) & 3, b = item >> 9;
    const int tok0 = b * T + c * 64;
    const unsigned short* zp = (const unsigned short*)p.z() + (size_t)(tok0 + sq * 16) * INW + h * 64 + kcol;
#pragma unroll
    for (int j = 0; j < 8; ++j) {
        const unsigned short* z0 = zp + (size_t)(2 * j) * INW;
        const unsigned short* z1 = z0 + INW;
        d.q[j] = (unsigned)z0[1536] | ((unsigned)z1[1536] << 16);
        d.f[0][j] = (unsigned)z0[1792] | ((unsigned)z1[1792] << 16);
        d.f[1][j] = (unsigned)z0[2048] | ((unsigned)z1[2048] << 16);
        d.v[j] = (unsigned)z0[2304] | ((unsigned)z1[2304] << 16);
    }
#pragma unroll
    for (int dir = 0; dir < 2; ++dir) {
        const bf16_t* sp = (const bf16_t*)p.h() + ((size_t)(((b * 4 + h) * 2 + dir) * 128 + c)) * 4096;
#pragma unroll
        for (int i = 0; i < 4; ++i) d.st[dir][i] = *(const uint2*)(sp + tid * 4 + 1024 * i);
    }
    const int vi = w >> 1, ti = w & 1;
    const int tok = tok0 + ti * 32 + l31;
#pragma unroll
    for (int g = 0; g < 4; ++g) d.gz[g] = *(const uint2*)(p.z() + (size_t)tok * INW + 2560 + h * 64 + vi * 32 + 8 * g + 4 * hh);
}
__device__ __forceinline__ float hg_gates_r(const Params& p, float* sTot, const unsigned (&fp)[8], int h, int dir, int kcol, int sq, float (&bj)[16], float (&kk)[16]) {
    const float lbv = p.lb()[dir * 256 + h * 64 + kcol];
#pragma unroll
    for (int j = 0; j < 16; ++j) {
        const float pre = (j & 1) ? bfhi(fp[j >> 1]) : bflo(fp[j >> 1]);
        const float f = lbv + (1.0f - lbv) * (1.0f / (1.0f + __expf(-pre)));
        bj[j] = __logf(f);
        kk[j] = 1.0f - f;
    }
    if (dir == 0) {
#pragma unroll
        for (int j = 1; j < 16; ++j) bj[j] += bj[j - 1];
        sTot[sq * 64 + kcol] = bj[15];
    } else {
#pragma unroll
        for (int j = 14; j >= 0; --j) bj[j] += bj[j + 1];
        sTot[sq * 64 + kcol] = bj[0];
    }
    __syncthreads();
    const float t0 = sTot[kcol], t1 = sTot[64 + kcol], t2 = sTot[128 + kcol], t3 = sTot[192 + kcol];
    float off;
    if (dir == 0) off = (sq > 0 ? t0 : 0.f) + (sq > 1 ? t1 : 0.f) + (sq > 2 ? t2 : 0.f);
    else off = (sq < 3 ? t3 : 0.f) + (sq < 2 ? t2 : 0.f) + (sq < 1 ? t1 : 0.f);
#pragma unroll
    for (int j = 0; j < 16; ++j) bj[j] += off;
    return t0 + t1 + t2 + t3;
}

__device__ void phase_hg_out(const Params& p, char* smem) {
    char* sQt = smem;
    char* sKt = smem + 9216;
    char* sQh = smem + 18432;
    char* sVT = smem + 27648;
    char* sST = smem + 36864;
    char* sP = smem + 46080;
    float* sTot = (float*)(smem + 55296);
    float* sSS = sTot + 256;
    const int tid = VTID, lane = tid & 63, w = tid >> 6;
    const int kcol = tid & 63, sq = tid >> 6;
    const int l31 = lane & 31, hh = lane >> 5;
    HgIn cur, nxt;
    if (VBID < 2048) hg_in_load(p, cur, VBID, tid);
    for (int item = VBID; item < 2048; item += VGRID) {
        const int c = item & 127, h = (item >> 7) & 3, b = item >> 9;
        const int tok0 = b * T + c * 64;
        (void)c; (void)b;
        if (item + VGRID < 2048) hg_in_load(p, nxt, item + VGRID, tid);
        __syncthreads();
        *(uint4*)(sVT + kcol * HRS + sq * 32) = make_uint4(cur.v[0], cur.v[1], cur.v[2], cur.v[3]);
        *(uint4*)(sVT + kcol * HRS + sq * 32 + 16) = make_uint4(cur.v[4], cur.v[5], cur.v[6], cur.v[7]);
        float qv[16];
#pragma unroll
        for (int j = 0; j < 16; ++j) qv[j] = (j & 1) ? bfhi(cur.q[j >> 1]) : bflo(cur.q[j >> 1]);
        f32x16 accO;
#pragma unroll
        for (int r = 0; r < 16; ++r) accO[r] = 0.f;
        for (int dir = 0; dir < 2; ++dir) {
            float bj[16], kk[16];
            const float btot = hg_gates_r(p, sTot, cur.f[dir], h, dir, kcol, sq, bj, kk);
            const float bref = 0.5f * btot;
#pragma unroll
            for (int j = 0; j < 16; ++j) {
                const int s = sq * 16 + j;
                *(bf16_t*)(sQt + s * HRS + kcol * 2) = f2bf(qv[j] * __expf(bj[j] - bref));
                *(bf16_t*)(sKt + s * HRS + kcol * 2) = f2bf(kk[j] * __expf(bref - bj[j]));
                *(bf16_t*)(sQh + s * HRS + kcol * 2) = f2bf(qv[j] * __expf(bj[j]));
            }
#pragma unroll
            for (int i = 0; i < 4; ++i) {
                const int idx = tid * 4 + 1024 * i;
                *(uint2*)(sST + (idx >> 6) * HRS + (idx & 63) * 2) = cur.st[dir][i];
            }
            __syncthreads();
            {
                const int si = w >> 1, ti = w & 1;
                const bool live = dir == 0 ? (si <= ti) : (si >= ti);
                f32x16 pt;
#pragma unroll
                for (int r = 0; r < 16; ++r) pt[r] = 0.f;
                if (live) pt = tile_mm64(sKt, sQt, si * 32, ti * 32, lane, pt);
                const int t = ti * 32 + l31;
#pragma unroll
                for (int g = 0; g < 4; ++g) {
                    const int s0 = si * 32 + 8 * g + 4 * hh;
                    float v0 = pt[4 * g], v1 = pt[4 * g + 1], v2 = pt[4 * g + 2], v3 = pt[4 * g + 3];
                    if (dir == 0) {
                        if (s0 > t) v0 = 0.f; if (s0 + 1 > t) v1 = 0.f; if (s0 + 2 > t) v2 = 0.f; if (s0 + 3 > t) v3 = 0.f;
                    } else {
                        if (s0 < t) v0 = 0.f; if (s0 + 1 < t) v1 = 0.f; if (s0 + 2 < t) v2 = 0.f; if (s0 + 3 < t) v3 = 0.f;
                    }
                    uint2 pk; pk.x = pack2(v0, v1); pk.y = pack2(v2, v3);
                    *(uint2*)(sP + t * HRS + s0 * 2) = pk;
                }
            }
            __syncthreads();
            {
                const int vi = w >> 1, ti = w & 1;
                accO = tile_mm64(sVT, sP, vi * 32, ti * 32, lane, accO);
                accO = tile_mm64(sST, sQh, vi * 32, ti * 32, lane, accO);
            }
            __syncthreads();
        }
        const int vi = w >> 1, ti = w & 1;
        float ssq = 0.f;
#pragma unroll
        for (int r = 0; r < 16; ++r) ssq += accO[r] * accO[r];
        ssq += __shfl_xor(ssq, 32);
        sSS[w * 64 + lane] = ssq;
        __syncthreads();
        const float tot = sSS[ti * 64 + l31] + sSS[(2 + ti) * 64 + l31];
        const float rs = rsqrtf(tot * (1.0f / 64.0f) + EPS);
        const int tok = tok0 + ti * 32 + l31;
#pragma unroll
        for (int g = 0; g < 4; ++g) {
            const int v0 = vi * 32 + 8 * g + 4 * hh;
            const uint2 gz = cur.gz[g];
            const float4 gn = *(const float4*)(p.hg_g + h * 64 + v0);
            const float g0 = bflo(gz.x), g1 = bfhi(gz.x), g2 = bflo(gz.y), g3 = bfhi(gz.y);
            const float o0 = accO[4 * g] * rs * gn.x * (g0 / (1.0f + __expf(-g0)));
            const float o1 = accO[4 * g + 1] * rs * gn.y * (g1 / (1.0f + __expf(-g1)));
            const float o2 = accO[4 * g + 2] * rs * gn.z * (g2 / (1.0f + __expf(-g2)));
            const float o3 = accO[4 * g + 3] * rs * gn.w * (g3 / (1.0f + __expf(-g3)));
            uint2 pk; pk.x = pack2(o0, o1); pk.y = pack2(o2, o3);
            *(uint2*)(p.mix() + (size_t)tok * D + 512 + h * 64 + v0) = pk;
        }
        cur = nxt;
    }
    for (int base = VBID * 4; base < 4096; base += VGRID * 4) {
        const int h = (base >> 8) & 3, b = base >> 10;
        char* sK = smem;
        char* sV = smem + 36864;
        __syncthreads();
        {
            uint4 kk[8], vv[8];
#pragma unroll
            for (int i = 0; i < 8; ++i) {
                const int ch = tid + 256 * i;
                kk[i] = *(const uint4*)(p.kvb() + (size_t)(b * 256 + (ch >> 3)) * 512 + h * 64 + (ch & 7) * 8);
                vv[i] = *(const uint4*)(p.kvT() + ((size_t)(b * 4 + h) * 64 + (ch >> 5)) * 256 + (ch & 31) * 8);
            }
#pragma unroll
            for (int i = 0; i < 8; ++i) {
                const int ch = tid + 256 * i;
                *(uint4*)(sK + (ch >> 3) * 144 + (ch & 7) * 16) = kk[i];
                *(uint4*)(sV + (ch >> 5) * 528 + (ch & 31) * 16) = vv[i];
            }
        }
        __syncthreads();
        mem_attn_wave(p, base + w, lane, sK, sV);
    }
}


__device__ __forceinline__ int ord_key(int fb) { return fb ^ ((fb >> 31) & 0x7FFFFFFF); }

template <int N>
__device__ __forceinline__ void bitonic_sort_desc(int (&v)[N]) {
#pragma unroll
    for (int k = 2; k <= N; k <<= 1) {
#pragma unroll
        for (int j = k >> 1; j > 0; j >>= 1) {
#pragma unroll
            for (int i = 0; i < N; ++i) {
                const int l = i ^ j;
                if (l > i) {
                    const bool desc = ((i & k) == 0);
                    const int a = v[i], b = v[l];
                    const int mx = max(a, b), mn = min(a, b);
                    v[i] = desc ? mx : mn;
                    v[l] = desc ? mn : mx;
                }
            }
        }
    }
}
template <int N>
__device__ __forceinline__ void bitonic_merge_desc(int (&v)[N]) {
#pragma unroll
    for (int j = N >> 1; j > 0; j >>= 1) {
#pragma unroll
        for (int i = 0; i < N; ++i) {
            const int l = i ^ j;
            if (l > i) {
                const int a = v[i], b = v[l];
                v[i] = max(a, b);
                v[l] = min(a, b);
            }
        }
    }
}
__device__ __forceinline__ void merge_prune16(int (&r)[16], const int (&o)[16]) {
#pragma unroll
    for (int i = 0; i < 16; ++i) r[i] = max(r[i], o[15 - i]);
    bitonic_merge_desc<16>(r);
}

constexpr int QRS = 528;
struct EpiQpLds {
    char* qt; const float* ssrow; const unsigned* hmax; const float* sb; int brow, bcol;
    __device__ __forceinline__ void operator()(int row, int col, const f32x4& v) const {
        const float rs = rsqrtf(ssrow[row] * (1.0f / 1024.0f) + EPS) * __uint_as_float(hmax[row]) * (1.0f / 127.0f);
        const float4 b = *(const float4*)(sb + col);
        uint2 pk; pk.x = pack2(v[0] * rs * b.x, v[1] * rs * b.y); pk.y = pack2(v[2] * rs * b.z, v[3] * rs * b.w);
        *(uint2*)(qt + (row - brow) * QRS + (col - bcol) * 2) = pk;
    }
};
__device__ __forceinline__ int* route_slot(char* wrows, int e) { return (int*)(wrows + (e >> 6) * QRS + (e & 63) * 4); }

__device__ __forceinline__ void route_tile(const Params& p, char* qt, int tok0, int h) {
    const int tid = threadIdx.x, lane = tid & 63, w = tid >> 6;
    const int tl = lane & 31, hh = lane >> 5;
    char* wrows = qt + (w * 32) * QRS;
    const int tok = tok0 + w * 32 + tl;
    const bf16_t* sp = p.subk_b() + (size_t)(h * 2) * 16384 + tl * 128 + hh * 8;
    bf16x8 an[8];
#pragma unroll
    for (int ks = 0; ks < 8; ++ks) an[ks] = *(const bf16x8*)(sp + ks * 16);
#pragma unroll
    for (int c = 0; c < 2; ++c) {
        bf16x8 qf[8];
#pragma unroll
        for (int ks = 0; ks < 8; ++ks) qf[ks] = *(const bf16x8*)(wrows + tl * QRS + (c * 128 + ks * 16 + hh * 8) * 2);
        int cur[16];
#pragma unroll
        for (int kb = 0; kb < 4; ++kb) {
            bf16x8 af[8];
#pragma unroll
            for (int ks = 0; ks < 8; ++ks) af[ks] = an[ks];
            if (c * 4 + kb + 1 < 8) {
                const bf16_t* sn = sp + (c * 4 + kb + 1) * 4096;
#pragma unroll
                for (int ks = 0; ks < 8; ++ks) an[ks] = *(const bf16x8*)(sn + ks * 16);
            }
            f32x16 acc;
#pragma unroll
            for (int r = 0; r < 16; ++r) acc[r] = 0.f;
#pragma unroll
            for (int ks = 0; ks < 8; ++ks) acc = __builtin_amdgcn_mfma_f32_32x32x16_bf16(af[ks], qf[ks], acc, 0, 0, 0);
            int v[16];
#pragma unroll
            for (int r = 0; r < 16; ++r) {
                const int key = kb * 32 + (r & 3) + 8 * (r >> 2) + 4 * hh;
                const int fb = (__float_as_int(acc[r]) & ~127) | (127 - key);
                v[r] = ord_key(fb);
            }
            bitonic_sort_desc<16>(v);
            if (kb == 0) {
#pragma unroll
                for (int r = 0; r < 16; ++r) cur[r] = v[r];
            } else {
                merge_prune16(cur, v);
            }
            __builtin_amdgcn_sched_barrier(0);
        }
        {
            int o[16];
#pragma unroll
            for (int r = 0; r < 16; ++r) o[r] = __shfl_xor(cur[r], 32);
            merge_prune16(cur, o);
        }
#pragma unroll
        for (int r = 0; r < 16; ++r) *route_slot(wrows, c * 512 + r * 32 + tl) = cur[r];
        __builtin_amdgcn_sched_barrier(0);
    }
    float va[16], vb[16];
#pragma unroll
    for (int r = 0; r < 16; ++r) {
        const int fa = ord_key(*route_slot(wrows, r * 32 + tl)), fb = ord_key(*route_slot(wrows, 512 + r * 32 + tl));
        va[r] = __int_as_float(fa & ~127);
        vb[r] = __int_as_float(fb & ~127);
    }
    int best[16];
#pragma unroll
    for (int j = 0; j < 16; ++j) best[j] = ord_key((__float_as_int(va[0] + vb[j]) & ~255) | (255 - j));
#pragma unroll
    for (int i = 1; i < 8; ++i) {
        const int n = 16 / (i + 1);
        int row[16];
#pragma unroll
        for (int j = 0; j < 16; ++j)
            row[j] = (j < n) ? ord_key((__float_as_int(va[i] + vb[j]) & ~255) | (255 - (i * 16 + j))) : (int)0x80000000;
        merge_prune16(best, row);
    }
    {
        int row[16];
#pragma unroll
        for (int j = 0; j < 16; ++j)
            row[j] = (j < 8) ? ord_key((__float_as_int(va[8 + j] + vb[0]) & ~255) | (255 - ((8 + j) * 16))) : (int)0x80000000;
        merge_prune16(best, row);
    }
    float sv[16];
    int pid[16];
#pragma unroll
    for (int r = 0; r < 16; ++r) {
        const int cb = ord_key(best[r]);
        sv[r] = __int_as_float(cb & ~255);
        pid[r] = 255 - (cb & 255);
    }
    float tot = 0.f;
    const float smax = sv[0];
#pragma unroll
    for (int r = 0; r < 16; ++r) { sv[r] = __expf(sv[r] - smax); tot += sv[r]; }
    const float inv = 1.0f / tot;
    if (hh == 0) {
#pragma unroll
        for (int r = 0; r < 16; ++r) {
            const int ia = 127 - (ord_key(*route_slot(wrows, (pid[r] >> 4) * 32 + tl)) & 127);
            const int ib = 127 - (ord_key(*route_slot(wrows, 512 + (pid[r] & 15) * 32 + tl)) & 127);
            const int pos = (r & 7) * 16 + h * 2 + (r >> 3);
            p.eidx()[(size_t)tok * 128 + pos] = (unsigned short)(ia * 128 + ib);
            p.gate()[(size_t)tok * 128 + pos] = sv[r] * inv;
        }
    }
}

__device__ void phase_gemm_q_route(const Params& p, char* smem) {
    const int nM = NTOK / 256, nN = QW / 256;
    for (int i = 0; i * (int)gridDim.x + (int)blockIdx.x < nM * nN; ++i) {
        int pm, pn;
        g8::tile_of(i * gridDim.x + blockIdx.x, nM, nN, pm, pn);
        EpiQpLds e{smem, p.ss1(), p.hmax(), p.sb() + INW, pm * 256, pn * 256};
        gemm256_tile<false, false, true>(p.h2q(), p.w_q_q(), D, pm * 256, pn * 256, smem, e);
        __syncthreads();
        route_tile(p, smem, pm * 256, pn);
    }
}

__device__ void phase_route(const Params& p, char* smem) {
    char* sk = smem;
    const int tid = VTID, lane = tid & 63, w = tid >> 6;
    int* sA = (int*)(smem + 32768) + w * 2048;
    int* sB = (int*)(smem + 65536) + w * 512;
    const int tl = lane & 31, hh = lane >> 5;
    const int h = VBID & 7, tg0 = VBID >> 3, tgs = VGRID >> 3;
    for (int base = tg0; base < 256; base += 4 * tgs)
    for (int c = 0; c < 2; ++c) {
        const int hc = h * 2 + c;
        __syncthreads();
        {
            const bf16_t* sp = p.subk_b() + (size_t)hc * 16384;
#pragma unroll
            for (int i = 0; i < 8; ++i) {
                const int ch = tid + 256 * i;
                const int row = ch >> 4, cc = ch & 15;
                const uint4 v = *(const uint4*)(sp + row * 128 + cc * 8);
                *(uint4*)(sk + row * 256 + ((cc ^ (row & 15)) << 4)) = v;
            }
        }
        __syncthreads();
        bf16x8 qf[8];
        if (base < 256) {
            const bf16_t* qr = p.z() + (size_t)(base * 128 + w * 32 + tl) * QW + hc * 128 + hh * 8;
#pragma unroll
            for (int ks = 0; ks < 8; ++ks) qf[ks] = *(const bf16x8*)(qr + ks * 16);
        }
        for (int it = 0; it < 4; ++it) {
            const int tgp = base + it * tgs;
            if (tgp >= 256) break;
            const int tok = tgp * 128 + w * 32 + tl;
            int* sidx = sA + it * 512;
            f32x16 acc4[4];
#pragma unroll
            for (int kb = 0; kb < 4; ++kb) {
#pragma unroll
                for (int r = 0; r < 16; ++r) acc4[kb][r] = 0.f;
                const int row = kb * 32 + tl;
#pragma unroll
                for (int ks = 0; ks < 8; ++ks) {
                    const bf16x8 af = *(const bf16x8*)(sk + row * 256 + (((ks * 2 + hh) ^ (row & 15)) << 4));
                    acc4[kb] = __builtin_amdgcn_mfma_f32_32x32x16_bf16(af, qf[ks], acc4[kb], 0, 0, 0);
                }
            }
            if (it + 1 < 4 && tgp + tgs < 256) {
                const bf16_t* qr = p.z() + (size_t)((tgp + tgs) * 128 + w * 32 + tl) * QW + hc * 128 + hh * 8;
#pragma unroll
                for (int ks = 0; ks < 8; ++ks) qf[ks] = *(const bf16x8*)(qr + ks * 16);
            }
            int cur[16];
#pragma unroll
            for (int kb = 0; kb < 4; ++kb) {
                int v[16];
#pragma unroll
                for (int r = 0; r < 16; ++r) {
                    const int key = kb * 32 + (r & 3) + 8 * (r >> 2) + 4 * hh;
                    const int fb = (__float_as_int(acc4[kb][r]) & ~127) | (127 - key);
                    v[r] = ord_key(fb);
                }
                bitonic_sort_desc<16>(v);
                if (kb == 0) {
#pragma unroll
                    for (int r = 0; r < 16; ++r) cur[r] = v[r];
                } else {
                    merge_prune16(cur, v);
                }
            }
            {
                int o[16];
#pragma unroll
                for (int r = 0; r < 16; ++r) o[r] = __shfl_xor(cur[r], 32);
                merge_prune16(cur, o);
            }
            if (c == 0) {
#pragma unroll
                for (int r = 0; r < 16; ++r) sidx[r * 32 + tl] = cur[r];
                continue;
            }
#pragma unroll
            for (int r = 0; r < 16; ++r) sB[r * 32 + tl] = cur[r];
        float va[16], vb[16];
#pragma unroll
        for (int r = 0; r < 16; ++r) {
            const int fa = ord_key(sidx[r * 32 + tl]), fb = ord_key(sB[r * 32 + tl]);
            va[r] = __int_as_float(fa & ~127);
            vb[r] = __int_as_float(fb & ~127);
        }
        int best[16];
#pragma unroll
        for (int j = 0; j < 16; ++j) best[j] = ord_key((__float_as_int(va[0] + vb[j]) & ~255) | (255 - j));
#pragma unroll
        for (int i = 1; i < 8; ++i) {
            const int n = 16 / (i + 1);
            int row[16];
#pragma unroll
            for (int j = 0; j < 16; ++j)
                row[j] = (j < n) ? ord_key((__float_as_int(va[i] + vb[j]) & ~255) | (255 - (i * 16 + j))) : (int)0x80000000;
            merge_prune16(best, row);
        }
        {
            int row[16];
#pragma unroll
            for (int j = 0; j < 16; ++j)
                row[j] = (j < 8) ? ord_key((__float_as_int(va[8 + j] + vb[0]) & ~255) | (255 - ((8 + j) * 16))) : (int)0x80000000;
            merge_prune16(best, row);
        }
        float sv[16];
        int pid[16];
#pragma unroll
        for (int r = 0; r < 16; ++r) {
            const int cb = ord_key(best[r]);
            sv[r] = __int_as_float(cb & ~255);
            pid[r] = 255 - (cb & 255);
        }
        float tot = 0.f;
        const float smax = sv[0];
#pragma unroll
        for (int r = 0; r < 16; ++r) { sv[r] = __expf(sv[r] - smax); tot += sv[r]; }
        const float inv = 1.0f / tot;
        if (hh == 0) {
#pragma unroll
            for (int r = 0; r < 16; ++r) {
                const int ia = 127 - (ord_key(sidx[(pid[r] >> 4) * 32 + tl]) & 127);
                const int ib = 127 - (ord_key(sB[(pid[r] & 15) * 32 + tl]) & 127);
                const int pos = (r & 7) * 16 + h * 2 + (r >> 3);
                p.eidx()[(size_t)tok * 128 + pos] = (unsigned short)(ia * 128 + ib);
                p.gate()[(size_t)tok * 128 + pos] = sv[r] * inv;
            }
        }
        }
    }
}

constexpr int PEER_TG = 512;
constexpr int PEER_TPW = PEER_TG / 8;
constexpr int PEER_NTG = NTOK / PEER_TG;
constexpr int PEER_NCH = 8;

#define PEER_G1(base, wv, hi) (*(const uint4*)((base) + (unsigned)((((hi) ? ((wv) >> 16) : ((wv) & 0xFFFFu)) << 7) + dlo)))
#define PEER_GATHER16(dst, base, ia, ib)                                                             \
    dst[0] = PEER_G1(base, (ia).x, 0);  dst[1] = PEER_G1(base, (ia).x, 1);  dst[2] = PEER_G1(base, (ia).y, 0);  dst[3] = PEER_G1(base, (ia).y, 1);   \
    dst[4] = PEER_G1(base, (ia).z, 0);  dst[5] = PEER_G1(base, (ia).z, 1);  dst[6] = PEER_G1(base, (ia).w, 0);  dst[7] = PEER_G1(base, (ia).w, 1);   \
    dst[8] = PEER_G1(base, (ib).x, 0);  dst[9] = PEER_G1(base, (ib).x, 1);  dst[10] = PEER_G1(base, (ib).y, 0); dst[11] = PEER_G1(base, (ib).y, 1);  \
    dst[12] = PEER_G1(base, (ib).z, 0); dst[13] = PEER_G1(base, (ib).z, 1); dst[14] = PEER_G1(base, (ib).w, 0); dst[15] = PEER_G1(base, (ib).w, 1);

__device__ __forceinline__ unsigned quant4(float a, float b, float c, float d, float qs) {
    const int q0 = (int)rintf(__builtin_amdgcn_fmed3f(a * qs, -127.f, 127.f)), q1 = (int)rintf(__builtin_amdgcn_fmed3f(b * qs, -127.f, 127.f));
    const int q2 = (int)rintf(__builtin_amdgcn_fmed3f(c * qs, -127.f, 127.f)), q3 = (int)rintf(__builtin_amdgcn_fmed3f(d * qs, -127.f, 127.f));
    return (unsigned)(q0 & 255) | ((unsigned)(q1 & 255) << 8) | ((unsigned)(q2 & 255) << 16) | ((unsigned)(q3 & 255) << 24);
}
__device__ void phase_quant_h2(const Params& p) {
    const int tid = VTID, lane = tid & 63, w = tid >> 6;
    for (int r0 = VBID * 4; r0 < NTOK; r0 += VGRID * 4) {
        const int r = r0 + w;
        const uint4* xp = (const uint4*)(p.x1b() + (size_t)r * D + lane * 16);
        const uint4 xa = xp[0], xb = xp[1];
        const float4* gp = (const float4*)(p.ffn_g + lane * 16);
        const float4 g0 = gp[0], g1 = gp[1], g2 = gp[2], g3 = gp[3];
        const float hm = __uint_as_float(p.hmax()[r]);
        const float qs = hm > 0.f ? 127.0f / hm : 0.f;
        uint4 o;
        o.x = quant4(bflo(xa.x) * g0.x, bfhi(xa.x) * g0.y, bflo(xa.y) * g0.z, bfhi(xa.y) * g0.w, qs);
        o.y = quant4(bflo(xa.z) * g1.x, bfhi(xa.z) * g1.y, bflo(xa.w) * g1.z, bfhi(xa.w) * g1.w, qs);
        o.z = quant4(bflo(xb.x) * g2.x, bfhi(xb.x) * g2.y, bflo(xb.y) * g2.z, bfhi(xb.y) * g2.w, qs);
        o.w = quant4(bflo(xb.z) * g3.x, bfhi(xb.z) * g3.y, bflo(xb.w) * g3.z, bfhi(xb.w) * g3.w, qs);
        *(uint4*)(p.h2q() + (size_t)r * D + lane * 16) = o;
    }
}

template <int CTRL>
__device__ __forceinline__ int dpp_movi(int v) { return __builtin_amdgcn_update_dpp(0, v, CTRL, 0xf, 0xf, true); }

struct DotTok { uint4 ia, ib; uint4 ha; };
__device__ __forceinline__ void dots_load(const Params& p, DotTok& t, int tok, int c, int g, int d8) {
    const uint4* idp = (const uint4*)(p.eidx() + (size_t)tok * 128 + g * 16);
    t.ia = idp[0]; t.ib = idp[1];
    t.ha = *(const uint4*)(p.h2q() + (size_t)tok * D + c * 128 + d8 * 16);
}
__device__ __forceinline__ void dotsf_load(const Params& p, DotTok& t, int tokb, int s, int g, int d8) {
    dots_load(p, t, tokb + 8 * (s & 15), s >> 4, g, d8);
}
__device__ __forceinline__ void dotsf_finish(const uint4 (&uu)[16], const DotTok& t, int* part, int g, int d8) {
    const int h0 = (int)t.ha.x, h1 = (int)t.ha.y, h2 = (int)t.ha.z, h3 = (int)t.ha.w;
    int acc[16];
#pragma unroll
    for (int i = 0; i < 16; ++i) {
        int a = __builtin_amdgcn_sdot4((int)uu[i].x, h0, 0, false);
        a = __builtin_amdgcn_sdot4((int)uu[i].y, h1, a, false);
        a = __builtin_amdgcn_sdot4((int)uu[i].z, h2, a, false);
        a = __builtin_amdgcn_sdot4((int)uu[i].w, h3, a, false);
        a += dpp_movi<DPP_QP_X1>(a);
        a += dpp_movi<DPP_QP_X2>(a);
        a += dpp_movi<DPP_HMIRROR>(a);
        acc[i] = a;
    }
    if (d8 == 0) {
#pragma unroll
        for (int i = 0; i < 16; ++i) (void)__hip_atomic_fetch_add(part + g * 16 + i, acc[i], __ATOMIC_RELAXED, __HIP_MEMORY_SCOPE_WORKGROUP);
    }
}

__device__ __forceinline__ float gelu_erf(float v);

__device__ void phase_peer_dots(const Params& p, char* smem) {
    const int tid = threadIdx.x, lane = tid & 63, w = tid >> 6;
    const int g = lane >> 3, d8 = lane & 7;
    int* part = (int*)smem + w * 2048;
    for (int tgp = blockIdx.x; tgp < NTOK / 128; tgp += gridDim.x) {
        const int tokb = tgp * 128 + w;
        __syncthreads();
        for (int i = lane; i < 2048; i += 64) part[i] = 0;
        __syncthreads();
        const char* ubase = (const char*)p.u_c();
        const unsigned dlo = d8 * 16;
        DotTok ta, tb, tn;
        uint4 ua[16], ubuf[16];
        dotsf_load(p, ta, tokb, 0, g, d8);
        dotsf_load(p, tb, tokb, 1, g, d8);
        PEER_GATHER16(ua, ubase, ta.ia, ta.ib)
        PEER_GATHER16(ubuf, ubase, tb.ia, tb.ib)
        dotsf_load(p, tn, tokb, 2, g, d8);
        for (int s = 0; s < 128; s += 2) {
            dotsf_finish(ua, ta, part + (s & 15) * 128, g, d8);
            if (s + 2 < 128) {
                ta = tn;
                const char* ub = ubase + (size_t)((s + 2) >> 4) * 16384 * 128;
                PEER_GATHER16(ua, ub, ta.ia, ta.ib)
                dotsf_load(p, tn, tokb, min(s + 3, 127), g, d8);
            }
            dotsf_finish(ubuf, tb, part + ((s + 1) & 15) * 128, g, d8);
            if (s + 3 < 128) {
                tb = tn;
                const char* ub = ubase + (size_t)((s + 3) >> 4) * 16384 * 128;
                PEER_GATHER16(ubuf, ub, tb.ia, tb.ib)
                dotsf_load(p, tn, tokb, min(s + 4, 127), g, d8);
            }
        }
        __syncthreads();
        for (int k0 = 0; k0 < 16; k0 += 4) {
            int ps[4][2], e[4][2];
            float gt[4][2], sh[4];
#pragma unroll
            for (int q = 0; q < 4; ++q) {
                const int tok = tokb + 8 * (k0 + q);
                sh[q] = __uint_as_float(p.hmax()[tok]) * (1.0f / 127.0f) * rsqrtf(p.ss1()[tok] * (1.0f / 1024.0f) + EPS);
#pragma unroll
                for (int u = 0; u < 2; ++u) {
                    const int slot = lane + 64 * u;
                    ps[q][u] = part[(k0 + q) * 128 + slot];
                    e[q][u] = p.eidx()[(size_t)tok * 128 + slot];
                    gt[q][u] = p.gate()[(size_t)tok * 128 + slot];
                }
            }
            float su[4][2], sv[4][2];
#pragma unroll
            for (int q = 0; q < 4; ++q)
#pragma unroll
                for (int u = 0; u < 2; ++u) { su[q][u] = p.scale_u()[e[q][u]]; sv[q][u] = p.scale_v()[e[q][u]]; }
#pragma unroll
            for (int q = 0; q < 4; ++q) {
                const int tok = tokb + 8 * (k0 + q);
                float cf[2];
#pragma unroll
                for (int u = 0; u < 2; ++u) cf[u] = gelu_erf((float)ps[q][u] * su[q][u] * sh[q]) * gt[q][u] * sv[q][u];
                const float cm = wave_max(fmaxf(fabsf(cf[0]), fabsf(cf[1])));
                const float qs = cm > 0.f ? 127.0f / cm : 0.f;
                p.coef()[(size_t)tok * 128 + lane] = (signed char)(int)rintf(cf[0] * qs);
                p.coef()[(size_t)tok * 128 + lane + 64] = (signed char)(int)rintf(cf[1] * qs);
                if (lane == 0) p.csum()[tok] = cm * (1.0f / 127.0f);
            }
        }
    }
}

__device__ __forceinline__ float gelu_erf(float v) {
    const float av = fabsf(v);
    const float t = __builtin_amdgcn_rcpf(fmaf(av, 0.2316418882f, 1.0f));
    float q = fmaf(t, 0.5307027145f, -0.7265760135f);
    q = fmaf(q, t, 0.7107068705f);
    q = fmaf(q, t, -0.142248368f);
    q = fmaf(q, t, 0.127414796f);
    q = q * t;
    const float e = __builtin_amdgcn_exp2f(v * v * -0.72134752044f);
    const float m = v * (q * e);
    return v < 0.f ? m : v - m;
}
struct AccTok { uint4 ia, ib; uint4 cq; float cs; };
__device__ __forceinline__ void acc_load(const Params& p, AccTok& t, int tok, int g) {
    const uint4* idp = (const uint4*)(p.eidx() + (size_t)tok * 128 + g * 16);
    t.ia = idp[0]; t.ib = idp[1];
    t.cq = *(const uint4*)(p.coef() + (size_t)tok * 128 + g * 16);
    t.cs = p.csum()[tok];
}
#define PEER_T4DOT(acc, B, r0, r1, r2, r3, cq)                                   \
    {                                                                            \
        const unsigned t0 = __builtin_amdgcn_perm(r1, r0, 0x05010400u), t1 = __builtin_amdgcn_perm(r1, r0, 0x07030602u); \
        const unsigned t2 = __builtin_amdgcn_perm(r3, r2, 0x05010400u), t3 = __builtin_amdgcn_perm(r3, r2, 0x07030602u); \
        acc[(B) + 0] = __builtin_amdgcn_sdot4((int)__builtin_amdgcn_perm(t2, t0, 0x05040100u), (int)(cq), acc[(B) + 0], false); \
        acc[(B) + 1] = __builtin_amdgcn_sdot4((int)__builtin_amdgcn_perm(t2, t0, 0x07060302u), (int)(cq), acc[(B) + 1], false); \
        acc[(B) + 2] = __builtin_amdgcn_sdot4((int)__builtin_amdgcn_perm(t3, t1, 0x05040100u), (int)(cq), acc[(B) + 2], false); \
        acc[(B) + 3] = __builtin_amdgcn_sdot4((int)__builtin_amdgcn_perm(t3, t1, 0x07060302u), (int)(cq), acc[(B) + 3], false); \
    }
__device__ __forceinline__ void accf_finish(const uint4 (&vv)[16], const AccTok& t, char* rowp, int g) {
    const unsigned cw[4] = {t.cq.x, t.cq.y, t.cq.z, t.cq.w};
    int acc[16];
#pragma unroll
    for (int j = 0; j < 16; ++j) acc[j] = 0;
#pragma unroll
    for (int j = 0; j < 4; ++j) {
        PEER_T4DOT(acc, 0, vv[4 * j].x, vv[4 * j + 1].x, vv[4 * j + 2].x, vv[4 * j + 3].x, cw[j])
        PEER_T4DOT(acc, 4, vv[4 * j].y, vv[4 * j + 1].y, vv[4 * j + 2].y, vv[4 * j + 3].y, cw[j])
        PEER_T4DOT(acc, 8, vv[4 * j].z, vv[4 * j + 1].z, vv[4 * j + 2].z, vv[4 * j + 3].z, cw[j])
        PEER_T4DOT(acc, 12, vv[4 * j].w, vv[4 * j + 1].w, vv[4 * j + 2].w, vv[4 * j + 3].w, cw[j])
    }
    int t8[8], u4[4];
#pragma unroll
    for (int j = 0; j < 8; ++j) {
        const auto r = __builtin_amdgcn_permlane32_swap((unsigned)acc[j], (unsigned)acc[j + 8], false, false);
        t8[j] = (int)(r[0] + r[1]);
    }
#pragma unroll
    for (int j = 0; j < 4; ++j) {
        const auto r = __builtin_amdgcn_permlane16_swap((unsigned)t8[j], (unsigned)t8[j + 4], false, false);
        u4[j] = (int)(r[0] + r[1]);
    }
    float o[4];
#pragma unroll
    for (int j = 0; j < 4; ++j) {
        int v = u4[j];
        v += dpp_movi<DPP_ROR8>(v);
        o[j] = (float)v * t.cs;
    }
    if ((g & 1) == 0) {
        const int rho = g >> 1;
        uint2 w0; w0.x = pack2(o[0], o[1]); w0.y = pack2(o[2], o[3]);
        *(uint2*)(rowp + (4 * (rho & 1) + 8 * (rho >> 1)) * 2) = w0;
    }
}

__device__ void phase_peer_accum(const Params& p, char* smem) {
    const int tid = threadIdx.x, lane = tid & 63, w = tid >> 6;
    const int g = lane >> 3, d8 = lane & 7;
    char* rowbuf = smem + w * 16384;
    for (int tgp = blockIdx.x; tgp < NTOK / 64; tgp += gridDim.x) {
        const int tokb = tgp * 64 + w;
        __syncthreads();
        const char* vbase = (const char*)p.v_c();
        const unsigned dlo = d8 * 16;
        AccTok ta, tb, tn;
        uint4 va[16], vbuf[16];
        acc_load(p, ta, tokb, g);
        acc_load(p, tb, tokb + 8, g);
        PEER_GATHER16(va, vbase, ta.ia, ta.ib)
        PEER_GATHER16(vbuf, vbase, tb.ia, tb.ib)
        acc_load(p, tn, tokb + 16, g);
        for (int s = 0; s < 64; s += 2) {
            accf_finish(va, ta, rowbuf + (s & 7) * 2048 + (s >> 3) * 256 + d8 * 32, g);
            if (s + 2 < 64) {
                ta = tn;
                const char* vb = vbase + (size_t)((s + 2) >> 3) * 16384 * 128;
                PEER_GATHER16(va, vb, ta.ia, ta.ib)
                acc_load(p, tn, tokb + 8 * (min(s + 3, 63) & 7), g);
            }
            accf_finish(vbuf, tb, rowbuf + ((s + 1) & 7) * 2048 + ((s + 1) >> 3) * 256 + d8 * 32, g);
            if (s + 3 < 64) {
                tb = tn;
                const char* vb = vbase + (size_t)((s + 3) >> 3) * 16384 * 128;
                PEER_GATHER16(vbuf, vb, tb.ia, tb.ib)
                acc_load(p, tn, tokb + 8 * (min(s + 4, 63) & 7), g);
            }
        }
        __syncthreads();
        for (int k0 = 0; k0 < 8; k0 += 2) {
            float4 v[2][4];
#pragma unroll
            for (int q = 0; q < 2; ++q) {
                const bf16_t* xrow = p.x1b() + (size_t)(tokb + 8 * (k0 + q)) * D;
#pragma unroll
                for (int j = 0; j < 4; ++j) {
                    const uint2 xk = *(const uint2*)(xrow + (j * 64 + lane) * 4);
                    v[q][j] = make_float4(bflo(xk.x), bfhi(xk.x), bflo(xk.y), bfhi(xk.y));
                }
            }
#pragma unroll
            for (int q = 0; q < 2; ++q) {
                float* orow = p.out + (size_t)(tokb + 8 * (k0 + q)) * D;
                const char* prow = rowbuf + (k0 + q) * 2048;
                float ss = 0.f;
#pragma unroll
                for (int j = 0; j < 4; ++j) {
                    const uint2 pk = *(const uint2*)(prow + (j * 64 + lane) * 8);
                    v[q][j].x += bflo(pk.x); v[q][j].y += bfhi(pk.x); v[q][j].z += bflo(pk.y); v[q][j].w += bfhi(pk.y);
                    ss += v[q][j].x * v[q][j].x + v[q][j].y * v[q][j].y + v[q][j].z * v[q][j].z + v[q][j].w * v[q][j].w;
                }
                ss = wave_sum(ss);
                const float rs = rsqrtf(ss * (1.0f / 1024.0f) + EPS);
#pragma unroll
                for (int j = 0; j < 4; ++j) {
                    const float4 gg = *(const float4*)(p.fin_g + (j * 64 + lane) * 4);
                    float4 o;
                    o.x = v[q][j].x * rs * gg.x; o.y = v[q][j].y * rs * gg.y; o.z = v[q][j].z * rs * gg.z; o.w = v[q][j].w * rs * gg.w;
                    *(float4*)(orow + (j * 64 + lane) * 4) = o;
                }
            }
        }
    }
}

#define XB_TMO      128
#define XB_XCNT(j)  (256  + 64 * (j))
#define XB_XSUB(j)  (1280 + 64 * (j))
#define XB_XGEN(j)  (2304 + 64 * (j))
#define XB_TOP      3328
#define XB_TOPGEN   3392
#define XCD_BAR_WORDS 3456
#define XB_SPIN_CAP (1u << 18)
__device__ __forceinline__ unsigned xb_ld(unsigned* p)              { return __hip_atomic_load(p, __ATOMIC_RELAXED, __HIP_MEMORY_SCOPE_AGENT); }
__device__ __forceinline__ unsigned xb_add(unsigned* p, unsigned v) { return __hip_atomic_fetch_add(p, v, __ATOMIC_RELAXED, __HIP_MEMORY_SCOPE_AGENT); }
#define XB_SPIN(cond, bar) do { unsigned _sp = 0; while (cond) { __builtin_amdgcn_s_sleep(1); \
    if ((++_sp & 255u) == 0u) { if (xb_ld(&(bar)[XB_TMO])) break; if (_sp > XB_SPIN_CAP) { atomicAdd(&(bar)[XB_TMO], 1u); break; } } } } while (0)

struct XcdBarrier { unsigned* bar; unsigned x; volatile unsigned* st; };

__device__ __forceinline__ XcdBarrier xcd_barrier_post(unsigned* bar, volatile unsigned* st) {
    XcdBarrier b; b.bar = bar; b.x = xcc_id(); b.st = st;
    if (threadIdx.x == 0) (void)xb_add(&bar[XB_XCNT(b.x)], 1u);
    return b;
}
__device__ __forceinline__ void xcd_barrier_complete(unsigned* bar, unsigned x, unsigned& nloc, unsigned& nx) {
    const unsigned G = gridDim.x * gridDim.y * gridDim.z;
    unsigned sum, cnt, mine, sp = 0u;
    for (;;) {
        sum = 0u; cnt = 0u; mine = 0u;
#pragma unroll
        for (unsigned j = 0; j < 16; ++j) { const unsigned c = xb_ld(&bar[XB_XCNT(j)]); sum += c; cnt += (c > 0u) ? 1u : 0u; mine = (j == x) ? c : mine; }
        if (sum == G) break;
        __builtin_amdgcn_s_sleep(1);
        if ((++sp & 255u) == 0u) { if (xb_ld(&bar[XB_TMO])) break; if (sp > XB_SPIN_CAP) { atomicAdd(&bar[XB_TMO], 1u); break; } }
    }
    nloc = mine > 0u ? mine : 1u; nx = cnt > 0u ? cnt : 1u;
}
__device__ __forceinline__ void xcd_barrier(const XcdBarrier& b) {
    asm volatile("s_waitcnt vmcnt(0)" ::: "memory");
    __syncthreads();
    if (threadIdx.x == 0) {
        unsigned* bar = b.bar;
        __builtin_amdgcn_s_waitcnt(0);
        unsigned nloc = b.st[0], nx = b.st[1];
        if (nloc == 0u) { xcd_barrier_complete(bar, b.x, nloc, nx); b.st[0] = nloc; b.st[1] = nx; }
        const unsigned old = xb_add(&bar[XB_XSUB(b.x)], 1u);
        const unsigned gen = old / nloc;
        if (old + 1u == (gen + 1u) * nloc) {
            __builtin_amdgcn_fence(__ATOMIC_RELEASE, "agent");
            asm volatile("s_waitcnt vmcnt(0)" ::: "memory");
            const unsigned og = xb_add(&bar[XB_TOP], 1u);
            const unsigned tg = og / nx;
            if (og + 1u == (tg + 1u) * nx) xb_add(&bar[XB_TOPGEN], 1u);
            else XB_SPIN(xb_ld(&bar[XB_TOPGEN]) == tg, bar);
            __builtin_amdgcn_fence(__ATOMIC_ACQUIRE, "agent");
            xb_add(&bar[XB_XGEN(b.x)], 1u);
            asm volatile("s_waitcnt vmcnt(0)" ::: "memory");
        } else {
            XB_SPIN(xb_ld(&bar[XB_XGEN(b.x)]) == gen, bar);
            __builtin_amdgcn_fence(__ATOMIC_ACQUIRE, "agent");
            asm volatile("s_waitcnt vmcnt(0)" ::: "memory");
        }
    }
    __syncthreads();
}

#define RUN_PHASE(K, CALL)                                              \
    if (ph_lo <= (K) && (K) < ph_hi) {                                  \
        CALL;                                                           \
        if (COOP) { if ((K) + 1 < ph_hi) { xcd_barrier(xb); } } \
    }

template <bool COOP>
__global__ void __launch_bounds__(512, 2) fwd_kernel(Params p, int ph_lo, int ph_hi) {
    __shared__ __attribute__((aligned(16))) char smem[SMEM_BYTES + 16];
    char* smh = smem + VHB * HALF_SMEM;
    XcdBarrier xb;
    if (COOP) {
        if (threadIdx.x == 0) *(uint4*)(smem + SMEM_BYTES) = make_uint4(0u, 0u, 0u, 0u);
        __syncthreads();
        xb = xcd_barrier_post(p.bar(), (volatile unsigned*)(smem + SMEM_BYTES));
    }
    if (COOP) { if (ph_lo < 0) cg::this_grid().sync(); }
    RUN_PHASE(0, phase_prep(p, smh))
    RUN_PHASE(1, phase_gemm_in(p, smem))
    RUN_PHASE(2, phase_mixers(p, smh))
    RUN_PHASE(3, (phase_gemm_kv(p, smh), phase_hg_scan(p)))
    RUN_PHASE(4, phase_hg_out(p, smh))
    RUN_PHASE(5, phase_gemm_out(p, smem))
    RUN_PHASE(6, phase_quant_h2(p))
    RUN_PHASE(7, phase_gemm_q_route(p, smem))
    RUN_PHASE(10, phase_peer_dots(p, smem))
    RUN_PHASE(12, phase_peer_accum(p, smem))
}

extern "C" void kernel_launch(void* const* d_in, const int* in_sizes, int n_in, void* d_out, int out_size, void* d_ws, size_t ws_size,
                              hipStream_t stream) {
    Params p{};
    p.x = (const float*)d_in[0]; p.mem = (const float*)d_in[1]; p.attn_g = (const float*)d_in[2]; p.w_in = (const float*)d_in[3];
    p.rpb = (const float*)d_in[4]; p.hg_lb = (const float*)d_in[5]; p.hg_g = (const float*)d_in[6]; p.mem_g = (const float*)d_in[7];
    p.w_kv = (const float*)d_in[8]; p.w_out = (const float*)d_in[9]; p.ffn_g = (const float*)d_in[10]; p.w_q = (const float*)d_in[11];
    p.subk = (const float*)d_in[12]; p.pu = (const float*)d_in[13]; p.pv = (const float*)d_in[14]; p.fin_g = (const float*)d_in[15];
    p.out = (float*)d_out;
    p.ws = (char*)d_ws;
    if (WS_TOTAL > ws_size) { fprintf(stderr, "workspace too small: need %zu have %zu\n", (size_t)WS_TOTAL, ws_size); return; }

#if defined(MULTI_LAUNCH)
    for (int ph = 0; ph < NPHASE; ++ph) fwd_kernel<false><<<dim3(512), dim3(512), 0, stream>>>(p, ph, ph + 1);
#else
    static int grid_blocks = 0;
    if (!grid_blocks) {
        int dev = 0, cus = 0, per_cu = 0;
        hipGetDevice(&dev);
        hipDeviceGetAttribute(&cus, hipDeviceAttributeMultiprocessorCount, dev);
        hipOccupancyMaxActiveBlocksPerMultiprocessor(&per_cu, fwd_kernel<true>, 512, 0);
        if (per_cu > 1) per_cu = 1;
        grid_blocks = (cus * per_cu) & ~3;
    }
    (void)hipMemsetAsync((char*)d_ws + OFF_BAR, 0, XCD_BAR_WORDS * 4, stream);
    int lo = 0, hi = NPHASE;
    void* args[] = {&p, &lo, &hi};
    hipError_t e = hipLaunchCooperativeKernel((void*)fwd_kernel<true>, dim3(grid_blocks), dim3(512), args, 0, stream);
    if (e != hipSuccess) fprintf(stderr, "cooperative launch failed: %s (grid %d)\n", hipGetErrorString(e), grid_blocks);
#endif
}
```

```cpp
#include <hip/hip_runtime.h>
#include <hip/hip_cooperative_groups.h>
#include <stdint.h>
#include <cstdio>

namespace cg = cooperative_groups;

#define VTID ((int)(threadIdx.x & 255))
#define VHB ((int)(threadIdx.x >> 8))
#define VBID ((int)(blockIdx.x * 2 + (threadIdx.x >> 8)))
#define VGRID ((int)(gridDim.x * 2))
constexpr int HALF_SMEM = 73728;

typedef unsigned short bf16_t;
typedef short bf16x8 __attribute__((ext_vector_type(8)));
typedef float f32x4 __attribute__((ext_vector_type(4)));
typedef int i32x4 __attribute__((ext_vector_type(4)));

constexpr int D = 1024;
constexpr int NB = 4;
constexpr int T = 8192;
constexpr int NTOK = NB * T;
constexpr int INW = 3072;
constexpr int QW = 2048;
constexpr float EPS = 1e-6f;
constexpr int SMEM_BYTES = 2 * 73728;
constexpr int NPHASE = 14;

constexpr size_t al256(size_t x) { return (x + 255) & ~(size_t)255; }
constexpr size_t OFF_W_IN_T = 0;
constexpr size_t OFF_W_OUT_T = OFF_W_IN_T + al256((size_t)3072 * 1024 * 2);
constexpr size_t OFF_W_Q_T = OFF_W_OUT_T + al256((size_t)1024 * 1024 * 2);
constexpr size_t OFF_W_KV_T = OFF_W_Q_T + al256((size_t)2048 * 1024 * 2);
constexpr size_t OFF_H = OFF_W_KV_T + al256((size_t)512 * 1024 * 2);
constexpr size_t OFF_Z = OFF_H + al256((size_t)32768 * 1024 * 2);
constexpr size_t OFF_MIX = OFF_Z + al256((size_t)32768 * 3072 * 2);
constexpr size_t OFF_MEMN = OFF_MIX + al256((size_t)32768 * 1024 * 2);
constexpr size_t OFF_KVB = OFF_MEMN + al256((size_t)1024 * 1024 * 2);
constexpr size_t OFF_LB = OFF_KVB + al256((size_t)1024 * 512 * 2);
constexpr size_t OFF_HSTATE = OFF_LB + al256(512 * 4);
constexpr size_t OFF_HDEC = OFF_HSTATE + al256((size_t)4096 * 4096 * 4);
constexpr size_t OFF_UC = OFF_HDEC + al256((size_t)4096 * 64 * 4);
constexpr size_t OFF_VC = OFF_UC + al256((size_t)16384 * 1024);
constexpr size_t OFF_QUEUE = OFF_VC + al256((size_t)16384 * 1024);
constexpr size_t OFF_SUBK = OFF_QUEUE + al256(2048 * 4);
constexpr size_t OFF_BAR = OFF_SUBK + al256((size_t)16 * 128 * 128 * 2);
constexpr size_t OFF_SS1 = OFF_BAR + al256(4096 * 4);
constexpr size_t OFF_HMAX = OFF_SS1 + al256((size_t)32768 * 4);
constexpr size_t OFF_CSUM = OFF_HMAX + al256((size_t)32768 * 4);
constexpr size_t OFF_SCALE_U = OFF_CSUM + al256((size_t)32768 * 4);
constexpr size_t OFF_SCALE_V = OFF_SCALE_U + al256(16384 * 4);
constexpr size_t OFF_VT = OFF_SCALE_V + al256(16384 * 4);
constexpr size_t OFF_KVT = OFF_VT + al256((size_t)32768 * 512 * 2);
constexpr size_t OFF_SA = OFF_KVT + al256((size_t)1024 * 256 * 2);
constexpr size_t OFF_SB = OFF_SA + al256((size_t)32768 * 4);
constexpr size_t WS_TOTAL = OFF_SB + al256((size_t)8192 * 4);
constexpr size_t OFF_EIDX = OFF_HSTATE;
constexpr size_t OFF_GATE = OFF_HSTATE + (size_t)32768 * 128 * 4;
constexpr size_t OFF_COEF = OFF_HSTATE + (size_t)32768 * 128 * 8;
constexpr size_t OFF_SS = OFF_HSTATE + (size_t)32768 * 128 * 12;
constexpr size_t OFF_PARTIAL = OFF_Z;
constexpr size_t OFF_PEER_OUT = OFF_Z + (size_t)8 * 32768 * 128 * 4;

struct Params {
    const float *x, *mem, *attn_g, *w_in, *rpb, *hg_lb, *hg_g, *mem_g, *w_kv, *w_out, *ffn_g, *w_q, *subk, *pu, *pv, *fin_g;
    float* out;
    char* ws;
#define WSF(type, name, off) __device__ __forceinline__ type* name() const { return (type*)(ws + (off)); }
    WSF(bf16_t, w_in_t, OFF_W_IN_T) WSF(bf16_t, w_out_t, OFF_W_OUT_T) WSF(bf16_t, w_q_t, OFF_W_Q_T) WSF(bf16_t, w_kv_t, OFF_W_KV_T)
    WSF(bf16_t, h, OFF_H)
    WSF(bf16_t, z, OFF_Z)
    WSF(bf16_t, mix, OFF_MIX)
    WSF(bf16_t, memn, OFF_MEMN)
    WSF(bf16_t, kvb, OFF_KVB)
    WSF(float, lb, OFF_LB)
    WSF(float, hstate, OFF_HSTATE)
    WSF(float, hdec, OFF_HDEC)
    WSF(unsigned short, eidx, OFF_EIDX)
    WSF(float, gate, OFF_GATE)
    WSF(signed char, coef, OFF_COEF)
    WSF(bf16_t, x1b, OFF_PEER_OUT)
    WSF(float, ss, OFF_SS)
    WSF(float, partial, OFF_PARTIAL)
    WSF(bf16_t, u_c, OFF_UC) WSF(bf16_t, v_c, OFF_VC)
    WSF(unsigned, queue, OFF_QUEUE)
    WSF(bf16_t, subk_b, OFF_SUBK)
    WSF(unsigned, bar, OFF_BAR)
    WSF(float, ss1, OFF_SS1) WSF(unsigned, hmax, OFF_HMAX) WSF(float, csum, OFF_CSUM)
    WSF(float, scale_u, OFF_SCALE_U) WSF(float, scale_v, OFF_SCALE_V)
    WSF(bf16_t, kK, OFF_H + (size_t)32768 * 1024)
    WSF(bf16_t, vT, OFF_VT)
    WSF(signed char, hq, OFF_H)
    WSF(signed char, w_in_q, OFF_W_IN_T)
    WSF(float, sa, OFF_SA) WSF(float, sb, OFF_SB)
    WSF(signed char, h2q, OFF_MIX)
    WSF(signed char, w_q_q, OFF_W_Q_T)
    WSF(signed char, w_kv_q, OFF_W_KV_T)
    WSF(signed char, memq, OFF_MEMN)
    WSF(bf16_t, kvT, OFF_KVT)
#undef WSF
};

__device__ __forceinline__ float bf2f(bf16_t v) { return __uint_as_float(((unsigned)v) << 16); }
__device__ __forceinline__ bf16_t f2bf(float f) {
    unsigned u = __float_as_uint(f);
    u += 0x7FFFu + ((u >> 16) & 1u);
    return (bf16_t)(u >> 16);
}
__device__ __forceinline__ float bflo(unsigned u) { return __uint_as_float(u << 16); }
__device__ __forceinline__ float bfhi(unsigned u) { return __uint_as_float(u & 0xFFFF0000u); }
typedef __bf16 bf16x2v_t __attribute__((ext_vector_type(2)));
typedef float f32x2v_t __attribute__((ext_vector_type(2)));
__device__ __forceinline__ unsigned pack2(float a, float b) {
    const f32x2v_t v = {a, b};
    return __builtin_bit_cast(unsigned, __builtin_convertvector(v, bf16x2v_t));
}

__device__ __forceinline__ float fexp(float x) { return __builtin_amdgcn_exp2f(x * 1.4426950408889634f); }
__device__ __forceinline__ float flog(float x) { return __builtin_amdgcn_logf(x) * 0.6931471805599453f; }
__device__ __forceinline__ float flog2(float x) { return __builtin_amdgcn_logf(x); }
__device__ __forceinline__ float fexp2(float x) { return __builtin_amdgcn_exp2f(x); }
__device__ __forceinline__ float fsigmoid(float x) { return __builtin_amdgcn_rcpf(1.0f + __builtin_amdgcn_exp2f(x * -1.4426950408889634f)); }
template <int CTRL>
__device__ __forceinline__ float wr_dpp(float v) { return __int_as_float(__builtin_amdgcn_update_dpp(0, __float_as_int(v), CTRL, 0xf, 0xf, true)); }
__device__ __forceinline__ float wave_sum(float v) {
    v += wr_dpp<0xB1>(v);
    v += wr_dpp<0x4E>(v);
    v += wr_dpp<0x141>(v);
    v += wr_dpp<0x128>(v);
    { const auto r = __builtin_amdgcn_permlane16_swap(__float_as_uint(v), __float_as_uint(v), false, false); v = __uint_as_float(r[0]) + __uint_as_float(r[1]); }
    { const auto r = __builtin_amdgcn_permlane32_swap(__float_as_uint(v), __float_as_uint(v), false, false); v = __uint_as_float(r[0]) + __uint_as_float(r[1]); }
    return v;
}
__device__ __forceinline__ float wave_max(float v) {
    v = fmaxf(v, wr_dpp<0xB1>(v));
    v = fmaxf(v, wr_dpp<0x4E>(v));
    v = fmaxf(v, wr_dpp<0x141>(v));
    v = fmaxf(v, wr_dpp<0x128>(v));
    { const auto r = __builtin_amdgcn_permlane16_swap(__float_as_uint(v), __float_as_uint(v), false, false); v = fmaxf(__uint_as_float(r[0]), __uint_as_float(r[1])); }
    { const auto r = __builtin_amdgcn_permlane32_swap(__float_as_uint(v), __float_as_uint(v), false, false); v = fmaxf(__uint_as_float(r[0]), __uint_as_float(r[1])); }
    return v;
}


typedef __bf16 bf16x2_t __attribute__((ext_vector_type(2)));
template <int CTRL>
__device__ __forceinline__ float dpp_mov(float v) {
    return __builtin_bit_cast(float, __builtin_amdgcn_update_dpp(0, __builtin_bit_cast(int, v), CTRL, 0xf, 0xf, true));
}
#define DPP_QP_X1 0xB1
#define DPP_QP_X2 0x4E
#define DPP_HMIRROR 0x141
#define DPP_ROR8 0x128
__device__ __forceinline__ unsigned xcc_id() { return (unsigned)__builtin_amdgcn_s_getreg((3 << 11) | 20) & 0xFu; }

__device__ __forceinline__ void transpose_tile(const float* __restrict__ in, bf16_t* __restrict__ out, int K, int N, int tile, char* smem) {
    float* tl = (float*)smem;
    const int ntn = N >> 6;
    const int k0 = (tile / ntn) << 6, n0 = (tile % ntn) << 6;
    const int tid = VTID;
    __syncthreads();
#pragma unroll 4
    for (int i = 0; i < 16; ++i) {
        int idx = tid + 256 * i;
        int r = idx >> 6, c = idx & 63;
        tl[r * 65 + c] = in[(size_t)(k0 + r) * N + n0 + c];
    }
    __syncthreads();
#pragma unroll 4
    for (int i = 0; i < 16; ++i) {
        int idx = tid + 256 * i;
        int r = idx >> 6, c = idx & 63;
        out[(size_t)(n0 + r) * K + k0 + c] = f2bf(tl[c * 65 + r]);
    }
}

__device__ __forceinline__ void rmsnorm_row_bf16(const float* __restrict__ xr, const float* __restrict__ g, bf16_t* __restrict__ o, int lane) {
    float4 v[4];
    float ss = 0.f;
#pragma unroll
    for (int j = 0; j < 4; ++j) {
        v[j] = *(const float4*)(xr + (j * 64 + lane) * 4);
        ss += v[j].x * v[j].x + v[j].y * v[j].y + v[j].z * v[j].z + v[j].w * v[j].w;
    }
    ss = wave_sum(ss);
    const float rs = rsqrtf(ss * (1.0f / 1024.0f) + EPS);
#pragma unroll
    for (int j = 0; j < 4; ++j) {
        const float4 gg = *(const float4*)(g + (j * 64 + lane) * 4);
        uint2 pk;
        pk.x = pack2(v[j].x * rs * gg.x, v[j].y * rs * gg.y);
        pk.y = pack2(v[j].z * rs * gg.z, v[j].w * rs * gg.w);
        *(uint2*)(o + (j * 64 + lane) * 4) = pk;
    }
}

__device__ __forceinline__ void rmsnorm_row_i8(const float* __restrict__ xr, const float* __restrict__ g, signed char* __restrict__ o, float* __restrict__ sa, int lane) {
    float4 v[4];
    float ss = 0.f;
#pragma unroll
    for (int j = 0; j < 4; ++j) {
        v[j] = *(const float4*)(xr + (j * 64 + lane) * 4);
        ss += v[j].x * v[j].x + v[j].y * v[j].y + v[j].z * v[j].z + v[j].w * v[j].w;
    }
    ss = wave_sum(ss);
    const float rs = rsqrtf(ss * (1.0f / 1024.0f) + EPS);
    float am = 0.f;
#pragma unroll
    for (int j = 0; j < 4; ++j) {
        const float4 gg = *(const float4*)(g + (j * 64 + lane) * 4);
        v[j].x *= rs * gg.x; v[j].y *= rs * gg.y; v[j].z *= rs * gg.z; v[j].w *= rs * gg.w;
        am = fmaxf(am, fmaxf(fmaxf(fabsf(v[j].x), fabsf(v[j].y)), fmaxf(fabsf(v[j].z), fabsf(v[j].w))));
    }
    am = wave_max(am);
    const float qs = am > 0.f ? 127.0f * __builtin_amdgcn_rcpf(am) : 0.f;
    if (lane == 0) *sa = am * (1.0f / 127.0f);
#pragma unroll
    for (int j = 0; j < 4; ++j) {
        const int q0 = (int)rintf(v[j].x * qs), q1 = (int)rintf(v[j].y * qs), q2 = (int)rintf(v[j].z * qs), q3 = (int)rintf(v[j].w * qs);
        *(unsigned*)(o + (j * 64 + lane) * 4) = (unsigned)(q0 & 255) | ((unsigned)(q1 & 255) << 8) | ((unsigned)(q2 & 255) << 16) | ((unsigned)(q3 & 255) << 24);
    }
}
__device__ __forceinline__ void transpose_cols_i8(const float* __restrict__ in, signed char* __restrict__ out, float* __restrict__ sb, int N, int item, char* smem) {
    float* tl = (float*)smem;
    const int n0 = item << 4;
    const int tid = VTID;
    __syncthreads();
    {
        float4 v[16];
#pragma unroll
        for (int i = 0; i < 16; ++i) {
            const int idx = tid + 256 * i;
            v[i] = *(const float4*)(in + (size_t)(idx >> 2) * N + n0 + (idx & 3) * 4);
        }
#pragma unroll
        for (int i = 0; i < 16; ++i) {
            const int idx = tid + 256 * i;
            const int k = idx >> 2, c = (idx & 3) * 4;
            tl[(c + 0) * 1028 + k] = v[i].x; tl[(c + 1) * 1028 + k] = v[i].y; tl[(c + 2) * 1028 + k] = v[i].z; tl[(c + 3) * 1028 + k] = v[i].w;
        }
    }
    __syncthreads();
    float qs;
    {
        const int c = tid >> 4, l = tid & 15;
        float am = 0.f;
#pragma unroll 8
        for (int i = 0; i < 64; ++i) am = fmaxf(am, fabsf(tl[c * 1028 + l + 16 * i]));
        am = fmaxf(am, __shfl_xor(am, 1)); am = fmaxf(am, __shfl_xor(am, 2)); am = fmaxf(am, __shfl_xor(am, 4)); am = fmaxf(am, __shfl_xor(am, 8));
        if (l == 0) sb[n0 + c] = am * (1.0f / 127.0f);
        qs = am > 0.f ? 127.0f / am : 0.f;
    }
    __syncthreads();
    float* qt = tl + 16 * 1028;
    if ((tid & 15) == 0) qt[tid >> 4] = qs;
    __syncthreads();
#pragma unroll
    for (int i = 0; i < 16; ++i) {
        const int kq = tid * 4;
        const float q = qt[i];
        const float4 v = *(const float4*)(tl + i * 1028 + kq);
        const int q0 = (int)rintf(v.x * q), q1 = (int)rintf(v.y * q), q2 = (int)rintf(v.z * q), q3 = (int)rintf(v.w * q);
        *(unsigned*)(out + (size_t)(n0 + i) * 1024 + kq) = (unsigned)(q0 & 255) | ((unsigned)(q1 & 255) << 8) | ((unsigned)(q2 & 255) << 16) | ((unsigned)(q3 & 255) << 24);
    }
}

__device__ void phase_prep(const Params& p, char* smem) {
    const int tid = VTID, lane = tid & 63, w = tid >> 6;
    const int gsz = VGRID, bid = VBID;
    const int t_in = INW / 16;
    const int t_out = 16 * 16;
    const int t_q = QW / 16;
    const int t_kv = 512 / 16;
    (void)t_out; (void)t_q;
    for (int it = bid; it < t_in + t_kv; it += gsz) {
        if (it < t_in) transpose_cols_i8(p.w_in, p.w_in_q(), p.sb(), INW, it, smem);
        else transpose_cols_i8(p.w_kv, p.w_kv_q(), p.sb() + 5120, 512, it - t_in, smem);
    }
    for (int i = bid * 256 + tid; i < NTOK; i += gsz * 256) { p.ss1()[i] = 0.f; p.hmax()[i] = 0u; }
    if (bid == 0) {
        for (int i = tid; i < 512; i += 256) {
            int dir = i >> 8, k = i & 255;
            float a0 = p.hg_lb[(dir * 2 + 0) * 256 + k], a1 = p.hg_lb[(dir * 2 + 1) * 256 + k];
            float m = fmaxf(a0, a1);
            float e0 = expf(a0 - m), e1 = expf(a1 - m);
            p.lb()[i] = e0 / (e0 + e1);
        }
    }
    const int nrows = NTOK + 1024;
    for (int r0 = bid * 4; r0 < nrows; r0 += gsz * 4) {
        int r = r0 + w;
        const bool ism = r >= NTOK;
        const int rr = ism ? r - NTOK : r;
        if (r < nrows)
            rmsnorm_row_i8((ism ? p.mem : p.x) + (size_t)rr * D, ism ? p.mem_g : p.attn_g, (ism ? p.memq() : p.hq()) + (size_t)rr * D,
                           (ism ? p.sb() + 5632 : p.sa()) + rr, lane);
    }
    for (int i = bid * 256 + tid; i < 16 * 128 * 128 / 4; i += gsz * 256) {
        const float4 v = *(const float4*)(p.subk + (size_t)i * 4);
        uint2 pk; pk.x = pack2(v.x, v.y); pk.y = pack2(v.z, v.w);
        *(uint2*)(p.subk_b() + (size_t)i * 4) = pk;
    }
}

struct EpiBf16 {
    bf16_t* C; int ldc;
    __device__ __forceinline__ void operator()(int row, int col, const f32x4& v) const {
        uint2 pk; pk.x = pack2(v[0], v[1]); pk.y = pack2(v[2], v[3]);
        *(uint2*)(C + (size_t)row * ldc + col) = pk;
    }
};
struct EpiBf16T {
    bf16_t* C; int col0, ncols, rows_per_b;
    __device__ __forceinline__ void operator()(int row, int col, const f32x4& v) const {
        const int bb = row / rows_per_b, rr = row - bb * rows_per_b;
        uint2 pk; pk.x = pack2(v[0], v[1]); pk.y = pack2(v[2], v[3]);
        *(uint2*)(C + ((size_t)bb * ncols + (col - col0)) * rows_per_b + rr) = pk;
    }
};
struct EpiBf16S {
    bf16_t* C; int ldc; const float* sa; const float* sb;
    __device__ __forceinline__ void operator()(int row, int col, const f32x4& v) const {
        const float s = sa[row];
        const float4 b = *(const float4*)(sb + col);
        uint2 pk; pk.x = pack2(v[0] * s * b.x, v[1] * s * b.y); pk.y = pack2(v[2] * s * b.z, v[3] * s * b.w);
        *(uint2*)(C + (size_t)row * ldc + col) = pk;
    }
};
struct EpiBf16TS {
    bf16_t* C; int col0, ncols, rows_per_b; const float* sa; const float* sb;
    __device__ __forceinline__ void operator()(int row, int col, const f32x4& v) const {
        const int bb = row / rows_per_b, rr = row - bb * rows_per_b;
        const float4 a = *(const float4*)(sa + row);
        const float b = sb[col];
        uint2 pk; pk.x = pack2(v[0] * a.x * b, v[1] * a.y * b); pk.y = pack2(v[2] * a.z * b, v[3] * a.w * b);
        *(uint2*)(C + ((size_t)bb * ncols + (col - col0)) * rows_per_b + rr) = pk;
    }
};
constexpr int EPS_LD = 528;
struct EpiBf16SStaged {
    static constexpr bool staged = true;
    bf16_t* C; int ldc; const float* sa; const float* sb; char* lt; int brow, bcol;
    __device__ __forceinline__ void operator()(int row, int col, const f32x4& v) const {
        const float s = sa[row];
        const float4 b = *(const float4*)(sb + col);
        uint2 pk; pk.x = pack2(v[0] * s * b.x, v[1] * s * b.y); pk.y = pack2(v[2] * s * b.z, v[3] * s * b.w);
        *(uint2*)(lt + (row - brow) * EPS_LD + (col - bcol) * 2) = pk;
    }
    __device__ __forceinline__ void finish() const {
        int tid = threadIdx.x;
        asm volatile("" : "+v"(tid));
        const int c16 = tid & 31, r0 = tid >> 5;
#pragma unroll
        for (int i = 0; i < 16; ++i) {
            const int r = i * 16 + r0;
            *(uint4*)(C + (size_t)(brow + r) * ldc + bcol + c16 * 8) = *(const uint4*)(lt + r * EPS_LD + c16 * 16);
        }
    }
};
struct EpiBf16TSStagedRM {
    static constexpr bool staged = true;
    bf16_t* Cb; int ld; const float* sa; const float* sb; char* lt; int brow, bcol;
    __device__ __forceinline__ void operator()(int row, int col, const f32x4& v) const {
        const float4 a = *(const float4*)(sa + row);
        const float b = sb[col];
        uint2 pk; pk.x = pack2(v[0] * a.x * b, v[1] * a.y * b); pk.y = pack2(v[2] * a.z * b, v[3] * a.w * b);
        *(uint2*)(lt + (col - bcol) * EPS_LD + (row - brow) * 2) = pk;
    }
    __device__ __forceinline__ void finish() const {
        int tid = threadIdx.x;
        asm volatile("" : "+v"(tid));
        const int c16 = tid & 31, r0 = tid >> 5;
#pragma unroll
        for (int i = 0; i < 16; ++i) {
            const int r = i * 16 + r0;
            *(uint4*)(Cb + (size_t)r * ld + c16 * 8) = *(const uint4*)(lt + r * EPS_LD + c16 * 16);
        }
    }
};
struct EpiBf16SKStaged {
    static constexpr bool staged = true;
    bf16_t* Cb; const float* sa; const float* sb; char* lt; int brow, bcol;
    __device__ __forceinline__ void operator()(int row, int col, const f32x4& v) const {
        const float s = sa[row];
        const float4 b = *(const float4*)(sb + col);
        uint2 pk; pk.x = pack2(v[0] * s * b.x, v[1] * s * b.y); pk.y = pack2(v[2] * s * b.z, v[3] * s * b.w);
        *(uint2*)(lt + (row - brow) * EPS_LD + (col - bcol) * 2) = pk;
    }
    __device__ __forceinline__ void finish() const {
        int tid = threadIdx.x;
        asm volatile("" : "+v"(tid));
        const int lane = tid & 63, w = tid >> 6, tl = lane >> 1, half = lane & 1;
#pragma unroll
        for (int i = 0; i < 16; ++i) {
            const int idx = i * 8 + w, hk = idx >> 3, tb = idx & 7;
            *(uint4*)(Cb + ((size_t)hk * T + tb * 32 + tl) * 16 + half * 8) = *(const uint4*)(lt + (tb * 32 + tl) * EPS_LD + (hk * 16 + half * 8) * 2);
        }
    }
};
struct EpiBf16TSStaged {
    static constexpr bool staged = true;
    bf16_t* Cb; const float* sa; const float* sb; char* lt; int brow, bcol;
    __device__ __forceinline__ void operator()(int row, int col, const f32x4& v) const {
        const float4 a = *(const float4*)(sa + row);
        const float b = sb[col];
        uint2 pk; pk.x = pack2(v[0] * a.x * b, v[1] * a.y * b); pk.y = pack2(v[2] * a.z * b, v[3] * a.w * b);
        *(uint2*)(lt + (col - bcol) * EPS_LD + (row - brow) * 2) = pk;
    }
    __device__ __forceinline__ void finish() const {
        int tid = threadIdx.x;
        asm volatile("" : "+v"(tid));
        const int d = tid & 63, w = tid >> 6;
#pragma unroll
        for (int i = 0; i < 16; ++i) {
            const int idx = i * 8 + w, hl = idx >> 5, kgl = idx & 31;
            *(uint4*)(Cb + ((size_t)(hl * 1024 + kgl) * 64 + d) * 8) = *(const uint4*)(lt + (hl * 64 + d) * EPS_LD + kgl * 16);
        }
    }
};
struct EpiBf16RowScale {
    bf16_t* C; int ldc; const float* ssrow;
    __device__ __forceinline__ void operator()(int row, int col, const f32x4& v) const {
        const float rs = rsqrtf(ssrow[row] * (1.0f / 1024.0f) + EPS);
        uint2 pk; pk.x = pack2(v[0] * rs, v[1] * rs); pk.y = pack2(v[2] * rs, v[3] * rs);
        *(uint2*)(C + (size_t)row * ldc + col) = pk;
    }
};
constexpr int ERN_LD = 1040;
template <int CTRL>
__device__ __forceinline__ float dpp_movf(float v) { return __int_as_float(__builtin_amdgcn_update_dpp(0, __float_as_int(v), CTRL, 0xf, 0xf, true)); }
struct EpiResNorm {
    bf16_t* C; const float* R; const float* g; int ldc; float* ssrow; unsigned* hmax;
    __device__ __forceinline__ void rows(const char* lt, int row0, int bcol, int w, int lane) const {
        const float4 gg = *(const float4*)(g + bcol + lane * 4);
        float4 xr[16];
#pragma unroll
        for (int rr = 0; rr < 16; ++rr) xr[rr] = *(const float4*)(R + (size_t)(row0 + w * 16 + rr) * ldc + bcol + lane * 4);
        __builtin_amdgcn_sched_barrier(0);
        float ssq[16], am[16];
#pragma unroll
        for (int rr = 0; rr < 16; ++rr) {
            const float4 a = *(const float4*)(lt + (w * 16 + rr) * ERN_LD + lane * 16);
            float4 o; o.x = a.x + xr[rr].x; o.y = a.y + xr[rr].y; o.z = a.z + xr[rr].z; o.w = a.w + xr[rr].w;
            uint2 xk; xk.x = pack2(o.x, o.y); xk.y = pack2(o.z, o.w);
            *(uint2*)(C + (size_t)(row0 + w * 16 + rr) * ldc + bcol + lane * 4) = xk;
            const float h0 = bflo(xk.x) * gg.x, h1 = bfhi(xk.x) * gg.y, h2 = bflo(xk.y) * gg.z, h3 = bfhi(xk.y) * gg.w;
            ssq[rr] = o.x * o.x + o.y * o.y + o.z * o.z + o.w * o.w;
            am[rr] = fmaxf(fmaxf(fabsf(h0), fabsf(h1)), fmaxf(fabsf(h2), fabsf(h3)));
        }
        float s8[8], m8[8], s4[4], m4[4];
#pragma unroll
        for (int j = 0; j < 8; ++j) {
            const auto rs = __builtin_amdgcn_permlane32_swap(__float_as_uint(ssq[j]), __float_as_uint(ssq[j + 8]), false, false);
            s8[j] = __uint_as_float(rs[0]) + __uint_as_float(rs[1]);
            const auto rm = __builtin_amdgcn_permlane32_swap(__float_as_uint(am[j]), __float_as_uint(am[j + 8]), false, false);
            m8[j] = fmaxf(__uint_as_float(rm[0]), __uint_as_float(rm[1]));
        }
#pragma unroll
        for (int j = 0; j < 4; ++j) {
            const auto rs = __builtin_amdgcn_permlane16_swap(__float_as_uint(s8[j]), __float_as_uint(s8[j + 4]), false, false);
            s4[j] = __uint_as_float(rs[0]) + __uint_as_float(rs[1]);
            const auto rm = __builtin_amdgcn_permlane16_swap(__float_as_uint(m8[j]), __float_as_uint(m8[j + 4]), false, false);
            m4[j] = fmaxf(__uint_as_float(rm[0]), __uint_as_float(rm[1]));
        }
#pragma unroll
        for (int j = 0; j < 4; ++j) {
            s4[j] += dpp_movf<DPP_QP_X1>(s4[j]); s4[j] += dpp_movf<DPP_QP_X2>(s4[j]); s4[j] += dpp_movf<DPP_HMIRROR>(s4[j]); s4[j] += dpp_movf<DPP_ROR8>(s4[j]);
            m4[j] = fmaxf(m4[j], dpp_movf<DPP_QP_X1>(m4[j])); m4[j] = fmaxf(m4[j], dpp_movf<DPP_QP_X2>(m4[j]));
            m4[j] = fmaxf(m4[j], dpp_movf<DPP_HMIRROR>(m4[j])); m4[j] = fmaxf(m4[j], dpp_movf<DPP_ROR8>(m4[j]));
        }
        const int j = lane & 15, rho = lane >> 4;
        if (j < 4) {
            const float sv = j == 0 ? s4[0] : j == 1 ? s4[1] : j == 2 ? s4[2] : s4[3];
            const float mv = j == 0 ? m4[0] : j == 1 ? m4[1] : j == 2 ? m4[2] : m4[3];
            const int row = row0 + w * 16 + j + 4 * (rho & 1) + 8 * (rho >> 1);
            atomicAdd(ssrow + row, sv);
            atomicMax(hmax + row, __float_as_uint(mv));
        }
    }
};
struct EpiResF32 {
    float* C; const float* R; int ldc;
    __device__ __forceinline__ void operator()(int row, int col, const f32x4& v) const {
        const float4 r = *(const float4*)(R + (size_t)row * ldc + col);
        float4 o; o.x = v[0] + r.x; o.y = v[1] + r.y; o.z = v[2] + r.z; o.w = v[3] + r.w;
        *(float4*)(C + (size_t)row * ldc + col) = o;
    }
};

template <bool TRANS, class Epi, bool ROWSS = false>
__device__ __forceinline__ void gemm_tile(const bf16_t* __restrict__ A, int lda, const bf16_t* __restrict__ Bt, int ldb, int K,
                                          int m0, int n0, char* smem, const Epi& epi, float* ssrow = nullptr) {
    const int tid = VTID, lane = tid & 63, w = tid >> 6, wr = w >> 1, wc = w & 1;
    const int fr = lane & 15, fq = lane >> 4;
    const int srow = lane >> 3, sslot = lane & 7;
    f32x4 acc[4][4];
#pragma unroll
    for (int mi = 0; mi < 4; ++mi)
#pragma unroll
        for (int ni = 0; ni < 4; ++ni) acc[mi][ni] = (f32x4){0.f, 0.f, 0.f, 0.f};
    const int g0 = (sslot ^ (srow >> 1)) * 8, g1 = (sslot ^ (4 + (srow >> 1))) * 8;
    const bf16_t* Ab = A + (size_t)(m0 + w * 32 + srow) * lda;
    const bf16_t* Bb = Bt + (size_t)(n0 + w * 32 + srow) * ldb;
    const int nk = K >> 6;
    __syncthreads();
#define GEMM_STAGE(kt, buf)                                                                                                  \
    do {                                                                                                                     \
        char* sa = smem + (buf) * 32768 + w * 4096;                                                                          \
        char* sb = sa + 16384;                                                                                               \
        _Pragma("unroll") for (int i = 0; i < 4; ++i) {                                                                      \
            const int gc = (i & 1) ? g1 : g0;                                                                                \
            __builtin_amdgcn_global_load_lds((const unsigned*)(Ab + (size_t)(i * 8) * lda + (kt) * 64 + gc), (unsigned*)(sa + i * 1024), 16, 0, 0); \
            __builtin_amdgcn_global_load_lds((const unsigned*)(Bb + (size_t)(i * 8) * ldb + (kt) * 64 + gc), (unsigned*)(sb + i * 1024), 16, 0, 0); \
        }                                                                                                                    \
    } while (0)
    GEMM_STAGE(0, 0);
    const int key = fr >> 1;
    for (int kt = 0; kt < nk; ++kt) {
        asm volatile("s_waitcnt vmcnt(0)" ::: "memory");
        __syncthreads();
        if (kt + 1 < nk) GEMM_STAGE(kt + 1, (kt + 1) & 1);
        const char* sa = smem + (kt & 1) * 32768;
        const char* sb = sa + 16384;
#pragma unroll
        for (int ks = 0; ks < 2; ++ks) {
            bf16x8 af[4], bfr[4];
            const int co = ((ks * 4 + fq) ^ key) << 4;
#pragma unroll
            for (int mi = 0; mi < 4; ++mi) af[mi] = *(const bf16x8*)(sa + (wr * 64 + mi * 16 + fr) * 128 + co);
#pragma unroll
            for (int ni = 0; ni < 4; ++ni) bfr[ni] = *(const bf16x8*)(sb + (wc * 64 + ni * 16 + fr) * 128 + co);
#pragma unroll
            for (int mi = 0; mi < 4; ++mi)
#pragma unroll
                for (int ni = 0; ni < 4; ++ni)
                    acc[mi][ni] = TRANS ? __builtin_amdgcn_mfma_f32_16x16x32_bf16(af[mi], bfr[ni], acc[mi][ni], 0, 0, 0)
                                        : __builtin_amdgcn_mfma_f32_16x16x32_bf16(bfr[ni], af[mi], acc[mi][ni], 0, 0, 0);
        }
    }
#undef GEMM_STAGE
    if constexpr (ROWSS) {
#pragma unroll
        for (int mi = 0; mi < 4; ++mi) {
            const int row = m0 + wr * 64 + mi * 16 + fr;
            float ssq = 0.f, am = 0.f;
#pragma unroll
            for (int ni = 0; ni < 4; ++ni) epi(row, n0 + wc * 64 + ni * 16 + fq * 4, acc[mi][ni], ssq, am);
            ssq += __shfl_xor(ssq, 16);
            ssq += __shfl_xor(ssq, 32);
            am = fmaxf(am, __shfl_xor(am, 16));
            am = fmaxf(am, __shfl_xor(am, 32));
            if (fq == 0) epi.row_done(row, ssq, am);
        }
    } else {
#pragma unroll
        for (int mi = 0; mi < 4; ++mi)
#pragma unroll
            for (int ni = 0; ni < 4; ++ni) {
                if (TRANS) epi(m0 + wr * 64 + mi * 16 + fq * 4, n0 + wc * 64 + ni * 16 + fr, acc[mi][ni]);
                else epi(m0 + wr * 64 + mi * 16 + fr, n0 + wc * 64 + ni * 16 + fq * 4, acc[mi][ni]);
            }
    }
}


namespace g8 {
constexpr int BM = 256, BK = 64, HALF = 128, HT = HALF * BK;
__device__ __forceinline__ int lds_byte(int r, int c) {
    const int st = (r >> 4) * 2 + (c >> 5), rr = r & 15, cc = c & 31, ob = rr * 64 + cc * 2;
    return st * 1024 + (ob ^ (((ob >> 9) & 1) << 5));
}
__device__ __forceinline__ void stage_rc(int b, int& R, int& C) {
    const int st = b / 1024, sb = b % 1024, swz = sb ^ (((sb >> 9) & 1) << 5);
    R = (st >> 1) * 16 + swz / 64; C = (st & 1) * 32 + (swz % 64) / 2;
}
__device__ __forceinline__ void tile_of(int L, int nM, int nN, int& pm, int& pn) {
    const int nwg = nM * nN;
    int wgid = L;
    { const int q = nwg / 8, r = nwg % 8, xcd = wgid % 8, off = wgid / 8; wgid = (xcd < r ? xcd * (q + 1) : r * (q + 1) + (xcd - r) * q) + off; }
    const int nig = 8 * nN, gid = wgid / nig, fm = gid * 8, gsz = (nM - fm) < 8 ? (nM - fm) : 8;
    pm = fm + ((wgid % nig) % gsz); pn = (wgid % nig) / gsz;
}
}

#define G8_LAS __attribute__((address_space(3)))
template <bool I8, bool TRANS, class Acc>
__device__ __forceinline__ void g8_mma(Acc& c, const bf16x8& a, const bf16x8& b) {
    if constexpr (I8) {
        const i32x4 ai = __builtin_bit_cast(i32x4, a), bi = __builtin_bit_cast(i32x4, b);
        c = TRANS ? __builtin_amdgcn_mfma_i32_16x16x64_i8(ai, bi, c, 0, 0, 0) : __builtin_amdgcn_mfma_i32_16x16x64_i8(bi, ai, c, 0, 0, 0);
    } else {
        c = TRANS ? __builtin_amdgcn_mfma_f32_16x16x32_bf16(a, b, c, 0, 0, 0) : __builtin_amdgcn_mfma_f32_16x16x32_bf16(b, a, c, 0, 0, 0);
    }
}
template <bool I8> struct g8_acc { using type = f32x4; };
template <> struct g8_acc<true> { using type = i32x4; };
template <bool I8, class Acc> __device__ __forceinline__ f32x4 g8_cvt(const Acc& a) {
    if constexpr (I8) return (f32x4){(float)a[0], (float)a[1], (float)a[2], (float)a[3]};
    else return a;
}
constexpr int G8_SCALE_OFF = 256 * 528;
template <bool TRANS, bool ROWSS, bool I8, class Epi>
__device__ __forceinline__ void gemm256_tile(const void* __restrict__ A, const void* __restrict__ Bt, int K, int brow, int bcol,
                                             char* shmc, const Epi& epi, const float* g_sa = nullptr, const float* g_sb = nullptr) {
    using namespace g8;
    constexpr int ES = I8 ? 1 : 2;
    using acc_t = typename g8_acc<I8>::type;
    G8_LAS unsigned char* lds = (G8_LAS unsigned char*)shmc;
    int tid = threadIdx.x;
    asm volatile("" : "+v"(tid));
    const int wid = __builtin_amdgcn_readfirstlane(tid >> 6), lane = tid & 63, wr = wid >> 2, wc = wid & 3, fr = lane & 15, fq = lane >> 4;
    constexpr int HTB = HALF * BK * 2;
    unsigned voff[2];
#pragma unroll
    for (int i = 0; i < 2; ++i) { int R, C; stage_rc(tid * 16 + i * 8192, R, C); voff[i] = (unsigned)(R * K * ES + C * 2); }
    const size_t kstep = (size_t)(BK * 2);
    const size_t hstep = (size_t)HALF * K * ES;
    const unsigned ldsw = (unsigned)wid * 1024u;
    const int aoff = lds_byte(wr * 64 + fr, fq * 8), boff = lds_byte(wc * 32 + fr, fq * 8);
    const char* cA = (const char*)A + (size_t)brow * K * ES;
    const char* cB = (const char*)Bt + (size_t)bcol * K * ES;
#define G8_SA(b, h) (((b) * 2 + (h)) * HTB)
#define G8_SB(b, h) ((4 + (b) * 2 + (h)) * HTB)
#define G8_STAGE(bufoff, gbase) do { _Pragma("unroll") for (int _i = 0; _i < 2; ++_i) \
        __builtin_amdgcn_global_load_lds((const unsigned*)((const char*)(gbase) + voff[_i]), (G8_LAS unsigned*)(lds + (bufoff) + ldsw + _i * 8192), 16, 0, 0); } while (0)
#define G8_LDA(dst, b, h) do { _Pragma("unroll") for (int m = 0; m < 4; ++m) _Pragma("unroll") for (int k = 0; k < 2; ++k) dst[m][k] = *(const G8_LAS bf16x8*)(lds + G8_SA(b, h) + aoff + m * 2048 + k * 1024); } while (0)
#define G8_LDB(dst, b, h) do { _Pragma("unroll") for (int n = 0; n < 2; ++n) _Pragma("unroll") for (int k = 0; k < 2; ++k) dst[n][k] = *(const G8_LAS bf16x8*)(lds + G8_SB(b, h) + boff + n * 2048 + k * 1024); } while (0)
#define G8_MMA(ai, bj, At_, Bt_) do { __builtin_amdgcn_s_setprio(1); _Pragma("unroll") for (int m = 0; m < 4; ++m) _Pragma("unroll") for (int n = 0; n < 2; ++n) _Pragma("unroll") for (int k = 0; k < 2; ++k) \
        g8_mma<I8, TRANS>(acc[ai][bj][m][n], At_[m][k], Bt_[n][k]); \
        __builtin_amdgcn_s_setprio(0); } while (0)
#define G8_WAIT_V(n) asm volatile("s_waitcnt vmcnt(" #n ")" ::: "memory")
#define G8_WAIT_L(n) asm volatile("s_waitcnt lgkmcnt(" #n ")" ::: "memory")
#define G8_BAR __builtin_amdgcn_s_barrier()
#define G8_SCHED __builtin_amdgcn_sched_barrier(0)
    acc_t acc[2][2][4][2];
#pragma unroll
    for (int a = 0; a < 2; ++a)
#pragma unroll
        for (int b = 0; b < 2; ++b)
#pragma unroll
            for (int m = 0; m < 4; ++m)
#pragma unroll
                for (int n = 0; n < 2; ++n) acc[a][b][m][n] = (acc_t){0, 0, 0, 0};
    bf16x8 At[4][2], B0[2][2], B1[2][2];
    const int nt = K * ES / (BK * 2);
    float pre_scale = 0.f;
    if (g_sa) pre_scale = (tid < 256) ? g_sa[brow + tid] : g_sb[bcol + tid - 256];
    __syncthreads();
    G8_STAGE(G8_SB(0, 0), cB); G8_STAGE(G8_SA(0, 0), cA); G8_STAGE(G8_SB(0, 1), cB + hstep); G8_STAGE(G8_SA(0, 1), cA + hstep);
    if (wr == 1) G8_BAR;
    G8_WAIT_V(4); G8_BAR;
    G8_STAGE(G8_SB(1, 0), cB + kstep); G8_STAGE(G8_SA(1, 0), cA + kstep); G8_STAGE(G8_SB(1, 1), cB + hstep + kstep);
    G8_WAIT_V(6); G8_BAR;
    for (int t = 0; t < nt - 2; t += 2) {
        const char* a1 = cA + (size_t)(t + 1) * kstep; const char* a2 = a1 + kstep; const char* a3 = a2 + kstep;
        const char* b2 = cB + (size_t)(t + 2) * kstep; const char* b3 = b2 + kstep;
        G8_LDB(B0, 0, 0); G8_SCHED; G8_LDA(At, 0, 0); G8_STAGE(G8_SA(1, 1), a1 + hstep);
        G8_WAIT_L(8); G8_BAR; G8_WAIT_L(0); G8_MMA(0, 0, At, B0); G8_BAR; G8_SCHED;
        G8_LDB(B1, 0, 1); G8_STAGE(G8_SB(0, 0), b2);
        G8_BAR; G8_WAIT_L(0); G8_MMA(0, 1, At, B1); G8_BAR;
        G8_LDA(At, 0, 1); G8_STAGE(G8_SA(0, 0), a2);
        G8_BAR; G8_WAIT_L(0); G8_MMA(1, 0, At, B0); G8_BAR; G8_SCHED;
        G8_STAGE(G8_SB(0, 1), b2 + hstep);
        G8_WAIT_V(6); G8_BAR; G8_MMA(1, 1, At, B1); G8_BAR;
        G8_LDB(B0, 1, 0); G8_SCHED; G8_LDA(At, 1, 0); G8_STAGE(G8_SA(0, 1), a2 + hstep);
        G8_WAIT_L(8); G8_BAR; G8_WAIT_L(0); G8_MMA(0, 0, At, B0); G8_BAR; G8_SCHED;
        G8_LDB(B1, 1, 1); G8_STAGE(G8_SB(1, 0), b3);
        G8_BAR; G8_WAIT_L(0); G8_MMA(0, 1, At, B1); G8_BAR;
        G8_LDA(At, 1, 1); G8_STAGE(G8_SA(1, 0), a3);
        G8_BAR; G8_WAIT_L(0); G8_MMA(1, 0, At, B0); G8_BAR; G8_SCHED;
        G8_STAGE(G8_SB(1, 1), b3 + hstep);
        G8_WAIT_V(6); G8_BAR; G8_MMA(1, 1, At, B1); G8_BAR;
    }
    { G8_LDB(B0, 0, 0); G8_LDA(At, 0, 0); G8_STAGE(G8_SA(1, 1), cA + (size_t)(nt - 1) * kstep + hstep);
      G8_BAR; G8_WAIT_L(0); G8_MMA(0, 0, At, B0); G8_BAR;
      G8_LDB(B1, 0, 1); G8_BAR; G8_WAIT_L(0); G8_MMA(0, 1, At, B1); G8_BAR;
      G8_LDA(At, 0, 1); G8_WAIT_V(4); G8_BAR; G8_WAIT_L(0); G8_MMA(1, 0, At, B0); G8_MMA(1, 1, At, B1); G8_BAR; }
    { G8_LDB(B0, 1, 0); G8_LDA(At, 1, 0); G8_WAIT_V(2); G8_BAR; G8_WAIT_L(0); G8_MMA(0, 0, At, B0); G8_BAR;
      G8_LDB(B1, 1, 1); G8_WAIT_V(0); G8_BAR; G8_WAIT_L(0); G8_MMA(0, 1, At, B1); G8_BAR;
      G8_LDA(At, 1, 1); G8_BAR; G8_WAIT_L(0); G8_MMA(1, 0, At, B0); G8_MMA(1, 1, At, B1); G8_BAR; }
    if (wr == 0) G8_BAR;
    if (g_sa) { ((float*)(shmc + G8_SCALE_OFF))[tid] = pre_scale; __syncthreads(); }
    if constexpr (ROWSS) {
        int tq = threadIdx.x;
        asm volatile("" : "+v"(tq));
        const int fr2 = tq & 15, fq2 = (tq >> 4) & 3;
        char* lw = shmc + (wr * 64 + fr2) * ERN_LD + (wc * 32 + fq2 * 4) * 4;
#pragma unroll
        for (int ai = 0; ai < 2; ++ai) {
            if (ai) __syncthreads();
#pragma unroll
            for (int bj = 0; bj < 2; ++bj)
#pragma unroll
                for (int m = 0; m < 4; ++m)
#pragma unroll
                    for (int n = 0; n < 2; ++n) *(f32x4*)(lw + m * 16 * ERN_LD + (bj * HALF + n * 16) * 4) = g8_cvt<I8>(acc[ai][bj][m][n]);
            __syncthreads();
            epi.rows(shmc, brow + ai * HALF, bcol, tq >> 6, tq & 63);
        }
    } else {
#pragma unroll
        for (int ai = 0; ai < 2; ++ai)
#pragma unroll
            for (int bj = 0; bj < 2; ++bj)
#pragma unroll
                for (int m = 0; m < 4; ++m)
#pragma unroll
                    for (int n = 0; n < 2; ++n) {
                        if (TRANS) epi(brow + ai * HALF + wr * 64 + m * 16 + fq * 4, bcol + bj * HALF + wc * 32 + n * 16 + fr, g8_cvt<I8>(acc[ai][bj][m][n]));
                        else epi(brow + ai * HALF + wr * 64 + m * 16 + fr, bcol + bj * HALF + wc * 32 + n * 16 + fq * 4, g8_cvt<I8>(acc[ai][bj][m][n]));
                    }
    }
#undef G8_SA
#undef G8_SB
#undef G8_STAGE
#undef G8_LDA
#undef G8_LDB
#undef G8_MMA
#undef G8_WAIT_V
#undef G8_WAIT_L
#undef G8_BAR
#undef G8_SCHED
}

__device__ void phase_gemm_in(const Params& p, char* smem) {
    const int nM = NTOK / 256, nN = INW / 256;
    const float* lsa = (const float*)(smem + G8_SCALE_OFF);
    const float* lsb = lsa + 256;
    for (int i = 0; i * (int)gridDim.x + (int)blockIdx.x < nM * nN; ++i) {
        int pm, pn;
        g8::tile_of(i * gridDim.x + blockIdx.x, nM, nN, pm, pn);
        if (pn >= 4 && pn < 6) {
            const int bb = (pm * 256) / T, rr = (pm * 256) % T;
            EpiBf16TSStaged e1t{p.vT() + ((size_t)(bb * 8 + (pn - 4) * 4) * 1024 + (rr >> 3)) * 512, lsa - pm * 256, lsb - pn * 256, smem, pm * 256, pn * 256};
            gemm256_tile<true, false, true>(p.hq(), p.w_in_q(), D, pm * 256, pn * 256, smem, e1t, p.sa(), p.sb());
            __syncthreads();
            e1t.finish();
        } else if (pn >= 2 && pn < 4) {
            const int bb = (pm * 256) / T, rr = (pm * 256) % T;
            EpiBf16SKStaged e1k{p.kK() + ((size_t)((bb * 8 + (pn - 2) * 4) * 4) * T + rr) * 16, lsa - pm * 256, lsb - pn * 256, smem, pm * 256, pn * 256};
            gemm256_tile<false, false, true>(p.hq(), p.w_in_q(), D, pm * 256, pn * 256, smem, e1k, p.sa(), p.sb());
            __syncthreads();
            e1k.finish();
        } else {
            EpiBf16SStaged e1{p.z(), INW, lsa - pm * 256, lsb - pn * 256, smem, pm * 256, pn * 256};
            gemm256_tile<false, false, true>(p.hq(), p.w_in_q(), D, pm * 256, pn * 256, smem, e1, p.sa(), p.sb());
            __syncthreads();
            e1.finish();
        }
    }
}

__device__ void phase_gemm_kv(const Params& p, char* smem) {
    const float* sam = p.sb() + 5632;
    const float* sbk = p.sb() + 5120;
    const float* lsa = (const float*)(smem + G8_SCALE_OFF);
    const float* lsb = lsa + 256;
    for (int it = blockIdx.x; it < 8; it += gridDim.x) {
        const int pm = it >> 1, pn = it & 1;
        int bc = pn * 256;
        asm volatile("" : "+v"(bc));
        bc = __builtin_amdgcn_readfirstlane(bc);
        if (pn) {
            EpiBf16TSStagedRM e2t{p.kvT() + (size_t)pm * 256 * 256, 256, lsa - pm * 256, lsb - bc, smem, pm * 256, bc};
            gemm256_tile<true, false, true>(p.memq(), p.w_kv_q(), D, pm * 256, bc, smem, e2t, sam, sbk);
            __syncthreads();
            e2t.finish();
        } else {
            EpiBf16SStaged e2{p.kvb(), 512, lsa - pm * 256, lsb - bc, smem, pm * 256, bc};
            gemm256_tile<false, false, true>(p.memq(), p.w_kv_q(), D, pm * 256, bc, smem, e2, sam, sbk);
            __syncthreads();
            e2.finish();
        }
    }
}

__device__ void phase_gemm_out(const Params& p, char* smem) {
    const int nM = NTOK / 256, nN = D / 256;
    EpiResNorm e{p.x1b(), p.x, p.ffn_g, D, p.ss1(), p.hmax()};
    for (int i = 0; i * (int)gridDim.x + (int)blockIdx.x < nM * nN; ++i) {
        int pm, pn;
        g8::tile_of(i * gridDim.x + blockIdx.x, nM, nN, pm, pn);
        gemm256_tile<false, true, false>(p.mix(), p.w_out_t(), D, pm * 256, pn * 256, smem, e);
    }
}

__device__ void phase_gemm_q(const Params& p, char* smem) {
    const int nM = NTOK / 256, nN = QW / 256;
    EpiBf16RowScale e{p.z(), QW, p.ss1()};
    for (int i = 0; i * (int)gridDim.x + (int)blockIdx.x < nM * nN; ++i) {
        int pm, pn;
        g8::tile_of(i * gridDim.x + blockIdx.x, nM, nN, pm, pn);
        gemm256_tile<false, false, false>(p.h(), p.w_q_t(), D, pm * 256, pn * 256, smem, e);
    }
}

typedef float f32x16 __attribute__((ext_vector_type(16)));
constexpr int HRS = 144;
__device__ __forceinline__ f32x16 tile_mm64(const char* X, const char* Y, int xrow0, int yrow0, int lane, f32x16 acc) {
    const int r = lane & 31, hh = lane >> 5;
#pragma unroll
    for (int ks = 0; ks < 4; ++ks) {
        const bf16x8 a = *(const bf16x8*)(X + (xrow0 + r) * HRS + ks * 32 + hh * 16);
        const bf16x8 b = *(const bf16x8*)(Y + (yrow0 + r) * HRS + ks * 32 + hh * 16);
        acc = __builtin_amdgcn_mfma_f32_32x32x16_bf16(a, b, acc, 0, 0, 0);
    }
    return acc;
}
__device__ __forceinline__ int crow(int reg, int hh) { return (reg & 3) + 8 * (reg >> 2) + 4 * hh; }

__device__ __forceinline__ void hg_load_vt(const Params& p, char* sVT, int tok0, int h, int kcol, int sq) {
    const bf16_t* zp = p.z() + (size_t)(tok0 + sq * 16) * INW + 2304 + h * 64 + kcol;
    unsigned pk[8];
#pragma unroll
    for (int j = 0; j < 8; ++j) {
        const unsigned lo = zp[(size_t)(2 * j) * INW], hi = zp[(size_t)(2 * j + 1) * INW];
        pk[j] = lo | (hi << 16);
    }
    *(uint4*)(sVT + kcol * HRS + sq * 32) = make_uint4(pk[0], pk[1], pk[2], pk[3]);
    *(uint4*)(sVT + kcol * HRS + sq * 32 + 16) = make_uint4(pk[4], pk[5], pk[6], pk[7]);
}

__device__ __forceinline__ float hg_gates(const Params& p, float* sTot, int tok0, int h, int dir, int kcol, int sq, float (&bj)[16], float (&kk)[16]) {
    const bf16_t* zp = p.z() + (size_t)(tok0 + sq * 16) * INW + 1792 + dir * 256 + h * 64 + kcol;
    const float lbv = p.lb()[dir * 256 + h * 64 + kcol];
#pragma unroll
    for (int j = 0; j < 16; ++j) {
        const float pre = bf2f(zp[(size_t)j * INW]);
        const float f = lbv + (1.0f - lbv) * fsigmoid(pre);
        bj[j] = flog2(f);
        kk[j] = 1.0f - f;
    }
    if (dir == 0) {
#pragma unroll
        for (int j = 1; j < 16; ++j) bj[j] += bj[j - 1];
        sTot[sq * 64 + kcol] = bj[15];
    } else {
#pragma unroll
        for (int j = 14; j >= 0; --j) bj[j] += bj[j + 1];
        sTot[sq * 64 + kcol] = bj[0];
    }
    __syncthreads();
    const float t0 = sTot[kcol], t1 = sTot[64 + kcol], t2 = sTot[128 + kcol], t3 = sTot[192 + kcol];
    float off;
    if (dir == 0) off = (sq > 0 ? t0 : 0.f) + (sq > 1 ? t1 : 0.f) + (sq > 2 ? t2 : 0.f);
    else off = (sq < 3 ? t3 : 0.f) + (sq < 2 ? t2 : 0.f) + (sq < 1 ? t1 : 0.f);
#pragma unroll
    for (int j = 0; j < 16; ++j) bj[j] += off;
    return t0 + t1 + t2 + t3;
}

__device__ __forceinline__ float hg_gates_r(const float* slb, float* sTot, const unsigned (&fp)[8], int h, int dir, int kcol, int sq, float (&bj)[16], float (&kk)[16]);
__device__ void hg_local(const Params& p, char* smem, int skip) {
    char* sVT = smem;
    char* sKT = smem + 9216;
    float* sTot = (float*)(smem + 18432);
    char* sStV = smem + 20480;
    char* sStF = smem + 29696;
    char* sOut = smem + 38912;
    int tid0 = threadIdx.x;
    asm volatile("" : "+v"(tid0));
    const int tid = tid0 & 255, lane = tid & 63, w = tid >> 6;
    const int kcol = tid & 63, sq = tid >> 6;
    const int crow0 = tid >> 3, cc8 = tid & 7;
    uint4 wv0, wv1, wf0, wf1, nv0, nv1, nf0, nf1;
#define HGL_LOAD(dv0, dv1, df0, df1, it_)                                                                         \
    {                                                                                                             \
        const int c_ = (it_) & 127, dir_ = ((it_) >> 7) & 1, h_ = ((it_) >> 8) & 3, b_ = (it_) >> 10;               \
        const bf16_t* zp_ = p.z() + (size_t)(b_ * T + c_ * 64 + crow0) * INW + h_ * 64 + cc8 * 8;                 \
        dv0 = *(const uint4*)(zp_ + 2304); dv1 = *(const uint4*)(zp_ + (size_t)32 * INW + 2304);                  \
        df0 = *(const uint4*)(zp_ + 1792 + dir_ * 256); df1 = *(const uint4*)(zp_ + (size_t)32 * INW + 1792 + dir_ * 256); \
    }
    wv0 = wv1 = wf0 = wf1 = nv0 = nv1 = nf0 = nf1 = make_uint4(0u, 0u, 0u, 0u);
    const int vb = VBID - skip, vg = VGRID - skip;
    if (vb < 4096) HGL_LOAD(wv0, wv1, wf0, wf1, vb)
    float* slb = (float*)(smem + 48128);
    __syncthreads();
    slb[tid] = p.lb()[tid]; slb[256 + tid] = p.lb()[256 + tid];
    __syncthreads();
    for (int item = vb; item < 4096; item += vg) {
        const int dir = (item >> 7) & 1, h = (item >> 8) & 3;
        if (item + vg < 4096) HGL_LOAD(nv0, nv1, nf0, nf1, item + vg)
        *(uint4*)(sStV + crow0 * HRS + cc8 * 16) = wv0; *(uint4*)(sStV + (crow0 + 32) * HRS + cc8 * 16) = wv1;
        *(uint4*)(sStF + crow0 * HRS + cc8 * 16) = wf0; *(uint4*)(sStF + (crow0 + 32) * HRS + cc8 * 16) = wf1;
        __syncthreads();
        unsigned cv[8], cf[8];
#pragma unroll
        for (int j = 0; j < 8; ++j) {
            const unsigned short* v0 = (const unsigned short*)(sStV + (sq * 16 + 2 * j) * HRS) + kcol;
            const unsigned short* f0 = (const unsigned short*)(sStF + (sq * 16 + 2 * j) * HRS) + kcol;
            cv[j] = (unsigned)v0[0] | ((unsigned)v0[HRS / 2] << 16);
            cf[j] = (unsigned)f0[0] | ((unsigned)f0[HRS / 2] << 16);
        }
        *(uint4*)(sVT + kcol * HRS + sq * 32) = make_uint4(cv[0], cv[1], cv[2], cv[3]);
        *(uint4*)(sVT + kcol * HRS + sq * 32 + 16) = make_uint4(cv[4], cv[5], cv[6], cv[7]);
        float bj[16], kk[16];
        const float btot = hg_gates_r(slb, sTot, cf, h, dir, kcol, sq, bj, kk);
        unsigned pk[8];
#pragma unroll
        for (int j = 0; j < 8; ++j)
            pk[j] = pack2(kk[2 * j] * fexp2(btot - bj[2 * j]), kk[2 * j + 1] * fexp2(btot - bj[2 * j + 1]));
        *(uint4*)(sKT + kcol * HRS + sq * 32) = make_uint4(pk[0], pk[1], pk[2], pk[3]);
        *(uint4*)(sKT + kcol * HRS + sq * 32 + 16) = make_uint4(pk[4], pk[5], pk[6], pk[7]);
        if (sq == 0) p.hdec()[item * 64 + kcol] = fexp2(btot);
        __syncthreads();
        const int vi = w >> 1, ki = w & 1, hh = lane >> 5;
        f32x16 acc;
#pragma unroll
        for (int r = 0; r < 16; ++r) acc[r] = 0.f;
        acc = tile_mm64(sVT, sKT, vi * 32, ki * 32, lane, acc);
#pragma unroll
        for (int r = 0; r < 16; ++r) *(bf16_t*)(sOut + (vi * 32 + crow(r, hh)) * HRS + (ki * 32 + (lane & 31)) * 2) = f2bf(acc[r]);
        __syncthreads();
        bf16_t* dst = (bf16_t*)p.hstate() + (size_t)item * 4096;
        *(uint4*)(dst + crow0 * 64 + cc8 * 8) = *(const uint4*)(sOut + crow0 * HRS + cc8 * 16);
        *(uint4*)(dst + (crow0 + 32) * 64 + cc8 * 8) = *(const uint4*)(sOut + (crow0 + 32) * HRS + cc8 * 16);
        wv0 = nv0; wv1 = nv1; wf0 = nf0; wf1 = nf1;
    }
#undef HGL_LOAD
}

__device__ __forceinline__ bf16x8 pack8(const f32x16& x, int s8) {
    typedef unsigned u32x4_t __attribute__((ext_vector_type(4)));
    u32x4_t pk;
    pk[0] = pack2(x[s8], x[s8 + 1]); pk[1] = pack2(x[s8 + 2], x[s8 + 3]);
    pk[2] = pack2(x[s8 + 4], x[s8 + 5]); pk[3] = pack2(x[s8 + 6], x[s8 + 7]);
    return __builtin_bit_cast(bf16x8, pk);
}
__device__ __forceinline__ bf16x8 join8(const uint2& lo, const uint2& hi) {
    typedef unsigned u32x4_t __attribute__((ext_vector_type(4)));
    u32x4_t pk; pk[0] = lo.x; pk[1] = lo.y; pk[2] = hi.x; pk[3] = hi.y;
    return __builtin_bit_cast(bf16x8, pk);
}

__device__ __forceinline__ int swap23(int r) { return (r & ~12) | ((r & 4) << 1) | ((r & 8) >> 1); }

__device__ __forceinline__ void store_o_wide(bf16_t* rowp, const f32x16& o, float inv, int hh) {
#pragma unroll
    for (int q = 0; q < 2; ++q) {
        const unsigned ax = pack2(o[8 * q] * inv, o[8 * q + 1] * inv), ay = pack2(o[8 * q + 2] * inv, o[8 * q + 3] * inv);
        const unsigned bx = pack2(o[8 * q + 4] * inv, o[8 * q + 5] * inv), by = pack2(o[8 * q + 6] * inv, o[8 * q + 7] * inv);
        const auto rx = __builtin_amdgcn_permlane32_swap(ax, bx, false, false);
        const auto ry = __builtin_amdgcn_permlane32_swap(ay, by, false, false);
        *(uint4*)(rowp + 16 * q + 8 * hh) = make_uint4(rx[0], ry[0], rx[1], ry[1]);
    }
}

__device__ __forceinline__ void mem_attn_wave(const Params& p, int wu, int lane, const char* sK, const char* sV) {
    const int tile = wu & 255, h = (wu >> 8) & 3, b = wu >> 10;
    const int l31 = lane & 31, hh = lane >> 5;
    const int tok = b * T + tile * 32 + l31;
    bf16x8 qf[4];
#pragma unroll
    for (int ks = 0; ks < 4; ++ks) qf[ks] = *(const bf16x8*)(p.z() + (size_t)tok * INW + 2816 + h * 64 + ks * 16 + hh * 8);
    const char* kb = sK + swap23(l31) * 144 + hh * 16;
    float m = -1e30f;
    f32x16 o0, o1;
#pragma unroll
    for (int r = 0; r < 16; ++r) { o0[r] = 0.f; o1[r] = 0.f; }
    float sum = 0.f;
    const char* vt = sV + l31 * 528 + hh * 16;
#pragma unroll 2
    for (int kt = 0; kt < 8; ++kt) {
        bf16x8 kf[4], vf[4];
#pragma unroll
        for (int ks = 0; ks < 4; ++ks) kf[ks] = *(const bf16x8*)(kb + kt * 32 * 144 + ks * 32);
#pragma unroll
        for (int st = 0; st < 2; ++st) { vf[2 * st] = *(const bf16x8*)(vt + kt * 64 + st * 32); vf[2 * st + 1] = *(const bf16x8*)(vt + 32 * 528 + kt * 64 + st * 32); }
        f32x16 s;
#pragma unroll
        for (int r = 0; r < 16; ++r) s[r] = 0.f;
#pragma unroll
        for (int ks = 0; ks < 4; ++ks) s = __builtin_amdgcn_mfma_f32_32x32x16_bf16(kf[ks], qf[ks], s, 0, 0, 0);
        float tm = s[0];
#pragma unroll
        for (int r = 1; r < 16; ++r) tm = fmaxf(tm, s[r]);
        tm = fmaxf(tm, __shfl_xor(tm, 32));
        if (!__all(tm <= m + 44.36f)) {
            const float mn = fmaxf(m, tm);
            const float sc = __builtin_amdgcn_exp2f((m - mn) * 0.18033688011112042f);
            sum *= sc;
#pragma unroll
            for (int r = 0; r < 16; ++r) { o0[r] *= sc; o1[r] *= sc; }
            m = mn;
        }
        const float mb = m * 0.18033688011112042f;
#pragma unroll
        for (int r = 0; r < 16; ++r) { s[r] = __builtin_amdgcn_exp2f(fmaf(s[r], 0.18033688011112042f, -mb)); sum += s[r]; }
#pragma unroll
        for (int st = 0; st < 2; ++st) {
            const bf16x8 pb = pack8(s, st * 8);
            o0 = __builtin_amdgcn_mfma_f32_32x32x16_bf16(vf[2 * st], pb, o0, 0, 0, 0);
            o1 = __builtin_amdgcn_mfma_f32_32x32x16_bf16(vf[2 * st + 1], pb, o1, 0, 0, 0);
        }
    }
    sum += __shfl_xor(sum, 32);
    const float inv = __builtin_amdgcn_rcpf(sum);
    bf16_t* mo = p.mix() + (size_t)tok * D + 768 + h * 64;
    store_o_wide(mo, o0, inv, hh);
    store_o_wide(mo + 32, o1, inv, hh);
}

struct NaCtx {
    const bf16_t* kbase; const bf16_t* vbase; const float* bh;
    int rs, r, c, c0, cb, hh;
    bf16x8 qf[4];
    float m, sum;
    f32x16 o0, o1;
};
template <int TI>
__device__ __forceinline__ void na_load(const NaCtx& x, bf16x8 (&kf)[4], bf16x8 (&vf)[4]) {
    constexpr int ip = TI / 3, cg = TI % 3;
    const bf16_t* kp = x.kbase + (ip * 128 + cg * 16) * 16;
#pragma unroll
    for (int ks = 0; ks < 4; ++ks) kf[ks] = *(const bf16x8*)(kp + (size_t)ks * T * 16);
    const bf16_t* vr = x.vbase + (ip * 16 + cg * 2) * 512;
#pragma unroll
    for (int st = 0; st < 2; ++st) { vf[2 * st] = *(const bf16x8*)(vr + st * 4096); vf[2 * st + 1] = *(const bf16x8*)(vr + st * 4096 + 256); }
}
template <int TI>
__device__ __forceinline__ void na_comp(NaCtx& x, const bf16x8 (&kf)[4], const bf16x8 (&vf)[4]) {
    constexpr int ip = TI / 3, cg = TI % 3;
    f32x16 s;
#pragma unroll
    for (int q = 0; q < 16; ++q) s[q] = 0.f;
#pragma unroll
    for (int ks = 0; ks < 4; ++ks) s = __builtin_amdgcn_mfma_f32_32x32x16_bf16(kf[ks], x.qf[ks], s, 0, 0, 0);
    const int kc0 = x.cb + 16 * cg + 8 * x.hh;
    const float* brow = x.bh + (x.rs + 2 * ip - x.r + 7) * 31 + 15 - x.c + kc0;
    const int d0 = kc0 - x.c0;
    float tm = -1e30f;
    float bv[16];
#pragma unroll
    for (int q = 0; q < 16; ++q) bv[q] = brow[(q & 3) + 4 * ((q >> 2) & 1) + 31 * (q >> 3)];
#pragma unroll
    for (int q = 0; q < 16; ++q) asm volatile("" : "+v"(bv[q]));
#pragma unroll
    for (int q = 0; q < 16; ++q) {
        const int cq = (q & 3) + 4 * ((q >> 2) & 1);
        const bool valid = (unsigned)(d0 + cq) < 16u;
        const float sc = valid ? fmaf(s[q], 0.18033688011112042f, bv[q]) : -INFINITY;
        s[q] = sc;
        tm = fmaxf(tm, sc);
    }
    tm = fmaxf(tm, __shfl_xor(tm, 32));
    if (!__all(tm <= x.m + 8.0f)) {
        const float mn = fmaxf(x.m, tm);
        const float scl = __builtin_amdgcn_exp2f(x.m - mn);
        x.sum *= scl;
#pragma unroll
        for (int q = 0; q < 16; ++q) { x.o0[q] *= scl; x.o1[q] *= scl; }
        x.m = mn;
    }
#pragma unroll
    for (int q = 0; q < 16; ++q) { const float pe = __builtin_amdgcn_exp2f(s[q] - x.m); s[q] = pe; x.sum += pe; }
#pragma unroll
    for (int st = 0; st < 2; ++st) {
        const bf16x8 pb = pack8(s, st * 8);
        x.o0 = __builtin_amdgcn_mfma_f32_32x32x16_bf16(vf[2 * st], pb, x.o0, 0, 0, 0);
        x.o1 = __builtin_amdgcn_mfma_f32_32x32x16_bf16(vf[2 * st + 1], pb, x.o1, 0, 0, 0);
    }
}

__device__ __forceinline__ void na_attn_wave(const Params& p, int wu, int lane, const float* sbias) {
    asm volatile("" : "+v"(lane));
    const int j = wu & 1, h = (wu >> 1) & 7, r = (wu >> 4) & 127, b = wu >> 11;
    const int l31 = lane & 31, hh = lane >> 5;
    NaCtx x;
    x.hh = hh; x.r = r;
    x.c = 32 * j + l31;
    x.c0 = min(max(x.c - 8, 0), 48); x.rs = min(max(r - 4, 0), 120);
    const int tokq = b * T + r * 64 + x.c;
    x.cb = 16 * j;
#pragma unroll
    for (int ks = 0; ks < 4; ++ks) x.qf[ks] = *(const bf16x8*)(p.z() + (size_t)tokq * INW + h * 64 + ks * 16 + hh * 8);
    x.bh = sbias + 64 + h * 465;
    const int kap = swap23(l31);
    x.kbase = p.kK() + ((size_t)((b * 8 + h) * 4) * T + (x.rs + (kap >> 4)) * 64 + x.cb + (kap & 15)) * 16 + hh * 8;
    x.vbase = p.vT() + ((size_t)(b * 8 + h) * 1024 + x.rs * 8 + 2 * j + hh) * 512 + l31 * 8;
    x.m = -1e30f; x.sum = 0.f;
#pragma unroll
    for (int q = 0; q < 16; ++q) { x.o0[q] = 0.f; x.o1[q] = 0.f; }
    bf16x8 k0[4], v0[4], k1[4], v1[4], k2[4], v2[4], k3[4], v3[4];
    na_load<0>(x, k0, v0); na_load<1>(x, k1, v1); na_load<2>(x, k2, v2);
    na_load<3>(x, k3, v3);  na_comp<0>(x, k0, v0);
    na_load<4>(x, k0, v0);  na_comp<1>(x, k1, v1);
    na_load<5>(x, k1, v1);  na_comp<2>(x, k2, v2);
    na_load<6>(x, k2, v2);  na_comp<3>(x, k3, v3);
    na_load<7>(x, k3, v3);  na_comp<4>(x, k0, v0);
    na_load<8>(x, k0, v0);  na_comp<5>(x, k1, v1);
    na_load<9>(x, k1, v1);  na_comp<6>(x, k2, v2);
    na_load<10>(x, k2, v2); na_comp<7>(x, k3, v3);
    na_load<11>(x, k3, v3); na_comp<8>(x, k0, v0);
    na_comp<9>(x, k1, v1);
    na_comp<10>(x, k2, v2);
    na_comp<11>(x, k3, v3);
    float sum = x.sum;
    sum += __shfl_xor(sum, 32);
    const float inv = __builtin_amdgcn_rcpf(sum);
    bf16_t* mo = p.mix() + (size_t)tokq * D + h * 64;
    store_o_wide(mo, x.o0, inv, hh);
    store_o_wide(mo + 32, x.o1, inv, hh);
}

__device__ void phase_gemm_kv(const Params& p, char* smem);
__device__ void phase_mixers(const Params& p, char* smem, char* smem_wg) {
    const int tid = VTID, lane = tid & 63, w = tid >> 6;
    {
        float* sbias = (float*)smem;
        __syncthreads();
        {
            float tb[15];
#pragma unroll
            for (int k = 0; k < 15; ++k) { const int i = tid + 256 * k; tb[k] = i < 8 * 465 ? p.rpb[i] : 0.f; }
#pragma unroll
            for (int k = 0; k < 15; ++k) { const int i = tid + 256 * k; if (i < 8 * 465) sbias[64 + i] = tb[k] * 1.4426950408889634f; }
        }
        __syncthreads();
        const bool xa = (gridDim.x & 7) == 0;
        const int hx = blockIdx.x & 7;
        const int ustart = xa ? (((int)blockIdx.x >> 3) * 2 + VHB) * 4 + w : VBID * 4 + w;
        const int ustride = xa ? (int)(gridDim.x >> 3) * 8 : VGRID * 4;
        const int ulimit = xa ? 1024 : 8192;
        for (int u = ustart; u < ulimit; u += ustride) {
            const int wu = xa ? (((u >> 8) << 11) | (((u >> 1) & 127) << 4) | (hx << 1) | (u & 1)) : u;
            na_attn_wave(p, wu, lane, sbias);
        }
    }
    __syncthreads();
    if (gridDim.x >= 64) {
        if (blockIdx.x < 8) phase_gemm_kv(p, smem_wg);
        else hg_local(p, smem, 16);
    } else {
        phase_gemm_kv(p, smem_wg);
        __syncthreads();
        hg_local(p, smem, 0);
    }
}

__device__ void phase_hg_scan(const Params& p, int hb, int nhb) {
    const int tid = VTID;
    for (int item = hb; item < 256; item += nhb) {
        const int g = item * 256 + tid;
        const int seq = g >> 11, kv = (g & 2047) * 2, k = kv & 63;
        const int dir = seq & 1;
        float S0 = 0.f, S1 = 0.f;
        for (int cc0 = 0; cc0 < 128; cc0 += 16) {
            unsigned L[16];
            float2 d[16];
#pragma unroll
            for (int u = 0; u < 16; ++u) {
                const int c = dir ? 127 - (cc0 + u) : cc0 + u;
                const size_t it = (size_t)seq * 128 + c;
                L[u] = *(const unsigned*)((const bf16_t*)p.hstate() + it * 4096 + kv);
                d[u] = *(const float2*)(p.hdec() + it * 64 + k);
            }
#pragma unroll
            for (int u = 0; u < 16; ++u) {
                const int c = dir ? 127 - (cc0 + u) : cc0 + u;
                const size_t it = (size_t)seq * 128 + c;
                *(unsigned*)((bf16_t*)p.h() + it * 4096 + kv) = pack2(S0, S1);
                S0 = d[u].x * S0 + bflo(L[u]);
                S1 = d[u].y * S1 + bfhi(L[u]);
            }
        }
    }
}

#define HG_DECL(P) uint4 P##q0, P##q1, P##fa0, P##fa1, P##fb0, P##fb1, P##v0, P##v1, P##g0, P##g1; uint2 P##sa0, P##sa1, P##sa2, P##sa3, P##sb0, P##sb1, P##sb2, P##sb3;
#define HG_ZERO(P) P##q0 = P##q1 = P##fa0 = P##fa1 = P##fb0 = P##fb1 = P##v0 = P##v1 = P##g0 = P##g1 = make_uint4(0u, 0u, 0u, 0u); \
    P##sa0 = P##sa1 = P##sa2 = P##sa3 = P##sb0 = P##sb1 = P##sb2 = P##sb3 = make_uint2(0u, 0u);
#define HG_LOAD(P, it_)                                                                                           \
    {                                                                                                             \
        const int c_ = (it_) & 127, h_ = ((it_) >> 7) & 3, b_ = (it_) >> 9;                                       \
        const bf16_t* zp_ = p.z() + (size_t)(b_ * T + c_ * 64 + (tid >> 3)) * INW + 1536 + h_ * 64 + (tid & 7) * 8; \
        const bf16_t* zq_ = zp_ + (size_t)32 * INW;                                                               \
        P##q0 = *(const uint4*)(zp_);         P##q1 = *(const uint4*)(zq_);                                       \
        P##fa0 = *(const uint4*)(zp_ + 256);  P##fa1 = *(const uint4*)(zq_ + 256);                                \
        P##fb0 = *(const uint4*)(zp_ + 512);  P##fb1 = *(const uint4*)(zq_ + 512);                                \
        P##v0 = *(const uint4*)(zp_ + 768);   P##v1 = *(const uint4*)(zq_ + 768);                                 \
        P##g0 = *(const uint4*)(zp_ + 1024);  P##g1 = *(const uint4*)(zq_ + 1024);                                \
        const bf16_t* sp_ = (const bf16_t*)p.h() + ((size_t)(((b_ * 4 + h_) * 2) * 128 + c_)) * 4096 + tid * 4;   \
        P##sa0 = *(const uint2*)(sp_); P##sa1 = *(const uint2*)(sp_ + 1024); P##sa2 = *(const uint2*)(sp_ + 2048); P##sa3 = *(const uint2*)(sp_ + 3072); \
        sp_ += (size_t)128 * 4096;                                                                                \
        P##sb0 = *(const uint2*)(sp_); P##sb1 = *(const uint2*)(sp_ + 1024); P##sb2 = *(const uint2*)(sp_ + 2048); P##sb3 = *(const uint2*)(sp_ + 3072); \
    }
#define HG_COPY(D, S) D##q0 = S##q0; D##q1 = S##q1; D##fa0 = S##fa0; D##fa1 = S##fa1; D##fb0 = S##fb0; D##fb1 = S##fb1; D##v0 = S##v0; D##v1 = S##v1; \
    D##g0 = S##g0; D##g1 = S##g1; D##sa0 = S##sa0; D##sa1 = S##sa1; D##sa2 = S##sa2; D##sa3 = S##sa3; D##sb0 = S##sb0; D##sb1 = S##sb1; D##sb2 = S##sb2; D##sb3 = S##sb3;
__device__ __forceinline__ float hg_gates_r(const float* slb, float* sTot, const unsigned (&fp)[8], int h, int dir, int kcol, int sq, float (&bj)[16], float (&kk)[16]) {
    const float lbv = slb[dir * 256 + h * 64 + kcol];
#pragma unroll
    for (int j = 0; j < 16; ++j) {
        const float pre = (j & 1) ? bfhi(fp[j >> 1]) : bflo(fp[j >> 1]);
        const float f = lbv + (1.0f - lbv) * fsigmoid(pre);
        bj[j] = flog2(f);
        kk[j] = 1.0f - f;
    }
    if (dir == 0) {
#pragma unroll
        for (int j = 1; j < 16; ++j) bj[j] += bj[j - 1];
        sTot[sq * 64 + kcol] = bj[15];
    } else {
#pragma unroll
        for (int j = 14; j >= 0; --j) bj[j] += bj[j + 1];
        sTot[sq * 64 + kcol] = bj[0];
    }
    __syncthreads();
    const float t0 = sTot[kcol], t1 = sTot[64 + kcol], t2 = sTot[128 + kcol], t3 = sTot[192 + kcol];
    float off;
    if (dir == 0) off = (sq > 0 ? t0 : 0.f) + (sq > 1 ? t1 : 0.f) + (sq > 2 ? t2 : 0.f);
    else off = (sq < 3 ? t3 : 0.f) + (sq < 2 ? t2 : 0.f) + (sq < 1 ? t1 : 0.f);
#pragma unroll
    for (int j = 0; j < 16; ++j) bj[j] += off;
    return t0 + t1 + t2 + t3;
}

__device__ void phase_hg_out(const Params& p, char* smem) {
    char* sQt = smem;
    char* sKt = smem + 9216;
    char* sQh = smem + 18432;
    char* sVT = smem + 27648;
    char* sST = smem + 36864;
    char* sP = smem + 46080;
    float* sTot = (float*)(smem + 55296);
    float* sSS = sTot + 256;
    const int tid = VTID, lane = tid & 63, w = tid >> 6;
    const int kcol = tid & 63, sq = tid >> 6;
    const int l31 = lane & 31, hh = lane >> 5;
    HG_DECL(cur_) HG_DECL(nxt_)
    HG_ZERO(cur_) HG_ZERO(nxt_)
    if (VBID < 2048) HG_LOAD(cur_, VBID)
    float* slb = (float*)(smem + 57344);
    float* sgn = slb + 512;
    __syncthreads();
    slb[tid] = p.lb()[tid]; slb[256 + tid] = p.lb()[256 + tid]; sgn[tid] = p.hg_g[tid];
    __syncthreads();
    for (int item = VBID; item < 2048; item += VGRID) {
        const int c = item & 127, h = (item >> 7) & 3, b = item >> 9;
        const int tok0 = b * T + c * 64;
        (void)c; (void)b;
        if (item + VGRID < 2048) HG_LOAD(nxt_, item + VGRID)
        {
            const int so = (tid >> 3) * HRS + (tid & 7) * 16;
            *(uint4*)(sQt + so) = cur_q0;  *(uint4*)(sQt + so + 32 * HRS) = cur_q1;
            *(uint4*)(sKt + so) = cur_fa0; *(uint4*)(sKt + so + 32 * HRS) = cur_fa1;
            *(uint4*)(sQh + so) = cur_fb0; *(uint4*)(sQh + so + 32 * HRS) = cur_fb1;
            *(uint4*)(sST + so) = cur_v0;  *(uint4*)(sST + so + 32 * HRS) = cur_v1;
            *(uint4*)(sP + so) = cur_g0;   *(uint4*)(sP + so + 32 * HRS) = cur_g1;
        }
        __syncthreads();
        unsigned cq[8], cfa[8], cfb[8], cvv[8];
        uint2 gzr[4];
#pragma unroll
        for (int j = 0; j < 8; ++j) {
            const int ro = (sq * 16 + 2 * j) * HRS + kcol * 2;
            cq[j] = (unsigned)*(const unsigned short*)(sQt + ro) | ((unsigned)*(const unsigned short*)(sQt + ro + HRS) << 16);
            cfa[j] = (unsigned)*(const unsigned short*)(sKt + ro) | ((unsigned)*(const unsigned short*)(sKt + ro + HRS) << 16);
            cfb[j] = (unsigned)*(const unsigned short*)(sQh + ro) | ((unsigned)*(const unsigned short*)(sQh + ro + HRS) << 16);
            cvv[j] = (unsigned)*(const unsigned short*)(sST + ro) | ((unsigned)*(const unsigned short*)(sST + ro + HRS) << 16);
        }
        {
            const int vi_ = w >> 1, ti_ = w & 1;
#pragma unroll
            for (int g = 0; g < 4; ++g) gzr[g] = *(const uint2*)(sP + (ti_ * 32 + l31) * HRS + (vi_ * 32 + 8 * g + 4 * hh) * 2);
        }
        *(uint4*)(sVT + kcol * HRS + sq * 32) = make_uint4(cvv[0], cvv[1], cvv[2], cvv[3]);
        *(uint4*)(sVT + kcol * HRS + sq * 32 + 16) = make_uint4(cvv[4], cvv[5], cvv[6], cvv[7]);
        float qv[16];
#pragma unroll
        for (int j = 0; j < 16; ++j) qv[j] = (j & 1) ? bfhi(cq[j >> 1]) : bflo(cq[j >> 1]);
        f32x16 accO;
#pragma unroll
        for (int r = 0; r < 16; ++r) accO[r] = 0.f;
        for (int dir = 0; dir < 2; ++dir) {
            float bj[16], kk[16];
            unsigned cfd[8];
#pragma unroll
            for (int j = 0; j < 8; ++j) cfd[j] = dir ? cfb[j] : cfa[j];
            const float btot = hg_gates_r(slb, sTot, cfd, h, dir, kcol, sq, bj, kk);
            const float bref = 0.5f * btot;
#pragma unroll
            for (int j = 0; j < 16; j += 2) {
                const int so = (sq * 16 + j) * HRS + kcol * 2;
                const unsigned a = pack2(qv[j] * fexp2(bj[j] - bref), qv[j + 1] * fexp2(bj[j + 1] - bref));
                const unsigned b = pack2(kk[j] * fexp2(bref - bj[j]), kk[j + 1] * fexp2(bref - bj[j + 1]));
                const unsigned c = pack2(qv[j] * fexp2(bj[j]), qv[j + 1] * fexp2(bj[j + 1]));
                *(bf16_t*)(sQt + so) = (bf16_t)a; *(bf16_t*)(sQt + so + HRS) = (bf16_t)(a >> 16);
                *(bf16_t*)(sKt + so) = (bf16_t)b; *(bf16_t*)(sKt + so + HRS) = (bf16_t)(b >> 16);
                *(bf16_t*)(sQh + so) = (bf16_t)c; *(bf16_t*)(sQh + so + HRS) = (bf16_t)(c >> 16);
            }
            {
                const int so = (tid >> 4) * HRS + (tid & 15) * 8;
                *(uint2*)(sST + so) = dir ? cur_sb0 : cur_sa0;
                *(uint2*)(sST + so + 16 * HRS) = dir ? cur_sb1 : cur_sa1;
                *(uint2*)(sST + so + 32 * HRS) = dir ? cur_sb2 : cur_sa2;
                *(uint2*)(sST + so + 48 * HRS) = dir ? cur_sb3 : cur_sa3;
            }
            __syncthreads();
            {
                const int si = w >> 1, ti = w & 1;
                const bool live = dir == 0 ? (si <= ti) : (si >= ti);
                f32x16 pt;
#pragma unroll
                for (int r = 0; r < 16; ++r) pt[r] = 0.f;
                if (live) pt = tile_mm64(sKt, sQt, si * 32, ti * 32, lane, pt);
                const int t = ti * 32 + l31;
#pragma unroll
                for (int g = 0; g < 4; ++g) {
                    const int s0 = si * 32 + 8 * g + 4 * hh;
                    float v0 = pt[4 * g], v1 = pt[4 * g + 1], v2 = pt[4 * g + 2], v3 = pt[4 * g + 3];
                    if (dir == 0) {
                        if (s0 > t) v0 = 0.f; if (s0 + 1 > t) v1 = 0.f; if (s0 + 2 > t) v2 = 0.f; if (s0 + 3 > t) v3 = 0.f;
                    } else {
                        if (s0 < t) v0 = 0.f; if (s0 + 1 < t) v1 = 0.f; if (s0 + 2 < t) v2 = 0.f; if (s0 + 3 < t) v3 = 0.f;
                    }
                    uint2 pk; pk.x = pack2(v0, v1); pk.y = pack2(v2, v3);
                    *(uint2*)(sP + t * HRS + s0 * 2) = pk;
                }
            }
            __syncthreads();
            {
                const int vi = w >> 1, ti = w & 1;
                accO = tile_mm64(sVT, sP, vi * 32, ti * 32, lane, accO);
                accO = tile_mm64(sST, sQh, vi * 32, ti * 32, lane, accO);
            }
        }
        const int vi = w >> 1, ti = w & 1;
        float ssq = 0.f;
#pragma unroll
        for (int r = 0; r < 16; ++r) ssq += accO[r] * accO[r];
        ssq += __shfl_xor(ssq, 32);
        sSS[w * 64 + lane] = ssq;
        __syncthreads();
        const float tot = sSS[ti * 64 + l31] + sSS[(2 + ti) * 64 + l31];
        const float rs = rsqrtf(tot * (1.0f / 64.0f) + EPS);
        const int tok = tok0 + ti * 32 + l31;
#pragma unroll
        for (int g = 0; g < 4; ++g) {
            const int v0 = vi * 32 + 8 * g + 4 * hh;
            const uint2 gz = gzr[g];
            const float4 gn = *(const float4*)(sgn + h * 64 + v0);
            const float g0 = bflo(gz.x), g1 = bfhi(gz.x), g2 = bflo(gz.y), g3 = bfhi(gz.y);
            const float o0 = accO[4 * g] * rs * gn.x * (g0 * fsigmoid(g0));
            const float o1 = accO[4 * g + 1] * rs * gn.y * (g1 * fsigmoid(g1));
            const float o2 = accO[4 * g + 2] * rs * gn.z * (g2 * fsigmoid(g2));
            const float o3 = accO[4 * g + 3] * rs * gn.w * (g3 * fsigmoid(g3));
            uint2 pk; pk.x = pack2(o0, o1); pk.y = pack2(o2, o3);
            *(uint2*)(p.mix() + (size_t)tok * D + 512 + h * 64 + v0) = pk;
        }
        HG_COPY(cur_, nxt_)
    }
}
__device__ void phase_mem_attn(const Params& p, char* smem, int hb, int nhb) {
    const int tid = VTID, lane = tid & 63, w = tid >> 6;
    for (int base = hb * 4; base < 4096; base += nhb * 4) {
        const int h = (base >> 8) & 3, b = base >> 10;
        char* sK = smem;
        char* sV = smem + 36864;
        __syncthreads();
        {
            uint4 kk[8], vv[8];
#pragma unroll
            for (int i = 0; i < 8; ++i) {
                const int ch = tid + 256 * i;
                kk[i] = *(const uint4*)(p.kvb() + (size_t)(b * 256 + (ch >> 3)) * 512 + h * 64 + (ch & 7) * 8);
                vv[i] = *(const uint4*)(p.kvT() + ((size_t)(b * 4 + h) * 64 + (ch >> 5)) * 256 + (ch & 31) * 8);
            }
#pragma unroll
            for (int i = 0; i < 8; ++i) {
                const int ch = tid + 256 * i;
                *(uint4*)(sK + (ch >> 3) * 144 + (ch & 7) * 16) = kk[i];
                *(uint4*)(sV + (ch >> 5) * 528 + (ch & 31) * 16) = vv[i];
            }
        }
        __syncthreads();
        mem_attn_wave(p, base + w, lane, sK, sV);
    }
}


constexpr int FK_NEG_INF = (int)0xFF800000;
__device__ __forceinline__ int fkmax(int a, int b) { int d; asm("v_max_f32 %0, %1, %2" : "=v"(d) : "v"(a), "v"(b)); return d; }
__device__ __forceinline__ int fkmin(int a, int b) { int d; asm("v_min_f32 %0, %1, %2" : "=v"(d) : "v"(a), "v"(b)); return d; }
__device__ __forceinline__ int ord_key(int fb) { return fb; }

template <int N>
__device__ __forceinline__ void bitonic_sort_desc(int (&v)[N]) {
#pragma unroll
    for (int k = 2; k <= N; k <<= 1) {
#pragma unroll
        for (int j = k >> 1; j > 0; j >>= 1) {
#pragma unroll
            for (int i = 0; i < N; ++i) {
                const int l = i ^ j;
                if (l > i) {
                    const bool desc = ((i & k) == 0);
                    const int a = v[i], b = v[l];
                    const int mx = fkmax(a, b), mn = fkmin(a, b);
                    v[i] = desc ? mx : mn;
                    v[l] = desc ? mn : mx;
                }
            }
        }
    }
}
template <int N>
__device__ __forceinline__ void oddeven_sort_desc(int (&v)[N]) {
#pragma unroll
    for (int p = 1; p < N; p <<= 1) {
#pragma unroll
        for (int k = p; k >= 1; k >>= 1) {
#pragma unroll
            for (int j = k % p; j <= N - 1 - k; j += 2 * k) {
#pragma unroll
                for (int i = 0; i <= (k - 1 < N - j - k - 1 ? k - 1 : N - j - k - 1); ++i) {
                    if ((i + j) / (2 * p) == (i + j + k) / (2 * p)) {
                        const int a = v[i + j], b = v[i + j + k];
                        v[i + j] = fkmax(a, b);
                        v[i + j + k] = fkmin(a, b);
                    }
                }
            }
        }
    }
}
template <int N>
__device__ __forceinline__ void bitonic_merge_desc(int (&v)[N]) {
#pragma unroll
    for (int j = N >> 1; j > 0; j >>= 1) {
#pragma unroll
        for (int i = 0; i < N; ++i) {
            const int l = i ^ j;
            if (l > i) {
                const int a = v[i], b = v[l];
                v[i] = fkmax(a, b);
                v[l] = fkmin(a, b);
            }
        }
    }
}
template <int N>
__device__ __forceinline__ void merge_prune16n(int (&r)[16], const int (&o)[16]) {
#pragma unroll
    for (int i = 16 - N; i < 16; ++i) r[i] = fkmax(r[i], o[15 - i]);
    bitonic_merge_desc<16>(r);
}
__device__ __forceinline__ void merge_prune16(int (&r)[16], const int (&o)[16]) {
#pragma unroll
    for (int i = 0; i < 16; ++i) r[i] = fkmax(r[i], o[15 - i]);
    bitonic_merge_desc<16>(r);
}

constexpr int QRS = 528;
struct EpiQpLds {
    char* qt; const float* rsa; const float* sb; int brow, bcol;
    __device__ __forceinline__ void operator()(int row, int col, const f32x4& v) const {
        const float rs = rsa[row];
        const float4 b = *(const float4*)(sb + col);
        uint2 pk; pk.x = pack2(v[0] * rs * b.x, v[1] * rs * b.y); pk.y = pack2(v[2] * rs * b.z, v[3] * rs * b.w);
        *(uint2*)(qt + (row - brow) * QRS + (col - bcol) * 2) = pk;
    }
};
__device__ __forceinline__ int* route_slot(char* wrows, int e) { return (int*)(wrows + (e >> 6) * QRS + (e & 63) * 4); }

__device__ __forceinline__ void table_row_load(const Params& p, float4 (&v)[4], int r, int lane) {
    const float* srcp = (r >= 16384 ? p.pv : p.pu) + (size_t)(r & 16383) * D;
#pragma unroll
    for (int j = 0; j < 4; ++j) v[j] = *(const float4*)(srcp + (j * 64 + lane) * 4);
}
__device__ __forceinline__ void table_row_finish(const Params& p, const float4 (&v)[4], int r, int lane) {
    const bool isv = r >= 16384;
    const int e = r & 16383;
    unsigned* dst = (unsigned*)(isv ? p.v_c() : p.u_c());
    float am = 0.f;
#pragma unroll
    for (int j = 0; j < 4; ++j) am = fmaxf(am, fmaxf(fmaxf(fabsf(v[j].x), fabsf(v[j].y)), fmaxf(fabsf(v[j].z), fabsf(v[j].w))));
    am = wave_max(am);
    const float qs = am > 0.f ? 127.0f * __builtin_amdgcn_rcpf(am) : 0.f;
    if (lane == 0) (isv ? p.scale_v() : p.scale_u())[e] = am * (1.0f / 127.0f);
#pragma unroll
    for (int j = 0; j < 4; ++j) {
        const int q0 = (int)rintf(v[j].x * qs), q1 = (int)rintf(v[j].y * qs), q2 = (int)rintf(v[j].z * qs), q3 = (int)rintf(v[j].w * qs);
        const unsigned pk = (unsigned)(q0 & 255) | ((unsigned)(q1 & 255) << 8) | ((unsigned)(q2 & 255) << 16) | ((unsigned)(q3 & 255) << 24);
        const int c = j * 2 + (lane >> 5), d = (lane & 31) * 4;
        dst[(((size_t)c * 16384 + e) * 128 + d) >> 2] = pk;
    }
}

__device__ __forceinline__ void route_tile(const Params& p, char* qt, int tok0, int h, int unit) {
    int tid = threadIdx.x;
    asm volatile("" : "+v"(tid));
    const int lane = tid & 63, w = tid >> 6;
    const int tl = lane & 31, hh = lane >> 5;
    float4 tr0[4], tr1[4];
    const int trow = unit * 32 + w * 4;
    table_row_load(p, tr0, trow, lane); table_row_load(p, tr1, trow + 1, lane);
    char* wrows = qt + (w * 32) * QRS;
    const int tok = tok0 + w * 32 + tl;
    const bf16_t* sp = p.subk_b() + (size_t)(h * 2) * 16384 + tl * 128 + hh * 8;
    bf16x8 an[8];
#pragma unroll
    for (int ks = 0; ks < 8; ++ks) an[ks] = *(const bf16x8*)(sp + ks * 16);
#pragma unroll
    for (int c = 0; c < 2; ++c) {
        bf16x8 qf[8];
#pragma unroll
        for (int ks = 0; ks < 8; ++ks) qf[ks] = *(const bf16x8*)(wrows + tl * QRS + (c * 128 + ks * 16 + hh * 8) * 2);
        int cur[16];
#pragma unroll
        for (int kb = 0; kb < 4; ++kb) {
            bf16x8 af[8];
#pragma unroll
            for (int ks = 0; ks < 8; ++ks) af[ks] = an[ks];
            if (c * 4 + kb + 1 < 8) {
                const bf16_t* sn = sp + (c * 4 + kb + 1) * 4096;
#pragma unroll
                for (int ks = 0; ks < 8; ++ks) an[ks] = *(const bf16x8*)(sn + ks * 16);
            }
            f32x16 acc;
#pragma unroll
            for (int r = 0; r < 16; ++r) acc[r] = 0.f;
#pragma unroll
            for (int ks = 0; ks < 8; ++ks) acc = __builtin_amdgcn_mfma_f32_32x32x16_bf16(af[ks], qf[ks], acc, 0, 0, 0);
            int v[16];
#pragma unroll
            for (int r = 0; r < 16; ++r) {
                const int key = kb * 32 + (r & 3) + 8 * (r >> 2) + 4 * hh;
                const int fb = (__float_as_int(acc[r]) & ~127) | (127 - key);
                v[r] = ord_key(fb);
            }
            oddeven_sort_desc<16>(v);
            if (kb == 0) {
#pragma unroll
                for (int r = 0; r < 16; ++r) cur[r] = v[r];
            } else {
                merge_prune16(cur, v);
            }
            __builtin_amdgcn_sched_barrier(0);
        }
        {
            int o[16];
#pragma unroll
            for (int r = 0; r < 16; ++r) o[r] = __shfl_xor(cur[r], 32);
            merge_prune16(cur, o);
        }
#pragma unroll
        for (int r = 0; r < 16; ++r) *route_slot(wrows, c * 512 + r * 32 + tl) = cur[r];
        if (c == 0) {
            table_row_finish(p, tr0, trow, lane); table_row_finish(p, tr1, trow + 1, lane);
            table_row_load(p, tr0, trow + 2, lane); table_row_load(p, tr1, trow + 3, lane);
        }
        __builtin_amdgcn_sched_barrier(0);
    }
    float va[16], vb[16];
#pragma unroll
    for (int r = 0; r < 16; ++r) {
        const int fa = ord_key(*route_slot(wrows, r * 32 + tl)), fb = ord_key(*route_slot(wrows, 512 + r * 32 + tl));
        va[r] = __int_as_float(fa & ~127);
        vb[r] = __int_as_float(fb & ~127);
    }
    int best[16];
#pragma unroll
    for (int j = 0; j < 16; ++j) best[j] = ord_key((__float_as_int(va[0] + vb[j]) & ~255) | (255 - j));
#define ROUTE_CAND_ROW(I)                                                                                         \
    {                                                                                                             \
        constexpr int n = 16 / ((I) + 1);                                                                         \
        int row[16];                                                                                              \
        _Pragma("unroll") for (int j = 0; j < 16; ++j)                                                            \
            row[j] = (j < n) ? ((__float_as_int(va[(I)] + vb[j]) & ~255) | (255 - ((I) * 16 + j))) : FK_NEG_INF;  \
        merge_prune16n<n>(best, row);                                                                             \
    }
    ROUTE_CAND_ROW(1) ROUTE_CAND_ROW(2) ROUTE_CAND_ROW(3) ROUTE_CAND_ROW(4) ROUTE_CAND_ROW(5) ROUTE_CAND_ROW(6) ROUTE_CAND_ROW(7)
#undef ROUTE_CAND_ROW
    {
        int row[16];
#pragma unroll
        for (int j = 0; j < 16; ++j)
            row[j] = (j < 8) ? ((__float_as_int(va[8 + j] + vb[0]) & ~255) | (255 - ((8 + j) * 16))) : FK_NEG_INF;
        merge_prune16n<8>(best, row);
    }
    float sv[16];
    int pid[16];
#pragma unroll
    for (int r = 0; r < 16; ++r) {
        const int cb = ord_key(best[r]);
        sv[r] = __int_as_float(cb & ~255);
        pid[r] = 255 - (cb & 255);
    }
    float tot = 0.f;
    const float smax = sv[0];
#pragma unroll
    for (int r = 0; r < 16; ++r) { sv[r] = fexp(sv[r] - smax); tot += sv[r]; }
    const float inv = __builtin_amdgcn_rcpf(tot);
    if (hh == 0) {
        unsigned ew[8];
#pragma unroll
        for (int r = 0; r < 16; ++r) {
            const int ia = 127 - (ord_key(*route_slot(wrows, (pid[r] >> 4) * 32 + tl)) & 127);
            const int ib = 127 - (ord_key(*route_slot(wrows, 512 + (pid[r] & 15) * 32 + tl)) & 127);
            const unsigned id = (unsigned)(ia * 128 + ib);
            if (r & 1) ew[r >> 1] |= id << 16; else ew[r >> 1] = id;
            sv[r] *= inv;
        }
        uint4* ep = (uint4*)(p.eidx() + (size_t)tok * 128 + h * 16);
        ep[0] = make_uint4(ew[0], ew[1], ew[2], ew[3]);
        ep[1] = make_uint4(ew[4], ew[5], ew[6], ew[7]);
        float4* gp = (float4*)(p.gate() + (size_t)tok * 128 + h * 16);
#pragma unroll
        for (int q = 0; q < 4; ++q) gp[q] = make_float4(sv[4 * q], sv[4 * q + 1], sv[4 * q + 2], sv[4 * q + 3]);
    }
    table_row_finish(p, tr0, trow + 2, lane); table_row_finish(p, tr1, trow + 3, lane);
}

__device__ void phase_gemm_q_route(const Params& p, char* smem) {
    const int nM = NTOK / 256, nN = QW / 256;
    for (int i = 0; i * (int)gridDim.x + (int)blockIdx.x < nM * nN; ++i) {
        int pm, pn;
        g8::tile_of(i * gridDim.x + blockIdx.x, nM, nN, pm, pn);
        const float* lsa = (const float*)(smem + G8_SCALE_OFF);
        EpiQpLds e{smem, lsa - pm * 256, lsa + 256 - pn * 256, pm * 256, pn * 256};
        gemm256_tile<false, false, true>(p.h2q(), p.w_q_q(), D, pm * 256, pn * 256, smem, e, p.sa(), p.sb() + INW);
        __syncthreads();
        route_tile(p, smem, pm * 256, pn, i * gridDim.x + blockIdx.x);
    }
}

__device__ void phase_route(const Params& p, char* smem) {
    char* sk = smem;
    const int tid = VTID, lane = tid & 63, w = tid >> 6;
    int* sA = (int*)(smem + 32768) + w * 2048;
    int* sB = (int*)(smem + 65536) + w * 512;
    const int tl = lane & 31, hh = lane >> 5;
    const int h = VBID & 7, tg0 = VBID >> 3, tgs = VGRID >> 3;
    for (int base = tg0; base < 256; base += 4 * tgs)
    for (int c = 0; c < 2; ++c) {
        const int hc = h * 2 + c;
        __syncthreads();
        {
            const bf16_t* sp = p.subk_b() + (size_t)hc * 16384;
#pragma unroll
            for (int i = 0; i < 8; ++i) {
                const int ch = tid + 256 * i;
                const int row = ch >> 4, cc = ch & 15;
                const uint4 v = *(const uint4*)(sp + row * 128 + cc * 8);
                *(uint4*)(sk + row * 256 + ((cc ^ (row & 15)) << 4)) = v;
            }
        }
        __syncthreads();
        bf16x8 qf[8];
        if (base < 256) {
            const bf16_t* qr = p.z() + (size_t)(base * 128 + w * 32 + tl) * QW + hc * 128 + hh * 8;
#pragma unroll
            for (int ks = 0; ks < 8; ++ks) qf[ks] = *(const bf16x8*)(qr + ks * 16);
        }
        for (int it = 0; it < 4; ++it) {
            const int tgp = base + it * tgs;
            if (tgp >= 256) break;
            const int tok = tgp * 128 + w * 32 + tl;
            int* sidx = sA + it * 512;
            f32x16 acc4[4];
#pragma unroll
            for (int kb = 0; kb < 4; ++kb) {
#pragma unroll
                for (int r = 0; r < 16; ++r) acc4[kb][r] = 0.f;
                const int row = kb * 32 + tl;
#pragma unroll
                for (int ks = 0; ks < 8; ++ks) {
                    const bf16x8 af = *(const bf16x8*)(sk + row * 256 + (((ks * 2 + hh) ^ (row & 15)) << 4));
                    acc4[kb] = __builtin_amdgcn_mfma_f32_32x32x16_bf16(af, qf[ks], acc4[kb], 0, 0, 0);
                }
            }
            if (it + 1 < 4 && tgp + tgs < 256) {
                const bf16_t* qr = p.z() + (size_t)((tgp + tgs) * 128 + w * 32 + tl) * QW + hc * 128 + hh * 8;
#pragma unroll
                for (int ks = 0; ks < 8; ++ks) qf[ks] = *(const bf16x8*)(qr + ks * 16);
            }
            int cur[16];
#pragma unroll
            for (int kb = 0; kb < 4; ++kb) {
                int v[16];
#pragma unroll
                for (int r = 0; r < 16; ++r) {
                    const int key = kb * 32 + (r & 3) + 8 * (r >> 2) + 4 * hh;
                    const int fb = (__float_as_int(acc4[kb][r]) & ~127) | (127 - key);
                    v[r] = ord_key(fb);
                }
                bitonic_sort_desc<16>(v);
                if (kb == 0) {
#pragma unroll
                    for (int r = 0; r < 16; ++r) cur[r] = v[r];
                } else {
                    merge_prune16(cur, v);
                }
            }
            {
                int o[16];
#pragma unroll
                for (int r = 0; r < 16; ++r) o[r] = __shfl_xor(cur[r], 32);
                merge_prune16(cur, o);
            }
            if (c == 0) {
#pragma unroll
                for (int r = 0; r < 16; ++r) sidx[r * 32 + tl] = cur[r];
                continue;
            }
#pragma unroll
            for (int r = 0; r < 16; ++r) sB[r * 32 + tl] = cur[r];
        float va[16], vb[16];
#pragma unroll
        for (int r = 0; r < 16; ++r) {
            const int fa = ord_key(sidx[r * 32 + tl]), fb = ord_key(sB[r * 32 + tl]);
            va[r] = __int_as_float(fa & ~127);
            vb[r] = __int_as_float(fb & ~127);
        }
        int best[16];
#pragma unroll
        for (int j = 0; j < 16; ++j) best[j] = ord_key((__float_as_int(va[0] + vb[j]) & ~255) | (255 - j));
#pragma unroll
        for (int i = 1; i < 8; ++i) {
            const int n = 16 / (i + 1);
            int row[16];
#pragma unroll
            for (int j = 0; j < 16; ++j)
                row[j] = (j < n) ? ord_key((__float_as_int(va[i] + vb[j]) & ~255) | (255 - (i * 16 + j))) : FK_NEG_INF;
            merge_prune16(best, row);
        }
        {
            int row[16];
#pragma unroll
            for (int j = 0; j < 16; ++j)
                row[j] = (j < 8) ? ord_key((__float_as_int(va[8 + j] + vb[0]) & ~255) | (255 - ((8 + j) * 16))) : FK_NEG_INF;
            merge_prune16(best, row);
        }
        float sv[16];
        int pid[16];
#pragma unroll
        for (int r = 0; r < 16; ++r) {
            const int cb = ord_key(best[r]);
            sv[r] = __int_as_float(cb & ~255);
            pid[r] = 255 - (cb & 255);
        }
        float tot = 0.f;
        const float smax = sv[0];
#pragma unroll
        for (int r = 0; r < 16; ++r) { sv[r] = __expf(sv[r] - smax); tot += sv[r]; }
        const float inv = 1.0f / tot;
        if (hh == 0) {
#pragma unroll
            for (int r = 0; r < 16; ++r) {
                const int ia = 127 - (ord_key(sidx[(pid[r] >> 4) * 32 + tl]) & 127);
                const int ib = 127 - (ord_key(sB[(pid[r] & 15) * 32 + tl]) & 127);
                const int pos = (r & 7) * 16 + h * 2 + (r >> 3);
                p.eidx()[(size_t)tok * 128 + pos] = (unsigned short)(ia * 128 + ib);
                p.gate()[(size_t)tok * 128 + pos] = sv[r] * inv;
            }
        }
        }
    }
}

constexpr int PEER_TG = 512;
constexpr int PEER_TPW = PEER_TG / 8;
constexpr int PEER_NTG = NTOK / PEER_TG;
constexpr int PEER_NCH = 8;

#define PEER_G1(base, wv, hi) (*(const uint4*)((base) + (unsigned)((((hi) ? ((wv) >> 16) : ((wv) & 0xFFFFu)) << 7) + dlo)))
#define PEER_GATHER16(dst, base, ia, ib)                                                             \
    dst[0] = PEER_G1(base, (ia).x, 0);  dst[1] = PEER_G1(base, (ia).x, 1);  dst[2] = PEER_G1(base, (ia).y, 0);  dst[3] = PEER_G1(base, (ia).y, 1);   \
    dst[4] = PEER_G1(base, (ia).z, 0);  dst[5] = PEER_G1(base, (ia).z, 1);  dst[6] = PEER_G1(base, (ia).w, 0);  dst[7] = PEER_G1(base, (ia).w, 1);   \
    dst[8] = PEER_G1(base, (ib).x, 0);  dst[9] = PEER_G1(base, (ib).x, 1);  dst[10] = PEER_G1(base, (ib).y, 0); dst[11] = PEER_G1(base, (ib).y, 1);  \
    dst[12] = PEER_G1(base, (ib).z, 0); dst[13] = PEER_G1(base, (ib).z, 1); dst[14] = PEER_G1(base, (ib).w, 0); dst[15] = PEER_G1(base, (ib).w, 1);

__device__ __forceinline__ unsigned quant4(float a, float b, float c, float d, float qs) {
    const int q0 = (int)rintf(__builtin_amdgcn_fmed3f(a * qs, -127.f, 127.f)), q1 = (int)rintf(__builtin_amdgcn_fmed3f(b * qs, -127.f, 127.f));
    const int q2 = (int)rintf(__builtin_amdgcn_fmed3f(c * qs, -127.f, 127.f)), q3 = (int)rintf(__builtin_amdgcn_fmed3f(d * qs, -127.f, 127.f));
    return (unsigned)(q0 & 255) | ((unsigned)(q1 & 255) << 8) | ((unsigned)(q2 & 255) << 16) | ((unsigned)(q3 & 255) << 24);
}
__device__ void phase_quant_h2(const Params& p) {
    const int tid = VTID, lane = tid & 63, w = tid >> 6;
    const float4* gp = (const float4*)(p.ffn_g + lane * 16);
    const float4 g0 = gp[0], g1 = gp[1], g2 = gp[2], g3 = gp[3];
    int r = VBID * 4 + w;
    uint4 xa = make_uint4(0u, 0u, 0u, 0u), xb = xa;
    float hm = 0.f;
    if (r < NTOK) { const uint4* xp = (const uint4*)(p.x1b() + (size_t)r * D + lane * 16); xa = xp[0]; xb = xp[1]; hm = __uint_as_float(p.hmax()[r]); }
    for (; r < NTOK; r += VGRID * 4) {
        const int rn = r + VGRID * 4;
        uint4 na = xa, nb = xb;
        float nhm = hm;
        if (rn < NTOK) { const uint4* xp = (const uint4*)(p.x1b() + (size_t)rn * D + lane * 16); na = xp[0]; nb = xp[1]; nhm = __uint_as_float(p.hmax()[rn]); }
        const float qs = hm > 0.f ? 127.0f * __builtin_amdgcn_rcpf(hm) : 0.f;
        uint4 o;
        o.x = quant4(bflo(xa.x) * g0.x, bfhi(xa.x) * g0.y, bflo(xa.y) * g0.z, bfhi(xa.y) * g0.w, qs);
        o.y = quant4(bflo(xa.z) * g1.x, bfhi(xa.z) * g1.y, bflo(xa.w) * g1.z, bfhi(xa.w) * g1.w, qs);
        o.z = quant4(bflo(xb.x) * g2.x, bfhi(xb.x) * g2.y, bflo(xb.y) * g2.z, bfhi(xb.y) * g2.w, qs);
        o.w = quant4(bflo(xb.z) * g3.x, bfhi(xb.z) * g3.y, bflo(xb.w) * g3.z, bfhi(xb.w) * g3.w, qs);
        *(uint4*)(p.h2q() + (size_t)r * D + lane * 16) = o;
        if (lane == 0) p.sa()[r] = hm * (1.0f / 127.0f) * rsqrtf(p.ss1()[r] * (1.0f / 1024.0f) + EPS);
        xa = na; xb = nb; hm = nhm;
    }
}

template <int CTRL>
__device__ __forceinline__ int dpp_movi(int v) { return __builtin_amdgcn_update_dpp(0, v, CTRL, 0xf, 0xf, true); }

struct DotTok { uint4 ia, ib; uint4 ha; };
__device__ __forceinline__ void dots_load(const Params& p, DotTok& t, int tok, int c, int g, int d8) {
    const uint4* idp = (const uint4*)(p.eidx() + (size_t)tok * 128 + g * 16);
    t.ia = idp[0]; t.ib = idp[1];
    t.ha = *(const uint4*)(p.h2q() + (size_t)tok * D + c * 128 + d8 * 16);
}
__device__ __forceinline__ void dotsf_load(const Params& p, DotTok& t, int tokb, int s, int g, int d8) {
    dots_load(p, t, tokb + 8 * (s & 15), s >> 4, g, d8);
}
__device__ __forceinline__ void dotsf_finish(const uint4 (&uu)[16], const DotTok& t, int* part, int g, int d8) {
    const int h0 = (int)t.ha.x, h1 = (int)t.ha.y, h2 = (int)t.ha.z, h3 = (int)t.ha.w;
    int acc[16];
#pragma unroll
    for (int i = 0; i < 16; ++i) {
        int a = __builtin_amdgcn_sdot4((int)uu[i].x, h0, 0, false);
        a = __builtin_amdgcn_sdot4((int)uu[i].y, h1, a, false);
        a = __builtin_amdgcn_sdot4((int)uu[i].z, h2, a, false);
        a = __builtin_amdgcn_sdot4((int)uu[i].w, h3, a, false);
        a += dpp_movi<DPP_QP_X1>(a);
        a += dpp_movi<DPP_QP_X2>(a);
        a += dpp_movi<DPP_HMIRROR>(a);
        acc[i] = a;
    }
    if (d8 == 0) {
#pragma unroll
        for (int i = 0; i < 16; ++i) (void)__hip_atomic_fetch_add(part + g * 16 + i, acc[i], __ATOMIC_RELAXED, __HIP_MEMORY_SCOPE_WORKGROUP);
    }
}

__device__ __forceinline__ float gelu_erf(float v);

__device__ void phase_peer_dots(const Params& p, char* smem) {
    const int tid = threadIdx.x, lane = tid & 63, w = tid >> 6;
    const int g = lane >> 3, d8 = lane & 7;
    int* part = (int*)smem + w * 2048;
    _Float16* ssu = (_Float16*)(smem + 65536);
    _Float16* ssv = ssu + 16384;
    DotTok ta, tb, tn;
    if ((int)blockIdx.x < NTOK / 128) {
        dotsf_load(p, ta, (int)blockIdx.x * 128 + w, 0, g, d8);
        dotsf_load(p, tb, (int)blockIdx.x * 128 + w, 1, g, d8);
    }
    __syncthreads();
    {
        float4 s4[16];
#pragma unroll
        for (int k = 0; k < 16; ++k) {
            const int i = tid + 512 * k;
            s4[k] = *(const float4*)((i >= 4096 ? p.scale_v() : p.scale_u()) + (size_t)(i & 4095) * 4);
        }
#pragma unroll
        for (int k = 0; k < 16; ++k) {
            const int i = tid + 512 * k;
            typedef _Float16 h4_t __attribute__((ext_vector_type(4)));
            h4_t hv; hv[0] = (_Float16)s4[k].x; hv[1] = (_Float16)s4[k].y; hv[2] = (_Float16)s4[k].z; hv[3] = (_Float16)s4[k].w;
            *(h4_t*)((i >= 4096 ? ssv : ssu) + (size_t)(i & 4095) * 4) = hv;
        }
    }
    for (int tgp = blockIdx.x; tgp < NTOK / 128; tgp += gridDim.x) {
        const int tokb = tgp * 128 + w;
        __syncthreads();
        for (int i = lane; i < 2048; i += 64) part[i] = 0;
        __syncthreads();
        const char* ubase = (const char*)p.u_c();
        const unsigned dlo = d8 * 16;
        uint4 ua[16], ubuf[16];
        if (tgp != (int)blockIdx.x) {
            dotsf_load(p, ta, tokb, 0, g, d8);
            dotsf_load(p, tb, tokb, 1, g, d8);
        }
        PEER_GATHER16(ua, ubase, ta.ia, ta.ib)
        PEER_GATHER16(ubuf, ubase, tb.ia, tb.ib)
        dotsf_load(p, tn, tokb, 2, g, d8);
        for (int s = 0; s < 128; s += 2) {
            dotsf_finish(ua, ta, part + (s & 15) * 128, g, d8);
            if (s + 2 < 128) {
                ta = tn;
                const char* ub = ubase + (size_t)((s + 2) >> 4) * 16384 * 128;
                PEER_GATHER16(ua, ub, ta.ia, ta.ib)
                dotsf_load(p, tn, tokb, min(s + 3, 127), g, d8);
            }
            dotsf_finish(ubuf, tb, part + ((s + 1) & 15) * 128, g, d8);
            if (s + 3 < 128) {
                tb = tn;
                const char* ub = ubase + (size_t)((s + 3) >> 4) * 16384 * 128;
                PEER_GATHER16(ubuf, ub, tb.ia, tb.ib)
                dotsf_load(p, tn, tokb, min(s + 4, 127), g, d8);
            }
        }
        __syncthreads();
        {
            int e[16][2];
            float gt[16][2], hm[16], s1[16];
#pragma unroll
            for (int k = 0; k < 16; ++k) {
                const int tok = tokb + 8 * k;
                hm[k] = __uint_as_float(p.hmax()[tok]);
                s1[k] = p.ss1()[tok];
#pragma unroll
                for (int u = 0; u < 2; ++u) {
                    e[k][u] = p.eidx()[(size_t)tok * 128 + lane + 64 * u];
                    gt[k][u] = p.gate()[(size_t)tok * 128 + lane + 64 * u];
                }
            }
#pragma unroll
            for (int k = 0; k < 16; ++k) {
                const int tok = tokb + 8 * k;
                const float sh = hm[k] * (1.0f / 127.0f) * rsqrtf(s1[k] * (1.0f / 1024.0f) + EPS);
                float cf[2];
#pragma unroll
                for (int u = 0; u < 2; ++u) {
                    const float su = (float)ssu[e[k][u]], sv = (float)ssv[e[k][u]];
                    cf[u] = gelu_erf((float)part[k * 128 + lane + 64 * u] * su * sh) * gt[k][u] * sv;
                }
                const float cm = wave_max(fmaxf(fabsf(cf[0]), fabsf(cf[1])));
                const float qs = cm > 0.f ? 127.0f * __builtin_amdgcn_rcpf(cm) : 0.f;
                p.coef()[(size_t)tok * 128 + lane] = (signed char)(int)rintf(cf[0] * qs);
                p.coef()[(size_t)tok * 128 + lane + 64] = (signed char)(int)rintf(cf[1] * qs);
                if (lane == 0) p.csum()[tok] = cm * (1.0f / 127.0f);
            }
        }
    }
}

__device__ __forceinline__ float gelu_erf(float v) {
    const float av = fabsf(v);
    const float t = __builtin_amdgcn_rcpf(fmaf(av, 0.2316418882f, 1.0f));
    float q = fmaf(t, 0.5307027145f, -0.7265760135f);
    q = fmaf(q, t, 0.7107068705f);
    q = fmaf(q, t, -0.142248368f);
    q = fmaf(q, t, 0.127414796f);
    q = q * t;
    const float e = __builtin_amdgcn_exp2f(v * v * -0.72134752044f);
    const float m = v * (q * e);
    return v < 0.f ? m : v - m;
}
struct AccTok { uint4 ia, ib; uint4 cq; float cs; };
__device__ __forceinline__ void acc_load(const Params& p, AccTok& t, int tok, int g) {
    const uint4* idp = (const uint4*)(p.eidx() + (size_t)tok * 128 + g * 16);
    t.ia = idp[0]; t.ib = idp[1];
    t.cq = *(const uint4*)(p.coef() + (size_t)tok * 128 + g * 16);
    t.cs = p.csum()[tok];
}
#define PEER_T4DOT(acc, B, r0, r1, r2, r3, cq)                                   \
    {                                                                            \
        const unsigned t0 = __builtin_amdgcn_perm(r1, r0, 0x05010400u), t1 = __builtin_amdgcn_perm(r1, r0, 0x07030602u); \
        const unsigned t2 = __builtin_amdgcn_perm(r3, r2, 0x05010400u), t3 = __builtin_amdgcn_perm(r3, r2, 0x07030602u); \
        acc[(B) + 0] = __builtin_amdgcn_sdot4((int)__builtin_amdgcn_perm(t2, t0, 0x05040100u), (int)(cq), acc[(B) + 0], false); \
        acc[(B) + 1] = __builtin_amdgcn_sdot4((int)__builtin_amdgcn_perm(t2, t0, 0x07060302u), (int)(cq), acc[(B) + 1], false); \
        acc[(B) + 2] = __builtin_amdgcn_sdot4((int)__builtin_amdgcn_perm(t3, t1, 0x05040100u), (int)(cq), acc[(B) + 2], false); \
        acc[(B) + 3] = __builtin_amdgcn_sdot4((int)__builtin_amdgcn_perm(t3, t1, 0x07060302u), (int)(cq), acc[(B) + 3], false); \
    }
__device__ __forceinline__ void accf_finish(const uint4 (&vv)[16], const AccTok& t, char* rowp, int g) {
    const unsigned cw[4] = {t.cq.x, t.cq.y, t.cq.z, t.cq.w};
    int acc[16];
#pragma unroll
    for (int j = 0; j < 16; ++j) acc[j] = 0;
#pragma unroll
    for (int j = 0; j < 4; ++j) {
        PEER_T4DOT(acc, 0, vv[4 * j].x, vv[4 * j + 1].x, vv[4 * j + 2].x, vv[4 * j + 3].x, cw[j])
        PEER_T4DOT(acc, 4, vv[4 * j].y, vv[4 * j + 1].y, vv[4 * j + 2].y, vv[4 * j + 3].y, cw[j])
        PEER_T4DOT(acc, 8, vv[4 * j].z, vv[4 * j + 1].z, vv[4 * j + 2].z, vv[4 * j + 3].z, cw[j])
        PEER_T4DOT(acc, 12, vv[4 * j].w, vv[4 * j + 1].w, vv[4 * j + 2].w, vv[4 * j + 3].w, cw[j])
    }
    int t8[8], u4[4];
#pragma unroll
    for (int j = 0; j < 8; ++j) {
        const auto r = __builtin_amdgcn_permlane32_swap((unsigned)acc[j], (unsigned)acc[j + 8], false, false);
        t8[j] = (int)(r[0] + r[1]);
    }
#pragma unroll
    for (int j = 0; j < 4; ++j) {
        const auto r = __builtin_amdgcn_permlane16_swap((unsigned)t8[j], (unsigned)t8[j + 4], false, false);
        u4[j] = (int)(r[0] + r[1]);
    }
    float o[4];
#pragma unroll
    for (int j = 0; j < 4; ++j) {
        int v = u4[j];
        v += dpp_movi<DPP_ROR8>(v);
        o[j] = (float)v * t.cs;
    }
    if ((g & 1) == 0) {
        const int rho = g >> 1;
        uint2 w0; w0.x = pack2(o[0], o[1]); w0.y = pack2(o[2], o[3]);
        *(uint2*)(rowp + (4 * (rho & 1) + 8 * (rho >> 1)) * 2) = w0;
    }
}

__device__ void phase_peer_accum(const Params& p, char* smem) {
    int tid = threadIdx.x;
    asm volatile("" : "+v"(tid));
    const int lane = tid & 63, w = tid >> 6;
    const int g = lane >> 3, d8 = lane & 7;
    char* rowbuf = smem + w * 16384;
    for (int tg2 = blockIdx.x * 2; tg2 < NTOK / 64; tg2 += (tg2 & 1) ? 2 * (int)gridDim.x - 1 : 1) {
        const int tokb = tg2 * 64 + w;
        __syncthreads();
        const char* vbase = (const char*)p.v_c();
        const unsigned dlo = d8 * 16;
        AccTok ta, tb, tn;
        uint4 va[16], vbuf[16];
        acc_load(p, ta, tokb, g);
        acc_load(p, tb, tokb + 8, g);
        PEER_GATHER16(va, vbase, ta.ia, ta.ib)
        PEER_GATHER16(vbuf, vbase, tb.ia, tb.ib)
        acc_load(p, tn, tokb + 16, g);
        for (int s = 0; s < 64; s += 2) {
            accf_finish(va, ta, rowbuf + (s & 7) * 2048 + (s >> 3) * 256 + d8 * 32, g);
            if (s + 2 < 64) {
                ta = tn;
                const char* vb = vbase + (size_t)((s + 2) >> 3) * 16384 * 128;
                PEER_GATHER16(va, vb, ta.ia, ta.ib)
                acc_load(p, tn, tokb + 8 * (min(s + 3, 63) & 7), g);
            }
            accf_finish(vbuf, tb, rowbuf + ((s + 1) & 7) * 2048 + ((s + 1) >> 3) * 256 + d8 * 32, g);
            if (s + 3 < 64) {
                tb = tn;
                const char* vb = vbase + (size_t)((s + 3) >> 3) * 16384 * 128;
                PEER_GATHER16(vbuf, vb, tb.ia, tb.ib)
                acc_load(p, tn, tokb + 8 * (min(s + 4, 63) & 7), g);
            }
        }
        __syncthreads();
        {
            float4 gg[4];
#pragma unroll
            for (int j = 0; j < 4; ++j) gg[j] = *(const float4*)(p.fin_g + (j * 64 + lane) * 4);
            for (int k0 = 0; k0 < 8; k0 += 4) {
                uint2 xk[4][4];
#pragma unroll
                for (int q = 0; q < 4; ++q) {
                    const bf16_t* xrow = p.x1b() + (size_t)(tokb + 8 * (k0 + q)) * D;
#pragma unroll
                    for (int j = 0; j < 4; ++j) xk[q][j] = *(const uint2*)(xrow + (j * 64 + lane) * 4);
                }
#pragma unroll
                for (int q = 0; q < 4; ++q) {
                    float* orow = p.out + (size_t)(tokb + 8 * (k0 + q)) * D;
                    const char* prow = rowbuf + (k0 + q) * 2048;
                    float4 v[4];
                    float ss = 0.f;
#pragma unroll
                    for (int j = 0; j < 4; ++j) {
                        const uint2 pk = *(const uint2*)(prow + (j * 64 + lane) * 8);
                        v[j].x = bflo(xk[q][j].x) + bflo(pk.x); v[j].y = bfhi(xk[q][j].x) + bfhi(pk.x);
                        v[j].z = bflo(xk[q][j].y) + bflo(pk.y); v[j].w = bfhi(xk[q][j].y) + bfhi(pk.y);
                        ss += v[j].x * v[j].x + v[j].y * v[j].y + v[j].z * v[j].z + v[j].w * v[j].w;
                    }
                    ss = wave_sum(ss);
                    const float rs = rsqrtf(ss * (1.0f / 1024.0f) + EPS);
#pragma unroll
                    for (int j = 0; j < 4; ++j) {
                        float4 o;
                        o.x = v[j].x * rs * gg[j].x; o.y = v[j].y * rs * gg[j].y; o.z = v[j].z * rs * gg[j].z; o.w = v[j].w * rs * gg[j].w;
                        *(float4*)(orow + (j * 64 + lane) * 4) = o;
                    }
                }
            }
        }
    }
}

#define XB_TMO      128
#define XB_XCNT(j)  (256  + 64 * (j))
#define XB_XSUB(j)  (1280 + 64 * (j))
#define XB_XGEN(j)  (2304 + 64 * (j))
#define XB_TOP      3328
#define XB_TOPGEN   3392
#define XCD_BAR_WORDS 3456
#define XB_SPIN_CAP (1u << 18)
__device__ __forceinline__ unsigned xb_ld(unsigned* p)              { return __hip_atomic_load(p, __ATOMIC_RELAXED, __HIP_MEMORY_SCOPE_AGENT); }
__device__ __forceinline__ unsigned xb_add(unsigned* p, unsigned v) { return __hip_atomic_fetch_add(p, v, __ATOMIC_RELAXED, __HIP_MEMORY_SCOPE_AGENT); }
#define XB_SPIN(cond, bar) do { unsigned _sp = 0; while (cond) { __builtin_amdgcn_s_sleep(1); \
    if ((++_sp & 255u) == 0u) { if (xb_ld(&(bar)[XB_TMO])) break; if (_sp > XB_SPIN_CAP) { atomicAdd(&(bar)[XB_TMO], 1u); break; } } } } while (0)

struct XcdBarrier { unsigned* bar; unsigned x; volatile unsigned* st; };

__device__ __forceinline__ XcdBarrier xcd_barrier_post(unsigned* bar, volatile unsigned* st) {
    XcdBarrier b; b.bar = bar; b.x = xcc_id(); b.st = st;
    if (threadIdx.x == 0) (void)xb_add(&bar[XB_XCNT(b.x)], 1u);
    return b;
}
__device__ __forceinline__ void xcd_barrier_complete(unsigned* bar, unsigned x, unsigned& nloc, unsigned& nx) {
    const unsigned G = gridDim.x * gridDim.y * gridDim.z;
    unsigned sum, cnt, mine, sp = 0u;
    for (;;) {
        sum = 0u; cnt = 0u; mine = 0u;
#pragma unroll
        for (unsigned j = 0; j < 16; ++j) { const unsigned c = xb_ld(&bar[XB_XCNT(j)]); sum += c; cnt += (c > 0u) ? 1u : 0u; mine = (j == x) ? c : mine; }
        if (sum == G) break;
        __builtin_amdgcn_s_sleep(1);
        if ((++sp & 255u) == 0u) { if (xb_ld(&bar[XB_TMO])) break; if (sp > XB_SPIN_CAP) { atomicAdd(&bar[XB_TMO], 1u); break; } }
    }
    nloc = mine > 0u ? mine : 1u; nx = cnt > 0u ? cnt : 1u;
}
__device__ __forceinline__ void xcd_barrier(const XcdBarrier& b) {
    asm volatile("s_waitcnt vmcnt(0)" ::: "memory");
    __syncthreads();
    if (threadIdx.x == 0) {
        unsigned* bar = b.bar;
        __builtin_amdgcn_s_waitcnt(0);
        unsigned nloc = b.st[0], nx = b.st[1];
        if (nloc == 0u) { xcd_barrier_complete(bar, b.x, nloc, nx); b.st[0] = nloc; b.st[1] = nx; }
        const unsigned old = xb_add(&bar[XB_XSUB(b.x)], 1u);
        const unsigned gen = old / nloc;
        if (old + 1u == (gen + 1u) * nloc) {
            __builtin_amdgcn_fence(__ATOMIC_RELEASE, "agent");
            asm volatile("s_waitcnt vmcnt(0)" ::: "memory");
            const unsigned og = xb_add(&bar[XB_TOP], 1u);
            const unsigned tg = og / nx;
            if (og + 1u == (tg + 1u) * nx) xb_add(&bar[XB_TOPGEN], 1u);
            else XB_SPIN(xb_ld(&bar[XB_TOPGEN]) == tg, bar);
            __builtin_amdgcn_fence(__ATOMIC_ACQUIRE, "agent");
            xb_add(&bar[XB_XGEN(b.x)], 1u);
            asm volatile("s_waitcnt vmcnt(0)" ::: "memory");
        } else {
            XB_SPIN(xb_ld(&bar[XB_XGEN(b.x)]) == gen, bar);
            __builtin_amdgcn_fence(__ATOMIC_ACQUIRE, "agent");
            asm volatile("s_waitcnt vmcnt(0)" ::: "memory");
        }
    }
    __syncthreads();
}

#define RUN_PHASE(K, CALL)                                              \
    if (ph_lo <= (K) && (K) < ph_hi) {                                  \
        CALL;                                                           \
        if (COOP) { if ((K) + 1 < ph_hi) { xcd_barrier(xb); } } \
    }

__device__ void phase_late_weights(const Params& p, char* smem, int hb, int nhb) {
    for (int it = hb; it < QW / 16 + 256; it += nhb) {
        if (it < QW / 16) transpose_cols_i8(p.w_q, p.w_q_q(), p.sb() + INW, QW, it, smem);
        else transpose_tile(p.w_out, p.w_out_t(), 1024, 1024, it - QW / 16, smem);
    }
}
__device__ void phase_scan_mem(const Params& p, char* smh) {
    const int G = gridDim.x;
    if (G >= 64) {
        if ((int)blockIdx.x < G / 2) { phase_hg_scan(p, VBID, G); phase_late_weights(p, smh, VBID, G); }
        else phase_mem_attn(p, smh, VBID - G, G);
    } else {
        phase_hg_scan(p, VBID, VGRID);
        phase_mem_attn(p, smh, VBID, VGRID);
        phase_late_weights(p, smh, VBID, VGRID);
    }
}
template <bool COOP>
__global__ void __launch_bounds__(512, 2) fwd_kernel(Params p, int ph_lo, int ph_hi) {
    __shared__ __attribute__((aligned(16))) char smem[SMEM_BYTES + 16];
#define smh ({ int t_ = threadIdx.x; asm volatile("" : "+v"(t_)); smem + (t_ >> 8) * HALF_SMEM; })
    XcdBarrier xb;
    if (COOP) {
        if (threadIdx.x == 0) *(uint4*)(smem + SMEM_BYTES) = make_uint4(0u, 0u, 0u, 0u);
        __syncthreads();
        xb = xcd_barrier_post(p.bar(), (volatile unsigned*)(smem + SMEM_BYTES));
    }
    if (COOP) { if (ph_lo < 0) cg::this_grid().sync(); }
    RUN_PHASE(0, phase_prep(p, smh))
    RUN_PHASE(1, phase_gemm_in(p, smem))
    RUN_PHASE(2, phase_mixers(p, smh, smem))
    RUN_PHASE(3, phase_scan_mem(p, smh))
    RUN_PHASE(4, phase_hg_out(p, smh))
    RUN_PHASE(5, phase_gemm_out(p, smem))
    RUN_PHASE(6, phase_quant_h2(p))
    RUN_PHASE(7, phase_gemm_q_route(p, smem))
    RUN_PHASE(10, (phase_peer_dots(p, smem), __threadfence_block(), __syncthreads(), phase_peer_accum(p, smem)))
}

extern "C" void kernel_launch(void* const* d_in, const int* in_sizes, int n_in, void* d_out, int out_size, void* d_ws, size_t ws_size,
                              hipStream_t stream) {
    Params p{};
    p.x = (const float*)d_in[0]; p.mem = (const float*)d_in[1]; p.attn_g = (const float*)d_in[2]; p.w_in = (const float*)d_in[3];
    p.rpb = (const float*)d_in[4]; p.hg_lb = (const float*)d_in[5]; p.hg_g = (const float*)d_in[6]; p.mem_g = (const float*)d_in[7];
    p.w_kv = (const float*)d_in[8]; p.w_out = (const float*)d_in[9]; p.ffn_g = (const float*)d_in[10]; p.w_q = (const float*)d_in[11];
    p.subk = (const float*)d_in[12]; p.pu = (const float*)d_in[13]; p.pv = (const float*)d_in[14]; p.fin_g = (const float*)d_in[15];
    p.out = (float*)d_out;
    p.ws = (char*)d_ws;
    if (WS_TOTAL > ws_size) { fprintf(stderr, "workspace too small: need %zu have %zu\n", (size_t)WS_TOTAL, ws_size); return; }

#if defined(MULTI_LAUNCH)
    for (int ph = 0; ph < NPHASE; ++ph) fwd_kernel<false><<<dim3(512), dim3(512), 0, stream>>>(p, ph, ph + 1);
#else
    static int grid_blocks = 0;
    if (!grid_blocks) {
        int dev = 0, cus = 0, per_cu = 0;
        hipGetDevice(&dev);
        hipDeviceGetAttribute(&cus, hipDeviceAttributeMultiprocessorCount, dev);
        hipOccupancyMaxActiveBlocksPerMultiprocessor(&per_cu, fwd_kernel<true>, 512, 0);
        if (per_cu > 1) per_cu = 1;
        grid_blocks = (cus * per_cu) & ~3;
    }
    (void)hipMemsetAsync((char*)d_ws + OFF_BAR, 0, XCD_BAR_WORDS * 4, stream);
    int lo = 0, hi = NPHASE;
    void* args[] = {&p, &lo, &hi};
    hipError_t e = hipLaunchCooperativeKernel((void*)fwd_kernel<true>, dim3(grid_blocks), dim3(512), args, 0, stream);
    if (e != hipSuccess) fprintf(stderr, "cooperative launch failed: %s (grid %d)\n", hipGetErrorString(e), grid_blocks);
#endif
}
```
